# Optimizing an MI355X kernel written in HIP

```python
import jax, jax.numpy as jnp
from jax import lax
import numpy as np

D_MODEL = 1024
BATCH = 1
SEQ = 16384
DEPTH = 4

RET_HEADS = 4
RET_DK = 64
RET_DV = 128
RET_CHUNK = 128
RET_THETA = 10000.0
DSA_HEADS = 8
DSA_KV_HEADS = 2
DSA_DH = 64
DSA_ROT = DSA_DH // 4
ROPE_THETA = 500000.0
IDX_HEADS = 4
IDX_DH = 64
IDX_ROT = IDX_DH // 4
TOPK_MAX = 256
Q_BLOCK = 128
GLA_HEADS = 4
GLA_DK = 64
GLA_DV = 128
GLA_RANK = 16
GLA_TAU = 16.0
GLA_CHUNK = 64

N_BRANCH = 3
RMS_EPS = 1e-6
RET_W = RET_HEADS * RET_DV
DSA_W = DSA_HEADS * DSA_DH
GLA_W = GLA_HEADS * GLA_DV

IN_SPLITS = (
    ("ret_q", RET_HEADS * RET_DK), ("ret_k", RET_HEADS * RET_DK),
    ("ret_v", RET_W), ("ret_g", RET_W),
    ("dsa_q", DSA_W), ("dsa_k", DSA_KV_HEADS * DSA_DH), ("dsa_v", DSA_KV_HEADS * DSA_DH),
    ("dsa_g", DSA_W),
    ("idx_q", IDX_HEADS * IDX_DH), ("idx_k", IDX_DH), ("idx_w", IDX_HEADS),
    ("gla_q", GLA_HEADS * GLA_DK), ("gla_k", GLA_HEADS * GLA_DK),
    ("gla_v", GLA_W), ("gla_g", GLA_W), ("gla_a", GLA_RANK),
    ("merge", N_BRANCH * D_MODEL),
)
IN_WIDTH = sum(w for _, w in IN_SPLITS)

kernel_name = "hybrid_retention_dsa_gla_gated_merge"


def rms_norm(x, gain=None):
    xf = x.astype(jnp.float32)
    y = xf * lax.rsqrt(jnp.mean(xf * xf, axis=-1, keepdims=True) + RMS_EPS)
    if gain is not None:
        y = y * gain.astype(jnp.float32)
    return y.astype(x.dtype)


def split_proj(p):
    bounds = np.cumsum([w for _, w in IN_SPLITS])[:-1].tolist()
    parts = jnp.split(p, bounds, axis=-1)
    return {name: t for (name, _), t in zip(IN_SPLITS, parts)}


def rope(x, pos, rot_dim, theta):
    half = rot_dim // 2
    freqs = theta ** (-jnp.arange(half, dtype=jnp.float32) * 2.0 / rot_dim)
    ang = pos.astype(jnp.float32)[..., None] * freqs
    cos = jnp.cos(ang)[:, :, None, :]
    sin = jnp.sin(ang)[:, :, None, :]
    xf = x.astype(jnp.float32)
    x1 = xf[..., :half]
    x2 = xf[..., half:rot_dim]
    out = jnp.concatenate([x1 * cos - x2 * sin, x2 * cos + x1 * sin, xf[..., rot_dim:]], axis=-1)
    return out.astype(x.dtype)


def retention(q, k, v, pos):
    dt = v.dtype
    B, S, H, dk = q.shape
    dv = v.shape[-1]
    C = RET_CHUNK
    n = S // C
    q = rope(q, pos, dk, RET_THETA).astype(jnp.float32) * (dk ** -0.5)
    k = rope(k, pos, dk, RET_THETA).astype(jnp.float32)
    v = v.astype(jnp.float32)
    log_g = jnp.log1p(-jnp.exp2(-5.0 - jnp.arange(H, dtype=jnp.float32)))
    idx = jnp.arange(C, dtype=jnp.float32)
    rel = idx[:, None] - idx[None, :]
    decay = jnp.where(rel >= 0, jnp.exp(log_g[:, None, None] * jnp.maximum(rel, 0.0)), 0.0)
    qc = q.reshape(B, n, C, H, dk)
    kc = k.reshape(B, n, C, H, dk)
    vc = v.reshape(B, n, C, H, dv)
    scores = jnp.einsum('bnihd,bnjhd->bnhij', qc, kc) * decay
    o_intra = jnp.einsum('bnhij,bnjhe->bnihe', scores, vc)
    to_end = jnp.exp((C - 1 - idx)[:, None] * log_g[None, :])
    kv = jnp.einsum('bnjhd,bnjhe->bnhde', kc * to_end[None, None, :, :, None], vc)
    chunk_decay = jnp.exp(C * log_g)[None, :, None, None]

    def step(state, kv_n):
        return chunk_decay * state + kv_n, state

    _, prev = lax.scan(step, jnp.zeros((B, H, dk, dv), jnp.float32), jnp.moveaxis(kv, 1, 0))
    prev = jnp.moveaxis(prev, 0, 1)
    q_dec = qc * jnp.exp((idx + 1.0)[:, None] * log_g[None, :])[None, None, :, :, None]
    o_cross = jnp.einsum('bnihd,bnhde->bnihe', q_dec, prev)
    return (o_intra + o_cross).reshape(B, S, H, dv).astype(dt)


def gla(q, k, v, log_a):
    dt = v.dtype
    B, S, H, dk = q.shape
    dv = v.shape[-1]
    C = GLA_CHUNK
    n = S // C
    q = q.astype(jnp.float32) * (dk ** -0.5)
    k = k.astype(jnp.float32)
    v = v.astype(jnp.float32)
    log_a = log_a.astype(jnp.float32)
    causal = jnp.tril(jnp.ones((C, C), bool))

    def to_chunks(t):
        return jnp.moveaxis(t.reshape(B, n, C, H, t.shape[-1]), 1, 0)

    def step(state, inp):
        qn, kn, vn, an = inp
        bcum = jnp.cumsum(an, axis=1)
        diff = bcum[:, :, None] - bcum[:, None, :]
        w = jnp.exp(jnp.where(causal[None, :, :, None, None], diff, -jnp.inf))
        attn = jnp.einsum('bihd,bjhd,bijhd->bhij', qn, kn, w)
        o = (jnp.einsum('bhij,bjhe->bihe', attn, vn)
             + jnp.einsum('bihd,bhde->bihe', qn * jnp.exp(bcum), state))
        b_last = bcum[:, -1]
        new = (jnp.exp(b_last)[..., None] * state
               + jnp.einsum('bjhd,bjhe->bhde', kn * jnp.exp(b_last[:, None] - bcum), vn))
        return new, o

    _, o = lax.scan(step, jnp.zeros((B, H, dk, dv), jnp.float32),
                    (to_chunks(q), to_chunks(k), to_chunks(v), to_chunks(log_a)))
    return jnp.moveaxis(o, 0, 1).reshape(B, S, H, dv).astype(dt)


def dsa_attention(q, k, v, q_idx, k_idx, w_idx, pos):
    B, S, H, dh = q.shape
    KV = k.shape[2]
    G = H // KV
    topk = min(TOPK_MAX, S // 4)
    QB = Q_BLOCK
    nb = S // QB
    q = rope(q, pos, DSA_ROT, ROPE_THETA)
    k = rope(k, pos, DSA_ROT, ROPE_THETA)
    q_idx = rope(q_idx, pos, IDX_ROT, ROPE_THETA)
    k_idx_f = rope(k_idx[:, :, None], pos, IDX_ROT, ROPE_THETA)[:, :, 0].astype(jnp.float32)
    w_f = w_idx.astype(jnp.float32) * (IDX_HEADS ** -0.5)
    key_pos = jnp.arange(S)

    def blockify(t):
        return jnp.moveaxis(t.reshape(B, nb, QB, *t.shape[2:]), 1, 0)

    def one_block(inp):
        qb, qib, wb, tb = inp
        s = jnp.einsum('bqhd,bsd->bqhs', qib.astype(jnp.float32), k_idx_f) * (IDX_DH ** -0.5)
        score = jnp.einsum('bqh,bqhs->bqs', wb, jax.nn.relu(s))
        visible = key_pos[None, :] <= tb[:, None]
        score = jnp.where(visible[None], score, -jnp.inf)
        _, sel = lax.top_k(score, topk)
        valid = sel <= tb[None, :, None]
        ks = jax.vmap(lambda kk, ii: kk[ii])(k, sel)
        vs = jax.vmap(lambda vv, ii: vv[ii])(v, sel)
        qg = qb.reshape(B, QB, KV, G, dh)
        logits = jnp.einsum('bqngd,bqknd->bqngk', qg, ks).astype(jnp.float32) * (dh ** -0.5)
        logits = jnp.where(valid[:, :, None, None, :], logits, -jnp.inf)
        p = jax.nn.softmax(logits, axis=-1).astype(vs.dtype)
        o = jnp.einsum('bqngk,bqknd->bqngd', p, vs)
        return o.reshape(B, QB, H * dh)

    t_blocks = jnp.arange(S).reshape(nb, QB)
    out = lax.map(one_block, (blockify(q), blockify(q_idx), blockify(w_f), t_blocks))
    return jnp.moveaxis(out, 0, 1).reshape(B, S, H * dh)


def setup_inputs(seed: int = 0) -> dict:
    key = jax.random.key(seed)
    ks = jax.random.split(key, 16)
    D = D_MODEL
    nrm = jax.random.normal
    x = nrm(ks[0], (BATCH, SEQ, D), jnp.float32)
    c = nrm(ks[1], (BATCH, D), jnp.float32)
    positions = (jnp.arange(SEQ, dtype=jnp.int32)[None, :]
                 + jax.random.randint(ks[2], (BATCH, 1), 0, 4096, dtype=jnp.int32))
    ada_w = nrm(ks[3], (DEPTH, D, 3 * D), jnp.float32) * (0.1 * D ** -0.5)
    ada_b = nrm(ks[4], (DEPTH, 3 * D), jnp.float32) * 0.02
    pre_norm = 1.0 + 0.05 * nrm(ks[5], (DEPTH, D), jnp.float32)
    post_norm = 1.0 + 0.05 * nrm(ks[6], (DEPTH, D), jnp.float32)
    w_in = nrm(ks[7], (DEPTH, D, IN_WIDTH), jnp.float32) * (D ** -0.5)
    gla_w_lr = nrm(ks[8], (DEPTH, GLA_RANK, GLA_HEADS * GLA_DK), jnp.float32) * (GLA_RANK ** -0.5)
    gla_b_lr = 0.1 * nrm(ks[9], (DEPTH, GLA_HEADS * GLA_DK), jnp.float32)
    w_br_ret = nrm(ks[10], (DEPTH, RET_W, D), jnp.float32) * (RET_W ** -0.5)
    w_br_dsa = nrm(ks[11], (DEPTH, DSA_W, D), jnp.float32) * (DSA_W ** -0.5)
    w_br_gla = nrm(ks[12], (DEPTH, GLA_W, D), jnp.float32) * (GLA_W ** -0.5)
    w_out = nrm(ks[13], (DEPTH, D, D), jnp.float32) * (D ** -0.5)
    return {"x": x, "c": c, "positions": positions, "ada_w": ada_w, "ada_b": ada_b,
            "pre_norm": pre_norm, "post_norm": post_norm, "w_in": w_in,
            "gla_w_lr": gla_w_lr, "gla_b_lr": gla_b_lr, "w_br_ret": w_br_ret,
            "w_br_dsa": w_br_dsa, "w_br_gla": w_br_gla, "w_out": w_out}


def reference(x, c, positions, ada_w, ada_b, pre_norm, post_norm, w_in, gla_w_lr, gla_b_lr,
              w_br_ret, w_br_dsa, w_br_gla, w_out):
    B, S, D = x.shape
    c_act = jax.nn.silu(c)
    for l in range(DEPTH):
        mod = c_act @ ada_w[l] + ada_b[l]
        shift, scale, gate = jnp.split(mod, 3, axis=-1)
        h = rms_norm(x, pre_norm[l]) * (1.0 + scale[:, None]) + shift[:, None]
        p = split_proj(h @ w_in[l])
        ret = retention(p["ret_q"].reshape(B, S, RET_HEADS, RET_DK),
                        p["ret_k"].reshape(B, S, RET_HEADS, RET_DK),
                        p["ret_v"].reshape(B, S, RET_HEADS, RET_DV), positions)
        ret = rms_norm(ret).reshape(B, S, RET_W) * jax.nn.silu(p["ret_g"])
        dsa = dsa_attention(p["dsa_q"].reshape(B, S, DSA_HEADS, DSA_DH),
                            p["dsa_k"].reshape(B, S, DSA_KV_HEADS, DSA_DH),
                            p["dsa_v"].reshape(B, S, DSA_KV_HEADS, DSA_DH),
                            p["idx_q"].reshape(B, S, IDX_HEADS, IDX_DH),
                            p["idx_k"], p["idx_w"], positions)
        dsa = dsa * jax.nn.silu(p["dsa_g"])
        log_a = jax.nn.log_sigmoid((p["gla_a"] @ gla_w_lr[l] + gla_b_lr[l]).astype(jnp.float32)) / GLA_TAU
        gl = gla(p["gla_q"].reshape(B, S, GLA_HEADS, GLA_DK),
                 p["gla_k"].reshape(B, S, GLA_HEADS, GLA_DK),
                 p["gla_v"].reshape(B, S, GLA_HEADS, GLA_DV),
                 log_a.reshape(B, S, GLA_HEADS, GLA_DK))
        gl = rms_norm(gl).reshape(B, S, GLA_W) * jax.nn.silu(p["gla_g"])
        g = jax.nn.sigmoid(p["merge"]).reshape(B, S, N_BRANCH, D)
        y = (g[:, :, 0] * (ret @ w_br_ret[l])
             + g[:, :, 1] * (dsa @ w_br_dsa[l])
             + g[:, :, 2] * (gl @ w_br_gla[l]))
        y = y @ w_out[l]
        x = x + gate[:, None] * rms_norm(y, post_norm[l])
    return x
```

```cpp
#include <hip/hip_runtime.h>
#include <hip/hip_cooperative_groups.h>
#include <stdint.h>
#include <cstdio>
namespace cg = cooperative_groups;

typedef _Float16 half_t;
typedef _Float16 h8 __attribute__((ext_vector_type(8)));
typedef _Float16 h4 __attribute__((ext_vector_type(4)));
typedef _Float16 h2 __attribute__((ext_vector_type(2)));
typedef float f16v __attribute__((ext_vector_type(16)));
typedef float f4v __attribute__((ext_vector_type(4)));

#define S_LEN 16384
#define DM 1024
#define NIN 7764
#define NPAD 7936
#define PP 7808
#define DEPTH 4
#define NTHREADS 256
#define LDS_BYTES 136192

#define C_RETQ 0
#define C_RETK 256
#define C_RETV 512
#define C_RETG 1024
#define C_DSAQ 1536
#define C_DSAK 2048
#define C_DSAV 2176
#define C_DSAG 2304
#define C_IDXQ 2816
#define C_IDXK 3072
#define C_GLAQ 3136
#define C_GLAK 3392
#define C_GLAV 3648
#define C_GLAG 4160
#define C_GLAA 4672
#define C_MRG 4688
#define C_END 7760
#define C_IDXW 7760

#define OFF_WINT 0ull
#define OFF_WBRT (OFF_WINT + 4ull * NPAD * 1024 * 2)
#define OFF_WOUTT (OFF_WBRT + 4ull * 3 * 1024 * 512 * 2)
#define OFF_MOD (OFF_WOUTT + 4ull * 1024 * 1024 * 2)
#define OFF_RT (OFF_MOD + 4ull * 3072 * 4)
#define OFF_DT (OFF_RT + 16384ull * 64 * 4)
#define OFF_H (OFF_DT + 16384ull * 16 * 4)
#define OFF_P (OFF_H + 16384ull * 1024 * 2)
#define OFF_GA (OFF_P + 16384ull * PP * 2)
#define OFF_IW (OFF_GA + 16384ull * 16 * 4)
#define OFF_ST (OFF_IW + 16384ull * 4 * 4)
#define OFF_DEC (OFF_ST + 256ull * 65536 * 4)
#define OFF_BR (OFF_DEC + 256ull * 8 * 64 * 4)
#define WS_END (OFF_BR + 16384ull * 1536 * 2)
static_assert(WS_END <= 508821504ull, "workspace too large");

struct Params {
  const float* x; const float* c; const int* pos; const float* ada_w; const float* ada_b;
  const float* pre_norm; const float* post_norm; const float* w_in; const float* gla_w_lr;
  const float* gla_b_lr; const float* w_br_ret; const float* w_br_dsa; const float* w_br_gla;
  const float* w_out; float* out; unsigned char* ws;
  int ph_lo; int ph_hi;
};

__device__ __forceinline__ int otid() { int t = (int)__builtin_amdgcn_workitem_id_x(); asm volatile("" : "+v"(t)); return t; }
__device__ __forceinline__ float wave_sum(float v) {
#pragma unroll
  for (int o = 32; o > 0; o >>= 1) v += __shfl_xor(v, o);
  return v;
}
__device__ __forceinline__ float wave_max(float v) {
#pragma unroll
  for (int o = 32; o > 0; o >>= 1) v = fmaxf(v, __shfl_xor(v, o));
  return v;
}
__device__ __forceinline__ f16v mfma16(h8 a, h8 b, f16v c) {
  return __builtin_amdgcn_mfma_f32_32x32x16_f16(a, b, c, 0, 0, 0);
}
__device__ __forceinline__ int crow(int r, int l) { return (r & 3) + 8 * (r >> 2) + 4 * (l >> 5); }

__device__ __forceinline__ int win_col(int nv) {
  if (nv < 3136) return nv;
  if (nv < 7760) return nv + 4;
  if (nv < 7764) return nv - 7760 + 3136;
  return -1;
}
__device__ void transpose_tile(const float* __restrict__ src, int ldn, half_t* __restrict__ dst, int K,
                               int k0, int n0, int mapmode, unsigned char* lds) {
  float* T = (float*)lds;
  const int tid = otid();
  const int nn = tid & 63;
  int col = n0 + nn;
  if (mapmode) col = win_col(col);
#pragma unroll
  for (int i = 0; i < 16; ++i) {
    int kk = (tid >> 6) + 4 * i;
    float v = 0.f;
    if (col >= 0) v = src[(size_t)(k0 + kk) * ldn + col];
    T[kk * 65 + nn] = v;
  }
  __syncthreads();
#pragma unroll
  for (int i = 0; i < 2; ++i) {
    int n2 = (tid >> 3) + 32 * i;
    int kc = tid & 7;
    h8 o;
#pragma unroll
    for (int q = 0; q < 8; ++q) o[q] = (half_t)T[(kc * 8 + q) * 65 + n2];
    *(h8*)(dst + (size_t)(n0 + n2) * K + k0 + kc * 8) = o;
  }
  __syncthreads();
}

__device__ void phase_prologue(const Params& p, unsigned char* lds) {
  const int tid = otid();
  half_t* WinT = (half_t*)(p.ws + OFF_WINT);
  half_t* WbrT = (half_t*)(p.ws + OFF_WBRT);
  half_t* WoutT = (half_t*)(p.ws + OFF_WOUTT);
  float* MOD = (float*)(p.ws + OFF_MOD);
  float* RT = (float*)(p.ws + OFF_RT);
  float* DT = (float*)(p.ws + OFF_DT);
  const int T_WIN = 4 * 124 * 16;
  const int T_WBR = 12 * 16 * 8;
  const int T_WOUT = 4 * 16 * 16;
  const int T_MOD = 192;
  const int T_ROPE = 16384 * 40 / 256;
  const int total = T_WIN + T_WBR + T_WOUT + T_MOD + T_ROPE;
  for (int task = blockIdx.x; task < total; task += gridDim.x) {
    int t = task;
    if (t < T_WIN) {
      int l = t / (124 * 16); int r = t % (124 * 16); int nt = r / 16, kt = r % 16;
      transpose_tile(p.w_in + (size_t)l * 1024 * NIN, NIN, WinT + (size_t)l * NPAD * 1024, 1024, kt * 64, nt * 64, 1, lds);
      continue;
    }
    t -= T_WIN;
    if (t < T_WBR) {
      int lb = t / 128; int r = t % 128; int nt = r / 8, kt = r % 8;
      int l = lb / 3, b = lb % 3;
      const float* src = (b == 0 ? p.w_br_ret : (b == 1 ? p.w_br_dsa : p.w_br_gla)) + (size_t)l * 512 * 1024;
      transpose_tile(src, 1024, WbrT + (size_t)lb * 1024 * 512, 512, kt * 64, nt * 64, 0, lds);
      continue;
    }
    t -= T_WBR;
    if (t < T_WOUT) {
      int l = t / 256; int r = t % 256; int nt = r / 16, kt = r % 16;
      transpose_tile(p.w_out + (size_t)l * 1024 * 1024, 1024, WoutT + (size_t)l * 1024 * 1024, 1024, kt * 64, nt * 64, 0, lds);
      continue;
    }
    t -= T_WOUT;
    if (t < T_MOD) {
      int l = t / 48, jb = t % 48;
      int j = jb * 64 + (tid & 63);
      int ig = tid >> 6;
      float acc = 0.f;
      const float* aw = p.ada_w + (size_t)l * 1024 * 3072;
      for (int i = ig * 256; i < ig * 256 + 256; ++i) {
        float cv = p.c[i];
        float sc = cv / (1.f + expf(-cv));
        acc += sc * aw[(size_t)i * 3072 + j];
      }
      float* red = (float*)lds;
      red[tid] = acc;
      __syncthreads();
      if (tid < 64) {
        float s = red[tid] + red[tid + 64] + red[tid + 128] + red[tid + 192];
        MOD[l * 3072 + j] = s + p.ada_b[l * 3072 + j];
      }
      __syncthreads();
      continue;
    }
    t -= T_MOD;
    {
      int e = t * 256 + tid;
      int tok = e / 40, f = e % 40;
      float pf = (float)p.pos[tok];
      if (f < 32) {
        float fr = powf(10000.0f, -(float)f * 2.0f / 64.0f);
        float ang = pf * fr;
        RT[tok * 64 + f * 2] = cosf(ang);
        RT[tok * 64 + f * 2 + 1] = sinf(ang);
      } else {
        int g = f - 32;
        float fr = powf(500000.0f, -(float)g * 2.0f / 16.0f);
        float ang = pf * fr;
        DT[tok * 16 + g * 2] = cosf(ang);
        DT[tok * 16 + g * 2 + 1] = sinf(ang);
      }
    }
  }
}

__device__ __forceinline__ void write_h_row(const float (&xv)[16], const float* __restrict__ pre,
                                            const float* __restrict__ mod, half_t* __restrict__ hrow, int l) {
  float ss = 0.f;
#pragma unroll
  for (int i = 0; i < 16; ++i) ss += xv[i] * xv[i];
  ss = wave_sum(ss);
  float rs = rsqrtf(ss * (1.0f / 1024.0f) + 1e-6f);
#pragma unroll
  for (int i = 0; i < 4; ++i) {
    int c0 = i * 256 + l * 4;
    f4v pg = *(const f4v*)(pre + c0);
    f4v sh = *(const f4v*)(mod + c0);
    f4v sc = *(const f4v*)(mod + 1024 + c0);
    h4 o;
#pragma unroll
    for (int q = 0; q < 4; ++q) o[q] = (half_t)(xv[i * 4 + q] * rs * pg[q] * (1.f + sc[q]) + sh[q]);
    *(h4*)(hrow + c0) = o;
  }
}

__device__ void phase_h0(const Params& p) {
  const int w = otid() >> 6, l = otid() & 63;
  half_t* H = (half_t*)(p.ws + OFF_H);
  const float* MOD = (const float*)(p.ws + OFF_MOD);
  for (int row = blockIdx.x * 4 + w; row < S_LEN; row += gridDim.x * 4) {
    float xv[16];
#pragma unroll
    for (int i = 0; i < 4; ++i) {
      f4v v = *(const f4v*)(p.x + (size_t)row * 1024 + i * 256 + l * 4);
      xv[i * 4] = v[0]; xv[i * 4 + 1] = v[1]; xv[i * 4 + 2] = v[2]; xv[i * 4 + 3] = v[3];
    }
    write_h_row(xv, p.pre_norm, MOD, H + (size_t)row * 1024, l);
  }
}

template <int NT>
__device__ __forceinline__ void gemm_kloop(f16v (&acc)[4][NT], const half_t* __restrict__ A, int lda,
                                           const half_t* __restrict__ B, int ldb, int K, unsigned char* lds) {
  const int tid = otid(), w = tid >> 6, l = tid & 63;
  unsigned char* As = lds;
  unsigned char* Bs = lds + 256 * 144;
  const int wm = w >> 1, wn = w & 1;
  h8 ra[8], rb[2 * NT];
  const int kc = tid & 7;
  const int r0 = tid >> 3;
#pragma unroll
  for (int i = 0; i < 8; ++i) ra[i] = *(const h8*)(A + (size_t)(r0 + 32 * i) * lda + kc * 8);
#pragma unroll
  for (int i = 0; i < 2 * NT; ++i) rb[i] = *(const h8*)(B + (size_t)(r0 + 32 * i) * ldb + kc * 8);
  const int nk = K / 64;
  for (int kt = 0; kt < nk; ++kt) {
    __syncthreads();
#pragma unroll
    for (int i = 0; i < 8; ++i) *(h8*)(As + (r0 + 32 * i) * 144 + kc * 16) = ra[i];
#pragma unroll
    for (int i = 0; i < 2 * NT; ++i) *(h8*)(Bs + (r0 + 32 * i) * 144 + kc * 16) = rb[i];
    __syncthreads();
    if (kt + 1 < nk) {
      const int k0 = (kt + 1) * 64;
#pragma unroll
      for (int i = 0; i < 8; ++i) ra[i] = *(const h8*)(A + (size_t)(r0 + 32 * i) * lda + k0 + kc * 8);
#pragma unroll
      for (int i = 0; i < 2 * NT; ++i) rb[i] = *(const h8*)(B + (size_t)(r0 + 32 * i) * ldb + k0 + kc * 8);
    }
#pragma unroll
    for (int ks = 0; ks < 4; ++ks) {
      h8 a[4], b[NT];
#pragma unroll
      for (int i = 0; i < 4; ++i) a[i] = *(const h8*)(As + (wm * 128 + i * 32 + (l & 31)) * 144 + ks * 32 + (l >> 5) * 16);
#pragma unroll
      for (int j = 0; j < NT; ++j) b[j] = *(const h8*)(Bs + (wn * 32 * NT + j * 32 + (l & 31)) * 144 + ks * 32 + (l >> 5) * 16);
#pragma unroll
      for (int i = 0; i < 4; ++i)
#pragma unroll
        for (int j = 0; j < NT; ++j) acc[i][j] = mfma16(a[i], b[j], acc[i][j]);
    }
  }
}

template <int NT>
__device__ __forceinline__ void zero_acc(f16v (&acc)[4][NT]) {
#pragma unroll
  for (int i = 0; i < 4; ++i)
#pragma unroll
    for (int j = 0; j < NT; ++j)
#pragma unroll
      for (int r = 0; r < 16; ++r) acc[i][j][r] = 0.f;
}

__device__ __forceinline__ void stage_pair(float* E, const f16v& a0, const f16v& a1, int l) {
#pragma unroll
  for (int r = 0; r < 16; ++r) {
    const int rr = crow(r, l);
    E[rr * 65 + (l & 31)] = a0[r];
    E[rr * 65 + 32 + (l & 31)] = a1[r];
  }
}

__device__ void phase_A(const Params& p, int layer, unsigned char* lds) {
  const int tid = otid(), w = tid >> 6, l = tid & 63;
  const half_t* H = (const half_t*)(p.ws + OFF_H);
  const half_t* Wt = (const half_t*)(p.ws + OFF_WINT) + (size_t)layer * NPAD * 1024;
  half_t* P = (half_t*)(p.ws + OFF_P);
  float* GA = (float*)(p.ws + OFF_GA);
  float* IW = (float*)(p.ws + OFF_IW);
  const float* RT = (const float*)(p.ws + OFF_RT);
  const float* DT = (const float*)(p.ws + OFF_DT);
  const int wm = w >> 1, wn = w & 1;
  const int G = gridDim.x;
  const int ntiles = 64 * 62;
  const int nrounds = (G == 256) ? 16 : (ntiles + G - 1) / G;
  for (int rnd = 0; rnd < nrounds; ++rnd) {
    int mt, nt;
    if (G == 256) {
      const int xcd = blockIdx.x & 7, loc = blockIdx.x >> 3;
      const int s = loc + 32 * rnd;
      mt = xcd * 8 + (s & 7); nt = s >> 3;
      if (nt >= 62) continue;
    } else {
      const int tix = rnd * G + blockIdx.x;
      if (tix >= ntiles) continue;
      mt = tix & 63; nt = tix >> 6;
    }
    f16v acc[4][2];
    zero_acc<2>(acc);
    gemm_kloop<2>(acc, H + (size_t)mt * 256 * 1024, 1024, Wt + (size_t)nt * 128 * 1024, 1024, 1024, lds);
    const int m0w = mt * 256 + wm * 128;
    const int n0w = nt * 128 + wn * 64;
    float* E = (float*)(lds + 73728) + w * (32 * 65);
    const int prow = l >> 3, c0 = (l & 7) * 8;
    {
      const int jp = 0;
      const int nb2 = n0w + jp * 64;
      const int n0 = nb2 + c0;
      const bool rope64 = nb2 < 512;
      const bool rope16 = ((nb2 >= C_DSAQ && nb2 < C_DSAV) || (nb2 >= C_IDXQ && nb2 < C_GLAQ)) && (c0 < 16);
      float scale = 1.f;
      if (n0 < 256 || (n0 >= C_DSAQ && n0 < C_DSAK) || (n0 >= C_IDXQ && n0 < C_IDXK) || (n0 >= C_GLAQ && n0 < C_GLAK)) scale = 0.125f;
      int mode = 0;
      if ((n0 >= C_RETG && n0 < C_DSAQ) || (n0 >= C_DSAG && n0 < C_IDXQ) || (n0 >= C_GLAG && n0 < C_GLAA)) mode = 1;
      if (n0 >= C_MRG && n0 < C_END) mode = 2;
#pragma unroll
      for (int i = 0; i < 4; ++i) {
        stage_pair(E, acc[i][2 * jp], acc[i][2 * jp + 1], l);
#pragma unroll 1
        for (int ps = 0; ps < 4; ++ps) {
          const int rl = ps * 8 + prow;
          const int row = m0w + i * 32 + rl;
          float v[8], o[8];
#pragma unroll
          for (int q = 0; q < 8; ++q) { v[q] = E[rl * 65 + c0 + q]; o[q] = v[q]; }
          if (rope64) {
            const int cp = c0 ^ 32;
            const float* tb = RT + (size_t)row * 64 + (c0 & 31) * 2;
#pragma unroll
            for (int q = 0; q < 8; ++q) {
              const float pv = E[rl * 65 + cp + q];
              const float cs = tb[2 * q], sn = tb[2 * q + 1];
              o[q] = (c0 < 32) ? (v[q] * cs - pv * sn) : (v[q] * cs + pv * sn);
            }
          } else if (rope16) {
            const int cp = c0 ^ 8;
            const float* tb = DT + (size_t)row * 16;
#pragma unroll
            for (int q = 0; q < 8; ++q) {
              const float pv = E[rl * 65 + cp + q];
              const float cs = tb[2 * q], sn = tb[2 * q + 1];
              o[q] = (c0 < 8) ? (v[q] * cs - pv * sn) : (v[q] * cs + pv * sn);
            }
          }
          h8 ov;
#pragma unroll
          for (int q = 0; q < 8; ++q) {
            float t = o[q] * scale;
            if (mode == 1) t = t / (1.f + __expf(-t));
            else if (mode == 2) t = 1.f / (1.f + __expf(-t));
            ov[q] = (half_t)t;
          }
          if (n0 < C_END) *(h8*)(P + (size_t)row * PP + n0) = ov;
          if (n0 >= C_GLAA && n0 < C_MRG) {
#pragma unroll
            for (int q = 0; q < 8; ++q) GA[(size_t)row * 16 + (n0 - C_GLAA) + q] = v[q];
          }
          if (n0 == C_IDXW) {
#pragma unroll
            for (int q = 0; q < 4; ++q) IW[(size_t)row * 4 + q] = 0.5f * v[q];
          }
        }
      }
    }
  }
}

#define LA_BC 0
#define LA_GAS 16640
#define LA_WL 20736
#define LA_QT 24832
#define LA_KT 34048
#define LA_AT 43264
#define LA_VT 52480
#define LA_SS 70912
#define LA_OS 89344
#define LA_SEG 123136

__device__ void la_bcum(const Params& p, int layer, int n, int Hh, unsigned char* lds) {
  const int tid = otid();
  float* Bc = (float*)(lds + LA_BC);
  const int d = tid & 63, q = tid >> 6;
  if (Hh < 4) {
    float lg = log1pf(-exp2f(-5.0f - (float)Hh));
#pragma unroll
    for (int jj = 0; jj < 16; ++jj) { int j = q * 16 + jj; Bc[j * 65 + d] = (float)(j + 1) * lg; }
    __syncthreads();
    return;
  }
  const int h = Hh - 4;
  float* GAs = (float*)(lds + LA_GAS);
  float* WL = (float*)(lds + LA_WL);
  float* SEG = (float*)(lds + LA_SEG);
  const float* GA = (const float*)(p.ws + OFF_GA);
#pragma unroll
  for (int i = 0; i < 4; ++i) {
    int e = tid + 256 * i;
    GAs[e] = GA[(size_t)n * 64 * 16 + e];
    int r = e >> 6, dd = e & 63;
    WL[e] = p.gla_w_lr[(size_t)layer * 16 * 256 + r * 256 + h * 64 + dd];
  }
  __syncthreads();
  float wl[16];
#pragma unroll
  for (int r = 0; r < 16; ++r) wl[r] = WL[r * 64 + d];
  const float bl = p.gla_b_lr[layer * 256 + h * 64 + d];
  float run = 0.f;
#pragma unroll
  for (int jj = 0; jj < 16; ++jj) {
    int j = q * 16 + jj;
    float z = bl;
#pragma unroll
    for (int r = 0; r < 16; ++r) z += GAs[j * 16 + r] * wl[r];
    float ls = fminf(z, 0.f) - log1pf(expf(-fabsf(z)));
    run += ls * (1.0f / 16.0f);
    Bc[j * 65 + d] = run;
  }
  SEG[q * 64 + d] = run;
  __syncthreads();
  float off = 0.f;
  for (int qq = 0; qq < q; ++qq) off += SEG[qq * 64 + d];
  if (q > 0) {
#pragma unroll
    for (int jj = 0; jj < 16; ++jj) { int j = q * 16 + jj; Bc[j * 65 + d] += off; }
  }
  __syncthreads();
}

__device__ __forceinline__ void la_stage_vt(const half_t* __restrict__ P, int t0, int vcol, unsigned char* lds) {
  const int tid = otid(), w = tid >> 6, l = tid & 63;
  half_t* VT = (half_t*)(lds + LA_VT);
  const int jp = l & 31, cgp = l >> 5;
#pragma unroll
  for (int it = 0; it < 2; ++it) {
    int c = it * 8 + w * 2 + cgp;
    h8 v0 = *(const h8*)(P + (size_t)(t0 + 2 * jp) * PP + vcol + c * 8);
    h8 v1 = *(const h8*)(P + (size_t)(t0 + 2 * jp + 1) * PP + vcol + c * 8);
#pragma unroll
    for (int q = 0; q < 8; ++q) {
      h2 pr; pr[0] = v0[q]; pr[1] = v1[q];
      *(h2*)(VT + (c * 8 + q) * 72 + 2 * jp) = pr;
    }
  }
}

__device__ void la_item_kv(const Params& p, int layer, int item, unsigned char* lds) {
  const int tid = otid(), w = tid >> 6, l = tid & 63;
  const int n = item >> 3, Hh = item & 7;
  const int t0 = n * 64;
  const half_t* P = (const half_t*)(p.ws + OFF_P);
  float* ST = (float*)(p.ws + OFF_ST);
  float* DEC = (float*)(p.ws + OFF_DEC);
  const int kcol = (Hh < 4) ? (C_RETK + Hh * 64) : (C_GLAK + (Hh - 4) * 64);
  const int vcol = (Hh < 4) ? (C_RETV + Hh * 128) : (C_GLAV + (Hh - 4) * 128);
  __syncthreads();
  la_bcum(p, layer, n, Hh, lds);
  const float* Bc = (const float*)(lds + LA_BC);
  half_t* KhT = (half_t*)(lds + LA_KT);
  half_t* VT = (half_t*)(lds + LA_VT);
  {
    const int jp = l & 31, cgp = l >> 5;
    int c = w * 2 + cgp;
    h8 k0 = *(const h8*)(P + (size_t)(t0 + 2 * jp) * PP + kcol + c * 8);
    h8 k1 = *(const h8*)(P + (size_t)(t0 + 2 * jp + 1) * PP + kcol + c * 8);
#pragma unroll
    for (int q = 0; q < 8; ++q) {
      int d = c * 8 + q;
      float bl = Bc[63 * 65 + d];
      h2 pr;
      pr[0] = (half_t)((float)k0[q] * __expf(bl - Bc[(2 * jp) * 65 + d]));
      pr[1] = (half_t)((float)k1[q] * __expf(bl - Bc[(2 * jp + 1) * 65 + d]));
      *(h2*)(KhT + d * 72 + 2 * jp) = pr;
    }
  }
  la_stage_vt(P, t0, vcol, lds);
  if (tid < 64) DEC[(size_t)item * 64 + tid] = __expf(Bc[63 * 65 + tid]);
  __syncthreads();
  f16v acc[2];
#pragma unroll
  for (int j = 0; j < 2; ++j)
#pragma unroll
    for (int r = 0; r < 16; ++r) acc[j][r] = 0.f;
#pragma unroll
  for (int ks = 0; ks < 4; ++ks) {
    h8 a = *(const h8*)(VT + (32 * w + (l & 31)) * 72 + ks * 16 + (l >> 5) * 8);
#pragma unroll
    for (int j = 0; j < 2; ++j) {
      h8 b = *(const h8*)(KhT + (j * 32 + (l & 31)) * 72 + ks * 16 + (l >> 5) * 8);
      acc[j] = mfma16(a, b, acc[j]);
    }
  }
#pragma unroll
  for (int j = 0; j < 2; ++j)
#pragma unroll
    for (int r = 0; r < 16; ++r) {
      int e = 32 * w + crow(r, l);
      int d = j * 32 + (l & 31);
      ST[(size_t)item * 8192 + e * 64 + d] = acc[j][r];
    }
}

__device__ void phase_scan(const Params& p) {
  float* ST = (float*)(p.ws + OFF_ST);
  const float* DEC = (const float*)(p.ws + OFF_DEC);
  for (int f = blockIdx.x * NTHREADS + otid(); f < 65536; f += gridDim.x * NTHREADS) {
    const int Hh = f >> 13, d = f & 63;
    float s = 0.f;
    for (int n0 = 0; n0 < 256; n0 += 8) {
      float kv[8], dc[8];
#pragma unroll
      for (int u = 0; u < 8; ++u) {
        kv[u] = ST[(size_t)(n0 + u) * 65536 + f];
        dc[u] = DEC[(size_t)((n0 + u) * 8 + Hh) * 64 + d];
      }
#pragma unroll
      for (int u = 0; u < 8; ++u) {
        ST[(size_t)(n0 + u) * 65536 + f] = s;
        s = dc[u] * s + kv[u];
      }
    }
  }
}

__device__ void la_item_out(const Params& p, int layer, int item, unsigned char* lds) {
  const int tid = otid(), w = tid >> 6, l = tid & 63;
  const int n = item >> 3, Hh = item & 7;
  const int t0 = n * 64;
  const half_t* P = (const half_t*)(p.ws + OFF_P);
  const float* ST = (const float*)(p.ws + OFF_ST);
  half_t* BR = (half_t*)(p.ws + OFF_BR);
  const int qcol = (Hh < 4) ? (C_RETQ + Hh * 64) : (C_GLAQ + (Hh - 4) * 64);
  const int kcol = (Hh < 4) ? (C_RETK + Hh * 64) : (C_GLAK + (Hh - 4) * 64);
  const int vcol = (Hh < 4) ? (C_RETV + Hh * 128) : (C_GLAV + (Hh - 4) * 128);
  const int gcol = (Hh < 4) ? (C_RETG + Hh * 128) : (C_GLAG + (Hh - 4) * 128);
  const int ocol = (Hh < 4) ? (Hh * 128) : (1024 + (Hh - 4) * 128);
  __syncthreads();
  la_bcum(p, layer, n, Hh, lds);
  const float* Bc = (const float*)(lds + LA_BC);
  half_t* Qt = (half_t*)(lds + LA_QT);
  half_t* Kt = (half_t*)(lds + LA_KT);
  half_t* AT = (half_t*)(lds + LA_AT);
  half_t* VT = (half_t*)(lds + LA_VT);
  half_t* SS = (half_t*)(lds + LA_SS);
  float* OS = (float*)(lds + LA_OS);
#pragma unroll
  for (int it = 0; it < 2; ++it) {
    int c = tid + 256 * it;
    int row = c >> 3, kc = c & 7;
    h8 qv = *(const h8*)(P + (size_t)(t0 + row) * PP + qcol + kc * 8);
    h8 kv = *(const h8*)(P + (size_t)(t0 + row) * PP + kcol + kc * 8);
    h8 qo, ko;
#pragma unroll
    for (int q = 0; q < 8; ++q) {
      float b = Bc[row * 65 + kc * 8 + q];
      qo[q] = (half_t)((float)qv[q] * __expf(b));
      ko[q] = (half_t)((float)kv[q] * __expf(-b));
    }
    *(h8*)(Qt + row * 72 + kc * 8) = qo;
    *(h8*)(Kt + row * 72 + kc * 8) = ko;
  }
  la_stage_vt(P, t0, vcol, lds);
#pragma unroll
  for (int it = 0; it < 4; ++it) {
    int c = tid + 256 * it;
    int e = c >> 3, kc = c & 7;
    const float* sp = ST + (size_t)item * 8192 + e * 64 + kc * 8;
    f4v s0 = *(const f4v*)sp, s1 = *(const f4v*)(sp + 4);
    h8 o;
    o[0] = (half_t)s0[0]; o[1] = (half_t)s0[1]; o[2] = (half_t)s0[2]; o[3] = (half_t)s0[3];
    o[4] = (half_t)s1[0]; o[5] = (half_t)s1[1]; o[6] = (half_t)s1[2]; o[7] = (half_t)s1[3];
    *(h8*)(SS + e * 72 + kc * 8) = o;
  }
  __syncthreads();
  {
    const int mi = w >> 1, nj = w & 1;
    f16v acc;
#pragma unroll
    for (int r = 0; r < 16; ++r) acc[r] = 0.f;
#pragma unroll
    for (int ks = 0; ks < 4; ++ks) {
      h8 a = *(const h8*)(Qt + (mi * 32 + (l & 31)) * 72 + ks * 16 + (l >> 5) * 8);
      h8 b = *(const h8*)(Kt + (nj * 32 + (l & 31)) * 72 + ks * 16 + (l >> 5) * 8);
      acc = mfma16(a, b, acc);
    }
#pragma unroll
    for (int r = 0; r < 16; ++r) {
      int i = mi * 32 + crow(r, l);
      int j = nj * 32 + (l & 31);
      float v = (j <= i) ? acc[r] : 0.f;
      AT[i * 72 + j] = (half_t)v;
    }
  }
  __syncthreads();
  {
    const int mi = w >> 1, nh = w & 1;
    f16v acc[2];
#pragma unroll
    for (int j = 0; j < 2; ++j)
#pragma unroll
      for (int r = 0; r < 16; ++r) acc[j][r] = 0.f;
#pragma unroll
    for (int ks = 0; ks < 4; ++ks) {
      h8 a1 = *(const h8*)(AT + (mi * 32 + (l & 31)) * 72 + ks * 16 + (l >> 5) * 8);
      h8 a2 = *(const h8*)(Qt + (mi * 32 + (l & 31)) * 72 + ks * 16 + (l >> 5) * 8);
#pragma unroll
      for (int j = 0; j < 2; ++j) {
        h8 b1 = *(const h8*)(VT + (nh * 64 + j * 32 + (l & 31)) * 72 + ks * 16 + (l >> 5) * 8);
        h8 b2 = *(const h8*)(SS + (nh * 64 + j * 32 + (l & 31)) * 72 + ks * 16 + (l >> 5) * 8);
        acc[j] = mfma16(a1, b1, acc[j]);
        acc[j] = mfma16(a2, b2, acc[j]);
      }
    }
#pragma unroll
    for (int j = 0; j < 2; ++j)
#pragma unroll
      for (int r = 0; r < 16; ++r) {
        int i = mi * 32 + crow(r, l);
        int e = nh * 64 + j * 32 + (l & 31);
        OS[i * 132 + e] = acc[j][r];
      }
  }
  __syncthreads();
  {
    const int i = tid >> 2, qd = tid & 3;
    float ov[32];
    float ss = 0.f;
#pragma unroll
    for (int c = 0; c < 8; ++c) {
      f4v v = *(const f4v*)(OS + i * 132 + qd * 32 + c * 4);
      ov[c * 4] = v[0]; ov[c * 4 + 1] = v[1]; ov[c * 4 + 2] = v[2]; ov[c * 4 + 3] = v[3];
      ss += v[0] * v[0] + v[1] * v[1] + v[2] * v[2] + v[3] * v[3];
    }
    ss += __shfl_xor(ss, 1);
    ss += __shfl_xor(ss, 2);
    float rs = rsqrtf(ss * (1.0f / 128.0f) + 1e-6f);
#pragma unroll
    for (int c = 0; c < 4; ++c) {
      h8 g = *(const h8*)(P + (size_t)(t0 + i) * PP + gcol + qd * 32 + c * 8);
      h8 o;
#pragma unroll
      for (int q = 0; q < 8; ++q) o[q] = (half_t)(ov[c * 8 + q] * rs * (float)g[q]);
      *(h8*)(BR + (size_t)(t0 + i) * 1536 + ocol + qd * 32 + c * 8) = o;
    }
  }
}

#define DS_LS 0
#define DS_LI 65536
#define DS_CNT 98304
#define DS_THR (98304 + 128)
#define DS_WQ (98304 + 256)
#define DS_HIST (98304 + 1024)
#define DS_PW (98304 + 1024 + 4096)
#define DS_CAP 512

__device__ __forceinline__ void dsa_prune(float* LSm, unsigned short* LIm, int n, unsigned* hist, int* cntm, float* thrm, int l) {
  unsigned key[8], lo[8];
  bool act[8], val[8];
#pragma unroll
  for (int k = 0; k < 8; ++k) {
    int e = l + 64 * k;
    val[k] = e < n;
    unsigned u = 0, li = 0;
    if (val[k]) { u = __float_as_uint(LSm[e]); li = LIm[e]; }
    key[k] = (u >> 31) ? ~u : (u | 0x80000000u);
    lo[k] = 16383u - li;
    act[k] = val[k];
  }
  unsigned rank = 256;
  unsigned dig[6];
#pragma unroll
  for (int rd = 0; rd < 6; ++rd) {
    *(uint4*)(hist + 4 * l) = make_uint4(0, 0, 0, 0);
    __threadfence_block();
    unsigned dk[8];
#pragma unroll
    for (int k = 0; k < 8; ++k) {
      unsigned dgt;
      if (rd == 0) dgt = key[k] >> 24;
      else if (rd == 1) dgt = (key[k] >> 16) & 255u;
      else if (rd == 2) dgt = (key[k] >> 8) & 255u;
      else if (rd == 3) dgt = key[k] & 255u;
      else if (rd == 4) dgt = lo[k] >> 8;
      else dgt = lo[k] & 255u;
      dk[k] = dgt;
      if (act[k]) atomicAdd(&hist[dgt], 1u);
    }
    __threadfence_block();
    uint4 hv; hv.x = hist[4 * l]; hv.y = hist[4 * l + 1]; hv.z = hist[4 * l + 2]; hv.w = hist[4 * l + 3];
    unsigned tl = hv.x + hv.y + hv.z + hv.w;
    unsigned incl = tl;
#pragma unroll
    for (int off = 1; off < 64; off <<= 1) {
      unsigned v = __shfl_down(incl, off);
      if (l + off < 64) incl += v;
    }
    unsigned sx = incl - tl;
    bool mine = (sx < rank) && (rank <= sx + tl);
    unsigned dsel = 0, nr = 0;
    if (mine) {
      unsigned c = sx;
      if (c + hv.w >= rank) { dsel = 4 * l + 3; nr = rank - c; }
      else {
        c += hv.w;
        if (c + hv.z >= rank) { dsel = 4 * l + 2; nr = rank - c; }
        else {
          c += hv.z;
          if (c + hv.y >= rank) { dsel = 4 * l + 1; nr = rank - c; }
          else { c += hv.y; dsel = 4 * l; nr = rank - c; }
        }
      }
    }
    unsigned long long mk = __ballot(mine);
    int src = (mk == 0ull) ? 0 : (__ffsll((long long)mk) - 1);
    dsel = __shfl(dsel, src);
    rank = __shfl(nr, src);
    dig[rd] = dsel;
#pragma unroll
    for (int k = 0; k < 8; ++k) act[k] = act[k] && (dk[k] == dsel);
  }
  const unsigned T32 = (dig[0] << 24) | (dig[1] << 16) | (dig[2] << 8) | dig[3];
  const unsigned Tlo = (dig[4] << 8) | dig[5];
  bool keep[8];
  unsigned cntk = 0;
#pragma unroll
  for (int k = 0; k < 8; ++k) {
    keep[k] = val[k] && (key[k] > T32 || (key[k] == T32 && lo[k] >= Tlo));
    cntk += keep[k] ? 1u : 0u;
  }
  unsigned incl = cntk;
#pragma unroll
  for (int off = 1; off < 64; off <<= 1) {
    unsigned v = __shfl_up(incl, off);
    if (l >= off) incl += v;
  }
  unsigned pos = incl - cntk;
  __threadfence_block();
#pragma unroll
  for (int k = 0; k < 8; ++k) {
    if (keep[k]) {
      unsigned kk = key[k];
      unsigned u = (kk & 0x80000000u) ? (kk & 0x7FFFFFFFu) : ~kk;
      LSm[pos] = __uint_as_float(u);
      LIm[pos] = (unsigned short)(16383u - lo[k]);
      ++pos;
    }
  }
  if (l == 0) {
    *cntm = 256;
    *thrm = __uint_as_float((T32 & 0x80000000u) ? (T32 & 0x7FFFFFFFu) : ~T32);
  }
  __threadfence_block();
}

__device__ void dsa_item(const Params& p, int qb, unsigned char* lds) {
  const int tid = otid(), w = tid >> 6, l = tid & 63;
  const int t0 = qb * 32;
  const half_t* P = (const half_t*)(p.ws + OFF_P);
  const float* IW = (const float*)(p.ws + OFF_IW);
  half_t* BR = (half_t*)(p.ws + OFF_BR);
  float* LS = (float*)(lds + DS_LS);
  unsigned short* LI = (unsigned short*)(lds + DS_LI);
  int* cnt = (int*)(lds + DS_CNT);
  float* thr = (float*)(lds + DS_THR);
  float* wq = (float*)(lds + DS_WQ);
  unsigned* hist = (unsigned*)(lds + DS_HIST) + w * 256;
  float* PW = (float*)(lds + DS_PW) + w * 1024;
  __syncthreads();
  if (tid < 32) { cnt[tid] = 0; thr[tid] = -INFINITY; }
  if (tid < 128) wq[tid] = IW[(size_t)t0 * 4 + tid];
  __syncthreads();
  h8 aq[4][4];
#pragma unroll
  for (int h = 0; h < 4; ++h)
#pragma unroll
    for (int ks = 0; ks < 4; ++ks)
      aq[h][ks] = *(const h8*)(P + (size_t)(t0 + (l & 31)) * PP + C_IDXQ + h * 64 + ks * 16 + (l >> 5) * 8);
  const int nt = qb + 1;
  const int nr = (nt + 3) >> 2;
#pragma unroll 1
  for (int rd = 0; rd < nr; ++rd) {
    const int kt = 4 * rd + w;
    if (kt < nt) {
      const int sbase = kt * 32;
      h8 bk[4];
#pragma unroll
      for (int ks = 0; ks < 4; ++ks)
        bk[ks] = *(const h8*)(P + (size_t)(sbase + (l & 31)) * PP + C_IDXK + ks * 16 + (l >> 5) * 8);
      f16v acc[4];
#pragma unroll
      for (int h = 0; h < 4; ++h) {
#pragma unroll
        for (int r = 0; r < 16; ++r) acc[h][r] = 0.f;
#pragma unroll
        for (int ks = 0; ks < 4; ++ks) acc[h] = mfma16(aq[h][ks], bk[ks], acc[h]);
      }
      const int s = sbase + (l & 31);
#pragma unroll
      for (int r = 0; r < 16; ++r) {
        const int m = crow(r, l);
        const f4v wv = *(const f4v*)(wq + m * 4);
        float sc = wv[0] * fmaxf(acc[0][r], 0.f) + wv[1] * fmaxf(acc[1][r], 0.f) + wv[2] * fmaxf(acc[2][r], 0.f) + wv[3] * fmaxf(acc[3][r], 0.f);
        sc += 0.0f;
        const float th = thr[m];
        const bool pass = (s <= t0 + m) && (sc > th);
        const unsigned long long mk = __ballot(pass);
        if (mk != 0ull) {
          const unsigned hm = (l < 32) ? (unsigned)mk : (unsigned)(mk >> 32);
          const int nadd = __popc(hm);
          int base = 0;
          if ((l & 31) == 0 && nadd > 0) base = atomicAdd(&cnt[m], nadd);
          base = __shfl(base, l & 32);
          if (pass) {
            int slot = base + __popc(hm & ((1u << (l & 31)) - 1u));
            LS[m * DS_CAP + slot] = sc;
            LI[m * DS_CAP + slot] = (unsigned short)s;
          }
        }
      }
    }
    __syncthreads();
#pragma unroll 1
    for (int mm = 0; mm < 8; ++mm) {
      const int m = w * 8 + mm;
      const int c = cnt[m];
      if (c > 384) dsa_prune(LS + m * DS_CAP, LI + m * DS_CAP, c, hist, cnt + m, thr + m, l);
    }
    __syncthreads();
  }
#pragma unroll 1
  for (int mm = 0; mm < 8; ++mm) {
    const int m = w * 8 + mm;
    const int t = t0 + m;
    int c = cnt[m];
    if (c > 256) { dsa_prune(LS + m * DS_CAP, LI + m * DS_CAP, c, hist, cnt + m, thr + m, l); c = 256; }
    const unsigned short* LIm = LI + m * DS_CAP;
#pragma unroll 1
    for (int g = 0; g < 2; ++g) {
      h8 qv[4][8];
#pragma unroll
      for (int hh = 0; hh < 4; ++hh)
#pragma unroll
        for (int ch = 0; ch < 8; ++ch)
          qv[hh][ch] = *(const h8*)(P + (size_t)t * PP + C_DSAQ + (g * 4 + hh) * 64 + ch * 8);
      float lg[4][4];
#pragma unroll
      for (int kk = 0; kk < 4; ++kk) {
        const int e = l + 64 * kk;
        const bool valid = e < c;
        const int s = valid ? (int)LIm[e] : 0;
        const half_t* kr = P + (size_t)s * PP + C_DSAK + g * 64;
        h8 kv[8];
#pragma unroll
        for (int ch = 0; ch < 8; ++ch) kv[ch] = *(const h8*)(kr + ch * 8);
#pragma unroll
        for (int hh = 0; hh < 4; ++hh) {
          float a = 0.f;
#pragma unroll
          for (int ch = 0; ch < 8; ++ch) {
            a = __builtin_amdgcn_fdot2(__builtin_shufflevector(qv[hh][ch], qv[hh][ch], 0, 1), __builtin_shufflevector(kv[ch], kv[ch], 0, 1), a, false);
            a = __builtin_amdgcn_fdot2(__builtin_shufflevector(qv[hh][ch], qv[hh][ch], 2, 3), __builtin_shufflevector(kv[ch], kv[ch], 2, 3), a, false);
            a = __builtin_amdgcn_fdot2(__builtin_shufflevector(qv[hh][ch], qv[hh][ch], 4, 5), __builtin_shufflevector(kv[ch], kv[ch], 4, 5), a, false);
            a = __builtin_amdgcn_fdot2(__builtin_shufflevector(qv[hh][ch], qv[hh][ch], 6, 7), __builtin_shufflevector(kv[ch], kv[ch], 6, 7), a, false);
          }
          lg[hh][kk] = valid ? a : -INFINITY;
        }
      }
#pragma unroll
      for (int hh = 0; hh < 4; ++hh) {
        float mx = fmaxf(fmaxf(lg[hh][0], lg[hh][1]), fmaxf(lg[hh][2], lg[hh][3]));
        mx = wave_max(mx);
        float ev[4]; float sm = 0.f;
#pragma unroll
        for (int kk = 0; kk < 4; ++kk) { ev[kk] = __expf(lg[hh][kk] - mx); sm += ev[kk]; }
        sm = wave_sum(sm);
        const float inv = 1.0f / sm;
#pragma unroll
        for (int kk = 0; kk < 4; ++kk) PW[(l + 64 * kk) * 4 + hh] = ev[kk] * inv;
      }
      __threadfence_block();
      const int dch = l & 7, ksub = l >> 3;
      float o[4][8];
#pragma unroll
      for (int hh = 0; hh < 4; ++hh)
#pragma unroll
        for (int q = 0; q < 8; ++q) o[hh][q] = 0.f;
      const int nit = (c + 7) >> 3;
#pragma unroll 2
      for (int it = 0; it < nit; ++it) {
        const int e = it * 8 + ksub;
        const bool valid = e < c;
        const int s = valid ? (int)LIm[e] : 0;
        f4v pv = *(const f4v*)(PW + e * 4);
        if (!valid) { pv[0] = 0.f; pv[1] = 0.f; pv[2] = 0.f; pv[3] = 0.f; }
        const h8 vv = *(const h8*)(P + (size_t)s * PP + C_DSAV + g * 64 + dch * 8);
#pragma unroll
        for (int hh = 0; hh < 4; ++hh)
#pragma unroll
          for (int q = 0; q < 8; ++q) o[hh][q] += pv[hh] * (float)vv[q];
      }
#pragma unroll
      for (int hh = 0; hh < 4; ++hh)
#pragma unroll
        for (int q = 0; q < 8; ++q) {
          float v = o[hh][q];
          v += __shfl_xor(v, 8); v += __shfl_xor(v, 16); v += __shfl_xor(v, 32);
          o[hh][q] = v;
        }
      if (l < 8) {
#pragma unroll
        for (int hh = 0; hh < 4; ++hh) {
          const int col = (g * 4 + hh) * 64 + dch * 8;
          const h8 gt = *(const h8*)(P + (size_t)t * PP + C_DSAG + col);
          h8 ov;
#pragma unroll
          for (int q = 0; q < 8; ++q) ov[q] = (half_t)(o[hh][q] * (float)gt[q]);
          *(h8*)(BR + (size_t)t * 1536 + 512 + col) = ov;
        }
      }
      __threadfence_block();
    }
  }
}

__device__ void phase_B(const Params& p, int layer, unsigned char* lds) {
  const int G = gridDim.x;
  for (int j = 0; j * G < 512; ++j) {
    const int b = (j & 1) ? (G - 1 - (int)blockIdx.x) : (int)blockIdx.x;
    const int idx = j * G + b;
#ifndef NO_DSA
    if (idx < 512) dsa_item(p, 511 - idx, lds);
#endif
  }
#ifndef NO_LAKV
  for (int it = blockIdx.x; it < 2048; it += G) la_item_kv(p, layer, it, lds);
#endif
}

__device__ void phase_E1(const Params& p, int layer, unsigned char* lds) {
  const int tid = otid(), w = tid >> 6, l = tid & 63;
  const half_t* BR = (const half_t*)(p.ws + OFF_BR);
  const half_t* WbrT = (const half_t*)(p.ws + OFF_WBRT) + (size_t)layer * 3 * 1024 * 512;
  const half_t* P = (const half_t*)(p.ws + OFF_P);
  half_t* Y1 = (half_t*)(p.ws + OFF_H);
  const int wm = w >> 1, wn = w & 1;
  float* E = (float*)(lds + 73728) + w * (32 * 65);
  const int prow = l >> 3, c0 = (l & 7) * 8;
  for (int tix = blockIdx.x; tix < 512; tix += gridDim.x) {
    const int mt = tix & 63, nt = tix >> 6;
    float tot[4][4][8];
#pragma unroll
    for (int i = 0; i < 4; ++i)
#pragma unroll
      for (int ps = 0; ps < 4; ++ps)
#pragma unroll
        for (int q = 0; q < 8; ++q) tot[i][ps][q] = 0.f;
    const int m0w = mt * 256 + wm * 128;
    const int n0 = nt * 128 + wn * 64 + c0;
#pragma unroll 1
    for (int b = 0; b < 3; ++b) {
      f16v acc[4][2];
      zero_acc<2>(acc);
      gemm_kloop<2>(acc, BR + (size_t)mt * 256 * 1536 + b * 512, 1536, WbrT + (size_t)b * 1024 * 512 + (size_t)nt * 128 * 512, 512, 512, lds);
#pragma unroll
      for (int i = 0; i < 4; ++i) {
        stage_pair(E, acc[i][0], acc[i][1], l);
#pragma unroll
        for (int ps = 0; ps < 4; ++ps) {
          const int rl = ps * 8 + prow;
          const int row = m0w + i * 32 + rl;
          const h8 g = *(const h8*)(P + (size_t)row * PP + C_MRG + b * 1024 + n0);
#pragma unroll
          for (int q = 0; q < 8; ++q) tot[i][ps][q] += (float)g[q] * E[rl * 65 + c0 + q];
        }
      }
    }
#pragma unroll
    for (int i = 0; i < 4; ++i)
#pragma unroll
      for (int ps = 0; ps < 4; ++ps) {
        const int row = m0w + i * 32 + ps * 8 + prow;
        h8 o;
#pragma unroll
        for (int q = 0; q < 8; ++q) o[q] = (half_t)tot[i][ps][q];
        *(h8*)(Y1 + (size_t)row * 1024 + n0) = o;
      }
  }
}

__device__ void phase_E2(const Params& p, int layer, unsigned char* lds) {
  const int tid = otid(), w = tid >> 6, l = tid & 63;
  const half_t* Y1 = (const half_t*)(p.ws + OFF_H);
  const half_t* Wo = (const half_t*)(p.ws + OFF_WOUTT) + (size_t)layer * 1024 * 1024;
  float* Y = (float*)(p.ws + OFF_ST);
  const int wm = w >> 1, wn = w & 1;
  for (int tix = blockIdx.x; tix < 512; tix += gridDim.x) {
    const int mt = tix & 63, nt = tix >> 6;
    f16v acc[4][2];
    zero_acc<2>(acc);
    gemm_kloop<2>(acc, Y1 + (size_t)mt * 256 * 1024, 1024, Wo + (size_t)nt * 128 * 1024, 1024, 1024, lds);
    const int m0w = mt * 256 + wm * 128;
    const int n0w = nt * 128 + wn * 64;
#pragma unroll
    for (int i = 0; i < 4; ++i)
#pragma unroll
      for (int j = 0; j < 2; ++j)
#pragma unroll
        for (int r = 0; r < 16; ++r) {
          const int row = m0w + i * 32 + crow(r, l);
          const int n = n0w + j * 32 + (l & 31);
          Y[(size_t)row * 1024 + n] = acc[i][j][r];
        }
  }
}

__device__ void phase_E3(const Params& p, int layer) {
  const int w = otid() >> 6, l = otid() & 63;
  const float* Y = (const float*)(p.ws + OFF_ST);
  const float* MOD = (const float*)(p.ws + OFF_MOD);
  half_t* H = (half_t*)(p.ws + OFF_H);
  const float* xin = (layer == 0) ? p.x : p.out;
  const float* gate = MOD + layer * 3072 + 2048;
  const float* post = p.post_norm + layer * 1024;
  for (int row = blockIdx.x * 4 + w; row < S_LEN; row += gridDim.x * 4) {
    float yv[16], xv[16];
    float ss = 0.f;
#pragma unroll
    for (int i = 0; i < 4; ++i) {
      f4v v = *(const f4v*)(Y + (size_t)row * 1024 + i * 256 + l * 4);
      f4v xx = *(const f4v*)(xin + (size_t)row * 1024 + i * 256 + l * 4);
#pragma unroll
      for (int q = 0; q < 4; ++q) { yv[i * 4 + q] = v[q]; xv[i * 4 + q] = xx[q]; ss += v[q] * v[q]; }
    }
    ss = wave_sum(ss);
    const float rs = rsqrtf(ss * (1.0f / 1024.0f) + 1e-6f);
#pragma unroll
    for (int i = 0; i < 4; ++i) {
      const int c0 = i * 256 + l * 4;
      f4v gt = *(const f4v*)(gate + c0);
      f4v pn = *(const f4v*)(post + c0);
      f4v o;
#pragma unroll
      for (int q = 0; q < 4; ++q) { o[q] = xv[i * 4 + q] + gt[q] * (yv[i * 4 + q] * rs * pn[q]); xv[i * 4 + q] = o[q]; }
      *(f4v*)(p.out + (size_t)row * 1024 + c0) = o;
    }
    if (layer + 1 < DEPTH)
      write_h_row(xv, p.pre_norm + (layer + 1) * 1024, MOD + (layer + 1) * 3072, H + (size_t)row * 1024, l);
  }
}

#ifdef ONLY_PHASE
#define PH_EN(x) (ONLY_PHASE == (x))
#else
#define PH_EN(x) true
#endif
__global__ void __launch_bounds__(NTHREADS) fwd_megakernel(Params p) {
  extern __shared__ __attribute__((aligned(16))) unsigned char lds[];
  cg::grid_group grid = cg::this_grid();
  for (int ph = p.ph_lo; ph < p.ph_hi; ++ph) {
    if (ph == 0) { if (PH_EN(0)) phase_prologue(p, lds); }
    else if (ph == 1) { if (PH_EN(1)) phase_h0(p); }
    else {
      const int layer = (ph - 2) / 7, sub = (ph - 2) % 7;
      if (sub == 0) { if (PH_EN(2)) phase_A(p, layer, lds); }
      else if (sub == 1) { if (PH_EN(3)) phase_B(p, layer, lds); }
      else if (sub == 2) { if (PH_EN(4)) phase_scan(p); }
      else if (sub == 3) { if (PH_EN(5)) for (int it = blockIdx.x; it < 2048; it += gridDim.x) la_item_out(p, layer, it, lds); }
      else if (sub == 4) { if (PH_EN(6)) phase_E1(p, layer, lds); }
      else if (sub == 5) { if (PH_EN(7)) phase_E2(p, layer, lds); }
      else { if (PH_EN(8)) phase_E3(p, layer); }
    }
    if (ph + 1 < p.ph_hi) grid.sync();
  }
}

extern "C" void kernel_launch(void* const* d_in, const int* in_sizes, int n_in, void* d_out, int out_size,
                              void* d_ws, size_t ws_size, hipStream_t stream) {
  static int grid_blocks = 0;
  if (!grid_blocks) {
    int dev = 0, cus = 0, per_cu = 0;
    hipGetDevice(&dev);
    hipDeviceGetAttribute(&cus, hipDeviceAttributeMultiprocessorCount, dev);
    hipFuncSetAttribute((const void*)fwd_megakernel, hipFuncAttributeMaxDynamicSharedMemorySize, LDS_BYTES);
    hipOccupancyMaxActiveBlocksPerMultiprocessor(&per_cu, (const void*)fwd_megakernel, NTHREADS, LDS_BYTES);
    if (per_cu < 1) per_cu = 1;
    if (per_cu > 1) per_cu = 1;
    grid_blocks = cus * per_cu;
    if (ws_size < WS_END) fprintf(stderr, "workspace too small: %zu < %llu\n", ws_size, (unsigned long long)WS_END);
  }
  Params p{};
  p.x = (const float*)d_in[0]; p.c = (const float*)d_in[1]; p.pos = (const int*)d_in[2];
  p.ada_w = (const float*)d_in[3]; p.ada_b = (const float*)d_in[4];
  p.pre_norm = (const float*)d_in[5]; p.post_norm = (const float*)d_in[6];
  p.w_in = (const float*)d_in[7]; p.gla_w_lr = (const float*)d_in[8]; p.gla_b_lr = (const float*)d_in[9];
  p.w_br_ret = (const float*)d_in[10]; p.w_br_dsa = (const float*)d_in[11]; p.w_br_gla = (const float*)d_in[12];
  p.w_out = (const float*)d_in[13];
  p.out = (float*)d_out; p.ws = (unsigned char*)d_ws;
  p.ph_lo = 0; p.ph_hi = 2 + 7 * DEPTH;
  void* args[] = {&p};
  hipError_t e = hipLaunchCooperativeKernel((const void*)fwd_megakernel, dim3(grid_blocks), dim3(NTHREADS), args, LDS_BYTES, stream);
  if (e != hipSuccess) fprintf(stderr, "cooperative launch failed: %s (grid %d)\n", hipGetErrorString(e), grid_blocks);
}
```

```cpp
#include <hip/hip_runtime.h>
#include <hip/hip_cooperative_groups.h>
#include <stdint.h>
#include <cstdio>
namespace cg = cooperative_groups;
#ifndef REP_SEL
#define REP_SEL 1
#endif
#ifndef REP_ATT
#define REP_ATT 1
#endif

typedef _Float16 half_t;
typedef _Float16 h8 __attribute__((ext_vector_type(8)));
typedef _Float16 h4 __attribute__((ext_vector_type(4)));
typedef _Float16 h2 __attribute__((ext_vector_type(2)));
typedef float f16v __attribute__((ext_vector_type(16)));
typedef float f4v __attribute__((ext_vector_type(4)));

#define S_LEN 16384
#define DM 1024
#define NIN 7764
#define NPAD 7936
#define PP 7808
#define DEPTH 4
#define NTHREADS 256
#define LDS_BYTES 136192

#define C_RETQ 0
#define C_RETK 256
#define C_RETV 512
#define C_RETG 1024
#define C_DSAQ 1536
#define C_DSAK 2048
#define C_DSAV 2176
#define C_DSAG 2304
#define C_IDXQ 2816
#define C_IDXK 3072
#define C_GLAQ 3136
#define C_GLAK 3392
#define C_GLAV 3648
#define C_GLAG 4160
#define C_GLAA 4672
#define C_MRG 4688
#define C_END 7760
#define C_IDXW 7760

#define OFF_WINT 0ull
#define OFF_WBRT (OFF_WINT + 4ull * NPAD * 1024 * 2)
#define OFF_WOUTT (OFF_WBRT + 4ull * 3 * 1024 * 512 * 2)
#define OFF_MOD (OFF_WOUTT + 4ull * 1024 * 1024 * 2)
#define OFF_RT (OFF_MOD + 4ull * 3072 * 4)
#define OFF_DT (OFF_RT + 16384ull * 64 * 4)
#define OFF_H (OFF_DT + 16384ull * 16 * 4)
#define OFF_P (OFF_H + 16384ull * 1024 * 2)
#define OFF_GA (OFF_P + 16384ull * PP * 2)
#define OFF_IW (OFF_GA + 16384ull * 16 * 4)
#define OFF_ST (OFF_IW + 16384ull * 4 * 4)
#define OFF_DEC (OFF_ST + 256ull * 65536 * 4)
#define OFF_BR (OFF_DEC + 256ull * 8 * 64 * 4)
#define WS_END (OFF_BR + 16384ull * 1536 * 2)
static_assert(WS_END + 256 <= 508821504ull, "workspace too large");

struct Params {
  const float* x; const float* c; const int* pos; const float* ada_w; const float* ada_b;
  const float* pre_norm; const float* post_norm; const float* w_in; const float* gla_w_lr;
  const float* gla_b_lr; const float* w_br_ret; const float* w_br_dsa; const float* w_br_gla;
  const float* w_out; float* out; unsigned char* ws;
  int ph_lo; int ph_hi;
};

__device__ __forceinline__ int otid() { int t = (int)__builtin_amdgcn_workitem_id_x(); asm volatile("" : "+v"(t)); return t; }
__device__ __forceinline__ float wave_sum(float v) {
#pragma unroll
  for (int o = 32; o > 0; o >>= 1) v += __shfl_xor(v, o);
  return v;
}
__device__ __forceinline__ float wave_max(float v) {
#pragma unroll
  for (int o = 32; o > 0; o >>= 1) v = fmaxf(v, __shfl_xor(v, o));
  return v;
}
__device__ __forceinline__ f16v mfma16(h8 a, h8 b, f16v c) {
  return __builtin_amdgcn_mfma_f32_32x32x16_f16(a, b, c, 0, 0, 0);
}
__device__ __forceinline__ int crow(int r, int l) { return (r & 3) + 8 * (r >> 2) + 4 * (l >> 5); }

__device__ __forceinline__ int win_col(int nv) {
  if (nv < 3136) return nv;
  if (nv < 7760) return nv + 4;
  if (nv < 7764) return nv - 7760 + 3136;
  return -1;
}
__device__ void transpose_tile(const float* __restrict__ src, int ldn, half_t* __restrict__ dst, int K,
                               int k0, int n0, int mapmode, unsigned char* lds) {
  float* T = (float*)lds;
  const int tid = otid();
  const int nn = tid & 63;
  int col = n0 + nn;
  if (mapmode) col = win_col(col);
#pragma unroll
  for (int i = 0; i < 16; ++i) {
    int kk = (tid >> 6) + 4 * i;
    float v = 0.f;
    if (col >= 0) v = src[(size_t)(k0 + kk) * ldn + col];
    T[kk * 65 + nn] = v;
  }
  __syncthreads();
#pragma unroll
  for (int i = 0; i < 2; ++i) {
    int n2 = (tid >> 3) + 32 * i;
    int kc = tid & 7;
    h8 o;
#pragma unroll
    for (int q = 0; q < 8; ++q) o[q] = (half_t)T[(kc * 8 + q) * 65 + n2];
    *(h8*)(dst + (size_t)(n0 + n2) * K + k0 + kc * 8) = o;
  }
  __syncthreads();
}

__device__ void phase_prologue(const Params& p, unsigned char* lds) {
  const int tid = otid();
  half_t* WinT = (half_t*)(p.ws + OFF_WINT);
  half_t* WbrT = (half_t*)(p.ws + OFF_WBRT);
  half_t* WoutT = (half_t*)(p.ws + OFF_WOUTT);
  float* MOD = (float*)(p.ws + OFF_MOD);
  float* RT = (float*)(p.ws + OFF_RT);
  float* DT = (float*)(p.ws + OFF_DT);
  const int T_WIN = 4 * 124 * 16;
  const int T_WBR = 12 * 16 * 8;
  const int T_WOUT = 4 * 16 * 16;
  const int T_MOD = 192;
  const int T_ROPE = 16384 * 40 / 256;
  const int total = T_WIN + T_WBR + T_WOUT + T_MOD + T_ROPE;
  for (int task = blockIdx.x; task < total; task += gridDim.x) {
    int t = task;
    if (t < T_WIN) {
      int l = t / (124 * 16); int r = t % (124 * 16); int nt = r / 16, kt = r % 16;
      transpose_tile(p.w_in + (size_t)l * 1024 * NIN, NIN, WinT + (size_t)l * NPAD * 1024, 1024, kt * 64, nt * 64, 1, lds);
      continue;
    }
    t -= T_WIN;
    if (t < T_WBR) {
      int lb = t / 128; int r = t % 128; int nt = r / 8, kt = r % 8;
      int l = lb / 3, b = lb % 3;
      const float* src = (b == 0 ? p.w_br_ret : (b == 1 ? p.w_br_dsa : p.w_br_gla)) + (size_t)l * 512 * 1024;
      transpose_tile(src, 1024, WbrT + (size_t)lb * 1024 * 512, 512, kt * 64, nt * 64, 0, lds);
      continue;
    }
    t -= T_WBR;
    if (t < T_WOUT) {
      int l = t / 256; int r = t % 256; int nt = r / 16, kt = r % 16;
      transpose_tile(p.w_out + (size_t)l * 1024 * 1024, 1024, WoutT + (size_t)l * 1024 * 1024, 1024, kt * 64, nt * 64, 0, lds);
      continue;
    }
    t -= T_WOUT;
    if (t < T_MOD) {
      int l = t / 48, jb = t % 48;
      int j = jb * 64 + (tid & 63);
      int ig = tid >> 6;
      float acc = 0.f;
      const float* aw = p.ada_w + (size_t)l * 1024 * 3072;
      for (int i = ig * 256; i < ig * 256 + 256; ++i) {
        float cv = p.c[i];
        float sc = cv / (1.f + expf(-cv));
        acc += sc * aw[(size_t)i * 3072 + j];
      }
      float* red = (float*)lds;
      red[tid] = acc;
      __syncthreads();
      if (tid < 64) {
        float s = red[tid] + red[tid + 64] + red[tid + 128] + red[tid + 192];
        MOD[l * 3072 + j] = s + p.ada_b[l * 3072 + j];
      }
      __syncthreads();
      continue;
    }
    t -= T_MOD;
    {
      int e = t * 256 + tid;
      int tok = e / 40, f = e % 40;
      float pf = (float)p.pos[tok];
      if (f < 32) {
        float fr = powf(10000.0f, -(float)f * 2.0f / 64.0f);
        float ang = pf * fr;
        RT[tok * 64 + f * 2] = cosf(ang);
        RT[tok * 64 + f * 2 + 1] = sinf(ang);
      } else {
        int g = f - 32;
        float fr = powf(500000.0f, -(float)g * 2.0f / 16.0f);
        float ang = pf * fr;
        DT[tok * 16 + g * 2] = cosf(ang);
        DT[tok * 16 + g * 2 + 1] = sinf(ang);
      }
    }
  }
}

__device__ __forceinline__ void write_h_row(const float (&xv)[16], const float* __restrict__ pre,
                                            const float* __restrict__ mod, half_t* __restrict__ hrow, int l) {
  float ss = 0.f;
#pragma unroll
  for (int i = 0; i < 16; ++i) ss += xv[i] * xv[i];
  ss = wave_sum(ss);
  float rs = rsqrtf(ss * (1.0f / 1024.0f) + 1e-6f);
#pragma unroll
  for (int i = 0; i < 4; ++i) {
    int c0 = i * 256 + l * 4;
    f4v pg = *(const f4v*)(pre + c0);
    f4v sh = *(const f4v*)(mod + c0);
    f4v sc = *(const f4v*)(mod + 1024 + c0);
    h4 o;
#pragma unroll
    for (int q = 0; q < 4; ++q) o[q] = (half_t)(xv[i * 4 + q] * rs * pg[q] * (1.f + sc[q]) + sh[q]);
    *(h4*)(hrow + c0) = o;
  }
}

__device__ void phase_h0(const Params& p) {
  const int w = otid() >> 6, l = otid() & 63;
  half_t* H = (half_t*)(p.ws + OFF_H);
  const float* MOD = (const float*)(p.ws + OFF_MOD);
  for (int row = blockIdx.x * 4 + w; row < S_LEN; row += gridDim.x * 4) {
    float xv[16];
#pragma unroll
    for (int i = 0; i < 4; ++i) {
      f4v v = *(const f4v*)(p.x + (size_t)row * 1024 + i * 256 + l * 4);
      xv[i * 4] = v[0]; xv[i * 4 + 1] = v[1]; xv[i * 4 + 2] = v[2]; xv[i * 4 + 3] = v[3];
    }
    write_h_row(xv, p.pre_norm, MOD, H + (size_t)row * 1024, l);
  }
}

template <int NT>
__device__ __forceinline__ void gemm_kloop(f16v (&acc)[4][NT], const half_t* __restrict__ A, int lda,
                                           const half_t* __restrict__ B, int ldb, int K, unsigned char* lds) {
  const int tid = otid(), w = tid >> 6, l = tid & 63;
  unsigned char* As = lds;
  unsigned char* Bs = lds + 256 * 144;
  const int wm = w >> 1, wn = w & 1;
  h8 ra[8], rb[2 * NT];
  const int kc = tid & 7;
  const int r0 = tid >> 3;
#pragma unroll
  for (int i = 0; i < 8; ++i) ra[i] = *(const h8*)(A + (size_t)(r0 + 32 * i) * lda + kc * 8);
#pragma unroll
  for (int i = 0; i < 2 * NT; ++i) rb[i] = *(const h8*)(B + (size_t)(r0 + 32 * i) * ldb + kc * 8);
  const int nk = K / 64;
  for (int kt = 0; kt < nk; ++kt) {
    __syncthreads();
#pragma unroll
    for (int i = 0; i < 8; ++i) *(h8*)(As + (r0 + 32 * i) * 144 + kc * 16) = ra[i];
#pragma unroll
    for (int i = 0; i < 2 * NT; ++i) *(h8*)(Bs + (r0 + 32 * i) * 144 + kc * 16) = rb[i];
    __syncthreads();
    if (kt + 1 < nk) {
      const int k0 = (kt + 1) * 64;
#pragma unroll
      for (int i = 0; i < 8; ++i) ra[i] = *(const h8*)(A + (size_t)(r0 + 32 * i) * lda + k0 + kc * 8);
#pragma unroll
      for (int i = 0; i < 2 * NT; ++i) rb[i] = *(const h8*)(B + (size_t)(r0 + 32 * i) * ldb + k0 + kc * 8);
    }
#pragma unroll
    for (int ks = 0; ks < 4; ++ks) {
      h8 a[4], b[NT];
#pragma unroll
      for (int i = 0; i < 4; ++i) a[i] = *(const h8*)(As + (wm * 128 + i * 32 + (l & 31)) * 144 + ks * 32 + (l >> 5) * 16);
#pragma unroll
      for (int j = 0; j < NT; ++j) b[j] = *(const h8*)(Bs + (wn * 32 * NT + j * 32 + (l & 31)) * 144 + ks * 32 + (l >> 5) * 16);
#pragma unroll
      for (int i = 0; i < 4; ++i)
#pragma unroll
        for (int j = 0; j < NT; ++j) acc[i][j] = mfma16(a[i], b[j], acc[i][j]);
    }
  }
}

template <int NT>
__device__ __forceinline__ void zero_acc(f16v (&acc)[4][NT]) {
#pragma unroll
  for (int i = 0; i < 4; ++i)
#pragma unroll
    for (int j = 0; j < NT; ++j)
#pragma unroll
      for (int r = 0; r < 16; ++r) acc[i][j][r] = 0.f;
}

__device__ __forceinline__ void stage_pair(float* E, const f16v& a0, const f16v& a1, int l) {
#pragma unroll
  for (int r = 0; r < 16; ++r) {
    const int rr = crow(r, l);
    E[rr * 65 + (l & 31)] = a0[r];
    E[rr * 65 + 32 + (l & 31)] = a1[r];
  }
}

__device__ void phase_A(const Params& p, int layer, unsigned char* lds) {
  const int tid = otid(), w = tid >> 6, l = tid & 63;
  const half_t* H = (const half_t*)(p.ws + OFF_H);
  const half_t* Wt = (const half_t*)(p.ws + OFF_WINT) + (size_t)layer * NPAD * 1024;
  half_t* P = (half_t*)(p.ws + OFF_P);
  float* GA = (float*)(p.ws + OFF_GA);
  float* IW = (float*)(p.ws + OFF_IW);
  const float* RT = (const float*)(p.ws + OFF_RT);
  const float* DT = (const float*)(p.ws + OFF_DT);
  const int wm = w >> 1, wn = w & 1;
  const int G = gridDim.x;
  const int ntiles = 64 * 62;
  const int nrounds = (G == 256) ? 16 : (ntiles + G - 1) / G;
  for (int rnd = 0; rnd < nrounds; ++rnd) {
    int mt, nt;
    if (G == 256) {
      const int xcd = blockIdx.x & 7, loc = blockIdx.x >> 3;
      const int s = loc + 32 * rnd;
      mt = xcd * 8 + (s & 7); nt = s >> 3;
      if (nt >= 62) continue;
    } else {
      const int tix = rnd * G + blockIdx.x;
      if (tix >= ntiles) continue;
      mt = tix & 63; nt = tix >> 6;
    }
    f16v acc[4][2];
    zero_acc<2>(acc);
    gemm_kloop<2>(acc, H + (size_t)mt * 256 * 1024, 1024, Wt + (size_t)nt * 128 * 1024, 1024, 1024, lds);
    const int m0w = mt * 256 + wm * 128;
    const int n0w = nt * 128 + wn * 64;
    float* E = (float*)(lds + 73728) + w * (32 * 65);
    const int prow = l >> 3, c0 = (l & 7) * 8;
    {
      const int jp = 0;
      const int nb2 = n0w + jp * 64;
      const int n0 = nb2 + c0;
      const bool rope64 = nb2 < 512;
      const bool rope16 = ((nb2 >= C_DSAQ && nb2 < C_DSAV) || (nb2 >= C_IDXQ && nb2 < C_GLAQ)) && (c0 < 16);
      float scale = 1.f;
      if (n0 < 256 || (n0 >= C_DSAQ && n0 < C_DSAK) || (n0 >= C_IDXQ && n0 < C_IDXK) || (n0 >= C_GLAQ && n0 < C_GLAK)) scale = 0.125f;
      int mode = 0;
      if ((n0 >= C_RETG && n0 < C_DSAQ) || (n0 >= C_DSAG && n0 < C_IDXQ) || (n0 >= C_GLAG && n0 < C_GLAA)) mode = 1;
      if (n0 >= C_MRG && n0 < C_END) mode = 2;
#pragma unroll
      for (int i = 0; i < 4; ++i) {
        stage_pair(E, acc[i][2 * jp], acc[i][2 * jp + 1], l);
#pragma unroll 1
        for (int ps = 0; ps < 4; ++ps) {
          const int rl = ps * 8 + prow;
          const int row = m0w + i * 32 + rl;
          float v[8], o[8];
#pragma unroll
          for (int q = 0; q < 8; ++q) { v[q] = E[rl * 65 + c0 + q]; o[q] = v[q]; }
          if (rope64) {
            const int cp = c0 ^ 32;
            const float* tb = RT + (size_t)row * 64 + (c0 & 31) * 2;
#pragma unroll
            for (int q = 0; q < 8; ++q) {
              const float pv = E[rl * 65 + cp + q];
              const float cs = tb[2 * q], sn = tb[2 * q + 1];
              o[q] = (c0 < 32) ? (v[q] * cs - pv * sn) : (v[q] * cs + pv * sn);
            }
          } else if (rope16) {
            const int cp = c0 ^ 8;
            const float* tb = DT + (size_t)row * 16;
#pragma unroll
            for (int q = 0; q < 8; ++q) {
              const float pv = E[rl * 65 + cp + q];
              const float cs = tb[2 * q], sn = tb[2 * q + 1];
              o[q] = (c0 < 8) ? (v[q] * cs - pv * sn) : (v[q] * cs + pv * sn);
            }
          }
          h8 ov;
#pragma unroll
          for (int q = 0; q < 8; ++q) {
            float t = o[q] * scale;
            if (mode == 1) t = t / (1.f + __expf(-t));
            else if (mode == 2) t = 1.f / (1.f + __expf(-t));
            ov[q] = (half_t)t;
          }
          if (n0 < C_END) *(h8*)(P + (size_t)row * PP + n0) = ov;
          if (n0 >= C_GLAA && n0 < C_MRG) {
#pragma unroll
            for (int q = 0; q < 8; ++q) GA[(size_t)row * 16 + (n0 - C_GLAA) + q] = v[q];
          }
          if (n0 == C_IDXW) {
#pragma unroll
            for (int q = 0; q < 4; ++q) IW[(size_t)row * 4 + q] = 0.5f * v[q];
          }
        }
      }
    }
  }
}

#define LA_BC 0
#define LA_GAS 16640
#define LA_WL 20736
#define LA_QT 24832
#define LA_KT 34048
#define LA_AT 43264
#define LA_VT 52480
#define LA_SS 70912
#define LA_OS 89344
#define LA_SEG 123136

__device__ void la_bcum(const Params& p, int layer, int n, int Hh, unsigned char* lds) {
  const int tid = otid();
  float* Bc = (float*)(lds + LA_BC);
  const int d = tid & 63, q = tid >> 6;
  if (Hh < 4) {
    float lg = log1pf(-exp2f(-5.0f - (float)Hh));
#pragma unroll
    for (int jj = 0; jj < 16; ++jj) { int j = q * 16 + jj; Bc[j * 65 + d] = (float)(j + 1) * lg; }
    __syncthreads();
    return;
  }
  const int h = Hh - 4;
  float* GAs = (float*)(lds + LA_GAS);
  float* WL = (float*)(lds + LA_WL);
  float* SEG = (float*)(lds + LA_SEG);
  const float* GA = (const float*)(p.ws + OFF_GA);
#pragma unroll
  for (int i = 0; i < 4; ++i) {
    int e = tid + 256 * i;
    GAs[e] = GA[(size_t)n * 64 * 16 + e];
    int r = e >> 6, dd = e & 63;
    WL[e] = p.gla_w_lr[(size_t)layer * 16 * 256 + r * 256 + h * 64 + dd];
  }
  __syncthreads();
  float wl[16];
#pragma unroll
  for (int r = 0; r < 16; ++r) wl[r] = WL[r * 64 + d];
  const float bl = p.gla_b_lr[layer * 256 + h * 64 + d];
  float run = 0.f;
#pragma unroll
  for (int jj = 0; jj < 16; ++jj) {
    int j = q * 16 + jj;
    float z = bl;
#pragma unroll
    for (int r = 0; r < 16; ++r) z += GAs[j * 16 + r] * wl[r];
    float ls = fminf(z, 0.f) - log1pf(expf(-fabsf(z)));
    run += ls * (1.0f / 16.0f);
    Bc[j * 65 + d] = run;
  }
  SEG[q * 64 + d] = run;
  __syncthreads();
  float off = 0.f;
  for (int qq = 0; qq < q; ++qq) off += SEG[qq * 64 + d];
  if (q > 0) {
#pragma unroll
    for (int jj = 0; jj < 16; ++jj) { int j = q * 16 + jj; Bc[j * 65 + d] += off; }
  }
  __syncthreads();
}

__device__ __forceinline__ void la_stage_vt(const half_t* __restrict__ P, int t0, int vcol, unsigned char* lds) {
  const int tid = otid(), w = tid >> 6, l = tid & 63;
  half_t* VT = (half_t*)(lds + LA_VT);
  const int jp = l & 31, cgp = l >> 5;
#pragma unroll
  for (int it = 0; it < 2; ++it) {
    int c = it * 8 + w * 2 + cgp;
    h8 v0 = *(const h8*)(P + (size_t)(t0 + 2 * jp) * PP + vcol + c * 8);
    h8 v1 = *(const h8*)(P + (size_t)(t0 + 2 * jp + 1) * PP + vcol + c * 8);
#pragma unroll
    for (int q = 0; q < 8; ++q) {
      h2 pr; pr[0] = v0[q]; pr[1] = v1[q];
      *(h2*)(VT + (c * 8 + q) * 72 + 2 * jp) = pr;
    }
  }
}

__device__ void la_item_kv(const Params& p, int layer, int item, unsigned char* lds) {
  const int tid = otid(), w = tid >> 6, l = tid & 63;
  const int n = item >> 3, Hh = item & 7;
  const int t0 = n * 64;
  const half_t* P = (const half_t*)(p.ws + OFF_P);
  float* ST = (float*)(p.ws + OFF_ST);
  float* DEC = (float*)(p.ws + OFF_DEC);
  const int kcol = (Hh < 4) ? (C_RETK + Hh * 64) : (C_GLAK + (Hh - 4) * 64);
  const int vcol = (Hh < 4) ? (C_RETV + Hh * 128) : (C_GLAV + (Hh - 4) * 128);
  __syncthreads();
  la_bcum(p, layer, n, Hh, lds);
  const float* Bc = (const float*)(lds + LA_BC);
  half_t* KhT = (half_t*)(lds + LA_KT);
  half_t* VT = (half_t*)(lds + LA_VT);
  {
    const int jp = l & 31, cgp = l >> 5;
    int c = w * 2 + cgp;
    h8 k0 = *(const h8*)(P + (size_t)(t0 + 2 * jp) * PP + kcol + c * 8);
    h8 k1 = *(const h8*)(P + (size_t)(t0 + 2 * jp + 1) * PP + kcol + c * 8);
#pragma unroll
    for (int q = 0; q < 8; ++q) {
      int d = c * 8 + q;
      float bl = Bc[63 * 65 + d];
      h2 pr;
      pr[0] = (half_t)((float)k0[q] * __expf(bl - Bc[(2 * jp) * 65 + d]));
      pr[1] = (half_t)((float)k1[q] * __expf(bl - Bc[(2 * jp + 1) * 65 + d]));
      *(h2*)(KhT + d * 72 + 2 * jp) = pr;
    }
  }
  la_stage_vt(P, t0, vcol, lds);
  if (tid < 64) DEC[(size_t)item * 64 + tid] = __expf(Bc[63 * 65 + tid]);
  __syncthreads();
  f16v acc[2];
#pragma unroll
  for (int j = 0; j < 2; ++j)
#pragma unroll
    for (int r = 0; r < 16; ++r) acc[j][r] = 0.f;
#pragma unroll
  for (int ks = 0; ks < 4; ++ks) {
    h8 a = *(const h8*)(VT + (32 * w + (l & 31)) * 72 + ks * 16 + (l >> 5) * 8);
#pragma unroll
    for (int j = 0; j < 2; ++j) {
      h8 b = *(const h8*)(KhT + (j * 32 + (l & 31)) * 72 + ks * 16 + (l >> 5) * 8);
      acc[j] = mfma16(a, b, acc[j]);
    }
  }
#pragma unroll
  for (int j = 0; j < 2; ++j)
#pragma unroll
    for (int r = 0; r < 16; ++r) {
      int e = 32 * w + crow(r, l);
      int d = j * 32 + (l & 31);
      ST[(size_t)item * 8192 + e * 64 + d] = acc[j][r];
    }
}

__device__ void phase_scan(const Params& p) {
  float* ST = (float*)(p.ws + OFF_ST);
  const float* DEC = (const float*)(p.ws + OFF_DEC);
  for (int f = blockIdx.x * NTHREADS + otid(); f < 65536; f += gridDim.x * NTHREADS) {
    const int Hh = f >> 13, d = f & 63;
    float s = 0.f;
    for (int n0 = 0; n0 < 256; n0 += 8) {
      float kv[8], dc[8];
#pragma unroll
      for (int u = 0; u < 8; ++u) {
        kv[u] = ST[(size_t)(n0 + u) * 65536 + f];
        dc[u] = DEC[(size_t)((n0 + u) * 8 + Hh) * 64 + d];
      }
#pragma unroll
      for (int u = 0; u < 8; ++u) {
        ST[(size_t)(n0 + u) * 65536 + f] = s;
        s = dc[u] * s + kv[u];
      }
    }
  }
}

__device__ void la_item_out(const Params& p, int layer, int item, unsigned char* lds) {
  const int tid = otid(), w = tid >> 6, l = tid & 63;
  const int n = item >> 3, Hh = item & 7;
  const int t0 = n * 64;
  const half_t* P = (const half_t*)(p.ws + OFF_P);
  const float* ST = (const float*)(p.ws + OFF_ST);
  half_t* BR = (half_t*)(p.ws + OFF_BR);
  const int qcol = (Hh < 4) ? (C_RETQ + Hh * 64) : (C_GLAQ + (Hh - 4) * 64);
  const int kcol = (Hh < 4) ? (C_RETK + Hh * 64) : (C_GLAK + (Hh - 4) * 64);
  const int vcol = (Hh < 4) ? (C_RETV + Hh * 128) : (C_GLAV + (Hh - 4) * 128);
  const int gcol = (Hh < 4) ? (C_RETG + Hh * 128) : (C_GLAG + (Hh - 4) * 128);
  const int ocol = (Hh < 4) ? (Hh * 128) : (1024 + (Hh - 4) * 128);
  __syncthreads();
  la_bcum(p, layer, n, Hh, lds);
  const float* Bc = (const float*)(lds + LA_BC);
  half_t* Qt = (half_t*)(lds + LA_QT);
  half_t* Kt = (half_t*)(lds + LA_KT);
  half_t* AT = (half_t*)(lds + LA_AT);
  half_t* VT = (half_t*)(lds + LA_VT);
  half_t* SS = (half_t*)(lds + LA_SS);
  float* OS = (float*)(lds + LA_OS);
#pragma unroll
  for (int it = 0; it < 2; ++it) {
    int c = tid + 256 * it;
    int row = c >> 3, kc = c & 7;
    h8 qv = *(const h8*)(P + (size_t)(t0 + row) * PP + qcol + kc * 8);
    h8 kv = *(const h8*)(P + (size_t)(t0 + row) * PP + kcol + kc * 8);
    h8 qo, ko;
#pragma unroll
    for (int q = 0; q < 8; ++q) {
      float b = Bc[row * 65 + kc * 8 + q];
      qo[q] = (half_t)((float)qv[q] * __expf(b));
      ko[q] = (half_t)((float)kv[q] * __expf(-b));
    }
    *(h8*)(Qt + row * 72 + kc * 8) = qo;
    *(h8*)(Kt + row * 72 + kc * 8) = ko;
  }
  la_stage_vt(P, t0, vcol, lds);
#pragma unroll
  for (int it = 0; it < 4; ++it) {
    int c = tid + 256 * it;
    int e = c >> 3, kc = c & 7;
    const float* sp = ST + (size_t)item * 8192 + e * 64 + kc * 8;
    f4v s0 = *(const f4v*)sp, s1 = *(const f4v*)(sp + 4);
    h8 o;
    o[0] = (half_t)s0[0]; o[1] = (half_t)s0[1]; o[2] = (half_t)s0[2]; o[3] = (half_t)s0[3];
    o[4] = (half_t)s1[0]; o[5] = (half_t)s1[1]; o[6] = (half_t)s1[2]; o[7] = (half_t)s1[3];
    *(h8*)(SS + e * 72 + kc * 8) = o;
  }
  __syncthreads();
  {
    const int mi = w >> 1, nj = w & 1;
    f16v acc;
#pragma unroll
    for (int r = 0; r < 16; ++r) acc[r] = 0.f;
#pragma unroll
    for (int ks = 0; ks < 4; ++ks) {
      h8 a = *(const h8*)(Qt + (mi * 32 + (l & 31)) * 72 + ks * 16 + (l >> 5) * 8);
      h8 b = *(const h8*)(Kt + (nj * 32 + (l & 31)) * 72 + ks * 16 + (l >> 5) * 8);
      acc = mfma16(a, b, acc);
    }
#pragma unroll
    for (int r = 0; r < 16; ++r) {
      int i = mi * 32 + crow(r, l);
      int j = nj * 32 + (l & 31);
      float v = (j <= i) ? acc[r] : 0.f;
      AT[i * 72 + j] = (half_t)v;
    }
  }
  __syncthreads();
  {
    const int mi = w >> 1, nh = w & 1;
    f16v acc[2];
#pragma unroll
    for (int j = 0; j < 2; ++j)
#pragma unroll
      for (int r = 0; r < 16; ++r) acc[j][r] = 0.f;
#pragma unroll
    for (int ks = 0; ks < 4; ++ks) {
      h8 a1 = *(const h8*)(AT + (mi * 32 + (l & 31)) * 72 + ks * 16 + (l >> 5) * 8);
      h8 a2 = *(const h8*)(Qt + (mi * 32 + (l & 31)) * 72 + ks * 16 + (l >> 5) * 8);
#pragma unroll
      for (int j = 0; j < 2; ++j) {
        h8 b1 = *(const h8*)(VT + (nh * 64 + j * 32 + (l & 31)) * 72 + ks * 16 + (l >> 5) * 8);
        h8 b2 = *(const h8*)(SS + (nh * 64 + j * 32 + (l & 31)) * 72 + ks * 16 + (l >> 5) * 8);
        acc[j] = mfma16(a1, b1, acc[j]);
        acc[j] = mfma16(a2, b2, acc[j]);
      }
    }
#pragma unroll
    for (int j = 0; j < 2; ++j)
#pragma unroll
      for (int r = 0; r < 16; ++r) {
        int i = mi * 32 + crow(r, l);
        int e = nh * 64 + j * 32 + (l & 31);
        OS[i * 132 + e] = acc[j][r];
      }
  }
  __syncthreads();
  {
    const int i = tid >> 2, qd = tid & 3;
    float ov[32];
    float ss = 0.f;
#pragma unroll
    for (int c = 0; c < 8; ++c) {
      f4v v = *(const f4v*)(OS + i * 132 + qd * 32 + c * 4);
      ov[c * 4] = v[0]; ov[c * 4 + 1] = v[1]; ov[c * 4 + 2] = v[2]; ov[c * 4 + 3] = v[3];
      ss += v[0] * v[0] + v[1] * v[1] + v[2] * v[2] + v[3] * v[3];
    }
    ss += __shfl_xor(ss, 1);
    ss += __shfl_xor(ss, 2);
    float rs = rsqrtf(ss * (1.0f / 128.0f) + 1e-6f);
#pragma unroll
    for (int c = 0; c < 4; ++c) {
      h8 g = *(const h8*)(P + (size_t)(t0 + i) * PP + gcol + qd * 32 + c * 8);
      h8 o;
#pragma unroll
      for (int q = 0; q < 8; ++q) o[q] = (half_t)(ov[c * 8 + q] * rs * (float)g[q]);
      *(h8*)(BR + (size_t)(t0 + i) * 1536 + ocol + qd * 32 + c * 8) = o;
    }
  }
}

#define DS_LS 0
#define DS_LI 65536
#define DS_CNT 98304
#define DS_THR (98304 + 128)
#define DS_WQ (98304 + 256)
#define DS_HIST (98304 + 1024)
#define DS_PW (98304 + 1024 + 4096)
#define DS_CAP 512

__device__ __forceinline__ unsigned long long wave_or64(unsigned long long v) {
  unsigned lo = (unsigned)v, hi = (unsigned)(v >> 32);
#pragma unroll
  for (int o = 32; o > 0; o >>= 1) { lo |= __shfl_xor(lo, o); hi |= __shfl_xor(hi, o); }
  return ((unsigned long long)hi << 32) | lo;
}
__device__ __forceinline__ void dsa_prune(float* LSm, unsigned short* LIm, int n, unsigned* hist, int* cntm, float* thrm, int l) {
  unsigned long long comp[8];
  bool act[8], val[8];
#pragma unroll
  for (int k = 0; k < 8; ++k) {
    int e = l + 64 * k;
    val[k] = e < n;
    unsigned u = 0, li = 0;
    if (val[k]) { u = __float_as_uint(LSm[e]); li = LIm[e]; }
    const unsigned key = (u >> 31) ? ~u : (u | 0x80000000u);
    comp[k] = ((unsigned long long)key << 14) | (unsigned long long)(16383u - li);
    act[k] = val[k];
  }
  const unsigned long long c0 = ((unsigned long long)__shfl((unsigned)(comp[0] >> 32), 0) << 32) | __shfl((unsigned)comp[0], 0);
  unsigned long long x = 0;
#pragma unroll
  for (int k = 0; k < 8; ++k) x |= val[k] ? (comp[k] ^ c0) : 0ull;
  x = wave_or64(x);
  int shift = (x == 0ull) ? 0 : (63 - __clzll((long long)x)) - 7;
  if (shift < 0) shift = 0;
  unsigned rank = 256;
#pragma unroll 1
  for (int rd = 0; rd < 8; ++rd) {
    *(uint4*)(hist + 4 * l) = make_uint4(0, 0, 0, 0);
    __threadfence_block();
    unsigned dk[8];
#pragma unroll
    for (int k = 0; k < 8; ++k) {
      dk[k] = (unsigned)(comp[k] >> shift) & 255u;
      if (act[k]) atomicAdd(&hist[dk[k]], 1u);
    }
    __threadfence_block();
    uint4 hv; hv.x = hist[4 * l]; hv.y = hist[4 * l + 1]; hv.z = hist[4 * l + 2]; hv.w = hist[4 * l + 3];
    unsigned tl = hv.x + hv.y + hv.z + hv.w;
    unsigned incl = tl;
#pragma unroll
    for (int off = 1; off < 64; off <<= 1) {
      unsigned v = __shfl_down(incl, off);
      if (l + off < 64) incl += v;
    }
    unsigned sx = incl - tl;
    bool mine = (sx < rank) && (rank <= sx + tl);
    unsigned dsel = 0, nr = 0, hsel = 0;
    if (mine) {
      unsigned c = sx;
      if (c + hv.w >= rank) { dsel = 4 * l + 3; nr = rank - c; hsel = hv.w; }
      else {
        c += hv.w;
        if (c + hv.z >= rank) { dsel = 4 * l + 2; nr = rank - c; hsel = hv.z; }
        else {
          c += hv.z;
          if (c + hv.y >= rank) { dsel = 4 * l + 1; nr = rank - c; hsel = hv.y; }
          else { c += hv.y; dsel = 4 * l; nr = rank - c; hsel = hv.x; }
        }
      }
    }
    unsigned long long mk = __ballot(mine);
    int src = (mk == 0ull) ? 0 : (__ffsll((long long)mk) - 1);
    dsel = __shfl(dsel, src);
    rank = __shfl(nr, src);
    hsel = __shfl(hsel, src);
#pragma unroll
    for (int k = 0; k < 8; ++k) act[k] = act[k] && (dk[k] == dsel);
    if (hsel <= 1u || shift == 0) break;
    shift = (shift >= 8) ? (shift - 8) : 0;
  }
  unsigned long long tsel = 0;
#pragma unroll
  for (int k = 0; k < 8; ++k) tsel |= act[k] ? comp[k] : 0ull;
  const unsigned long long T = wave_or64(tsel);
  bool keep[8];
  unsigned cntk = 0;
#pragma unroll
  for (int k = 0; k < 8; ++k) {
    keep[k] = val[k] && (comp[k] >= T);
    cntk += keep[k] ? 1u : 0u;
  }
  unsigned incl = cntk;
#pragma unroll
  for (int off = 1; off < 64; off <<= 1) {
    unsigned v = __shfl_up(incl, off);
    if (l >= off) incl += v;
  }
  unsigned pos = incl - cntk;
  __threadfence_block();
#pragma unroll
  for (int k = 0; k < 8; ++k) {
    if (keep[k]) {
      const unsigned kk = (unsigned)(comp[k] >> 14);
      const unsigned u = (kk & 0x80000000u) ? (kk & 0x7FFFFFFFu) : ~kk;
      LSm[pos] = __uint_as_float(u);
      LIm[pos] = (unsigned short)(16383u - ((unsigned)comp[k] & 16383u));
      ++pos;
    }
  }
  if (l == 0) {
    const unsigned T32 = (unsigned)(T >> 14);
    *cntm = 256;
    *thrm = __uint_as_float((T32 & 0x80000000u) ? (T32 & 0x7FFFFFFFu) : ~T32);
  }
  __threadfence_block();
}

__device__ void dsa_item(const Params& p, int qb, unsigned char* lds) {
  const int tid = otid(), w = tid >> 6, l = tid & 63;
  const int t0 = qb * 32;
  const half_t* P = (const half_t*)(p.ws + OFF_P);
  const float* IW = (const float*)(p.ws + OFF_IW);
  half_t* BR = (half_t*)(p.ws + OFF_BR);
  float* LS = (float*)(lds + DS_LS);
  unsigned short* LI = (unsigned short*)(lds + DS_LI);
  int* cnt = (int*)(lds + DS_CNT);
  float* thr = (float*)(lds + DS_THR);
  float* wq = (float*)(lds + DS_WQ);
  unsigned* hist = (unsigned*)(lds + DS_HIST) + w * 256;
  float* PW = (float*)(lds + DS_PW) + w * 1024;
  half_t* QS = (half_t*)(lds + DS_PW + 16384) + w * 512;
  for (int rep_sel = 0; rep_sel < REP_SEL; ++rep_sel) {
  __syncthreads();
  if (tid < 32) { cnt[tid] = 0; thr[tid] = -INFINITY; }
  if (tid < 128) wq[tid] = IW[(size_t)t0 * 4 + tid];
  __syncthreads();
  h8 aq[4][4];
#pragma unroll
  for (int h = 0; h < 4; ++h)
#pragma unroll
    for (int ks = 0; ks < 4; ++ks)
      aq[h][ks] = *(const h8*)(P + (size_t)(t0 + (l & 31)) * PP + C_IDXQ + h * 64 + ks * 16 + (l >> 5) * 8);
  const int nt = qb + 1;
  const int nr = (nt + 3) >> 2;
  h8 bk[4];
  {
    const int k0 = (w < nt) ? w : 0;
#pragma unroll
    for (int ks = 0; ks < 4; ++ks)
      bk[ks] = *(const h8*)(P + (size_t)(k0 * 32 + (l & 31)) * PP + C_IDXK + ks * 16 + (l >> 5) * 8);
  }
#pragma unroll 1
  for (int rd = 0; rd < nr; ++rd) {
    const int kt = 4 * rd + w;
    h8 bkn[4];
    {
      const int kn = (kt + 4 < nt) ? (kt + 4) : 0;
#pragma unroll
      for (int ks = 0; ks < 4; ++ks)
        bkn[ks] = *(const h8*)(P + (size_t)(kn * 32 + (l & 31)) * PP + C_IDXK + ks * 16 + (l >> 5) * 8);
    }
    if (kt < nt) {
      const int sbase = kt * 32;
      f16v acc[4];
#pragma unroll
      for (int h = 0; h < 4; ++h) {
#pragma unroll
        for (int r = 0; r < 16; ++r) acc[h][r] = 0.f;
#pragma unroll
        for (int ks = 0; ks < 4; ++ks) acc[h] = mfma16(aq[h][ks], bk[ks], acc[h]);
      }
      const int s = sbase + (l & 31);
      float scv[16];
      unsigned pm = 0;
#pragma unroll
      for (int r = 0; r < 16; ++r) {
        const int m = crow(r, l);
        const f4v wv = *(const f4v*)(wq + m * 4);
        float sc = wv[0] * fmaxf(acc[0][r], 0.f) + wv[1] * fmaxf(acc[1][r], 0.f) + wv[2] * fmaxf(acc[2][r], 0.f) + wv[3] * fmaxf(acc[3][r], 0.f);
        sc += 0.0f;
        scv[r] = sc;
        const float th = thr[m];
        const bool pass = (s <= t0 + m) && (sc > th);
        pm |= pass ? (1u << r) : 0u;
      }
      if (__ballot(pm != 0u) != 0ull) {
        unsigned long long mks[16];
        int mycnt = 0;
#pragma unroll
        for (int r = 0; r < 16; ++r) {
          const unsigned long long mk = __ballot(((pm >> r) & 1u) != 0u);
          mks[r] = mk;
          const unsigned hm = (l < 32) ? (unsigned)mk : (unsigned)(mk >> 32);
          if ((l & 31) == r) mycnt = __popc(hm);
        }
        int base = 0;
        if ((l & 31) < 16 && mycnt > 0) base = atomicAdd(&cnt[crow(l & 31, l)], mycnt);
#pragma unroll
        for (int r = 0; r < 16; ++r) {
          const unsigned long long mk = mks[r];
          if (mk != 0ull) {
            const unsigned hm = (l < 32) ? (unsigned)mk : (unsigned)(mk >> 32);
            const int bb = __shfl(base, (l & 32) + r);
            if ((pm >> r) & 1u) {
              const int m = crow(r, l);
              const int slot = bb + __popc(hm & ((1u << (l & 31)) - 1u));
              LS[m * DS_CAP + slot] = scv[r];
              LI[m * DS_CAP + slot] = (unsigned short)s;
            }
          }
        }
      }
    }
    __syncthreads();
    {
      const int cv = (l < 32) ? cnt[l] : 0;
      unsigned pmask = (unsigned)__ballot(cv > 384);
      int j = 0;
      while (pmask != 0u) {
        const int m = __ffs((int)pmask) - 1;
        pmask &= pmask - 1u;
        if ((j & 3) == w) dsa_prune(LS + m * DS_CAP, LI + m * DS_CAP, cnt[m], hist, cnt + m, thr + m, l);
        ++j;
      }
    }
    __syncthreads();
#pragma unroll
    for (int ks = 0; ks < 4; ++ks) bk[ks] = bkn[ks];
  }
  }
  for (int rep_att = 0; rep_att < REP_ATT; ++rep_att)
#pragma unroll 1
  for (int mm = 0; mm < 8; ++mm) {
    const int m = w * 8 + mm;
    const int t = t0 + m;
    int c = cnt[m];
    if (c > 256) { dsa_prune(LS + m * DS_CAP, LI + m * DS_CAP, c, hist, cnt + m, thr + m, l); c = 256; }
    const unsigned short* LIm = LI + m * DS_CAP;
    *(h8*)(QS + l * 8) = *(const h8*)(P + (size_t)t * PP + C_DSAQ + l * 8);
    __threadfence_block();
#pragma unroll 1
    for (int g = 0; g < 2; ++g) {
      h8 kvr[4][8];
      bool vld[4];
#pragma unroll
      for (int kk = 0; kk < 4; ++kk) {
        const int e = l + 64 * kk;
        vld[kk] = e < c;
        const int s = vld[kk] ? (int)LIm[e] : 0;
        const half_t* kr = P + (size_t)s * PP + C_DSAK + g * 64;
#pragma unroll
        for (int ch = 0; ch < 8; ++ch) kvr[kk][ch] = *(const h8*)(kr + ch * 8);
      }
      float lg[4][4];
#pragma unroll
      for (int hh = 0; hh < 4; ++hh) {
#pragma unroll
        for (int kk = 0; kk < 4; ++kk) lg[hh][kk] = 0.f;
#pragma unroll
        for (int ch = 0; ch < 8; ++ch) {
          const h8 qq = *(const h8*)(QS + (g * 4 + hh) * 64 + ch * 8);
#pragma unroll
          for (int kk = 0; kk < 4; ++kk) {
            float a = lg[hh][kk];
            a = __builtin_amdgcn_fdot2(__builtin_shufflevector(qq, qq, 0, 1), __builtin_shufflevector(kvr[kk][ch], kvr[kk][ch], 0, 1), a, false);
            a = __builtin_amdgcn_fdot2(__builtin_shufflevector(qq, qq, 2, 3), __builtin_shufflevector(kvr[kk][ch], kvr[kk][ch], 2, 3), a, false);
            a = __builtin_amdgcn_fdot2(__builtin_shufflevector(qq, qq, 4, 5), __builtin_shufflevector(kvr[kk][ch], kvr[kk][ch], 4, 5), a, false);
            a = __builtin_amdgcn_fdot2(__builtin_shufflevector(qq, qq, 6, 7), __builtin_shufflevector(kvr[kk][ch], kvr[kk][ch], 6, 7), a, false);
            lg[hh][kk] = a;
          }
        }
#pragma unroll
        for (int kk = 0; kk < 4; ++kk) lg[hh][kk] = vld[kk] ? lg[hh][kk] : -INFINITY;
      }
#pragma unroll
      for (int hh = 0; hh < 4; ++hh) {
        float mx = fmaxf(fmaxf(lg[hh][0], lg[hh][1]), fmaxf(lg[hh][2], lg[hh][3]));
        mx = wave_max(mx);
        float ev[4]; float sm = 0.f;
#pragma unroll
        for (int kk = 0; kk < 4; ++kk) { ev[kk] = __expf(lg[hh][kk] - mx); sm += ev[kk]; }
        sm = wave_sum(sm);
        const float inv = 1.0f / sm;
#pragma unroll
        for (int kk = 0; kk < 4; ++kk) PW[(l + 64 * kk) * 4 + hh] = ev[kk] * inv;
      }
      __threadfence_block();
      const int dch = l & 7, ksub = l >> 3;
      float o[4][8];
#pragma unroll
      for (int hh = 0; hh < 4; ++hh)
#pragma unroll
        for (int q = 0; q < 8; ++q) o[hh][q] = 0.f;
      const int nit = (c + 7) >> 3;
#pragma unroll 1
      for (int it0 = 0; it0 < nit; it0 += 16) {
        h8 vv[16];
#pragma unroll
        for (int i = 0; i < 16; ++i) {
          const int e = (it0 + i) * 8 + ksub;
          const int s = (e < c) ? (int)LIm[e] : 0;
          vv[i] = *(const h8*)(P + (size_t)s * PP + C_DSAV + g * 64 + dch * 8);
        }
#pragma unroll
        for (int i = 0; i < 16; ++i) {
          const int e = (it0 + i) * 8 + ksub;
          const f4v pv = *(const f4v*)(PW + e * 4);
#pragma unroll
          for (int hh = 0; hh < 4; ++hh)
#pragma unroll
            for (int q = 0; q < 8; ++q) o[hh][q] += pv[hh] * (float)vv[i][q];
        }
      }
#pragma unroll
      for (int hh = 0; hh < 4; ++hh)
#pragma unroll
        for (int q = 0; q < 8; ++q) {
          float v = o[hh][q];
          v += __shfl_xor(v, 8); v += __shfl_xor(v, 16); v += __shfl_xor(v, 32);
          o[hh][q] = v;
        }
      if (l < 8) {
#pragma unroll
        for (int hh = 0; hh < 4; ++hh) {
          const int col = (g * 4 + hh) * 64 + dch * 8;
          const h8 gt = *(const h8*)(P + (size_t)t * PP + C_DSAG + col);
          h8 ov;
#pragma unroll
          for (int q = 0; q < 8; ++q) ov[q] = (half_t)(o[hh][q] * (float)gt[q]);
          *(h8*)(BR + (size_t)t * 1536 + 512 + col) = ov;
        }
      }
      __threadfence_block();
    }
  }
}

__device__ void phase_B(const Params& p, int layer, unsigned char* lds) {
  const int G = gridDim.x;
  for (int j = 0; j * G < 512; ++j) {
    const int b = (j & 1) ? (G - 1 - (int)blockIdx.x) : (int)blockIdx.x;
    const int idx = j * G + b;
#ifndef NO_DSA
    if (idx < 512) dsa_item(p, 511 - idx, lds);
#endif
  }
#ifndef NO_LAKV
  for (int it = blockIdx.x; it < 2048; it += G) la_item_kv(p, layer, it, lds);
#endif
}

__device__ void phase_E1(const Params& p, int layer, unsigned char* lds) {
  const int tid = otid(), w = tid >> 6, l = tid & 63;
  const half_t* BR = (const half_t*)(p.ws + OFF_BR);
  const half_t* WbrT = (const half_t*)(p.ws + OFF_WBRT) + (size_t)layer * 3 * 1024 * 512;
  const half_t* P = (const half_t*)(p.ws + OFF_P);
  half_t* Y1 = (half_t*)(p.ws + OFF_H);
  const int wm = w >> 1, wn = w & 1;
  float* E = (float*)(lds + 73728) + w * (32 * 65);
  const int prow = l >> 3, c0 = (l & 7) * 8;
  for (int tix = blockIdx.x; tix < 512; tix += gridDim.x) {
    const int mt = tix & 63, nt = tix >> 6;
    float tot[4][4][8];
#pragma unroll
    for (int i = 0; i < 4; ++i)
#pragma unroll
      for (int ps = 0; ps < 4; ++ps)
#pragma unroll
        for (int q = 0; q < 8; ++q) tot[i][ps][q] = 0.f;
    const int m0w = mt * 256 + wm * 128;
    const int n0 = nt * 128 + wn * 64 + c0;
#pragma unroll 1
    for (int b = 0; b < 3; ++b) {
      f16v acc[4][2];
      zero_acc<2>(acc);
      gemm_kloop<2>(acc, BR + (size_t)mt * 256 * 1536 + b * 512, 1536, WbrT + (size_t)b * 1024 * 512 + (size_t)nt * 128 * 512, 512, 512, lds);
#pragma unroll
      for (int i = 0; i < 4; ++i) {
        stage_pair(E, acc[i][0], acc[i][1], l);
#pragma unroll
        for (int ps = 0; ps < 4; ++ps) {
          const int rl = ps * 8 + prow;
          const int row = m0w + i * 32 + rl;
          const h8 g = *(const h8*)(P + (size_t)row * PP + C_MRG + b * 1024 + n0);
#pragma unroll
          for (int q = 0; q < 8; ++q) tot[i][ps][q] += (float)g[q] * E[rl * 65 + c0 + q];
        }
      }
    }
#pragma unroll
    for (int i = 0; i < 4; ++i)
#pragma unroll
      for (int ps = 0; ps < 4; ++ps) {
        const int row = m0w + i * 32 + ps * 8 + prow;
        h8 o;
#pragma unroll
        for (int q = 0; q < 8; ++q) o[q] = (half_t)tot[i][ps][q];
        *(h8*)(Y1 + (size_t)row * 1024 + n0) = o;
      }
  }
}

__device__ void phase_E2(const Params& p, int layer, unsigned char* lds) {
  const int tid = otid(), w = tid >> 6, l = tid & 63;
  const half_t* Y1 = (const half_t*)(p.ws + OFF_H);
  const half_t* Wo = (const half_t*)(p.ws + OFF_WOUTT) + (size_t)layer * 1024 * 1024;
  float* Y = (float*)(p.ws + OFF_ST);
  const int wm = w >> 1, wn = w & 1;
  for (int tix = blockIdx.x; tix < 512; tix += gridDim.x) {
    const int mt = tix & 63, nt = tix >> 6;
    f16v acc[4][2];
    zero_acc<2>(acc);
    gemm_kloop<2>(acc, Y1 + (size_t)mt * 256 * 1024, 1024, Wo + (size_t)nt * 128 * 1024, 1024, 1024, lds);
    const int m0w = mt * 256 + wm * 128;
    const int n0w = nt * 128 + wn * 64;
#pragma unroll
    for (int i = 0; i < 4; ++i)
#pragma unroll
      for (int j = 0; j < 2; ++j)
#pragma unroll
        for (int r = 0; r < 16; ++r) {
          const int row = m0w + i * 32 + crow(r, l);
          const int n = n0w + j * 32 + (l & 31);
          Y[(size_t)row * 1024 + n] = acc[i][j][r];
        }
  }
}

__device__ void phase_E3(const Params& p, int layer) {
  const int w = otid() >> 6, l = otid() & 63;
  const float* Y = (const float*)(p.ws + OFF_ST);
  const float* MOD = (const float*)(p.ws + OFF_MOD);
  half_t* H = (half_t*)(p.ws + OFF_H);
  const float* xin = (layer == 0) ? p.x : p.out;
  const float* gate = MOD + layer * 3072 + 2048;
  const float* post = p.post_norm + layer * 1024;
  for (int row = blockIdx.x * 4 + w; row < S_LEN; row += gridDim.x * 4) {
    float yv[16], xv[16];
    float ss = 0.f;
#pragma unroll
    for (int i = 0; i < 4; ++i) {
      f4v v = *(const f4v*)(Y + (size_t)row * 1024 + i * 256 + l * 4);
      f4v xx = *(const f4v*)(xin + (size_t)row * 1024 + i * 256 + l * 4);
#pragma unroll
      for (int q = 0; q < 4; ++q) { yv[i * 4 + q] = v[q]; xv[i * 4 + q] = xx[q]; ss += v[q] * v[q]; }
    }
    ss = wave_sum(ss);
    const float rs = rsqrtf(ss * (1.0f / 1024.0f) + 1e-6f);
#pragma unroll
    for (int i = 0; i < 4; ++i) {
      const int c0 = i * 256 + l * 4;
      f4v gt = *(const f4v*)(gate + c0);
      f4v pn = *(const f4v*)(post + c0);
      f4v o;
#pragma unroll
      for (int q = 0; q < 4; ++q) { o[q] = xv[i * 4 + q] + gt[q] * (yv[i * 4 + q] * rs * pn[q]); xv[i * 4 + q] = o[q]; }
      *(f4v*)(p.out + (size_t)row * 1024 + c0) = o;
    }
    if (layer + 1 < DEPTH)
      write_h_row(xv, p.pre_norm + (layer + 1) * 1024, MOD + (layer + 1) * 3072, H + (size_t)row * 1024, l);
  }
}

#ifndef REP_A
#define REP_A 1
#endif
#ifndef REP_B
#define REP_B 1
#endif
#ifdef ONLY_PHASE
#define PH_EN(x) (ONLY_PHASE == (x))
#else
#define PH_EN(x) true
#endif
__global__ void __launch_bounds__(NTHREADS) fwd_megakernel(Params p) {
  extern __shared__ __attribute__((aligned(16))) unsigned char lds[];
  cg::grid_group grid = cg::this_grid();
  unsigned* bar = (unsigned*)(p.ws + WS_END);
  unsigned nbar = 0;
  if (blockIdx.x == 0 && otid() == 0) __hip_atomic_store(bar, 0u, __ATOMIC_RELAXED, __HIP_MEMORY_SCOPE_AGENT);
  for (int ph = p.ph_lo; ph < p.ph_hi; ++ph) {
    if (ph == 0) { if (PH_EN(0)) phase_prologue(p, lds); }
    else if (ph == 1) { if (PH_EN(1)) phase_h0(p); }
    else {
      const int layer = (ph - 2) / 7, sub = (ph - 2) % 7;
      if (sub == 0) { if (PH_EN(2)) for (int rep = 0; rep < REP_A; ++rep) { phase_A(p, layer, lds); __syncthreads(); } }
      else if (sub == 1) { if (PH_EN(3)) for (int rep = 0; rep < REP_B; ++rep) { phase_B(p, layer, lds); __syncthreads(); } }
      else if (sub == 2) { if (PH_EN(4)) phase_scan(p); }
      else if (sub == 3) { if (PH_EN(5)) for (int it = blockIdx.x; it < 2048; it += gridDim.x) la_item_out(p, layer, it, lds); }
      else if (sub == 4) { if (PH_EN(6)) phase_E1(p, layer, lds); }
      else if (sub == 5) { if (PH_EN(7)) phase_E2(p, layer, lds); }
      else { if (PH_EN(8)) phase_E3(p, layer); }
    }
    if (ph + 1 < p.ph_hi) {
      if (ph == p.ph_lo) grid.sync();
      else {
        __threadfence();
        __syncthreads();
        if (otid() == 0) {
          ++nbar;
          const unsigned target = nbar * gridDim.x;
          __hip_atomic_fetch_add(bar, 1u, __ATOMIC_RELAXED, __HIP_MEMORY_SCOPE_AGENT);
          while (__hip_atomic_load(bar, __ATOMIC_RELAXED, __HIP_MEMORY_SCOPE_AGENT) < target) __builtin_amdgcn_s_sleep(2);
        }
        __syncthreads();
        __threadfence();
      }
    }
  }
}

extern "C" void kernel_launch(void* const* d_in, const int* in_sizes, int n_in, void* d_out, int out_size,
                              void* d_ws, size_t ws_size, hipStream_t stream) {
  static int grid_blocks = 0;
  if (!grid_blocks) {
    int dev = 0, cus = 0, per_cu = 0;
    hipGetDevice(&dev);
    hipDeviceGetAttribute(&cus, hipDeviceAttributeMultiprocessorCount, dev);
    hipFuncSetAttribute((const void*)fwd_megakernel, hipFuncAttributeMaxDynamicSharedMemorySize, LDS_BYTES);
    hipOccupancyMaxActiveBlocksPerMultiprocessor(&per_cu, (const void*)fwd_megakernel, NTHREADS, LDS_BYTES);
    if (per_cu < 1) per_cu = 1;
    if (per_cu > 1) per_cu = 1;
    grid_blocks = cus * per_cu;
    if (ws_size < WS_END) fprintf(stderr, "workspace too small: %zu < %llu\n", ws_size, (unsigned long long)WS_END);
  }
  Params p{};
  p.x = (const float*)d_in[0]; p.c = (const float*)d_in[1]; p.pos = (const int*)d_in[2];
  p.ada_w = (const float*)d_in[3]; p.ada_b = (const float*)d_in[4];
  p.pre_norm = (const float*)d_in[5]; p.post_norm = (const float*)d_in[6];
  p.w_in = (const float*)d_in[7]; p.gla_w_lr = (const float*)d_in[8]; p.gla_b_lr = (const float*)d_in[9];
  p.w_br_ret = (const float*)d_in[10]; p.w_br_dsa = (const float*)d_in[11]; p.w_br_gla = (const float*)d_in[12];
  p.w_out = (const float*)d_in[13];
  p.out = (float*)d_out; p.ws = (unsigned char*)d_ws;
  p.ph_lo = 0; p.ph_hi = 2 + 7 * DEPTH;
  void* args[] = {&p};
  hipError_t e = hipLaunchCooperativeKernel((const void*)fwd_megakernel, dim3(grid_blocks), dim3(NTHREADS), args, LDS_BYTES, stream);
  if (e != hipSuccess) fprintf(stderr, "cooperative launch failed: %s (grid %d)\n", hipGetErrorString(e), grid_blocks);
}
```

```cpp
#include <hip/hip_runtime.h>
#include <hip/hip_cooperative_groups.h>
#include <stdint.h>
#include <cstdio>
namespace cg = cooperative_groups;
#ifndef REP_SEL
#define REP_SEL 1
#endif
#ifndef REP_ATT
#define REP_ATT 1
#endif

typedef _Float16 half_t;
typedef _Float16 h8 __attribute__((ext_vector_type(8)));
typedef _Float16 h4 __attribute__((ext_vector_type(4)));
typedef _Float16 h2 __attribute__((ext_vector_type(2)));
typedef float f16v __attribute__((ext_vector_type(16)));
typedef float f4v __attribute__((ext_vector_type(4)));

#define S_LEN 16384
#define DM 1024
#define NIN 7764
#define NPAD 7936
#define PP 7808
#define DEPTH 4
#define NTHREADS 256
#define LDS_BYTES 149504

#define C_RETQ 0
#define C_RETK 256
#define C_RETV 512
#define C_RETG 1024
#define C_DSAQ 1536
#define C_DSAK 2048
#define C_DSAV 2176
#define C_DSAG 2304
#define C_IDXQ 2816
#define C_IDXK 3072
#define C_GLAQ 3136
#define C_GLAK 3392
#define C_GLAV 3648
#define C_GLAG 4160
#define C_GLAA 4672
#define C_MRG 4688
#define C_END 7760
#define C_IDXW 7760

#define OFF_WINT 0ull
#define OFF_WBRT (OFF_WINT + 4ull * NPAD * 1024 * 2)
#define OFF_WOUTT (OFF_WBRT + 4ull * 3 * 1024 * 512 * 2)
#define OFF_MOD (OFF_WOUTT + 4ull * 1024 * 1024 * 2)
#define OFF_RT (OFF_MOD + 4ull * 3072 * 4)
#define OFF_DT (OFF_RT + 16384ull * 64 * 4)
#define OFF_H (OFF_DT + 16384ull * 16 * 4)
#define OFF_P (OFF_H + 16384ull * 1024 * 2)
#define OFF_GA (OFF_P + 16384ull * PP * 2)
#define OFF_IW (OFF_GA + 16384ull * 16 * 4)
#define OFF_ST (OFF_IW + 16384ull * 4 * 4)
#define OFF_DEC (OFF_ST + 256ull * 65536 * 4)
#define OFF_BR (OFF_DEC + 256ull * 8 * 64 * 4)
#define WS_END (OFF_BR + 16384ull * 1536 * 2)
static_assert(WS_END + 256 <= 508821504ull, "workspace too large");

struct Params {
  const float* x; const float* c; const int* pos; const float* ada_w; const float* ada_b;
  const float* pre_norm; const float* post_norm; const float* w_in; const float* gla_w_lr;
  const float* gla_b_lr; const float* w_br_ret; const float* w_br_dsa; const float* w_br_gla;
  const float* w_out; float* out; unsigned char* ws;
  int ph_lo; int ph_hi;
};

__device__ __forceinline__ int otid() { int t = (int)__builtin_amdgcn_workitem_id_x(); asm volatile("" : "+v"(t)); return t; }
template <int CTRL>
__device__ __forceinline__ float dppf(float v) {
  return __int_as_float(__builtin_amdgcn_update_dpp(0, __float_as_int(v), CTRL, 0xF, 0xF, true));
}
template <int CTRL>
__device__ __forceinline__ unsigned dppu(unsigned v) {
  return (unsigned)__builtin_amdgcn_update_dpp(0, (int)v, CTRL, 0xF, 0xF, true);
}
__device__ __forceinline__ float wave_sum(float v) {
  v += dppf<0xB1>(v); v += dppf<0x4E>(v); v += dppf<0x141>(v); v += dppf<0x140>(v);
  v += __shfl_xor(v, 16); v += __shfl_xor(v, 32);
  return v;
}
__device__ __forceinline__ float wave_max(float v) {
  v = fmaxf(v, dppf<0xB1>(v)); v = fmaxf(v, dppf<0x4E>(v)); v = fmaxf(v, dppf<0x141>(v)); v = fmaxf(v, dppf<0x140>(v));
  v = fmaxf(v, __shfl_xor(v, 16)); v = fmaxf(v, __shfl_xor(v, 32));
  return v;
}
__device__ __forceinline__ unsigned wave_or(unsigned v) {
  v |= dppu<0xB1>(v); v |= dppu<0x4E>(v); v |= dppu<0x141>(v); v |= dppu<0x140>(v);
  v |= __shfl_xor(v, 16); v |= __shfl_xor(v, 32);
  return v;
}
__device__ __forceinline__ unsigned wave_incl_scan(unsigned v) {
  v += (unsigned)__builtin_amdgcn_update_dpp(0, (int)v, 0x111, 0xF, 0xF, false);
  v += (unsigned)__builtin_amdgcn_update_dpp(0, (int)v, 0x112, 0xF, 0xF, false);
  v += (unsigned)__builtin_amdgcn_update_dpp(0, (int)v, 0x114, 0xF, 0xF, false);
  v += (unsigned)__builtin_amdgcn_update_dpp(0, (int)v, 0x118, 0xF, 0xF, false);
  v += (unsigned)__builtin_amdgcn_update_dpp(0, (int)v, 0x142, 0xA, 0xF, false);
  v += (unsigned)__builtin_amdgcn_update_dpp(0, (int)v, 0x143, 0xC, 0xF, false);
  return v;
}
__device__ __forceinline__ f16v mfma16(h8 a, h8 b, f16v c) {
  return __builtin_amdgcn_mfma_f32_32x32x16_f16(a, b, c, 0, 0, 0);
}
__device__ __forceinline__ int crow(int r, int l) { return (r & 3) + 8 * (r >> 2) + 4 * (l >> 5); }

__device__ __forceinline__ int win_col(int nv) {
  if (nv < 3136) return nv;
  if (nv < 7760) return nv + 4;
  if (nv < 7764) return nv - 7760 + 3136;
  return -1;
}
__device__ void transpose_tile(const float* __restrict__ src, int ldn, half_t* __restrict__ dst, int K,
                               int k0, int n0, int mapmode, unsigned char* lds) {
  float* T = (float*)lds;
  const int tid = otid();
  const int nn = tid & 63;
  int col = n0 + nn;
  if (mapmode) col = win_col(col);
#pragma unroll
  for (int i = 0; i < 16; ++i) {
    int kk = (tid >> 6) + 4 * i;
    float v = 0.f;
    if (col >= 0) v = src[(size_t)(k0 + kk) * ldn + col];
    T[kk * 65 + nn] = v;
  }
  __syncthreads();
#pragma unroll
  for (int i = 0; i < 2; ++i) {
    int n2 = (tid >> 3) + 32 * i;
    int kc = tid & 7;
    h8 o;
#pragma unroll
    for (int q = 0; q < 8; ++q) o[q] = (half_t)T[(kc * 8 + q) * 65 + n2];
    *(h8*)(dst + (size_t)(n0 + n2) * K + k0 + kc * 8) = o;
  }
  __syncthreads();
}

__device__ void phase_prologue(const Params& p, unsigned char* lds) {
  const int tid = otid();
  half_t* WinT = (half_t*)(p.ws + OFF_WINT);
  half_t* WbrT = (half_t*)(p.ws + OFF_WBRT);
  half_t* WoutT = (half_t*)(p.ws + OFF_WOUTT);
  float* MOD = (float*)(p.ws + OFF_MOD);
  float* RT = (float*)(p.ws + OFF_RT);
  float* DT = (float*)(p.ws + OFF_DT);
  const int T_WIN = 4 * 124 * 16;
  const int T_WBR = 12 * 16 * 8;
  const int T_WOUT = 4 * 16 * 16;
  const int T_MOD = 192;
  const int T_ROPE = 16384 * 40 / 256;
  const int total = T_WIN + T_WBR + T_WOUT + T_MOD + T_ROPE;
  for (int task = blockIdx.x; task < total; task += gridDim.x) {
    int t = task;
    if (t < T_WIN) {
      int l = t / (124 * 16); int r = t % (124 * 16); int nt = r / 16, kt = r % 16;
      transpose_tile(p.w_in + (size_t)l * 1024 * NIN, NIN, WinT + (size_t)l * NPAD * 1024, 1024, kt * 64, nt * 64, 1, lds);
      continue;
    }
    t -= T_WIN;
    if (t < T_WBR) {
      int lb = t / 128; int r = t % 128; int nt = r / 8, kt = r % 8;
      int l = lb / 3, b = lb % 3;
      const float* src = (b == 0 ? p.w_br_ret : (b == 1 ? p.w_br_dsa : p.w_br_gla)) + (size_t)l * 512 * 1024;
      transpose_tile(src, 1024, WbrT + (size_t)lb * 1024 * 512, 512, kt * 64, nt * 64, 0, lds);
      continue;
    }
    t -= T_WBR;
    if (t < T_WOUT) {
      int l = t / 256; int r = t % 256; int nt = r / 16, kt = r % 16;
      transpose_tile(p.w_out + (size_t)l * 1024 * 1024, 1024, WoutT + (size_t)l * 1024 * 1024, 1024, kt * 64, nt * 64, 0, lds);
      continue;
    }
    t -= T_WOUT;
    if (t < T_MOD) {
      int l = t / 48, jb = t % 48;
      int j = jb * 64 + (tid & 63);
      int ig = tid >> 6;
      float acc = 0.f;
      const float* aw = p.ada_w + (size_t)l * 1024 * 3072;
      for (int i = ig * 256; i < ig * 256 + 256; ++i) {
        float cv = p.c[i];
        float sc = cv / (1.f + expf(-cv));
        acc += sc * aw[(size_t)i * 3072 + j];
      }
      float* red = (float*)lds;
      red[tid] = acc;
      __syncthreads();
      if (tid < 64) {
        float s = red[tid] + red[tid + 64] + red[tid + 128] + red[tid + 192];
        MOD[l * 3072 + j] = s + p.ada_b[l * 3072 + j];
      }
      __syncthreads();
      continue;
    }
    t -= T_MOD;
    {
      int e = t * 256 + tid;
      int tok = e / 40, f = e % 40;
      float pf = (float)p.pos[tok];
      if (f < 32) {
        float fr = powf(10000.0f, -(float)f * 2.0f / 64.0f);
        float ang = pf * fr;
        RT[tok * 64 + f * 2] = cosf(ang);
        RT[tok * 64 + f * 2 + 1] = sinf(ang);
      } else {
        int g = f - 32;
        float fr = powf(500000.0f, -(float)g * 2.0f / 16.0f);
        float ang = pf * fr;
        DT[tok * 16 + g * 2] = cosf(ang);
        DT[tok * 16 + g * 2 + 1] = sinf(ang);
      }
    }
  }
}

__device__ __forceinline__ void write_h_row(const float (&xv)[16], const float* __restrict__ pre,
                                            const float* __restrict__ mod, half_t* __restrict__ hrow, int l) {
  float ss = 0.f;
#pragma unroll
  for (int i = 0; i < 16; ++i) ss += xv[i] * xv[i];
  ss = wave_sum(ss);
  float rs = rsqrtf(ss * (1.0f / 1024.0f) + 1e-6f);
#pragma unroll
  for (int i = 0; i < 4; ++i) {
    int c0 = i * 256 + l * 4;
    f4v pg = *(const f4v*)(pre + c0);
    f4v sh = *(const f4v*)(mod + c0);
    f4v sc = *(const f4v*)(mod + 1024 + c0);
    h4 o;
#pragma unroll
    for (int q = 0; q < 4; ++q) o[q] = (half_t)(xv[i * 4 + q] * rs * pg[q] * (1.f + sc[q]) + sh[q]);
    *(h4*)(hrow + c0) = o;
  }
}

__device__ void phase_h0(const Params& p) {
  const int w = otid() >> 6, l = otid() & 63;
  half_t* H = (half_t*)(p.ws + OFF_H);
  const float* MOD = (const float*)(p.ws + OFF_MOD);
  for (int row = blockIdx.x * 4 + w; row < S_LEN; row += gridDim.x * 4) {
    float xv[16];
#pragma unroll
    for (int i = 0; i < 4; ++i) {
      f4v v = *(const f4v*)(p.x + (size_t)row * 1024 + i * 256 + l * 4);
      xv[i * 4] = v[0]; xv[i * 4 + 1] = v[1]; xv[i * 4 + 2] = v[2]; xv[i * 4 + 3] = v[3];
    }
    write_h_row(xv, p.pre_norm, MOD, H + (size_t)row * 1024, l);
  }
}

__device__ __forceinline__ void lds_barrier() {
  asm volatile("s_waitcnt lgkmcnt(0)" ::: "memory");
  __builtin_amdgcn_s_barrier();
  asm volatile("" ::: "memory");
}
template <int NT>
__device__ __forceinline__ void gemm_gload(h8 (&ra)[8], h8 (&rb)[2 * NT], const half_t* __restrict__ A, int lda,
                                           const half_t* __restrict__ B, int ldb, int k0, int r0, int kc) {
#pragma unroll
  for (int i = 0; i < 8; ++i) ra[i] = *(const h8*)(A + (size_t)(r0 + 32 * i) * lda + k0 + kc * 8);
#pragma unroll
  for (int i = 0; i < 2 * NT; ++i) rb[i] = *(const h8*)(B + (size_t)(r0 + 32 * i) * ldb + k0 + kc * 8);
}
template <int NT>
__device__ __forceinline__ void gemm_lwrite(const h8 (&ra)[8], const h8 (&rb)[2 * NT], unsigned char* As, unsigned char* Bs, int r0, int kc) {
#pragma unroll
  for (int i = 0; i < 8; ++i) *(h8*)(As + (r0 + 32 * i) * 144 + kc * 16) = ra[i];
#pragma unroll
  for (int i = 0; i < 2 * NT; ++i) *(h8*)(Bs + (r0 + 32 * i) * 144 + kc * 16) = rb[i];
}
template <int NT>
__device__ __forceinline__ void gemm_compute(f16v (&acc)[4][NT], const unsigned char* As, const unsigned char* Bs, int wm, int wn, int l) {
#pragma unroll
  for (int ks = 0; ks < 4; ++ks) {
    h8 a[4], b[NT];
#pragma unroll
    for (int i = 0; i < 4; ++i) a[i] = *(const h8*)(As + (wm * 128 + i * 32 + (l & 31)) * 144 + ks * 32 + (l >> 5) * 16);
#pragma unroll
    for (int j = 0; j < NT; ++j) b[j] = *(const h8*)(Bs + (wn * 32 * NT + j * 32 + (l & 31)) * 144 + ks * 32 + (l >> 5) * 16);
#pragma unroll
    for (int i = 0; i < 4; ++i)
#pragma unroll
      for (int j = 0; j < NT; ++j) acc[i][j] = mfma16(a[i], b[j], acc[i][j]);
  }
}
template <int NT>
__device__ __forceinline__ void gemm_kloop(f16v (&acc)[4][NT], const half_t* __restrict__ A, int lda,
                                           const half_t* __restrict__ B, int ldb, int K, unsigned char* lds) {
  const int tid = otid(), w = tid >> 6, l = tid & 63;
  unsigned char* As = lds;
  unsigned char* Bs = lds + 256 * 144;
  const int wm = w >> 1, wn = w & 1;
  const int kc = tid & 7;
  const int r0 = tid >> 3;
  h8 ra0[8], rb0[2 * NT], ra1[8], rb1[2 * NT];
  gemm_gload<NT>(ra0, rb0, A, lda, B, ldb, 0, r0, kc);
  gemm_gload<NT>(ra1, rb1, A, lda, B, ldb, 64, r0, kc);
  const int nk = K / 64;
#pragma unroll 1
  for (int kt = 0; kt < nk; kt += 2) {
    lds_barrier();
    gemm_lwrite<NT>(ra0, rb0, As, Bs, r0, kc);
    lds_barrier();
    gemm_gload<NT>(ra0, rb0, A, lda, B, ldb, (kt + 2 < nk) ? (kt + 2) * 64 : 0, r0, kc);
    gemm_compute<NT>(acc, As, Bs, wm, wn, l);
    lds_barrier();
    gemm_lwrite<NT>(ra1, rb1, As, Bs, r0, kc);
    lds_barrier();
    gemm_gload<NT>(ra1, rb1, A, lda, B, ldb, (kt + 3 < nk) ? (kt + 3) * 64 : 0, r0, kc);
    gemm_compute<NT>(acc, As, Bs, wm, wn, l);
  }
  __syncthreads();
}

template <int NT>
__device__ __forceinline__ void zero_acc(f16v (&acc)[4][NT]) {
#pragma unroll
  for (int i = 0; i < 4; ++i)
#pragma unroll
    for (int j = 0; j < NT; ++j)
#pragma unroll
      for (int r = 0; r < 16; ++r) acc[i][j][r] = 0.f;
}

__device__ __forceinline__ void stage_pair(float* E, const f16v& a0, const f16v& a1, int l) {
#pragma unroll
  for (int r = 0; r < 16; ++r) {
    const int rr = crow(r, l);
    E[rr * 65 + (l & 31)] = a0[r];
    E[rr * 65 + 32 + (l & 31)] = a1[r];
  }
}

__device__ void phase_A(const Params& p, int layer, unsigned char* lds) {
  const int tid = otid(), w = tid >> 6, l = tid & 63;
  const half_t* H = (const half_t*)(p.ws + OFF_H);
  const half_t* Wt = (const half_t*)(p.ws + OFF_WINT) + (size_t)layer * NPAD * 1024;
  half_t* P = (half_t*)(p.ws + OFF_P);
  float* GA = (float*)(p.ws + OFF_GA);
  float* IW = (float*)(p.ws + OFF_IW);
  const float* RT = (const float*)(p.ws + OFF_RT);
  const float* DT = (const float*)(p.ws + OFF_DT);
  const int wm = w >> 1, wn = w & 1;
  const int G = gridDim.x;
  const int ntiles = 64 * 62;
  const int nrounds = (G == 256) ? 16 : (ntiles + G - 1) / G;
  for (int rnd = 0; rnd < nrounds; ++rnd) {
    int mt, nt;
    if (G == 256) {
      const int xcd = blockIdx.x & 7, loc = blockIdx.x >> 3;
      const int s = loc + 32 * rnd;
      mt = xcd * 8 + (s & 7); nt = s >> 3;
      if (nt >= 62) continue;
    } else {
      const int tix = rnd * G + blockIdx.x;
      if (tix >= ntiles) continue;
      mt = tix & 63; nt = tix >> 6;
    }
    f16v acc[4][2];
    zero_acc<2>(acc);
    gemm_kloop<2>(acc, H + (size_t)mt * 256 * 1024, 1024, Wt + (size_t)nt * 128 * 1024, 1024, 1024, lds);
    const int m0w = mt * 256 + wm * 128;
    const int n0w = nt * 128 + wn * 64;
    float* E = (float*)(lds + 73728) + w * (32 * 65);
    const int prow = l >> 3, c0 = (l & 7) * 8;
    {
      const int jp = 0;
      const int nb2 = n0w + jp * 64;
      const int n0 = nb2 + c0;
      const bool rope64 = nb2 < 512;
      const bool rope16 = ((nb2 >= C_DSAQ && nb2 < C_DSAV) || (nb2 >= C_IDXQ && nb2 < C_GLAQ)) && (c0 < 16);
      float scale = 1.f;
      if (n0 < 256 || (n0 >= C_DSAQ && n0 < C_DSAK) || (n0 >= C_IDXQ && n0 < C_IDXK) || (n0 >= C_GLAQ && n0 < C_GLAK)) scale = 0.125f;
      int mode = 0;
      if ((n0 >= C_RETG && n0 < C_DSAQ) || (n0 >= C_DSAG && n0 < C_IDXQ) || (n0 >= C_GLAG && n0 < C_GLAA)) mode = 1;
      if (n0 >= C_MRG && n0 < C_END) mode = 2;
#pragma unroll
      for (int i = 0; i < 4; ++i) {
        stage_pair(E, acc[i][2 * jp], acc[i][2 * jp + 1], l);
#pragma unroll 1
        for (int ps = 0; ps < 4; ++ps) {
          const int rl = ps * 8 + prow;
          const int row = m0w + i * 32 + rl;
          float v[8], o[8];
#pragma unroll
          for (int q = 0; q < 8; ++q) { v[q] = E[rl * 65 + c0 + q]; o[q] = v[q]; }
          if (rope64) {
            const int cp = c0 ^ 32;
            const float* tb = RT + (size_t)row * 64 + (c0 & 31) * 2;
#pragma unroll
            for (int q = 0; q < 8; ++q) {
              const float pv = E[rl * 65 + cp + q];
              const float cs = tb[2 * q], sn = tb[2 * q + 1];
              o[q] = (c0 < 32) ? (v[q] * cs - pv * sn) : (v[q] * cs + pv * sn);
            }
          } else if (rope16) {
            const int cp = c0 ^ 8;
            const float* tb = DT + (size_t)row * 16;
#pragma unroll
            for (int q = 0; q < 8; ++q) {
              const float pv = E[rl * 65 + cp + q];
              const float cs = tb[2 * q], sn = tb[2 * q + 1];
              o[q] = (c0 < 8) ? (v[q] * cs - pv * sn) : (v[q] * cs + pv * sn);
            }
          }
          h8 ov;
#pragma unroll
          for (int q = 0; q < 8; ++q) {
            float t = o[q] * scale;
            if (mode == 1) t = t / (1.f + __expf(-t));
            else if (mode == 2) t = 1.f / (1.f + __expf(-t));
            ov[q] = (half_t)t;
          }
          if (n0 < C_END) *(h8*)(P + (size_t)row * PP + n0) = ov;
          if (n0 >= C_GLAA && n0 < C_MRG) {
#pragma unroll
            for (int q = 0; q < 8; ++q) GA[(size_t)row * 16 + (n0 - C_GLAA) + q] = v[q];
          }
          if (n0 == C_IDXW) {
#pragma unroll
            for (int q = 0; q < 4; ++q) IW[(size_t)row * 4 + q] = 0.5f * v[q];
          }
        }
      }
    }
  }
}

#define LA_BC 0
#define LA_GAS 16640
#define LA_WL 20736
#define LA_QT 24832
#define LA_KT 34048
#define LA_AT 43264
#define LA_VT 52480
#define LA_SS 70912
#define LA_OS 89344
#define LA_SEG 123136

__device__ void la_bcum(const Params& p, int layer, int n, int Hh, unsigned char* lds) {
  const int tid = otid();
  float* Bc = (float*)(lds + LA_BC);
  const int d = tid & 63, q = tid >> 6;
  if (Hh < 4) {
    float lg = log1pf(-exp2f(-5.0f - (float)Hh));
#pragma unroll
    for (int jj = 0; jj < 16; ++jj) { int j = q * 16 + jj; Bc[j * 65 + d] = (float)(j + 1) * lg; }
    __syncthreads();
    return;
  }
  const int h = Hh - 4;
  float* GAs = (float*)(lds + LA_GAS);
  float* WL = (float*)(lds + LA_WL);
  float* SEG = (float*)(lds + LA_SEG);
  const float* GA = (const float*)(p.ws + OFF_GA);
#pragma unroll
  for (int i = 0; i < 4; ++i) {
    int e = tid + 256 * i;
    GAs[e] = GA[(size_t)n * 64 * 16 + e];
    int r = e >> 6, dd = e & 63;
    WL[e] = p.gla_w_lr[(size_t)layer * 16 * 256 + r * 256 + h * 64 + dd];
  }
  __syncthreads();
  float wl[16];
#pragma unroll
  for (int r = 0; r < 16; ++r) wl[r] = WL[r * 64 + d];
  const float bl = p.gla_b_lr[layer * 256 + h * 64 + d];
  float run = 0.f;
#pragma unroll
  for (int jj = 0; jj < 16; ++jj) {
    int j = q * 16 + jj;
    float z = bl;
#pragma unroll
    for (int r = 0; r < 16; ++r) z += GAs[j * 16 + r] * wl[r];
    float ls = fminf(z, 0.f) - log1pf(expf(-fabsf(z)));
    run += ls * (1.0f / 16.0f);
    Bc[j * 65 + d] = run;
  }
  SEG[q * 64 + d] = run;
  __syncthreads();
  float off = 0.f;
  for (int qq = 0; qq < q; ++qq) off += SEG[qq * 64 + d];
  if (q > 0) {
#pragma unroll
    for (int jj = 0; jj < 16; ++jj) { int j = q * 16 + jj; Bc[j * 65 + d] += off; }
  }
  __syncthreads();
}

__device__ __forceinline__ void la_stage_vt(const half_t* __restrict__ P, int t0, int vcol, unsigned char* lds) {
  const int tid = otid(), w = tid >> 6, l = tid & 63;
  half_t* VT = (half_t*)(lds + LA_VT);
  const int jp = l & 31, cgp = l >> 5;
#pragma unroll
  for (int it = 0; it < 2; ++it) {
    int c = it * 8 + w * 2 + cgp;
    h8 v0 = *(const h8*)(P + (size_t)(t0 + 2 * jp) * PP + vcol + c * 8);
    h8 v1 = *(const h8*)(P + (size_t)(t0 + 2 * jp + 1) * PP + vcol + c * 8);
#pragma unroll
    for (int q = 0; q < 8; ++q) {
      h2 pr; pr[0] = v0[q]; pr[1] = v1[q];
      *(h2*)(VT + (c * 8 + q) * 72 + 2 * jp) = pr;
    }
  }
}

__device__ void la_item_kv(const Params& p, int layer, int item, unsigned char* lds) {
  const int tid = otid(), w = tid >> 6, l = tid & 63;
  const int n = item >> 3, Hh = item & 7;
  const int t0 = n * 64;
  const half_t* P = (const half_t*)(p.ws + OFF_P);
  float* ST = (float*)(p.ws + OFF_ST);
  float* DEC = (float*)(p.ws + OFF_DEC);
  const int kcol = (Hh < 4) ? (C_RETK + Hh * 64) : (C_GLAK + (Hh - 4) * 64);
  const int vcol = (Hh < 4) ? (C_RETV + Hh * 128) : (C_GLAV + (Hh - 4) * 128);
  __syncthreads();
  la_bcum(p, layer, n, Hh, lds);
  const float* Bc = (const float*)(lds + LA_BC);
  half_t* KhT = (half_t*)(lds + LA_KT);
  half_t* VT = (half_t*)(lds + LA_VT);
  {
    const int jp = l & 31, cgp = l >> 5;
    int c = w * 2 + cgp;
    h8 k0 = *(const h8*)(P + (size_t)(t0 + 2 * jp) * PP + kcol + c * 8);
    h8 k1 = *(const h8*)(P + (size_t)(t0 + 2 * jp + 1) * PP + kcol + c * 8);
#pragma unroll
    for (int q = 0; q < 8; ++q) {
      int d = c * 8 + q;
      float bl = Bc[63 * 65 + d];
      h2 pr;
      pr[0] = (half_t)((float)k0[q] * __expf(bl - Bc[(2 * jp) * 65 + d]));
      pr[1] = (half_t)((float)k1[q] * __expf(bl - Bc[(2 * jp + 1) * 65 + d]));
      *(h2*)(KhT + d * 72 + 2 * jp) = pr;
    }
  }
  la_stage_vt(P, t0, vcol, lds);
  if (tid < 64) DEC[(size_t)item * 64 + tid] = __expf(Bc[63 * 65 + tid]);
  __syncthreads();
  f16v acc[2];
#pragma unroll
  for (int j = 0; j < 2; ++j)
#pragma unroll
    for (int r = 0; r < 16; ++r) acc[j][r] = 0.f;
#pragma unroll
  for (int ks = 0; ks < 4; ++ks) {
    h8 a = *(const h8*)(VT + (32 * w + (l & 31)) * 72 + ks * 16 + (l >> 5) * 8);
#pragma unroll
    for (int j = 0; j < 2; ++j) {
      h8 b = *(const h8*)(KhT + (j * 32 + (l & 31)) * 72 + ks * 16 + (l >> 5) * 8);
      acc[j] = mfma16(a, b, acc[j]);
    }
  }
#pragma unroll
  for (int j = 0; j < 2; ++j)
#pragma unroll
    for (int r = 0; r < 16; ++r) {
      int e = 32 * w + crow(r, l);
      int d = j * 32 + (l & 31);
      ST[(size_t)item * 8192 + e * 64 + d] = acc[j][r];
    }
}

__device__ void phase_scan(const Params& p) {
  float* ST = (float*)(p.ws + OFF_ST);
  const float* DEC = (const float*)(p.ws + OFF_DEC);
  for (int f = blockIdx.x * NTHREADS + otid(); f < 65536; f += gridDim.x * NTHREADS) {
    const int Hh = f >> 13, d = f & 63;
    float s = 0.f;
    for (int n0 = 0; n0 < 256; n0 += 8) {
      float kv[8], dc[8];
#pragma unroll
      for (int u = 0; u < 8; ++u) {
        kv[u] = ST[(size_t)(n0 + u) * 65536 + f];
        dc[u] = DEC[(size_t)((n0 + u) * 8 + Hh) * 64 + d];
      }
#pragma unroll
      for (int u = 0; u < 8; ++u) {
        ST[(size_t)(n0 + u) * 65536 + f] = s;
        s = dc[u] * s + kv[u];
      }
    }
  }
}

__device__ void la_item_out(const Params& p, int layer, int item, unsigned char* lds) {
  const int tid = otid(), w = tid >> 6, l = tid & 63;
  const int n = item >> 3, Hh = item & 7;
  const int t0 = n * 64;
  const half_t* P = (const half_t*)(p.ws + OFF_P);
  const float* ST = (const float*)(p.ws + OFF_ST);
  half_t* BR = (half_t*)(p.ws + OFF_BR);
  const int qcol = (Hh < 4) ? (C_RETQ + Hh * 64) : (C_GLAQ + (Hh - 4) * 64);
  const int kcol = (Hh < 4) ? (C_RETK + Hh * 64) : (C_GLAK + (Hh - 4) * 64);
  const int vcol = (Hh < 4) ? (C_RETV + Hh * 128) : (C_GLAV + (Hh - 4) * 128);
  const int gcol = (Hh < 4) ? (C_RETG + Hh * 128) : (C_GLAG + (Hh - 4) * 128);
  const int ocol = (Hh < 4) ? (Hh * 128) : (1024 + (Hh - 4) * 128);
  __syncthreads();
  la_bcum(p, layer, n, Hh, lds);
  const float* Bc = (const float*)(lds + LA_BC);
  half_t* Qt = (half_t*)(lds + LA_QT);
  half_t* Kt = (half_t*)(lds + LA_KT);
  half_t* AT = (half_t*)(lds + LA_AT);
  half_t* VT = (half_t*)(lds + LA_VT);
  half_t* SS = (half_t*)(lds + LA_SS);
  float* OS = (float*)(lds + LA_OS);
#pragma unroll
  for (int it = 0; it < 2; ++it) {
    int c = tid + 256 * it;
    int row = c >> 3, kc = c & 7;
    h8 qv = *(const h8*)(P + (size_t)(t0 + row) * PP + qcol + kc * 8);
    h8 kv = *(const h8*)(P + (size_t)(t0 + row) * PP + kcol + kc * 8);
    h8 qo, ko;
#pragma unroll
    for (int q = 0; q < 8; ++q) {
      float b = Bc[row * 65 + kc * 8 + q];
      qo[q] = (half_t)((float)qv[q] * __expf(b));
      ko[q] = (half_t)((float)kv[q] * __expf(-b));
    }
    *(h8*)(Qt + row * 72 + kc * 8) = qo;
    *(h8*)(Kt + row * 72 + kc * 8) = ko;
  }
  la_stage_vt(P, t0, vcol, lds);
#pragma unroll
  for (int it = 0; it < 4; ++it) {
    int c = tid + 256 * it;
    int e = c >> 3, kc = c & 7;
    const float* sp = ST + (size_t)item * 8192 + e * 64 + kc * 8;
    f4v s0 = *(const f4v*)sp, s1 = *(const f4v*)(sp + 4);
    h8 o;
    o[0] = (half_t)s0[0]; o[1] = (half_t)s0[1]; o[2] = (half_t)s0[2]; o[3] = (half_t)s0[3];
    o[4] = (half_t)s1[0]; o[5] = (half_t)s1[1]; o[6] = (half_t)s1[2]; o[7] = (half_t)s1[3];
    *(h8*)(SS + e * 72 + kc * 8) = o;
  }
  __syncthreads();
  {
    const int mi = w >> 1, nj = w & 1;
    f16v acc;
#pragma unroll
    for (int r = 0; r < 16; ++r) acc[r] = 0.f;
#pragma unroll
    for (int ks = 0; ks < 4; ++ks) {
      h8 a = *(const h8*)(Qt + (mi * 32 + (l & 31)) * 72 + ks * 16 + (l >> 5) * 8);
      h8 b = *(const h8*)(Kt + (nj * 32 + (l & 31)) * 72 + ks * 16 + (l >> 5) * 8);
      acc = mfma16(a, b, acc);
    }
#pragma unroll
    for (int r = 0; r < 16; ++r) {
      int i = mi * 32 + crow(r, l);
      int j = nj * 32 + (l & 31);
      float v = (j <= i) ? acc[r] : 0.f;
      AT[i * 72 + j] = (half_t)v;
    }
  }
  __syncthreads();
  {
    const int mi = w >> 1, nh = w & 1;
    f16v acc[2];
#pragma unroll
    for (int j = 0; j < 2; ++j)
#pragma unroll
      for (int r = 0; r < 16; ++r) acc[j][r] = 0.f;
#pragma unroll
    for (int ks = 0; ks < 4; ++ks) {
      h8 a1 = *(const h8*)(AT + (mi * 32 + (l & 31)) * 72 + ks * 16 + (l >> 5) * 8);
      h8 a2 = *(const h8*)(Qt + (mi * 32 + (l & 31)) * 72 + ks * 16 + (l >> 5) * 8);
#pragma unroll
      for (int j = 0; j < 2; ++j) {
        h8 b1 = *(const h8*)(VT + (nh * 64 + j * 32 + (l & 31)) * 72 + ks * 16 + (l >> 5) * 8);
        h8 b2 = *(const h8*)(SS + (nh * 64 + j * 32 + (l & 31)) * 72 + ks * 16 + (l >> 5) * 8);
        acc[j] = mfma16(a1, b1, acc[j]);
        acc[j] = mfma16(a2, b2, acc[j]);
      }
    }
#pragma unroll
    for (int j = 0; j < 2; ++j)
#pragma unroll
      for (int r = 0; r < 16; ++r) {
        int i = mi * 32 + crow(r, l);
        int e = nh * 64 + j * 32 + (l & 31);
        OS[i * 132 + e] = acc[j][r];
      }
  }
  __syncthreads();
  {
    const int i = tid >> 2, qd = tid & 3;
    float ov[32];
    float ss = 0.f;
#pragma unroll
    for (int c = 0; c < 8; ++c) {
      f4v v = *(const f4v*)(OS + i * 132 + qd * 32 + c * 4);
      ov[c * 4] = v[0]; ov[c * 4 + 1] = v[1]; ov[c * 4 + 2] = v[2]; ov[c * 4 + 3] = v[3];
      ss += v[0] * v[0] + v[1] * v[1] + v[2] * v[2] + v[3] * v[3];
    }
    ss += __shfl_xor(ss, 1);
    ss += __shfl_xor(ss, 2);
    float rs = rsqrtf(ss * (1.0f / 128.0f) + 1e-6f);
#pragma unroll
    for (int c = 0; c < 4; ++c) {
      h8 g = *(const h8*)(P + (size_t)(t0 + i) * PP + gcol + qd * 32 + c * 8);
      h8 o;
#pragma unroll
      for (int q = 0; q < 8; ++q) o[q] = (half_t)(ov[c * 8 + q] * rs * (float)g[q]);
      *(h8*)(BR + (size_t)(t0 + i) * 1536 + ocol + qd * 32 + c * 8) = o;
    }
  }
}

#define DS_CAP 640
#define DS_PRUNE_AT 512
#define NPL 10
#define DS_LS 0
#define DS_LI (32 * DS_CAP * 4)
#define DS_CNT (32 * DS_CAP * 6)
#define DS_THR (DS_CNT + 128)
#define DS_WQ (DS_CNT + 256)
#define DS_HIST (DS_CNT + 1024)
#define DS_PW (DS_CNT + 1024 + 4096)

__device__ __forceinline__ unsigned long long wave_or64(unsigned long long v) {
  const unsigned lo = wave_or((unsigned)v), hi = wave_or((unsigned)(v >> 32));
  return ((unsigned long long)hi << 32) | lo;
}
__device__ __forceinline__ void dsa_prune(float* LSm, unsigned short* LIm, int n, unsigned* hist, int* cntm, float* thrm, int l) {
  unsigned long long comp[NPL];
  bool act[NPL], val[NPL];
#pragma unroll
  for (int k = 0; k < NPL; ++k) {
    int e = l + 64 * k;
    val[k] = e < n;
    unsigned u = 0, li = 0;
    if (val[k]) { u = __float_as_uint(LSm[e]); li = LIm[e]; }
    const unsigned key = (u >> 31) ? ~u : (u | 0x80000000u);
    comp[k] = ((unsigned long long)key << 14) | (unsigned long long)(16383u - li);
    act[k] = val[k];
  }
  const unsigned long long c0 = ((unsigned long long)(unsigned)__builtin_amdgcn_readfirstlane((int)(unsigned)(comp[0] >> 32)) << 32) | (unsigned)__builtin_amdgcn_readfirstlane((int)(unsigned)comp[0]);
  unsigned long long x = 0;
#pragma unroll
  for (int k = 0; k < NPL; ++k) x |= val[k] ? (comp[k] ^ c0) : 0ull;
  x = wave_or64(x);
  int shift = (x == 0ull) ? 0 : (63 - __clzll((long long)x)) - 7;
  if (shift < 0) shift = 0;
  unsigned rank = 256;
#pragma unroll 1
  for (int rd = 0; rd < 8; ++rd) {
    *(uint4*)(hist + 4 * l) = make_uint4(0, 0, 0, 0);
    __threadfence_block();
    unsigned dk[NPL];
#pragma unroll
    for (int k = 0; k < NPL; ++k) {
      dk[k] = (unsigned)(comp[k] >> shift) & 255u;
      if (act[k]) atomicAdd(&hist[dk[k]], 1u);
    }
    __threadfence_block();
    uint4 hv; hv.x = hist[4 * l]; hv.y = hist[4 * l + 1]; hv.z = hist[4 * l + 2]; hv.w = hist[4 * l + 3];
    unsigned tl = hv.x + hv.y + hv.z + hv.w;
    const unsigned pin = wave_incl_scan(tl);
    const unsigned tot = (unsigned)__builtin_amdgcn_readlane((int)pin, 63);
    unsigned sx = tot - pin;
    bool mine = (sx < rank) && (rank <= sx + tl);
    unsigned dsel = 0, nr = 0, hsel = 0;
    if (mine) {
      unsigned c = sx;
      if (c + hv.w >= rank) { dsel = 4 * l + 3; nr = rank - c; hsel = hv.w; }
      else {
        c += hv.w;
        if (c + hv.z >= rank) { dsel = 4 * l + 2; nr = rank - c; hsel = hv.z; }
        else {
          c += hv.z;
          if (c + hv.y >= rank) { dsel = 4 * l + 1; nr = rank - c; hsel = hv.y; }
          else { c += hv.y; dsel = 4 * l; nr = rank - c; hsel = hv.x; }
        }
      }
    }
    unsigned long long mk = __ballot(mine);
    int src = (mk == 0ull) ? 0 : (__ffsll((long long)mk) - 1);
    dsel = (unsigned)__builtin_amdgcn_readlane((int)dsel, src);
    rank = (unsigned)__builtin_amdgcn_readlane((int)nr, src);
    hsel = (unsigned)__builtin_amdgcn_readlane((int)hsel, src);
#pragma unroll
    for (int k = 0; k < NPL; ++k) act[k] = act[k] && (dk[k] == dsel);
    if (hsel <= 1u || shift == 0) break;
    shift = (shift >= 8) ? (shift - 8) : 0;
  }
  unsigned long long tsel = 0;
#pragma unroll
  for (int k = 0; k < NPL; ++k) tsel |= act[k] ? comp[k] : 0ull;
  const unsigned long long T = wave_or64(tsel);
  bool keep[NPL];
  unsigned cntk = 0;
#pragma unroll
  for (int k = 0; k < NPL; ++k) {
    keep[k] = val[k] && (comp[k] >= T);
    cntk += keep[k] ? 1u : 0u;
  }
  unsigned pos = wave_incl_scan(cntk) - cntk;
  __threadfence_block();
#pragma unroll
  for (int k = 0; k < NPL; ++k) {
    if (keep[k]) {
      const unsigned kk = (unsigned)(comp[k] >> 14);
      const unsigned u = (kk & 0x80000000u) ? (kk & 0x7FFFFFFFu) : ~kk;
      LSm[pos] = __uint_as_float(u);
      LIm[pos] = (unsigned short)(16383u - ((unsigned)comp[k] & 16383u));
      ++pos;
    }
  }
  if (l == 0) {
    const unsigned T32 = (unsigned)(T >> 14);
    *cntm = 256;
    *thrm = __uint_as_float((T32 & 0x80000000u) ? (T32 & 0x7FFFFFFFu) : ~T32);
  }
  __threadfence_block();
}

__device__ void dsa_item(const Params& p, int qb, unsigned char* lds) {
  const int tid = otid(), w = tid >> 6, l = tid & 63;
  const int t0 = qb * 32;
  const half_t* P = (const half_t*)(p.ws + OFF_P);
  const float* IW = (const float*)(p.ws + OFF_IW);
  half_t* BR = (half_t*)(p.ws + OFF_BR);
  float* LS = (float*)(lds + DS_LS);
  unsigned short* LI = (unsigned short*)(lds + DS_LI);
  int* cnt = (int*)(lds + DS_CNT);
  float* thr = (float*)(lds + DS_THR);
  float* wq = (float*)(lds + DS_WQ);
  unsigned* hist = (unsigned*)(lds + DS_HIST) + w * 256;
  float* PW = (float*)(lds + DS_PW) + w * 1024;
  half_t* QS = (half_t*)(lds + DS_PW + 16384) + w * 512;
  for (int rep_sel = 0; rep_sel < REP_SEL; ++rep_sel) {
  __syncthreads();
  if (tid < 32) { cnt[tid] = 0; thr[tid] = -INFINITY; }
  if (tid < 128) wq[tid] = IW[(size_t)t0 * 4 + tid];
  __syncthreads();
  h8 aq[4][4];
#pragma unroll
  for (int h = 0; h < 4; ++h)
#pragma unroll
    for (int ks = 0; ks < 4; ++ks)
      aq[h][ks] = *(const h8*)(P + (size_t)(t0 + (l & 31)) * PP + C_IDXQ + h * 64 + ks * 16 + (l >> 5) * 8);
  const int nt = qb + 1;
  const int nr = (nt + 3) >> 2;
  h8 bk[4];
  {
    const int k0 = (w < nt) ? w : 0;
#pragma unroll
    for (int ks = 0; ks < 4; ++ks)
      bk[ks] = *(const h8*)(P + (size_t)(k0 * 32 + (l & 31)) * PP + C_IDXK + ks * 16 + (l >> 5) * 8);
  }
#pragma unroll 1
  for (int rd = 0; rd < nr; ++rd) {
    const int kt = 4 * rd + w;
    h8 bkn[4];
    {
      const int kn = (kt + 4 < nt) ? (kt + 4) : 0;
#pragma unroll
      for (int ks = 0; ks < 4; ++ks)
        bkn[ks] = *(const h8*)(P + (size_t)(kn * 32 + (l & 31)) * PP + C_IDXK + ks * 16 + (l >> 5) * 8);
    }
    if (kt < nt) {
      const int sbase = kt * 32;
      f16v acc[4];
#pragma unroll
      for (int h = 0; h < 4; ++h) {
#pragma unroll
        for (int r = 0; r < 16; ++r) acc[h][r] = 0.f;
#pragma unroll
        for (int ks = 0; ks < 4; ++ks) acc[h] = mfma16(aq[h][ks], bk[ks], acc[h]);
      }
      const int s = sbase + (l & 31);
      float scv[16];
      unsigned pm = 0;
#pragma unroll
      for (int r = 0; r < 16; ++r) {
        const int m = crow(r, l);
        const f4v wv = *(const f4v*)(wq + m * 4);
        float sc = wv[0] * fmaxf(acc[0][r], 0.f) + wv[1] * fmaxf(acc[1][r], 0.f) + wv[2] * fmaxf(acc[2][r], 0.f) + wv[3] * fmaxf(acc[3][r], 0.f);
        sc += 0.0f;
        scv[r] = sc;
        const float th = thr[m];
        const bool pass = (s <= t0 + m) && (sc > th);
        pm |= pass ? (1u << r) : 0u;
      }
      if (__ballot(pm != 0u) != 0ull) {
        unsigned long long mks[16];
        int mycnt = 0;
#pragma unroll
        for (int r = 0; r < 16; ++r) {
          const unsigned long long mk = __ballot(((pm >> r) & 1u) != 0u);
          mks[r] = mk;
          const unsigned hm = (l < 32) ? (unsigned)mk : (unsigned)(mk >> 32);
          if ((l & 31) == r) mycnt = __popc(hm);
        }
        int base = 0;
        if ((l & 31) < 16 && mycnt > 0) base = atomicAdd(&cnt[crow(l & 31, l)], mycnt);
#pragma unroll
        for (int r = 0; r < 16; ++r) {
          const unsigned long long mk = mks[r];
          if (mk != 0ull) {
            const unsigned hm = (l < 32) ? (unsigned)mk : (unsigned)(mk >> 32);
            const int b_lo = __builtin_amdgcn_readlane(base, r), b_hi = __builtin_amdgcn_readlane(base, 32 + r);
            const int bb = (l < 32) ? b_lo : b_hi;
            if ((pm >> r) & 1u) {
              const int m = crow(r, l);
              const int slot = bb + __popc(hm & ((1u << (l & 31)) - 1u));
              LS[m * DS_CAP + slot] = scv[r];
              LI[m * DS_CAP + slot] = (unsigned short)s;
            }
          }
        }
      }
    }
    __syncthreads();
    {
      const int cv = (l < 32) ? cnt[l] : 0;
      unsigned pmask = (unsigned)__ballot(cv > DS_PRUNE_AT);
      int j = 0;
      while (pmask != 0u) {
        const int m = __ffs((int)pmask) - 1;
        pmask &= pmask - 1u;
        if ((j & 3) == w) dsa_prune(LS + m * DS_CAP, LI + m * DS_CAP, cnt[m], hist, cnt + m, thr + m, l);
        ++j;
      }
    }
    __syncthreads();
#pragma unroll
    for (int ks = 0; ks < 4; ++ks) bk[ks] = bkn[ks];
  }
  }
  for (int rep_att = 0; rep_att < REP_ATT; ++rep_att)
#pragma unroll 1
  for (int mm = 0; mm < 8; ++mm) {
    const int m = w * 8 + mm;
    const int t = t0 + m;
    int c = cnt[m];
    if (c > 256) { dsa_prune(LS + m * DS_CAP, LI + m * DS_CAP, c, hist, cnt + m, thr + m, l); c = 256; }
    const unsigned short* LIm = LI + m * DS_CAP;
    *(h8*)(QS + l * 8) = *(const h8*)(P + (size_t)t * PP + C_DSAQ + l * 8);
    __threadfence_block();
#pragma unroll 1
    for (int g = 0; g < 2; ++g) {
      h8 kvr[4][8];
      bool vld[4];
#pragma unroll
      for (int kk = 0; kk < 4; ++kk) {
        const int e = l + 64 * kk;
        vld[kk] = e < c;
        const int s = vld[kk] ? (int)LIm[e] : 0;
        const half_t* kr = P + (size_t)s * PP + C_DSAK + g * 64;
#pragma unroll
        for (int ch = 0; ch < 8; ++ch) kvr[kk][ch] = *(const h8*)(kr + ch * 8);
      }
      float lg[4][4];
#pragma unroll
      for (int hh = 0; hh < 4; ++hh) {
#pragma unroll
        for (int kk = 0; kk < 4; ++kk) lg[hh][kk] = 0.f;
#pragma unroll
        for (int ch = 0; ch < 8; ++ch) {
          const h8 qq = *(const h8*)(QS + (g * 4 + hh) * 64 + ch * 8);
#pragma unroll
          for (int kk = 0; kk < 4; ++kk) {
            float a = lg[hh][kk];
            a = __builtin_amdgcn_fdot2(__builtin_shufflevector(qq, qq, 0, 1), __builtin_shufflevector(kvr[kk][ch], kvr[kk][ch], 0, 1), a, false);
            a = __builtin_amdgcn_fdot2(__builtin_shufflevector(qq, qq, 2, 3), __builtin_shufflevector(kvr[kk][ch], kvr[kk][ch], 2, 3), a, false);
            a = __builtin_amdgcn_fdot2(__builtin_shufflevector(qq, qq, 4, 5), __builtin_shufflevector(kvr[kk][ch], kvr[kk][ch], 4, 5), a, false);
            a = __builtin_amdgcn_fdot2(__builtin_shufflevector(qq, qq, 6, 7), __builtin_shufflevector(kvr[kk][ch], kvr[kk][ch], 6, 7), a, false);
            lg[hh][kk] = a;
          }
        }
#pragma unroll
        for (int kk = 0; kk < 4; ++kk) lg[hh][kk] = vld[kk] ? lg[hh][kk] : -INFINITY;
      }
#pragma unroll
      for (int hh = 0; hh < 4; ++hh) {
        float mx = fmaxf(fmaxf(lg[hh][0], lg[hh][1]), fmaxf(lg[hh][2], lg[hh][3]));
        mx = wave_max(mx);
        float ev[4]; float sm = 0.f;
#pragma unroll
        for (int kk = 0; kk < 4; ++kk) { ev[kk] = __expf(lg[hh][kk] - mx); sm += ev[kk]; }
        sm = wave_sum(sm);
        const float inv = 1.0f / sm;
#pragma unroll
        for (int kk = 0; kk < 4; ++kk) PW[(l + 64 * kk) * 4 + hh] = ev[kk] * inv;
      }
      __threadfence_block();
      const int dch = l & 7, ksub = l >> 3;
      float o[4][8];
#pragma unroll
      for (int hh = 0; hh < 4; ++hh)
#pragma unroll
        for (int q = 0; q < 8; ++q) o[hh][q] = 0.f;
      const int nit = (c + 7) >> 3;
#pragma unroll 1
      for (int it0 = 0; it0 < nit; it0 += 16) {
        h8 vv[16];
#pragma unroll
        for (int i = 0; i < 16; ++i) {
          const int e = (it0 + i) * 8 + ksub;
          const int s = (e < c) ? (int)LIm[e] : 0;
          vv[i] = *(const h8*)(P + (size_t)s * PP + C_DSAV + g * 64 + dch * 8);
        }
#pragma unroll
        for (int i = 0; i < 16; ++i) {
          const int e = (it0 + i) * 8 + ksub;
          const f4v pv = *(const f4v*)(PW + e * 4);
#pragma unroll
          for (int hh = 0; hh < 4; ++hh)
#pragma unroll
            for (int q = 0; q < 8; ++q) o[hh][q] += pv[hh] * (float)vv[i][q];
        }
      }
#pragma unroll
      for (int hh = 0; hh < 4; ++hh)
#pragma unroll
        for (int q = 0; q < 8; ++q) {
          float v = o[hh][q];
          v += dppf<0x128>(v); v += __shfl_xor(v, 16); v += __shfl_xor(v, 32);
          o[hh][q] = v;
        }
      if (l < 8) {
#pragma unroll
        for (int hh = 0; hh < 4; ++hh) {
          const int col = (g * 4 + hh) * 64 + dch * 8;
          const h8 gt = *(const h8*)(P + (size_t)t * PP + C_DSAG + col);
          h8 ov;
#pragma unroll
          for (int q = 0; q < 8; ++q) ov[q] = (half_t)(o[hh][q] * (float)gt[q]);
          *(h8*)(BR + (size_t)t * 1536 + 512 + col) = ov;
        }
      }
      __threadfence_block();
    }
  }
}

__device__ void phase_B(const Params& p, int layer, unsigned char* lds) {
  const int G = gridDim.x;
  for (int j = 0; j * G < 512; ++j) {
    const int b = (j & 1) ? (G - 1 - (int)blockIdx.x) : (int)blockIdx.x;
    const int idx = j * G + b;
#ifndef NO_DSA
    if (idx < 512) dsa_item(p, 511 - idx, lds);
#endif
  }
#ifndef NO_LAKV
  for (int it = blockIdx.x; it < 2048; it += G) la_item_kv(p, layer, it, lds);
#endif
}

__device__ void phase_E1(const Params& p, int layer, unsigned char* lds) {
  const int tid = otid(), w = tid >> 6, l = tid & 63;
  const half_t* BR = (const half_t*)(p.ws + OFF_BR);
  const half_t* WbrT = (const half_t*)(p.ws + OFF_WBRT) + (size_t)layer * 3 * 1024 * 512;
  const half_t* P = (const half_t*)(p.ws + OFF_P);
  half_t* Y1 = (half_t*)(p.ws + OFF_H);
  const int wm = w >> 1, wn = w & 1;
  float* E = (float*)(lds + 73728) + w * (32 * 65);
  const int prow = l >> 3, c0 = (l & 7) * 8;
  for (int tix = blockIdx.x; tix < 512; tix += gridDim.x) {
    const int mt = tix & 63, nt = tix >> 6;
    float tot[4][4][8];
#pragma unroll
    for (int i = 0; i < 4; ++i)
#pragma unroll
      for (int ps = 0; ps < 4; ++ps)
#pragma unroll
        for (int q = 0; q < 8; ++q) tot[i][ps][q] = 0.f;
    const int m0w = mt * 256 + wm * 128;
    const int n0 = nt * 128 + wn * 64 + c0;
#pragma unroll 1
    for (int b = 0; b < 3; ++b) {
      f16v acc[4][2];
      zero_acc<2>(acc);
      gemm_kloop<2>(acc, BR + (size_t)mt * 256 * 1536 + b * 512, 1536, WbrT + (size_t)b * 1024 * 512 + (size_t)nt * 128 * 512, 512, 512, lds);
#pragma unroll
      for (int i = 0; i < 4; ++i) {
        stage_pair(E, acc[i][0], acc[i][1], l);
#pragma unroll
        for (int ps = 0; ps < 4; ++ps) {
          const int rl = ps * 8 + prow;
          const int row = m0w + i * 32 + rl;
          const h8 g = *(const h8*)(P + (size_t)row * PP + C_MRG + b * 1024 + n0);
#pragma unroll
          for (int q = 0; q < 8; ++q) tot[i][ps][q] += (float)g[q] * E[rl * 65 + c0 + q];
        }
      }
    }
#pragma unroll
    for (int i = 0; i < 4; ++i)
#pragma unroll
      for (int ps = 0; ps < 4; ++ps) {
        const int row = m0w + i * 32 + ps * 8 + prow;
        h8 o;
#pragma unroll
        for (int q = 0; q < 8; ++q) o[q] = (half_t)tot[i][ps][q];
        *(h8*)(Y1 + (size_t)row * 1024 + n0) = o;
      }
  }
}

__device__ void phase_E2(const Params& p, int layer, unsigned char* lds) {
  const int tid = otid(), w = tid >> 6, l = tid & 63;
  const half_t* Y1 = (const half_t*)(p.ws + OFF_H);
  const half_t* Wo = (const half_t*)(p.ws + OFF_WOUTT) + (size_t)layer * 1024 * 1024;
  float* Y = (float*)(p.ws + OFF_ST);
  const int wm = w >> 1, wn = w & 1;
  for (int tix = blockIdx.x; tix < 512; tix += gridDim.x) {
    const int mt = tix & 63, nt = tix >> 6;
    f16v acc[4][2];
    zero_acc<2>(acc);
    gemm_kloop<2>(acc, Y1 + (size_t)mt * 256 * 1024, 1024, Wo + (size_t)nt * 128 * 1024, 1024, 1024, lds);
    const int m0w = mt * 256 + wm * 128;
    const int n0w = nt * 128 + wn * 64;
#pragma unroll
    for (int i = 0; i < 4; ++i)
#pragma unroll
      for (int j = 0; j < 2; ++j)
#pragma unroll
        for (int r = 0; r < 16; ++r) {
          const int row = m0w + i * 32 + crow(r, l);
          const int n = n0w + j * 32 + (l & 31);
          Y[(size_t)row * 1024 + n] = acc[i][j][r];
        }
  }
}

__device__ void phase_E3(const Params& p, int layer) {
  const int w = otid() >> 6, l = otid() & 63;
  const float* Y = (const float*)(p.ws + OFF_ST);
  const float* MOD = (const float*)(p.ws + OFF_MOD);
  half_t* H = (half_t*)(p.ws + OFF_H);
  const float* xin = (layer == 0) ? p.x : p.out;
  const float* gate = MOD + layer * 3072 + 2048;
  const float* post = p.post_norm + layer * 1024;
  for (int row = blockIdx.x * 4 + w; row < S_LEN; row += gridDim.x * 4) {
    float yv[16], xv[16];
    float ss = 0.f;
#pragma unroll
    for (int i = 0; i < 4; ++i) {
      f4v v = *(const f4v*)(Y + (size_t)row * 1024 + i * 256 + l * 4);
      f4v xx = *(const f4v*)(xin + (size_t)row * 1024 + i * 256 + l * 4);
#pragma unroll
      for (int q = 0; q < 4; ++q) { yv[i * 4 + q] = v[q]; xv[i * 4 + q] = xx[q]; ss += v[q] * v[q]; }
    }
    ss = wave_sum(ss);
    const float rs = rsqrtf(ss * (1.0f / 1024.0f) + 1e-6f);
#pragma unroll
    for (int i = 0; i < 4; ++i) {
      const int c0 = i * 256 + l * 4;
      f4v gt = *(const f4v*)(gate + c0);
      f4v pn = *(const f4v*)(post + c0);
      f4v o;
#pragma unroll
      for (int q = 0; q < 4; ++q) { o[q] = xv[i * 4 + q] + gt[q] * (yv[i * 4 + q] * rs * pn[q]); xv[i * 4 + q] = o[q]; }
      *(f4v*)(p.out + (size_t)row * 1024 + c0) = o;
    }
    if (layer + 1 < DEPTH)
      write_h_row(xv, p.pre_norm + (layer + 1) * 1024, MOD + (layer + 1) * 3072, H + (size_t)row * 1024, l);
  }
}

#ifndef REP_D
#define REP_D 1
#endif
#ifndef REP_E
#define REP_E 1
#endif
#ifndef REP_A
#define REP_A 1
#endif
#ifndef REP_B
#define REP_B 1
#endif
#ifdef ONLY_PHASE
#define PH_EN(x) (ONLY_PHASE == (x))
#else
#define PH_EN(x) true
#endif
__global__ void __launch_bounds__(NTHREADS) fwd_megakernel(Params p) {
  extern __shared__ __attribute__((aligned(16))) unsigned char lds[];
  cg::grid_group grid = cg::this_grid();
  unsigned* bar = (unsigned*)(p.ws + WS_END);
  unsigned nbar = 0;
  if (blockIdx.x == 0 && otid() == 0) __hip_atomic_store(bar, 0u, __ATOMIC_RELAXED, __HIP_MEMORY_SCOPE_AGENT);
  for (int ph = p.ph_lo; ph < p.ph_hi; ++ph) {
    if (ph == 0) { if (PH_EN(0)) phase_prologue(p, lds); }
    else if (ph == 1) { if (PH_EN(1)) phase_h0(p); }
    else {
      const int layer = (ph - 2) / 7, sub = (ph - 2) % 7;
      if (sub == 0) { if (PH_EN(2)) for (int rep = 0; rep < REP_A; ++rep) { phase_A(p, layer, lds); __syncthreads(); } }
      else if (sub == 1) { if (PH_EN(3)) for (int rep = 0; rep < REP_B; ++rep) { phase_B(p, layer, lds); __syncthreads(); } }
      else if (sub == 2) { if (PH_EN(4)) phase_scan(p); }
      else if (sub == 3) { if (PH_EN(5)) for (int rep = 0; rep < REP_D; ++rep) { for (int it = blockIdx.x; it < 2048; it += gridDim.x) la_item_out(p, layer, it, lds); __syncthreads(); } }
      else if (sub == 4) { if (PH_EN(6)) for (int rep = 0; rep < REP_E; ++rep) { phase_E1(p, layer, lds); __syncthreads(); } }
      else if (sub == 5) { if (PH_EN(7)) for (int rep = 0; rep < REP_E; ++rep) { phase_E2(p, layer, lds); __syncthreads(); } }
      else { if (PH_EN(8)) phase_E3(p, layer); }
    }
    if (ph + 1 < p.ph_hi) {
      if (ph == p.ph_lo) grid.sync();
      else {
        __threadfence();
        __syncthreads();
        if (otid() == 0) {
          ++nbar;
          const unsigned target = nbar * gridDim.x;
          __hip_atomic_fetch_add(bar, 1u, __ATOMIC_RELAXED, __HIP_MEMORY_SCOPE_AGENT);
          while (__hip_atomic_load(bar, __ATOMIC_RELAXED, __HIP_MEMORY_SCOPE_AGENT) < target) __builtin_amdgcn_s_sleep(2);
        }
        __syncthreads();
        __threadfence();
      }
    }
  }
}

extern "C" void kernel_launch(void* const* d_in, const int* in_sizes, int n_in, void* d_out, int out_size,
                              void* d_ws, size_t ws_size, hipStream_t stream) {
  static int grid_blocks = 0;
  if (!grid_blocks) {
    int dev = 0, cus = 0, per_cu = 0;
    hipGetDevice(&dev);
    hipDeviceGetAttribute(&cus, hipDeviceAttributeMultiprocessorCount, dev);
    hipFuncSetAttribute((const void*)fwd_megakernel, hipFuncAttributeMaxDynamicSharedMemorySize, LDS_BYTES);
    hipOccupancyMaxActiveBlocksPerMultiprocessor(&per_cu, (const void*)fwd_megakernel, NTHREADS, LDS_BYTES);
    if (per_cu < 1) per_cu = 1;
    if (per_cu > 1) per_cu = 1;
    grid_blocks = cus * per_cu;
    if (ws_size < WS_END) fprintf(stderr, "workspace too small: %zu < %llu\n", ws_size, (unsigned long long)WS_END);
  }
  Params p{};
  p.x = (const float*)d_in[0]; p.c = (const float*)d_in[1]; p.pos = (const int*)d_in[2];
  p.ada_w = (const float*)d_in[3]; p.ada_b = (const float*)d_in[4];
  p.pre_norm = (const float*)d_in[5]; p.post_norm = (const float*)d_in[6];
  p.w_in = (const float*)d_in[7]; p.gla_w_lr = (const float*)d_in[8]; p.gla_b_lr = (const float*)d_in[9];
  p.w_br_ret = (const float*)d_in[10]; p.w_br_dsa = (const float*)d_in[11]; p.w_br_gla = (const float*)d_in[12];
  p.w_out = (const float*)d_in[13];
  p.out = (float*)d_out; p.ws = (unsigned char*)d_ws;
  p.ph_lo = 0; p.ph_hi = 2 + 7 * DEPTH;
  void* args[] = {&p};
  hipError_t e = hipLaunchCooperativeKernel((const void*)fwd_megakernel, dim3(grid_blocks), dim3(NTHREADS), args, LDS_BYTES, stream);
  if (e != hipSuccess) fprintf(stderr, "cooperative launch failed: %s (grid %d)\n", hipGetErrorString(e), grid_blocks);
}
```

```cpp
#include <hip/hip_runtime.h>
#include <hip/hip_cooperative_groups.h>
#include <stdint.h>
#include <cstdio>
namespace cg = cooperative_groups;
#ifndef REP_P
#define REP_P 1
#endif
#ifndef REP_KV
#define REP_KV 1
#endif
#ifndef REP_SEL
#define REP_SEL 1
#endif
#ifndef REP_ATT
#define REP_ATT 1
#endif

typedef _Float16 half_t;
typedef _Float16 h8 __attribute__((ext_vector_type(8)));
typedef _Float16 h4 __attribute__((ext_vector_type(4)));
typedef _Float16 h2 __attribute__((ext_vector_type(2)));
typedef float f16v __attribute__((ext_vector_type(16)));
typedef float f4v __attribute__((ext_vector_type(4)));

#define S_LEN 16384
#define DM 1024
#define NIN 7764
#define NPAD 7936
#define PP 7808
#define DEPTH 4
#define NTHREADS 256
#define HP 1088
#define WP 1088
#define WBP 576
#define LDS_BYTES 149504

#define C_RETQ 0
#define C_RETK 256
#define C_RETV 512
#define C_RETG 1024
#define C_DSAQ 1536
#define C_DSAK 2048
#define C_DSAV 2176
#define C_DSAG 2304
#define C_IDXQ 2816
#define C_IDXK 3072
#define C_GLAQ 3136
#define C_GLAK 3392
#define C_GLAV 3648
#define C_GLAG 4160
#define C_GLAA 4672
#define C_MRG 4688
#define C_END 7760
#define C_IDXW 7760

#define OFF_WINT 0ull
#define OFF_WBRT (OFF_WINT + 4ull * NPAD * WP * 2)
#define OFF_WOUTT (OFF_WBRT + 4ull * 3 * 1024 * WBP * 2)
#define OFF_MOD (OFF_WOUTT + 4ull * 1024 * WP * 2)
#define OFF_RT (OFF_MOD + 4ull * 3072 * 4)
#define OFF_DT (OFF_RT + 16384ull * 64 * 4)
#define OFF_H (OFF_DT + 16384ull * 16 * 4)
#define OFF_P (OFF_H + 16384ull * HP * 2)
#define OFF_GA (OFF_P + 16384ull * PP * 2)
#define OFF_IW (OFF_GA + 16384ull * 16 * 4)
#define OFF_ST (OFF_IW + 16384ull * 4 * 4)
#define OFF_DEC (OFF_ST + 256ull * 65536 * 4)
#define OFF_BR (OFF_DEC + 256ull * 8 * 64 * 4)
#define WS_END (OFF_BR + 16384ull * 1536 * 2)
static_assert(WS_END + 512 <= 508821504ull, "workspace too large");

struct Params {
  const float* x; const float* c; const int* pos; const float* ada_w; const float* ada_b;
  const float* pre_norm; const float* post_norm; const float* w_in; const float* gla_w_lr;
  const float* gla_b_lr; const float* w_br_ret; const float* w_br_dsa; const float* w_br_gla;
  const float* w_out; float* out; unsigned char* ws;
  int ph_lo; int ph_hi;
};

__device__ __forceinline__ int otid() { int t = (int)__builtin_amdgcn_workitem_id_x(); asm volatile("" : "+v"(t)); return t; }
template <int CTRL>
__device__ __forceinline__ float dppf(float v) {
  return __int_as_float(__builtin_amdgcn_update_dpp(0, __float_as_int(v), CTRL, 0xF, 0xF, true));
}
template <int CTRL>
__device__ __forceinline__ unsigned dppu(unsigned v) {
  return (unsigned)__builtin_amdgcn_update_dpp(0, (int)v, CTRL, 0xF, 0xF, true);
}
__device__ __forceinline__ float wave_sum(float v) {
  v += dppf<0xB1>(v); v += dppf<0x4E>(v); v += dppf<0x141>(v); v += dppf<0x140>(v);
  v += __shfl_xor(v, 16); v += __shfl_xor(v, 32);
  return v;
}
__device__ __forceinline__ float wave_max(float v) {
  v = fmaxf(v, dppf<0xB1>(v)); v = fmaxf(v, dppf<0x4E>(v)); v = fmaxf(v, dppf<0x141>(v)); v = fmaxf(v, dppf<0x140>(v));
  v = fmaxf(v, __shfl_xor(v, 16)); v = fmaxf(v, __shfl_xor(v, 32));
  return v;
}
__device__ __forceinline__ unsigned wave_or(unsigned v) {
  v |= dppu<0xB1>(v); v |= dppu<0x4E>(v); v |= dppu<0x141>(v); v |= dppu<0x140>(v);
  v |= __shfl_xor(v, 16); v |= __shfl_xor(v, 32);
  return v;
}
__device__ __forceinline__ unsigned wave_incl_scan(unsigned v) {
  v += (unsigned)__builtin_amdgcn_update_dpp(0, (int)v, 0x111, 0xF, 0xF, false);
  v += (unsigned)__builtin_amdgcn_update_dpp(0, (int)v, 0x112, 0xF, 0xF, false);
  v += (unsigned)__builtin_amdgcn_update_dpp(0, (int)v, 0x114, 0xF, 0xF, false);
  v += (unsigned)__builtin_amdgcn_update_dpp(0, (int)v, 0x118, 0xF, 0xF, false);
  v += (unsigned)__builtin_amdgcn_update_dpp(0, (int)v, 0x142, 0xA, 0xF, false);
  v += (unsigned)__builtin_amdgcn_update_dpp(0, (int)v, 0x143, 0xC, 0xF, false);
  return v;
}
__device__ __forceinline__ f16v mfma16(h8 a, h8 b, f16v c) {
  return __builtin_amdgcn_mfma_f32_32x32x16_f16(a, b, c, 0, 0, 0);
}
__device__ __forceinline__ float relu_f(float x) { return __int_as_float(max(__float_as_int(x), 0)); }
__device__ __forceinline__ int crow(int r, int l) { return (r & 3) + 8 * (r >> 2) + 4 * (l >> 5); }

__device__ __forceinline__ int win_col(int nv) {
  if (nv < 3136) return nv;
  if (nv < 7760) return nv + 4;
  if (nv < 7764) return nv - 7760 + 3136;
  return -1;
}
__device__ void transpose_tile(const float* __restrict__ src, int ldn, half_t* __restrict__ dst, int K,
                               int k0, int n0, int mapmode, unsigned char* lds) {
  float* T = (float*)lds;
  const int tid = otid();
  const int nn = tid & 63;
  int col = n0 + nn;
  if (mapmode) col = win_col(col);
#pragma unroll
  for (int i = 0; i < 16; ++i) {
    int kk = (tid >> 6) + 4 * i;
    float v = 0.f;
    if (col >= 0) v = src[(size_t)(k0 + kk) * ldn + col];
    T[kk * 65 + nn] = v;
  }
  __syncthreads();
#pragma unroll
  for (int i = 0; i < 2; ++i) {
    int n2 = (tid >> 3) + 32 * i;
    int kc = tid & 7;
    h8 o;
#pragma unroll
    for (int q = 0; q < 8; ++q) o[q] = (half_t)T[(kc * 8 + q) * 65 + n2];
    *(h8*)(dst + (size_t)(n0 + n2) * K + k0 + kc * 8) = o;
  }
  __syncthreads();
}

__device__ void phase_prologue(const Params& p, unsigned char* lds) {
  const int tid = otid();
  half_t* WinT = (half_t*)(p.ws + OFF_WINT);
  half_t* WbrT = (half_t*)(p.ws + OFF_WBRT);
  half_t* WoutT = (half_t*)(p.ws + OFF_WOUTT);
  float* MOD = (float*)(p.ws + OFF_MOD);
  float* RT = (float*)(p.ws + OFF_RT);
  float* DT = (float*)(p.ws + OFF_DT);
  const int T_WIN = 4 * 124 * 16;
  const int T_WBR = 12 * 16 * 8;
  const int T_WOUT = 4 * 16 * 16;
  const int T_MOD = 192;
  const int T_ROPE = 16384 * 40 / 256;
  const int total = T_WIN + T_WBR + T_WOUT + T_MOD + T_ROPE;
  for (int task = blockIdx.x; task < total; task += gridDim.x) {
    int t = task;
    if (t < T_WIN) {
      int l = t / (124 * 16); int r = t % (124 * 16); int nt = r / 16, kt = r % 16;
      transpose_tile(p.w_in + (size_t)l * 1024 * NIN, NIN, WinT + (size_t)l * NPAD * WP, WP, kt * 64, nt * 64, 1, lds);
      continue;
    }
    t -= T_WIN;
    if (t < T_WBR) {
      int lb = t / 128; int r = t % 128; int nt = r / 8, kt = r % 8;
      int l = lb / 3, b = lb % 3;
      const float* src = (b == 0 ? p.w_br_ret : (b == 1 ? p.w_br_dsa : p.w_br_gla)) + (size_t)l * 512 * 1024;
      transpose_tile(src, 1024, WbrT + (size_t)lb * 1024 * WBP, WBP, kt * 64, nt * 64, 0, lds);
      continue;
    }
    t -= T_WBR;
    if (t < T_WOUT) {
      int l = t / 256; int r = t % 256; int nt = r / 16, kt = r % 16;
      transpose_tile(p.w_out + (size_t)l * 1024 * 1024, 1024, WoutT + (size_t)l * 1024 * WP, WP, kt * 64, nt * 64, 0, lds);
      continue;
    }
    t -= T_WOUT;
    if (t < T_MOD) {
      int l = t / 48, jb = t % 48;
      int j = jb * 64 + (tid & 63);
      int ig = tid >> 6;
      float acc = 0.f;
      const float* aw = p.ada_w + (size_t)l * 1024 * 3072;
      for (int i = ig * 256; i < ig * 256 + 256; ++i) {
        float cv = p.c[i];
        float sc = cv / (1.f + expf(-cv));
        acc += sc * aw[(size_t)i * 3072 + j];
      }
      float* red = (float*)lds;
      red[tid] = acc;
      __syncthreads();
      if (tid < 64) {
        float s = red[tid] + red[tid + 64] + red[tid + 128] + red[tid + 192];
        MOD[l * 3072 + j] = s + p.ada_b[l * 3072 + j];
      }
      __syncthreads();
      continue;
    }
    t -= T_MOD;
    {
      int e = t * 256 + tid;
      int tok = e / 40, f = e % 40;
      float pf = (float)p.pos[tok];
      if (f < 32) {
        float fr = powf(10000.0f, -(float)f * 2.0f / 64.0f);
        float ang = pf * fr;
        RT[tok * 64 + f * 2] = cosf(ang);
        RT[tok * 64 + f * 2 + 1] = sinf(ang);
      } else {
        int g = f - 32;
        float fr = powf(500000.0f, -(float)g * 2.0f / 16.0f);
        float ang = pf * fr;
        DT[tok * 16 + g * 2] = cosf(ang);
        DT[tok * 16 + g * 2 + 1] = sinf(ang);
      }
    }
  }
}

__device__ __forceinline__ void write_h_row(const float (&xv)[16], const float* __restrict__ pre,
                                            const float* __restrict__ mod, half_t* __restrict__ hrow, int l) {
  float ss = 0.f;
#pragma unroll
  for (int i = 0; i < 16; ++i) ss += xv[i] * xv[i];
  ss = wave_sum(ss);
  float rs = rsqrtf(ss * (1.0f / 1024.0f) + 1e-6f);
#pragma unroll
  for (int i = 0; i < 4; ++i) {
    int c0 = i * 256 + l * 4;
    f4v pg = *(const f4v*)(pre + c0);
    f4v sh = *(const f4v*)(mod + c0);
    f4v sc = *(const f4v*)(mod + 1024 + c0);
    h4 o;
#pragma unroll
    for (int q = 0; q < 4; ++q) o[q] = (half_t)(xv[i * 4 + q] * rs * pg[q] * (1.f + sc[q]) + sh[q]);
    *(h4*)(hrow + c0) = o;
  }
}

__device__ void phase_h0(const Params& p) {
  const int w = otid() >> 6, l = otid() & 63;
  half_t* H = (half_t*)(p.ws + OFF_H);
  const float* MOD = (const float*)(p.ws + OFF_MOD);
  for (int row = blockIdx.x * 4 + w; row < S_LEN; row += gridDim.x * 4) {
    float xv[16];
#pragma unroll
    for (int i = 0; i < 4; ++i) {
      f4v v = *(const f4v*)(p.x + (size_t)row * 1024 + i * 256 + l * 4);
      xv[i * 4] = v[0]; xv[i * 4 + 1] = v[1]; xv[i * 4 + 2] = v[2]; xv[i * 4 + 3] = v[3];
    }
    write_h_row(xv, p.pre_norm, MOD, H + (size_t)row * HP, l);
  }
}

__device__ __forceinline__ void lds_barrier() {
  asm volatile("s_waitcnt lgkmcnt(0)" ::: "memory");
  __builtin_amdgcn_s_barrier();
  asm volatile("" ::: "memory");
}
#define GEMM_BUF 55296
#define GEMM_EOFF 110592
template <int NT>
__device__ __forceinline__ void gemm_step(f16v (&acc)[4][NT], h8 (&ra)[8], h8 (&rb)[2 * NT],
                                          const unsigned char* As, const unsigned char* Bs, unsigned char* Aw, unsigned char* Bw,
                                          const half_t* __restrict__ A, int lda, const half_t* __restrict__ B, int ldb, int kload,
                                          int wm, int wn, int l, int r0, int kc) {
  h8 af[2][4], bf[2][NT];
#pragma unroll
  for (int i = 0; i < 4; ++i) af[0][i] = *(const h8*)(As + (wm * 128 + i * 32 + (l & 31)) * 144 + (l >> 5) * 16);
#pragma unroll
  for (int j = 0; j < NT; ++j) bf[0][j] = *(const h8*)(Bs + (wn * 32 * NT + j * 32 + (l & 31)) * 144 + (l >> 5) * 16);
#pragma unroll
  for (int ks = 0; ks < 4; ++ks) {
    if (ks < 3) {
#pragma unroll
      for (int i = 0; i < 4; ++i) af[(ks + 1) & 1][i] = *(const h8*)(As + (wm * 128 + i * 32 + (l & 31)) * 144 + (ks + 1) * 32 + (l >> 5) * 16);
#pragma unroll
      for (int j = 0; j < NT; ++j) bf[(ks + 1) & 1][j] = *(const h8*)(Bs + (wn * 32 * NT + j * 32 + (l & 31)) * 144 + (ks + 1) * 32 + (l >> 5) * 16);
    }
#pragma unroll
    for (int i = 0; i < 4; ++i)
#pragma unroll
      for (int j = 0; j < NT; ++j) acc[i][j] = mfma16(af[ks & 1][i], bf[ks & 1][j], acc[i][j]);
#pragma unroll
    for (int i = 2 * ks; i < 2 * ks + 2; ++i) {
      *(h8*)(Aw + (r0 + 32 * i) * 144 + kc * 16) = ra[i];
      ra[i] = *(const h8*)(A + (size_t)(r0 + 32 * i) * lda + kload + kc * 8);
    }
    if (NT == 2) {
      *(h8*)(Bw + (r0 + 32 * ks) * 144 + kc * 16) = rb[ks];
      rb[ks] = *(const h8*)(B + (size_t)(r0 + 32 * ks) * ldb + kload + kc * 8);
    } else {
#pragma unroll
      for (int i = 2 * ks; i < 2 * ks + 2; ++i) {
        *(h8*)(Bw + (r0 + 32 * i) * 144 + kc * 16) = rb[i];
        rb[i] = *(const h8*)(B + (size_t)(r0 + 32 * i) * ldb + kload + kc * 8);
      }
    }
  }
}
template <int NT>
__device__ __forceinline__ void gemm_issue(h8 (&ra0)[8], h8 (&rb0)[2 * NT], h8 (&ra1)[8], h8 (&rb1)[2 * NT],
                                           const half_t* __restrict__ A, int lda, const half_t* __restrict__ B, int ldb) {
  const int tid = otid();
  const int kc = tid & 7, r0 = tid >> 3;
#pragma unroll
  for (int i = 0; i < 8; ++i) ra0[i] = *(const h8*)(A + (size_t)(r0 + 32 * i) * lda + kc * 8);
#pragma unroll
  for (int i = 0; i < 2 * NT; ++i) rb0[i] = *(const h8*)(B + (size_t)(r0 + 32 * i) * ldb + kc * 8);
#pragma unroll
  for (int i = 0; i < 8; ++i) ra1[i] = *(const h8*)(A + (size_t)(r0 + 32 * i) * lda + 64 + kc * 8);
#pragma unroll
  for (int i = 0; i < 2 * NT; ++i) rb1[i] = *(const h8*)(B + (size_t)(r0 + 32 * i) * ldb + 64 + kc * 8);
}
template <int NT>
__device__ __forceinline__ void gemm_run(f16v (&acc)[4][NT], h8 (&ra0)[8], h8 (&rb0)[2 * NT], h8 (&ra1)[8], h8 (&rb1)[2 * NT],
                                         const half_t* __restrict__ A, int lda, const half_t* __restrict__ B, int ldb, int K, unsigned char* lds) {
  const int tid = otid(), w = tid >> 6, l = tid & 63;
  unsigned char* A0 = lds;
  unsigned char* B0 = lds + 256 * 144;
  unsigned char* A1 = lds + GEMM_BUF;
  unsigned char* B1 = lds + GEMM_BUF + 256 * 144;
  const int wm = w >> 1, wn = w & 1;
  const int kc = tid & 7;
  const int r0 = tid >> 3;
  lds_barrier();
#pragma unroll
  for (int i = 0; i < 8; ++i) { *(h8*)(A0 + (r0 + 32 * i) * 144 + kc * 16) = ra0[i]; ra0[i] = *(const h8*)(A + (size_t)(r0 + 32 * i) * lda + 128 + kc * 8); }
#pragma unroll
  for (int i = 0; i < 2 * NT; ++i) { *(h8*)(B0 + (r0 + 32 * i) * 144 + kc * 16) = rb0[i]; rb0[i] = *(const h8*)(B + (size_t)(r0 + 32 * i) * ldb + 128 + kc * 8); }
  lds_barrier();
  const int nk = K / 64;
#pragma unroll 1
  for (int kt = 0; kt < nk; kt += 2) {
    gemm_step<NT>(acc, ra1, rb1, A0, B0, A1, B1, A, lda, B, ldb, (kt + 3 < nk) ? (kt + 3) * 64 : 0, wm, wn, l, r0, kc);
    lds_barrier();
    gemm_step<NT>(acc, ra0, rb0, A1, B1, A0, B0, A, lda, B, ldb, (kt + 4 < nk) ? (kt + 4) * 64 : 0, wm, wn, l, r0, kc);
    lds_barrier();
  }
}
template <int NT>
__device__ __forceinline__ void gemm_kloop(f16v (&acc)[4][NT], const half_t* __restrict__ A, int lda,
                                           const half_t* __restrict__ B, int ldb, int K, unsigned char* lds) {
  h8 ra0[8], rb0[2 * NT], ra1[8], rb1[2 * NT];
  gemm_issue<NT>(ra0, rb0, ra1, rb1, A, lda, B, ldb);
  gemm_run<NT>(acc, ra0, rb0, ra1, rb1, A, lda, B, ldb, K, lds);
}

template <int NT>
__device__ __forceinline__ void zero_acc(f16v (&acc)[4][NT]) {
#pragma unroll
  for (int i = 0; i < 4; ++i)
#pragma unroll
    for (int j = 0; j < NT; ++j)
#pragma unroll
      for (int r = 0; r < 16; ++r) acc[i][j][r] = 0.f;
}

__device__ __forceinline__ void stage_pair(float* E, const f16v& a0, const f16v& a1, int l) {
#pragma unroll
  for (int r = 0; r < 16; ++r) {
    const int rr = crow(r, l);
    E[rr * 65 + (l & 31)] = a0[r];
    E[rr * 65 + 32 + (l & 31)] = a1[r];
  }
}

__device__ __forceinline__ int xcc_census(const unsigned* xcnt, int my_xcc) {
  unsigned sum = 0; bool ok = my_xcc < 8; int mine = 0;
#pragma unroll
  for (int j = 0; j < 16; ++j) {
    const unsigned c = __hip_atomic_load(xcnt + j, __ATOMIC_RELAXED, __HIP_MEMORY_SCOPE_AGENT);
    sum += c;
    if (j < 8 && c == 0u) ok = false;
    if (j >= 8 && c != 0u) ok = false;
    if (j == my_xcc) mine = (int)c;
  }
  if (sum != gridDim.x) ok = false;
  return ok ? mine : 0;
}

__device__ void phase_A(const Params& p, int layer, unsigned char* lds, int my_xcc, int my_loc, const unsigned* xcnt) {
  const int tid = otid(), w = tid >> 6, l = tid & 63;
  const half_t* H = (const half_t*)(p.ws + OFF_H);
  const half_t* Wt = (const half_t*)(p.ws + OFF_WINT) + (size_t)layer * NPAD * WP;
  half_t* P = (half_t*)(p.ws + OFF_P);
  float* GA = (float*)(p.ws + OFF_GA);
  float* IW = (float*)(p.ws + OFF_IW);
  const float* RT = (const float*)(p.ws + OFF_RT);
  const float* DT = (const float*)(p.ws + OFF_DT);
  const int wm = w >> 1, wn = w & 1;
  const int G = gridDim.x;
  const int ntiles = 64 * 62;
  const int nx = xcc_census(xcnt, my_xcc);
  int nmine;
  if (nx > 0) nmine = (my_loc < 496) ? (496 - my_loc + nx - 1) / nx : 0;
  else nmine = ((int)blockIdx.x < ntiles) ? (ntiles - (int)blockIdx.x + G - 1) / G : 0;
  h8 ra0[8], rb0[4], ra1[8], rb1[4];
  int mt = 0, nt = 0;
  if (nmine > 0) {
    if (nx > 0) { const int s0 = my_loc; mt = my_xcc * 8 + (s0 & 7); nt = s0 >> 3; }
    else { const int tix = blockIdx.x; mt = tix & 63; nt = tix >> 6; }
    gemm_issue<2>(ra0, rb0, ra1, rb1, H + (size_t)mt * 256 * HP, HP, Wt + (size_t)nt * 128 * WP, WP);
  }
#pragma unroll 1
  for (int rnd = 0; rnd < nmine; ++rnd) {
    f16v acc[4][2];
    zero_acc<2>(acc);
    gemm_run<2>(acc, ra0, rb0, ra1, rb1, H + (size_t)mt * 256 * HP, HP, Wt + (size_t)nt * 128 * WP, WP, 1024, lds);
    const int mt_cur = mt, nt_cur = nt;
    if (rnd + 1 < nmine) {
      if (nx > 0) { const int s1 = my_loc + nx * (rnd + 1); mt = my_xcc * 8 + (s1 & 7); nt = s1 >> 3; }
      else { const int tix = (rnd + 1) * G + blockIdx.x; mt = tix & 63; nt = tix >> 6; }
      gemm_issue<2>(ra0, rb0, ra1, rb1, H + (size_t)mt * 256 * HP, HP, Wt + (size_t)nt * 128 * WP, WP);
    }
    const int m0w = mt_cur * 256 + wm * 128;
    const int n0w = nt_cur * 128 + wn * 64;
    float* E = (float*)(lds + GEMM_EOFF) + w * (32 * 65);
    const int prow = l >> 3, c0 = (l & 7) * 8;
    {
      const int jp = 0;
      const int nb2 = n0w + jp * 64;
      const int n0 = nb2 + c0;
      const bool rope64 = nb2 < 512;
      const bool rope16 = ((nb2 >= C_DSAQ && nb2 < C_DSAV) || (nb2 >= C_IDXQ && nb2 < C_GLAQ)) && (c0 < 16);
      float scale = 1.f;
      if (n0 < 256 || (n0 >= C_DSAQ && n0 < C_DSAK) || (n0 >= C_IDXQ && n0 < C_IDXK) || (n0 >= C_GLAQ && n0 < C_GLAK)) scale = 0.125f;
      int mode = 0;
      if ((n0 >= C_RETG && n0 < C_DSAQ) || (n0 >= C_DSAG && n0 < C_IDXQ) || (n0 >= C_GLAG && n0 < C_GLAA)) mode = 1;
      if (n0 >= C_MRG && n0 < C_END) mode = 2;
#pragma unroll
      for (int i = 0; i < 4; ++i) {
        stage_pair(E, acc[i][2 * jp], acc[i][2 * jp + 1], l);
#pragma unroll 1
        for (int ps = 0; ps < 4; ++ps) {
          const int rl = ps * 8 + prow;
          const int row = m0w + i * 32 + rl;
          float v[8], o[8];
#pragma unroll
          for (int q = 0; q < 8; ++q) { v[q] = E[rl * 65 + c0 + q]; o[q] = v[q]; }
          if (rope64) {
            const int cp = c0 ^ 32;
            const float* tb = RT + (size_t)row * 64 + (c0 & 31) * 2;
#pragma unroll
            for (int q = 0; q < 8; ++q) {
              const float pv = E[rl * 65 + cp + q];
              const float cs = tb[2 * q], sn = tb[2 * q + 1];
              o[q] = (c0 < 32) ? (v[q] * cs - pv * sn) : (v[q] * cs + pv * sn);
            }
          } else if (rope16) {
            const int cp = c0 ^ 8;
            const float* tb = DT + (size_t)row * 16;
#pragma unroll
            for (int q = 0; q < 8; ++q) {
              const float pv = E[rl * 65 + cp + q];
              const float cs = tb[2 * q], sn = tb[2 * q + 1];
              o[q] = (c0 < 8) ? (v[q] * cs - pv * sn) : (v[q] * cs + pv * sn);
            }
          }
          h8 ov;
#pragma unroll
          for (int q = 0; q < 8; ++q) {
            float t = o[q] * scale;
            if (mode == 1) t = t / (1.f + __expf(-t));
            else if (mode == 2) t = 1.f / (1.f + __expf(-t));
            ov[q] = (half_t)t;
          }
          if (n0 < C_END) __builtin_nontemporal_store(ov, (h8*)(P + (size_t)row * PP + n0));
          if (n0 >= C_GLAA && n0 < C_MRG) {
#pragma unroll
            for (int q = 0; q < 8; ++q) GA[(size_t)row * 16 + (n0 - C_GLAA) + q] = v[q];
          }
          if (n0 == C_IDXW) {
#pragma unroll
            for (int q = 0; q < 4; ++q) IW[(size_t)row * 4 + q] = 0.5f * v[q];
          }
        }
      }
    }
  }
}

#define LA_BC 0
#define LA_GAS 16640
#define LA_WL 20736
#define LA_QT 24832
#define LA_KT 34048
#define LA_AT 43264
#define LA_VT 52480
#define LA_SS 70912
#define LA_OS 89344
#define LA_SEG 123136

__device__ void la_bcum(const Params& p, int layer, int n, int Hh, unsigned char* lds) {
  const int tid = otid();
  float* Bc = (float*)(lds + LA_BC);
  const int d = tid & 63, q = tid >> 6;
  if (Hh < 4) {
    float lg = log1pf(-exp2f(-5.0f - (float)Hh));
#pragma unroll
    for (int jj = 0; jj < 16; ++jj) { int j = q * 16 + jj; Bc[j * 65 + d] = (float)(j + 1) * lg; }
    __syncthreads();
    return;
  }
  const int h = Hh - 4;
  float* GAs = (float*)(lds + LA_GAS);
  float* WL = (float*)(lds + LA_WL);
  float* SEG = (float*)(lds + LA_SEG);
  const float* GA = (const float*)(p.ws + OFF_GA);
#pragma unroll
  for (int i = 0; i < 4; ++i) {
    int e = tid + 256 * i;
    GAs[e] = GA[(size_t)n * 64 * 16 + e];
    int r = e >> 6, dd = e & 63;
    WL[e] = p.gla_w_lr[(size_t)layer * 16 * 256 + r * 256 + h * 64 + dd];
  }
  __syncthreads();
  float wl[16];
#pragma unroll
  for (int r = 0; r < 16; ++r) wl[r] = WL[r * 64 + d];
  const float bl = p.gla_b_lr[layer * 256 + h * 64 + d];
  float run = 0.f;
#pragma unroll
  for (int jj = 0; jj < 16; ++jj) {
    int j = q * 16 + jj;
    float z = bl;
#pragma unroll
    for (int r = 0; r < 16; ++r) z += GAs[j * 16 + r] * wl[r];
    float ls = fminf(z, 0.f) - log1pf(expf(-fabsf(z)));
    run += ls * (1.0f / 16.0f);
    Bc[j * 65 + d] = run;
  }
  SEG[q * 64 + d] = run;
  __syncthreads();
  float off = 0.f;
  for (int qq = 0; qq < q; ++qq) off += SEG[qq * 64 + d];
  if (q > 0) {
#pragma unroll
    for (int jj = 0; jj < 16; ++jj) { int j = q * 16 + jj; Bc[j * 65 + d] += off; }
  }
  __syncthreads();
}

__device__ __forceinline__ void la_stage_vt(const half_t* __restrict__ P, int t0, int vcol, unsigned char* lds) {
  const int tid = otid(), w = tid >> 6, l = tid & 63;
  half_t* VT = (half_t*)(lds + LA_VT);
  const int jp = l & 31, cgp = l >> 5;
#pragma unroll
  for (int it = 0; it < 2; ++it) {
    int c = it * 8 + w * 2 + cgp;
    h8 v0 = *(const h8*)(P + (size_t)(t0 + 2 * jp) * PP + vcol + c * 8);
    h8 v1 = *(const h8*)(P + (size_t)(t0 + 2 * jp + 1) * PP + vcol + c * 8);
#pragma unroll
    for (int q = 0; q < 8; ++q) {
      h2 pr; pr[0] = v0[q]; pr[1] = v1[q];
      *(h2*)(VT + (c * 8 + q) * 72 + 2 * jp) = pr;
    }
  }
}

__device__ void la_item_kv(const Params& p, int layer, int item, unsigned char* lds) {
  const int tid = otid(), w = tid >> 6, l = tid & 63;
  const int n = item >> 3, Hh = item & 7;
  const int t0 = n * 64;
  const half_t* P = (const half_t*)(p.ws + OFF_P);
  float* ST = (float*)(p.ws + OFF_ST);
  float* DEC = (float*)(p.ws + OFF_DEC);
  const int kcol = (Hh < 4) ? (C_RETK + Hh * 64) : (C_GLAK + (Hh - 4) * 64);
  const int vcol = (Hh < 4) ? (C_RETV + Hh * 128) : (C_GLAV + (Hh - 4) * 128);
  __syncthreads();
  la_bcum(p, layer, n, Hh, lds);
  const float* Bc = (const float*)(lds + LA_BC);
  half_t* KhT = (half_t*)(lds + LA_KT);
  half_t* VT = (half_t*)(lds + LA_VT);
  {
    const int jp = l & 31, cgp = l >> 5;
    int c = w * 2 + cgp;
    h8 k0 = *(const h8*)(P + (size_t)(t0 + 2 * jp) * PP + kcol + c * 8);
    h8 k1 = *(const h8*)(P + (size_t)(t0 + 2 * jp + 1) * PP + kcol + c * 8);
#pragma unroll
    for (int q = 0; q < 8; ++q) {
      int d = c * 8 + q;
      float bl = Bc[63 * 65 + d];
      h2 pr;
      pr[0] = (half_t)((float)k0[q] * __expf(bl - Bc[(2 * jp) * 65 + d]));
      pr[1] = (half_t)((float)k1[q] * __expf(bl - Bc[(2 * jp + 1) * 65 + d]));
      *(h2*)(KhT + d * 72 + 2 * jp) = pr;
    }
  }
  la_stage_vt(P, t0, vcol, lds);
  if (tid < 64) DEC[(size_t)item * 64 + tid] = __expf(Bc[63 * 65 + tid]);
  __syncthreads();
  f16v acc[2];
#pragma unroll
  for (int j = 0; j < 2; ++j)
#pragma unroll
    for (int r = 0; r < 16; ++r) acc[j][r] = 0.f;
#pragma unroll
  for (int ks = 0; ks < 4; ++ks) {
    h8 a = *(const h8*)(VT + (32 * w + (l & 31)) * 72 + ks * 16 + (l >> 5) * 8);
#pragma unroll
    for (int j = 0; j < 2; ++j) {
      h8 b = *(const h8*)(KhT + (j * 32 + (l & 31)) * 72 + ks * 16 + (l >> 5) * 8);
      acc[j] = mfma16(a, b, acc[j]);
    }
  }
#pragma unroll
  for (int j = 0; j < 2; ++j)
#pragma unroll
    for (int r = 0; r < 16; ++r) {
      int e = 32 * w + crow(r, l);
      int d = j * 32 + (l & 31);
      ST[(size_t)item * 8192 + e * 64 + d] = acc[j][r];
    }
}

__device__ void phase_scan(const Params& p) {
  float* ST = (float*)(p.ws + OFF_ST);
  const float* DEC = (const float*)(p.ws + OFF_DEC);
  for (int f = blockIdx.x * NTHREADS + otid(); f < 65536; f += gridDim.x * NTHREADS) {
    const int Hh = f >> 13, d = f & 63;
    float s = 0.f;
    for (int n0 = 0; n0 < 256; n0 += 16) {
      float kv[16], dc[16];
#pragma unroll
      for (int u = 0; u < 16; ++u) {
        kv[u] = ST[(size_t)(n0 + u) * 65536 + f];
        dc[u] = DEC[(size_t)((n0 + u) * 8 + Hh) * 64 + d];
      }
#pragma unroll
      for (int u = 0; u < 16; ++u) {
        ST[(size_t)(n0 + u) * 65536 + f] = s;
        s = dc[u] * s + kv[u];
      }
    }
  }
}

__device__ void la_item_out(const Params& p, int layer, int item, unsigned char* lds) {
  const int tid = otid(), w = tid >> 6, l = tid & 63;
  const int n = item >> 3, Hh = item & 7;
  const int t0 = n * 64;
  const half_t* P = (const half_t*)(p.ws + OFF_P);
  const float* ST = (const float*)(p.ws + OFF_ST);
  half_t* BR = (half_t*)(p.ws + OFF_BR);
  const int qcol = (Hh < 4) ? (C_RETQ + Hh * 64) : (C_GLAQ + (Hh - 4) * 64);
  const int kcol = (Hh < 4) ? (C_RETK + Hh * 64) : (C_GLAK + (Hh - 4) * 64);
  const int vcol = (Hh < 4) ? (C_RETV + Hh * 128) : (C_GLAV + (Hh - 4) * 128);
  const int gcol = (Hh < 4) ? (C_RETG + Hh * 128) : (C_GLAG + (Hh - 4) * 128);
  const int ocol = (Hh < 4) ? (Hh * 128) : (1024 + (Hh - 4) * 128);
  __syncthreads();
  la_bcum(p, layer, n, Hh, lds);
  const float* Bc = (const float*)(lds + LA_BC);
  half_t* Qt = (half_t*)(lds + LA_QT);
  half_t* Kt = (half_t*)(lds + LA_KT);
  half_t* AT = (half_t*)(lds + LA_AT);
  half_t* VT = (half_t*)(lds + LA_VT);
  half_t* SS = (half_t*)(lds + LA_SS);
  float* OS = (float*)(lds + LA_OS);
#pragma unroll
  for (int it = 0; it < 2; ++it) {
    int c = tid + 256 * it;
    int row = c >> 3, kc = c & 7;
    h8 qv = *(const h8*)(P + (size_t)(t0 + row) * PP + qcol + kc * 8);
    h8 kv = *(const h8*)(P + (size_t)(t0 + row) * PP + kcol + kc * 8);
    h8 qo, ko;
#pragma unroll
    for (int q = 0; q < 8; ++q) {
      float b = Bc[row * 65 + kc * 8 + q];
      qo[q] = (half_t)((float)qv[q] * __expf(b));
      ko[q] = (half_t)((float)kv[q] * __expf(-b));
    }
    *(h8*)(Qt + row * 72 + kc * 8) = qo;
    *(h8*)(Kt + row * 72 + kc * 8) = ko;
  }
  la_stage_vt(P, t0, vcol, lds);
#pragma unroll
  for (int it = 0; it < 4; ++it) {
    int c = tid + 256 * it;
    int e = c >> 3, kc = c & 7;
    const float* sp = ST + (size_t)item * 8192 + e * 64 + kc * 8;
    f4v s0 = *(const f4v*)sp, s1 = *(const f4v*)(sp + 4);
    h8 o;
    o[0] = (half_t)s0[0]; o[1] = (half_t)s0[1]; o[2] = (half_t)s0[2]; o[3] = (half_t)s0[3];
    o[4] = (half_t)s1[0]; o[5] = (half_t)s1[1]; o[6] = (half_t)s1[2]; o[7] = (half_t)s1[3];
    *(h8*)(SS + e * 72 + kc * 8) = o;
  }
  __syncthreads();
  {
    const int mi = w >> 1, nj = w & 1;
    f16v acc;
#pragma unroll
    for (int r = 0; r < 16; ++r) acc[r] = 0.f;
#pragma unroll
    for (int ks = 0; ks < 4; ++ks) {
      h8 a = *(const h8*)(Qt + (mi * 32 + (l & 31)) * 72 + ks * 16 + (l >> 5) * 8);
      h8 b = *(const h8*)(Kt + (nj * 32 + (l & 31)) * 72 + ks * 16 + (l >> 5) * 8);
      acc = mfma16(a, b, acc);
    }
#pragma unroll
    for (int r = 0; r < 16; ++r) {
      int i = mi * 32 + crow(r, l);
      int j = nj * 32 + (l & 31);
      float v = (j <= i) ? acc[r] : 0.f;
      AT[i * 72 + j] = (half_t)v;
    }
  }
  __syncthreads();
  {
    const int mi = w >> 1, nh = w & 1;
    f16v acc[2];
#pragma unroll
    for (int j = 0; j < 2; ++j)
#pragma unroll
      for (int r = 0; r < 16; ++r) acc[j][r] = 0.f;
#pragma unroll
    for (int ks = 0; ks < 4; ++ks) {
      h8 a1 = *(const h8*)(AT + (mi * 32 + (l & 31)) * 72 + ks * 16 + (l >> 5) * 8);
      h8 a2 = *(const h8*)(Qt + (mi * 32 + (l & 31)) * 72 + ks * 16 + (l >> 5) * 8);
#pragma unroll
      for (int j = 0; j < 2; ++j) {
        h8 b1 = *(const h8*)(VT + (nh * 64 + j * 32 + (l & 31)) * 72 + ks * 16 + (l >> 5) * 8);
        h8 b2 = *(const h8*)(SS + (nh * 64 + j * 32 + (l & 31)) * 72 + ks * 16 + (l >> 5) * 8);
        acc[j] = mfma16(a1, b1, acc[j]);
        acc[j] = mfma16(a2, b2, acc[j]);
      }
    }
#pragma unroll
    for (int j = 0; j < 2; ++j)
#pragma unroll
      for (int r = 0; r < 16; ++r) {
        int i = mi * 32 + crow(r, l);
        int e = nh * 64 + j * 32 + (l & 31);
        OS[i * 132 + e] = acc[j][r];
      }
  }
  __syncthreads();
  {
    const int i = tid >> 2, qd = tid & 3;
    float ov[32];
    float ss = 0.f;
#pragma unroll
    for (int c = 0; c < 8; ++c) {
      f4v v = *(const f4v*)(OS + i * 132 + qd * 32 + c * 4);
      ov[c * 4] = v[0]; ov[c * 4 + 1] = v[1]; ov[c * 4 + 2] = v[2]; ov[c * 4 + 3] = v[3];
      ss += v[0] * v[0] + v[1] * v[1] + v[2] * v[2] + v[3] * v[3];
    }
    ss += __shfl_xor(ss, 1);
    ss += __shfl_xor(ss, 2);
    float rs = rsqrtf(ss * (1.0f / 128.0f) + 1e-6f);
#pragma unroll
    for (int c = 0; c < 4; ++c) {
      h8 g = *(const h8*)(P + (size_t)(t0 + i) * PP + gcol + qd * 32 + c * 8);
      h8 o;
#pragma unroll
      for (int q = 0; q < 8; ++q) o[q] = (half_t)(ov[c * 8 + q] * rs * (float)g[q]);
      *(h8*)(BR + (size_t)(t0 + i) * 1536 + ocol + qd * 32 + c * 8) = o;
    }
  }
}

#define DS_CAP 640
#define DS_PRUNE_AT 512
#define NPL 10
#define DS_LS 0
#define DS_LI (32 * DS_CAP * 4)
#define DS_CNT (32 * DS_CAP * 6)
#define DS_THR (DS_CNT + 128)
#define DS_WQ (DS_CNT + 256)
#define DS_HIST (DS_CNT + 1024)
#define DS_PW (DS_CNT + 1024 + 4096)

__device__ __forceinline__ unsigned long long wave_or64(unsigned long long v) {
  const unsigned lo = wave_or((unsigned)v), hi = wave_or((unsigned)(v >> 32));
  return ((unsigned long long)hi << 32) | lo;
}
__device__ __forceinline__ void dsa_prune(float* LSm, unsigned short* LIm, int n, unsigned* hist, int* cntm, float* thrm, int l) {
  unsigned long long comp[NPL];
  bool act[NPL], val[NPL];
#pragma unroll
  for (int k = 0; k < NPL; ++k) {
    int e = l + 64 * k;
    val[k] = e < n;
    unsigned u = 0, li = 0;
    if (val[k]) { u = __float_as_uint(LSm[e]); li = LIm[e]; }
    const unsigned key = (u >> 31) ? ~u : (u | 0x80000000u);
    comp[k] = ((unsigned long long)key << 14) | (unsigned long long)(16383u - li);
    act[k] = val[k];
  }
  const unsigned long long c0 = ((unsigned long long)(unsigned)__builtin_amdgcn_readfirstlane((int)(unsigned)(comp[0] >> 32)) << 32) | (unsigned)__builtin_amdgcn_readfirstlane((int)(unsigned)comp[0]);
  unsigned long long x = 0;
#pragma unroll
  for (int k = 0; k < NPL; ++k) x |= val[k] ? (comp[k] ^ c0) : 0ull;
  x = wave_or64(x);
  int shift = (x == 0ull) ? 0 : (63 - __clzll((long long)x)) - 7;
  if (shift < 0) shift = 0;
  unsigned rank = 256;
#pragma unroll 1
  for (int rd = 0; rd < 8; ++rd) {
    *(uint4*)(hist + 4 * l) = make_uint4(0, 0, 0, 0);
    __threadfence_block();
    unsigned dk[NPL];
#pragma unroll
    for (int k = 0; k < NPL; ++k) {
      dk[k] = (unsigned)(comp[k] >> shift) & 255u;
      if (act[k]) atomicAdd(&hist[dk[k]], 1u);
    }
    __threadfence_block();
    uint4 hv; hv.x = hist[4 * l]; hv.y = hist[4 * l + 1]; hv.z = hist[4 * l + 2]; hv.w = hist[4 * l + 3];
    unsigned tl = hv.x + hv.y + hv.z + hv.w;
    const unsigned pin = wave_incl_scan(tl);
    const unsigned tot = (unsigned)__builtin_amdgcn_readlane((int)pin, 63);
    unsigned sx = tot - pin;
    bool mine = (sx < rank) && (rank <= sx + tl);
    unsigned dsel = 0, nr = 0, hsel = 0;
    if (mine) {
      unsigned c = sx;
      if (c + hv.w >= rank) { dsel = 4 * l + 3; nr = rank - c; hsel = hv.w; }
      else {
        c += hv.w;
        if (c + hv.z >= rank) { dsel = 4 * l + 2; nr = rank - c; hsel = hv.z; }
        else {
          c += hv.z;
          if (c + hv.y >= rank) { dsel = 4 * l + 1; nr = rank - c; hsel = hv.y; }
          else { c += hv.y; dsel = 4 * l; nr = rank - c; hsel = hv.x; }
        }
      }
    }
    unsigned long long mk = __ballot(mine);
    int src = (mk == 0ull) ? 0 : (__ffsll((long long)mk) - 1);
    dsel = (unsigned)__builtin_amdgcn_readlane((int)dsel, src);
    rank = (unsigned)__builtin_amdgcn_readlane((int)nr, src);
    hsel = (unsigned)__builtin_amdgcn_readlane((int)hsel, src);
#pragma unroll
    for (int k = 0; k < NPL; ++k) act[k] = act[k] && (dk[k] == dsel);
    if (hsel <= 1u || shift == 0) break;
    shift = (shift >= 8) ? (shift - 8) : 0;
  }
  unsigned long long tsel = 0;
#pragma unroll
  for (int k = 0; k < NPL; ++k) tsel |= act[k] ? comp[k] : 0ull;
  const unsigned long long T = wave_or64(tsel);
  bool keep[NPL];
  unsigned cntk = 0;
#pragma unroll
  for (int k = 0; k < NPL; ++k) {
    keep[k] = val[k] && (comp[k] >= T);
    cntk += keep[k] ? 1u : 0u;
  }
  unsigned pos = wave_incl_scan(cntk) - cntk;
  __threadfence_block();
#pragma unroll
  for (int k = 0; k < NPL; ++k) {
    if (keep[k]) {
      const unsigned kk = (unsigned)(comp[k] >> 14);
      const unsigned u = (kk & 0x80000000u) ? (kk & 0x7FFFFFFFu) : ~kk;
      LSm[pos] = __uint_as_float(u);
      LIm[pos] = (unsigned short)(16383u - ((unsigned)comp[k] & 16383u));
      ++pos;
    }
  }
  if (l == 0) {
    const unsigned T32 = (unsigned)(T >> 14);
    *cntm = 256;
    *thrm = __uint_as_float((T32 & 0x80000000u) ? (T32 & 0x7FFFFFFFu) : ~T32);
  }
  __threadfence_block();
}

__device__ void dsa_item(const Params& p, int qb, unsigned char* lds) {
  const int tid = otid(), w = tid >> 6, l = tid & 63;
  const int t0 = qb * 32;
  const half_t* P = (const half_t*)(p.ws + OFF_P);
  const float* IW = (const float*)(p.ws + OFF_IW);
  half_t* BR = (half_t*)(p.ws + OFF_BR);
  float* LS = (float*)(lds + DS_LS);
  unsigned short* LI = (unsigned short*)(lds + DS_LI);
  int* cnt = (int*)(lds + DS_CNT);
  float* thr = (float*)(lds + DS_THR);
  float* wq = (float*)(lds + DS_WQ);
  unsigned* hist = (unsigned*)(lds + DS_HIST) + w * 256;
  float* PW = (float*)(lds + DS_PW) + w * 1024;
  half_t* QS = (half_t*)(lds + DS_PW + 16384) + w * 512;
  for (int rep_sel = 0; rep_sel < REP_SEL; ++rep_sel) {
  __syncthreads();
  if (tid < 32) { cnt[tid] = 0; thr[tid] = -INFINITY; }
  if (tid < 128) wq[tid] = IW[(size_t)t0 * 4 + tid];
  __syncthreads();
  h8 aq[4][4];
#pragma unroll
  for (int h = 0; h < 4; ++h)
#pragma unroll
    for (int ks = 0; ks < 4; ++ks)
      aq[h][ks] = *(const h8*)(P + (size_t)(t0 + (l & 31)) * PP + C_IDXQ + h * 64 + ks * 16 + (l >> 5) * 8);
  const int nt = qb + 1;
  const int nr = (nt + 3) >> 2;
  h8 bk[4];
  {
    const int k0 = (w < nt) ? w : 0;
#pragma unroll
    for (int ks = 0; ks < 4; ++ks)
      bk[ks] = *(const h8*)(P + (size_t)(k0 * 32 + (l & 31)) * PP + C_IDXK + ks * 16 + (l >> 5) * 8);
  }
#pragma unroll 1
  for (int rd = 0; rd < nr; ++rd) {
    const int kt = 4 * rd + w;
    h8 bkn[4];
    {
      const int kn = (kt + 4 < nt) ? (kt + 4) : 0;
#pragma unroll
      for (int ks = 0; ks < 4; ++ks)
        bkn[ks] = *(const h8*)(P + (size_t)(kn * 32 + (l & 31)) * PP + C_IDXK + ks * 16 + (l >> 5) * 8);
    }
    if (kt < nt) {
      const int sbase = kt * 32;
      f16v acc[4];
#pragma unroll
      for (int h = 0; h < 4; ++h) {
#pragma unroll
        for (int r = 0; r < 16; ++r) acc[h][r] = 0.f;
#pragma unroll
        for (int ks = 0; ks < 4; ++ks) acc[h] = mfma16(aq[h][ks], bk[ks], acc[h]);
      }
      const int s = sbase + (l & 31);
      float scv[16];
      unsigned pm = 0;
#pragma unroll
      for (int r = 0; r < 16; ++r) {
        const int m = crow(r, l);
        const f4v wv = *(const f4v*)(wq + m * 4);
        float sc = wv[0] * relu_f(acc[0][r]) + wv[1] * relu_f(acc[1][r]) + wv[2] * relu_f(acc[2][r]) + wv[3] * relu_f(acc[3][r]);
        sc += 0.0f;
        scv[r] = sc;
        const float th = thr[m];
        const bool pass = (s <= t0 + m) && (sc > th);
        pm |= pass ? (1u << r) : 0u;
      }
      if (__ballot(pm != 0u) != 0ull) {
        unsigned long long mks[16];
        int mycnt = 0;
#pragma unroll
        for (int r = 0; r < 16; ++r) {
          const unsigned long long mk = __ballot(((pm >> r) & 1u) != 0u);
          mks[r] = mk;
          const unsigned hm = (l < 32) ? (unsigned)mk : (unsigned)(mk >> 32);
          if ((l & 31) == r) mycnt = __popc(hm);
        }
        int base = 0;
        if ((l & 31) < 16 && mycnt > 0) base = atomicAdd(&cnt[crow(l & 31, l)], mycnt);
#pragma unroll
        for (int r = 0; r < 16; ++r) {
          const unsigned long long mk = mks[r];
          if (mk != 0ull) {
            const unsigned hm = (l < 32) ? (unsigned)mk : (unsigned)(mk >> 32);
            const int b_lo = __builtin_amdgcn_readlane(base, r), b_hi = __builtin_amdgcn_readlane(base, 32 + r);
            const int bb = (l < 32) ? b_lo : b_hi;
            if ((pm >> r) & 1u) {
              const int m = crow(r, l);
              const int slot = bb + __popc(hm & ((1u << (l & 31)) - 1u));
              LS[m * DS_CAP + slot] = scv[r];
              LI[m * DS_CAP + slot] = (unsigned short)s;
            }
          }
        }
      }
    }
    __syncthreads();
    {
      const int cv = (l < 32) ? cnt[l] : 0;
      unsigned pmask = (unsigned)__ballot(cv > DS_PRUNE_AT);
      int j = 0;
      while (pmask != 0u) {
        const int m = __ffs((int)pmask) - 1;
        pmask &= pmask - 1u;
        if ((j & 3) == w) dsa_prune(LS + m * DS_CAP, LI + m * DS_CAP, cnt[m], hist, cnt + m, thr + m, l);
        ++j;
      }
    }
    __syncthreads();
#pragma unroll
    for (int ks = 0; ks < 4; ++ks) bk[ks] = bkn[ks];
  }
  }
#pragma unroll 1
  for (int mm = 0; mm < 8; ++mm) {
    const int m = w * 8 + mm;
    const int c = cnt[m];
    if (c > 256) dsa_prune(LS + m * DS_CAP, LI + m * DS_CAP, c, hist, cnt + m, thr + m, l);
  }
  asm volatile("s_waitcnt lgkmcnt(0)" ::: "memory");
  for (int rep_att = 0; rep_att < REP_ATT; ++rep_att) {
  h8 kvr[4][8];
  {
    const int m = w * 8;
    const int c = min(cnt[m], 256);
    const unsigned short* LIm = LI + m * DS_CAP;
#pragma unroll
    for (int kk = 0; kk < 4; ++kk) {
      const int e = l + 64 * kk;
      const int s = (e < c) ? (int)LIm[e] : 0;
      const half_t* kr = P + (size_t)s * PP + C_DSAK;
#pragma unroll
      for (int ch = 0; ch < 8; ++ch) kvr[kk][ch] = *(const h8*)(kr + ch * 8);
    }
  }
  h8 qreg = *(const h8*)(P + (size_t)(t0 + w * 8) * PP + C_DSAQ + l * 8);
  const int dch = l & 7, ksub = l >> 3;
#pragma unroll 1
  for (int u = 0; u < 16; ++u) {
    const int mm = u >> 1, g = u & 1;
    const int m = w * 8 + mm;
    const int t = t0 + m;
    const int c = min(cnt[m], 256);
    const unsigned short* LIm = LI + m * DS_CAP;
    if (g == 0) {
      *(h8*)(QS + l * 8) = qreg;
      const int mq = (mm < 7) ? (m + 1) : m;
      qreg = *(const h8*)(P + (size_t)(t0 + mq) * PP + C_DSAQ + l * 8);
    }
    h8 gt[4];
#pragma unroll
    for (int hh = 0; hh < 4; ++hh) gt[hh] = *(const h8*)(P + (size_t)t * PP + C_DSAG + (g * 4 + hh) * 64 + dch * 8);
    h8 vv[16];
#pragma unroll
    for (int i = 0; i < 16; ++i) {
      const int e = i * 8 + ksub;
      const int s = (e < c) ? (int)LIm[e] : 0;
      vv[i] = *(const h8*)(P + (size_t)s * PP + C_DSAV + g * 64 + dch * 8);
    }
    asm volatile("s_waitcnt lgkmcnt(0)" ::: "memory");
    float lg[4][4];
#pragma unroll
    for (int hh = 0; hh < 4; ++hh) {
#pragma unroll
      for (int kk = 0; kk < 4; ++kk) lg[hh][kk] = 0.f;
#pragma unroll
      for (int ch = 0; ch < 8; ++ch) {
        const h8 qq = *(const h8*)(QS + (g * 4 + hh) * 64 + ch * 8);
#pragma unroll
        for (int kk = 0; kk < 4; ++kk) {
          float a = lg[hh][kk];
          a = __builtin_amdgcn_fdot2(__builtin_shufflevector(qq, qq, 0, 1), __builtin_shufflevector(kvr[kk][ch], kvr[kk][ch], 0, 1), a, false);
          a = __builtin_amdgcn_fdot2(__builtin_shufflevector(qq, qq, 2, 3), __builtin_shufflevector(kvr[kk][ch], kvr[kk][ch], 2, 3), a, false);
          a = __builtin_amdgcn_fdot2(__builtin_shufflevector(qq, qq, 4, 5), __builtin_shufflevector(kvr[kk][ch], kvr[kk][ch], 4, 5), a, false);
          a = __builtin_amdgcn_fdot2(__builtin_shufflevector(qq, qq, 6, 7), __builtin_shufflevector(kvr[kk][ch], kvr[kk][ch], 6, 7), a, false);
          lg[hh][kk] = a;
        }
      }
#pragma unroll
      for (int kk = 0; kk < 4; ++kk) lg[hh][kk] = (l + 64 * kk < c) ? lg[hh][kk] : -INFINITY;
    }
    {
      const int un = (u < 15) ? (u + 1) : 15;
      const int mn = w * 8 + (un >> 1), gn = un & 1;
      const int cn = min(cnt[mn], 256);
      const unsigned short* LIn = LI + mn * DS_CAP;
#pragma unroll
      for (int kk = 0; kk < 4; ++kk) {
        const int e = l + 64 * kk;
        const int s = (e < cn) ? (int)LIn[e] : 0;
        const half_t* kr = P + (size_t)s * PP + C_DSAK + gn * 64;
#pragma unroll
        for (int ch = 0; ch < 8; ++ch) kvr[kk][ch] = *(const h8*)(kr + ch * 8);
      }
    }
#pragma unroll
    for (int hh = 0; hh < 4; ++hh) {
      float mx = fmaxf(fmaxf(lg[hh][0], lg[hh][1]), fmaxf(lg[hh][2], lg[hh][3]));
      mx = wave_max(mx);
      float ev[4]; float sm = 0.f;
#pragma unroll
      for (int kk = 0; kk < 4; ++kk) { ev[kk] = __expf(lg[hh][kk] - mx); sm += ev[kk]; }
      sm = wave_sum(sm);
      const float inv = 1.0f / sm;
#pragma unroll
      for (int kk = 0; kk < 4; ++kk) PW[(l + 64 * kk) * 4 + hh] = ev[kk] * inv;
    }
    asm volatile("s_waitcnt lgkmcnt(0)" ::: "memory");
    float o[4][8];
#pragma unroll
    for (int hh = 0; hh < 4; ++hh)
#pragma unroll
      for (int q = 0; q < 8; ++q) o[hh][q] = 0.f;
    const int nit = (c + 7) >> 3;
#pragma unroll 1
    for (int it0 = 0; it0 < nit; it0 += 16) {
      if (it0 > 0) {
#pragma unroll
        for (int i = 0; i < 16; ++i) {
          const int e = (it0 + i) * 8 + ksub;
          const int s = (e < c) ? (int)LIm[e] : 0;
          vv[i] = *(const h8*)(P + (size_t)s * PP + C_DSAV + g * 64 + dch * 8);
        }
      }
#pragma unroll
      for (int i = 0; i < 16; ++i) {
        const int e = (it0 + i) * 8 + ksub;
        const f4v pv = *(const f4v*)(PW + e * 4);
#pragma unroll
        for (int hh = 0; hh < 4; ++hh)
#pragma unroll
          for (int q = 0; q < 8; ++q) o[hh][q] += pv[hh] * (float)vv[i][q];
      }
    }
#pragma unroll
    for (int hh = 0; hh < 4; ++hh)
#pragma unroll
      for (int q = 0; q < 8; ++q) {
        float v = o[hh][q];
        v += dppf<0x128>(v); v += __shfl_xor(v, 16); v += __shfl_xor(v, 32);
        o[hh][q] = v;
      }
    if (l < 8) {
#pragma unroll
      for (int hh = 0; hh < 4; ++hh) {
        const int col = (g * 4 + hh) * 64 + dch * 8;
        h8 ov;
#pragma unroll
        for (int q = 0; q < 8; ++q) ov[q] = (half_t)(o[hh][q] * (float)gt[hh][q]);
        *(h8*)(BR + (size_t)t * 1536 + 512 + col) = ov;
      }
    }
    asm volatile("s_waitcnt lgkmcnt(0)" ::: "memory");
  }
  }
}

__device__ void phase_B(const Params& p, int layer, unsigned char* lds) {
  const int G = gridDim.x;
  for (int j = 0; j * G < 512; ++j) {
    const int b = (j & 1) ? (G - 1 - (int)blockIdx.x) : (int)blockIdx.x;
    const int idx = j * G + b;
#ifndef NO_DSA
    if (idx < 512) dsa_item(p, 511 - idx, lds);
#endif
  }
  for (int rep = 0; rep < REP_KV; ++rep)
  for (int it = blockIdx.x; it < 2048; it += G) la_item_kv(p, layer, it, lds);
}

__device__ void phase_E1(const Params& p, int layer, unsigned char* lds, int my_xcc, int my_loc, const unsigned* xcnt) {
  const int tid = otid(), w = tid >> 6, l = tid & 63;
  const half_t* BR = (const half_t*)(p.ws + OFF_BR);
  const half_t* WbrT = (const half_t*)(p.ws + OFF_WBRT) + (size_t)layer * 3 * 1024 * WBP;
  const half_t* P = (const half_t*)(p.ws + OFF_P);
  half_t* Y1 = (half_t*)(p.ws + OFF_H);
  const int wm = w >> 1, wn = w & 1;
  float* E = (float*)(lds + GEMM_EOFF) + w * (32 * 65);
  const int prow = l >> 3, c0 = (l & 7) * 8;
  const int nx = xcc_census(xcnt, my_xcc);
  const int nrounds = (nx > 0) ? (64 + nx - 1) / nx : (512 + (int)gridDim.x - 1) / (int)gridDim.x;
  for (int rnd = 0; rnd < nrounds; ++rnd) {
    int mt, nt;
    if (nx > 0) {
      const int s = my_loc + nx * rnd;
      if (s >= 64) continue;
      mt = my_xcc * 8 + (s & 7); nt = s >> 3;
    } else {
      const int tix = rnd * (int)gridDim.x + (int)blockIdx.x;
      if (tix >= 512) continue;
      mt = tix & 63; nt = tix >> 6;
    }
    h8 tot[4][4];
#pragma unroll
    for (int i = 0; i < 4; ++i)
#pragma unroll
      for (int ps = 0; ps < 4; ++ps)
#pragma unroll
        for (int q = 0; q < 8; ++q) tot[i][ps][q] = (half_t)0.f;
    const int m0w = mt * 256 + wm * 128;
    const int n0 = nt * 128 + wn * 64 + c0;
#pragma unroll 1
    for (int b = 0; b < 3; ++b) {
      f16v acc[4][2];
      zero_acc<2>(acc);
      gemm_kloop<2>(acc, BR + (size_t)mt * 256 * 1536 + b * 512, 1536, WbrT + (size_t)b * 1024 * WBP + (size_t)nt * 128 * WBP, WBP, 512, lds);
#pragma unroll
      for (int i = 0; i < 4; ++i) {
        stage_pair(E, acc[i][0], acc[i][1], l);
#pragma unroll
        for (int ps = 0; ps < 4; ++ps) {
          const int rl = ps * 8 + prow;
          const int row = m0w + i * 32 + rl;
          const h8 g = *(const h8*)(P + (size_t)row * PP + C_MRG + b * 1024 + n0);
#pragma unroll
          for (int q = 0; q < 8; ++q) tot[i][ps][q] = (half_t)((float)tot[i][ps][q] + (float)g[q] * E[rl * 65 + c0 + q]);
        }
      }
    }
#pragma unroll
    for (int i = 0; i < 4; ++i)
#pragma unroll
      for (int ps = 0; ps < 4; ++ps) {
        const int row = m0w + i * 32 + ps * 8 + prow;
        *(h8*)(Y1 + (size_t)row * HP + n0) = tot[i][ps];
      }
  }
}

__device__ void phase_E2(const Params& p, int layer, unsigned char* lds, int my_xcc, int my_loc, const unsigned* xcnt) {
  const int tid = otid(), w = tid >> 6, l = tid & 63;
  const half_t* Y1 = (const half_t*)(p.ws + OFF_H);
  const half_t* Wo = (const half_t*)(p.ws + OFF_WOUTT) + (size_t)layer * 1024 * WP;
  float* Y = (float*)(p.ws + OFF_ST);
  const int wm = w >> 1, wn = w & 1;
  const int nx = xcc_census(xcnt, my_xcc);
  const int nrounds = (nx > 0) ? (64 + nx - 1) / nx : (512 + (int)gridDim.x - 1) / (int)gridDim.x;
  for (int rnd = 0; rnd < nrounds; ++rnd) {
    int mt, nt;
    if (nx > 0) {
      const int s = my_loc + nx * rnd;
      if (s >= 64) continue;
      mt = my_xcc * 8 + (s & 7); nt = s >> 3;
    } else {
      const int tix = rnd * (int)gridDim.x + (int)blockIdx.x;
      if (tix >= 512) continue;
      mt = tix & 63; nt = tix >> 6;
    }
    f16v acc[4][2];
    zero_acc<2>(acc);
    gemm_kloop<2>(acc, Y1 + (size_t)mt * 256 * HP, HP, Wo + (size_t)nt * 128 * WP, WP, 1024, lds);
    const int m0w = mt * 256 + wm * 128;
    const int n0w = nt * 128 + wn * 64;
#pragma unroll
    for (int i = 0; i < 4; ++i)
#pragma unroll
      for (int j = 0; j < 2; ++j)
#pragma unroll
        for (int r = 0; r < 16; ++r) {
          const int row = m0w + i * 32 + crow(r, l);
          const int n = n0w + j * 32 + (l & 31);
          Y[(size_t)row * 1024 + n] = acc[i][j][r];
        }
  }
}

__device__ void phase_E3(const Params& p, int layer) {
  const int w = otid() >> 6, l = otid() & 63;
  const float* Y = (const float*)(p.ws + OFF_ST);
  const float* MOD = (const float*)(p.ws + OFF_MOD);
  half_t* H = (half_t*)(p.ws + OFF_H);
  const float* xin = (layer == 0) ? p.x : p.out;
  const float* gate = MOD + layer * 3072 + 2048;
  const float* post = p.post_norm + layer * 1024;
  for (int row = blockIdx.x * 4 + w; row < S_LEN; row += gridDim.x * 4) {
    float yv[16], xv[16];
    float ss = 0.f;
#pragma unroll
    for (int i = 0; i < 4; ++i) {
      f4v v = *(const f4v*)(Y + (size_t)row * 1024 + i * 256 + l * 4);
      f4v xx = *(const f4v*)(xin + (size_t)row * 1024 + i * 256 + l * 4);
#pragma unroll
      for (int q = 0; q < 4; ++q) { yv[i * 4 + q] = v[q]; xv[i * 4 + q] = xx[q]; ss += v[q] * v[q]; }
    }
    ss = wave_sum(ss);
    const float rs = rsqrtf(ss * (1.0f / 1024.0f) + 1e-6f);
#pragma unroll
    for (int i = 0; i < 4; ++i) {
      const int c0 = i * 256 + l * 4;
      f4v gt = *(const f4v*)(gate + c0);
      f4v pn = *(const f4v*)(post + c0);
      f4v o;
#pragma unroll
      for (int q = 0; q < 4; ++q) { o[q] = xv[i * 4 + q] + gt[q] * (yv[i * 4 + q] * rs * pn[q]); xv[i * 4 + q] = o[q]; }
      *(f4v*)(p.out + (size_t)row * 1024 + c0) = o;
    }
    if (layer + 1 < DEPTH)
      write_h_row(xv, p.pre_norm + (layer + 1) * 1024, MOD + (layer + 1) * 3072, H + (size_t)row * HP, l);
  }
}

#ifndef REP_D
#define REP_D 1
#endif
#ifndef REP_E
#define REP_E 1
#endif
#ifndef REP_A
#define REP_A 1
#endif
#ifndef REP_B
#define REP_B 1
#endif
#ifdef ONLY_PHASE
#define PH_EN(x) (ONLY_PHASE == (x))
#else
#define PH_EN(x) true
#endif
__global__ void __launch_bounds__(NTHREADS) fwd_megakernel(Params p) {
  extern __shared__ __attribute__((aligned(16))) unsigned char lds[];
  cg::grid_group grid = cg::this_grid();
  unsigned* bar = (unsigned*)(p.ws + WS_END);
  unsigned nbar = 0;
  unsigned* xcnt = bar + 16;
  if (blockIdx.x == 0 && otid() < 17) __hip_atomic_store(bar + (otid() == 16 ? 0 : 16 + otid()), 0u, __ATOMIC_RELAXED, __HIP_MEMORY_SCOPE_AGENT);
  int my_xcc = 0, my_loc = 0;
  for (int ph = p.ph_lo; ph < p.ph_hi; ++ph) {
    if (ph == 0) { if (PH_EN(0)) for (int rep = 0; rep < REP_P; ++rep) { phase_prologue(p, lds); __syncthreads(); } }
    else if (ph == 1) {
      int* sh = (int*)lds;
      if (otid() == 0) {
        const int xc = (int)(__builtin_amdgcn_s_getreg((3 << 11) | 20) & 0xFu);
        sh[0] = xc;
        sh[1] = (int)__hip_atomic_fetch_add(xcnt + xc, 1u, __ATOMIC_RELAXED, __HIP_MEMORY_SCOPE_AGENT);
      }
      __syncthreads();
      my_xcc = __builtin_amdgcn_readfirstlane(sh[0]);
      my_loc = __builtin_amdgcn_readfirstlane(sh[1]);
      __syncthreads();
      if (PH_EN(1)) phase_h0(p);
    }
    else {
      const int layer = (ph - 2) / 7, sub = (ph - 2) % 7;
      if (sub == 0) { if (PH_EN(2)) for (int rep = 0; rep < REP_A; ++rep) { phase_A(p, layer, lds, my_xcc, my_loc, xcnt); __syncthreads(); } }
      else if (sub == 1) { if (PH_EN(3)) for (int rep = 0; rep < REP_B; ++rep) { phase_B(p, layer, lds); __syncthreads(); } }
      else if (sub == 2) { if (PH_EN(4)) phase_scan(p); }
      else if (sub == 3) { if (PH_EN(5)) for (int rep = 0; rep < REP_D; ++rep) { for (int it = blockIdx.x; it < 2048; it += gridDim.x) la_item_out(p, layer, it, lds); __syncthreads(); } }
      else if (sub == 4) { if (PH_EN(6)) for (int rep = 0; rep < REP_E; ++rep) { phase_E1(p, layer, lds, my_xcc, my_loc, xcnt); __syncthreads(); } }
      else if (sub == 5) { if (PH_EN(7)) for (int rep = 0; rep < REP_E; ++rep) { phase_E2(p, layer, lds, my_xcc, my_loc, xcnt); __syncthreads(); } }
      else { if (PH_EN(8)) phase_E3(p, layer); }
    }
    if (ph + 1 < p.ph_hi) {
      if (ph == p.ph_lo) grid.sync();
      else {
        __threadfence();
        __syncthreads();
        if (otid() == 0) {
          ++nbar;
          const unsigned target = nbar * gridDim.x;
          __hip_atomic_fetch_add(bar, 1u, __ATOMIC_RELAXED, __HIP_MEMORY_SCOPE_AGENT);
          while (__hip_atomic_load(bar, __ATOMIC_RELAXED, __HIP_MEMORY_SCOPE_AGENT) < target) __builtin_amdgcn_s_sleep(2);
        }
        __syncthreads();
        __threadfence();
      }
    }
  }
}

extern "C" void kernel_launch(void* const* d_in, const int* in_sizes, int n_in, void* d_out, int out_size,
                              void* d_ws, size_t ws_size, hipStream_t stream) {
  static int grid_blocks = 0;
  if (!grid_blocks) {
    int dev = 0, cus = 0, per_cu = 0;
    hipGetDevice(&dev);
    hipDeviceGetAttribute(&cus, hipDeviceAttributeMultiprocessorCount, dev);
    hipFuncSetAttribute((const void*)fwd_megakernel, hipFuncAttributeMaxDynamicSharedMemorySize, LDS_BYTES);
    hipOccupancyMaxActiveBlocksPerMultiprocessor(&per_cu, (const void*)fwd_megakernel, NTHREADS, LDS_BYTES);
    if (per_cu < 1) per_cu = 1;
    if (per_cu > 1) per_cu = 1;
    grid_blocks = cus * per_cu;
    if (ws_size < WS_END) fprintf(stderr, "workspace too small: %zu < %llu\n", ws_size, (unsigned long long)WS_END);
  }
  Params p{};
  p.x = (const float*)d_in[0]; p.c = (const float*)d_in[1]; p.pos = (const int*)d_in[2];
  p.ada_w = (const float*)d_in[3]; p.ada_b = (const float*)d_in[4];
  p.pre_norm = (const float*)d_in[5]; p.post_norm = (const float*)d_in[6];
  p.w_in = (const float*)d_in[7]; p.gla_w_lr = (const float*)d_in[8]; p.gla_b_lr = (const float*)d_in[9];
  p.w_br_ret = (const float*)d_in[10]; p.w_br_dsa = (const float*)d_in[11]; p.w_br_gla = (const float*)d_in[12];
  p.w_out = (const float*)d_in[13];
  p.out = (float*)d_out; p.ws = (unsigned char*)d_ws;
  p.ph_lo = 0; p.ph_hi = 2 + 7 * DEPTH;
  void* args[] = {&p};
  hipError_t e = hipLaunchCooperativeKernel((const void*)fwd_megakernel, dim3(grid_blocks), dim3(NTHREADS), args, LDS_BYTES, stream);
  if (e != hipSuccess) fprintf(stderr, "cooperative launch failed: %s (grid %d)\n", hipGetErrorString(e), grid_blocks);
}
```

```cpp
#include <hip/hip_runtime.h>
#include <hip/hip_cooperative_groups.h>
#include <stdint.h>
#include <cstdio>
namespace cg = cooperative_groups;
#ifndef REP_P
#define REP_P 1
#endif
#ifndef REP_KV
#define REP_KV 1
#endif
#ifndef REP_SEL
#define REP_SEL 1
#endif
#ifndef REP_ATT
#define REP_ATT 1
#endif

typedef _Float16 half_t;
typedef _Float16 h8 __attribute__((ext_vector_type(8)));
typedef _Float16 h4 __attribute__((ext_vector_type(4)));
typedef _Float16 h2 __attribute__((ext_vector_type(2)));
typedef float f16v __attribute__((ext_vector_type(16)));
typedef float f4v __attribute__((ext_vector_type(4)));

#define S_LEN 16384
#define DM 1024
#define NIN 7764
#define NPAD 7936
#define PP 7808
#define DEPTH 4
#define NTHREADS 256
#define HP 1088
#define WP 1088
#define WBP 576
#define LDS_BYTES 149504

#define C_RETQ 0
#define C_RETK 256
#define C_RETV 512
#define C_RETG 1024
#define C_DSAQ 1536
#define C_DSAK 2048
#define C_DSAV 2176
#define C_DSAG 2304
#define C_IDXQ 2816
#define C_IDXK 3072
#define C_GLAQ 3136
#define C_GLAK 3392
#define C_GLAV 3648
#define C_GLAG 4160
#define C_GLAA 4672
#define C_MRG 4688
#define C_END 7760
#define C_IDXW 7760

#define OFF_WINT 0ull
#define OFF_WBRT (OFF_WINT + 4ull * NPAD * WP * 2)
#define OFF_WOUTT (OFF_WBRT + 4ull * 3 * 1024 * WBP * 2)
#define OFF_MOD (OFF_WOUTT + 4ull * 1024 * WP * 2)
#define OFF_RT (OFF_MOD + 4ull * 3072 * 4)
#define OFF_DT (OFF_RT + 16384ull * 64 * 4)
#define OFF_H (OFF_DT + 16384ull * 16 * 4)
#define OFF_P (OFF_H + 16384ull * HP * 2)
#define OFF_GA (OFF_P + 16384ull * PP * 2)
#define OFF_IW (OFF_GA + 16384ull * 16 * 4)
#define OFF_ST (OFF_IW + 16384ull * 4 * 4)
#define OFF_DEC (OFF_ST + 256ull * 65536 * 4)
#define OFF_BR (OFF_DEC + 256ull * 8 * 64 * 4)
#define WS_END (OFF_BR + 16384ull * 1536 * 2)
static_assert(WS_END + 16384 <= 508821504ull, "workspace too large");

struct Params {
  const float* x; const float* c; const int* pos; const float* ada_w; const float* ada_b;
  const float* pre_norm; const float* post_norm; const float* w_in; const float* gla_w_lr;
  const float* gla_b_lr; const float* w_br_ret; const float* w_br_dsa; const float* w_br_gla;
  const float* w_out; float* out; unsigned char* ws;
  int ph_lo; int ph_hi;
};

__device__ __forceinline__ int otid() { int t = (int)__builtin_amdgcn_workitem_id_x(); asm volatile("" : "+v"(t)); return t; }
template <int CTRL>
__device__ __forceinline__ float dppf(float v) {
  return __int_as_float(__builtin_amdgcn_update_dpp(0, __float_as_int(v), CTRL, 0xF, 0xF, true));
}
template <int CTRL>
__device__ __forceinline__ unsigned dppu(unsigned v) {
  return (unsigned)__builtin_amdgcn_update_dpp(0, (int)v, CTRL, 0xF, 0xF, true);
}
__device__ __forceinline__ float wave_sum(float v) {
  v += dppf<0xB1>(v); v += dppf<0x4E>(v); v += dppf<0x141>(v); v += dppf<0x140>(v);
  v += __shfl_xor(v, 16); v += __shfl_xor(v, 32);
  return v;
}
__device__ __forceinline__ float wave_max(float v) {
  v = fmaxf(v, dppf<0xB1>(v)); v = fmaxf(v, dppf<0x4E>(v)); v = fmaxf(v, dppf<0x141>(v)); v = fmaxf(v, dppf<0x140>(v));
  v = fmaxf(v, __shfl_xor(v, 16)); v = fmaxf(v, __shfl_xor(v, 32));
  return v;
}
__device__ __forceinline__ unsigned wave_or(unsigned v) {
  v |= dppu<0xB1>(v); v |= dppu<0x4E>(v); v |= dppu<0x141>(v); v |= dppu<0x140>(v);
  v |= __shfl_xor(v, 16); v |= __shfl_xor(v, 32);
  return v;
}
__device__ __forceinline__ unsigned wave_incl_scan(unsigned v) {
  v += (unsigned)__builtin_amdgcn_update_dpp(0, (int)v, 0x111, 0xF, 0xF, false);
  v += (unsigned)__builtin_amdgcn_update_dpp(0, (int)v, 0x112, 0xF, 0xF, false);
  v += (unsigned)__builtin_amdgcn_update_dpp(0, (int)v, 0x114, 0xF, 0xF, false);
  v += (unsigned)__builtin_amdgcn_update_dpp(0, (int)v, 0x118, 0xF, 0xF, false);
  v += (unsigned)__builtin_amdgcn_update_dpp(0, (int)v, 0x142, 0xA, 0xF, false);
  v += (unsigned)__builtin_amdgcn_update_dpp(0, (int)v, 0x143, 0xC, 0xF, false);
  return v;
}
__device__ __forceinline__ f16v mfma16(h8 a, h8 b, f16v c) {
  return __builtin_amdgcn_mfma_f32_32x32x16_f16(a, b, c, 0, 0, 0);
}
__device__ __forceinline__ float relu_f(float x) { return __int_as_float(max(__float_as_int(x), 0)); }
__device__ __forceinline__ int crow(int r, int l) { return (r & 3) + 8 * (r >> 2) + 4 * (l >> 5); }

__device__ __forceinline__ int win_col(int nv) {
  if (nv < 3136) return nv;
  if (nv < 7760) return nv + 4;
  if (nv < 7764) return nv - 7760 + 3136;
  return -1;
}
__device__ void transpose_tile(const float* __restrict__ src, int ldn, half_t* __restrict__ dst, int K,
                               int k0, int n0, int mapmode, unsigned char* lds) {
  float* T = (float*)lds;
  const int tid = otid();
  const int nn = tid & 63;
  int col = n0 + nn;
  if (mapmode) col = win_col(col);
#pragma unroll
  for (int i = 0; i < 16; ++i) {
    int kk = (tid >> 6) + 4 * i;
    float v = 0.f;
    if (col >= 0) v = src[(size_t)(k0 + kk) * ldn + col];
    T[kk * 65 + nn] = v;
  }
  __syncthreads();
#pragma unroll
  for (int i = 0; i < 2; ++i) {
    int n2 = (tid >> 3) + 32 * i;
    int kc = tid & 7;
    h8 o;
#pragma unroll
    for (int q = 0; q < 8; ++q) o[q] = (half_t)T[(kc * 8 + q) * 65 + n2];
    *(h8*)(dst + (size_t)(n0 + n2) * K + k0 + kc * 8) = o;
  }
  __syncthreads();
}

__device__ void phase_prologue(const Params& p, unsigned char* lds) {
  const int tid = otid();
  half_t* WinT = (half_t*)(p.ws + OFF_WINT);
  half_t* WbrT = (half_t*)(p.ws + OFF_WBRT);
  half_t* WoutT = (half_t*)(p.ws + OFF_WOUTT);
  float* MOD = (float*)(p.ws + OFF_MOD);
  float* RT = (float*)(p.ws + OFF_RT);
  float* DT = (float*)(p.ws + OFF_DT);
  const int T_WIN = 4 * 124 * 16;
  const int T_WBR = 12 * 16 * 8;
  const int T_WOUT = 4 * 16 * 16;
  const int T_MOD = 192;
  const int T_ROPE = 16384 * 40 / 256;
  const int total = T_WIN + T_WBR + T_WOUT + T_MOD + T_ROPE;
  for (int task = blockIdx.x; task < total; task += gridDim.x) {
    int t = task;
    if (t < T_WIN) {
      int l = t / (124 * 16); int r = t % (124 * 16); int nt = r / 16, kt = r % 16;
      transpose_tile(p.w_in + (size_t)l * 1024 * NIN, NIN, WinT + (size_t)l * NPAD * WP, WP, kt * 64, nt * 64, 1, lds);
      continue;
    }
    t -= T_WIN;
    if (t < T_WBR) {
      int lb = t / 128; int r = t % 128; int nt = r / 8, kt = r % 8;
      int l = lb / 3, b = lb % 3;
      const float* src = (b == 0 ? p.w_br_ret : (b == 1 ? p.w_br_dsa : p.w_br_gla)) + (size_t)l * 512 * 1024;
      transpose_tile(src, 1024, WbrT + (size_t)lb * 1024 * WBP, WBP, kt * 64, nt * 64, 0, lds);
      continue;
    }
    t -= T_WBR;
    if (t < T_WOUT) {
      int l = t / 256; int r = t % 256; int nt = r / 16, kt = r % 16;
      transpose_tile(p.w_out + (size_t)l * 1024 * 1024, 1024, WoutT + (size_t)l * 1024 * WP, WP, kt * 64, nt * 64, 0, lds);
      continue;
    }
    t -= T_WOUT;
    if (t < T_MOD) {
      int l = t / 48, jb = t % 48;
      int j = jb * 64 + (tid & 63);
      int ig = tid >> 6;
      float acc = 0.f;
      const float* aw = p.ada_w + (size_t)l * 1024 * 3072;
      for (int i = ig * 256; i < ig * 256 + 256; ++i) {
        float cv = p.c[i];
        float sc = cv / (1.f + expf(-cv));
        acc += sc * aw[(size_t)i * 3072 + j];
      }
      float* red = (float*)lds;
      red[tid] = acc;
      __syncthreads();
      if (tid < 64) {
        float s = red[tid] + red[tid + 64] + red[tid + 128] + red[tid + 192];
        MOD[l * 3072 + j] = s + p.ada_b[l * 3072 + j];
      }
      __syncthreads();
      continue;
    }
    t -= T_MOD;
    {
      int e = t * 256 + tid;
      int tok = e / 40, f = e % 40;
      float pf = (float)p.pos[tok];
      if (f < 32) {
        float fr = powf(10000.0f, -(float)f * 2.0f / 64.0f);
        float ang = pf * fr;
        RT[tok * 64 + f * 2] = cosf(ang);
        RT[tok * 64 + f * 2 + 1] = sinf(ang);
      } else {
        int g = f - 32;
        float fr = powf(500000.0f, -(float)g * 2.0f / 16.0f);
        float ang = pf * fr;
        DT[tok * 16 + g * 2] = cosf(ang);
        DT[tok * 16 + g * 2 + 1] = sinf(ang);
      }
    }
  }
}

__device__ __forceinline__ void write_h_row(const float (&xv)[16], const float* __restrict__ pre,
                                            const float* __restrict__ mod, half_t* __restrict__ hrow, int l) {
  float ss = 0.f;
#pragma unroll
  for (int i = 0; i < 16; ++i) ss += xv[i] * xv[i];
  ss = wave_sum(ss);
  float rs = rsqrtf(ss * (1.0f / 1024.0f) + 1e-6f);
#pragma unroll
  for (int i = 0; i < 4; ++i) {
    int c0 = i * 256 + l * 4;
    f4v pg = *(const f4v*)(pre + c0);
    f4v sh = *(const f4v*)(mod + c0);
    f4v sc = *(const f4v*)(mod + 1024 + c0);
    h4 o;
#pragma unroll
    for (int q = 0; q < 4; ++q) o[q] = (half_t)(xv[i * 4 + q] * rs * pg[q] * (1.f + sc[q]) + sh[q]);
    *(h4*)(hrow + c0) = o;
  }
}

__device__ void phase_h0(const Params& p) {
  const int w = otid() >> 6, l = otid() & 63;
  half_t* H = (half_t*)(p.ws + OFF_H);
  const float* MOD = (const float*)(p.ws + OFF_MOD);
  for (int row = blockIdx.x * 4 + w; row < S_LEN; row += gridDim.x * 4) {
    float xv[16];
#pragma unroll
    for (int i = 0; i < 4; ++i) {
      f4v v = *(const f4v*)(p.x + (size_t)row * 1024 + i * 256 + l * 4);
      xv[i * 4] = v[0]; xv[i * 4 + 1] = v[1]; xv[i * 4 + 2] = v[2]; xv[i * 4 + 3] = v[3];
    }
    write_h_row(xv, p.pre_norm, MOD, H + (size_t)row * HP, l);
  }
}

__device__ __forceinline__ void lds_barrier() {
  asm volatile("s_waitcnt lgkmcnt(0)" ::: "memory");
  __builtin_amdgcn_s_barrier();
  asm volatile("" ::: "memory");
}
#define GEMM_BUF 55296
#define GEMM_EOFF 110592
template <int NT>
__device__ __forceinline__ void gemm_step(f16v (&acc)[4][NT], h8 (&ra)[8], h8 (&rb)[2 * NT],
                                          const unsigned char* As, const unsigned char* Bs, unsigned char* Aw, unsigned char* Bw,
                                          const half_t* __restrict__ A, int lda, const half_t* __restrict__ B, int ldb, int kload,
                                          int wm, int wn, int l, int r0, int kc) {
  h8 af[2][4], bf[2][NT];
#pragma unroll
  for (int i = 0; i < 4; ++i) af[0][i] = *(const h8*)(As + (wm * 128 + i * 32 + (l & 31)) * 144 + (l >> 5) * 16);
#pragma unroll
  for (int j = 0; j < NT; ++j) bf[0][j] = *(const h8*)(Bs + (wn * 32 * NT + j * 32 + (l & 31)) * 144 + (l >> 5) * 16);
#pragma unroll
  for (int ks = 0; ks < 4; ++ks) {
    if (ks < 3) {
#pragma unroll
      for (int i = 0; i < 4; ++i) af[(ks + 1) & 1][i] = *(const h8*)(As + (wm * 128 + i * 32 + (l & 31)) * 144 + (ks + 1) * 32 + (l >> 5) * 16);
#pragma unroll
      for (int j = 0; j < NT; ++j) bf[(ks + 1) & 1][j] = *(const h8*)(Bs + (wn * 32 * NT + j * 32 + (l & 31)) * 144 + (ks + 1) * 32 + (l >> 5) * 16);
    }
#pragma unroll
    for (int i = 0; i < 4; ++i)
#pragma unroll
      for (int j = 0; j < NT; ++j) acc[i][j] = mfma16(af[ks & 1][i], bf[ks & 1][j], acc[i][j]);
#pragma unroll
    for (int i = 2 * ks; i < 2 * ks + 2; ++i) {
      *(h8*)(Aw + (r0 + 32 * i) * 144 + kc * 16) = ra[i];
      ra[i] = *(const h8*)(A + (size_t)(r0 + 32 * i) * lda + kload + kc * 8);
    }
    if (NT == 2) {
      *(h8*)(Bw + (r0 + 32 * ks) * 144 + kc * 16) = rb[ks];
      rb[ks] = *(const h8*)(B + (size_t)(r0 + 32 * ks) * ldb + kload + kc * 8);
    } else {
#pragma unroll
      for (int i = 2 * ks; i < 2 * ks + 2; ++i) {
        *(h8*)(Bw + (r0 + 32 * i) * 144 + kc * 16) = rb[i];
        rb[i] = *(const h8*)(B + (size_t)(r0 + 32 * i) * ldb + kload + kc * 8);
      }
    }
  }
}
template <int NT>
__device__ __forceinline__ void gemm_issue(h8 (&ra0)[8], h8 (&rb0)[2 * NT], h8 (&ra1)[8], h8 (&rb1)[2 * NT],
                                           const half_t* __restrict__ A, int lda, const half_t* __restrict__ B, int ldb) {
  const int tid = otid();
  const int kc = tid & 7, r0 = tid >> 3;
#pragma unroll
  for (int i = 0; i < 8; ++i) ra0[i] = *(const h8*)(A + (size_t)(r0 + 32 * i) * lda + kc * 8);
#pragma unroll
  for (int i = 0; i < 2 * NT; ++i) rb0[i] = *(const h8*)(B + (size_t)(r0 + 32 * i) * ldb + kc * 8);
#pragma unroll
  for (int i = 0; i < 8; ++i) ra1[i] = *(const h8*)(A + (size_t)(r0 + 32 * i) * lda + 64 + kc * 8);
#pragma unroll
  for (int i = 0; i < 2 * NT; ++i) rb1[i] = *(const h8*)(B + (size_t)(r0 + 32 * i) * ldb + 64 + kc * 8);
}
template <int NT>
__device__ __forceinline__ void gemm_run(f16v (&acc)[4][NT], h8 (&ra0)[8], h8 (&rb0)[2 * NT], h8 (&ra1)[8], h8 (&rb1)[2 * NT],
                                         const half_t* __restrict__ A, int lda, const half_t* __restrict__ B, int ldb, int K, unsigned char* lds) {
  const int tid = otid(), w = tid >> 6, l = tid & 63;
  unsigned char* A0 = lds;
  unsigned char* B0 = lds + 256 * 144;
  unsigned char* A1 = lds + GEMM_BUF;
  unsigned char* B1 = lds + GEMM_BUF + 256 * 144;
  const int wm = w >> 1, wn = w & 1;
  const int kc = tid & 7;
  const int r0 = tid >> 3;
  lds_barrier();
#pragma unroll
  for (int i = 0; i < 8; ++i) { *(h8*)(A0 + (r0 + 32 * i) * 144 + kc * 16) = ra0[i]; ra0[i] = *(const h8*)(A + (size_t)(r0 + 32 * i) * lda + 128 + kc * 8); }
#pragma unroll
  for (int i = 0; i < 2 * NT; ++i) { *(h8*)(B0 + (r0 + 32 * i) * 144 + kc * 16) = rb0[i]; rb0[i] = *(const h8*)(B + (size_t)(r0 + 32 * i) * ldb + 128 + kc * 8); }
  lds_barrier();
  const int nk = K / 64;
#pragma unroll 1
  for (int kt = 0; kt < nk; kt += 2) {
    gemm_step<NT>(acc, ra1, rb1, A0, B0, A1, B1, A, lda, B, ldb, (kt + 3 < nk) ? (kt + 3) * 64 : 0, wm, wn, l, r0, kc);
    lds_barrier();
    gemm_step<NT>(acc, ra0, rb0, A1, B1, A0, B0, A, lda, B, ldb, (kt + 4 < nk) ? (kt + 4) * 64 : 0, wm, wn, l, r0, kc);
    lds_barrier();
  }
}
template <int NT>
__device__ __forceinline__ void gemm_kloop(f16v (&acc)[4][NT], const half_t* __restrict__ A, int lda,
                                           const half_t* __restrict__ B, int ldb, int K, unsigned char* lds) {
  h8 ra0[8], rb0[2 * NT], ra1[8], rb1[2 * NT];
  gemm_issue<NT>(ra0, rb0, ra1, rb1, A, lda, B, ldb);
  gemm_run<NT>(acc, ra0, rb0, ra1, rb1, A, lda, B, ldb, K, lds);
}

template <int NT>
__device__ __forceinline__ void zero_acc(f16v (&acc)[4][NT]) {
#pragma unroll
  for (int i = 0; i < 4; ++i)
#pragma unroll
    for (int j = 0; j < NT; ++j)
#pragma unroll
      for (int r = 0; r < 16; ++r) acc[i][j][r] = 0.f;
}

__device__ __forceinline__ void stage_pair(float* E, const f16v& a0, const f16v& a1, int l) {
#pragma unroll
  for (int r = 0; r < 16; ++r) {
    const int rr = crow(r, l);
    E[rr * 65 + (l & 31)] = a0[r];
    E[rr * 65 + 32 + (l & 31)] = a1[r];
  }
}

__device__ __forceinline__ int xcc_census(const unsigned* xcnt, int my_xcc) {
  unsigned sum = 0; bool ok = my_xcc < 8; int mine = 0;
#pragma unroll
  for (int j = 0; j < 16; ++j) {
    const unsigned c = __hip_atomic_load(xcnt + j, __ATOMIC_RELAXED, __HIP_MEMORY_SCOPE_AGENT);
    sum += c;
    if (j < 8 && c == 0u) ok = false;
    if (j >= 8 && c != 0u) ok = false;
    if (j == my_xcc) mine = (int)c;
  }
  if (sum != gridDim.x) ok = false;
  return ok ? mine : 0;
}

__device__ void phase_A(const Params& p, int layer, unsigned char* lds, int my_xcc, int my_loc, const unsigned* xcnt) {
  const int tid = otid(), w = tid >> 6, l = tid & 63;
  const half_t* H = (const half_t*)(p.ws + OFF_H);
  const half_t* Wt = (const half_t*)(p.ws + OFF_WINT) + (size_t)layer * NPAD * WP;
  half_t* P = (half_t*)(p.ws + OFF_P);
  float* GA = (float*)(p.ws + OFF_GA);
  float* IW = (float*)(p.ws + OFF_IW);
  const float* RT = (const float*)(p.ws + OFF_RT);
  const float* DT = (const float*)(p.ws + OFF_DT);
  const int wm = w >> 1, wn = w & 1;
  const int G = gridDim.x;
  const int ntiles = 64 * 62;
  const int nx = xcc_census(xcnt, my_xcc);
  int nmine;
  if (nx > 0) nmine = (my_loc < 496) ? (496 - my_loc + nx - 1) / nx : 0;
  else nmine = ((int)blockIdx.x < ntiles) ? (ntiles - (int)blockIdx.x + G - 1) / G : 0;
  h8 ra0[8], rb0[4], ra1[8], rb1[4];
  int mt = 0, nt = 0;
  if (nmine > 0) {
    if (nx > 0) { const int s0 = my_loc; mt = my_xcc * 8 + (s0 & 7); nt = s0 >> 3; }
    else { const int tix = blockIdx.x; mt = tix & 63; nt = tix >> 6; }
    gemm_issue<2>(ra0, rb0, ra1, rb1, H + (size_t)mt * 256 * HP, HP, Wt + (size_t)nt * 128 * WP, WP);
  }
#pragma unroll 1
  for (int rnd = 0; rnd < nmine; ++rnd) {
    f16v acc[4][2];
    zero_acc<2>(acc);
    gemm_run<2>(acc, ra0, rb0, ra1, rb1, H + (size_t)mt * 256 * HP, HP, Wt + (size_t)nt * 128 * WP, WP, 1024, lds);
    const int mt_cur = mt, nt_cur = nt;
    if (rnd + 1 < nmine) {
      if (nx > 0) { const int s1 = my_loc + nx * (rnd + 1); mt = my_xcc * 8 + (s1 & 7); nt = s1 >> 3; }
      else { const int tix = (rnd + 1) * G + blockIdx.x; mt = tix & 63; nt = tix >> 6; }
      gemm_issue<2>(ra0, rb0, ra1, rb1, H + (size_t)mt * 256 * HP, HP, Wt + (size_t)nt * 128 * WP, WP);
    }
    const int m0w = mt_cur * 256 + wm * 128;
    const int n0w = nt_cur * 128 + wn * 64;
    float* E = (float*)(lds + GEMM_EOFF) + w * (32 * 65);
    const int prow = l >> 3, c0 = (l & 7) * 8;
    {
      const int jp = 0;
      const int nb2 = n0w + jp * 64;
      const int n0 = nb2 + c0;
      const bool rope64 = nb2 < 512;
      const bool rope16 = ((nb2 >= C_DSAQ && nb2 < C_DSAV) || (nb2 >= C_IDXQ && nb2 < C_GLAQ)) && (c0 < 16);
      float scale = 1.f;
      if (n0 < 256 || (n0 >= C_DSAQ && n0 < C_DSAK) || (n0 >= C_IDXQ && n0 < C_IDXK) || (n0 >= C_GLAQ && n0 < C_GLAK)) scale = 0.125f;
      int mode = 0;
      if ((n0 >= C_RETG && n0 < C_DSAQ) || (n0 >= C_DSAG && n0 < C_IDXQ) || (n0 >= C_GLAG && n0 < C_GLAA)) mode = 1;
      if (n0 >= C_MRG && n0 < C_END) mode = 2;
#pragma unroll
      for (int i = 0; i < 4; ++i) {
        stage_pair(E, acc[i][2 * jp], acc[i][2 * jp + 1], l);
#pragma unroll 1
        for (int ps = 0; ps < 4; ++ps) {
          const int rl = ps * 8 + prow;
          const int row = m0w + i * 32 + rl;
          float v[8], o[8];
#pragma unroll
          for (int q = 0; q < 8; ++q) { v[q] = E[rl * 65 + c0 + q]; o[q] = v[q]; }
          if (rope64) {
            const int cp = c0 ^ 32;
            const float* tb = RT + (size_t)row * 64 + (c0 & 31) * 2;
#pragma unroll
            for (int q = 0; q < 8; ++q) {
              const float pv = E[rl * 65 + cp + q];
              const float cs = tb[2 * q], sn = tb[2 * q + 1];
              o[q] = (c0 < 32) ? (v[q] * cs - pv * sn) : (v[q] * cs + pv * sn);
            }
          } else if (rope16) {
            const int cp = c0 ^ 8;
            const float* tb = DT + (size_t)row * 16;
#pragma unroll
            for (int q = 0; q < 8; ++q) {
              const float pv = E[rl * 65 + cp + q];
              const float cs = tb[2 * q], sn = tb[2 * q + 1];
              o[q] = (c0 < 8) ? (v[q] * cs - pv * sn) : (v[q] * cs + pv * sn);
            }
          }
          h8 ov;
#pragma unroll
          for (int q = 0; q < 8; ++q) {
            float t = o[q] * scale;
            if (mode == 1) t = t / (1.f + __expf(-t));
            else if (mode == 2) t = 1.f / (1.f + __expf(-t));
            ov[q] = (half_t)t;
          }
          if (n0 < C_END) __builtin_nontemporal_store(ov, (h8*)(P + (size_t)row * PP + n0));
          if (n0 >= C_GLAA && n0 < C_MRG) {
#pragma unroll
            for (int q = 0; q < 8; ++q) GA[(size_t)row * 16 + (n0 - C_GLAA) + q] = v[q];
          }
          if (n0 == C_IDXW) {
#pragma unroll
            for (int q = 0; q < 4; ++q) IW[(size_t)row * 4 + q] = 0.5f * v[q];
          }
        }
      }
    }
  }
}

#define LA_BC 0
#define LA_GAS 16640
#define LA_WL 20736
#define LA_QT 24832
#define LA_KT 34048
#define LA_AT 43264
#define LA_VT 52480
#define LA_SS 70912
#define LA_OS 89344
#define LA_SEG 123136

__device__ void la_bcum(const Params& p, int layer, int n, int Hh, unsigned char* lds) {
  const int tid = otid();
  float* Bc = (float*)(lds + LA_BC);
  const int d = tid & 63, q = tid >> 6;
  if (Hh < 4) {
    float lg = log1pf(-exp2f(-5.0f - (float)Hh));
#pragma unroll
    for (int jj = 0; jj < 16; ++jj) { int j = q * 16 + jj; Bc[j * 65 + d] = (float)(j + 1) * lg; }
    __syncthreads();
    return;
  }
  const int h = Hh - 4;
  float* GAs = (float*)(lds + LA_GAS);
  float* WL = (float*)(lds + LA_WL);
  float* SEG = (float*)(lds + LA_SEG);
  const float* GA = (const float*)(p.ws + OFF_GA);
#pragma unroll
  for (int i = 0; i < 4; ++i) {
    int e = tid + 256 * i;
    GAs[e] = GA[(size_t)n * 64 * 16 + e];
    int r = e >> 6, dd = e & 63;
    WL[e] = p.gla_w_lr[(size_t)layer * 16 * 256 + r * 256 + h * 64 + dd];
  }
  __syncthreads();
  float wl[16];
#pragma unroll
  for (int r = 0; r < 16; ++r) wl[r] = WL[r * 64 + d];
  const float bl = p.gla_b_lr[layer * 256 + h * 64 + d];
  float run = 0.f;
#pragma unroll
  for (int jj = 0; jj < 16; ++jj) {
    int j = q * 16 + jj;
    float z = bl;
#pragma unroll
    for (int r = 0; r < 16; ++r) z += GAs[j * 16 + r] * wl[r];
    float ls = fminf(z, 0.f) - log1pf(expf(-fabsf(z)));
    run += ls * (1.0f / 16.0f);
    Bc[j * 65 + d] = run;
  }
  SEG[q * 64 + d] = run;
  __syncthreads();
  float off = 0.f;
  for (int qq = 0; qq < q; ++qq) off += SEG[qq * 64 + d];
  if (q > 0) {
#pragma unroll
    for (int jj = 0; jj < 16; ++jj) { int j = q * 16 + jj; Bc[j * 65 + d] += off; }
  }
  __syncthreads();
}

__device__ __forceinline__ void la_stage_vt(const half_t* __restrict__ P, int t0, int vcol, unsigned char* lds) {
  const int tid = otid(), w = tid >> 6, l = tid & 63;
  half_t* VT = (half_t*)(lds + LA_VT);
  const int jp = l & 31, cgp = l >> 5;
#pragma unroll
  for (int it = 0; it < 2; ++it) {
    int c = it * 8 + w * 2 + cgp;
    h8 v0 = *(const h8*)(P + (size_t)(t0 + 2 * jp) * PP + vcol + c * 8);
    h8 v1 = *(const h8*)(P + (size_t)(t0 + 2 * jp + 1) * PP + vcol + c * 8);
#pragma unroll
    for (int q = 0; q < 8; ++q) {
      h2 pr; pr[0] = v0[q]; pr[1] = v1[q];
      *(h2*)(VT + (c * 8 + q) * 72 + 2 * jp) = pr;
    }
  }
}

__device__ void la_item_kv(const Params& p, int layer, int item, unsigned char* lds) {
  const int tid = otid(), w = tid >> 6, l = tid & 63;
  const int n = item >> 3, Hh = item & 7;
  const int t0 = n * 64;
  const half_t* P = (const half_t*)(p.ws + OFF_P);
  float* ST = (float*)(p.ws + OFF_ST);
  float* DEC = (float*)(p.ws + OFF_DEC);
  const int kcol = (Hh < 4) ? (C_RETK + Hh * 64) : (C_GLAK + (Hh - 4) * 64);
  const int vcol = (Hh < 4) ? (C_RETV + Hh * 128) : (C_GLAV + (Hh - 4) * 128);
  __syncthreads();
  la_bcum(p, layer, n, Hh, lds);
  const float* Bc = (const float*)(lds + LA_BC);
  half_t* KhT = (half_t*)(lds + LA_KT);
  half_t* VT = (half_t*)(lds + LA_VT);
  {
    const int jp = l & 31, cgp = l >> 5;
    int c = w * 2 + cgp;
    h8 k0 = *(const h8*)(P + (size_t)(t0 + 2 * jp) * PP + kcol + c * 8);
    h8 k1 = *(const h8*)(P + (size_t)(t0 + 2 * jp + 1) * PP + kcol + c * 8);
#pragma unroll
    for (int q = 0; q < 8; ++q) {
      int d = c * 8 + q;
      float bl = Bc[63 * 65 + d];
      h2 pr;
      pr[0] = (half_t)((float)k0[q] * __expf(bl - Bc[(2 * jp) * 65 + d]));
      pr[1] = (half_t)((float)k1[q] * __expf(bl - Bc[(2 * jp + 1) * 65 + d]));
      *(h2*)(KhT + d * 72 + 2 * jp) = pr;
    }
  }
  la_stage_vt(P, t0, vcol, lds);
  if (tid < 64) DEC[(size_t)item * 64 + tid] = __expf(Bc[63 * 65 + tid]);
  __syncthreads();
  f16v acc[2];
#pragma unroll
  for (int j = 0; j < 2; ++j)
#pragma unroll
    for (int r = 0; r < 16; ++r) acc[j][r] = 0.f;
#pragma unroll
  for (int ks = 0; ks < 4; ++ks) {
    h8 a = *(const h8*)(VT + (32 * w + (l & 31)) * 72 + ks * 16 + (l >> 5) * 8);
#pragma unroll
    for (int j = 0; j < 2; ++j) {
      h8 b = *(const h8*)(KhT + (j * 32 + (l & 31)) * 72 + ks * 16 + (l >> 5) * 8);
      acc[j] = mfma16(a, b, acc[j]);
    }
  }
#pragma unroll
  for (int j = 0; j < 2; ++j)
#pragma unroll
    for (int r = 0; r < 16; ++r) {
      int e = 32 * w + crow(r, l);
      int d = j * 32 + (l & 31);
      ST[(size_t)item * 8192 + e * 64 + d] = acc[j][r];
    }
}

__device__ void phase_scan(const Params& p) {
  float* ST = (float*)(p.ws + OFF_ST);
  const float* DEC = (const float*)(p.ws + OFF_DEC);
  for (int f = blockIdx.x * NTHREADS + otid(); f < 65536; f += gridDim.x * NTHREADS) {
    const int Hh = f >> 13, d = f & 63;
    float s = 0.f;
    for (int n0 = 0; n0 < 256; n0 += 16) {
      float kv[16], dc[16];
#pragma unroll
      for (int u = 0; u < 16; ++u) {
        kv[u] = ST[(size_t)(n0 + u) * 65536 + f];
        dc[u] = DEC[(size_t)((n0 + u) * 8 + Hh) * 64 + d];
      }
#pragma unroll
      for (int u = 0; u < 16; ++u) {
        ST[(size_t)(n0 + u) * 65536 + f] = s;
        s = dc[u] * s + kv[u];
      }
    }
  }
}

__device__ void la_item_out(const Params& p, int layer, int item, unsigned char* lds) {
  const int tid = otid(), w = tid >> 6, l = tid & 63;
  const int n = item >> 3, Hh = item & 7;
  const int t0 = n * 64;
  const half_t* P = (const half_t*)(p.ws + OFF_P);
  const float* ST = (const float*)(p.ws + OFF_ST);
  half_t* BR = (half_t*)(p.ws + OFF_BR);
  const int qcol = (Hh < 4) ? (C_RETQ + Hh * 64) : (C_GLAQ + (Hh - 4) * 64);
  const int kcol = (Hh < 4) ? (C_RETK + Hh * 64) : (C_GLAK + (Hh - 4) * 64);
  const int vcol = (Hh < 4) ? (C_RETV + Hh * 128) : (C_GLAV + (Hh - 4) * 128);
  const int gcol = (Hh < 4) ? (C_RETG + Hh * 128) : (C_GLAG + (Hh - 4) * 128);
  const int ocol = (Hh < 4) ? (Hh * 128) : (1024 + (Hh - 4) * 128);
  __syncthreads();
  la_bcum(p, layer, n, Hh, lds);
  const float* Bc = (const float*)(lds + LA_BC);
  half_t* Qt = (half_t*)(lds + LA_QT);
  half_t* Kt = (half_t*)(lds + LA_KT);
  half_t* AT = (half_t*)(lds + LA_AT);
  half_t* VT = (half_t*)(lds + LA_VT);
  half_t* SS = (half_t*)(lds + LA_SS);
  float* OS = (float*)(lds + LA_OS);
#pragma unroll
  for (int it = 0; it < 2; ++it) {
    int c = tid + 256 * it;
    int row = c >> 3, kc = c & 7;
    h8 qv = *(const h8*)(P + (size_t)(t0 + row) * PP + qcol + kc * 8);
    h8 kv = *(const h8*)(P + (size_t)(t0 + row) * PP + kcol + kc * 8);
    h8 qo, ko;
#pragma unroll
    for (int q = 0; q < 8; ++q) {
      float b = Bc[row * 65 + kc * 8 + q];
      qo[q] = (half_t)((float)qv[q] * __expf(b));
      ko[q] = (half_t)((float)kv[q] * __expf(-b));
    }
    *(h8*)(Qt + row * 72 + kc * 8) = qo;
    *(h8*)(Kt + row * 72 + kc * 8) = ko;
  }
  la_stage_vt(P, t0, vcol, lds);
#pragma unroll
  for (int it = 0; it < 4; ++it) {
    int c = tid + 256 * it;
    int e = c >> 3, kc = c & 7;
    const float* sp = ST + (size_t)item * 8192 + e * 64 + kc * 8;
    f4v s0 = *(const f4v*)sp, s1 = *(const f4v*)(sp + 4);
    h8 o;
    o[0] = (half_t)s0[0]; o[1] = (half_t)s0[1]; o[2] = (half_t)s0[2]; o[3] = (half_t)s0[3];
    o[4] = (half_t)s1[0]; o[5] = (half_t)s1[1]; o[6] = (half_t)s1[2]; o[7] = (half_t)s1[3];
    *(h8*)(SS + e * 72 + kc * 8) = o;
  }
  __syncthreads();
  {
    const int mi = w >> 1, nj = w & 1;
    f16v acc;
#pragma unroll
    for (int r = 0; r < 16; ++r) acc[r] = 0.f;
#pragma unroll
    for (int ks = 0; ks < 4; ++ks) {
      h8 a = *(const h8*)(Qt + (mi * 32 + (l & 31)) * 72 + ks * 16 + (l >> 5) * 8);
      h8 b = *(const h8*)(Kt + (nj * 32 + (l & 31)) * 72 + ks * 16 + (l >> 5) * 8);
      acc = mfma16(a, b, acc);
    }
#pragma unroll
    for (int r = 0; r < 16; ++r) {
      int i = mi * 32 + crow(r, l);
      int j = nj * 32 + (l & 31);
      float v = (j <= i) ? acc[r] : 0.f;
      AT[i * 72 + j] = (half_t)v;
    }
  }
  __syncthreads();
  {
    const int mi = w >> 1, nh = w & 1;
    f16v acc[2];
#pragma unroll
    for (int j = 0; j < 2; ++j)
#pragma unroll
      for (int r = 0; r < 16; ++r) acc[j][r] = 0.f;
#pragma unroll
    for (int ks = 0; ks < 4; ++ks) {
      h8 a1 = *(const h8*)(AT + (mi * 32 + (l & 31)) * 72 + ks * 16 + (l >> 5) * 8);
      h8 a2 = *(const h8*)(Qt + (mi * 32 + (l & 31)) * 72 + ks * 16 + (l >> 5) * 8);
#pragma unroll
      for (int j = 0; j < 2; ++j) {
        h8 b1 = *(const h8*)(VT + (nh * 64 + j * 32 + (l & 31)) * 72 + ks * 16 + (l >> 5) * 8);
        h8 b2 = *(const h8*)(SS + (nh * 64 + j * 32 + (l & 31)) * 72 + ks * 16 + (l >> 5) * 8);
        acc[j] = mfma16(a1, b1, acc[j]);
        acc[j] = mfma16(a2, b2, acc[j]);
      }
    }
#pragma unroll
    for (int j = 0; j < 2; ++j)
#pragma unroll
      for (int r = 0; r < 16; ++r) {
        int i = mi * 32 + crow(r, l);
        int e = nh * 64 + j * 32 + (l & 31);
        OS[i * 132 + e] = acc[j][r];
      }
  }
  __syncthreads();
  {
    const int i = tid >> 2, qd = tid & 3;
    float ov[32];
    float ss = 0.f;
#pragma unroll
    for (int c = 0; c < 8; ++c) {
      f4v v = *(const f4v*)(OS + i * 132 + qd * 32 + c * 4);
      ov[c * 4] = v[0]; ov[c * 4 + 1] = v[1]; ov[c * 4 + 2] = v[2]; ov[c * 4 + 3] = v[3];
      ss += v[0] * v[0] + v[1] * v[1] + v[2] * v[2] + v[3] * v[3];
    }
    ss += __shfl_xor(ss, 1);
    ss += __shfl_xor(ss, 2);
    float rs = rsqrtf(ss * (1.0f / 128.0f) + 1e-6f);
#pragma unroll
    for (int c = 0; c < 4; ++c) {
      h8 g = *(const h8*)(P + (size_t)(t0 + i) * PP + gcol + qd * 32 + c * 8);
      h8 o;
#pragma unroll
      for (int q = 0; q < 8; ++q) o[q] = (half_t)(ov[c * 8 + q] * rs * (float)g[q]);
      *(h8*)(BR + (size_t)(t0 + i) * 1536 + ocol + qd * 32 + c * 8) = o;
    }
  }
}

#define DS_CAP 640
#define DS_PRUNE_AT 512
#define NPL 10
#define DS_LS 0
#define DS_LI (32 * DS_CAP * 4)
#define DS_CNT (32 * DS_CAP * 6)
#define DS_THR (DS_CNT + 128)
#define DS_WQ (DS_CNT + 256)
#define DS_HIST (DS_CNT + 1024)
#define DS_PW (DS_CNT + 1024 + 4096)

__device__ __forceinline__ unsigned long long wave_or64(unsigned long long v) {
  const unsigned lo = wave_or((unsigned)v), hi = wave_or((unsigned)(v >> 32));
  return ((unsigned long long)hi << 32) | lo;
}
__device__ __forceinline__ void dsa_prune(float* LSm, unsigned short* LIm, int n, unsigned* hist, int* cntm, float* thrm, int l) {
  unsigned long long comp[NPL];
  bool act[NPL], val[NPL];
#pragma unroll
  for (int k = 0; k < NPL; ++k) {
    int e = l + 64 * k;
    val[k] = e < n;
    unsigned u = 0, li = 0;
    if (val[k]) { u = __float_as_uint(LSm[e]); li = LIm[e]; }
    const unsigned key = (u >> 31) ? ~u : (u | 0x80000000u);
    comp[k] = ((unsigned long long)key << 14) | (unsigned long long)(16383u - li);
    act[k] = val[k];
  }
  const unsigned long long c0 = ((unsigned long long)(unsigned)__builtin_amdgcn_readfirstlane((int)(unsigned)(comp[0] >> 32)) << 32) | (unsigned)__builtin_amdgcn_readfirstlane((int)(unsigned)comp[0]);
  unsigned long long x = 0;
#pragma unroll
  for (int k = 0; k < NPL; ++k) x |= val[k] ? (comp[k] ^ c0) : 0ull;
  x = wave_or64(x);
  int shift = (x == 0ull) ? 0 : (63 - __clzll((long long)x)) - 7;
  if (shift < 0) shift = 0;
  unsigned rank = 256;
#pragma unroll 1
  for (int rd = 0; rd < 8; ++rd) {
    *(uint4*)(hist + 4 * l) = make_uint4(0, 0, 0, 0);
    __threadfence_block();
    unsigned dk[NPL];
#pragma unroll
    for (int k = 0; k < NPL; ++k) {
      dk[k] = (unsigned)(comp[k] >> shift) & 255u;
      if (act[k]) atomicAdd(&hist[dk[k]], 1u);
    }
    __threadfence_block();
    uint4 hv; hv.x = hist[4 * l]; hv.y = hist[4 * l + 1]; hv.z = hist[4 * l + 2]; hv.w = hist[4 * l + 3];
    unsigned tl = hv.x + hv.y + hv.z + hv.w;
    const unsigned pin = wave_incl_scan(tl);
    const unsigned tot = (unsigned)__builtin_amdgcn_readlane((int)pin, 63);
    unsigned sx = tot - pin;
    bool mine = (sx < rank) && (rank <= sx + tl);
    unsigned dsel = 0, nr = 0, hsel = 0;
    if (mine) {
      unsigned c = sx;
      if (c + hv.w >= rank) { dsel = 4 * l + 3; nr = rank - c; hsel = hv.w; }
      else {
        c += hv.w;
        if (c + hv.z >= rank) { dsel = 4 * l + 2; nr = rank - c; hsel = hv.z; }
        else {
          c += hv.z;
          if (c + hv.y >= rank) { dsel = 4 * l + 1; nr = rank - c; hsel = hv.y; }
          else { c += hv.y; dsel = 4 * l; nr = rank - c; hsel = hv.x; }
        }
      }
    }
    unsigned long long mk = __ballot(mine);
    int src = (mk == 0ull) ? 0 : (__ffsll((long long)mk) - 1);
    dsel = (unsigned)__builtin_amdgcn_readlane((int)dsel, src);
    rank = (unsigned)__builtin_amdgcn_readlane((int)nr, src);
    hsel = (unsigned)__builtin_amdgcn_readlane((int)hsel, src);
#pragma unroll
    for (int k = 0; k < NPL; ++k) act[k] = act[k] && (dk[k] == dsel);
    if (hsel <= 1u || shift == 0) break;
    shift = (shift >= 8) ? (shift - 8) : 0;
  }
  unsigned long long tsel = 0;
#pragma unroll
  for (int k = 0; k < NPL; ++k) tsel |= act[k] ? comp[k] : 0ull;
  const unsigned long long T = wave_or64(tsel);
  bool keep[NPL];
  unsigned cntk = 0;
#pragma unroll
  for (int k = 0; k < NPL; ++k) {
    keep[k] = val[k] && (comp[k] >= T);
    cntk += keep[k] ? 1u : 0u;
  }
  unsigned pos = wave_incl_scan(cntk) - cntk;
  __threadfence_block();
#pragma unroll
  for (int k = 0; k < NPL; ++k) {
    if (keep[k]) {
      const unsigned kk = (unsigned)(comp[k] >> 14);
      const unsigned u = (kk & 0x80000000u) ? (kk & 0x7FFFFFFFu) : ~kk;
      LSm[pos] = __uint_as_float(u);
      LIm[pos] = (unsigned short)(16383u - ((unsigned)comp[k] & 16383u));
      ++pos;
    }
  }
  if (l == 0) {
    const unsigned T32 = (unsigned)(T >> 14);
    *cntm = 256;
    *thrm = __uint_as_float((T32 & 0x80000000u) ? (T32 & 0x7FFFFFFFu) : ~T32);
  }
  __threadfence_block();
}

__device__ void dsa_item(const Params& p, int qb, unsigned char* lds) {
  const int tid = otid(), w = tid >> 6, l = tid & 63;
  const int t0 = qb * 32;
  const half_t* P = (const half_t*)(p.ws + OFF_P);
  const float* IW = (const float*)(p.ws + OFF_IW);
  half_t* BR = (half_t*)(p.ws + OFF_BR);
  float* LS = (float*)(lds + DS_LS);
  unsigned short* LI = (unsigned short*)(lds + DS_LI);
  int* cnt = (int*)(lds + DS_CNT);
  float* thr = (float*)(lds + DS_THR);
  float* wq = (float*)(lds + DS_WQ);
  unsigned* hist = (unsigned*)(lds + DS_HIST) + w * 256;
  float* PW = (float*)(lds + DS_PW) + w * 1024;
  half_t* QS = (half_t*)(lds + DS_PW + 16384) + w * 512;
  for (int rep_sel = 0; rep_sel < REP_SEL; ++rep_sel) {
  __syncthreads();
  if (tid < 32) { cnt[tid] = 0; thr[tid] = -INFINITY; }
  if (tid < 128) wq[tid] = IW[(size_t)t0 * 4 + tid];
  __syncthreads();
  h8 aq[4][4];
#pragma unroll
  for (int h = 0; h < 4; ++h)
#pragma unroll
    for (int ks = 0; ks < 4; ++ks)
      aq[h][ks] = *(const h8*)(P + (size_t)(t0 + (l & 31)) * PP + C_IDXQ + h * 64 + ks * 16 + (l >> 5) * 8);
  const int nt = qb + 1;
  const int nr = (nt + 3) >> 2;
  h8 bk[4];
  {
    const int k0 = (w < nt) ? w : 0;
#pragma unroll
    for (int ks = 0; ks < 4; ++ks)
      bk[ks] = *(const h8*)(P + (size_t)(k0 * 32 + (l & 31)) * PP + C_IDXK + ks * 16 + (l >> 5) * 8);
  }
#pragma unroll 1
  for (int rd = 0; rd < nr; ++rd) {
    const int kt = 4 * rd + w;
    h8 bkn[4];
    {
      const int kn = (kt + 4 < nt) ? (kt + 4) : 0;
#pragma unroll
      for (int ks = 0; ks < 4; ++ks)
        bkn[ks] = *(const h8*)(P + (size_t)(kn * 32 + (l & 31)) * PP + C_IDXK + ks * 16 + (l >> 5) * 8);
    }
    if (kt < nt) {
      const int sbase = kt * 32;
      f16v acc[4];
#pragma unroll
      for (int h = 0; h < 4; ++h) {
#pragma unroll
        for (int r = 0; r < 16; ++r) acc[h][r] = 0.f;
#pragma unroll
        for (int ks = 0; ks < 4; ++ks) acc[h] = mfma16(aq[h][ks], bk[ks], acc[h]);
      }
      const int s = sbase + (l & 31);
      float scv[16];
      unsigned pm = 0;
#pragma unroll
      for (int r = 0; r < 16; ++r) {
        const int m = crow(r, l);
        const f4v wv = *(const f4v*)(wq + m * 4);
        float sc = wv[0] * relu_f(acc[0][r]) + wv[1] * relu_f(acc[1][r]) + wv[2] * relu_f(acc[2][r]) + wv[3] * relu_f(acc[3][r]);
        sc += 0.0f;
        scv[r] = sc;
        const float th = thr[m];
        const bool pass = (s <= t0 + m) && (sc > th);
        pm |= pass ? (1u << r) : 0u;
      }
      if (__ballot(pm != 0u) != 0ull) {
        unsigned long long mks[16];
        int mycnt = 0;
#pragma unroll
        for (int r = 0; r < 16; ++r) {
          const unsigned long long mk = __ballot(((pm >> r) & 1u) != 0u);
          mks[r] = mk;
          const unsigned hm = (l < 32) ? (unsigned)mk : (unsigned)(mk >> 32);
          if ((l & 31) == r) mycnt = __popc(hm);
        }
        int base = 0;
        if ((l & 31) < 16 && mycnt > 0) base = atomicAdd(&cnt[crow(l & 31, l)], mycnt);
#pragma unroll
        for (int r = 0; r < 16; ++r) {
          const unsigned long long mk = mks[r];
          if (mk != 0ull) {
            const unsigned hm = (l < 32) ? (unsigned)mk : (unsigned)(mk >> 32);
            const int b_lo = __builtin_amdgcn_readlane(base, r), b_hi = __builtin_amdgcn_readlane(base, 32 + r);
            const int bb = (l < 32) ? b_lo : b_hi;
            if ((pm >> r) & 1u) {
              const int m = crow(r, l);
              const int slot = bb + __popc(hm & ((1u << (l & 31)) - 1u));
              LS[m * DS_CAP + slot] = scv[r];
              LI[m * DS_CAP + slot] = (unsigned short)s;
            }
          }
        }
      }
    }
    __syncthreads();
    {
      const int cv = (l < 32) ? cnt[l] : 0;
      unsigned pmask = (unsigned)__ballot(cv > DS_PRUNE_AT);
      int j = 0;
      while (pmask != 0u) {
        const int m = __ffs((int)pmask) - 1;
        pmask &= pmask - 1u;
        if ((j & 3) == w) dsa_prune(LS + m * DS_CAP, LI + m * DS_CAP, cnt[m], hist, cnt + m, thr + m, l);
        ++j;
      }
    }
    __syncthreads();
#pragma unroll
    for (int ks = 0; ks < 4; ++ks) bk[ks] = bkn[ks];
  }
  }
#pragma unroll 1
  for (int mm = 0; mm < 8; ++mm) {
    const int m = w * 8 + mm;
    const int c = cnt[m];
    if (c > 256) dsa_prune(LS + m * DS_CAP, LI + m * DS_CAP, c, hist, cnt + m, thr + m, l);
  }
  asm volatile("s_waitcnt lgkmcnt(0)" ::: "memory");
  for (int rep_att = 0; rep_att < REP_ATT; ++rep_att) {
  h8 kvr[4][8];
  {
    const int m = w * 8;
    const int c = min(cnt[m], 256);
    const unsigned short* LIm = LI + m * DS_CAP;
#pragma unroll
    for (int kk = 0; kk < 4; ++kk) {
      const int e = l + 64 * kk;
      const int s = (e < c) ? (int)LIm[e] : 0;
      const half_t* kr = P + (size_t)s * PP + C_DSAK;
#pragma unroll
      for (int ch = 0; ch < 8; ++ch) kvr[kk][ch] = *(const h8*)(kr + ch * 8);
    }
  }
  h8 qreg = *(const h8*)(P + (size_t)(t0 + w * 8) * PP + C_DSAQ + l * 8);
  const int dch = l & 7, ksub = l >> 3;
#pragma unroll 1
  for (int u = 0; u < 16; ++u) {
    const int mm = u >> 1, g = u & 1;
    const int m = w * 8 + mm;
    const int t = t0 + m;
    const int c = min(cnt[m], 256);
    const unsigned short* LIm = LI + m * DS_CAP;
    if (g == 0) {
      *(h8*)(QS + l * 8) = qreg;
      const int mq = (mm < 7) ? (m + 1) : m;
      qreg = *(const h8*)(P + (size_t)(t0 + mq) * PP + C_DSAQ + l * 8);
    }
    h8 gt[4];
#pragma unroll
    for (int hh = 0; hh < 4; ++hh) gt[hh] = *(const h8*)(P + (size_t)t * PP + C_DSAG + (g * 4 + hh) * 64 + dch * 8);
    h8 vv[16];
#pragma unroll
    for (int i = 0; i < 16; ++i) {
      const int e = i * 8 + ksub;
      const int s = (e < c) ? (int)LIm[e] : 0;
      vv[i] = *(const h8*)(P + (size_t)s * PP + C_DSAV + g * 64 + dch * 8);
    }
    asm volatile("s_waitcnt lgkmcnt(0)" ::: "memory");
    float lg[4][4];
#pragma unroll
    for (int hh = 0; hh < 4; ++hh) {
#pragma unroll
      for (int kk = 0; kk < 4; ++kk) lg[hh][kk] = 0.f;
#pragma unroll
      for (int ch = 0; ch < 8; ++ch) {
        const h8 qq = *(const h8*)(QS + (g * 4 + hh) * 64 + ch * 8);
#pragma unroll
        for (int kk = 0; kk < 4; ++kk) {
          float a = lg[hh][kk];
          a = __builtin_amdgcn_fdot2(__builtin_shufflevector(qq, qq, 0, 1), __builtin_shufflevector(kvr[kk][ch], kvr[kk][ch], 0, 1), a, false);
          a = __builtin_amdgcn_fdot2(__builtin_shufflevector(qq, qq, 2, 3), __builtin_shufflevector(kvr[kk][ch], kvr[kk][ch], 2, 3), a, false);
          a = __builtin_amdgcn_fdot2(__builtin_shufflevector(qq, qq, 4, 5), __builtin_shufflevector(kvr[kk][ch], kvr[kk][ch], 4, 5), a, false);
          a = __builtin_amdgcn_fdot2(__builtin_shufflevector(qq, qq, 6, 7), __builtin_shufflevector(kvr[kk][ch], kvr[kk][ch], 6, 7), a, false);
          lg[hh][kk] = a;
        }
      }
#pragma unroll
      for (int kk = 0; kk < 4; ++kk) lg[hh][kk] = (l + 64 * kk < c) ? lg[hh][kk] : -INFINITY;
    }
    {
      const int un = (u < 15) ? (u + 1) : 15;
      const int mn = w * 8 + (un >> 1), gn = un & 1;
      const int cn = min(cnt[mn], 256);
      const unsigned short* LIn = LI + mn * DS_CAP;
#pragma unroll
      for (int kk = 0; kk < 4; ++kk) {
        const int e = l + 64 * kk;
        const int s = (e < cn) ? (int)LIn[e] : 0;
        const half_t* kr = P + (size_t)s * PP + C_DSAK + gn * 64;
#pragma unroll
        for (int ch = 0; ch < 8; ++ch) kvr[kk][ch] = *(const h8*)(kr + ch * 8);
      }
    }
#pragma unroll
    for (int hh = 0; hh < 4; ++hh) {
      float mx = fmaxf(fmaxf(lg[hh][0], lg[hh][1]), fmaxf(lg[hh][2], lg[hh][3]));
      mx = wave_max(mx);
      float ev[4]; float sm = 0.f;
#pragma unroll
      for (int kk = 0; kk < 4; ++kk) { ev[kk] = __expf(lg[hh][kk] - mx); sm += ev[kk]; }
      sm = wave_sum(sm);
      const float inv = 1.0f / sm;
#pragma unroll
      for (int kk = 0; kk < 4; ++kk) PW[(l + 64 * kk) * 4 + hh] = ev[kk] * inv;
    }
    asm volatile("s_waitcnt lgkmcnt(0)" ::: "memory");
    float o[4][8];
#pragma unroll
    for (int hh = 0; hh < 4; ++hh)
#pragma unroll
      for (int q = 0; q < 8; ++q) o[hh][q] = 0.f;
    const int nit = (c + 7) >> 3;
#pragma unroll 1
    for (int it0 = 0; it0 < nit; it0 += 16) {
      if (it0 > 0) {
#pragma unroll
        for (int i = 0; i < 16; ++i) {
          const int e = (it0 + i) * 8 + ksub;
          const int s = (e < c) ? (int)LIm[e] : 0;
          vv[i] = *(const h8*)(P + (size_t)s * PP + C_DSAV + g * 64 + dch * 8);
        }
      }
#pragma unroll
      for (int i = 0; i < 16; ++i) {
        const int e = (it0 + i) * 8 + ksub;
        const f4v pv = *(const f4v*)(PW + e * 4);
#pragma unroll
        for (int hh = 0; hh < 4; ++hh)
#pragma unroll
          for (int q = 0; q < 8; ++q) o[hh][q] += pv[hh] * (float)vv[i][q];
      }
    }
#pragma unroll
    for (int hh = 0; hh < 4; ++hh)
#pragma unroll
      for (int q = 0; q < 8; ++q) {
        float v = o[hh][q];
        v += dppf<0x128>(v); v += __shfl_xor(v, 16); v += __shfl_xor(v, 32);
        o[hh][q] = v;
      }
    if (l < 8) {
#pragma unroll
      for (int hh = 0; hh < 4; ++hh) {
        const int col = (g * 4 + hh) * 64 + dch * 8;
        h8 ov;
#pragma unroll
        for (int q = 0; q < 8; ++q) ov[q] = (half_t)(o[hh][q] * (float)gt[hh][q]);
        *(h8*)(BR + (size_t)t * 1536 + 512 + col) = ov;
      }
    }
    asm volatile("s_waitcnt lgkmcnt(0)" ::: "memory");
  }
  }
}

__device__ void phase_B(const Params& p, int layer, unsigned char* lds) {
  const int G = gridDim.x;
  for (int j = 0; j * G < 512; ++j) {
    const int b = (j & 1) ? (G - 1 - (int)blockIdx.x) : (int)blockIdx.x;
    const int idx = j * G + b;
#ifndef NO_DSA
    if (idx < 512) dsa_item(p, 511 - idx, lds);
#endif
  }
  for (int rep = 0; rep < REP_KV; ++rep)
  for (int it = blockIdx.x; it < 2048; it += G) la_item_kv(p, layer, it, lds);
}

__device__ void phase_E1(const Params& p, int layer, unsigned char* lds, int my_xcc, int my_loc, const unsigned* xcnt) {
  const int tid = otid(), w = tid >> 6, l = tid & 63;
  const half_t* BR = (const half_t*)(p.ws + OFF_BR);
  const half_t* WbrT = (const half_t*)(p.ws + OFF_WBRT) + (size_t)layer * 3 * 1024 * WBP;
  const half_t* P = (const half_t*)(p.ws + OFF_P);
  half_t* Y1 = (half_t*)(p.ws + OFF_H);
  const int wm = w >> 1, wn = w & 1;
  float* E = (float*)(lds + GEMM_EOFF) + w * (32 * 65);
  const int prow = l >> 3, c0 = (l & 7) * 8;
  const int nx = xcc_census(xcnt, my_xcc);
  const int nrounds = (nx > 0) ? (64 + nx - 1) / nx : (512 + (int)gridDim.x - 1) / (int)gridDim.x;
  for (int rnd = 0; rnd < nrounds; ++rnd) {
    int mt, nt;
    if (nx > 0) {
      const int s = my_loc + nx * rnd;
      if (s >= 64) continue;
      mt = my_xcc * 8 + (s & 7); nt = s >> 3;
    } else {
      const int tix = rnd * (int)gridDim.x + (int)blockIdx.x;
      if (tix >= 512) continue;
      mt = tix & 63; nt = tix >> 6;
    }
    h8 tot[4][4];
#pragma unroll
    for (int i = 0; i < 4; ++i)
#pragma unroll
      for (int ps = 0; ps < 4; ++ps)
#pragma unroll
        for (int q = 0; q < 8; ++q) tot[i][ps][q] = (half_t)0.f;
    const int m0w = mt * 256 + wm * 128;
    const int n0 = nt * 128 + wn * 64 + c0;
#pragma unroll 1
    for (int b = 0; b < 3; ++b) {
      f16v acc[4][2];
      zero_acc<2>(acc);
      gemm_kloop<2>(acc, BR + (size_t)mt * 256 * 1536 + b * 512, 1536, WbrT + (size_t)b * 1024 * WBP + (size_t)nt * 128 * WBP, WBP, 512, lds);
#pragma unroll
      for (int i = 0; i < 4; ++i) {
        stage_pair(E, acc[i][0], acc[i][1], l);
#pragma unroll
        for (int ps = 0; ps < 4; ++ps) {
          const int rl = ps * 8 + prow;
          const int row = m0w + i * 32 + rl;
          const h8 g = *(const h8*)(P + (size_t)row * PP + C_MRG + b * 1024 + n0);
#pragma unroll
          for (int q = 0; q < 8; ++q) tot[i][ps][q] = (half_t)((float)tot[i][ps][q] + (float)g[q] * E[rl * 65 + c0 + q]);
        }
      }
    }
#pragma unroll
    for (int i = 0; i < 4; ++i)
#pragma unroll
      for (int ps = 0; ps < 4; ++ps) {
        const int row = m0w + i * 32 + ps * 8 + prow;
        *(h8*)(Y1 + (size_t)row * HP + n0) = tot[i][ps];
      }
  }
}

__device__ void phase_E2(const Params& p, int layer, unsigned char* lds, int my_xcc, int my_loc, const unsigned* xcnt) {
  const int tid = otid(), w = tid >> 6, l = tid & 63;
  const half_t* Y1 = (const half_t*)(p.ws + OFF_H);
  const half_t* Wo = (const half_t*)(p.ws + OFF_WOUTT) + (size_t)layer * 1024 * WP;
  float* Y = (float*)(p.ws + OFF_ST);
  const int wm = w >> 1, wn = w & 1;
  const int nx = xcc_census(xcnt, my_xcc);
  const int nrounds = (nx > 0) ? (64 + nx - 1) / nx : (512 + (int)gridDim.x - 1) / (int)gridDim.x;
  for (int rnd = 0; rnd < nrounds; ++rnd) {
    int mt, nt;
    if (nx > 0) {
      const int s = my_loc + nx * rnd;
      if (s >= 64) continue;
      mt = my_xcc * 8 + (s & 7); nt = s >> 3;
    } else {
      const int tix = rnd * (int)gridDim.x + (int)blockIdx.x;
      if (tix >= 512) continue;
      mt = tix & 63; nt = tix >> 6;
    }
    f16v acc[4][2];
    zero_acc<2>(acc);
    gemm_kloop<2>(acc, Y1 + (size_t)mt * 256 * HP, HP, Wo + (size_t)nt * 128 * WP, WP, 1024, lds);
    const int m0w = mt * 256 + wm * 128;
    const int n0w = nt * 128 + wn * 64;
#pragma unroll
    for (int i = 0; i < 4; ++i)
#pragma unroll
      for (int j = 0; j < 2; ++j)
#pragma unroll
        for (int r = 0; r < 16; ++r) {
          const int row = m0w + i * 32 + crow(r, l);
          const int n = n0w + j * 32 + (l & 31);
          Y[(size_t)row * 1024 + n] = acc[i][j][r];
        }
  }
}

__device__ void phase_E3(const Params& p, int layer) {
  const int w = otid() >> 6, l = otid() & 63;
  const float* Y = (const float*)(p.ws + OFF_ST);
  const float* MOD = (const float*)(p.ws + OFF_MOD);
  half_t* H = (half_t*)(p.ws + OFF_H);
  const float* xin = (layer == 0) ? p.x : p.out;
  const float* gate = MOD + layer * 3072 + 2048;
  const float* post = p.post_norm + layer * 1024;
  for (int row = blockIdx.x * 4 + w; row < S_LEN; row += gridDim.x * 4) {
    float yv[16], xv[16];
    float ss = 0.f;
#pragma unroll
    for (int i = 0; i < 4; ++i) {
      f4v v = *(const f4v*)(Y + (size_t)row * 1024 + i * 256 + l * 4);
      f4v xx = *(const f4v*)(xin + (size_t)row * 1024 + i * 256 + l * 4);
#pragma unroll
      for (int q = 0; q < 4; ++q) { yv[i * 4 + q] = v[q]; xv[i * 4 + q] = xx[q]; ss += v[q] * v[q]; }
    }
    ss = wave_sum(ss);
    const float rs = rsqrtf(ss * (1.0f / 1024.0f) + 1e-6f);
#pragma unroll
    for (int i = 0; i < 4; ++i) {
      const int c0 = i * 256 + l * 4;
      f4v gt = *(const f4v*)(gate + c0);
      f4v pn = *(const f4v*)(post + c0);
      f4v o;
#pragma unroll
      for (int q = 0; q < 4; ++q) { o[q] = xv[i * 4 + q] + gt[q] * (yv[i * 4 + q] * rs * pn[q]); xv[i * 4 + q] = o[q]; }
      *(f4v*)(p.out + (size_t)row * 1024 + c0) = o;
    }
    if (layer + 1 < DEPTH)
      write_h_row(xv, p.pre_norm + (layer + 1) * 1024, MOD + (layer + 1) * 3072, H + (size_t)row * HP, l);
  }
}

#define XB_TMO      128
#define XB_XCNT(j)  (256  + 64 * (j))
#define XB_XSUB(j)  (1280 + 64 * (j))
#define XB_XGEN(j)  (2304 + 64 * (j))
#define XB_TOP      3328
#define XB_TOPGEN   3392
#define XCD_BAR_WORDS 3456
#define XB_SPIN_CAP (1u << 18)
#define LAS __attribute__((address_space(3)))

__device__ __forceinline__ unsigned xb_ld(unsigned* p)              { return __hip_atomic_load(p, __ATOMIC_RELAXED, __HIP_MEMORY_SCOPE_AGENT); }
__device__ __forceinline__ unsigned xb_add(unsigned* p, unsigned v) { return __hip_atomic_fetch_add(p, v, __ATOMIC_RELAXED, __HIP_MEMORY_SCOPE_AGENT); }
__device__ __forceinline__ unsigned xb_xcc_id() { return (unsigned)__builtin_amdgcn_s_getreg((3 << 11) | 20) & 0xFu; }
#define XB_SPIN(cond, bar) do { unsigned _sp = 0; while (cond) { __builtin_amdgcn_s_sleep(1); \
    if ((++_sp & 255u) == 0u) { if (xb_ld(&(bar)[XB_TMO])) break; if (_sp > XB_SPIN_CAP) { atomicAdd(&(bar)[XB_TMO], 1u); break; } } } } while (0)

struct XcdBarrier {
    unsigned* bar; unsigned x;
    volatile LAS unsigned* st;
};

__device__ __forceinline__ XcdBarrier xcd_barrier_post(unsigned* bar, volatile LAS unsigned* st) {
    XcdBarrier b; b.bar = bar; b.x = xb_xcc_id(); b.st = st;
    if (threadIdx.x == 0) (void)xb_add(&bar[XB_XCNT(b.x)], 1u);
    return b;
}
__device__ __forceinline__ void xcd_barrier_complete(unsigned* bar, unsigned x, unsigned& nloc, unsigned& nx) {
    const unsigned G = gridDim.x * gridDim.y * gridDim.z;
    unsigned sum, cnt, mine, sp = 0u;
    for (;;) {
        sum = 0u; cnt = 0u; mine = 0u;
#pragma unroll
        for (unsigned j = 0; j < 16; ++j) { const unsigned c = xb_ld(&bar[XB_XCNT(j)]); sum += c; cnt += (c > 0u) ? 1u : 0u; mine = (j == x) ? c : mine; }
        if (sum == G) break;
        __builtin_amdgcn_s_sleep(1);
        if ((++sp & 255u) == 0u) { if (xb_ld(&bar[XB_TMO])) break; if (sp > XB_SPIN_CAP) { atomicAdd(&bar[XB_TMO], 1u); break; } }
    }
    nloc = mine > 0u ? mine : 1u; nx = cnt > 0u ? cnt : 1u;
}

__device__ __forceinline__ void xcd_barrier(const XcdBarrier& b) {
    asm volatile("s_waitcnt vmcnt(0)" ::: "memory");
    __syncthreads();
    if (threadIdx.x == 0) {
        unsigned* bar = b.bar;
        __builtin_amdgcn_s_waitcnt(0);
        unsigned nloc = b.st[0], nx = b.st[1];
        if (nloc == 0u) { xcd_barrier_complete(bar, b.x, nloc, nx); b.st[0] = nloc; b.st[1] = nx; }
        const unsigned old = xb_add(&bar[XB_XSUB(b.x)], 1u);
        const unsigned gen = old / nloc;
        if (old + 1u == (gen + 1u) * nloc) {
            __builtin_amdgcn_fence(__ATOMIC_RELEASE, "agent");
            asm volatile("s_waitcnt vmcnt(0)" ::: "memory");
            const unsigned og = xb_add(&bar[XB_TOP], 1u);
            const unsigned tg = og / nx;
            if (og + 1u == (tg + 1u) * nx) xb_add(&bar[XB_TOPGEN], 1u);
            else XB_SPIN(xb_ld(&bar[XB_TOPGEN]) == tg, bar);
            __builtin_amdgcn_fence(__ATOMIC_ACQUIRE, "agent");
            xb_add(&bar[XB_XGEN(b.x)], 1u);
            asm volatile("s_waitcnt vmcnt(0)" ::: "memory");
        } else {
            XB_SPIN(xb_ld(&bar[XB_XGEN(b.x)]) == gen, bar);
            __builtin_amdgcn_fence(__ATOMIC_ACQUIRE, "agent");
            asm volatile("s_waitcnt vmcnt(0)" ::: "memory");
        }
    }
    __syncthreads();
}


#ifndef REP_D
#define REP_D 1
#endif
#ifndef REP_E
#define REP_E 1
#endif
#ifndef REP_A
#define REP_A 1
#endif
#ifndef REP_B
#define REP_B 1
#endif
#ifdef ONLY_PHASE
#define PH_EN(x) (ONLY_PHASE == (x))
#else
#define PH_EN(x) true
#endif
__global__ void __launch_bounds__(NTHREADS) fwd_megakernel(Params p) {
  extern __shared__ __attribute__((aligned(16))) unsigned char lds[];
  cg::grid_group grid = cg::this_grid();
  unsigned* bar = (unsigned*)(p.ws + WS_END);
  unsigned* xcnt = bar + 16;
  unsigned* xbar = (unsigned*)(p.ws + WS_END + 1024);
  if (blockIdx.x == 0) {
    if (otid() < 17) __hip_atomic_store(bar + (otid() == 16 ? 0 : 16 + otid()), 0u, __ATOMIC_RELAXED, __HIP_MEMORY_SCOPE_AGENT);
    for (int i = otid(); i < XCD_BAR_WORDS; i += NTHREADS) __hip_atomic_store(xbar + i, 0u, __ATOMIC_RELAXED, __HIP_MEMORY_SCOPE_AGENT);
  }
  volatile LAS unsigned* xst = (volatile LAS unsigned*)(lds + LDS_BYTES - 16);
  if (otid() == 0) { xst[0] = 0u; xst[1] = 0u; }
  __syncthreads();
  XcdBarrier xb; xb.bar = xbar; xb.x = 0; xb.st = xst;
  int my_xcc = 0, my_loc = 0;
  for (int ph = p.ph_lo; ph < p.ph_hi; ++ph) {
    if (ph == 0) { if (PH_EN(0)) for (int rep = 0; rep < REP_P; ++rep) { phase_prologue(p, lds); __syncthreads(); } }
    else if (ph == 1) {
      xb = xcd_barrier_post(xbar, xst);
      int* sh = (int*)lds;
      if (otid() == 0) {
        const int xc = (int)(__builtin_amdgcn_s_getreg((3 << 11) | 20) & 0xFu);
        sh[0] = xc;
        sh[1] = (int)__hip_atomic_fetch_add(xcnt + xc, 1u, __ATOMIC_RELAXED, __HIP_MEMORY_SCOPE_AGENT);
      }
      __syncthreads();
      my_xcc = __builtin_amdgcn_readfirstlane(sh[0]);
      my_loc = __builtin_amdgcn_readfirstlane(sh[1]);
      __syncthreads();
      if (PH_EN(1)) phase_h0(p);
    }
    else {
      const int layer = (ph - 2) / 7, sub = (ph - 2) % 7;
      if (sub == 0) { if (PH_EN(2)) for (int rep = 0; rep < REP_A; ++rep) { phase_A(p, layer, lds, my_xcc, my_loc, xcnt); __syncthreads(); } }
      else if (sub == 1) { if (PH_EN(3)) for (int rep = 0; rep < REP_B; ++rep) { phase_B(p, layer, lds); __syncthreads(); } }
      else if (sub == 2) { if (PH_EN(4)) phase_scan(p); }
      else if (sub == 3) { if (PH_EN(5)) for (int rep = 0; rep < REP_D; ++rep) { for (int it = blockIdx.x; it < 2048; it += gridDim.x) la_item_out(p, layer, it, lds); __syncthreads(); } }
      else if (sub == 4) { if (PH_EN(6)) for (int rep = 0; rep < REP_E; ++rep) { phase_E1(p, layer, lds, my_xcc, my_loc, xcnt); __syncthreads(); } }
      else if (sub == 5) { if (PH_EN(7)) for (int rep = 0; rep < REP_E; ++rep) { phase_E2(p, layer, lds, my_xcc, my_loc, xcnt); __syncthreads(); } }
      else { if (PH_EN(8)) phase_E3(p, layer); }
    }
    if (ph + 1 < p.ph_hi) {
      if (ph == p.ph_lo) grid.sync();
      else xcd_barrier(xb);
    }
  }
}

extern "C" void kernel_launch(void* const* d_in, const int* in_sizes, int n_in, void* d_out, int out_size,
                              void* d_ws, size_t ws_size, hipStream_t stream) {
  static int grid_blocks = 0;
  if (!grid_blocks) {
    int dev = 0, cus = 0, per_cu = 0;
    hipGetDevice(&dev);
    hipDeviceGetAttribute(&cus, hipDeviceAttributeMultiprocessorCount, dev);
    hipFuncSetAttribute((const void*)fwd_megakernel, hipFuncAttributeMaxDynamicSharedMemorySize, LDS_BYTES);
    hipOccupancyMaxActiveBlocksPerMultiprocessor(&per_cu, (const void*)fwd_megakernel, NTHREADS, LDS_BYTES);
    if (per_cu < 1) per_cu = 1;
    if (per_cu > 1) per_cu = 1;
    grid_blocks = cus * per_cu;
    if (ws_size < WS_END) fprintf(stderr, "workspace too small: %zu < %llu\n", ws_size, (unsigned long long)WS_END);
  }
  Params p{};
  p.x = (const float*)d_in[0]; p.c = (const float*)d_in[1]; p.pos = (const int*)d_in[2];
  p.ada_w = (const float*)d_in[3]; p.ada_b = (const float*)d_in[4];
  p.pre_norm = (const float*)d_in[5]; p.post_norm = (const float*)d_in[6];
  p.w_in = (const float*)d_in[7]; p.gla_w_lr = (const float*)d_in[8]; p.gla_b_lr = (const float*)d_in[9];
  p.w_br_ret = (const float*)d_in[10]; p.w_br_dsa = (const float*)d_in[11]; p.w_br_gla = (const float*)d_in[12];
  p.w_out = (const float*)d_in[13];
  p.out = (float*)d_out; p.ws = (unsigned char*)d_ws;
  p.ph_lo = 0; p.ph_hi = 2 + 7 * DEPTH;
  void* args[] = {&p};
  hipError_t e = hipLaunchCooperativeKernel((const void*)fwd_megakernel, dim3(grid_blocks), dim3(NTHREADS), args, LDS_BYTES, stream);
  if (e != hipSuccess) fprintf(stderr, "cooperative launch failed: %s (grid %d)\n", hipGetErrorString(e), grid_blocks);
}
```

```cpp
#include <hip/hip_runtime.h>
#include <hip/hip_cooperative_groups.h>
#include <stdint.h>
#include <cstdio>
namespace cg = cooperative_groups;
#ifndef REP_P
#define REP_P 1
#endif
#ifndef REP_KV
#define REP_KV 1
#endif
#ifndef REP_SEL
#define REP_SEL 1
#endif
#ifndef REP_ATT
#define REP_ATT 1
#endif

typedef _Float16 half_t;
typedef _Float16 h8 __attribute__((ext_vector_type(8)));
typedef _Float16 h4 __attribute__((ext_vector_type(4)));
typedef _Float16 h2 __attribute__((ext_vector_type(2)));
typedef float f16v __attribute__((ext_vector_type(16)));
typedef float f4v __attribute__((ext_vector_type(4)));

#define S_LEN 16384
#define DM 1024
#define NIN 7764
#define NPAD 7936
#define PP 7808
#define DEPTH 4
#define NTHREADS 256
#define HP 1088
#define WP 1088
#define WBP 576
#define LDS_BYTES 149504

#define C_RETQ 0
#define C_RETK 256
#define C_RETV 512
#define C_RETG 1024
#define C_DSAQ 1536
#define C_DSAK 2048
#define C_DSAV 2176
#define C_DSAG 2304
#define C_IDXQ 2816
#define C_IDXK 3072
#define C_GLAQ 3136
#define C_GLAK 3392
#define C_GLAV 3648
#define C_GLAG 4160
#define C_GLAA 4672
#define C_MRG 4688
#define C_END 7760
#define C_IDXW 7760

#define OFF_WINT 0ull
#define OFF_WBRT (OFF_WINT + 4ull * NPAD * WP * 2)
#define OFF_WOUTT (OFF_WBRT + 4ull * 3 * 1024 * WBP * 2)
#define OFF_MOD (OFF_WOUTT + 4ull * 1024 * WP * 2)
#define OFF_RT (OFF_MOD + 4ull * 3072 * 4)
#define OFF_DT (OFF_RT + 16384ull * 64 * 4)
#define OFF_H (OFF_DT + 16384ull * 16 * 4)
#define OFF_P (OFF_H + 16384ull * HP * 2)
#define OFF_GA (OFF_P + 16384ull * PP * 2)
#define OFF_IW (OFF_GA + 16384ull * 16 * 4)
#define OFF_ST (OFF_IW + 16384ull * 4 * 4)
#define OFF_DEC (OFF_ST + 256ull * 65536 * 4)
#define OFF_BR (OFF_DEC + 256ull * 8 * 64 * 4)
#define WS_END (OFF_BR + 16384ull * 1536 * 2)
static_assert(WS_END + 16384 <= 508821504ull, "workspace too large");

struct Params {
  const float* x; const float* c; const int* pos; const float* ada_w; const float* ada_b;
  const float* pre_norm; const float* post_norm; const float* w_in; const float* gla_w_lr;
  const float* gla_b_lr; const float* w_br_ret; const float* w_br_dsa; const float* w_br_gla;
  const float* w_out; float* out; unsigned char* ws;
  int ph_lo; int ph_hi;
};

__device__ __forceinline__ int otid() { int t = (int)__builtin_amdgcn_workitem_id_x(); asm volatile("" : "+v"(t)); return t; }
template <int CTRL>
__device__ __forceinline__ float dppf(float v) {
  return __int_as_float(__builtin_amdgcn_update_dpp(0, __float_as_int(v), CTRL, 0xF, 0xF, true));
}
template <int CTRL>
__device__ __forceinline__ unsigned dppu(unsigned v) {
  return (unsigned)__builtin_amdgcn_update_dpp(0, (int)v, CTRL, 0xF, 0xF, true);
}
__device__ __forceinline__ float wave_sum(float v) {
  v += dppf<0xB1>(v); v += dppf<0x4E>(v); v += dppf<0x141>(v); v += dppf<0x140>(v);
  v += __shfl_xor(v, 16); v += __shfl_xor(v, 32);
  return v;
}
__device__ __forceinline__ float wave_max(float v) {
  v = fmaxf(v, dppf<0xB1>(v)); v = fmaxf(v, dppf<0x4E>(v)); v = fmaxf(v, dppf<0x141>(v)); v = fmaxf(v, dppf<0x140>(v));
  v = fmaxf(v, __shfl_xor(v, 16)); v = fmaxf(v, __shfl_xor(v, 32));
  return v;
}
__device__ __forceinline__ unsigned wave_or(unsigned v) {
  v |= dppu<0xB1>(v); v |= dppu<0x4E>(v); v |= dppu<0x141>(v); v |= dppu<0x140>(v);
  v |= __shfl_xor(v, 16); v |= __shfl_xor(v, 32);
  return v;
}
__device__ __forceinline__ unsigned wave_incl_scan(unsigned v) {
  v += (unsigned)__builtin_amdgcn_update_dpp(0, (int)v, 0x111, 0xF, 0xF, false);
  v += (unsigned)__builtin_amdgcn_update_dpp(0, (int)v, 0x112, 0xF, 0xF, false);
  v += (unsigned)__builtin_amdgcn_update_dpp(0, (int)v, 0x114, 0xF, 0xF, false);
  v += (unsigned)__builtin_amdgcn_update_dpp(0, (int)v, 0x118, 0xF, 0xF, false);
  v += (unsigned)__builtin_amdgcn_update_dpp(0, (int)v, 0x142, 0xA, 0xF, false);
  v += (unsigned)__builtin_amdgcn_update_dpp(0, (int)v, 0x143, 0xC, 0xF, false);
  return v;
}
__device__ __forceinline__ f16v mfma16(h8 a, h8 b, f16v c) {
  return __builtin_amdgcn_mfma_f32_32x32x16_f16(a, b, c, 0, 0, 0);
}
__device__ __forceinline__ float relu_f(float x) { return __int_as_float(max(__float_as_int(x), 0)); }
__device__ __forceinline__ int crow(int r, int l) { return (r & 3) + 8 * (r >> 2) + 4 * (l >> 5); }

__device__ __forceinline__ int win_col(int nv) {
  if (nv < 3136) return nv;
  if (nv < 7760) return nv + 4;
  if (nv < 7764) return nv - 7760 + 3136;
  return -1;
}
__device__ void transpose_tile(const float* __restrict__ src, int ldn, half_t* __restrict__ dst, int K,
                               int k0, int n0, int mapmode, unsigned char* lds) {
  float* T = (float*)lds;
  const int tid = otid();
  const int nn = tid & 63;
  int col = n0 + nn;
  if (mapmode) col = win_col(col);
#pragma unroll
  for (int i = 0; i < 16; ++i) {
    int kk = (tid >> 6) + 4 * i;
    float v = 0.f;
    if (col >= 0) v = src[(size_t)(k0 + kk) * ldn + col];
    T[kk * 65 + nn] = v;
  }
  __syncthreads();
#pragma unroll
  for (int i = 0; i < 2; ++i) {
    int n2 = (tid >> 3) + 32 * i;
    int kc = tid & 7;
    h8 o;
#pragma unroll
    for (int q = 0; q < 8; ++q) o[q] = (half_t)T[(kc * 8 + q) * 65 + n2];
    *(h8*)(dst + (size_t)(n0 + n2) * K + k0 + kc * 8) = o;
  }
  __syncthreads();
}

__device__ void phase_prologue(const Params& p, unsigned char* lds) {
  const int tid = otid();
  half_t* WinT = (half_t*)(p.ws + OFF_WINT);
  half_t* WbrT = (half_t*)(p.ws + OFF_WBRT);
  half_t* WoutT = (half_t*)(p.ws + OFF_WOUTT);
  float* MOD = (float*)(p.ws + OFF_MOD);
  float* RT = (float*)(p.ws + OFF_RT);
  float* DT = (float*)(p.ws + OFF_DT);
  const int T_WIN = 4 * 124 * 16;
  const int T_WBR = 12 * 16 * 8;
  const int T_WOUT = 4 * 16 * 16;
  const int T_MOD = 192;
  const int T_ROPE = 16384 * 40 / 256;
  const int total = T_WIN + T_WBR + T_WOUT + T_MOD + T_ROPE;
  for (int task = blockIdx.x; task < total; task += gridDim.x) {
    int t = task;
    if (t < T_WIN) {
      int l = t / (124 * 16); int r = t % (124 * 16); int nt = r / 16, kt = r % 16;
      transpose_tile(p.w_in + (size_t)l * 1024 * NIN, NIN, WinT + (size_t)l * NPAD * WP, WP, kt * 64, nt * 64, 1, lds);
      continue;
    }
    t -= T_WIN;
    if (t < T_WBR) {
      int lb = t / 128; int r = t % 128; int nt = r / 8, kt = r % 8;
      int l = lb / 3, b = lb % 3;
      const float* src = (b == 0 ? p.w_br_ret : (b == 1 ? p.w_br_dsa : p.w_br_gla)) + (size_t)l * 512 * 1024;
      transpose_tile(src, 1024, WbrT + (size_t)lb * 1024 * WBP, WBP, kt * 64, nt * 64, 0, lds);
      continue;
    }
    t -= T_WBR;
    if (t < T_WOUT) {
      int l = t / 256; int r = t % 256; int nt = r / 16, kt = r % 16;
      transpose_tile(p.w_out + (size_t)l * 1024 * 1024, 1024, WoutT + (size_t)l * 1024 * WP, WP, kt * 64, nt * 64, 0, lds);
      continue;
    }
    t -= T_WOUT;
    if (t < T_MOD) {
      int l = t / 48, jb = t % 48;
      int j = jb * 64 + (tid & 63);
      int ig = tid >> 6;
      float acc = 0.f;
      const float* aw = p.ada_w + (size_t)l * 1024 * 3072;
      for (int i = ig * 256; i < ig * 256 + 256; ++i) {
        float cv = p.c[i];
        float sc = cv / (1.f + expf(-cv));
        acc += sc * aw[(size_t)i * 3072 + j];
      }
      float* red = (float*)lds;
      red[tid] = acc;
      __syncthreads();
      if (tid < 64) {
        float s = red[tid] + red[tid + 64] + red[tid + 128] + red[tid + 192];
        MOD[l * 3072 + j] = s + p.ada_b[l * 3072 + j];
      }
      __syncthreads();
      continue;
    }
    t -= T_MOD;
    {
      int e = t * 256 + tid;
      int tok = e / 40, f = e % 40;
      float pf = (float)p.pos[tok];
      if (f < 32) {
        float fr = powf(10000.0f, -(float)f * 2.0f / 64.0f);
        float ang = pf * fr;
        RT[tok * 64 + f * 2] = cosf(ang);
        RT[tok * 64 + f * 2 + 1] = sinf(ang);
      } else {
        int g = f - 32;
        float fr = powf(500000.0f, -(float)g * 2.0f / 16.0f);
        float ang = pf * fr;
        DT[tok * 16 + g * 2] = cosf(ang);
        DT[tok * 16 + g * 2 + 1] = sinf(ang);
      }
    }
  }
}

__device__ __forceinline__ void write_h_row(const float (&xv)[16], const float* __restrict__ pre,
                                            const float* __restrict__ mod, half_t* __restrict__ hrow, int l) {
  float ss = 0.f;
#pragma unroll
  for (int i = 0; i < 16; ++i) ss += xv[i] * xv[i];
  ss = wave_sum(ss);
  float rs = rsqrtf(ss * (1.0f / 1024.0f) + 1e-6f);
#pragma unroll
  for (int i = 0; i < 4; ++i) {
    int c0 = i * 256 + l * 4;
    f4v pg = *(const f4v*)(pre + c0);
    f4v sh = *(const f4v*)(mod + c0);
    f4v sc = *(const f4v*)(mod + 1024 + c0);
    h4 o;
#pragma unroll
    for (int q = 0; q < 4; ++q) o[q] = (half_t)(xv[i * 4 + q] * rs * pg[q] * (1.f + sc[q]) + sh[q]);
    *(h4*)(hrow + c0) = o;
  }
}

__device__ void phase_h0(const Params& p) {
  const int w = otid() >> 6, l = otid() & 63;
  half_t* H = (half_t*)(p.ws + OFF_H);
  const float* MOD = (const float*)(p.ws + OFF_MOD);
  for (int row = blockIdx.x * 4 + w; row < S_LEN; row += gridDim.x * 4) {
    float xv[16];
#pragma unroll
    for (int i = 0; i < 4; ++i) {
      f4v v = *(const f4v*)(p.x + (size_t)row * 1024 + i * 256 + l * 4);
      xv[i * 4] = v[0]; xv[i * 4 + 1] = v[1]; xv[i * 4 + 2] = v[2]; xv[i * 4 + 3] = v[3];
    }
    write_h_row(xv, p.pre_norm, MOD, H + (size_t)row * HP, l);
  }
}

__device__ __forceinline__ void lds_barrier() {
  asm volatile("s_waitcnt lgkmcnt(0)" ::: "memory");
  __builtin_amdgcn_s_barrier();
  asm volatile("" ::: "memory");
}
#define GEMM_BUF 55296
#define GEMM_EOFF 110592
template <int NT>
__device__ __forceinline__ void gemm_step(f16v (&acc)[4][NT], h8 (&ra)[8], h8 (&rb)[2 * NT],
                                          const unsigned char* As, const unsigned char* Bs, unsigned char* Aw, unsigned char* Bw,
                                          const half_t* __restrict__ A, int lda, const half_t* __restrict__ B, int ldb, int kload,
                                          int wm, int wn, int l, int r0, int kc) {
  h8 af[2][4], bf[2][NT];
#pragma unroll
  for (int i = 0; i < 4; ++i) af[0][i] = *(const h8*)(As + (wm * 128 + i * 32 + (l & 31)) * 144 + (l >> 5) * 16);
#pragma unroll
  for (int j = 0; j < NT; ++j) bf[0][j] = *(const h8*)(Bs + (wn * 32 * NT + j * 32 + (l & 31)) * 144 + (l >> 5) * 16);
#pragma unroll
  for (int ks = 0; ks < 4; ++ks) {
    if (ks < 3) {
#pragma unroll
      for (int i = 0; i < 4; ++i) af[(ks + 1) & 1][i] = *(const h8*)(As + (wm * 128 + i * 32 + (l & 31)) * 144 + (ks + 1) * 32 + (l >> 5) * 16);
#pragma unroll
      for (int j = 0; j < NT; ++j) bf[(ks + 1) & 1][j] = *(const h8*)(Bs + (wn * 32 * NT + j * 32 + (l & 31)) * 144 + (ks + 1) * 32 + (l >> 5) * 16);
    }
#pragma unroll
    for (int i = 0; i < 4; ++i)
#pragma unroll
      for (int j = 0; j < NT; ++j) acc[i][j] = mfma16(af[ks & 1][i], bf[ks & 1][j], acc[i][j]);
#pragma unroll
    for (int i = 2 * ks; i < 2 * ks + 2; ++i) {
      *(h8*)(Aw + (r0 + 32 * i) * 144 + kc * 16) = ra[i];
      ra[i] = *(const h8*)(A + (size_t)(r0 + 32 * i) * lda + kload + kc * 8);
    }
    if (NT == 2) {
      *(h8*)(Bw + (r0 + 32 * ks) * 144 + kc * 16) = rb[ks];
      rb[ks] = *(const h8*)(B + (size_t)(r0 + 32 * ks) * ldb + kload + kc * 8);
    } else {
#pragma unroll
      for (int i = 2 * ks; i < 2 * ks + 2; ++i) {
        *(h8*)(Bw + (r0 + 32 * i) * 144 + kc * 16) = rb[i];
        rb[i] = *(const h8*)(B + (size_t)(r0 + 32 * i) * ldb + kload + kc * 8);
      }
    }
  }
}
template <int NT>
__device__ __forceinline__ void gemm_issue(h8 (&ra0)[8], h8 (&rb0)[2 * NT], h8 (&ra1)[8], h8 (&rb1)[2 * NT],
                                           const half_t* __restrict__ A, int lda, const half_t* __restrict__ B, int ldb) {
  const int tid = otid();
  const int kc = tid & 7, r0 = tid >> 3;
#pragma unroll
  for (int i = 0; i < 8; ++i) ra0[i] = *(const h8*)(A + (size_t)(r0 + 32 * i) * lda + kc * 8);
#pragma unroll
  for (int i = 0; i < 2 * NT; ++i) rb0[i] = *(const h8*)(B + (size_t)(r0 + 32 * i) * ldb + kc * 8);
#pragma unroll
  for (int i = 0; i < 8; ++i) ra1[i] = *(const h8*)(A + (size_t)(r0 + 32 * i) * lda + 64 + kc * 8);
#pragma unroll
  for (int i = 0; i < 2 * NT; ++i) rb1[i] = *(const h8*)(B + (size_t)(r0 + 32 * i) * ldb + 64 + kc * 8);
}
template <int NT>
__device__ __forceinline__ void gemm_run(f16v (&acc)[4][NT], h8 (&ra0)[8], h8 (&rb0)[2 * NT], h8 (&ra1)[8], h8 (&rb1)[2 * NT],
                                         const half_t* __restrict__ A, int lda, const half_t* __restrict__ B, int ldb, int K, unsigned char* lds) {
  const int tid = otid(), w = tid >> 6, l = tid & 63;
  unsigned char* A0 = lds;
  unsigned char* B0 = lds + 256 * 144;
  unsigned char* A1 = lds + GEMM_BUF;
  unsigned char* B1 = lds + GEMM_BUF + 256 * 144;
  const int wm = w >> 1, wn = w & 1;
  const int kc = tid & 7;
  const int r0 = tid >> 3;
  lds_barrier();
#pragma unroll
  for (int i = 0; i < 8; ++i) { *(h8*)(A0 + (r0 + 32 * i) * 144 + kc * 16) = ra0[i]; ra0[i] = *(const h8*)(A + (size_t)(r0 + 32 * i) * lda + 128 + kc * 8); }
#pragma unroll
  for (int i = 0; i < 2 * NT; ++i) { *(h8*)(B0 + (r0 + 32 * i) * 144 + kc * 16) = rb0[i]; rb0[i] = *(const h8*)(B + (size_t)(r0 + 32 * i) * ldb + 128 + kc * 8); }
  lds_barrier();
  const int nk = K / 64;
#pragma unroll 1
  for (int kt = 0; kt < nk; kt += 2) {
    gemm_step<NT>(acc, ra1, rb1, A0, B0, A1, B1, A, lda, B, ldb, (kt + 3 < nk) ? (kt + 3) * 64 : 0, wm, wn, l, r0, kc);
    lds_barrier();
    gemm_step<NT>(acc, ra0, rb0, A1, B1, A0, B0, A, lda, B, ldb, (kt + 4 < nk) ? (kt + 4) * 64 : 0, wm, wn, l, r0, kc);
    lds_barrier();
  }
}
template <int NT>
__device__ __forceinline__ void gemm_kloop(f16v (&acc)[4][NT], const half_t* __restrict__ A, int lda,
                                           const half_t* __restrict__ B, int ldb, int K, unsigned char* lds) {
  h8 ra0[8], rb0[2 * NT], ra1[8], rb1[2 * NT];
  gemm_issue<NT>(ra0, rb0, ra1, rb1, A, lda, B, ldb);
  gemm_run<NT>(acc, ra0, rb0, ra1, rb1, A, lda, B, ldb, K, lds);
}

template <int NT>
__device__ __forceinline__ void zero_acc(f16v (&acc)[4][NT]) {
#pragma unroll
  for (int i = 0; i < 4; ++i)
#pragma unroll
    for (int j = 0; j < NT; ++j)
#pragma unroll
      for (int r = 0; r < 16; ++r) acc[i][j][r] = 0.f;
}

__device__ __forceinline__ void stage_pair(float* E, const f16v& a0, const f16v& a1, int l) {
#pragma unroll
  for (int r = 0; r < 16; ++r) {
    const int rr = crow(r, l);
    E[rr * 65 + (l & 31)] = a0[r];
    E[rr * 65 + 32 + (l & 31)] = a1[r];
  }
}

__device__ __forceinline__ int xcc_census(const unsigned* xcnt, int my_xcc) {
  unsigned sum = 0; bool ok = my_xcc < 8; int mine = 0;
#pragma unroll
  for (int j = 0; j < 16; ++j) {
    const unsigned c = __hip_atomic_load(xcnt + j, __ATOMIC_RELAXED, __HIP_MEMORY_SCOPE_AGENT);
    sum += c;
    if (j < 8 && c == 0u) ok = false;
    if (j >= 8 && c != 0u) ok = false;
    if (j == my_xcc) mine = (int)c;
  }
  if (sum != gridDim.x) ok = false;
  return ok ? mine : 0;
}

__device__ void phase_A(const Params& p, int layer, unsigned char* lds, int my_xcc, int my_loc, const unsigned* xcnt) {
  const int tid = otid(), w = tid >> 6, l = tid & 63;
  const half_t* H = (const half_t*)(p.ws + OFF_H);
  const half_t* Wt = (const half_t*)(p.ws + OFF_WINT) + (size_t)layer * NPAD * WP;
  half_t* P = (half_t*)(p.ws + OFF_P);
  float* GA = (float*)(p.ws + OFF_GA);
  float* IW = (float*)(p.ws + OFF_IW);
  const float* RT = (const float*)(p.ws + OFF_RT);
  const float* DT = (const float*)(p.ws + OFF_DT);
  const int wm = w >> 1, wn = w & 1;
  const int G = gridDim.x;
  const int ntiles = 64 * 62;
  const int nx = xcc_census(xcnt, my_xcc);
  int nmine;
  if (nx > 0) nmine = (my_loc < 496) ? (496 - my_loc + nx - 1) / nx : 0;
  else nmine = ((int)blockIdx.x < ntiles) ? (ntiles - (int)blockIdx.x + G - 1) / G : 0;
  h8 ra0[8], rb0[4], ra1[8], rb1[4];
  int mt = 0, nt = 0;
  if (nmine > 0) {
    if (nx > 0) { const int s0 = my_loc; mt = my_xcc * 8 + (s0 & 7); nt = s0 >> 3; }
    else { const int tix = blockIdx.x; mt = tix & 63; nt = tix >> 6; }
    gemm_issue<2>(ra0, rb0, ra1, rb1, H + (size_t)mt * 256 * HP, HP, Wt + (size_t)nt * 128 * WP, WP);
  }
#pragma unroll 1
  for (int rnd = 0; rnd < nmine; ++rnd) {
    f16v acc[4][2];
    zero_acc<2>(acc);
    gemm_run<2>(acc, ra0, rb0, ra1, rb1, H + (size_t)mt * 256 * HP, HP, Wt + (size_t)nt * 128 * WP, WP, 1024, lds);
    const int mt_cur = mt, nt_cur = nt;
    if (rnd + 1 < nmine) {
      if (nx > 0) { const int s1 = my_loc + nx * (rnd + 1); mt = my_xcc * 8 + (s1 & 7); nt = s1 >> 3; }
      else { const int tix = (rnd + 1) * G + blockIdx.x; mt = tix & 63; nt = tix >> 6; }
      gemm_issue<2>(ra0, rb0, ra1, rb1, H + (size_t)mt * 256 * HP, HP, Wt + (size_t)nt * 128 * WP, WP);
    }
    const int m0w = mt_cur * 256 + wm * 128;
    const int n0w = nt_cur * 128 + wn * 64;
    float* E = (float*)(lds + GEMM_EOFF) + w * (32 * 65);
    const int prow = l >> 3, c0 = (l & 7) * 8;
    {
      const int jp = 0;
      const int nb2 = n0w + jp * 64;
      const int n0 = nb2 + c0;
      const bool rope64 = nb2 < 512;
      const bool rope16 = ((nb2 >= C_DSAQ && nb2 < C_DSAV) || (nb2 >= C_IDXQ && nb2 < C_GLAQ)) && (c0 < 16);
      float scale = 1.f;
      if (n0 < 256 || (n0 >= C_DSAQ && n0 < C_DSAK) || (n0 >= C_IDXQ && n0 < C_IDXK) || (n0 >= C_GLAQ && n0 < C_GLAK)) scale = 0.125f;
      int mode = 0;
      if ((n0 >= C_RETG && n0 < C_DSAQ) || (n0 >= C_DSAG && n0 < C_IDXQ) || (n0 >= C_GLAG && n0 < C_GLAA)) mode = 1;
      if (n0 >= C_MRG && n0 < C_END) mode = 2;
#pragma unroll
      for (int i = 0; i < 4; ++i) {
        stage_pair(E, acc[i][2 * jp], acc[i][2 * jp + 1], l);
#pragma unroll 1
        for (int ps = 0; ps < 4; ++ps) {
          const int rl = ps * 8 + prow;
          const int row = m0w + i * 32 + rl;
          float v[8], o[8];
#pragma unroll
          for (int q = 0; q < 8; ++q) { v[q] = E[rl * 65 + c0 + q]; o[q] = v[q]; }
          if (rope64) {
            const int cp = c0 ^ 32;
            const float* tb = RT + (size_t)row * 64 + (c0 & 31) * 2;
#pragma unroll
            for (int q = 0; q < 8; ++q) {
              const float pv = E[rl * 65 + cp + q];
              const float cs = tb[2 * q], sn = tb[2 * q + 1];
              o[q] = (c0 < 32) ? (v[q] * cs - pv * sn) : (v[q] * cs + pv * sn);
            }
          } else if (rope16) {
            const int cp = c0 ^ 8;
            const float* tb = DT + (size_t)row * 16;
#pragma unroll
            for (int q = 0; q < 8; ++q) {
              const float pv = E[rl * 65 + cp + q];
              const float cs = tb[2 * q], sn = tb[2 * q + 1];
              o[q] = (c0 < 8) ? (v[q] * cs - pv * sn) : (v[q] * cs + pv * sn);
            }
          }
          h8 ov;
#pragma unroll
          for (int q = 0; q < 8; ++q) {
            float t = o[q] * scale;
            if (mode == 1) t = t / (1.f + __expf(-t));
            else if (mode == 2) t = 1.f / (1.f + __expf(-t));
            ov[q] = (half_t)t;
          }
          if (n0 < C_END) __builtin_nontemporal_store(ov, (h8*)(P + (size_t)row * PP + n0));
          if (n0 >= C_GLAA && n0 < C_MRG) {
#pragma unroll
            for (int q = 0; q < 8; ++q) GA[(size_t)row * 16 + (n0 - C_GLAA) + q] = v[q];
          }
          if (n0 == C_IDXW) {
#pragma unroll
            for (int q = 0; q < 4; ++q) IW[(size_t)row * 4 + q] = 0.5f * v[q];
          }
        }
      }
    }
  }
}

#define LA_BC 0
#define LA_GAS 16640
#define LA_WL 20736
#define LA_QT 24832
#define LA_KT 34048
#define LA_AT 43264
#define LA_VT 52480
#define LA_SS 70912
#define LA_OS 89344
#define LA_SEG 123136

__device__ void la_bcum(const Params& p, int layer, int n, int Hh, unsigned char* lds) {
  const int tid = otid();
  float* Bc = (float*)(lds + LA_BC);
  const int d = tid & 63, q = tid >> 6;
  if (Hh < 4) {
    float lg = log1pf(-exp2f(-5.0f - (float)Hh));
#pragma unroll
    for (int jj = 0; jj < 16; ++jj) { int j = q * 16 + jj; Bc[j * 65 + d] = (float)(j + 1) * lg; }
    __syncthreads();
    return;
  }
  const int h = Hh - 4;
  float* GAs = (float*)(lds + LA_GAS);
  float* WL = (float*)(lds + LA_WL);
  float* SEG = (float*)(lds + LA_SEG);
  const float* GA = (const float*)(p.ws + OFF_GA);
#pragma unroll
  for (int i = 0; i < 4; ++i) {
    int e = tid + 256 * i;
    GAs[e] = GA[(size_t)n * 64 * 16 + e];
    int r = e >> 6, dd = e & 63;
    WL[e] = p.gla_w_lr[(size_t)layer * 16 * 256 + r * 256 + h * 64 + dd];
  }
  __syncthreads();
  float wl[16];
#pragma unroll
  for (int r = 0; r < 16; ++r) wl[r] = WL[r * 64 + d];
  const float bl = p.gla_b_lr[layer * 256 + h * 64 + d];
  float run = 0.f;
#pragma unroll
  for (int jj = 0; jj < 16; ++jj) {
    int j = q * 16 + jj;
    float z = bl;
#pragma unroll
    for (int r = 0; r < 16; ++r) z += GAs[j * 16 + r] * wl[r];
    float ls = fminf(z, 0.f) - log1pf(expf(-fabsf(z)));
    run += ls * (1.0f / 16.0f);
    Bc[j * 65 + d] = run;
  }
  SEG[q * 64 + d] = run;
  __syncthreads();
  float off = 0.f;
  for (int qq = 0; qq < q; ++qq) off += SEG[qq * 64 + d];
  if (q > 0) {
#pragma unroll
    for (int jj = 0; jj < 16; ++jj) { int j = q * 16 + jj; Bc[j * 65 + d] += off; }
  }
  __syncthreads();
}

__device__ __forceinline__ void la_stage_vt(const half_t* __restrict__ P, int t0, int vcol, unsigned char* lds) {
  const int tid = otid(), w = tid >> 6, l = tid & 63;
  half_t* VT = (half_t*)(lds + LA_VT);
  const int jp = l & 31, cgp = l >> 5;
#pragma unroll
  for (int it = 0; it < 2; ++it) {
    int c = it * 8 + w * 2 + cgp;
    h8 v0 = *(const h8*)(P + (size_t)(t0 + 2 * jp) * PP + vcol + c * 8);
    h8 v1 = *(const h8*)(P + (size_t)(t0 + 2 * jp + 1) * PP + vcol + c * 8);
#pragma unroll
    for (int q = 0; q < 8; ++q) {
      h2 pr; pr[0] = v0[q]; pr[1] = v1[q];
      *(h2*)(VT + (c * 8 + q) * 72 + 2 * jp) = pr;
    }
  }
}

__device__ void la_item_kv(const Params& p, int layer, int item, unsigned char* lds) {
  const int tid = otid(), w = tid >> 6, l = tid & 63;
  const int n = item >> 3, Hh = item & 7;
  const int t0 = n * 64;
  const half_t* P = (const half_t*)(p.ws + OFF_P);
  half_t* ST = (half_t*)(p.ws + OFF_ST);
  float* DEC = (float*)(p.ws + OFF_DEC);
  const int kcol = (Hh < 4) ? (C_RETK + Hh * 64) : (C_GLAK + (Hh - 4) * 64);
  const int vcol = (Hh < 4) ? (C_RETV + Hh * 128) : (C_GLAV + (Hh - 4) * 128);
  __syncthreads();
  la_bcum(p, layer, n, Hh, lds);
  const float* Bc = (const float*)(lds + LA_BC);
  half_t* KhT = (half_t*)(lds + LA_KT);
  half_t* VT = (half_t*)(lds + LA_VT);
  {
    const int jp = l & 31, cgp = l >> 5;
    int c = w * 2 + cgp;
    h8 k0 = *(const h8*)(P + (size_t)(t0 + 2 * jp) * PP + kcol + c * 8);
    h8 k1 = *(const h8*)(P + (size_t)(t0 + 2 * jp + 1) * PP + kcol + c * 8);
#pragma unroll
    for (int q = 0; q < 8; ++q) {
      int d = c * 8 + q;
      float bl = Bc[63 * 65 + d];
      h2 pr;
      pr[0] = (half_t)((float)k0[q] * __expf(bl - Bc[(2 * jp) * 65 + d]));
      pr[1] = (half_t)((float)k1[q] * __expf(bl - Bc[(2 * jp + 1) * 65 + d]));
      *(h2*)(KhT + d * 72 + 2 * jp) = pr;
    }
  }
  la_stage_vt(P, t0, vcol, lds);
  if (tid < 64) DEC[(size_t)item * 64 + tid] = __expf(Bc[63 * 65 + tid]);
  __syncthreads();
  f16v acc[2];
#pragma unroll
  for (int j = 0; j < 2; ++j)
#pragma unroll
    for (int r = 0; r < 16; ++r) acc[j][r] = 0.f;
#pragma unroll
  for (int ks = 0; ks < 4; ++ks) {
    h8 a = *(const h8*)(VT + (32 * w + (l & 31)) * 72 + ks * 16 + (l >> 5) * 8);
#pragma unroll
    for (int j = 0; j < 2; ++j) {
      h8 b = *(const h8*)(KhT + (j * 32 + (l & 31)) * 72 + ks * 16 + (l >> 5) * 8);
      acc[j] = mfma16(a, b, acc[j]);
    }
  }
#pragma unroll
  for (int j = 0; j < 2; ++j)
#pragma unroll
    for (int r = 0; r < 16; ++r) {
      int e = 32 * w + crow(r, l);
      int d = j * 32 + (l & 31);
      ST[(size_t)item * 8192 + e * 64 + d] = (half_t)acc[j][r];
    }
}

__device__ void phase_scan(const Params& p) {
  half_t* ST = (half_t*)(p.ws + OFF_ST);
  const float* DEC = (const float*)(p.ws + OFF_DEC);
  for (int f2 = blockIdx.x * NTHREADS + otid(); f2 < 32768; f2 += gridDim.x * NTHREADS) {
    const int f = f2 * 2;
    const int Hh = f >> 13, d = f & 63;
    float s0 = 0.f, s1 = 0.f;
    for (int n0 = 0; n0 < 256; n0 += 16) {
      h2 kv[16]; float2 dc[16];
#pragma unroll
      for (int u = 0; u < 16; ++u) {
        kv[u] = *(const h2*)(ST + (size_t)(n0 + u) * 65536 + f);
        dc[u] = *(const float2*)(DEC + (size_t)((n0 + u) * 8 + Hh) * 64 + d);
      }
#pragma unroll
      for (int u = 0; u < 16; ++u) {
        h2 o; o[0] = (half_t)s0; o[1] = (half_t)s1;
        *(h2*)(ST + (size_t)(n0 + u) * 65536 + f) = o;
        s0 = dc[u].x * s0 + (float)kv[u][0];
        s1 = dc[u].y * s1 + (float)kv[u][1];
      }
    }
  }
}

__device__ void la_item_out(const Params& p, int layer, int item, unsigned char* lds) {
  const int tid = otid(), w = tid >> 6, l = tid & 63;
  const int n = item >> 3, Hh = item & 7;
  const int t0 = n * 64;
  const half_t* P = (const half_t*)(p.ws + OFF_P);
  const half_t* ST = (const half_t*)(p.ws + OFF_ST);
  half_t* BR = (half_t*)(p.ws + OFF_BR);
  const int qcol = (Hh < 4) ? (C_RETQ + Hh * 64) : (C_GLAQ + (Hh - 4) * 64);
  const int kcol = (Hh < 4) ? (C_RETK + Hh * 64) : (C_GLAK + (Hh - 4) * 64);
  const int vcol = (Hh < 4) ? (C_RETV + Hh * 128) : (C_GLAV + (Hh - 4) * 128);
  const int gcol = (Hh < 4) ? (C_RETG + Hh * 128) : (C_GLAG + (Hh - 4) * 128);
  const int ocol = (Hh < 4) ? (Hh * 128) : (1024 + (Hh - 4) * 128);
  __syncthreads();
  la_bcum(p, layer, n, Hh, lds);
  const float* Bc = (const float*)(lds + LA_BC);
  half_t* Qt = (half_t*)(lds + LA_QT);
  half_t* Kt = (half_t*)(lds + LA_KT);
  half_t* AT = (half_t*)(lds + LA_AT);
  half_t* VT = (half_t*)(lds + LA_VT);
  half_t* SS = (half_t*)(lds + LA_SS);
  float* OS = (float*)(lds + LA_OS);
#pragma unroll
  for (int it = 0; it < 2; ++it) {
    int c = tid + 256 * it;
    int row = c >> 3, kc = c & 7;
    h8 qv = *(const h8*)(P + (size_t)(t0 + row) * PP + qcol + kc * 8);
    h8 kv = *(const h8*)(P + (size_t)(t0 + row) * PP + kcol + kc * 8);
    h8 qo, ko;
#pragma unroll
    for (int q = 0; q < 8; ++q) {
      float b = Bc[row * 65 + kc * 8 + q];
      qo[q] = (half_t)((float)qv[q] * __expf(b));
      ko[q] = (half_t)((float)kv[q] * __expf(-b));
    }
    *(h8*)(Qt + row * 72 + kc * 8) = qo;
    *(h8*)(Kt + row * 72 + kc * 8) = ko;
  }
  la_stage_vt(P, t0, vcol, lds);
#pragma unroll
  for (int it = 0; it < 4; ++it) {
    int c = tid + 256 * it;
    int e = c >> 3, kc = c & 7;
    *(h8*)(SS + e * 72 + kc * 8) = *(const h8*)(ST + (size_t)item * 8192 + e * 64 + kc * 8);
  }
  __syncthreads();
  {
    const int mi = w >> 1, nj = w & 1;
    f16v acc;
#pragma unroll
    for (int r = 0; r < 16; ++r) acc[r] = 0.f;
#pragma unroll
    for (int ks = 0; ks < 4; ++ks) {
      h8 a = *(const h8*)(Qt + (mi * 32 + (l & 31)) * 72 + ks * 16 + (l >> 5) * 8);
      h8 b = *(const h8*)(Kt + (nj * 32 + (l & 31)) * 72 + ks * 16 + (l >> 5) * 8);
      acc = mfma16(a, b, acc);
    }
#pragma unroll
    for (int r = 0; r < 16; ++r) {
      int i = mi * 32 + crow(r, l);
      int j = nj * 32 + (l & 31);
      float v = (j <= i) ? acc[r] : 0.f;
      AT[i * 72 + j] = (half_t)v;
    }
  }
  __syncthreads();
  {
    const int mi = w >> 1, nh = w & 1;
    f16v acc[2];
#pragma unroll
    for (int j = 0; j < 2; ++j)
#pragma unroll
      for (int r = 0; r < 16; ++r) acc[j][r] = 0.f;
#pragma unroll
    for (int ks = 0; ks < 4; ++ks) {
      h8 a1 = *(const h8*)(AT + (mi * 32 + (l & 31)) * 72 + ks * 16 + (l >> 5) * 8);
      h8 a2 = *(const h8*)(Qt + (mi * 32 + (l & 31)) * 72 + ks * 16 + (l >> 5) * 8);
#pragma unroll
      for (int j = 0; j < 2; ++j) {
        h8 b1 = *(const h8*)(VT + (nh * 64 + j * 32 + (l & 31)) * 72 + ks * 16 + (l >> 5) * 8);
        h8 b2 = *(const h8*)(SS + (nh * 64 + j * 32 + (l & 31)) * 72 + ks * 16 + (l >> 5) * 8);
        acc[j] = mfma16(a1, b1, acc[j]);
        acc[j] = mfma16(a2, b2, acc[j]);
      }
    }
#pragma unroll
    for (int j = 0; j < 2; ++j)
#pragma unroll
      for (int r = 0; r < 16; ++r) {
        int i = mi * 32 + crow(r, l);
        int e = nh * 64 + j * 32 + (l & 31);
        OS[i * 132 + e] = acc[j][r];
      }
  }
  __syncthreads();
  {
    const int i = tid >> 2, qd = tid & 3;
    float ov[32];
    float ss = 0.f;
#pragma unroll
    for (int c = 0; c < 8; ++c) {
      f4v v = *(const f4v*)(OS + i * 132 + qd * 32 + c * 4);
      ov[c * 4] = v[0]; ov[c * 4 + 1] = v[1]; ov[c * 4 + 2] = v[2]; ov[c * 4 + 3] = v[3];
      ss += v[0] * v[0] + v[1] * v[1] + v[2] * v[2] + v[3] * v[3];
    }
    ss += __shfl_xor(ss, 1);
    ss += __shfl_xor(ss, 2);
    float rs = rsqrtf(ss * (1.0f / 128.0f) + 1e-6f);
#pragma unroll
    for (int c = 0; c < 4; ++c) {
      h8 g = *(const h8*)(P + (size_t)(t0 + i) * PP + gcol + qd * 32 + c * 8);
      h8 o;
#pragma unroll
      for (int q = 0; q < 8; ++q) o[q] = (half_t)(ov[c * 8 + q] * rs * (float)g[q]);
      *(h8*)(BR + (size_t)(t0 + i) * 1536 + ocol + qd * 32 + c * 8) = o;
    }
  }
}

#define DS_CAP 640
#define DS_PRUNE_AT 512
#define NPL 10
#define DS_LS 0
#define DS_LI (32 * DS_CAP * 4)
#define DS_CNT (32 * DS_CAP * 6)
#define DS_THR (DS_CNT + 128)
#define DS_WQ (DS_CNT + 256)
#define DS_HIST (DS_CNT + 1024)
#define DS_PW (DS_CNT + 1024 + 4096)

__device__ __forceinline__ unsigned long long wave_or64(unsigned long long v) {
  const unsigned lo = wave_or((unsigned)v), hi = wave_or((unsigned)(v >> 32));
  return ((unsigned long long)hi << 32) | lo;
}
__device__ __forceinline__ void dsa_prune(float* LSm, unsigned short* LIm, int n, unsigned* hist, int* cntm, float* thrm, int l) {
  unsigned long long comp[NPL];
  bool act[NPL], val[NPL];
#pragma unroll
  for (int k = 0; k < NPL; ++k) {
    int e = l + 64 * k;
    val[k] = e < n;
    unsigned u = 0, li = 0;
    if (val[k]) { u = __float_as_uint(LSm[e]); li = LIm[e]; }
    const unsigned key = (u >> 31) ? ~u : (u | 0x80000000u);
    comp[k] = ((unsigned long long)key << 14) | (unsigned long long)(16383u - li);
    act[k] = val[k];
  }
  const unsigned long long c0 = ((unsigned long long)(unsigned)__builtin_amdgcn_readfirstlane((int)(unsigned)(comp[0] >> 32)) << 32) | (unsigned)__builtin_amdgcn_readfirstlane((int)(unsigned)comp[0]);
  unsigned long long x = 0;
#pragma unroll
  for (int k = 0; k < NPL; ++k) x |= val[k] ? (comp[k] ^ c0) : 0ull;
  x = wave_or64(x);
  int shift = (x == 0ull) ? 0 : (63 - __clzll((long long)x)) - 7;
  if (shift < 0) shift = 0;
  unsigned rank = 256;
#pragma unroll 1
  for (int rd = 0; rd < 8; ++rd) {
    *(uint4*)(hist + 4 * l) = make_uint4(0, 0, 0, 0);
    __threadfence_block();
    unsigned dk[NPL];
#pragma unroll
    for (int k = 0; k < NPL; ++k) {
      dk[k] = (unsigned)(comp[k] >> shift) & 255u;
      if (act[k]) atomicAdd(&hist[dk[k]], 1u);
    }
    __threadfence_block();
    uint4 hv; hv.x = hist[4 * l]; hv.y = hist[4 * l + 1]; hv.z = hist[4 * l + 2]; hv.w = hist[4 * l + 3];
    unsigned tl = hv.x + hv.y + hv.z + hv.w;
    const unsigned pin = wave_incl_scan(tl);
    const unsigned tot = (unsigned)__builtin_amdgcn_readlane((int)pin, 63);
    unsigned sx = tot - pin;
    bool mine = (sx < rank) && (rank <= sx + tl);
    unsigned dsel = 0, nr = 0, hsel = 0;
    if (mine) {
      unsigned c = sx;
      if (c + hv.w >= rank) { dsel = 4 * l + 3; nr = rank - c; hsel = hv.w; }
      else {
        c += hv.w;
        if (c + hv.z >= rank) { dsel = 4 * l + 2; nr = rank - c; hsel = hv.z; }
        else {
          c += hv.z;
          if (c + hv.y >= rank) { dsel = 4 * l + 1; nr = rank - c; hsel = hv.y; }
          else { c += hv.y; dsel = 4 * l; nr = rank - c; hsel = hv.x; }
        }
      }
    }
    unsigned long long mk = __ballot(mine);
    int src = (mk == 0ull) ? 0 : (__ffsll((long long)mk) - 1);
    dsel = (unsigned)__builtin_amdgcn_readlane((int)dsel, src);
    rank = (unsigned)__builtin_amdgcn_readlane((int)nr, src);
    hsel = (unsigned)__builtin_amdgcn_readlane((int)hsel, src);
#pragma unroll
    for (int k = 0; k < NPL; ++k) act[k] = act[k] && (dk[k] == dsel);
    if (hsel <= 1u || shift == 0) break;
    shift = (shift >= 8) ? (shift - 8) : 0;
  }
  unsigned long long tsel = 0;
#pragma unroll
  for (int k = 0; k < NPL; ++k) tsel |= act[k] ? comp[k] : 0ull;
  const unsigned long long T = wave_or64(tsel);
  bool keep[NPL];
  unsigned cntk = 0;
#pragma unroll
  for (int k = 0; k < NPL; ++k) {
    keep[k] = val[k] && (comp[k] >= T);
    cntk += keep[k] ? 1u : 0u;
  }
  unsigned pos = wave_incl_scan(cntk) - cntk;
  __threadfence_block();
#pragma unroll
  for (int k = 0; k < NPL; ++k) {
    if (keep[k]) {
      const unsigned kk = (unsigned)(comp[k] >> 14);
      const unsigned u = (kk & 0x80000000u) ? (kk & 0x7FFFFFFFu) : ~kk;
      LSm[pos] = __uint_as_float(u);
      LIm[pos] = (unsigned short)(16383u - ((unsigned)comp[k] & 16383u));
      ++pos;
    }
  }
  if (l == 0) {
    const unsigned T32 = (unsigned)(T >> 14);
    *cntm = 256;
    *thrm = __uint_as_float((T32 & 0x80000000u) ? (T32 & 0x7FFFFFFFu) : ~T32);
  }
  __threadfence_block();
}

__device__ void dsa_item(const Params& p, int qb, unsigned char* lds) {
  const int tid = otid(), w = tid >> 6, l = tid & 63;
  const int t0 = qb * 32;
  const half_t* P = (const half_t*)(p.ws + OFF_P);
  const float* IW = (const float*)(p.ws + OFF_IW);
  half_t* BR = (half_t*)(p.ws + OFF_BR);
  float* LS = (float*)(lds + DS_LS);
  unsigned short* LI = (unsigned short*)(lds + DS_LI);
  int* cnt = (int*)(lds + DS_CNT);
  float* thr = (float*)(lds + DS_THR);
  float* wq = (float*)(lds + DS_WQ);
  unsigned* hist = (unsigned*)(lds + DS_HIST) + w * 256;
  float* PW = (float*)(lds + DS_PW) + w * 1024;
  half_t* QS = (half_t*)(lds + DS_PW + 16384) + w * 512;
  for (int rep_sel = 0; rep_sel < REP_SEL; ++rep_sel) {
  __syncthreads();
  if (tid < 32) { cnt[tid] = 0; thr[tid] = -INFINITY; }
  if (tid < 128) wq[tid] = IW[(size_t)t0 * 4 + tid];
  __syncthreads();
  h8 aq[4][4];
#pragma unroll
  for (int h = 0; h < 4; ++h)
#pragma unroll
    for (int ks = 0; ks < 4; ++ks)
      aq[h][ks] = *(const h8*)(P + (size_t)(t0 + (l & 31)) * PP + C_IDXQ + h * 64 + ks * 16 + (l >> 5) * 8);
  const int nt = qb + 1;
  const int nr = (nt + 3) >> 2;
  float thv[16];
#pragma unroll
  for (int r = 0; r < 16; ++r) thv[r] = -INFINITY;
  h8 bk[4];
  {
    const int k0 = (w < nt) ? w : 0;
#pragma unroll
    for (int ks = 0; ks < 4; ++ks)
      bk[ks] = *(const h8*)(P + (size_t)(k0 * 32 + (l & 31)) * PP + C_IDXK + ks * 16 + (l >> 5) * 8);
  }
#pragma unroll 1
  for (int rd = 0; rd < nr; ++rd) {
    const int kt = 4 * rd + w;
    h8 bkn[4];
    {
      const int kn = (kt + 4 < nt) ? (kt + 4) : 0;
#pragma unroll
      for (int ks = 0; ks < 4; ++ks)
        bkn[ks] = *(const h8*)(P + (size_t)(kn * 32 + (l & 31)) * PP + C_IDXK + ks * 16 + (l >> 5) * 8);
    }
    if (kt < nt) {
      const int sbase = kt * 32;
      f16v acc[4];
#pragma unroll
      for (int h = 0; h < 4; ++h) {
#pragma unroll
        for (int r = 0; r < 16; ++r) acc[h][r] = 0.f;
#pragma unroll
        for (int ks = 0; ks < 4; ++ks) acc[h] = mfma16(aq[h][ks], bk[ks], acc[h]);
      }
      const int s = sbase + (l & 31);
      float scv[16];
      unsigned pm = 0;
#pragma unroll
      for (int r = 0; r < 16; ++r) {
        const int m = crow(r, l);
        const f4v wv = *(const f4v*)(wq + m * 4);
        float sc = wv[0] * relu_f(acc[0][r]) + wv[1] * relu_f(acc[1][r]) + wv[2] * relu_f(acc[2][r]) + wv[3] * relu_f(acc[3][r]);
        sc += 0.0f;
        scv[r] = sc;
      }
      if (kt == qb) {
#pragma unroll
        for (int r = 0; r < 16; ++r) if (s > t0 + crow(r, l)) scv[r] = -INFINITY;
      }
#pragma unroll
      for (int r = 0; r < 16; ++r) pm |= (scv[r] > thv[r]) ? (1u << r) : 0u;
      if (__ballot(pm != 0u) != 0ull) {
        unsigned long long mks[16];
        int mycnt = 0;
#pragma unroll
        for (int r = 0; r < 16; ++r) {
          const unsigned long long mk = __ballot(((pm >> r) & 1u) != 0u);
          mks[r] = mk;
          const unsigned hm = (l < 32) ? (unsigned)mk : (unsigned)(mk >> 32);
          if ((l & 31) == r) mycnt = __popc(hm);
        }
        int base = 0;
        if ((l & 31) < 16 && mycnt > 0) base = atomicAdd(&cnt[crow(l & 31, l)], mycnt);
#pragma unroll
        for (int r = 0; r < 16; ++r) {
          const unsigned long long mk = mks[r];
          if (mk != 0ull) {
            const unsigned hm = (l < 32) ? (unsigned)mk : (unsigned)(mk >> 32);
            const int b_lo = __builtin_amdgcn_readlane(base, r), b_hi = __builtin_amdgcn_readlane(base, 32 + r);
            const int bb = (l < 32) ? b_lo : b_hi;
            if ((pm >> r) & 1u) {
              const int m = crow(r, l);
              const int slot = bb + __popc(hm & ((1u << (l & 31)) - 1u));
              LS[m * DS_CAP + slot] = scv[r];
              LI[m * DS_CAP + slot] = (unsigned short)s;
            }
          }
        }
      }
    }
    __syncthreads();
    bool any_prune;
    {
      const int cv = (l < 32) ? cnt[l] : 0;
      unsigned pmask = (unsigned)__ballot(cv > DS_PRUNE_AT);
      any_prune = pmask != 0u;
      int j = 0;
      while (pmask != 0u) {
        const int m = __ffs((int)pmask) - 1;
        pmask &= pmask - 1u;
        if ((j & 3) == w) dsa_prune(LS + m * DS_CAP, LI + m * DS_CAP, cnt[m], hist, cnt + m, thr + m, l);
        ++j;
      }
    }
    __syncthreads();
    if (any_prune) {
#pragma unroll
      for (int r = 0; r < 16; ++r) thv[r] = thr[crow(r, l)];
    }
#pragma unroll
    for (int ks = 0; ks < 4; ++ks) bk[ks] = bkn[ks];
  }
  }
#pragma unroll 1
  for (int mm = 0; mm < 8; ++mm) {
    const int m = w * 8 + mm;
    const int c = cnt[m];
    if (c > 256) dsa_prune(LS + m * DS_CAP, LI + m * DS_CAP, c, hist, cnt + m, thr + m, l);
  }
  asm volatile("s_waitcnt lgkmcnt(0)" ::: "memory");
  for (int rep_att = 0; rep_att < REP_ATT; ++rep_att) {
  h8 kvr[4][8];
  {
    const int m = w * 8;
    const int c = min(cnt[m], 256);
    const unsigned short* LIm = LI + m * DS_CAP;
#pragma unroll
    for (int kk = 0; kk < 4; ++kk) {
      const int e = l + 64 * kk;
      const int s = (e < c) ? (int)LIm[e] : 0;
      const half_t* kr = P + (size_t)s * PP + C_DSAK;
#pragma unroll
      for (int ch = 0; ch < 8; ++ch) kvr[kk][ch] = *(const h8*)(kr + ch * 8);
    }
  }
  h8 qreg = *(const h8*)(P + (size_t)(t0 + w * 8) * PP + C_DSAQ + l * 8);
  const int dch = l & 7, ksub = l >> 3;
#pragma unroll 1
  for (int u = 0; u < 16; ++u) {
    const int mm = u >> 1, g = u & 1;
    const int m = w * 8 + mm;
    const int t = t0 + m;
    const int c = min(cnt[m], 256);
    const unsigned short* LIm = LI + m * DS_CAP;
    if (g == 0) {
      *(h8*)(QS + l * 8) = qreg;
      const int mq = (mm < 7) ? (m + 1) : m;
      qreg = *(const h8*)(P + (size_t)(t0 + mq) * PP + C_DSAQ + l * 8);
    }
    h8 gt[4];
#pragma unroll
    for (int hh = 0; hh < 4; ++hh) gt[hh] = *(const h8*)(P + (size_t)t * PP + C_DSAG + (g * 4 + hh) * 64 + dch * 8);
    h8 vv[16];
#pragma unroll
    for (int i = 0; i < 16; ++i) {
      const int e = i * 8 + ksub;
      const int s = (e < c) ? (int)LIm[e] : 0;
      vv[i] = *(const h8*)(P + (size_t)s * PP + C_DSAV + g * 64 + dch * 8);
    }
    asm volatile("s_waitcnt lgkmcnt(0)" ::: "memory");
    float lg[4][4];
#pragma unroll
    for (int hh = 0; hh < 4; ++hh) {
#pragma unroll
      for (int kk = 0; kk < 4; ++kk) lg[hh][kk] = 0.f;
#pragma unroll
      for (int ch = 0; ch < 8; ++ch) {
        const h8 qq = *(const h8*)(QS + (g * 4 + hh) * 64 + ch * 8);
#pragma unroll
        for (int kk = 0; kk < 4; ++kk) {
          float a = lg[hh][kk];
          a = __builtin_amdgcn_fdot2(__builtin_shufflevector(qq, qq, 0, 1), __builtin_shufflevector(kvr[kk][ch], kvr[kk][ch], 0, 1), a, false);
          a = __builtin_amdgcn_fdot2(__builtin_shufflevector(qq, qq, 2, 3), __builtin_shufflevector(kvr[kk][ch], kvr[kk][ch], 2, 3), a, false);
          a = __builtin_amdgcn_fdot2(__builtin_shufflevector(qq, qq, 4, 5), __builtin_shufflevector(kvr[kk][ch], kvr[kk][ch], 4, 5), a, false);
          a = __builtin_amdgcn_fdot2(__builtin_shufflevector(qq, qq, 6, 7), __builtin_shufflevector(kvr[kk][ch], kvr[kk][ch], 6, 7), a, false);
          lg[hh][kk] = a;
        }
      }
#pragma unroll
      for (int kk = 0; kk < 4; ++kk) lg[hh][kk] = (l + 64 * kk < c) ? lg[hh][kk] : -INFINITY;
    }
    {
      const int un = (u < 15) ? (u + 1) : 15;
      const int mn = w * 8 + (un >> 1), gn = un & 1;
      const int cn = min(cnt[mn], 256);
      const unsigned short* LIn = LI + mn * DS_CAP;
#pragma unroll
      for (int kk = 0; kk < 4; ++kk) {
        const int e = l + 64 * kk;
        const int s = (e < cn) ? (int)LIn[e] : 0;
        const half_t* kr = P + (size_t)s * PP + C_DSAK + gn * 64;
#pragma unroll
        for (int ch = 0; ch < 8; ++ch) kvr[kk][ch] = *(const h8*)(kr + ch * 8);
      }
    }
#pragma unroll
    for (int hh = 0; hh < 4; ++hh) {
      float mx = fmaxf(fmaxf(lg[hh][0], lg[hh][1]), fmaxf(lg[hh][2], lg[hh][3]));
      mx = wave_max(mx);
      float ev[4]; float sm = 0.f;
#pragma unroll
      for (int kk = 0; kk < 4; ++kk) { ev[kk] = __expf(lg[hh][kk] - mx); sm += ev[kk]; }
      sm = wave_sum(sm);
      const float inv = 1.0f / sm;
#pragma unroll
      for (int kk = 0; kk < 4; ++kk) PW[(l + 64 * kk) * 4 + hh] = ev[kk] * inv;
    }
    asm volatile("s_waitcnt lgkmcnt(0)" ::: "memory");
    float o[4][8];
#pragma unroll
    for (int hh = 0; hh < 4; ++hh)
#pragma unroll
      for (int q = 0; q < 8; ++q) o[hh][q] = 0.f;
    const int nit = (c + 7) >> 3;
#pragma unroll 1
    for (int it0 = 0; it0 < nit; it0 += 16) {
      if (it0 > 0) {
#pragma unroll
        for (int i = 0; i < 16; ++i) {
          const int e = (it0 + i) * 8 + ksub;
          const int s = (e < c) ? (int)LIm[e] : 0;
          vv[i] = *(const h8*)(P + (size_t)s * PP + C_DSAV + g * 64 + dch * 8);
        }
      }
#pragma unroll
      for (int i = 0; i < 16; ++i) {
        const int e = (it0 + i) * 8 + ksub;
        const f4v pv = *(const f4v*)(PW + e * 4);
#pragma unroll
        for (int hh = 0; hh < 4; ++hh)
#pragma unroll
          for (int q = 0; q < 8; ++q) o[hh][q] += pv[hh] * (float)vv[i][q];
      }
    }
#pragma unroll
    for (int hh = 0; hh < 4; ++hh)
#pragma unroll
      for (int q = 0; q < 8; ++q) {
        float v = o[hh][q];
        v += dppf<0x128>(v); v += __shfl_xor(v, 16); v += __shfl_xor(v, 32);
        o[hh][q] = v;
      }
    if (l < 8) {
#pragma unroll
      for (int hh = 0; hh < 4; ++hh) {
        const int col = (g * 4 + hh) * 64 + dch * 8;
        h8 ov;
#pragma unroll
        for (int q = 0; q < 8; ++q) ov[q] = (half_t)(o[hh][q] * (float)gt[hh][q]);
        *(h8*)(BR + (size_t)t * 1536 + 512 + col) = ov;
      }
    }
    asm volatile("s_waitcnt lgkmcnt(0)" ::: "memory");
  }
  }
}

__device__ void phase_B(const Params& p, int layer, unsigned char* lds) {
  const int G = gridDim.x;
  for (int j = 0; j * G < 512; ++j) {
    const int b = (j & 1) ? (G - 1 - (int)blockIdx.x) : (int)blockIdx.x;
    const int idx = j * G + b;
#ifndef NO_DSA
    if (idx < 512) dsa_item(p, 511 - idx, lds);
#endif
  }
  for (int rep = 0; rep < REP_KV; ++rep)
  for (int it = blockIdx.x; it < 2048; it += G) la_item_kv(p, layer, it, lds);
}

__device__ void phase_E1(const Params& p, int layer, unsigned char* lds, int my_xcc, int my_loc, const unsigned* xcnt) {
  const int tid = otid(), w = tid >> 6, l = tid & 63;
  const half_t* BR = (const half_t*)(p.ws + OFF_BR);
  const half_t* WbrT = (const half_t*)(p.ws + OFF_WBRT) + (size_t)layer * 3 * 1024 * WBP;
  const half_t* P = (const half_t*)(p.ws + OFF_P);
  half_t* Y1 = (half_t*)(p.ws + OFF_H);
  const int wm = w >> 1, wn = w & 1;
  float* E = (float*)(lds + GEMM_EOFF) + w * (32 * 65);
  const int prow = l >> 3, c0 = (l & 7) * 8;
  const int nx = xcc_census(xcnt, my_xcc);
  const int nrounds = (nx > 0) ? (64 + nx - 1) / nx : (512 + (int)gridDim.x - 1) / (int)gridDim.x;
  for (int rnd = 0; rnd < nrounds; ++rnd) {
    int mt, nt;
    if (nx > 0) {
      const int s = my_loc + nx * rnd;
      if (s >= 64) continue;
      mt = my_xcc * 8 + (s & 7); nt = s >> 3;
    } else {
      const int tix = rnd * (int)gridDim.x + (int)blockIdx.x;
      if (tix >= 512) continue;
      mt = tix & 63; nt = tix >> 6;
    }
    h8 tot[4][4];
#pragma unroll
    for (int i = 0; i < 4; ++i)
#pragma unroll
      for (int ps = 0; ps < 4; ++ps)
#pragma unroll
        for (int q = 0; q < 8; ++q) tot[i][ps][q] = (half_t)0.f;
    const int m0w = mt * 256 + wm * 128;
    const int n0 = nt * 128 + wn * 64 + c0;
#pragma unroll 1
    for (int b = 0; b < 3; ++b) {
      f16v acc[4][2];
      zero_acc<2>(acc);
      gemm_kloop<2>(acc, BR + (size_t)mt * 256 * 1536 + b * 512, 1536, WbrT + (size_t)b * 1024 * WBP + (size_t)nt * 128 * WBP, WBP, 512, lds);
#pragma unroll
      for (int i = 0; i < 4; ++i) {
        stage_pair(E, acc[i][0], acc[i][1], l);
#pragma unroll
        for (int ps = 0; ps < 4; ++ps) {
          const int rl = ps * 8 + prow;
          const int row = m0w + i * 32 + rl;
          const h8 g = *(const h8*)(P + (size_t)row * PP + C_MRG + b * 1024 + n0);
#pragma unroll
          for (int q = 0; q < 8; ++q) tot[i][ps][q] = (half_t)((float)tot[i][ps][q] + (float)g[q] * E[rl * 65 + c0 + q]);
        }
      }
    }
#pragma unroll
    for (int i = 0; i < 4; ++i)
#pragma unroll
      for (int ps = 0; ps < 4; ++ps) {
        const int row = m0w + i * 32 + ps * 8 + prow;
        *(h8*)(Y1 + (size_t)row * HP + n0) = tot[i][ps];
      }
  }
}

__device__ void phase_E2(const Params& p, int layer, unsigned char* lds, int my_xcc, int my_loc, const unsigned* xcnt) {
  const int tid = otid(), w = tid >> 6, l = tid & 63;
  const half_t* Y1 = (const half_t*)(p.ws + OFF_H);
  const half_t* Wo = (const half_t*)(p.ws + OFF_WOUTT) + (size_t)layer * 1024 * WP;
  float* Y = (float*)(p.ws + OFF_ST);
  const int wm = w >> 1, wn = w & 1;
  const int nx = xcc_census(xcnt, my_xcc);
  const int nrounds = (nx > 0) ? (64 + nx - 1) / nx : (512 + (int)gridDim.x - 1) / (int)gridDim.x;
  for (int rnd = 0; rnd < nrounds; ++rnd) {
    int mt, nt;
    if (nx > 0) {
      const int s = my_loc + nx * rnd;
      if (s >= 64) continue;
      mt = my_xcc * 8 + (s & 7); nt = s >> 3;
    } else {
      const int tix = rnd * (int)gridDim.x + (int)blockIdx.x;
      if (tix >= 512) continue;
      mt = tix & 63; nt = tix >> 6;
    }
    f16v acc[4][2];
    zero_acc<2>(acc);
    gemm_kloop<2>(acc, Y1 + (size_t)mt * 256 * HP, HP, Wo + (size_t)nt * 128 * WP, WP, 1024, lds);
    const int m0w = mt * 256 + wm * 128;
    const int n0w = nt * 128 + wn * 64;
#pragma unroll
    for (int i = 0; i < 4; ++i)
#pragma unroll
      for (int j = 0; j < 2; ++j)
#pragma unroll
        for (int r = 0; r < 16; ++r) {
          const int row = m0w + i * 32 + crow(r, l);
          const int n = n0w + j * 32 + (l & 31);
          Y[(size_t)row * 1024 + n] = acc[i][j][r];
        }
  }
}

__device__ void phase_E3(const Params& p, int layer) {
  const int w = otid() >> 6, l = otid() & 63;
  const float* Y = (const float*)(p.ws + OFF_ST);
  const float* MOD = (const float*)(p.ws + OFF_MOD);
  half_t* H = (half_t*)(p.ws + OFF_H);
  const float* xin = (layer == 0) ? p.x : p.out;
  const float* gate = MOD + layer * 3072 + 2048;
  const float* post = p.post_norm + layer * 1024;
  const int stride = gridDim.x * 4;
  int row = blockIdx.x * 4 + w;
  f4v yn[4], xn[4];
  if (row < S_LEN) {
#pragma unroll
    for (int i = 0; i < 4; ++i) {
      yn[i] = *(const f4v*)(Y + (size_t)row * 1024 + i * 256 + l * 4);
      xn[i] = *(const f4v*)(xin + (size_t)row * 1024 + i * 256 + l * 4);
    }
  }
  for (; row < S_LEN; row += stride) {
    float yv[16], xv[16];
    float ss = 0.f;
#pragma unroll
    for (int i = 0; i < 4; ++i)
#pragma unroll
      for (int q = 0; q < 4; ++q) { yv[i * 4 + q] = yn[i][q]; xv[i * 4 + q] = xn[i][q]; ss += yn[i][q] * yn[i][q]; }
    const int nrow = (row + stride < S_LEN) ? (row + stride) : row;
#pragma unroll
    for (int i = 0; i < 4; ++i) {
      yn[i] = *(const f4v*)(Y + (size_t)nrow * 1024 + i * 256 + l * 4);
      xn[i] = *(const f4v*)(xin + (size_t)nrow * 1024 + i * 256 + l * 4);
    }
    ss = wave_sum(ss);
    const float rs = rsqrtf(ss * (1.0f / 1024.0f) + 1e-6f);
#pragma unroll
    for (int i = 0; i < 4; ++i) {
      const int c0 = i * 256 + l * 4;
      f4v gt = *(const f4v*)(gate + c0);
      f4v pn = *(const f4v*)(post + c0);
      f4v o;
#pragma unroll
      for (int q = 0; q < 4; ++q) { o[q] = xv[i * 4 + q] + gt[q] * (yv[i * 4 + q] * rs * pn[q]); xv[i * 4 + q] = o[q]; }
      *(f4v*)(p.out + (size_t)row * 1024 + c0) = o;
    }
    if (layer + 1 < DEPTH)
      write_h_row(xv, p.pre_norm + (layer + 1) * 1024, MOD + (layer + 1) * 3072, H + (size_t)row * HP, l);
  }
}

#define XB_TMO      128
#define XB_XCNT(j)  (256  + 64 * (j))
#define XB_XSUB(j)  (1280 + 64 * (j))
#define XB_XGEN(j)  (2304 + 64 * (j))
#define XB_TOP      3328
#define XB_TOPGEN   3392
#define XCD_BAR_WORDS 3456
#define XB_SPIN_CAP (1u << 18)
#define LAS __attribute__((address_space(3)))

__device__ __forceinline__ unsigned xb_ld(unsigned* p)              { return __hip_atomic_load(p, __ATOMIC_RELAXED, __HIP_MEMORY_SCOPE_AGENT); }
__device__ __forceinline__ unsigned xb_add(unsigned* p, unsigned v) { return __hip_atomic_fetch_add(p, v, __ATOMIC_RELAXED, __HIP_MEMORY_SCOPE_AGENT); }
__device__ __forceinline__ unsigned xb_xcc_id() { return (unsigned)__builtin_amdgcn_s_getreg((3 << 11) | 20) & 0xFu; }
#define XB_SPIN(cond, bar) do { unsigned _sp = 0; while (cond) { __builtin_amdgcn_s_sleep(1); \
    if ((++_sp & 255u) == 0u) { if (xb_ld(&(bar)[XB_TMO])) break; if (_sp > XB_SPIN_CAP) { atomicAdd(&(bar)[XB_TMO], 1u); break; } } } } while (0)

struct XcdBarrier {
    unsigned* bar; unsigned x;
    volatile LAS unsigned* st;
};

__device__ __forceinline__ XcdBarrier xcd_barrier_post(unsigned* bar, volatile LAS unsigned* st) {
    XcdBarrier b; b.bar = bar; b.x = xb_xcc_id(); b.st = st;
    if (threadIdx.x == 0) (void)xb_add(&bar[XB_XCNT(b.x)], 1u);
    return b;
}
__device__ __forceinline__ void xcd_barrier_complete(unsigned* bar, unsigned x, unsigned& nloc, unsigned& nx) {
    const unsigned G = gridDim.x * gridDim.y * gridDim.z;
    unsigned sum, cnt, mine, sp = 0u;
    for (;;) {
        sum = 0u; cnt = 0u; mine = 0u;
#pragma unroll
        for (unsigned j = 0; j < 16; ++j) { const unsigned c = xb_ld(&bar[XB_XCNT(j)]); sum += c; cnt += (c > 0u) ? 1u : 0u; mine = (j == x) ? c : mine; }
        if (sum == G) break;
        __builtin_amdgcn_s_sleep(1);
        if ((++sp & 255u) == 0u) { if (xb_ld(&bar[XB_TMO])) break; if (sp > XB_SPIN_CAP) { atomicAdd(&bar[XB_TMO], 1u); break; } }
    }
    nloc = mine > 0u ? mine : 1u; nx = cnt > 0u ? cnt : 1u;
}

__device__ __forceinline__ void xcd_barrier(const XcdBarrier& b) {
    asm volatile("s_waitcnt vmcnt(0)" ::: "memory");
    __syncthreads();
    if (threadIdx.x == 0) {
        unsigned* bar = b.bar;
        __builtin_amdgcn_s_waitcnt(0);
        unsigned nloc = b.st[0], nx = b.st[1];
        if (nloc == 0u) { xcd_barrier_complete(bar, b.x, nloc, nx); b.st[0] = nloc; b.st[1] = nx; }
        const unsigned old = xb_add(&bar[XB_XSUB(b.x)], 1u);
        const unsigned gen = old / nloc;
        if (old + 1u == (gen + 1u) * nloc) {
            __builtin_amdgcn_fence(__ATOMIC_RELEASE, "agent");
            asm volatile("s_waitcnt vmcnt(0)" ::: "memory");
            const unsigned og = xb_add(&bar[XB_TOP], 1u);
            const unsigned tg = og / nx;
            if (og + 1u == (tg + 1u) * nx) xb_add(&bar[XB_TOPGEN], 1u);
            else XB_SPIN(xb_ld(&bar[XB_TOPGEN]) == tg, bar);
            __builtin_amdgcn_fence(__ATOMIC_ACQUIRE, "agent");
            xb_add(&bar[XB_XGEN(b.x)], 1u);
            asm volatile("s_waitcnt vmcnt(0)" ::: "memory");
        } else {
            XB_SPIN(xb_ld(&bar[XB_XGEN(b.x)]) == gen, bar);
            __builtin_amdgcn_fence(__ATOMIC_ACQUIRE, "agent");
            asm volatile("s_waitcnt vmcnt(0)" ::: "memory");
        }
    }
    __syncthreads();
}


#ifndef REP_D
#define REP_D 1
#endif
#ifndef REP_E
#define REP_E 1
#endif
#ifndef REP_A
#define REP_A 1
#endif
#ifndef REP_B
#define REP_B 1
#endif
#ifdef ONLY_PHASE
#define PH_EN(x) (ONLY_PHASE == (x))
#else
#define PH_EN(x) true
#endif
__global__ void __launch_bounds__(NTHREADS) fwd_megakernel(Params p) {
  extern __shared__ __attribute__((aligned(16))) unsigned char lds[];
  cg::grid_group grid = cg::this_grid();
  unsigned* bar = (unsigned*)(p.ws + WS_END);
  unsigned* xcnt = bar + 16;
  unsigned* xbar = (unsigned*)(p.ws + WS_END + 1024);
  if (blockIdx.x == 0) {
    if (otid() < 17) __hip_atomic_store(bar + (otid() == 16 ? 0 : 16 + otid()), 0u, __ATOMIC_RELAXED, __HIP_MEMORY_SCOPE_AGENT);
    for (int i = otid(); i < XCD_BAR_WORDS; i += NTHREADS) __hip_atomic_store(xbar + i, 0u, __ATOMIC_RELAXED, __HIP_MEMORY_SCOPE_AGENT);
  }
  volatile LAS unsigned* xst = (volatile LAS unsigned*)(lds + LDS_BYTES - 16);
  if (otid() == 0) { xst[0] = 0u; xst[1] = 0u; }
  __syncthreads();
  XcdBarrier xb; xb.bar = xbar; xb.x = 0; xb.st = xst;
  int my_xcc = 0, my_loc = 0;
  for (int ph = p.ph_lo; ph < p.ph_hi; ++ph) {
    if (ph == 0) { if (PH_EN(0)) for (int rep = 0; rep < REP_P; ++rep) { phase_prologue(p, lds); __syncthreads(); } }
    else if (ph == 1) {
      xb = xcd_barrier_post(xbar, xst);
      int* sh = (int*)lds;
      if (otid() == 0) {
        const int xc = (int)(__builtin_amdgcn_s_getreg((3 << 11) | 20) & 0xFu);
        sh[0] = xc;
        sh[1] = (int)__hip_atomic_fetch_add(xcnt + xc, 1u, __ATOMIC_RELAXED, __HIP_MEMORY_SCOPE_AGENT);
      }
      __syncthreads();
      my_xcc = __builtin_amdgcn_readfirstlane(sh[0]);
      my_loc = __builtin_amdgcn_readfirstlane(sh[1]);
      __syncthreads();
      if (PH_EN(1)) phase_h0(p);
    }
    else {
      const int layer = (ph - 2) / 7, sub = (ph - 2) % 7;
      if (sub == 0) { if (PH_EN(2)) for (int rep = 0; rep < REP_A; ++rep) { phase_A(p, layer, lds, my_xcc, my_loc, xcnt); __syncthreads(); } }
      else if (sub == 1) { if (PH_EN(3)) for (int rep = 0; rep < REP_B; ++rep) { phase_B(p, layer, lds); __syncthreads(); } }
      else if (sub == 2) { if (PH_EN(4)) phase_scan(p); }
      else if (sub == 3) { if (PH_EN(5)) for (int rep = 0; rep < REP_D; ++rep) { for (int it = blockIdx.x; it < 2048; it += gridDim.x) la_item_out(p, layer, it, lds); __syncthreads(); } }
      else if (sub == 4) { if (PH_EN(6)) for (int rep = 0; rep < REP_E; ++rep) { phase_E1(p, layer, lds, my_xcc, my_loc, xcnt); __syncthreads(); } }
      else if (sub == 5) { if (PH_EN(7)) for (int rep = 0; rep < REP_E; ++rep) { phase_E2(p, layer, lds, my_xcc, my_loc, xcnt); __syncthreads(); } }
      else { if (PH_EN(8)) phase_E3(p, layer); }
    }
    if (ph + 1 < p.ph_hi) {
      if (ph == p.ph_lo) grid.sync();
      else xcd_barrier(xb);
    }
  }
}

extern "C" void kernel_launch(void* const* d_in, const int* in_sizes, int n_in, void* d_out, int out_size,
                              void* d_ws, size_t ws_size, hipStream_t stream) {
  static int grid_blocks = 0;
  if (!grid_blocks) {
    int dev = 0, cus = 0, per_cu = 0;
    hipGetDevice(&dev);
    hipDeviceGetAttribute(&cus, hipDeviceAttributeMultiprocessorCount, dev);
    hipFuncSetAttribute((const void*)fwd_megakernel, hipFuncAttributeMaxDynamicSharedMemorySize, LDS_BYTES);
    hipOccupancyMaxActiveBlocksPerMultiprocessor(&per_cu, (const void*)fwd_megakernel, NTHREADS, LDS_BYTES);
    if (per_cu < 1) per_cu = 1;
    if (per_cu > 1) per_cu = 1;
    grid_blocks = cus * per_cu;
    if (ws_size < WS_END) fprintf(stderr, "workspace too small: %zu < %llu\n", ws_size, (unsigned long long)WS_END);
  }
  Params p{};
  p.x = (const float*)d_in[0]; p.c = (const float*)d_in[1]; p.pos = (const int*)d_in[2];
  p.ada_w = (const float*)d_in[3]; p.ada_b = (const float*)d_in[4];
  p.pre_norm = (const float*)d_in[5]; p.post_norm = (const float*)d_in[6];
  p.w_in = (const float*)d_in[7]; p.gla_w_lr = (const float*)d_in[8]; p.gla_b_lr = (const float*)d_in[9];
  p.w_br_ret = (const float*)d_in[10]; p.w_br_dsa = (const float*)d_in[11]; p.w_br_gla = (const float*)d_in[12];
  p.w_out = (const float*)d_in[13];
  p.out = (float*)d_out; p.ws = (unsigned char*)d_ws;
  p.ph_lo = 0; p.ph_hi = 2 + 7 * DEPTH;
  void* args[] = {&p};
  hipError_t e = hipLaunchCooperativeKernel((const void*)fwd_megakernel, dim3(grid_blocks), dim3(NTHREADS), args, LDS_BYTES, stream);
  if (e != hipSuccess) fprintf(stderr, "cooperative launch failed: %s (grid %d)\n", hipGetErrorString(e), grid_blocks);
}
```

```cpp
#include <hip/hip_runtime.h>
#include <hip/hip_cooperative_groups.h>
#include <stdint.h>
#include <cstdio>
namespace cg = cooperative_groups;
#ifndef REP_P
#define REP_P 1
#endif
#ifndef REP_KV
#define REP_KV 1
#endif
#ifndef REP_SEL
#define REP_SEL 1
#endif
#ifndef REP_ATT
#define REP_ATT 1
#endif

typedef _Float16 half_t;
typedef _Float16 h8 __attribute__((ext_vector_type(8)));
typedef _Float16 h4 __attribute__((ext_vector_type(4)));
typedef _Float16 h2 __attribute__((ext_vector_type(2)));
typedef float f16v __attribute__((ext_vector_type(16)));
typedef float f4v __attribute__((ext_vector_type(4)));

#define S_LEN 16384
#define DM 1024
#define NIN 7764
#define NPAD 7936
#define PP 7808
#define DEPTH 4
#define NTHREADS 256
#define HP 1088
#define WP 1088
#define WBP 576
#define LDS_BYTES 149504

#define C_RETQ 0
#define C_RETK 256
#define C_RETV 512
#define C_RETG 1024
#define C_DSAQ 1536
#define C_DSAK 2048
#define C_DSAV 2176
#define C_DSAG 2304
#define C_IDXQ 2816
#define C_IDXK 3072
#define C_GLAQ 3136
#define C_GLAK 3392
#define C_GLAV 3648
#define C_GLAG 4160
#define C_GLAA 4672
#define C_MRG 4688
#define C_END 7760
#define C_IDXW 7760

#define OFF_WINT 0ull
#define OFF_WBRT (OFF_WINT + 4ull * NPAD * WP * 2)
#define OFF_WOUTT (OFF_WBRT + 4ull * 3 * 1024 * WBP * 2)
#define OFF_MOD (OFF_WOUTT + 4ull * 1024 * WP * 2)
#define OFF_RT (OFF_MOD + 4ull * 3072 * 4)
#define OFF_DT (OFF_RT + 16384ull * 64 * 4)
#define OFF_H (OFF_DT + 16384ull * 16 * 4)
#define OFF_P (OFF_H + 16384ull * HP * 2)
#define OFF_GA (OFF_P + 16384ull * PP * 2)
#define OFF_IW (OFF_GA + 16384ull * 16 * 4)
#define OFF_ST (OFF_IW + 16384ull * 4 * 4)
#define OFF_DEC (OFF_ST + 256ull * 65536 * 4)
#define OFF_BR (OFF_DEC + 256ull * 8 * 64 * 4)
#define WS_END (OFF_BR + 16384ull * 1536 * 2)
static_assert(WS_END + 16384 <= 508821504ull, "workspace too large");

struct Params {
  const float* x; const float* c; const int* pos; const float* ada_w; const float* ada_b;
  const float* pre_norm; const float* post_norm; const float* w_in; const float* gla_w_lr;
  const float* gla_b_lr; const float* w_br_ret; const float* w_br_dsa; const float* w_br_gla;
  const float* w_out; float* out; unsigned char* ws;
  int ph_lo; int ph_hi;
};

struct K {
int wbase;
__device__ __forceinline__ int otid() const {
  int lane;
  asm volatile("v_mbcnt_lo_u32_b32 %0, -1, 0\n\tv_mbcnt_hi_u32_b32 %0, -1, %0" : "=v"(lane));
  return wbase | lane;
}
__device__ __forceinline__ static float ozero() { float z = 0.f; asm volatile("" : "+v"(z)); return z; }
template <int CTRL>
__device__ __forceinline__ float dppf(float v) {
  return __int_as_float(__builtin_amdgcn_update_dpp(0, __float_as_int(v), CTRL, 0xF, 0xF, true));
}
template <int CTRL>
__device__ __forceinline__ unsigned dppu(unsigned v) {
  return (unsigned)__builtin_amdgcn_update_dpp(0, (int)v, CTRL, 0xF, 0xF, true);
}
__device__ __forceinline__ int olane() { return otid() & 63; }
__device__ __forceinline__ float xor16f(float v) { return __int_as_float(__builtin_amdgcn_ds_bpermute((olane() ^ 16) << 2, __float_as_int(v))); }
__device__ __forceinline__ float xor32f(float v) { return __int_as_float(__builtin_amdgcn_ds_bpermute((olane() ^ 32) << 2, __float_as_int(v))); }
__device__ __forceinline__ unsigned xor16u(unsigned v) { return (unsigned)__builtin_amdgcn_ds_bpermute((olane() ^ 16) << 2, (int)v); }
__device__ __forceinline__ unsigned xor32u(unsigned v) { return (unsigned)__builtin_amdgcn_ds_bpermute((olane() ^ 32) << 2, (int)v); }
__device__ __forceinline__ float wave_sum(float v) {
  v += dppf<0xB1>(v); v += dppf<0x4E>(v); v += dppf<0x141>(v); v += dppf<0x140>(v);
  v += xor16f(v); v += xor32f(v);
  return v;
}
__device__ __forceinline__ float wave_max(float v) {
  v = fmaxf(v, dppf<0xB1>(v)); v = fmaxf(v, dppf<0x4E>(v)); v = fmaxf(v, dppf<0x141>(v)); v = fmaxf(v, dppf<0x140>(v));
  v = fmaxf(v, xor16f(v)); v = fmaxf(v, xor32f(v));
  return v;
}
__device__ __forceinline__ unsigned wave_or(unsigned v) {
  v |= dppu<0xB1>(v); v |= dppu<0x4E>(v); v |= dppu<0x141>(v); v |= dppu<0x140>(v);
  v |= xor16u(v); v |= xor32u(v);
  return v;
}
__device__ __forceinline__ unsigned wave_incl_scan(unsigned v) {
  v += (unsigned)__builtin_amdgcn_update_dpp(0, (int)v, 0x111, 0xF, 0xF, false);
  v += (unsigned)__builtin_amdgcn_update_dpp(0, (int)v, 0x112, 0xF, 0xF, false);
  v += (unsigned)__builtin_amdgcn_update_dpp(0, (int)v, 0x114, 0xF, 0xF, false);
  v += (unsigned)__builtin_amdgcn_update_dpp(0, (int)v, 0x118, 0xF, 0xF, false);
  v += (unsigned)__builtin_amdgcn_update_dpp(0, (int)v, 0x142, 0xA, 0xF, false);
  v += (unsigned)__builtin_amdgcn_update_dpp(0, (int)v, 0x143, 0xC, 0xF, false);
  return v;
}
__device__ __forceinline__ f16v mfma16(h8 a, h8 b, f16v c) {
  return __builtin_amdgcn_mfma_f32_32x32x16_f16(a, b, c, 0, 0, 0);
}
__device__ __forceinline__ float relu_f(float x) { return __int_as_float(max(__float_as_int(x), 0)); }
__device__ __forceinline__ int crow(int r, int l) { return (r & 3) + 8 * (r >> 2) + 4 * (l >> 5); }

__device__ __forceinline__ int win_col(int nv) {
  if (nv < 3136) return nv;
  if (nv < 7760) return nv + 4;
  if (nv < 7764) return nv - 7760 + 3136;
  return -1;
}
__device__ void transpose_tile(const float* __restrict__ src, int ldn, half_t* __restrict__ dst, int K,
                               int k0, int n0, int mapmode, unsigned char* lds) {
  float* T = (float*)lds;
  const int tid = otid();
  const int nn = tid & 63;
  int col = n0 + nn;
  if (mapmode) col = win_col(col);
#pragma unroll
  for (int i = 0; i < 16; ++i) {
    int kk = (tid >> 6) + 4 * i;
    float v = 0.f;
    if (col >= 0) v = src[(size_t)(k0 + kk) * ldn + col];
    T[kk * 65 + nn] = v;
  }
  __syncthreads();
#pragma unroll
  for (int i = 0; i < 2; ++i) {
    int n2 = (tid >> 3) + 32 * i;
    int kc = tid & 7;
    h8 o;
#pragma unroll
    for (int q = 0; q < 8; ++q) o[q] = (half_t)T[(kc * 8 + q) * 65 + n2];
    *(h8*)(dst + (size_t)(n0 + n2) * K + k0 + kc * 8) = o;
  }
  __syncthreads();
}

__device__ void phase_prologue(const Params& p, unsigned char* lds) {
  const int tid = otid();
  half_t* WinT = (half_t*)(p.ws + OFF_WINT);
  half_t* WbrT = (half_t*)(p.ws + OFF_WBRT);
  half_t* WoutT = (half_t*)(p.ws + OFF_WOUTT);
  float* MOD = (float*)(p.ws + OFF_MOD);
  float* RT = (float*)(p.ws + OFF_RT);
  float* DT = (float*)(p.ws + OFF_DT);
  const int T_WIN = 4 * 124 * 16;
  const int T_WBR = 12 * 16 * 8;
  const int T_WOUT = 4 * 16 * 16;
  const int T_MOD = 192;
  const int T_ROPE = 16384 * 40 / 256;
  const int total = T_WIN + T_WBR + T_WOUT + T_MOD + T_ROPE;
  for (int task = blockIdx.x; task < total; task += gridDim.x) {
    int t = task;
    if (t < T_WIN) {
      int l = t / (124 * 16); int r = t % (124 * 16); int nt = r / 16, kt = r % 16;
      transpose_tile(p.w_in + (size_t)l * 1024 * NIN, NIN, WinT + (size_t)l * NPAD * WP, WP, kt * 64, nt * 64, 1, lds);
      continue;
    }
    t -= T_WIN;
    if (t < T_WBR) {
      int lb = t / 128; int r = t % 128; int nt = r / 8, kt = r % 8;
      int l = lb / 3, b = lb % 3;
      const float* src = (b == 0 ? p.w_br_ret : (b == 1 ? p.w_br_dsa : p.w_br_gla)) + (size_t)l * 512 * 1024;
      transpose_tile(src, 1024, WbrT + (size_t)lb * 1024 * WBP, WBP, kt * 64, nt * 64, 0, lds);
      continue;
    }
    t -= T_WBR;
    if (t < T_WOUT) {
      int l = t / 256; int r = t % 256; int nt = r / 16, kt = r % 16;
      transpose_tile(p.w_out + (size_t)l * 1024 * 1024, 1024, WoutT + (size_t)l * 1024 * WP, WP, kt * 64, nt * 64, 0, lds);
      continue;
    }
    t -= T_WOUT;
    if (t < T_MOD) {
      int l = t / 48, jb = t % 48;
      int j = jb * 64 + (tid & 63);
      int ig = tid >> 6;
      float acc = 0.f;
      const float* aw = p.ada_w + (size_t)l * 1024 * 3072;
      for (int i = ig * 256; i < ig * 256 + 256; ++i) {
        float cv = p.c[i];
        float sc = cv / (1.f + expf(-cv));
        acc += sc * aw[(size_t)i * 3072 + j];
      }
      float* red = (float*)lds;
      red[tid] = acc;
      __syncthreads();
      if (tid < 64) {
        float s = red[tid] + red[tid + 64] + red[tid + 128] + red[tid + 192];
        MOD[l * 3072 + j] = s + p.ada_b[l * 3072 + j];
      }
      __syncthreads();
      continue;
    }
    t -= T_MOD;
    {
      int e = t * 256 + tid;
      int tok = e / 40, f = e % 40;
      float pf = (float)p.pos[tok];
      if (f < 32) {
        float fr = powf(10000.0f, -(float)f * 2.0f / 64.0f);
        float ang = pf * fr;
        RT[tok * 64 + f * 2] = cosf(ang);
        RT[tok * 64 + f * 2 + 1] = sinf(ang);
      } else {
        int g = f - 32;
        float fr = powf(500000.0f, -(float)g * 2.0f / 16.0f);
        float ang = pf * fr;
        DT[tok * 16 + g * 2] = cosf(ang);
        DT[tok * 16 + g * 2 + 1] = sinf(ang);
      }
    }
  }
}

__device__ __forceinline__ void write_h_row(const float (&xv)[16], const float* __restrict__ pre,
                                            const float* __restrict__ mod, half_t* __restrict__ hrow, int l) {
  float ss = 0.f;
#pragma unroll
  for (int i = 0; i < 16; ++i) ss += xv[i] * xv[i];
  ss = wave_sum(ss);
  float rs = rsqrtf(ss * (1.0f / 1024.0f) + 1e-6f);
#pragma unroll
  for (int i = 0; i < 4; ++i) {
    int c0 = i * 256 + l * 4;
    f4v pg = *(const f4v*)(pre + c0);
    f4v sh = *(const f4v*)(mod + c0);
    f4v sc = *(const f4v*)(mod + 1024 + c0);
    h4 o;
#pragma unroll
    for (int q = 0; q < 4; ++q) o[q] = (half_t)(xv[i * 4 + q] * rs * pg[q] * (1.f + sc[q]) + sh[q]);
    *(h4*)(hrow + c0) = o;
  }
}

__device__ void phase_h0(const Params& p) {
  const int w = otid() >> 6, l = otid() & 63;
  half_t* H = (half_t*)(p.ws + OFF_H);
  const float* MOD = (const float*)(p.ws + OFF_MOD);
  for (int row = blockIdx.x * 4 + w; row < S_LEN; row += gridDim.x * 4) {
    float xv[16];
#pragma unroll
    for (int i = 0; i < 4; ++i) {
      f4v v = *(const f4v*)(p.x + (size_t)row * 1024 + i * 256 + l * 4);
      xv[i * 4] = v[0]; xv[i * 4 + 1] = v[1]; xv[i * 4 + 2] = v[2]; xv[i * 4 + 3] = v[3];
    }
    write_h_row(xv, p.pre_norm, MOD, H + (size_t)row * HP, l);
  }
}

__device__ __forceinline__ void lds_barrier() {
  asm volatile("s_waitcnt lgkmcnt(0)" ::: "memory");
  __builtin_amdgcn_s_barrier();
  asm volatile("" ::: "memory");
}
#define GEMM_BUF 55296
#define GEMM_EOFF 110592
template <int NT>
__device__ __forceinline__ void gemm_step(f16v (&acc)[4][NT], h8 (&ra)[8], h8 (&rb)[2 * NT],
                                          const unsigned char* As, const unsigned char* Bs, unsigned char* Aw, unsigned char* Bw,
                                          const half_t* __restrict__ A, int lda, const half_t* __restrict__ B, int ldb, int kload,
                                          int wm, int wn, int l, int r0, int kc) {
  constexpr int NF = (NT == 2) ? 2 : 1;
  h8 af[NF][4], bf[NF][NT];
  if (NF == 2) {
#pragma unroll
    for (int i = 0; i < 4; ++i) af[0][i] = *(const h8*)(As + (wm * 128 + i * 32 + (l & 31)) * 144 + (l >> 5) * 16);
#pragma unroll
    for (int j = 0; j < NT; ++j) bf[0][j] = *(const h8*)(Bs + (wn * 32 * NT + j * 32 + (l & 31)) * 144 + (l >> 5) * 16);
  }
#pragma unroll
  for (int ks = 0; ks < 4; ++ks) {
    if (NF == 2) {
      if (ks < 3) {
#pragma unroll
        for (int i = 0; i < 4; ++i) af[(ks + 1) & 1][i] = *(const h8*)(As + (wm * 128 + i * 32 + (l & 31)) * 144 + (ks + 1) * 32 + (l >> 5) * 16);
#pragma unroll
        for (int j = 0; j < NT; ++j) bf[(ks + 1) & 1][j] = *(const h8*)(Bs + (wn * 32 * NT + j * 32 + (l & 31)) * 144 + (ks + 1) * 32 + (l >> 5) * 16);
      }
    } else {
#pragma unroll
      for (int i = 0; i < 4; ++i) af[0][i] = *(const h8*)(As + (wm * 128 + i * 32 + (l & 31)) * 144 + ks * 32 + (l >> 5) * 16);
#pragma unroll
      for (int j = 0; j < NT; ++j) bf[0][j] = *(const h8*)(Bs + (wn * 32 * NT + j * 32 + (l & 31)) * 144 + ks * 32 + (l >> 5) * 16);
    }
#pragma unroll
    for (int i = 0; i < 4; ++i)
#pragma unroll
      for (int j = 0; j < NT; ++j) acc[i][j] = mfma16(af[(NF == 2) ? (ks & 1) : 0][i], bf[(NF == 2) ? (ks & 1) : 0][j], acc[i][j]);
#pragma unroll
    for (int i = 2 * ks; i < 2 * ks + 2; ++i) {
      *(h8*)(Aw + (r0 + 32 * i) * 144 + kc * 16) = ra[i];
      ra[i] = *(const h8*)(A + (size_t)(r0 + 32 * i) * lda + kload + kc * 8);
    }
    if (NT == 2) {
      *(h8*)(Bw + (r0 + 32 * ks) * 144 + kc * 16) = rb[ks];
      rb[ks] = *(const h8*)(B + (size_t)(r0 + 32 * ks) * ldb + kload + kc * 8);
    } else {
#pragma unroll
      for (int i = 2 * ks; i < 2 * ks + 2; ++i) {
        *(h8*)(Bw + (r0 + 32 * i) * 144 + kc * 16) = rb[i];
        rb[i] = *(const h8*)(B + (size_t)(r0 + 32 * i) * ldb + kload + kc * 8);
      }
    }
    __builtin_amdgcn_sched_barrier(0);
  }
}
template <int NT>
__device__ __forceinline__ void gemm_issue(h8 (&ra0)[8], h8 (&rb0)[2 * NT], h8 (&ra1)[8], h8 (&rb1)[2 * NT],
                                           const half_t* __restrict__ A, int lda, const half_t* __restrict__ B, int ldb) {
  const int tid = otid();
  const int kc = tid & 7, r0 = tid >> 3;
#pragma unroll
  for (int i = 0; i < 8; ++i) ra0[i] = *(const h8*)(A + (size_t)(r0 + 32 * i) * lda + kc * 8);
#pragma unroll
  for (int i = 0; i < 2 * NT; ++i) rb0[i] = *(const h8*)(B + (size_t)(r0 + 32 * i) * ldb + kc * 8);
#pragma unroll
  for (int i = 0; i < 8; ++i) ra1[i] = *(const h8*)(A + (size_t)(r0 + 32 * i) * lda + 64 + kc * 8);
#pragma unroll
  for (int i = 0; i < 2 * NT; ++i) rb1[i] = *(const h8*)(B + (size_t)(r0 + 32 * i) * ldb + 64 + kc * 8);
}
template <int NT>
__device__ __forceinline__ void gemm_run(f16v (&acc)[4][NT], h8 (&ra0)[8], h8 (&rb0)[2 * NT], h8 (&ra1)[8], h8 (&rb1)[2 * NT],
                                         const half_t* __restrict__ A, int lda, const half_t* __restrict__ B, int ldb, int K, unsigned char* lds) {
  const int tid = otid(), w = tid >> 6, l = tid & 63;
  constexpr int STAGE = 256 * 144 + 64 * NT * 144;
  unsigned char* A0 = lds;
  unsigned char* B0 = lds + 256 * 144;
  unsigned char* A1 = lds + STAGE;
  unsigned char* B1 = lds + STAGE + 256 * 144;
  const int wm = w >> 1, wn = w & 1;
  const int kc = tid & 7;
  const int r0 = tid >> 3;
  lds_barrier();
#pragma unroll
  for (int i = 0; i < 8; ++i) { *(h8*)(A0 + (r0 + 32 * i) * 144 + kc * 16) = ra0[i]; ra0[i] = *(const h8*)(A + (size_t)(r0 + 32 * i) * lda + 128 + kc * 8); }
#pragma unroll
  for (int i = 0; i < 2 * NT; ++i) { *(h8*)(B0 + (r0 + 32 * i) * 144 + kc * 16) = rb0[i]; rb0[i] = *(const h8*)(B + (size_t)(r0 + 32 * i) * ldb + 128 + kc * 8); }
  lds_barrier();
  const int nk = K / 64;
#pragma unroll 1
  for (int kt = 0; kt < nk; kt += 2) {
    gemm_step<NT>(acc, ra1, rb1, A0, B0, A1, B1, A, lda, B, ldb, (kt + 3 < nk) ? (kt + 3) * 64 : 0, wm, wn, l, r0, kc);
    lds_barrier();
    gemm_step<NT>(acc, ra0, rb0, A1, B1, A0, B0, A, lda, B, ldb, (kt + 4 < nk) ? (kt + 4) * 64 : 0, wm, wn, l, r0, kc);
    lds_barrier();
  }
}
template <int NT>
__device__ __forceinline__ void gemm_kloop(f16v (&acc)[4][NT], const half_t* __restrict__ A, int lda,
                                           const half_t* __restrict__ B, int ldb, int K, unsigned char* lds) {
  h8 ra0[8], rb0[2 * NT], ra1[8], rb1[2 * NT];
  gemm_issue<NT>(ra0, rb0, ra1, rb1, A, lda, B, ldb);
  gemm_run<NT>(acc, ra0, rb0, ra1, rb1, A, lda, B, ldb, K, lds);
}

template <int NT>
__device__ __forceinline__ void gemm_issue1(h8 (&ra)[8], h8 (&rb)[2 * NT], const half_t* __restrict__ A, int lda, const half_t* __restrict__ B, int ldb) {
  const int tid = otid();
  const int kc = tid & 7, r0 = tid >> 3;
#pragma unroll
  for (int i = 0; i < 8; ++i) ra[i] = *(const h8*)(A + (size_t)(r0 + 32 * i) * lda + kc * 8);
#pragma unroll
  for (int i = 0; i < 2 * NT; ++i) rb[i] = *(const h8*)(B + (size_t)(r0 + 32 * i) * ldb + kc * 8);
}
template <int NT>
__device__ __forceinline__ void gemm_run1(f16v (&acc)[4][NT], h8 (&ra)[8], h8 (&rb)[2 * NT],
                                          const half_t* __restrict__ A, int lda, const half_t* __restrict__ B, int ldb, int K, unsigned char* lds) {
  const int tid = otid(), w = tid >> 6, l = tid & 63;
  constexpr int STAGE = 256 * 144 + 64 * NT * 144;
  const int wm = w >> 1, wn = w & 1;
  const int kc = tid & 7;
  const int r0 = tid >> 3;
  lds_barrier();
#pragma unroll
  for (int i = 0; i < 8; ++i) { *(h8*)(lds + (r0 + 32 * i) * 144 + kc * 16) = ra[i]; ra[i] = *(const h8*)(A + (size_t)(r0 + 32 * i) * lda + 64 + kc * 8); }
#pragma unroll
  for (int i = 0; i < 2 * NT; ++i) { *(h8*)(lds + 256 * 144 + (r0 + 32 * i) * 144 + kc * 16) = rb[i]; rb[i] = *(const h8*)(B + (size_t)(r0 + 32 * i) * ldb + 64 + kc * 8); }
  lds_barrier();
  const int nk = K / 64;
#pragma unroll 1
  for (int kt = 0; kt < nk; ++kt) {
    unsigned char* cur = lds + (kt & 1) * STAGE;
    unsigned char* nxt = lds + ((kt + 1) & 1) * STAGE;
    gemm_step<NT>(acc, ra, rb, cur, cur + 256 * 144, nxt, nxt + 256 * 144, A, lda, B, ldb, (kt + 2 < nk) ? (kt + 2) * 64 : 0, wm, wn, l, r0, kc);
    lds_barrier();
  }
}

template <int NT>
__device__ __forceinline__ void zero_acc(f16v (&acc)[4][NT]) {
  float z = 0.f;
  asm volatile("" : "+v"(z));
#pragma unroll
  for (int i = 0; i < 4; ++i)
#pragma unroll
    for (int j = 0; j < NT; ++j)
#pragma unroll
      for (int r = 0; r < 16; ++r) acc[i][j][r] = z;
}

__device__ __forceinline__ void stage_pair(float* E, const f16v& a0, const f16v& a1, int l) {
#pragma unroll
  for (int r = 0; r < 16; ++r) {
    const int rr = crow(r, l);
    E[rr * 65 + (l & 31)] = a0[r];
    E[rr * 65 + 32 + (l & 31)] = a1[r];
  }
}

__device__ __forceinline__ int xcc_census(const unsigned* xcnt, int my_xcc) {
  unsigned sum = 0; bool ok = my_xcc < 8; int mine = 0;
#pragma unroll
  for (int j = 0; j < 16; ++j) {
    const unsigned c = __hip_atomic_load(xcnt + j, __ATOMIC_RELAXED, __HIP_MEMORY_SCOPE_AGENT);
    sum += c;
    if (j < 8 && c == 0u) ok = false;
    if (j >= 8 && c != 0u) ok = false;
    if (j == my_xcc) mine = (int)c;
  }
  if (sum != gridDim.x) ok = false;
  return ok ? mine : 0;
}

__device__ void phase_A(const Params& p, int layer, unsigned char* lds, int my_xcc, int my_loc, const unsigned* xcnt) {
  const int tid = otid(), w = tid >> 6, l = tid & 63;
  const half_t* H = (const half_t*)(p.ws + OFF_H);
  const half_t* Wt = (const half_t*)(p.ws + OFF_WINT) + (size_t)layer * NPAD * WP;
  half_t* P = (half_t*)(p.ws + OFF_P);
  float* GA = (float*)(p.ws + OFF_GA);
  float* IW = (float*)(p.ws + OFF_IW);
  const float* RT = (const float*)(p.ws + OFF_RT);
  const float* DT = (const float*)(p.ws + OFF_DT);
  const int wm = w >> 1, wn = w & 1;
  const int G = gridDim.x;
  const int ntiles = 64 * 31;
  const int nx = xcc_census(xcnt, my_xcc);
  int nmine;
  if (nx > 0) nmine = (my_loc < 248) ? (248 - my_loc + nx - 1) / nx : 0;
  else nmine = ((int)blockIdx.x < ntiles) ? (ntiles - (int)blockIdx.x + G - 1) / G : 0;
  h8 ra0[8], rb0[8];
  int mt = 0, nt = 0;
  if (nmine > 0) {
    if (nx > 0) { const int s0 = my_loc; mt = my_xcc * 8 + (s0 & 7); nt = s0 >> 3; }
    else { const int tix = blockIdx.x; mt = tix & 63; nt = tix >> 6; }
    gemm_issue1<4>(ra0, rb0, H + (size_t)mt * 256 * HP, HP, Wt + (size_t)nt * 256 * WP, WP);
  }
#pragma unroll 1
  for (int rnd = 0; rnd < nmine; ++rnd) {
    f16v acc[4][4];
    zero_acc<4>(acc);
    gemm_run1<4>(acc, ra0, rb0, H + (size_t)mt * 256 * HP, HP, Wt + (size_t)nt * 256 * WP, WP, 1024, lds);
    const int mt_cur = mt, nt_cur = nt;
    if (rnd + 1 < nmine) {
      if (nx > 0) { const int s1 = my_loc + nx * (rnd + 1); mt = my_xcc * 8 + (s1 & 7); nt = s1 >> 3; }
      else { const int tix = (rnd + 1) * G + blockIdx.x; mt = tix & 63; nt = tix >> 6; }
      gemm_issue1<4>(ra0, rb0, H + (size_t)mt * 256 * HP, HP, Wt + (size_t)nt * 256 * WP, WP);
    }
    const int m0w = mt_cur * 256 + wm * 128;
    const int n0w = nt_cur * 256 + wn * 128;
    float* E = (float*)(lds) + w * (32 * 65);
    const int prow = l >> 3, c0 = (l & 7) * 8;
#pragma unroll
    for (int jp = 0; jp < 2; ++jp) {
      const int nb2 = n0w + jp * 64;
      const int n0 = nb2 + c0;
      const bool rope64 = nb2 < 512;
      const bool rope16 = ((nb2 >= C_DSAQ && nb2 < C_DSAV) || (nb2 >= C_IDXQ && nb2 < C_GLAQ)) && (c0 < 16);
      float scale = 1.f;
      if (n0 < 256 || (n0 >= C_DSAQ && n0 < C_DSAK) || (n0 >= C_IDXQ && n0 < C_IDXK) || (n0 >= C_GLAQ && n0 < C_GLAK)) scale = 0.125f;
      int mode = 0;
      if ((n0 >= C_RETG && n0 < C_DSAQ) || (n0 >= C_DSAG && n0 < C_IDXQ) || (n0 >= C_GLAG && n0 < C_GLAA)) mode = 1;
      if (n0 >= C_MRG && n0 < C_END) mode = 2;
#pragma unroll
      for (int i = 0; i < 4; ++i) {
        stage_pair(E, acc[i][2 * jp], acc[i][2 * jp + 1], l);
#pragma unroll 1
        for (int ps = 0; ps < 4; ++ps) {
          const int rl = ps * 8 + prow;
          const int row = m0w + i * 32 + rl;
          float v[8], o[8];
#pragma unroll
          for (int q = 0; q < 8; ++q) { v[q] = E[rl * 65 + c0 + q]; o[q] = v[q]; }
          if (rope64) {
            const int cp = c0 ^ 32;
            const float* tb = RT + (size_t)row * 64 + (c0 & 31) * 2;
#pragma unroll
            for (int q = 0; q < 8; ++q) {
              const float pv = E[rl * 65 + cp + q];
              const float cs = tb[2 * q], sn = tb[2 * q + 1];
              o[q] = (c0 < 32) ? (v[q] * cs - pv * sn) : (v[q] * cs + pv * sn);
            }
          } else if (rope16) {
            const int cp = c0 ^ 8;
            const float* tb = DT + (size_t)row * 16;
#pragma unroll
            for (int q = 0; q < 8; ++q) {
              const float pv = E[rl * 65 + cp + q];
              const float cs = tb[2 * q], sn = tb[2 * q + 1];
              o[q] = (c0 < 8) ? (v[q] * cs - pv * sn) : (v[q] * cs + pv * sn);
            }
          }
          h8 ov;
#pragma unroll
          for (int q = 0; q < 8; ++q) {
            float t = o[q] * scale;
            if (mode == 1) t = t / (1.f + __expf(-t));
            else if (mode == 2) t = 1.f / (1.f + __expf(-t));
            ov[q] = (half_t)t;
          }
          if (n0 < C_END) __builtin_nontemporal_store(ov, (h8*)(P + (size_t)row * PP + n0));
          if (n0 >= C_GLAA && n0 < C_MRG) {
#pragma unroll
            for (int q = 0; q < 8; ++q) GA[(size_t)row * 16 + (n0 - C_GLAA) + q] = v[q];
          }
          if (n0 == C_IDXW) {
#pragma unroll
            for (int q = 0; q < 4; ++q) IW[(size_t)row * 4 + q] = 0.5f * v[q];
          }
        }
      }
    }
  }
}

#define LA_BC 0
#define LA_GAS 16640
#define LA_WL 20736
#define LA_QT 24832
#define LA_KT 34048
#define LA_AT 43264
#define LA_VT 52480
#define LA_SS 70912
#define LA_OS 89344
#define LA_SEG 123136

__device__ void la_bcum(const Params& p, int layer, int n, int Hh, unsigned char* lds) {
  const int tid = otid();
  float* Bc = (float*)(lds + LA_BC);
  const int d = tid & 63, q = tid >> 6;
  if (Hh < 4) {
    float lg = log1pf(-exp2f(-5.0f - (float)Hh));
#pragma unroll
    for (int jj = 0; jj < 16; ++jj) { int j = q * 16 + jj; Bc[j * 65 + d] = (float)(j + 1) * lg; }
    __syncthreads();
    return;
  }
  const int h = Hh - 4;
  float* GAs = (float*)(lds + LA_GAS);
  float* WL = (float*)(lds + LA_WL);
  float* SEG = (float*)(lds + LA_SEG);
  const float* GA = (const float*)(p.ws + OFF_GA);
#pragma unroll
  for (int i = 0; i < 4; ++i) {
    int e = tid + 256 * i;
    GAs[e] = GA[(size_t)n * 64 * 16 + e];
    int r = e >> 6, dd = e & 63;
    WL[e] = p.gla_w_lr[(size_t)layer * 16 * 256 + r * 256 + h * 64 + dd];
  }
  __syncthreads();
  float wl[16];
#pragma unroll
  for (int r = 0; r < 16; ++r) wl[r] = WL[r * 64 + d];
  const float bl = p.gla_b_lr[layer * 256 + h * 64 + d];
  float run = 0.f;
#pragma unroll
  for (int jj = 0; jj < 16; ++jj) {
    int j = q * 16 + jj;
    float z = bl;
#pragma unroll
    for (int r = 0; r < 16; ++r) z += GAs[j * 16 + r] * wl[r];
    float ls = fminf(z, 0.f) - log1pf(expf(-fabsf(z)));
    run += ls * (1.0f / 16.0f);
    Bc[j * 65 + d] = run;
  }
  SEG[q * 64 + d] = run;
  __syncthreads();
  float off = 0.f;
  for (int qq = 0; qq < q; ++qq) off += SEG[qq * 64 + d];
  if (q > 0) {
#pragma unroll
    for (int jj = 0; jj < 16; ++jj) { int j = q * 16 + jj; Bc[j * 65 + d] += off; }
  }
  __syncthreads();
}

__device__ __forceinline__ void la_stage_vt(const half_t* __restrict__ P, int t0, int vcol, unsigned char* lds) {
  const int tid = otid(), w = tid >> 6, l = tid & 63;
  half_t* VT = (half_t*)(lds + LA_VT);
  const int jp = l & 31, cgp = l >> 5;
#pragma unroll
  for (int it = 0; it < 2; ++it) {
    int c = it * 8 + w * 2 + cgp;
    h8 v0 = *(const h8*)(P + (size_t)(t0 + 2 * jp) * PP + vcol + c * 8);
    h8 v1 = *(const h8*)(P + (size_t)(t0 + 2 * jp + 1) * PP + vcol + c * 8);
#pragma unroll
    for (int q = 0; q < 8; ++q) {
      h2 pr; pr[0] = v0[q]; pr[1] = v1[q];
      *(h2*)(VT + (c * 8 + q) * 72 + 2 * jp) = pr;
    }
  }
}

__device__ void la_item_kv(const Params& p, int layer, int item, unsigned char* lds) {
  const int tid = otid(), w = tid >> 6, l = tid & 63;
  const int n = item >> 3, Hh = item & 7;
  const int t0 = n * 64;
  const half_t* P = (const half_t*)(p.ws + OFF_P);
  half_t* ST = (half_t*)(p.ws + OFF_ST);
  float* DEC = (float*)(p.ws + OFF_DEC);
  const int kcol = (Hh < 4) ? (C_RETK + Hh * 64) : (C_GLAK + (Hh - 4) * 64);
  const int vcol = (Hh < 4) ? (C_RETV + Hh * 128) : (C_GLAV + (Hh - 4) * 128);
  __syncthreads();
  la_bcum(p, layer, n, Hh, lds);
  const float* Bc = (const float*)(lds + LA_BC);
  half_t* KhT = (half_t*)(lds + LA_KT);
  half_t* VT = (half_t*)(lds + LA_VT);
  {
    const int jp = l & 31, cgp = l >> 5;
    int c = w * 2 + cgp;
    h8 k0 = *(const h8*)(P + (size_t)(t0 + 2 * jp) * PP + kcol + c * 8);
    h8 k1 = *(const h8*)(P + (size_t)(t0 + 2 * jp + 1) * PP + kcol + c * 8);
#pragma unroll
    for (int q = 0; q < 8; ++q) {
      int d = c * 8 + q;
      float bl = Bc[63 * 65 + d];
      h2 pr;
      pr[0] = (half_t)((float)k0[q] * __expf(bl - Bc[(2 * jp) * 65 + d]));
      pr[1] = (half_t)((float)k1[q] * __expf(bl - Bc[(2 * jp + 1) * 65 + d]));
      *(h2*)(KhT + d * 72 + 2 * jp) = pr;
    }
  }
  la_stage_vt(P, t0, vcol, lds);
  if (tid < 64) DEC[(size_t)item * 64 + tid] = __expf(Bc[63 * 65 + tid]);
  __syncthreads();
  f16v acc[2];
#pragma unroll
  for (int j = 0; j < 2; ++j)
#pragma unroll
    for (int r = 0; r < 16; ++r) acc[j][r] = ozero();
#pragma unroll
  for (int ks = 0; ks < 4; ++ks) {
    h8 a = *(const h8*)(VT + (32 * w + (l & 31)) * 72 + ks * 16 + (l >> 5) * 8);
#pragma unroll
    for (int j = 0; j < 2; ++j) {
      h8 b = *(const h8*)(KhT + (j * 32 + (l & 31)) * 72 + ks * 16 + (l >> 5) * 8);
      acc[j] = mfma16(a, b, acc[j]);
    }
  }
#pragma unroll
  for (int j = 0; j < 2; ++j)
#pragma unroll
    for (int r = 0; r < 16; ++r) {
      int e = 32 * w + crow(r, l);
      int d = j * 32 + (l & 31);
      ST[(size_t)item * 8192 + e * 64 + d] = (half_t)acc[j][r];
    }
}

__device__ void phase_scan(const Params& p) {
  half_t* ST = (half_t*)(p.ws + OFF_ST);
  const float* DEC = (const float*)(p.ws + OFF_DEC);
  for (int f2 = blockIdx.x * NTHREADS + otid(); f2 < 32768; f2 += gridDim.x * NTHREADS) {
    const int f = f2 * 2;
    const int Hh = f >> 13, d = f & 63;
    float s0 = 0.f, s1 = 0.f;
    for (int n0 = 0; n0 < 256; n0 += 16) {
      h2 kv[16]; float2 dc[16];
#pragma unroll
      for (int u = 0; u < 16; ++u) {
        kv[u] = *(const h2*)(ST + (size_t)(n0 + u) * 65536 + f);
        dc[u] = *(const float2*)(DEC + (size_t)((n0 + u) * 8 + Hh) * 64 + d);
      }
#pragma unroll
      for (int u = 0; u < 16; ++u) {
        h2 o; o[0] = (half_t)s0; o[1] = (half_t)s1;
        *(h2*)(ST + (size_t)(n0 + u) * 65536 + f) = o;
        s0 = dc[u].x * s0 + (float)kv[u][0];
        s1 = dc[u].y * s1 + (float)kv[u][1];
      }
    }
  }
}

__device__ void la_item_out(const Params& p, int layer, int item, unsigned char* lds) {
  const int tid = otid(), w = tid >> 6, l = tid & 63;
  const int n = item >> 3, Hh = item & 7;
  const int t0 = n * 64;
  const half_t* P = (const half_t*)(p.ws + OFF_P);
  const half_t* ST = (const half_t*)(p.ws + OFF_ST);
  half_t* BR = (half_t*)(p.ws + OFF_BR);
  const int qcol = (Hh < 4) ? (C_RETQ + Hh * 64) : (C_GLAQ + (Hh - 4) * 64);
  const int kcol = (Hh < 4) ? (C_RETK + Hh * 64) : (C_GLAK + (Hh - 4) * 64);
  const int vcol = (Hh < 4) ? (C_RETV + Hh * 128) : (C_GLAV + (Hh - 4) * 128);
  const int gcol = (Hh < 4) ? (C_RETG + Hh * 128) : (C_GLAG + (Hh - 4) * 128);
  const int ocol = (Hh < 4) ? (Hh * 128) : (1024 + (Hh - 4) * 128);
  __syncthreads();
  la_bcum(p, layer, n, Hh, lds);
  const float* Bc = (const float*)(lds + LA_BC);
  half_t* Qt = (half_t*)(lds + LA_QT);
  half_t* Kt = (half_t*)(lds + LA_KT);
  half_t* AT = (half_t*)(lds + LA_AT);
  half_t* VT = (half_t*)(lds + LA_VT);
  half_t* SS = (half_t*)(lds + LA_SS);
  float* OS = (float*)(lds + LA_OS);
#pragma unroll
  for (int it = 0; it < 2; ++it) {
    int c = tid + 256 * it;
    int row = c >> 3, kc = c & 7;
    h8 qv = *(const h8*)(P + (size_t)(t0 + row) * PP + qcol + kc * 8);
    h8 kv = *(const h8*)(P + (size_t)(t0 + row) * PP + kcol + kc * 8);
    h8 qo, ko;
#pragma unroll
    for (int q = 0; q < 8; ++q) {
      float b = Bc[row * 65 + kc * 8 + q];
      qo[q] = (half_t)((float)qv[q] * __expf(b));
      ko[q] = (half_t)((float)kv[q] * __expf(-b));
    }
    *(h8*)(Qt + row * 72 + kc * 8) = qo;
    *(h8*)(Kt + row * 72 + kc * 8) = ko;
  }
  la_stage_vt(P, t0, vcol, lds);
#pragma unroll
  for (int it = 0; it < 4; ++it) {
    int c = tid + 256 * it;
    int e = c >> 3, kc = c & 7;
    *(h8*)(SS + e * 72 + kc * 8) = *(const h8*)(ST + (size_t)item * 8192 + e * 64 + kc * 8);
  }
  __syncthreads();
  {
    const int mi = w >> 1, nj = w & 1;
    f16v acc;
#pragma unroll
    for (int r = 0; r < 16; ++r) acc[r] = ozero();
#pragma unroll
    for (int ks = 0; ks < 4; ++ks) {
      h8 a = *(const h8*)(Qt + (mi * 32 + (l & 31)) * 72 + ks * 16 + (l >> 5) * 8);
      h8 b = *(const h8*)(Kt + (nj * 32 + (l & 31)) * 72 + ks * 16 + (l >> 5) * 8);
      acc = mfma16(a, b, acc);
    }
#pragma unroll
    for (int r = 0; r < 16; ++r) {
      int i = mi * 32 + crow(r, l);
      int j = nj * 32 + (l & 31);
      float v = (j <= i) ? acc[r] : 0.f;
      AT[i * 72 + j] = (half_t)v;
    }
  }
  __syncthreads();
  {
    const int mi = w >> 1, nh = w & 1;
    f16v acc[2];
#pragma unroll
    for (int j = 0; j < 2; ++j)
#pragma unroll
      for (int r = 0; r < 16; ++r) acc[j][r] = ozero();
#pragma unroll
    for (int ks = 0; ks < 4; ++ks) {
      h8 a1 = *(const h8*)(AT + (mi * 32 + (l & 31)) * 72 + ks * 16 + (l >> 5) * 8);
      h8 a2 = *(const h8*)(Qt + (mi * 32 + (l & 31)) * 72 + ks * 16 + (l >> 5) * 8);
#pragma unroll
      for (int j = 0; j < 2; ++j) {
        h8 b1 = *(const h8*)(VT + (nh * 64 + j * 32 + (l & 31)) * 72 + ks * 16 + (l >> 5) * 8);
        h8 b2 = *(const h8*)(SS + (nh * 64 + j * 32 + (l & 31)) * 72 + ks * 16 + (l >> 5) * 8);
        acc[j] = mfma16(a1, b1, acc[j]);
        acc[j] = mfma16(a2, b2, acc[j]);
      }
    }
#pragma unroll
    for (int j = 0; j < 2; ++j)
#pragma unroll
      for (int r = 0; r < 16; ++r) {
        int i = mi * 32 + crow(r, l);
        int e = nh * 64 + j * 32 + (l & 31);
        OS[i * 132 + e] = acc[j][r];
      }
  }
  __syncthreads();
  {
    const int i = tid >> 2, qd = tid & 3;
    float ov[32];
    float ss = 0.f;
#pragma unroll
    for (int c = 0; c < 8; ++c) {
      f4v v = *(const f4v*)(OS + i * 132 + qd * 32 + c * 4);
      ov[c * 4] = v[0]; ov[c * 4 + 1] = v[1]; ov[c * 4 + 2] = v[2]; ov[c * 4 + 3] = v[3];
      ss += v[0] * v[0] + v[1] * v[1] + v[2] * v[2] + v[3] * v[3];
    }
    ss += dppf<0xB1>(ss);
    ss += dppf<0x4E>(ss);
    float rs = rsqrtf(ss * (1.0f / 128.0f) + 1e-6f);
#pragma unroll
    for (int c = 0; c < 4; ++c) {
      h8 g = *(const h8*)(P + (size_t)(t0 + i) * PP + gcol + qd * 32 + c * 8);
      h8 o;
#pragma unroll
      for (int q = 0; q < 8; ++q) o[q] = (half_t)(ov[c * 8 + q] * rs * (float)g[q]);
      *(h8*)(BR + (size_t)(t0 + i) * 1536 + ocol + qd * 32 + c * 8) = o;
    }
  }
}

#define DS_CAP 640
#define DS_PRUNE_AT 512
#define NPL 10
#define DS_LS 0
#define DS_LI (32 * DS_CAP * 4)
#define DS_CNT (32 * DS_CAP * 6)
#define DS_THR (DS_CNT + 128)
#define DS_WQ (DS_CNT + 256)
#define DS_HIST (DS_CNT + 1024)
#define DS_PW (DS_CNT + 1024 + 4096)

__device__ __forceinline__ unsigned long long wave_or64(unsigned long long v) {
  const unsigned lo = wave_or((unsigned)v), hi = wave_or((unsigned)(v >> 32));
  return ((unsigned long long)hi << 32) | lo;
}
__device__ __forceinline__ void dsa_prune(float* LSm, unsigned short* LIm, int n, unsigned* hist, int* cntm, float* thrm, int l) {
  unsigned long long comp[NPL];
  bool act[NPL], val[NPL];
#pragma unroll
  for (int k = 0; k < NPL; ++k) {
    int e = l + 64 * k;
    val[k] = e < n;
    unsigned u = 0, li = 0;
    if (val[k]) { u = __float_as_uint(LSm[e]); li = LIm[e]; }
    const unsigned key = (u >> 31) ? ~u : (u | 0x80000000u);
    comp[k] = ((unsigned long long)key << 14) | (unsigned long long)(16383u - li);
    act[k] = val[k];
  }
  const unsigned long long c0 = ((unsigned long long)(unsigned)__builtin_amdgcn_readfirstlane((int)(unsigned)(comp[0] >> 32)) << 32) | (unsigned)__builtin_amdgcn_readfirstlane((int)(unsigned)comp[0]);
  unsigned long long x = 0;
#pragma unroll
  for (int k = 0; k < NPL; ++k) x |= val[k] ? (comp[k] ^ c0) : 0ull;
  x = wave_or64(x);
  int shift = (x == 0ull) ? 0 : (63 - __clzll((long long)x)) - 7;
  if (shift < 0) shift = 0;
  unsigned rank = 256;
#pragma unroll 1
  for (int rd = 0; rd < 8; ++rd) {
    *(uint4*)(hist + 4 * l) = make_uint4(0, 0, 0, 0);
    __threadfence_block();
    unsigned dk[NPL];
#pragma unroll
    for (int k = 0; k < NPL; ++k) {
      dk[k] = (unsigned)(comp[k] >> shift) & 255u;
      if (act[k]) atomicAdd(&hist[dk[k]], 1u);
    }
    __threadfence_block();
    uint4 hv; hv.x = hist[4 * l]; hv.y = hist[4 * l + 1]; hv.z = hist[4 * l + 2]; hv.w = hist[4 * l + 3];
    unsigned tl = hv.x + hv.y + hv.z + hv.w;
    const unsigned pin = wave_incl_scan(tl);
    const unsigned tot = (unsigned)__builtin_amdgcn_readlane((int)pin, 63);
    unsigned sx = tot - pin;
    bool mine = (sx < rank) && (rank <= sx + tl);
    unsigned dsel = 0, nr = 0, hsel = 0;
    if (mine) {
      unsigned c = sx;
      if (c + hv.w >= rank) { dsel = 4 * l + 3; nr = rank - c; hsel = hv.w; }
      else {
        c += hv.w;
        if (c + hv.z >= rank) { dsel = 4 * l + 2; nr = rank - c; hsel = hv.z; }
        else {
          c += hv.z;
          if (c + hv.y >= rank) { dsel = 4 * l + 1; nr = rank - c; hsel = hv.y; }
          else { c += hv.y; dsel = 4 * l; nr = rank - c; hsel = hv.x; }
        }
      }
    }
    unsigned long long mk = __ballot(mine);
    int src = (mk == 0ull) ? 0 : (__ffsll((long long)mk) - 1);
    dsel = (unsigned)__builtin_amdgcn_readlane((int)dsel, src);
    rank = (unsigned)__builtin_amdgcn_readlane((int)nr, src);
    hsel = (unsigned)__builtin_amdgcn_readlane((int)hsel, src);
#pragma unroll
    for (int k = 0; k < NPL; ++k) act[k] = act[k] && (dk[k] == dsel);
    if (hsel <= 1u || shift == 0) break;
    shift = (shift >= 8) ? (shift - 8) : 0;
  }
  unsigned long long tsel = 0;
#pragma unroll
  for (int k = 0; k < NPL; ++k) tsel |= act[k] ? comp[k] : 0ull;
  const unsigned long long T = wave_or64(tsel);
  bool keep[NPL];
  unsigned cntk = 0;
#pragma unroll
  for (int k = 0; k < NPL; ++k) {
    keep[k] = val[k] && (comp[k] >= T);
    cntk += keep[k] ? 1u : 0u;
  }
  unsigned pos = wave_incl_scan(cntk) - cntk;
  __threadfence_block();
#pragma unroll
  for (int k = 0; k < NPL; ++k) {
    if (keep[k]) {
      const unsigned kk = (unsigned)(comp[k] >> 14);
      const unsigned u = (kk & 0x80000000u) ? (kk & 0x7FFFFFFFu) : ~kk;
      LSm[pos] = __uint_as_float(u);
      LIm[pos] = (unsigned short)(16383u - ((unsigned)comp[k] & 16383u));
      ++pos;
    }
  }
  if (l == 0) {
    const unsigned T32 = (unsigned)(T >> 14);
    *cntm = 256;
    *thrm = __uint_as_float((T32 & 0x80000000u) ? (T32 & 0x7FFFFFFFu) : ~T32);
  }
  __threadfence_block();
}

__device__ void dsa_item(const Params& p, int qb, unsigned char* lds) {
  const int tid = otid(), w = tid >> 6, l = tid & 63;
  const int t0 = qb * 32;
  const half_t* P = (const half_t*)(p.ws + OFF_P);
  const float* IW = (const float*)(p.ws + OFF_IW);
  half_t* BR = (half_t*)(p.ws + OFF_BR);
  float* LS = (float*)(lds + DS_LS);
  unsigned short* LI = (unsigned short*)(lds + DS_LI);
  int* cnt = (int*)(lds + DS_CNT);
  float* thr = (float*)(lds + DS_THR);
  float* wq = (float*)(lds + DS_WQ);
  unsigned* hist = (unsigned*)(lds + DS_HIST) + w * 256;
  float* PW = (float*)(lds + DS_PW) + w * 1024;
  half_t* QS = (half_t*)(lds + DS_PW + 16384) + w * 512;
  for (int rep_sel = 0; rep_sel < REP_SEL; ++rep_sel) {
  __syncthreads();
  if (tid < 32) { cnt[tid] = 0; thr[tid] = -INFINITY; }
  if (tid < 128) wq[tid] = IW[(size_t)t0 * 4 + tid];
  __syncthreads();
  h8 aq[4][4];
#pragma unroll
  for (int h = 0; h < 4; ++h)
#pragma unroll
    for (int ks = 0; ks < 4; ++ks)
      aq[h][ks] = *(const h8*)(P + (size_t)(t0 + (l & 31)) * PP + C_IDXQ + h * 64 + ks * 16 + (l >> 5) * 8);
  const int nt = qb + 1;
  const int nr = (nt + 3) >> 2;
  f4v wqv[16];
#pragma unroll
  for (int r = 0; r < 16; ++r) wqv[r] = *(const f4v*)(wq + crow(r, l) * 4);
  float thv[16];
  { float ninf = -INFINITY; asm volatile("" : "+v"(ninf));
#pragma unroll
  for (int r = 0; r < 16; ++r) thv[r] = ninf; }
  h8 bk[4];
  {
    const int k0 = (w < nt) ? w : 0;
#pragma unroll
    for (int ks = 0; ks < 4; ++ks)
      bk[ks] = *(const h8*)(P + (size_t)(k0 * 32 + (l & 31)) * PP + C_IDXK + ks * 16 + (l >> 5) * 8);
  }
#pragma unroll 1
  for (int rd = 0; rd < nr; ++rd) {
    const int kt = 4 * rd + w;
    h8 bkn[4];
    {
      const int kn = (kt + 4 < nt) ? (kt + 4) : 0;
#pragma unroll
      for (int ks = 0; ks < 4; ++ks)
        bkn[ks] = *(const h8*)(P + (size_t)(kn * 32 + (l & 31)) * PP + C_IDXK + ks * 16 + (l >> 5) * 8);
    }
    if (kt < nt) {
      const int sbase = kt * 32;
      f16v acc[4];
#pragma unroll
      for (int h = 0; h < 4; ++h) {
#pragma unroll
        for (int r = 0; r < 16; ++r) acc[h][r] = ozero();
#pragma unroll
        for (int ks = 0; ks < 4; ++ks) acc[h] = mfma16(aq[h][ks], bk[ks], acc[h]);
      }
      const int s = sbase + (l & 31);
      float scv[16];
      unsigned pm = 0;
#pragma unroll
      for (int r = 0; r < 16; ++r) {
        const int m = crow(r, l);
        const f4v wv = wqv[r];
        float sc = wv[0] * relu_f(acc[0][r]) + wv[1] * relu_f(acc[1][r]) + wv[2] * relu_f(acc[2][r]) + wv[3] * relu_f(acc[3][r]);
        sc += 0.0f;
        scv[r] = sc;
      }
      if (kt == qb) {
#pragma unroll
        for (int r = 0; r < 16; ++r) if (s > t0 + crow(r, l)) scv[r] = -INFINITY;
      }
#pragma unroll
      for (int r = 0; r < 16; ++r) pm |= (scv[r] > thv[r]) ? (1u << r) : 0u;
      if (__ballot(pm != 0u) != 0ull) {
        unsigned long long mks[16];
        int mycnt = 0;
#pragma unroll
        for (int r = 0; r < 16; ++r) {
          const unsigned long long mk = __ballot(((pm >> r) & 1u) != 0u);
          mks[r] = mk;
          const unsigned hm = (l < 32) ? (unsigned)mk : (unsigned)(mk >> 32);
          if ((l & 31) == r) mycnt = __popc(hm);
        }
        int base = 0;
        if ((l & 31) < 16 && mycnt > 0) base = atomicAdd(&cnt[crow(l & 31, l)], mycnt);
#pragma unroll
        for (int r = 0; r < 16; ++r) {
          const unsigned long long mk = mks[r];
          if (mk != 0ull) {
            const unsigned hm = (l < 32) ? (unsigned)mk : (unsigned)(mk >> 32);
            const int b_lo = __builtin_amdgcn_readlane(base, r), b_hi = __builtin_amdgcn_readlane(base, 32 + r);
            const int bb = (l < 32) ? b_lo : b_hi;
            if ((pm >> r) & 1u) {
              const int m = crow(r, l);
              const int slot = bb + __popc(hm & ((1u << (l & 31)) - 1u));
              LS[m * DS_CAP + slot] = scv[r];
              LI[m * DS_CAP + slot] = (unsigned short)s;
            }
          }
        }
      }
    }
    __syncthreads();
    bool any_prune;
    {
      const int cv = (l < 32) ? cnt[l] : 0;
      unsigned pmask = (unsigned)__ballot(cv > DS_PRUNE_AT);
      any_prune = pmask != 0u;
      int j = 0;
      while (pmask != 0u) {
        const int m = __ffs((int)pmask) - 1;
        pmask &= pmask - 1u;
        if ((j & 3) == w) dsa_prune(LS + m * DS_CAP, LI + m * DS_CAP, cnt[m], hist, cnt + m, thr + m, l);
        ++j;
      }
    }
    __syncthreads();
    if (any_prune) {
#pragma unroll
      for (int r = 0; r < 16; ++r) thv[r] = thr[crow(r, l)];
    }
#pragma unroll
    for (int ks = 0; ks < 4; ++ks) bk[ks] = bkn[ks];
  }
  }
#pragma unroll 1
  for (int mm = 0; mm < 8; ++mm) {
    const int m = w * 8 + mm;
    const int c = cnt[m];
    if (c > 256) dsa_prune(LS + m * DS_CAP, LI + m * DS_CAP, c, hist, cnt + m, thr + m, l);
  }
  asm volatile("s_waitcnt lgkmcnt(0)" ::: "memory");
  for (int rep_att = 0; rep_att < REP_ATT; ++rep_att) {
  h8 kvr[4][8];
  {
    const int m = w * 8;
    const int c = min(cnt[m], 256);
    const unsigned short* LIm = LI + m * DS_CAP;
#pragma unroll
    for (int kk = 0; kk < 4; ++kk) {
      const int e = l + 64 * kk;
      const int s = (e < c) ? (int)LIm[e] : 0;
      const half_t* kr = P + (size_t)s * PP + C_DSAK;
#pragma unroll
      for (int ch = 0; ch < 8; ++ch) kvr[kk][ch] = *(const h8*)(kr + ch * 8);
    }
  }
  h8 qreg = *(const h8*)(P + (size_t)(t0 + w * 8) * PP + C_DSAQ + l * 8);
  const int dch = l & 7, ksub = l >> 3;
#pragma unroll 1
  for (int u = 0; u < 16; ++u) {
    const int mm = u >> 1, g = u & 1;
    const int m = w * 8 + mm;
    const int t = t0 + m;
    const int c = min(cnt[m], 256);
    const unsigned short* LIm = LI + m * DS_CAP;
    if (g == 0) {
      *(h8*)(QS + l * 8) = qreg;
      const int mq = (mm < 7) ? (m + 1) : m;
      qreg = *(const h8*)(P + (size_t)(t0 + mq) * PP + C_DSAQ + l * 8);
    }
    h8 gt[4];
#pragma unroll
    for (int hh = 0; hh < 4; ++hh) gt[hh] = *(const h8*)(P + (size_t)t * PP + C_DSAG + (g * 4 + hh) * 64 + dch * 8);
    h8 vv[16];
#pragma unroll
    for (int i = 0; i < 16; ++i) {
      const int e = i * 8 + ksub;
      const int s = (e < c) ? (int)LIm[e] : 0;
      vv[i] = *(const h8*)(P + (size_t)s * PP + C_DSAV + g * 64 + dch * 8);
    }
    asm volatile("s_waitcnt lgkmcnt(0)" ::: "memory");
    float lg[4][4];
#pragma unroll
    for (int hh = 0; hh < 4; ++hh) {
#pragma unroll
      for (int kk = 0; kk < 4; ++kk) lg[hh][kk] = ozero();
#pragma unroll
      for (int ch = 0; ch < 8; ++ch) {
        const h8 qq = *(const h8*)(QS + (g * 4 + hh) * 64 + ch * 8);
#pragma unroll
        for (int kk = 0; kk < 4; ++kk) {
          float a = lg[hh][kk];
          a = __builtin_amdgcn_fdot2(__builtin_shufflevector(qq, qq, 0, 1), __builtin_shufflevector(kvr[kk][ch], kvr[kk][ch], 0, 1), a, false);
          a = __builtin_amdgcn_fdot2(__builtin_shufflevector(qq, qq, 2, 3), __builtin_shufflevector(kvr[kk][ch], kvr[kk][ch], 2, 3), a, false);
          a = __builtin_amdgcn_fdot2(__builtin_shufflevector(qq, qq, 4, 5), __builtin_shufflevector(kvr[kk][ch], kvr[kk][ch], 4, 5), a, false);
          a = __builtin_amdgcn_fdot2(__builtin_shufflevector(qq, qq, 6, 7), __builtin_shufflevector(kvr[kk][ch], kvr[kk][ch], 6, 7), a, false);
          lg[hh][kk] = a;
        }
      }
#pragma unroll
      for (int kk = 0; kk < 4; ++kk) lg[hh][kk] = (l + 64 * kk < c) ? lg[hh][kk] : -INFINITY;
    }
    {
      const int un = (u < 15) ? (u + 1) : 15;
      const int mn = w * 8 + (un >> 1), gn = un & 1;
      const int cn = min(cnt[mn], 256);
      const unsigned short* LIn = LI + mn * DS_CAP;
#pragma unroll
      for (int kk = 0; kk < 4; ++kk) {
        const int e = l + 64 * kk;
        const int s = (e < cn) ? (int)LIn[e] : 0;
        const half_t* kr = P + (size_t)s * PP + C_DSAK + gn * 64;
#pragma unroll
        for (int ch = 0; ch < 8; ++ch) kvr[kk][ch] = *(const h8*)(kr + ch * 8);
      }
    }
#pragma unroll
    for (int hh = 0; hh < 4; ++hh) {
      float mx = fmaxf(fmaxf(lg[hh][0], lg[hh][1]), fmaxf(lg[hh][2], lg[hh][3]));
      mx = wave_max(mx);
      float ev[4]; float sm = 0.f;
#pragma unroll
      for (int kk = 0; kk < 4; ++kk) { ev[kk] = __expf(lg[hh][kk] - mx); sm += ev[kk]; }
      sm = wave_sum(sm);
      const float inv = 1.0f / sm;
#pragma unroll
      for (int kk = 0; kk < 4; ++kk) PW[(l + 64 * kk) * 4 + hh] = ev[kk] * inv;
    }
    asm volatile("s_waitcnt lgkmcnt(0)" ::: "memory");
    float o[4][8];
#pragma unroll
    for (int hh = 0; hh < 4; ++hh)
#pragma unroll
      for (int q = 0; q < 8; ++q) o[hh][q] = ozero();
    const int nit = (c + 7) >> 3;
#pragma unroll 1
    for (int it0 = 0; it0 < nit; it0 += 16) {
      if (it0 > 0) {
#pragma unroll
        for (int i = 0; i < 16; ++i) {
          const int e = (it0 + i) * 8 + ksub;
          const int s = (e < c) ? (int)LIm[e] : 0;
          vv[i] = *(const h8*)(P + (size_t)s * PP + C_DSAV + g * 64 + dch * 8);
        }
      }
#pragma unroll
      for (int i = 0; i < 16; ++i) {
        const int e = (it0 + i) * 8 + ksub;
        const f4v pv = *(const f4v*)(PW + e * 4);
#pragma unroll
        for (int hh = 0; hh < 4; ++hh)
#pragma unroll
          for (int q = 0; q < 8; ++q) o[hh][q] += pv[hh] * (float)vv[i][q];
      }
    }
#pragma unroll
    for (int hh = 0; hh < 4; ++hh)
#pragma unroll
      for (int q = 0; q < 8; ++q) {
        float v = o[hh][q];
        v += dppf<0x128>(v); v += xor16f(v); v += xor32f(v);
        o[hh][q] = v;
      }
    if (l < 8) {
#pragma unroll
      for (int hh = 0; hh < 4; ++hh) {
        const int col = (g * 4 + hh) * 64 + dch * 8;
        h8 ov;
#pragma unroll
        for (int q = 0; q < 8; ++q) ov[q] = (half_t)(o[hh][q] * (float)gt[hh][q]);
        *(h8*)(BR + (size_t)t * 1536 + 512 + col) = ov;
      }
    }
    asm volatile("s_waitcnt lgkmcnt(0)" ::: "memory");
  }
  }
}

__device__ void phase_B(const Params& p, int layer, unsigned char* lds) {
  const int G = gridDim.x;
  for (int j = 0; j * G < 512; ++j) {
    const int b = (j & 1) ? (G - 1 - (int)blockIdx.x) : (int)blockIdx.x;
    const int idx = j * G + b;
#ifndef NO_DSA
    if (idx < 512) dsa_item(p, 511 - idx, lds);
#endif
  }
  for (int rep = 0; rep < REP_KV; ++rep)
  for (int it = blockIdx.x; it < 2048; it += G) la_item_kv(p, layer, it, lds);
}

__device__ void phase_E1(const Params& p, int layer, unsigned char* lds, int my_xcc, int my_loc, const unsigned* xcnt) {
  const int tid = otid(), w = tid >> 6, l = tid & 63;
  const half_t* BR = (const half_t*)(p.ws + OFF_BR);
  const half_t* WbrT = (const half_t*)(p.ws + OFF_WBRT) + (size_t)layer * 3 * 1024 * WBP;
  const half_t* P = (const half_t*)(p.ws + OFF_P);
  half_t* Y1 = (half_t*)(p.ws + OFF_H);
  const int wm = w >> 1, wn = w & 1;
  float* E = (float*)(lds + GEMM_EOFF) + w * (32 * 65);
  const int prow = l >> 3, c0 = (l & 7) * 8;
  const int nx = xcc_census(xcnt, my_xcc);
  const int nrounds = (nx > 0) ? (64 + nx - 1) / nx : (512 + (int)gridDim.x - 1) / (int)gridDim.x;
  for (int rnd = 0; rnd < nrounds; ++rnd) {
    int mt, nt;
    if (nx > 0) {
      const int s = my_loc + nx * rnd;
      if (s >= 64) continue;
      mt = my_xcc * 8 + (s & 7); nt = s >> 3;
    } else {
      const int tix = rnd * (int)gridDim.x + (int)blockIdx.x;
      if (tix >= 512) continue;
      mt = tix & 63; nt = tix >> 6;
    }
    h8 tot[4][4];
#pragma unroll
    for (int i = 0; i < 4; ++i)
#pragma unroll
      for (int ps = 0; ps < 4; ++ps)
#pragma unroll
        for (int q = 0; q < 8; ++q) tot[i][ps][q] = (half_t)ozero();
    const int m0w = mt * 256 + wm * 128;
    const int n0 = nt * 128 + wn * 64 + c0;
#pragma unroll 1
    for (int b = 0; b < 3; ++b) {
      f16v acc[4][2];
      zero_acc<2>(acc);
      gemm_kloop<2>(acc, BR + (size_t)mt * 256 * 1536 + b * 512, 1536, WbrT + (size_t)b * 1024 * WBP + (size_t)nt * 128 * WBP, WBP, 512, lds);
#pragma unroll
      for (int i = 0; i < 4; ++i) {
        stage_pair(E, acc[i][0], acc[i][1], l);
#pragma unroll
        for (int ps = 0; ps < 4; ++ps) {
          const int rl = ps * 8 + prow;
          const int row = m0w + i * 32 + rl;
          const h8 g = *(const h8*)(P + (size_t)row * PP + C_MRG + b * 1024 + n0);
#pragma unroll
          for (int q = 0; q < 8; ++q) tot[i][ps][q] = (half_t)((float)tot[i][ps][q] + (float)g[q] * E[rl * 65 + c0 + q]);
        }
      }
    }
#pragma unroll
    for (int i = 0; i < 4; ++i)
#pragma unroll
      for (int ps = 0; ps < 4; ++ps) {
        const int row = m0w + i * 32 + ps * 8 + prow;
        *(h8*)(Y1 + (size_t)row * HP + n0) = tot[i][ps];
      }
  }
}

__device__ void phase_E2(const Params& p, int layer, unsigned char* lds, int my_xcc, int my_loc, const unsigned* xcnt) {
  const int tid = otid(), w = tid >> 6, l = tid & 63;
  const half_t* Y1 = (const half_t*)(p.ws + OFF_H);
  const half_t* Wo = (const half_t*)(p.ws + OFF_WOUTT) + (size_t)layer * 1024 * WP;
  float* Y = (float*)(p.ws + OFF_ST);
  const int wm = w >> 1, wn = w & 1;
  const int nx = xcc_census(xcnt, my_xcc);
  const int nrounds = (nx > 0) ? (64 + nx - 1) / nx : (512 + (int)gridDim.x - 1) / (int)gridDim.x;
  for (int rnd = 0; rnd < nrounds; ++rnd) {
    int mt, nt;
    if (nx > 0) {
      const int s = my_loc + nx * rnd;
      if (s >= 64) continue;
      mt = my_xcc * 8 + (s & 7); nt = s >> 3;
    } else {
      const int tix = rnd * (int)gridDim.x + (int)blockIdx.x;
      if (tix >= 512) continue;
      mt = tix & 63; nt = tix >> 6;
    }
    f16v acc[4][2];
    zero_acc<2>(acc);
    gemm_kloop<2>(acc, Y1 + (size_t)mt * 256 * HP, HP, Wo + (size_t)nt * 128 * WP, WP, 1024, lds);
    const int m0w = mt * 256 + wm * 128;
    const int n0w = nt * 128 + wn * 64;
#pragma unroll
    for (int i = 0; i < 4; ++i)
#pragma unroll
      for (int j = 0; j < 2; ++j)
#pragma unroll
        for (int r = 0; r < 16; ++r) {
          const int row = m0w + i * 32 + crow(r, l);
          const int n = n0w + j * 32 + (l & 31);
          Y[(size_t)row * 1024 + n] = acc[i][j][r];
        }
  }
}

__device__ void phase_E3(const Params& p, int layer) {
  const int w = otid() >> 6, l = otid() & 63;
  const float* Y = (const float*)(p.ws + OFF_ST);
  const float* MOD = (const float*)(p.ws + OFF_MOD);
  half_t* H = (half_t*)(p.ws + OFF_H);
  const float* xin = (layer == 0) ? p.x : p.out;
  const float* gate = MOD + layer * 3072 + 2048;
  const float* post = p.post_norm + layer * 1024;
  const int stride = gridDim.x * 4;
  int row = blockIdx.x * 4 + w;
  f4v yn[4], xn[4];
  if (row < S_LEN) {
#pragma unroll
    for (int i = 0; i < 4; ++i) {
      yn[i] = *(const f4v*)(Y + (size_t)row * 1024 + i * 256 + l * 4);
      xn[i] = *(const f4v*)(xin + (size_t)row * 1024 + i * 256 + l * 4);
    }
  }
  for (; row < S_LEN; row += stride) {
    float yv[16], xv[16];
    float ss = 0.f;
#pragma unroll
    for (int i = 0; i < 4; ++i)
#pragma unroll
      for (int q = 0; q < 4; ++q) { yv[i * 4 + q] = yn[i][q]; xv[i * 4 + q] = xn[i][q]; ss += yn[i][q] * yn[i][q]; }
    const int nrow = (row + stride < S_LEN) ? (row + stride) : row;
#pragma unroll
    for (int i = 0; i < 4; ++i) {
      yn[i] = *(const f4v*)(Y + (size_t)nrow * 1024 + i * 256 + l * 4);
      xn[i] = *(const f4v*)(xin + (size_t)nrow * 1024 + i * 256 + l * 4);
    }
    ss = wave_sum(ss);
    const float rs = rsqrtf(ss * (1.0f / 1024.0f) + 1e-6f);
#pragma unroll
    for (int i = 0; i < 4; ++i) {
      const int c0 = i * 256 + l * 4;
      f4v gt = *(const f4v*)(gate + c0);
      f4v pn = *(const f4v*)(post + c0);
      f4v o;
#pragma unroll
      for (int q = 0; q < 4; ++q) { o[q] = xv[i * 4 + q] + gt[q] * (yv[i * 4 + q] * rs * pn[q]); xv[i * 4 + q] = o[q]; }
      *(f4v*)(p.out + (size_t)row * 1024 + c0) = o;
    }
    if (layer + 1 < DEPTH)
      write_h_row(xv, p.pre_norm + (layer + 1) * 1024, MOD + (layer + 1) * 3072, H + (size_t)row * HP, l);
  }
}

#define XB_TMO      128
#define XB_XCNT(j)  (256  + 64 * (j))
#define XB_XSUB(j)  (1280 + 64 * (j))
#define XB_XGEN(j)  (2304 + 64 * (j))
#define XB_TOP      3328
#define XB_TOPGEN   3392
#define XCD_BAR_WORDS 3456
#define XB_SPIN_CAP (1u << 18)
#define LAS __attribute__((address_space(3)))

__device__ __forceinline__ unsigned xb_ld(unsigned* p)              { return __hip_atomic_load(p, __ATOMIC_RELAXED, __HIP_MEMORY_SCOPE_AGENT); }
__device__ __forceinline__ unsigned xb_add(unsigned* p, unsigned v) { return __hip_atomic_fetch_add(p, v, __ATOMIC_RELAXED, __HIP_MEMORY_SCOPE_AGENT); }
__device__ __forceinline__ unsigned xb_xcc_id() { return (unsigned)__builtin_amdgcn_s_getreg((3 << 11) | 20) & 0xFu; }
#define XB_SPIN(cond, bar) do { unsigned _sp = 0; while (cond) { __builtin_amdgcn_s_sleep(1); \
    if ((++_sp & 255u) == 0u) { if (xb_ld(&(bar)[XB_TMO])) break; if (_sp > XB_SPIN_CAP) { atomicAdd(&(bar)[XB_TMO], 1u); break; } } } } while (0)

struct XcdBarrier {
    unsigned* bar; unsigned x;
    volatile LAS unsigned* st;
};

__device__ __forceinline__ XcdBarrier xcd_barrier_post(unsigned* bar, volatile LAS unsigned* st) {
    XcdBarrier b; b.bar = bar; b.x = xb_xcc_id(); b.st = st;
    if (otid() == 0) (void)xb_add(&bar[XB_XCNT(b.x)], 1u);
    return b;
}
__device__ __forceinline__ void xcd_barrier_complete(unsigned* bar, unsigned x, unsigned& nloc, unsigned& nx) {
    const unsigned G = gridDim.x * gridDim.y * gridDim.z;
    unsigned sum, cnt, mine, sp = 0u;
    for (;;) {
        sum = 0u; cnt = 0u; mine = 0u;
#pragma unroll
        for (unsigned j = 0; j < 16; ++j) { const unsigned c = xb_ld(&bar[XB_XCNT(j)]); sum += c; cnt += (c > 0u) ? 1u : 0u; mine = (j == x) ? c : mine; }
        if (sum == G) break;
        __builtin_amdgcn_s_sleep(1);
        if ((++sp & 255u) == 0u) { if (xb_ld(&bar[XB_TMO])) break; if (sp > XB_SPIN_CAP) { atomicAdd(&bar[XB_TMO], 1u); break; } }
    }
    nloc = mine > 0u ? mine : 1u; nx = cnt > 0u ? cnt : 1u;
}

__device__ __forceinline__ void xcd_barrier(const XcdBarrier& b) {
    asm volatile("s_waitcnt vmcnt(0)" ::: "memory");
    __syncthreads();
    if (otid() == 0) {
        unsigned* bar = b.bar;
        __builtin_amdgcn_s_waitcnt(0);
        unsigned nloc = b.st[0], nx = b.st[1];
        if (nloc == 0u) { xcd_barrier_complete(bar, b.x, nloc, nx); b.st[0] = nloc; b.st[1] = nx; }
        const unsigned old = xb_add(&bar[XB_XSUB(b.x)], 1u);
        const unsigned gen = old / nloc;
        if (old + 1u == (gen + 1u) * nloc) {
            __builtin_amdgcn_fence(__ATOMIC_RELEASE, "agent");
            asm volatile("s_waitcnt vmcnt(0)" ::: "memory");
            const unsigned og = xb_add(&bar[XB_TOP], 1u);
            const unsigned tg = og / nx;
            if (og + 1u == (tg + 1u) * nx) xb_add(&bar[XB_TOPGEN], 1u);
            else XB_SPIN(xb_ld(&bar[XB_TOPGEN]) == tg, bar);
            __builtin_amdgcn_fence(__ATOMIC_ACQUIRE, "agent");
            xb_add(&bar[XB_XGEN(b.x)], 1u);
            asm volatile("s_waitcnt vmcnt(0)" ::: "memory");
        } else {
            XB_SPIN(xb_ld(&bar[XB_XGEN(b.x)]) == gen, bar);
            __builtin_amdgcn_fence(__ATOMIC_ACQUIRE, "agent");
            asm volatile("s_waitcnt vmcnt(0)" ::: "memory");
        }
    }
    __syncthreads();
}


};

#ifndef REP_D
#define REP_D 1
#endif
#ifndef REP_E
#define REP_E 1
#endif
#ifndef REP_A
#define REP_A 1
#endif
#ifndef REP_B
#define REP_B 1
#endif
#ifdef ONLY_PHASE
#define PH_EN(x) (ONLY_PHASE == (x))
#else
#define PH_EN(x) true
#endif
__global__ void __launch_bounds__(NTHREADS) fwd_megakernel(Params p) {
  extern __shared__ __attribute__((aligned(16))) unsigned char lds[];
  cg::grid_group grid = cg::this_grid();
  K k; k.wbase = __builtin_amdgcn_readfirstlane((int)__builtin_amdgcn_workitem_id_x()) & ~63;
  unsigned* bar = (unsigned*)(p.ws + WS_END);
  unsigned* xcnt = bar + 16;
  unsigned* xbar = (unsigned*)(p.ws + WS_END + 1024);
  if (blockIdx.x == 0) {
    if (k.otid() < 17) __hip_atomic_store(bar + (k.otid() == 16 ? 0 : 16 + k.otid()), 0u, __ATOMIC_RELAXED, __HIP_MEMORY_SCOPE_AGENT);
    for (int i = k.otid(); i < XCD_BAR_WORDS; i += NTHREADS) __hip_atomic_store(xbar + i, 0u, __ATOMIC_RELAXED, __HIP_MEMORY_SCOPE_AGENT);
  }
  volatile LAS unsigned* xst = (volatile LAS unsigned*)(lds + LDS_BYTES - 16);
  if (k.otid() == 0) { xst[0] = 0u; xst[1] = 0u; }
  __syncthreads();
  K::XcdBarrier xb; xb.bar = xbar; xb.x = 0; xb.st = xst;
  int my_xcc = 0, my_loc = 0;
  for (int ph = p.ph_lo; ph < p.ph_hi; ++ph) {
    if (ph == 0) { if (PH_EN(0)) for (int rep = 0; rep < REP_P; ++rep) { k.phase_prologue(p, lds); __syncthreads(); } }
    else if (ph == 1) {
      xb = k.xcd_barrier_post(xbar, xst);
      int* sh = (int*)lds;
      if (k.otid() == 0) {
        const int xc = (int)(__builtin_amdgcn_s_getreg((3 << 11) | 20) & 0xFu);
        sh[0] = xc;
        sh[1] = (int)__hip_atomic_fetch_add(xcnt + xc, 1u, __ATOMIC_RELAXED, __HIP_MEMORY_SCOPE_AGENT);
      }
      __syncthreads();
      my_xcc = __builtin_amdgcn_readfirstlane(sh[0]);
      my_loc = __builtin_amdgcn_readfirstlane(sh[1]);
      __syncthreads();
      if (PH_EN(1)) k.phase_h0(p);
    }
    else {
      const int layer = (ph - 2) / 7, sub = (ph - 2) % 7;
      if (sub == 0) { if (PH_EN(2)) for (int rep = 0; rep < REP_A; ++rep) { k.phase_A(p, layer, lds, my_xcc, my_loc, xcnt); __syncthreads(); } }
      else if (sub == 1) { if (PH_EN(3)) for (int rep = 0; rep < REP_B; ++rep) { k.phase_B(p, layer, lds); __syncthreads(); } }
      else if (sub == 2) { if (PH_EN(4)) k.phase_scan(p); }
      else if (sub == 3) { if (PH_EN(5)) for (int rep = 0; rep < REP_D; ++rep) { for (int it = blockIdx.x; it < 2048; it += gridDim.x) k.la_item_out(p, layer, it, lds); __syncthreads(); } }
      else if (sub == 4) { if (PH_EN(6)) for (int rep = 0; rep < REP_E; ++rep) { k.phase_E1(p, layer, lds, my_xcc, my_loc, xcnt); __syncthreads(); } }
      else if (sub == 5) { if (PH_EN(7)) for (int rep = 0; rep < REP_E; ++rep) { k.phase_E2(p, layer, lds, my_xcc, my_loc, xcnt); __syncthreads(); } }
      else { if (PH_EN(8)) k.phase_E3(p, layer); }
    }
    if (ph + 1 < p.ph_hi) {
      if (ph == p.ph_lo) grid.sync();
      else k.xcd_barrier(xb);
    }
  }
}

extern "C" void kernel_launch(void* const* d_in, const int* in_sizes, int n_in, void* d_out, int out_size,
                              void* d_ws, size_t ws_size, hipStream_t stream) {
  static int grid_blocks = 0;
  if (!grid_blocks) {
    int dev = 0, cus = 0, per_cu = 0;
    hipGetDevice(&dev);
    hipDeviceGetAttribute(&cus, hipDeviceAttributeMultiprocessorCount, dev);
    hipFuncSetAttribute((const void*)fwd_megakernel, hipFuncAttributeMaxDynamicSharedMemorySize, LDS_BYTES);
    hipOccupancyMaxActiveBlocksPerMultiprocessor(&per_cu, (const void*)fwd_megakernel, NTHREADS, LDS_BYTES);
    if (per_cu < 1) per_cu = 1;
    if (per_cu > 1) per_cu = 1;
    grid_blocks = cus * per_cu;
    if (ws_size < WS_END) fprintf(stderr, "workspace too small: %zu < %llu\n", ws_size, (unsigned long long)WS_END);
  }
  Params p{};
  p.x = (const float*)d_in[0]; p.c = (const float*)d_in[1]; p.pos = (const int*)d_in[2];
  p.ada_w = (const float*)d_in[3]; p.ada_b = (const float*)d_in[4];
  p.pre_norm = (const float*)d_in[5]; p.post_norm = (const float*)d_in[6];
  p.w_in = (const float*)d_in[7]; p.gla_w_lr = (const float*)d_in[8]; p.gla_b_lr = (const float*)d_in[9];
  p.w_br_ret = (const float*)d_in[10]; p.w_br_dsa = (const float*)d_in[11]; p.w_br_gla = (const float*)d_in[12];
  p.w_out = (const float*)d_in[13];
  p.out = (float*)d_out; p.ws = (unsigned char*)d_ws;
  p.ph_lo = 0; p.ph_hi = 2 + 7 * DEPTH;
  void* args[] = {&p};
  hipError_t e = hipLaunchCooperativeKernel((const void*)fwd_megakernel, dim3(grid_blocks), dim3(NTHREADS), args, LDS_BYTES, stream);
  if (e != hipSuccess) fprintf(stderr, "cooperative launch failed: %s (grid %d)\n", hipGetErrorString(e), grid_blocks);
}
```

```cpp
#include <hip/hip_runtime.h>
#include <hip/hip_cooperative_groups.h>
#include <stdint.h>
#include <cstdio>
namespace cg = cooperative_groups;
#ifndef REP_P
#define REP_P 1
#endif
#ifndef REP_KV
#define REP_KV 1
#endif
#ifndef REP_SEL
#define REP_SEL 1
#endif
#ifndef REP_ATT
#define REP_ATT 1
#endif

typedef _Float16 half_t;
typedef _Float16 h8 __attribute__((ext_vector_type(8)));
typedef _Float16 h4 __attribute__((ext_vector_type(4)));
typedef _Float16 h2 __attribute__((ext_vector_type(2)));
typedef float f16v __attribute__((ext_vector_type(16)));
typedef float f4v __attribute__((ext_vector_type(4)));

#define S_LEN 16384
#define DM 1024
#define NIN 7764
#define NPAD 7936
#define PP 7808
#define DEPTH 4
#define NTHREADS 256
#define HP 1088
#define WP 1088
#define WBP 576
#define LDS_BYTES 149504

#define C_RETQ 0
#define C_RETK 256
#define C_RETV 512
#define C_RETG 1024
#define C_DSAQ 1536
#define C_DSAK 2048
#define C_DSAV 2176
#define C_DSAG 2304
#define C_IDXQ 2816
#define C_IDXK 3072
#define C_GLAQ 3136
#define C_GLAK 3392
#define C_GLAV 3648
#define C_GLAG 4160
#define C_GLAA 4672
#define C_MRG 4688
#define C_END 7760
#define C_IDXW 7760

#define OFF_WINT 0ull
#define OFF_WBRT (OFF_WINT + 4ull * NPAD * WP * 2)
#define OFF_WOUTT (OFF_WBRT + 4ull * 3 * 1024 * WBP * 2)
#define OFF_MOD (OFF_WOUTT + 4ull * 1024 * WP * 2)
#define OFF_RT (OFF_MOD + 4ull * 3072 * 4)
#define OFF_DT (OFF_RT + 16384ull * 64 * 4)
#define OFF_H (OFF_DT + 16384ull * 16 * 4)
#define OFF_P (OFF_H + 16384ull * HP * 2)
#define OFF_GA (OFF_P + 16384ull * PP * 2)
#define OFF_IW (OFF_GA + 16384ull * 16 * 4)
#define OFF_ST (OFF_IW + 16384ull * 4 * 4)
#define OFF_DEC (OFF_ST + 256ull * 65536 * 4)
#define OFF_BR (OFF_DEC + 256ull * 8 * 64 * 4)
#define WS_END (OFF_BR + 16384ull * 1536 * 2)
static_assert(WS_END + 16384 <= 508821504ull, "workspace too large");

struct Params {
  const float* x; const float* c; const int* pos; const float* ada_w; const float* ada_b;
  const float* pre_norm; const float* post_norm; const float* w_in; const float* gla_w_lr;
  const float* gla_b_lr; const float* w_br_ret; const float* w_br_dsa; const float* w_br_gla;
  const float* w_out; float* out; unsigned char* ws;
  int ph_lo; int ph_hi;
};

struct K {
int wbase;
__device__ __forceinline__ int otid() const {
  int lane;
  asm volatile("v_mbcnt_lo_u32_b32 %0, -1, 0\n\tv_mbcnt_hi_u32_b32 %0, -1, %0" : "=v"(lane));
  return wbase | lane;
}
__device__ __forceinline__ static float ozero() { float z = 0.f; asm volatile("" : "+v"(z)); return z; }
template <int CTRL>
__device__ __forceinline__ float dppf(float v) {
  return __int_as_float(__builtin_amdgcn_update_dpp(0, __float_as_int(v), CTRL, 0xF, 0xF, true));
}
template <int CTRL>
__device__ __forceinline__ unsigned dppu(unsigned v) {
  return (unsigned)__builtin_amdgcn_update_dpp(0, (int)v, CTRL, 0xF, 0xF, true);
}
__device__ __forceinline__ int olane() { return otid() & 63; }
__device__ __forceinline__ float xor16f(float v) { return __int_as_float(__builtin_amdgcn_ds_bpermute((olane() ^ 16) << 2, __float_as_int(v))); }
__device__ __forceinline__ float xor32f(float v) { return __int_as_float(__builtin_amdgcn_ds_bpermute((olane() ^ 32) << 2, __float_as_int(v))); }
__device__ __forceinline__ unsigned xor16u(unsigned v) { return (unsigned)__builtin_amdgcn_ds_bpermute((olane() ^ 16) << 2, (int)v); }
__device__ __forceinline__ unsigned xor32u(unsigned v) { return (unsigned)__builtin_amdgcn_ds_bpermute((olane() ^ 32) << 2, (int)v); }
__device__ __forceinline__ float wave_sum(float v) {
  v += dppf<0xB1>(v); v += dppf<0x4E>(v); v += dppf<0x141>(v); v += dppf<0x140>(v);
  v += xor16f(v); v += xor32f(v);
  return v;
}
__device__ __forceinline__ float wave_max(float v) {
  v = fmaxf(v, dppf<0xB1>(v)); v = fmaxf(v, dppf<0x4E>(v)); v = fmaxf(v, dppf<0x141>(v)); v = fmaxf(v, dppf<0x140>(v));
  v = fmaxf(v, xor16f(v)); v = fmaxf(v, xor32f(v));
  return v;
}
__device__ __forceinline__ unsigned wave_or(unsigned v) {
  v |= dppu<0xB1>(v); v |= dppu<0x4E>(v); v |= dppu<0x141>(v); v |= dppu<0x140>(v);
  v |= xor16u(v); v |= xor32u(v);
  return v;
}
__device__ __forceinline__ unsigned wave_incl_scan(unsigned v) {
  v += (unsigned)__builtin_amdgcn_update_dpp(0, (int)v, 0x111, 0xF, 0xF, false);
  v += (unsigned)__builtin_amdgcn_update_dpp(0, (int)v, 0x112, 0xF, 0xF, false);
  v += (unsigned)__builtin_amdgcn_update_dpp(0, (int)v, 0x114, 0xF, 0xF, false);
  v += (unsigned)__builtin_amdgcn_update_dpp(0, (int)v, 0x118, 0xF, 0xF, false);
  v += (unsigned)__builtin_amdgcn_update_dpp(0, (int)v, 0x142, 0xA, 0xF, false);
  v += (unsigned)__builtin_amdgcn_update_dpp(0, (int)v, 0x143, 0xC, 0xF, false);
  return v;
}
__device__ __forceinline__ f16v mfma16(h8 a, h8 b, f16v c) {
  return __builtin_amdgcn_mfma_f32_32x32x16_f16(a, b, c, 0, 0, 0);
}
__device__ __forceinline__ float relu_f(float x) { return __int_as_float(max(__float_as_int(x), 0)); }
__device__ __forceinline__ int crow(int r, int l) { return (r & 3) + 8 * (r >> 2) + 4 * (l >> 5); }

__device__ __forceinline__ int win_col(int nv) {
  if (nv < 3136) return nv;
  if (nv < 7760) return nv + 4;
  if (nv < 7764) return nv - 7760 + 3136;
  return -1;
}
__device__ void transpose_tile(const float* __restrict__ src, int ldn, half_t* __restrict__ dst, int K,
                               int k0, int n0, int mapmode, unsigned char* lds) {
  float* T = (float*)lds;
  const int tid = otid();
  const int nn = tid & 63;
  int col = n0 + nn;
  if (mapmode) col = win_col(col);
#pragma unroll
  for (int i = 0; i < 16; ++i) {
    int kk = (tid >> 6) + 4 * i;
    float v = 0.f;
    if (col >= 0) v = src[(size_t)(k0 + kk) * ldn + col];
    T[kk * 65 + nn] = v;
  }
  __syncthreads();
#pragma unroll
  for (int i = 0; i < 2; ++i) {
    int n2 = (tid >> 3) + 32 * i;
    int kc = tid & 7;
    h8 o;
#pragma unroll
    for (int q = 0; q < 8; ++q) o[q] = (half_t)T[(kc * 8 + q) * 65 + n2];
    *(h8*)(dst + (size_t)(n0 + n2) * K + k0 + kc * 8) = o;
  }
  __syncthreads();
}

__device__ void phase_prologue(const Params& p, unsigned char* lds) {
  const int tid = otid();
  half_t* WinT = (half_t*)(p.ws + OFF_WINT);
  half_t* WbrT = (half_t*)(p.ws + OFF_WBRT);
  half_t* WoutT = (half_t*)(p.ws + OFF_WOUTT);
  float* MOD = (float*)(p.ws + OFF_MOD);
  float* RT = (float*)(p.ws + OFF_RT);
  float* DT = (float*)(p.ws + OFF_DT);
  const int T_WIN = 4 * 124 * 16;
  const int T_WBR = 12 * 16 * 8;
  const int T_WOUT = 4 * 16 * 16;
  const int T_MOD = 192;
  const int T_ROPE = 16384 * 40 / 256;
  const int total = T_WIN + T_WBR + T_WOUT + T_MOD + T_ROPE;
  for (int task = blockIdx.x; task < total; task += gridDim.x) {
    int t = task;
    if (t < T_WIN) {
      int l = t / (124 * 16); int r = t % (124 * 16); int nt = r / 16, kt = r % 16;
      transpose_tile(p.w_in + (size_t)l * 1024 * NIN, NIN, WinT + (size_t)l * NPAD * WP, WP, kt * 64, nt * 64, 1, lds);
      continue;
    }
    t -= T_WIN;
    if (t < T_WBR) {
      int lb = t / 128; int r = t % 128; int nt = r / 8, kt = r % 8;
      int l = lb / 3, b = lb % 3;
      const float* src = (b == 0 ? p.w_br_ret : (b == 1 ? p.w_br_dsa : p.w_br_gla)) + (size_t)l * 512 * 1024;
      transpose_tile(src, 1024, WbrT + (size_t)lb * 1024 * WBP, WBP, kt * 64, nt * 64, 0, lds);
      continue;
    }
    t -= T_WBR;
    if (t < T_WOUT) {
      int l = t / 256; int r = t % 256; int nt = r / 16, kt = r % 16;
      transpose_tile(p.w_out + (size_t)l * 1024 * 1024, 1024, WoutT + (size_t)l * 1024 * WP, WP, kt * 64, nt * 64, 0, lds);
      continue;
    }
    t -= T_WOUT;
    if (t < T_MOD) {
      int l = t / 48, jb = t % 48;
      int j = jb * 64 + (tid & 63);
      int ig = tid >> 6;
      float acc = 0.f;
      const float* aw = p.ada_w + (size_t)l * 1024 * 3072;
      for (int i = ig * 256; i < ig * 256 + 256; ++i) {
        float cv = p.c[i];
        float sc = cv / (1.f + expf(-cv));
        acc += sc * aw[(size_t)i * 3072 + j];
      }
      float* red = (float*)lds;
      red[tid] = acc;
      __syncthreads();
      if (tid < 64) {
        float s = red[tid] + red[tid + 64] + red[tid + 128] + red[tid + 192];
        MOD[l * 3072 + j] = s + p.ada_b[l * 3072 + j];
      }
      __syncthreads();
      continue;
    }
    t -= T_MOD;
    {
      int e = t * 256 + tid;
      int tok = e / 40, f = e % 40;
      float pf = (float)p.pos[tok];
      if (f < 32) {
        float fr = powf(10000.0f, -(float)f * 2.0f / 64.0f);
        float ang = pf * fr;
        RT[tok * 64 + f * 2] = cosf(ang);
        RT[tok * 64 + f * 2 + 1] = sinf(ang);
      } else {
        int g = f - 32;
        float fr = powf(500000.0f, -(float)g * 2.0f / 16.0f);
        float ang = pf * fr;
        DT[tok * 16 + g * 2] = cosf(ang);
        DT[tok * 16 + g * 2 + 1] = sinf(ang);
      }
    }
  }
}

__device__ __forceinline__ void write_h_row(const float (&xv)[16], const float* __restrict__ pre,
                                            const float* __restrict__ mod, half_t* __restrict__ hrow, int l) {
  float ss = 0.f;
#pragma unroll
  for (int i = 0; i < 16; ++i) ss += xv[i] * xv[i];
  ss = wave_sum(ss);
  float rs = rsqrtf(ss * (1.0f / 1024.0f) + 1e-6f);
#pragma unroll
  for (int i = 0; i < 4; ++i) {
    int c0 = i * 256 + l * 4;
    f4v pg = *(const f4v*)(pre + c0);
    f4v sh = *(const f4v*)(mod + c0);
    f4v sc = *(const f4v*)(mod + 1024 + c0);
    h4 o;
#pragma unroll
    for (int q = 0; q < 4; ++q) o[q] = (half_t)(xv[i * 4 + q] * rs * pg[q] * (1.f + sc[q]) + sh[q]);
    *(h4*)(hrow + c0) = o;
  }
}

__device__ void phase_h0(const Params& p) {
  const int w = otid() >> 6, l = otid() & 63;
  half_t* H = (half_t*)(p.ws + OFF_H);
  const float* MOD = (const float*)(p.ws + OFF_MOD);
  for (int row = blockIdx.x * 4 + w; row < S_LEN; row += gridDim.x * 4) {
    float xv[16];
#pragma unroll
    for (int i = 0; i < 4; ++i) {
      f4v v = *(const f4v*)(p.x + (size_t)row * 1024 + i * 256 + l * 4);
      xv[i * 4] = v[0]; xv[i * 4 + 1] = v[1]; xv[i * 4 + 2] = v[2]; xv[i * 4 + 3] = v[3];
    }
    write_h_row(xv, p.pre_norm, MOD, H + (size_t)row * HP, l);
  }
}

__device__ __forceinline__ void lds_barrier() {
  asm volatile("s_waitcnt lgkmcnt(0)" ::: "memory");
  __builtin_amdgcn_s_barrier();
  asm volatile("" ::: "memory");
}
#define GEMM_BUF 55296
#define GEMM_EOFF 110592
template <int NT>
__device__ __forceinline__ void gemm_step(f16v (&acc)[4][NT], h8 (&ra)[8], h8 (&rb)[2 * NT],
                                          const unsigned char* As, const unsigned char* Bs, unsigned char* Aw, unsigned char* Bw,
                                          const half_t* __restrict__ A, int lda, const half_t* __restrict__ B, int ldb, int kload,
                                          int wm, int wn, int l, int r0, int kc) {
  h8 af[2][4], bf[2][NT];
#pragma unroll
  for (int i = 0; i < 4; ++i) af[0][i] = *(const h8*)(As + (wm * 128 + i * 32 + (l & 31)) * 144 + (l >> 5) * 16);
#pragma unroll
  for (int j = 0; j < NT; ++j) bf[0][j] = *(const h8*)(Bs + (wn * 32 * NT + j * 32 + (l & 31)) * 144 + (l >> 5) * 16);
#pragma unroll
  for (int ks = 0; ks < 4; ++ks) {
    if (ks < 3) {
#pragma unroll
      for (int i = 0; i < 4; ++i) af[(ks + 1) & 1][i] = *(const h8*)(As + (wm * 128 + i * 32 + (l & 31)) * 144 + (ks + 1) * 32 + (l >> 5) * 16);
#pragma unroll
      for (int j = 0; j < NT; ++j) bf[(ks + 1) & 1][j] = *(const h8*)(Bs + (wn * 32 * NT + j * 32 + (l & 31)) * 144 + (ks + 1) * 32 + (l >> 5) * 16);
    }
    __builtin_amdgcn_sched_barrier(0);
#pragma unroll
    for (int i = 0; i < 4; ++i)
#pragma unroll
      for (int j = 0; j < NT; ++j) acc[i][j] = mfma16(af[ks & 1][i], bf[ks & 1][j], acc[i][j]);
#pragma unroll
    for (int i = 2 * ks; i < 2 * ks + 2; ++i) {
      *(h8*)(Aw + (r0 + 32 * i) * 144 + kc * 16) = ra[i];
      ra[i] = *(const h8*)(A + (size_t)(r0 + 32 * i) * lda + kload + kc * 8);
    }
    if (NT == 2) {
      *(h8*)(Bw + (r0 + 32 * ks) * 144 + kc * 16) = rb[ks];
      rb[ks] = *(const h8*)(B + (size_t)(r0 + 32 * ks) * ldb + kload + kc * 8);
    } else {
#pragma unroll
      for (int i = 2 * ks; i < 2 * ks + 2; ++i) {
        *(h8*)(Bw + (r0 + 32 * i) * 144 + kc * 16) = rb[i];
        rb[i] = *(const h8*)(B + (size_t)(r0 + 32 * i) * ldb + kload + kc * 8);
      }
    }
    __builtin_amdgcn_sched_barrier(0);
  }
}
template <int NT>
__device__ __forceinline__ void gemm_issue(h8 (&ra0)[8], h8 (&rb0)[2 * NT], h8 (&ra1)[8], h8 (&rb1)[2 * NT],
                                           const half_t* __restrict__ A, int lda, const half_t* __restrict__ B, int ldb) {
  const int tid = otid();
  const int kc = tid & 7, r0 = tid >> 3;
#pragma unroll
  for (int i = 0; i < 8; ++i) ra0[i] = *(const h8*)(A + (size_t)(r0 + 32 * i) * lda + kc * 8);
#pragma unroll
  for (int i = 0; i < 2 * NT; ++i) rb0[i] = *(const h8*)(B + (size_t)(r0 + 32 * i) * ldb + kc * 8);
#pragma unroll
  for (int i = 0; i < 8; ++i) ra1[i] = *(const h8*)(A + (size_t)(r0 + 32 * i) * lda + 64 + kc * 8);
#pragma unroll
  for (int i = 0; i < 2 * NT; ++i) rb1[i] = *(const h8*)(B + (size_t)(r0 + 32 * i) * ldb + 64 + kc * 8);
}
template <int NT>
__device__ __forceinline__ void gemm_run(f16v (&acc)[4][NT], h8 (&ra0)[8], h8 (&rb0)[2 * NT], h8 (&ra1)[8], h8 (&rb1)[2 * NT],
                                         const half_t* __restrict__ A, int lda, const half_t* __restrict__ B, int ldb, int K, unsigned char* lds) {
  const int tid = otid(), w = tid >> 6, l = tid & 63;
  constexpr int STAGE = 256 * 144 + 64 * NT * 144;
  unsigned char* A0 = lds;
  unsigned char* B0 = lds + 256 * 144;
  unsigned char* A1 = lds + STAGE;
  unsigned char* B1 = lds + STAGE + 256 * 144;
  const int wm = w >> 1, wn = w & 1;
  const int kc = tid & 7;
  const int r0 = tid >> 3;
  lds_barrier();
#pragma unroll
  for (int i = 0; i < 8; ++i) { *(h8*)(A0 + (r0 + 32 * i) * 144 + kc * 16) = ra0[i]; ra0[i] = *(const h8*)(A + (size_t)(r0 + 32 * i) * lda + 128 + kc * 8); }
#pragma unroll
  for (int i = 0; i < 2 * NT; ++i) { *(h8*)(B0 + (r0 + 32 * i) * 144 + kc * 16) = rb0[i]; rb0[i] = *(const h8*)(B + (size_t)(r0 + 32 * i) * ldb + 128 + kc * 8); }
  lds_barrier();
  const int nk = K / 64;
#pragma unroll 1
  for (int kt = 0; kt < nk; kt += 2) {
    gemm_step<NT>(acc, ra1, rb1, A0, B0, A1, B1, A, lda, B, ldb, (kt + 3 < nk) ? (kt + 3) * 64 : 0, wm, wn, l, r0, kc);
    lds_barrier();
    gemm_step<NT>(acc, ra0, rb0, A1, B1, A0, B0, A, lda, B, ldb, (kt + 4 < nk) ? (kt + 4) * 64 : 0, wm, wn, l, r0, kc);
    lds_barrier();
  }
}
template <int NT>
__device__ __forceinline__ void gemm_kloop(f16v (&acc)[4][NT], const half_t* __restrict__ A, int lda,
                                           const half_t* __restrict__ B, int ldb, int K, unsigned char* lds) {
  h8 ra0[8], rb0[2 * NT], ra1[8], rb1[2 * NT];
  gemm_issue<NT>(ra0, rb0, ra1, rb1, A, lda, B, ldb);
  gemm_run<NT>(acc, ra0, rb0, ra1, rb1, A, lda, B, ldb, K, lds);
}

template <int NT>
__device__ __forceinline__ void gemm_issue1(h8 (&ra)[8], h8 (&rb)[2 * NT], const half_t* __restrict__ A, int lda, const half_t* __restrict__ B, int ldb) {
  const int tid = otid();
  const int kc = tid & 7, r0 = tid >> 3;
#pragma unroll
  for (int i = 0; i < 8; ++i) ra[i] = *(const h8*)(A + (size_t)(r0 + 32 * i) * lda + kc * 8);
#pragma unroll
  for (int i = 0; i < 2 * NT; ++i) rb[i] = *(const h8*)(B + (size_t)(r0 + 32 * i) * ldb + kc * 8);
}
template <int NT>
__device__ __forceinline__ void gemm_run1(f16v (&acc)[4][NT], h8 (&ra)[8], h8 (&rb)[2 * NT],
                                          const half_t* __restrict__ A, int lda, const half_t* __restrict__ B, int ldb, int K, unsigned char* lds) {
  const int tid = otid(), w = tid >> 6, l = tid & 63;
  constexpr int STAGE = 256 * 144 + 64 * NT * 144;
  const int wm = w >> 1, wn = w & 1;
  const int kc = tid & 7;
  const int r0 = tid >> 3;
  lds_barrier();
#pragma unroll
  for (int i = 0; i < 8; ++i) { *(h8*)(lds + (r0 + 32 * i) * 144 + kc * 16) = ra[i]; ra[i] = *(const h8*)(A + (size_t)(r0 + 32 * i) * lda + 64 + kc * 8); }
#pragma unroll
  for (int i = 0; i < 2 * NT; ++i) { *(h8*)(lds + 256 * 144 + (r0 + 32 * i) * 144 + kc * 16) = rb[i]; rb[i] = *(const h8*)(B + (size_t)(r0 + 32 * i) * ldb + 64 + kc * 8); }
  lds_barrier();
  const int nk = K / 64;
#pragma unroll 1
  for (int kt = 0; kt < nk; ++kt) {
    unsigned char* cur = lds + (kt & 1) * STAGE;
    unsigned char* nxt = lds + ((kt + 1) & 1) * STAGE;
    gemm_step<NT>(acc, ra, rb, cur, cur + 256 * 144, nxt, nxt + 256 * 144, A, lda, B, ldb, (kt + 2 < nk) ? (kt + 2) * 64 : 0, wm, wn, l, r0, kc);
    lds_barrier();
  }
}

template <int NT>
__device__ __forceinline__ void zero_acc(f16v (&acc)[4][NT]) {
  float z = 0.f;
  asm volatile("" : "+v"(z));
#pragma unroll
  for (int i = 0; i < 4; ++i)
#pragma unroll
    for (int j = 0; j < NT; ++j)
#pragma unroll
      for (int r = 0; r < 16; ++r) acc[i][j][r] = z;
}

__device__ __forceinline__ void stage_pair(float* E, const f16v& a0, const f16v& a1, int l) {
#pragma unroll
  for (int r = 0; r < 16; ++r) {
    const int rr = crow(r, l);
    E[rr * 65 + (l & 31)] = a0[r];
    E[rr * 65 + 32 + (l & 31)] = a1[r];
  }
}

__device__ __forceinline__ int xcc_census(const unsigned* xcnt, int my_xcc) {
  unsigned sum = 0; bool ok = my_xcc < 8; int mine = 0;
#pragma unroll
  for (int j = 0; j < 16; ++j) {
    const unsigned c = __hip_atomic_load(xcnt + j, __ATOMIC_RELAXED, __HIP_MEMORY_SCOPE_AGENT);
    sum += c;
    if (j < 8 && c == 0u) ok = false;
    if (j >= 8 && c != 0u) ok = false;
    if (j == my_xcc) mine = (int)c;
  }
  if (sum != gridDim.x) ok = false;
  return ok ? mine : 0;
}

__device__ void phase_A(const Params& p, int layer, unsigned char* lds, int my_xcc, int my_loc, const unsigned* xcnt) {
  const int tid = otid(), w = tid >> 6, l = tid & 63;
  const half_t* H = (const half_t*)(p.ws + OFF_H);
  const half_t* Wt = (const half_t*)(p.ws + OFF_WINT) + (size_t)layer * NPAD * WP;
  half_t* P = (half_t*)(p.ws + OFF_P);
  float* GA = (float*)(p.ws + OFF_GA);
  float* IW = (float*)(p.ws + OFF_IW);
  const float* RT = (const float*)(p.ws + OFF_RT);
  const float* DT = (const float*)(p.ws + OFF_DT);
  const int wm = w >> 1, wn = w & 1;
  const int G = gridDim.x;
  const int ntiles = 64 * 31;
  const int nx = xcc_census(xcnt, my_xcc);
  int nmine;
  if (nx > 0) nmine = (my_loc < 248) ? (248 - my_loc + nx - 1) / nx : 0;
  else nmine = ((int)blockIdx.x < ntiles) ? (ntiles - (int)blockIdx.x + G - 1) / G : 0;
  h8 ra0[8], rb0[8];
  int mt = 0, nt = 0;
  if (nmine > 0) {
    if (nx > 0) { const int s0 = my_loc; mt = my_xcc * 8 + (s0 & 7); nt = s0 >> 3; }
    else { const int tix = blockIdx.x; mt = tix & 63; nt = tix >> 6; }
    gemm_issue1<4>(ra0, rb0, H + (size_t)mt * 256 * HP, HP, Wt + (size_t)nt * 256 * WP, WP);
  }
#pragma unroll 1
  for (int rnd = 0; rnd < nmine; ++rnd) {
    f16v acc[4][4];
    zero_acc<4>(acc);
    gemm_run1<4>(acc, ra0, rb0, H + (size_t)mt * 256 * HP, HP, Wt + (size_t)nt * 256 * WP, WP, 1024, lds);
    const int mt_cur = mt, nt_cur = nt;
    if (rnd + 1 < nmine) {
      if (nx > 0) { const int s1 = my_loc + nx * (rnd + 1); mt = my_xcc * 8 + (s1 & 7); nt = s1 >> 3; }
      else { const int tix = (rnd + 1) * G + blockIdx.x; mt = tix & 63; nt = tix >> 6; }
      gemm_issue1<4>(ra0, rb0, H + (size_t)mt * 256 * HP, HP, Wt + (size_t)nt * 256 * WP, WP);
    }
    const int m0w = mt_cur * 256 + wm * 128;
    const int n0w = nt_cur * 256 + wn * 128;
    float* E = (float*)(lds) + w * (32 * 65);
    const int prow = l >> 3, c0 = (l & 7) * 8;
#pragma unroll
    for (int jp = 0; jp < 2; ++jp) {
      const int nb2 = n0w + jp * 64;
      const int n0 = nb2 + c0;
      const bool rope64 = nb2 < 512;
      const bool rope16 = ((nb2 >= C_DSAQ && nb2 < C_DSAV) || (nb2 >= C_IDXQ && nb2 < C_GLAQ)) && (c0 < 16);
      float scale = 1.f;
      if (n0 < 256 || (n0 >= C_DSAQ && n0 < C_DSAK) || (n0 >= C_IDXQ && n0 < C_IDXK) || (n0 >= C_GLAQ && n0 < C_GLAK)) scale = 0.125f;
      int mode = 0;
      if ((n0 >= C_RETG && n0 < C_DSAQ) || (n0 >= C_DSAG && n0 < C_IDXQ) || (n0 >= C_GLAG && n0 < C_GLAA)) mode = 1;
      if (n0 >= C_MRG && n0 < C_END) mode = 2;
#pragma unroll
      for (int i = 0; i < 4; ++i) {
        stage_pair(E, acc[i][2 * jp], acc[i][2 * jp + 1], l);
#pragma unroll 1
        for (int ps = 0; ps < 4; ++ps) {
          const int rl = ps * 8 + prow;
          const int row = m0w + i * 32 + rl;
          float v[8], o[8];
#pragma unroll
          for (int q = 0; q < 8; ++q) { v[q] = E[rl * 65 + c0 + q]; o[q] = v[q]; }
          if (rope64) {
            const int cp = c0 ^ 32;
            const float* tb = RT + (size_t)row * 64 + (c0 & 31) * 2;
#pragma unroll
            for (int q = 0; q < 8; ++q) {
              const float pv = E[rl * 65 + cp + q];
              const float cs = tb[2 * q], sn = tb[2 * q + 1];
              o[q] = (c0 < 32) ? (v[q] * cs - pv * sn) : (v[q] * cs + pv * sn);
            }
          } else if (rope16) {
            const int cp = c0 ^ 8;
            const float* tb = DT + (size_t)row * 16;
#pragma unroll
            for (int q = 0; q < 8; ++q) {
              const float pv = E[rl * 65 + cp + q];
              const float cs = tb[2 * q], sn = tb[2 * q + 1];
              o[q] = (c0 < 8) ? (v[q] * cs - pv * sn) : (v[q] * cs + pv * sn);
            }
          }
          h8 ov;
#pragma unroll
          for (int q = 0; q < 8; ++q) {
            float t = o[q] * scale;
            if (mode == 1) t = t / (1.f + __expf(-t));
            else if (mode == 2) t = 1.f / (1.f + __expf(-t));
            ov[q] = (half_t)t;
          }
          if (n0 < C_END) __builtin_nontemporal_store(ov, (h8*)(P + (size_t)row * PP + n0));
          if (n0 >= C_GLAA && n0 < C_MRG) {
#pragma unroll
            for (int q = 0; q < 8; ++q) GA[(size_t)row * 16 + (n0 - C_GLAA) + q] = v[q];
          }
          if (n0 == C_IDXW) {
#pragma unroll
            for (int q = 0; q < 4; ++q) IW[(size_t)row * 4 + q] = 0.5f * v[q];
          }
        }
      }
    }
  }
}

#define LA_BC 0
#define LA_GAS 16640
#define LA_WL 20736
#define LA_QT 24832
#define LA_KT 34048
#define LA_AT 43264
#define LA_VT 52480
#define LA_SS 70912
#define LA_OS 89344
#define LA_SEG 123136

__device__ void la_bcum(const Params& p, int layer, int n, int Hh, unsigned char* lds) {
  const int tid = otid();
  float* Bc = (float*)(lds + LA_BC);
  const int d = tid & 63, q = tid >> 6;
  if (Hh < 4) {
    float lg = log1pf(-exp2f(-5.0f - (float)Hh));
#pragma unroll
    for (int jj = 0; jj < 16; ++jj) { int j = q * 16 + jj; Bc[j * 65 + d] = (float)(j + 1) * lg; }
    __syncthreads();
    return;
  }
  const int h = Hh - 4;
  float* GAs = (float*)(lds + LA_GAS);
  float* WL = (float*)(lds + LA_WL);
  float* SEG = (float*)(lds + LA_SEG);
  const float* GA = (const float*)(p.ws + OFF_GA);
#pragma unroll
  for (int i = 0; i < 4; ++i) {
    int e = tid + 256 * i;
    GAs[e] = GA[(size_t)n * 64 * 16 + e];
    int r = e >> 6, dd = e & 63;
    WL[e] = p.gla_w_lr[(size_t)layer * 16 * 256 + r * 256 + h * 64 + dd];
  }
  __syncthreads();
  float wl[16];
#pragma unroll
  for (int r = 0; r < 16; ++r) wl[r] = WL[r * 64 + d];
  const float bl = p.gla_b_lr[layer * 256 + h * 64 + d];
  float run = 0.f;
#pragma unroll
  for (int jj = 0; jj < 16; ++jj) {
    int j = q * 16 + jj;
    float z = bl;
#pragma unroll
    for (int r = 0; r < 16; ++r) z += GAs[j * 16 + r] * wl[r];
    float ls = fminf(z, 0.f) - log1pf(expf(-fabsf(z)));
    run += ls * (1.0f / 16.0f);
    Bc[j * 65 + d] = run;
  }
  SEG[q * 64 + d] = run;
  __syncthreads();
  float off = 0.f;
  for (int qq = 0; qq < q; ++qq) off += SEG[qq * 64 + d];
  if (q > 0) {
#pragma unroll
    for (int jj = 0; jj < 16; ++jj) { int j = q * 16 + jj; Bc[j * 65 + d] += off; }
  }
  __syncthreads();
}

__device__ __forceinline__ void la_stage_vt(const half_t* __restrict__ P, int t0, int vcol, unsigned char* lds) {
  const int tid = otid(), w = tid >> 6, l = tid & 63;
  half_t* VT = (half_t*)(lds + LA_VT);
  const int jp = l & 31, cgp = l >> 5;
#pragma unroll
  for (int it = 0; it < 2; ++it) {
    int c = it * 8 + w * 2 + cgp;
    h8 v0 = *(const h8*)(P + (size_t)(t0 + 2 * jp) * PP + vcol + c * 8);
    h8 v1 = *(const h8*)(P + (size_t)(t0 + 2 * jp + 1) * PP + vcol + c * 8);
#pragma unroll
    for (int q = 0; q < 8; ++q) {
      h2 pr; pr[0] = v0[q]; pr[1] = v1[q];
      *(h2*)(VT + (c * 8 + q) * 72 + 2 * jp) = pr;
    }
  }
}

__device__ void la_item_kv(const Params& p, int layer, int item, unsigned char* lds) {
  const int tid = otid(), w = tid >> 6, l = tid & 63;
  const int n = item >> 3, Hh = item & 7;
  const int t0 = n * 64;
  const half_t* P = (const half_t*)(p.ws + OFF_P);
  half_t* ST = (half_t*)(p.ws + OFF_ST);
  float* DEC = (float*)(p.ws + OFF_DEC);
  const int kcol = (Hh < 4) ? (C_RETK + Hh * 64) : (C_GLAK + (Hh - 4) * 64);
  const int vcol = (Hh < 4) ? (C_RETV + Hh * 128) : (C_GLAV + (Hh - 4) * 128);
  __syncthreads();
  la_bcum(p, layer, n, Hh, lds);
  const float* Bc = (const float*)(lds + LA_BC);
  half_t* KhT = (half_t*)(lds + LA_KT);
  half_t* VT = (half_t*)(lds + LA_VT);
  {
    const int jp = l & 31, cgp = l >> 5;
    int c = w * 2 + cgp;
    h8 k0 = *(const h8*)(P + (size_t)(t0 + 2 * jp) * PP + kcol + c * 8);
    h8 k1 = *(const h8*)(P + (size_t)(t0 + 2 * jp + 1) * PP + kcol + c * 8);
#pragma unroll
    for (int q = 0; q < 8; ++q) {
      int d = c * 8 + q;
      float bl = Bc[63 * 65 + d];
      h2 pr;
      pr[0] = (half_t)((float)k0[q] * __expf(bl - Bc[(2 * jp) * 65 + d]));
      pr[1] = (half_t)((float)k1[q] * __expf(bl - Bc[(2 * jp + 1) * 65 + d]));
      *(h2*)(KhT + d * 72 + 2 * jp) = pr;
    }
  }
  la_stage_vt(P, t0, vcol, lds);
  if (tid < 64) DEC[(size_t)item * 64 + tid] = __expf(Bc[63 * 65 + tid]);
  __syncthreads();
  f16v acc[2];
#pragma unroll
  for (int j = 0; j < 2; ++j)
#pragma unroll
    for (int r = 0; r < 16; ++r) acc[j][r] = ozero();
#pragma unroll
  for (int ks = 0; ks < 4; ++ks) {
    h8 a = *(const h8*)(VT + (32 * w + (l & 31)) * 72 + ks * 16 + (l >> 5) * 8);
#pragma unroll
    for (int j = 0; j < 2; ++j) {
      h8 b = *(const h8*)(KhT + (j * 32 + (l & 31)) * 72 + ks * 16 + (l >> 5) * 8);
      acc[j] = mfma16(a, b, acc[j]);
    }
  }
#pragma unroll
  for (int j = 0; j < 2; ++j)
#pragma unroll
    for (int r = 0; r < 16; ++r) {
      int e = 32 * w + crow(r, l);
      int d = j * 32 + (l & 31);
      ST[(size_t)item * 8192 + e * 64 + d] = (half_t)acc[j][r];
    }
}

__device__ void phase_scan(const Params& p) {
  half_t* ST = (half_t*)(p.ws + OFF_ST);
  const float* DEC = (const float*)(p.ws + OFF_DEC);
  for (int f2 = blockIdx.x * NTHREADS + otid(); f2 < 32768; f2 += gridDim.x * NTHREADS) {
    const int f = f2 * 2;
    const int Hh = f >> 13, d = f & 63;
    float s0 = 0.f, s1 = 0.f;
    for (int n0 = 0; n0 < 256; n0 += 16) {
      h2 kv[16]; float2 dc[16];
#pragma unroll
      for (int u = 0; u < 16; ++u) {
        kv[u] = *(const h2*)(ST + (size_t)(n0 + u) * 65536 + f);
        dc[u] = *(const float2*)(DEC + (size_t)((n0 + u) * 8 + Hh) * 64 + d);
      }
#pragma unroll
      for (int u = 0; u < 16; ++u) {
        h2 o; o[0] = (half_t)s0; o[1] = (half_t)s1;
        *(h2*)(ST + (size_t)(n0 + u) * 65536 + f) = o;
        s0 = dc[u].x * s0 + (float)kv[u][0];
        s1 = dc[u].y * s1 + (float)kv[u][1];
      }
    }
  }
}

__device__ void la_item_out(const Params& p, int layer, int item, unsigned char* lds) {
  const int tid = otid(), w = tid >> 6, l = tid & 63;
  const int n = item >> 3, Hh = item & 7;
  const int t0 = n * 64;
  const half_t* P = (const half_t*)(p.ws + OFF_P);
  const half_t* ST = (const half_t*)(p.ws + OFF_ST);
  half_t* BR = (half_t*)(p.ws + OFF_BR);
  const int qcol = (Hh < 4) ? (C_RETQ + Hh * 64) : (C_GLAQ + (Hh - 4) * 64);
  const int kcol = (Hh < 4) ? (C_RETK + Hh * 64) : (C_GLAK + (Hh - 4) * 64);
  const int vcol = (Hh < 4) ? (C_RETV + Hh * 128) : (C_GLAV + (Hh - 4) * 128);
  const int gcol = (Hh < 4) ? (C_RETG + Hh * 128) : (C_GLAG + (Hh - 4) * 128);
  const int ocol = (Hh < 4) ? (Hh * 128) : (1024 + (Hh - 4) * 128);
  __syncthreads();
  la_bcum(p, layer, n, Hh, lds);
  const float* Bc = (const float*)(lds + LA_BC);
  half_t* Qt = (half_t*)(lds + LA_QT);
  half_t* Kt = (half_t*)(lds + LA_KT);
  half_t* AT = (half_t*)(lds + LA_AT);
  half_t* VT = (half_t*)(lds + LA_VT);
  half_t* SS = (half_t*)(lds + LA_SS);
  float* OS = (float*)(lds + LA_OS);
#pragma unroll
  for (int it = 0; it < 2; ++it) {
    int c = tid + 256 * it;
    int row = c >> 3, kc = c & 7;
    h8 qv = *(const h8*)(P + (size_t)(t0 + row) * PP + qcol + kc * 8);
    h8 kv = *(const h8*)(P + (size_t)(t0 + row) * PP + kcol + kc * 8);
    h8 qo, ko;
#pragma unroll
    for (int q = 0; q < 8; ++q) {
      float b = Bc[row * 65 + kc * 8 + q];
      qo[q] = (half_t)((float)qv[q] * __expf(b));
      ko[q] = (half_t)((float)kv[q] * __expf(-b));
    }
    *(h8*)(Qt + row * 72 + kc * 8) = qo;
    *(h8*)(Kt + row * 72 + kc * 8) = ko;
  }
  la_stage_vt(P, t0, vcol, lds);
#pragma unroll
  for (int it = 0; it < 4; ++it) {
    int c = tid + 256 * it;
    int e = c >> 3, kc = c & 7;
    *(h8*)(SS + e * 72 + kc * 8) = *(const h8*)(ST + (size_t)item * 8192 + e * 64 + kc * 8);
  }
  __syncthreads();
  {
    const int mi = w >> 1, nj = w & 1;
    f16v acc;
#pragma unroll
    for (int r = 0; r < 16; ++r) acc[r] = ozero();
#pragma unroll
    for (int ks = 0; ks < 4; ++ks) {
      h8 a = *(const h8*)(Qt + (mi * 32 + (l & 31)) * 72 + ks * 16 + (l >> 5) * 8);
      h8 b = *(const h8*)(Kt + (nj * 32 + (l & 31)) * 72 + ks * 16 + (l >> 5) * 8);
      acc = mfma16(a, b, acc);
    }
#pragma unroll
    for (int r = 0; r < 16; ++r) {
      int i = mi * 32 + crow(r, l);
      int j = nj * 32 + (l & 31);
      float v = (j <= i) ? acc[r] : 0.f;
      AT[i * 72 + j] = (half_t)v;
    }
  }
  __syncthreads();
  {
    const int mi = w >> 1, nh = w & 1;
    f16v acc[2];
#pragma unroll
    for (int j = 0; j < 2; ++j)
#pragma unroll
      for (int r = 0; r < 16; ++r) acc[j][r] = ozero();
#pragma unroll
    for (int ks = 0; ks < 4; ++ks) {
      h8 a1 = *(const h8*)(AT + (mi * 32 + (l & 31)) * 72 + ks * 16 + (l >> 5) * 8);
      h8 a2 = *(const h8*)(Qt + (mi * 32 + (l & 31)) * 72 + ks * 16 + (l >> 5) * 8);
#pragma unroll
      for (int j = 0; j < 2; ++j) {
        h8 b1 = *(const h8*)(VT + (nh * 64 + j * 32 + (l & 31)) * 72 + ks * 16 + (l >> 5) * 8);
        h8 b2 = *(const h8*)(SS + (nh * 64 + j * 32 + (l & 31)) * 72 + ks * 16 + (l >> 5) * 8);
        acc[j] = mfma16(a1, b1, acc[j]);
        acc[j] = mfma16(a2, b2, acc[j]);
      }
    }
#pragma unroll
    for (int j = 0; j < 2; ++j)
#pragma unroll
      for (int r = 0; r < 16; ++r) {
        int i = mi * 32 + crow(r, l);
        int e = nh * 64 + j * 32 + (l & 31);
        OS[i * 132 + e] = acc[j][r];
      }
  }
  __syncthreads();
  {
    const int i = tid >> 2, qd = tid & 3;
    float ov[32];
    float ss = 0.f;
#pragma unroll
    for (int c = 0; c < 8; ++c) {
      f4v v = *(const f4v*)(OS + i * 132 + qd * 32 + c * 4);
      ov[c * 4] = v[0]; ov[c * 4 + 1] = v[1]; ov[c * 4 + 2] = v[2]; ov[c * 4 + 3] = v[3];
      ss += v[0] * v[0] + v[1] * v[1] + v[2] * v[2] + v[3] * v[3];
    }
    ss += dppf<0xB1>(ss);
    ss += dppf<0x4E>(ss);
    float rs = rsqrtf(ss * (1.0f / 128.0f) + 1e-6f);
#pragma unroll
    for (int c = 0; c < 4; ++c) {
      h8 g = *(const h8*)(P + (size_t)(t0 + i) * PP + gcol + qd * 32 + c * 8);
      h8 o;
#pragma unroll
      for (int q = 0; q < 8; ++q) o[q] = (half_t)(ov[c * 8 + q] * rs * (float)g[q]);
      *(h8*)(BR + (size_t)(t0 + i) * 1536 + ocol + qd * 32 + c * 8) = o;
    }
  }
}

#define DS_CAP 640
#define DS_PRUNE_AT 512
#define NPL 10
#define DS_LS 0
#define DS_LI (32 * DS_CAP * 4)
#define DS_CNT (32 * DS_CAP * 6)
#define DS_THR (DS_CNT + 128)
#define DS_WQ (DS_CNT + 256)
#define DS_HIST (DS_CNT + 1024)
#define DS_PW (DS_CNT + 1024 + 4096)

__device__ __forceinline__ unsigned long long wave_or64(unsigned long long v) {
  const unsigned lo = wave_or((unsigned)v), hi = wave_or((unsigned)(v >> 32));
  return ((unsigned long long)hi << 32) | lo;
}
__device__ __forceinline__ void dsa_prune(float* LSm, unsigned short* LIm, int n, unsigned* hist, int* cntm, float* thrm, int l) {
  unsigned long long comp[NPL];
  bool act[NPL], val[NPL];
#pragma unroll
  for (int k = 0; k < NPL; ++k) {
    int e = l + 64 * k;
    val[k] = e < n;
    unsigned u = 0, li = 0;
    if (val[k]) { u = __float_as_uint(LSm[e]); li = LIm[e]; }
    const unsigned key = (u >> 31) ? ~u : (u | 0x80000000u);
    comp[k] = ((unsigned long long)key << 14) | (unsigned long long)(16383u - li);
    act[k] = val[k];
  }
  const unsigned long long c0 = ((unsigned long long)(unsigned)__builtin_amdgcn_readfirstlane((int)(unsigned)(comp[0] >> 32)) << 32) | (unsigned)__builtin_amdgcn_readfirstlane((int)(unsigned)comp[0]);
  unsigned long long x = 0;
#pragma unroll
  for (int k = 0; k < NPL; ++k) x |= val[k] ? (comp[k] ^ c0) : 0ull;
  x = wave_or64(x);
  int shift = (x == 0ull) ? 0 : (63 - __clzll((long long)x)) - 7;
  if (shift < 0) shift = 0;
  unsigned rank = 256;
#pragma unroll 1
  for (int rd = 0; rd < 8; ++rd) {
    *(uint4*)(hist + 4 * l) = make_uint4(0, 0, 0, 0);
    __threadfence_block();
    unsigned dk[NPL];
#pragma unroll
    for (int k = 0; k < NPL; ++k) {
      dk[k] = (unsigned)(comp[k] >> shift) & 255u;
      if (act[k]) atomicAdd(&hist[dk[k]], 1u);
    }
    __threadfence_block();
    uint4 hv; hv.x = hist[4 * l]; hv.y = hist[4 * l + 1]; hv.z = hist[4 * l + 2]; hv.w = hist[4 * l + 3];
    unsigned tl = hv.x + hv.y + hv.z + hv.w;
    const unsigned pin = wave_incl_scan(tl);
    const unsigned tot = (unsigned)__builtin_amdgcn_readlane((int)pin, 63);
    unsigned sx = tot - pin;
    bool mine = (sx < rank) && (rank <= sx + tl);
    unsigned dsel = 0, nr = 0, hsel = 0;
    if (mine) {
      unsigned c = sx;
      if (c + hv.w >= rank) { dsel = 4 * l + 3; nr = rank - c; hsel = hv.w; }
      else {
        c += hv.w;
        if (c + hv.z >= rank) { dsel = 4 * l + 2; nr = rank - c; hsel = hv.z; }
        else {
          c += hv.z;
          if (c + hv.y >= rank) { dsel = 4 * l + 1; nr = rank - c; hsel = hv.y; }
          else { c += hv.y; dsel = 4 * l; nr = rank - c; hsel = hv.x; }
        }
      }
    }
    unsigned long long mk = __ballot(mine);
    int src = (mk == 0ull) ? 0 : (__ffsll((long long)mk) - 1);
    dsel = (unsigned)__builtin_amdgcn_readlane((int)dsel, src);
    rank = (unsigned)__builtin_amdgcn_readlane((int)nr, src);
    hsel = (unsigned)__builtin_amdgcn_readlane((int)hsel, src);
#pragma unroll
    for (int k = 0; k < NPL; ++k) act[k] = act[k] && (dk[k] == dsel);
    if (hsel <= 1u || shift == 0) break;
    shift = (shift >= 8) ? (shift - 8) : 0;
  }
  unsigned long long tsel = 0;
#pragma unroll
  for (int k = 0; k < NPL; ++k) tsel |= act[k] ? comp[k] : 0ull;
  const unsigned long long T = wave_or64(tsel);
  bool keep[NPL];
  unsigned cntk = 0;
#pragma unroll
  for (int k = 0; k < NPL; ++k) {
    keep[k] = val[k] && (comp[k] >= T);
    cntk += keep[k] ? 1u : 0u;
  }
  unsigned pos = wave_incl_scan(cntk) - cntk;
  __threadfence_block();
#pragma unroll
  for (int k = 0; k < NPL; ++k) {
    if (keep[k]) {
      const unsigned kk = (unsigned)(comp[k] >> 14);
      const unsigned u = (kk & 0x80000000u) ? (kk & 0x7FFFFFFFu) : ~kk;
      LSm[pos] = __uint_as_float(u);
      LIm[pos] = (unsigned short)(16383u - ((unsigned)comp[k] & 16383u));
      ++pos;
    }
  }
  if (l == 0) {
    const unsigned T32 = (unsigned)(T >> 14);
    *cntm = 256;
    *thrm = __uint_as_float((T32 & 0x80000000u) ? (T32 & 0x7FFFFFFFu) : ~T32);
  }
  __threadfence_block();
}

__device__ void dsa_item(const Params& p, int qb, unsigned char* lds) {
  const int tid = otid(), w = tid >> 6, l = tid & 63;
  const int t0 = qb * 32;
  const half_t* P = (const half_t*)(p.ws + OFF_P);
  const float* IW = (const float*)(p.ws + OFF_IW);
  half_t* BR = (half_t*)(p.ws + OFF_BR);
  float* LS = (float*)(lds + DS_LS);
  unsigned short* LI = (unsigned short*)(lds + DS_LI);
  int* cnt = (int*)(lds + DS_CNT);
  float* thr = (float*)(lds + DS_THR);
  float* wq = (float*)(lds + DS_WQ);
  unsigned* hist = (unsigned*)(lds + DS_HIST) + w * 256;
  float* PW = (float*)(lds + DS_PW) + w * 1024;
  half_t* QS = (half_t*)(lds + DS_PW + 16384) + w * 512;
  for (int rep_sel = 0; rep_sel < REP_SEL; ++rep_sel) {
  __syncthreads();
  if (tid < 32) { cnt[tid] = 0; thr[tid] = -INFINITY; }
  if (tid < 128) wq[tid] = IW[(size_t)t0 * 4 + tid];
  __syncthreads();
  h8 aq[4][4];
#pragma unroll
  for (int h = 0; h < 4; ++h)
#pragma unroll
    for (int ks = 0; ks < 4; ++ks)
      aq[h][ks] = *(const h8*)(P + (size_t)(t0 + (l & 31)) * PP + C_IDXQ + h * 64 + ks * 16 + (l >> 5) * 8);
  const int nt = qb + 1;
  const int nr = (nt + 3) >> 2;
  f4v wqv[16];
#pragma unroll
  for (int r = 0; r < 16; ++r) wqv[r] = *(const f4v*)(wq + crow(r, l) * 4);
  float thv[16];
  { float ninf = -INFINITY; asm volatile("" : "+v"(ninf));
#pragma unroll
  for (int r = 0; r < 16; ++r) thv[r] = ninf; }
  h8 bk[4];
  {
    const int k0 = (w < nt) ? w : 0;
#pragma unroll
    for (int ks = 0; ks < 4; ++ks)
      bk[ks] = *(const h8*)(P + (size_t)(k0 * 32 + (l & 31)) * PP + C_IDXK + ks * 16 + (l >> 5) * 8);
  }
#pragma unroll 1
  for (int rd = 0; rd < nr; ++rd) {
    const int kt = 4 * rd + w;
    h8 bkn[4];
    {
      const int kn = (kt + 4 < nt) ? (kt + 4) : 0;
#pragma unroll
      for (int ks = 0; ks < 4; ++ks)
        bkn[ks] = *(const h8*)(P + (size_t)(kn * 32 + (l & 31)) * PP + C_IDXK + ks * 16 + (l >> 5) * 8);
    }
    if (kt < nt) {
      const int sbase = kt * 32;
      f16v acc[4];
#pragma unroll
      for (int h = 0; h < 4; ++h) {
#pragma unroll
        for (int r = 0; r < 16; ++r) acc[h][r] = ozero();
#pragma unroll
        for (int ks = 0; ks < 4; ++ks) acc[h] = mfma16(aq[h][ks], bk[ks], acc[h]);
      }
      const int s = sbase + (l & 31);
      float scv[16];
      unsigned pm = 0;
#pragma unroll
      for (int r = 0; r < 16; ++r) {
        const int m = crow(r, l);
        const f4v wv = wqv[r];
        float sc = wv[0] * relu_f(acc[0][r]) + wv[1] * relu_f(acc[1][r]) + wv[2] * relu_f(acc[2][r]) + wv[3] * relu_f(acc[3][r]);
        sc += 0.0f;
        scv[r] = sc;
      }
      if (kt == qb) {
#pragma unroll
        for (int r = 0; r < 16; ++r) if (s > t0 + crow(r, l)) scv[r] = -INFINITY;
      }
#pragma unroll
      for (int r = 0; r < 16; ++r) pm |= (scv[r] > thv[r]) ? (1u << r) : 0u;
      if (__ballot(pm != 0u) != 0ull) {
        unsigned long long mks[16];
        int mycnt = 0;
#pragma unroll
        for (int r = 0; r < 16; ++r) {
          const unsigned long long mk = __ballot(((pm >> r) & 1u) != 0u);
          mks[r] = mk;
          const unsigned hm = (l < 32) ? (unsigned)mk : (unsigned)(mk >> 32);
          if ((l & 31) == r) mycnt = __popc(hm);
        }
        int base = 0;
        if ((l & 31) < 16 && mycnt > 0) base = atomicAdd(&cnt[crow(l & 31, l)], mycnt);
#pragma unroll
        for (int r = 0; r < 16; ++r) {
          const unsigned long long mk = mks[r];
          if (mk != 0ull) {
            const unsigned hm = (l < 32) ? (unsigned)mk : (unsigned)(mk >> 32);
            const int b_lo = __builtin_amdgcn_readlane(base, r), b_hi = __builtin_amdgcn_readlane(base, 32 + r);
            const int bb = (l < 32) ? b_lo : b_hi;
            if ((pm >> r) & 1u) {
              const int m = crow(r, l);
              const int slot = bb + __popc(hm & ((1u << (l & 31)) - 1u));
              LS[m * DS_CAP + slot] = scv[r];
              LI[m * DS_CAP + slot] = (unsigned short)s;
            }
          }
        }
      }
    }
    __syncthreads();
    bool any_prune;
    {
      const int cv = (l < 32) ? cnt[l] : 0;
      unsigned pmask = (unsigned)__ballot(cv > DS_PRUNE_AT);
      any_prune = pmask != 0u;
      int j = 0;
      while (pmask != 0u) {
        const int m = __ffs((int)pmask) - 1;
        pmask &= pmask - 1u;
        if ((j & 3) == w) dsa_prune(LS + m * DS_CAP, LI + m * DS_CAP, cnt[m], hist, cnt + m, thr + m, l);
        ++j;
      }
    }
    __syncthreads();
    if (any_prune) {
#pragma unroll
      for (int r = 0; r < 16; ++r) thv[r] = thr[crow(r, l)];
    }
#pragma unroll
    for (int ks = 0; ks < 4; ++ks) bk[ks] = bkn[ks];
  }
  }
#pragma unroll 1
  for (int mm = 0; mm < 8; ++mm) {
    const int m = w * 8 + mm;
    const int c = cnt[m];
    if (c > 256) dsa_prune(LS + m * DS_CAP, LI + m * DS_CAP, c, hist, cnt + m, thr + m, l);
  }
  asm volatile("s_waitcnt lgkmcnt(0)" ::: "memory");
  for (int rep_att = 0; rep_att < REP_ATT; ++rep_att) {
  h8 kvr[4][8];
  {
    const int m = w * 8;
    const int c = min(cnt[m], 256);
    const unsigned short* LIm = LI + m * DS_CAP;
#pragma unroll
    for (int kk = 0; kk < 4; ++kk) {
      const int e = l + 64 * kk;
      const int s = (e < c) ? (int)LIm[e] : 0;
      const half_t* kr = P + (size_t)s * PP + C_DSAK;
#pragma unroll
      for (int ch = 0; ch < 8; ++ch) kvr[kk][ch] = *(const h8*)(kr + ch * 8);
    }
  }
  h8 qreg = *(const h8*)(P + (size_t)(t0 + w * 8) * PP + C_DSAQ + l * 8);
  const int dch = l & 7, ksub = l >> 3;
#pragma unroll 1
  for (int u = 0; u < 16; ++u) {
    const int mm = u >> 1, g = u & 1;
    const int m = w * 8 + mm;
    const int t = t0 + m;
    const int c = min(cnt[m], 256);
    const unsigned short* LIm = LI + m * DS_CAP;
    if (g == 0) {
      *(h8*)(QS + l * 8) = qreg;
      const int mq = (mm < 7) ? (m + 1) : m;
      qreg = *(const h8*)(P + (size_t)(t0 + mq) * PP + C_DSAQ + l * 8);
    }
    h8 gt[4];
#pragma unroll
    for (int hh = 0; hh < 4; ++hh) gt[hh] = *(const h8*)(P + (size_t)t * PP + C_DSAG + (g * 4 + hh) * 64 + dch * 8);
    h8 vv[16];
#pragma unroll
    for (int i = 0; i < 16; ++i) {
      const int e = i * 8 + ksub;
      const int s = (e < c) ? (int)LIm[e] : 0;
      vv[i] = *(const h8*)(P + (size_t)s * PP + C_DSAV + g * 64 + dch * 8);
    }
    asm volatile("s_waitcnt lgkmcnt(0)" ::: "memory");
    float lg[4][4];
#pragma unroll
    for (int hh = 0; hh < 4; ++hh) {
#pragma unroll
      for (int kk = 0; kk < 4; ++kk) lg[hh][kk] = ozero();
#pragma unroll
      for (int ch = 0; ch < 8; ++ch) {
        const h8 qq = *(const h8*)(QS + (g * 4 + hh) * 64 + ch * 8);
#pragma unroll
        for (int kk = 0; kk < 4; ++kk) {
          float a = lg[hh][kk];
          a = __builtin_amdgcn_fdot2(__builtin_shufflevector(qq, qq, 0, 1), __builtin_shufflevector(kvr[kk][ch], kvr[kk][ch], 0, 1), a, false);
          a = __builtin_amdgcn_fdot2(__builtin_shufflevector(qq, qq, 2, 3), __builtin_shufflevector(kvr[kk][ch], kvr[kk][ch], 2, 3), a, false);
          a = __builtin_amdgcn_fdot2(__builtin_shufflevector(qq, qq, 4, 5), __builtin_shufflevector(kvr[kk][ch], kvr[kk][ch], 4, 5), a, false);
          a = __builtin_amdgcn_fdot2(__builtin_shufflevector(qq, qq, 6, 7), __builtin_shufflevector(kvr[kk][ch], kvr[kk][ch], 6, 7), a, false);
          lg[hh][kk] = a;
        }
      }
#pragma unroll
      for (int kk = 0; kk < 4; ++kk) lg[hh][kk] = (l + 64 * kk < c) ? lg[hh][kk] : -INFINITY;
    }
    {
      const int un = (u < 15) ? (u + 1) : 15;
      const int mn = w * 8 + (un >> 1), gn = un & 1;
      const int cn = min(cnt[mn], 256);
      const unsigned short* LIn = LI + mn * DS_CAP;
#pragma unroll
      for (int kk = 0; kk < 4; ++kk) {
        const int e = l + 64 * kk;
        const int s = (e < cn) ? (int)LIn[e] : 0;
        const half_t* kr = P + (size_t)s * PP + C_DSAK + gn * 64;
#pragma unroll
        for (int ch = 0; ch < 8; ++ch) kvr[kk][ch] = *(const h8*)(kr + ch * 8);
      }
    }
#pragma unroll
    for (int hh = 0; hh < 4; ++hh) {
      float mx = fmaxf(fmaxf(lg[hh][0], lg[hh][1]), fmaxf(lg[hh][2], lg[hh][3]));
      mx = wave_max(mx);
      float ev[4]; float sm = 0.f;
#pragma unroll
      for (int kk = 0; kk < 4; ++kk) { ev[kk] = __expf(lg[hh][kk] - mx); sm += ev[kk]; }
      sm = wave_sum(sm);
      const float inv = 1.0f / sm;
#pragma unroll
      for (int kk = 0; kk < 4; ++kk) PW[(l + 64 * kk) * 4 + hh] = ev[kk] * inv;
    }
    asm volatile("s_waitcnt lgkmcnt(0)" ::: "memory");
    float o[4][8];
#pragma unroll
    for (int hh = 0; hh < 4; ++hh)
#pragma unroll
      for (int q = 0; q < 8; ++q) o[hh][q] = ozero();
    const int nit = (c + 7) >> 3;
#pragma unroll 1
    for (int it0 = 0; it0 < nit; it0 += 16) {
      if (it0 > 0) {
#pragma unroll
        for (int i = 0; i < 16; ++i) {
          const int e = (it0 + i) * 8 + ksub;
          const int s = (e < c) ? (int)LIm[e] : 0;
          vv[i] = *(const h8*)(P + (size_t)s * PP + C_DSAV + g * 64 + dch * 8);
        }
      }
#pragma unroll
      for (int i = 0; i < 16; ++i) {
        const int e = (it0 + i) * 8 + ksub;
        const f4v pv = *(const f4v*)(PW + e * 4);
#pragma unroll
        for (int hh = 0; hh < 4; ++hh)
#pragma unroll
          for (int q = 0; q < 8; ++q) o[hh][q] += pv[hh] * (float)vv[i][q];
      }
    }
#pragma unroll
    for (int hh = 0; hh < 4; ++hh)
#pragma unroll
      for (int q = 0; q < 8; ++q) {
        float v = o[hh][q];
        v += dppf<0x128>(v); v += xor16f(v); v += xor32f(v);
        o[hh][q] = v;
      }
    if (l < 8) {
#pragma unroll
      for (int hh = 0; hh < 4; ++hh) {
        const int col = (g * 4 + hh) * 64 + dch * 8;
        h8 ov;
#pragma unroll
        for (int q = 0; q < 8; ++q) ov[q] = (half_t)(o[hh][q] * (float)gt[hh][q]);
        *(h8*)(BR + (size_t)t * 1536 + 512 + col) = ov;
      }
    }
    asm volatile("s_waitcnt lgkmcnt(0)" ::: "memory");
  }
  }
}

__device__ void phase_B(const Params& p, int layer, unsigned char* lds) {
  const int G = gridDim.x;
  for (int j = 0; j * G < 512; ++j) {
    const int b = (j & 1) ? (G - 1 - (int)blockIdx.x) : (int)blockIdx.x;
    const int idx = j * G + b;
#ifndef NO_DSA
    if (idx < 512) dsa_item(p, 511 - idx, lds);
#endif
  }
  for (int rep = 0; rep < REP_KV; ++rep)
  for (int it = blockIdx.x; it < 2048; it += G) la_item_kv(p, layer, it, lds);
}

__device__ void phase_E1(const Params& p, int layer, unsigned char* lds, int my_xcc, int my_loc, const unsigned* xcnt) {
  const int tid = otid(), w = tid >> 6, l = tid & 63;
  const half_t* BR = (const half_t*)(p.ws + OFF_BR);
  const half_t* WbrT = (const half_t*)(p.ws + OFF_WBRT) + (size_t)layer * 3 * 1024 * WBP;
  const half_t* P = (const half_t*)(p.ws + OFF_P);
  half_t* Y1 = (half_t*)(p.ws + OFF_H);
  const int wm = w >> 1, wn = w & 1;
  float* E = (float*)(lds + GEMM_EOFF) + w * (32 * 65);
  const int prow = l >> 3, c0 = (l & 7) * 8;
  const int nx = xcc_census(xcnt, my_xcc);
  const int nrounds = (nx > 0) ? (64 + nx - 1) / nx : (512 + (int)gridDim.x - 1) / (int)gridDim.x;
  for (int rnd = 0; rnd < nrounds; ++rnd) {
    int mt, nt;
    if (nx > 0) {
      const int s = my_loc + nx * rnd;
      if (s >= 64) continue;
      mt = my_xcc * 8 + (s & 7); nt = s >> 3;
    } else {
      const int tix = rnd * (int)gridDim.x + (int)blockIdx.x;
      if (tix >= 512) continue;
      mt = tix & 63; nt = tix >> 6;
    }
    h8 tot[4][4];
#pragma unroll
    for (int i = 0; i < 4; ++i)
#pragma unroll
      for (int ps = 0; ps < 4; ++ps)
#pragma unroll
        for (int q = 0; q < 8; ++q) tot[i][ps][q] = (half_t)ozero();
    const int m0w = mt * 256 + wm * 128;
    const int n0 = nt * 128 + wn * 64 + c0;
#pragma unroll 1
    for (int b = 0; b < 3; ++b) {
      f16v acc[4][2];
      zero_acc<2>(acc);
      gemm_kloop<2>(acc, BR + (size_t)mt * 256 * 1536 + b * 512, 1536, WbrT + (size_t)b * 1024 * WBP + (size_t)nt * 128 * WBP, WBP, 512, lds);
#pragma unroll
      for (int i = 0; i < 4; ++i) {
        stage_pair(E, acc[i][0], acc[i][1], l);
#pragma unroll
        for (int ps = 0; ps < 4; ++ps) {
          const int rl = ps * 8 + prow;
          const int row = m0w + i * 32 + rl;
          const h8 g = *(const h8*)(P + (size_t)row * PP + C_MRG + b * 1024 + n0);
#pragma unroll
          for (int q = 0; q < 8; ++q) tot[i][ps][q] = (half_t)((float)tot[i][ps][q] + (float)g[q] * E[rl * 65 + c0 + q]);
        }
      }
    }
#pragma unroll
    for (int i = 0; i < 4; ++i)
#pragma unroll
      for (int ps = 0; ps < 4; ++ps) {
        const int row = m0w + i * 32 + ps * 8 + prow;
        *(h8*)(Y1 + (size_t)row * HP + n0) = tot[i][ps];
      }
  }
}

__device__ void phase_E2(const Params& p, int layer, unsigned char* lds, int my_xcc, int my_loc, const unsigned* xcnt) {
  const int tid = otid(), w = tid >> 6, l = tid & 63;
  const half_t* Y1 = (const half_t*)(p.ws + OFF_H);
  const half_t* Wo = (const half_t*)(p.ws + OFF_WOUTT) + (size_t)layer * 1024 * WP;
  float* Y = (float*)(p.ws + OFF_ST);
  const int wm = w >> 1, wn = w & 1;
  const int nx = xcc_census(xcnt, my_xcc);
  const int nrounds = (nx > 0) ? (64 + nx - 1) / nx : (512 + (int)gridDim.x - 1) / (int)gridDim.x;
  for (int rnd = 0; rnd < nrounds; ++rnd) {
    int mt, nt;
    if (nx > 0) {
      const int s = my_loc + nx * rnd;
      if (s >= 64) continue;
      mt = my_xcc * 8 + (s & 7); nt = s >> 3;
    } else {
      const int tix = rnd * (int)gridDim.x + (int)blockIdx.x;
      if (tix >= 512) continue;
      mt = tix & 63; nt = tix >> 6;
    }
    f16v acc[4][2];
    zero_acc<2>(acc);
    gemm_kloop<2>(acc, Y1 + (size_t)mt * 256 * HP, HP, Wo + (size_t)nt * 128 * WP, WP, 1024, lds);
    const int m0w = mt * 256 + wm * 128;
    const int n0w = nt * 128 + wn * 64;
#pragma unroll
    for (int i = 0; i < 4; ++i)
#pragma unroll
      for (int j = 0; j < 2; ++j)
#pragma unroll
        for (int r = 0; r < 16; ++r) {
          const int row = m0w + i * 32 + crow(r, l);
          const int n = n0w + j * 32 + (l & 31);
          Y[(size_t)row * 1024 + n] = acc[i][j][r];
        }
  }
}

__device__ void phase_E3(const Params& p, int layer) {
  const int w = otid() >> 6, l = otid() & 63;
  const float* Y = (const float*)(p.ws + OFF_ST);
  const float* MOD = (const float*)(p.ws + OFF_MOD);
  half_t* H = (half_t*)(p.ws + OFF_H);
  const float* xin = (layer == 0) ? p.x : p.out;
  const float* gate = MOD + layer * 3072 + 2048;
  const float* post = p.post_norm + layer * 1024;
  const int stride = gridDim.x * 4;
  int row = blockIdx.x * 4 + w;
  f4v yn[4], xn[4];
  if (row < S_LEN) {
#pragma unroll
    for (int i = 0; i < 4; ++i) {
      yn[i] = *(const f4v*)(Y + (size_t)row * 1024 + i * 256 + l * 4);
      xn[i] = *(const f4v*)(xin + (size_t)row * 1024 + i * 256 + l * 4);
    }
  }
  for (; row < S_LEN; row += stride) {
    float yv[16], xv[16];
    float ss = 0.f;
#pragma unroll
    for (int i = 0; i < 4; ++i)
#pragma unroll
      for (int q = 0; q < 4; ++q) { yv[i * 4 + q] = yn[i][q]; xv[i * 4 + q] = xn[i][q]; ss += yn[i][q] * yn[i][q]; }
    const int nrow = (row + stride < S_LEN) ? (row + stride) : row;
#pragma unroll
    for (int i = 0; i < 4; ++i) {
      yn[i] = *(const f4v*)(Y + (size_t)nrow * 1024 + i * 256 + l * 4);
      xn[i] = *(const f4v*)(xin + (size_t)nrow * 1024 + i * 256 + l * 4);
    }
    ss = wave_sum(ss);
    const float rs = rsqrtf(ss * (1.0f / 1024.0f) + 1e-6f);
#pragma unroll
    for (int i = 0; i < 4; ++i) {
      const int c0 = i * 256 + l * 4;
      f4v gt = *(const f4v*)(gate + c0);
      f4v pn = *(const f4v*)(post + c0);
      f4v o;
#pragma unroll
      for (int q = 0; q < 4; ++q) { o[q] = xv[i * 4 + q] + gt[q] * (yv[i * 4 + q] * rs * pn[q]); xv[i * 4 + q] = o[q]; }
      *(f4v*)(p.out + (size_t)row * 1024 + c0) = o;
    }
    if (layer + 1 < DEPTH)
      write_h_row(xv, p.pre_norm + (layer + 1) * 1024, MOD + (layer + 1) * 3072, H + (size_t)row * HP, l);
  }
}

#define XB_TMO      128
#define XB_XCNT(j)  (256  + 64 * (j))
#define XB_XSUB(j)  (1280 + 64 * (j))
#define XB_XGEN(j)  (2304 + 64 * (j))
#define XB_TOP      3328
#define XB_TOPGEN   3392
#define XCD_BAR_WORDS 3456
#define XB_SPIN_CAP (1u << 18)
#define LAS __attribute__((address_space(3)))

__device__ __forceinline__ unsigned xb_ld(unsigned* p)              { return __hip_atomic_load(p, __ATOMIC_RELAXED, __HIP_MEMORY_SCOPE_AGENT); }
__device__ __forceinline__ unsigned xb_add(unsigned* p, unsigned v) { return __hip_atomic_fetch_add(p, v, __ATOMIC_RELAXED, __HIP_MEMORY_SCOPE_AGENT); }
__device__ __forceinline__ unsigned xb_xcc_id() { return (unsigned)__builtin_amdgcn_s_getreg((3 << 11) | 20) & 0xFu; }
#define XB_SPIN(cond, bar) do { unsigned _sp = 0; while (cond) { __builtin_amdgcn_s_sleep(1); \
    if ((++_sp & 255u) == 0u) { if (xb_ld(&(bar)[XB_TMO])) break; if (_sp > XB_SPIN_CAP) { atomicAdd(&(bar)[XB_TMO], 1u); break; } } } } while (0)

struct XcdBarrier {
    unsigned* bar; unsigned x;
    volatile LAS unsigned* st;
};

__device__ __forceinline__ XcdBarrier xcd_barrier_post(unsigned* bar, volatile LAS unsigned* st) {
    XcdBarrier b; b.bar = bar; b.x = xb_xcc_id(); b.st = st;
    if (otid() == 0) (void)xb_add(&bar[XB_XCNT(b.x)], 1u);
    return b;
}
__device__ __forceinline__ void xcd_barrier_complete(unsigned* bar, unsigned x, unsigned& nloc, unsigned& nx) {
    const unsigned G = gridDim.x * gridDim.y * gridDim.z;
    unsigned sum, cnt, mine, sp = 0u;
    for (;;) {
        sum = 0u; cnt = 0u; mine = 0u;
#pragma unroll
        for (unsigned j = 0; j < 16; ++j) { const unsigned c = xb_ld(&bar[XB_XCNT(j)]); sum += c; cnt += (c > 0u) ? 1u : 0u; mine = (j == x) ? c : mine; }
        if (sum == G) break;
        __builtin_amdgcn_s_sleep(1);
        if ((++sp & 255u) == 0u) { if (xb_ld(&bar[XB_TMO])) break; if (sp > XB_SPIN_CAP) { atomicAdd(&bar[XB_TMO], 1u); break; } }
    }
    nloc = mine > 0u ? mine : 1u; nx = cnt > 0u ? cnt : 1u;
}

__device__ __forceinline__ void xcd_barrier(const XcdBarrier& b) {
    asm volatile("s_waitcnt vmcnt(0)" ::: "memory");
    __syncthreads();
    if (otid() == 0) {
        unsigned* bar = b.bar;
        __builtin_amdgcn_s_waitcnt(0);
        unsigned nloc = b.st[0], nx = b.st[1];
        if (nloc == 0u) { xcd_barrier_complete(bar, b.x, nloc, nx); b.st[0] = nloc; b.st[1] = nx; }
        const unsigned old = xb_add(&bar[XB_XSUB(b.x)], 1u);
        const unsigned gen = old / nloc;
        if (old + 1u == (gen + 1u) * nloc) {
            __builtin_amdgcn_fence(__ATOMIC_RELEASE, "agent");
            asm volatile("s_waitcnt vmcnt(0)" ::: "memory");
            const unsigned og = xb_add(&bar[XB_TOP], 1u);
            const unsigned tg = og / nx;
            if (og + 1u == (tg + 1u) * nx) xb_add(&bar[XB_TOPGEN], 1u);
            else XB_SPIN(xb_ld(&bar[XB_TOPGEN]) == tg, bar);
            __builtin_amdgcn_fence(__ATOMIC_ACQUIRE, "agent");
            xb_add(&bar[XB_XGEN(b.x)], 1u);
            asm volatile("s_waitcnt vmcnt(0)" ::: "memory");
        } else {
            XB_SPIN(xb_ld(&bar[XB_XGEN(b.x)]) == gen, bar);
            __builtin_amdgcn_fence(__ATOMIC_ACQUIRE, "agent");
            asm volatile("s_waitcnt vmcnt(0)" ::: "memory");
        }
    }
    __syncthreads();
}


};

#ifndef REP_D
#define REP_D 1
#endif
#ifndef REP_E
#define REP_E 1
#endif
#ifndef REP_A
#define REP_A 1
#endif
#ifndef REP_B
#define REP_B 1
#endif
#ifdef ONLY_PHASE
#define PH_EN(x) (ONLY_PHASE == (x))
#else
#define PH_EN(x) true
#endif
__global__ void __launch_bounds__(NTHREADS) fwd_megakernel(Params p) {
  extern __shared__ __attribute__((aligned(16))) unsigned char lds[];
  cg::grid_group grid = cg::this_grid();
  K k; k.wbase = __builtin_amdgcn_readfirstlane((int)__builtin_amdgcn_workitem_id_x()) & ~63;
  unsigned* bar = (unsigned*)(p.ws + WS_END);
  unsigned* xcnt = bar + 16;
  unsigned* xbar = (unsigned*)(p.ws + WS_END + 1024);
  if (blockIdx.x == 0) {
    if (k.otid() < 17) __hip_atomic_store(bar + (k.otid() == 16 ? 0 : 16 + k.otid()), 0u, __ATOMIC_RELAXED, __HIP_MEMORY_SCOPE_AGENT);
    for (int i = k.otid(); i < XCD_BAR_WORDS; i += NTHREADS) __hip_atomic_store(xbar + i, 0u, __ATOMIC_RELAXED, __HIP_MEMORY_SCOPE_AGENT);
  }
  volatile LAS unsigned* xst = (volatile LAS unsigned*)(lds + LDS_BYTES - 16);
  if (k.otid() == 0) { xst[0] = 0u; xst[1] = 0u; }
  __syncthreads();
  K::XcdBarrier xb; xb.bar = xbar; xb.x = 0; xb.st = xst;
  int my_xcc = 0, my_loc = 0;
  for (int ph = p.ph_lo; ph < p.ph_hi; ++ph) {
    if (ph == 0) { if (PH_EN(0)) for (int rep = 0; rep < REP_P; ++rep) { k.phase_prologue(p, lds); __syncthreads(); } }
    else if (ph == 1) {
      xb = k.xcd_barrier_post(xbar, xst);
      int* sh = (int*)lds;
      if (k.otid() == 0) {
        const int xc = (int)(__builtin_amdgcn_s_getreg((3 << 11) | 20) & 0xFu);
        sh[0] = xc;
        sh[1] = (int)__hip_atomic_fetch_add(xcnt + xc, 1u, __ATOMIC_RELAXED, __HIP_MEMORY_SCOPE_AGENT);
      }
      __syncthreads();
      my_xcc = __builtin_amdgcn_readfirstlane(sh[0]);
      my_loc = __builtin_amdgcn_readfirstlane(sh[1]);
      __syncthreads();
      if (PH_EN(1)) k.phase_h0(p);
    }
    else {
      const int layer = (ph - 2) / 7, sub = (ph - 2) % 7;
      if (sub == 0) { if (PH_EN(2)) for (int rep = 0; rep < REP_A; ++rep) { k.phase_A(p, layer, lds, my_xcc, my_loc, xcnt); __syncthreads(); } }
      else if (sub == 1) { if (PH_EN(3)) for (int rep = 0; rep < REP_B; ++rep) { k.phase_B(p, layer, lds); __syncthreads(); } }
      else if (sub == 2) { if (PH_EN(4)) k.phase_scan(p); }
      else if (sub == 3) { if (PH_EN(5)) for (int rep = 0; rep < REP_D; ++rep) { for (int it = blockIdx.x; it < 2048; it += gridDim.x) k.la_item_out(p, layer, it, lds); __syncthreads(); } }
      else if (sub == 4) { if (PH_EN(6)) for (int rep = 0; rep < REP_E; ++rep) { k.phase_E1(p, layer, lds, my_xcc, my_loc, xcnt); __syncthreads(); } }
      else if (sub == 5) { if (PH_EN(7)) for (int rep = 0; rep < REP_E; ++rep) { k.phase_E2(p, layer, lds, my_xcc, my_loc, xcnt); __syncthreads(); } }
      else { if (PH_EN(8)) k.phase_E3(p, layer); }
    }
    if (ph + 1 < p.ph_hi) {
      if (ph == p.ph_lo) grid.sync();
      else k.xcd_barrier(xb);
    }
  }
}

extern "C" void kernel_launch(void* const* d_in, const int* in_sizes, int n_in, void* d_out, int out_size,
                              void* d_ws, size_t ws_size, hipStream_t stream) {
  static int grid_blocks = 0;
  if (!grid_blocks) {
    int dev = 0, cus = 0, per_cu = 0;
    hipGetDevice(&dev);
    hipDeviceGetAttribute(&cus, hipDeviceAttributeMultiprocessorCount, dev);
    hipFuncSetAttribute((const void*)fwd_megakernel, hipFuncAttributeMaxDynamicSharedMemorySize, LDS_BYTES);
    hipOccupancyMaxActiveBlocksPerMultiprocessor(&per_cu, (const void*)fwd_megakernel, NTHREADS, LDS_BYTES);
    if (per_cu < 1) per_cu = 1;
    if (per_cu > 1) per_cu = 1;
    grid_blocks = cus * per_cu;
    if (ws_size < WS_END) fprintf(stderr, "workspace too small: %zu < %llu\n", ws_size, (unsigned long long)WS_END);
  }
  Params p{};
  p.x = (const float*)d_in[0]; p.c = (const float*)d_in[1]; p.pos = (const int*)d_in[2];
  p.ada_w = (const float*)d_in[3]; p.ada_b = (const float*)d_in[4];
  p.pre_norm = (const float*)d_in[5]; p.post_norm = (const float*)d_in[6];
  p.w_in = (const float*)d_in[7]; p.gla_w_lr = (const float*)d_in[8]; p.gla_b_lr = (const float*)d_in[9];
  p.w_br_ret = (const float*)d_in[10]; p.w_br_dsa = (const float*)d_in[11]; p.w_br_gla = (const float*)d_in[12];
  p.w_out = (const float*)d_in[13];
  p.out = (float*)d_out; p.ws = (unsigned char*)d_ws;
  p.ph_lo = 0; p.ph_hi = 2 + 7 * DEPTH;
  void* args[] = {&p};
  hipError_t e = hipLaunchCooperativeKernel((const void*)fwd_megakernel, dim3(grid_blocks), dim3(NTHREADS), args, LDS_BYTES, stream);
  if (e != hipSuccess) fprintf(stderr, "cooperative launch failed: %s (grid %d)\n", hipGetErrorString(e), grid_blocks);
}
```

```cpp
#include <hip/hip_runtime.h>
#include <hip/hip_cooperative_groups.h>
#include <stdint.h>
#include <cstdio>
namespace cg = cooperative_groups;
#ifndef REP_P
#define REP_P 1
#endif
#ifndef REP_KV
#define REP_KV 1
#endif
#ifndef REP_SEL
#define REP_SEL 1
#endif
#ifndef REP_ATT
#define REP_ATT 1
#endif

typedef _Float16 half_t;
typedef _Float16 h8 __attribute__((ext_vector_type(8)));
typedef _Float16 h4 __attribute__((ext_vector_type(4)));
typedef _Float16 h2 __attribute__((ext_vector_type(2)));
typedef float f16v __attribute__((ext_vector_type(16)));
typedef float f4v __attribute__((ext_vector_type(4)));

#define S_LEN 16384
#define DM 1024
#define NIN 7764
#define NPAD 7936
#define PP 7808
#define DEPTH 4
#define NTHREADS 256
#define HP 1088
#define WP 1088
#define WBP 576
#define LDS_BYTES 149504

#define C_RETQ 0
#define C_RETK 256
#define C_RETV 512
#define C_RETG 1024
#define C_DSAQ 1536
#define C_DSAK 2048
#define C_DSAV 2176
#define C_DSAG 2304
#define C_IDXQ 2816
#define C_IDXK 3072
#define C_GLAQ 3136
#define C_GLAK 3392
#define C_GLAV 3648
#define C_GLAG 4160
#define C_GLAA 4672
#define C_MRG 4688
#define C_END 7760
#define C_IDXW 7760

#define OFF_WINT 0ull
#define OFF_WBRT (OFF_WINT + 4ull * NPAD * WP * 2)
#define OFF_WOUTT (OFF_WBRT + 4ull * 3 * 1024 * WBP * 2)
#define OFF_MOD (OFF_WOUTT + 4ull * 1024 * WP * 2)
#define OFF_RT (OFF_MOD + 4ull * 3072 * 4)
#define OFF_DT (OFF_RT + 16384ull * 64 * 4)
#define OFF_H (OFF_DT + 16384ull * 16 * 4)
#define OFF_P (OFF_H + 16384ull * HP * 2)
#define OFF_GA (OFF_P + 16384ull * PP * 2)
#define OFF_IW (OFF_GA + 16384ull * 16 * 4)
#define OFF_ST (OFF_IW + 16384ull * 4 * 4)
#define OFF_DEC (OFF_ST + 256ull * 65536 * 4)
#define OFF_BR (OFF_DEC + 256ull * 8 * 64 * 4)
#define WS_END (OFF_BR + 16384ull * 1536 * 2)
static_assert(WS_END + 16384 <= 508821504ull, "workspace too large");

struct Params {
  const float* x; const float* c; const int* pos; const float* ada_w; const float* ada_b;
  const float* pre_norm; const float* post_norm; const float* w_in; const float* gla_w_lr;
  const float* gla_b_lr; const float* w_br_ret; const float* w_br_dsa; const float* w_br_gla;
  const float* w_out; float* out; unsigned char* ws;
  int ph_lo; int ph_hi;
};

struct K {
int wbase;
__device__ __forceinline__ int otid() const {
  int lane;
  asm volatile("v_mbcnt_lo_u32_b32 %0, -1, 0\n\tv_mbcnt_hi_u32_b32 %0, -1, %0" : "=v"(lane));
  return wbase | lane;
}
__device__ __forceinline__ static float ozero() { float z = 0.f; asm volatile("" : "+v"(z)); return z; }
template <int CTRL>
__device__ __forceinline__ float dppf(float v) {
  return __int_as_float(__builtin_amdgcn_update_dpp(0, __float_as_int(v), CTRL, 0xF, 0xF, true));
}
template <int CTRL>
__device__ __forceinline__ unsigned dppu(unsigned v) {
  return (unsigned)__builtin_amdgcn_update_dpp(0, (int)v, CTRL, 0xF, 0xF, true);
}
__device__ __forceinline__ int olane() { return otid() & 63; }
__device__ __forceinline__ float xor16f(float v) { return __int_as_float(__builtin_amdgcn_ds_bpermute((olane() ^ 16) << 2, __float_as_int(v))); }
__device__ __forceinline__ float xor32f(float v) { return __int_as_float(__builtin_amdgcn_ds_bpermute((olane() ^ 32) << 2, __float_as_int(v))); }
__device__ __forceinline__ unsigned xor16u(unsigned v) { return (unsigned)__builtin_amdgcn_ds_bpermute((olane() ^ 16) << 2, (int)v); }
__device__ __forceinline__ unsigned xor32u(unsigned v) { return (unsigned)__builtin_amdgcn_ds_bpermute((olane() ^ 32) << 2, (int)v); }
__device__ __forceinline__ float wave_sum(float v) {
  v += dppf<0xB1>(v); v += dppf<0x4E>(v); v += dppf<0x141>(v); v += dppf<0x140>(v);
  v += xor16f(v); v += xor32f(v);
  return v;
}
__device__ __forceinline__ float wave_max(float v) {
  v = fmaxf(v, dppf<0xB1>(v)); v = fmaxf(v, dppf<0x4E>(v)); v = fmaxf(v, dppf<0x141>(v)); v = fmaxf(v, dppf<0x140>(v));
  v = fmaxf(v, xor16f(v)); v = fmaxf(v, xor32f(v));
  return v;
}
__device__ __forceinline__ unsigned wave_or(unsigned v) {
  v |= dppu<0xB1>(v); v |= dppu<0x4E>(v); v |= dppu<0x141>(v); v |= dppu<0x140>(v);
  v |= xor16u(v); v |= xor32u(v);
  return v;
}
__device__ __forceinline__ unsigned wave_incl_scan(unsigned v) {
  v += (unsigned)__builtin_amdgcn_update_dpp(0, (int)v, 0x111, 0xF, 0xF, false);
  v += (unsigned)__builtin_amdgcn_update_dpp(0, (int)v, 0x112, 0xF, 0xF, false);
  v += (unsigned)__builtin_amdgcn_update_dpp(0, (int)v, 0x114, 0xF, 0xF, false);
  v += (unsigned)__builtin_amdgcn_update_dpp(0, (int)v, 0x118, 0xF, 0xF, false);
  v += (unsigned)__builtin_amdgcn_update_dpp(0, (int)v, 0x142, 0xA, 0xF, false);
  v += (unsigned)__builtin_amdgcn_update_dpp(0, (int)v, 0x143, 0xC, 0xF, false);
  return v;
}
__device__ __forceinline__ f16v mfma16(h8 a, h8 b, f16v c) {
  return __builtin_amdgcn_mfma_f32_32x32x16_f16(a, b, c, 0, 0, 0);
}
__device__ __forceinline__ float relu_f(float x) { return __int_as_float(max(__float_as_int(x), 0)); }
__device__ __forceinline__ int crow(int r, int l) { return (r & 3) + 8 * (r >> 2) + 4 * (l >> 5); }

__device__ __forceinline__ int win_col(int nv) {
  if (nv < 3136) return nv;
  if (nv < 7760) return nv + 4;
  if (nv < 7764) return nv - 7760 + 3136;
  return -1;
}
__device__ void transpose_tile(const float* __restrict__ src, int ldn, half_t* __restrict__ dst, int K,
                               int k0, int n0, int mapmode, unsigned char* lds) {
  float* T = (float*)lds;
  const int tid = otid();
  const int nn = tid & 63;
  int col = n0 + nn;
  if (mapmode) col = win_col(col);
#pragma unroll
  for (int i = 0; i < 16; ++i) {
    int kk = (tid >> 6) + 4 * i;
    float v = 0.f;
    if (col >= 0) v = src[(size_t)(k0 + kk) * ldn + col];
    T[kk * 65 + nn] = v;
  }
  __syncthreads();
#pragma unroll
  for (int i = 0; i < 2; ++i) {
    int n2 = (tid >> 3) + 32 * i;
    int kc = tid & 7;
    h8 o;
#pragma unroll
    for (int q = 0; q < 8; ++q) o[q] = (half_t)T[(kc * 8 + q) * 65 + n2];
    *(h8*)(dst + (size_t)(n0 + n2) * K + k0 + kc * 8) = o;
  }
  __syncthreads();
}

__device__ void phase_prologue(const Params& p, unsigned char* lds) {
  const int tid = otid();
  half_t* WinT = (half_t*)(p.ws + OFF_WINT);
  half_t* WbrT = (half_t*)(p.ws + OFF_WBRT);
  half_t* WoutT = (half_t*)(p.ws + OFF_WOUTT);
  float* MOD = (float*)(p.ws + OFF_MOD);
  float* RT = (float*)(p.ws + OFF_RT);
  float* DT = (float*)(p.ws + OFF_DT);
  const int T_WIN = 4 * 124 * 16;
  const int T_WBR = 12 * 16 * 8;
  const int T_WOUT = 4 * 16 * 16;
  const int T_MOD = 192;
  const int T_ROPE = 16384 * 40 / 256;
  const int total = T_WIN + T_WBR + T_WOUT + T_MOD + T_ROPE;
  {
    float* T = (float*)lds;
    const int nn = tid & 63;
    float cur[16], nxt[16];
    int task = blockIdx.x;
    if (task < T_WIN) {
      const int l = task / (124 * 16), r = task % (124 * 16), nt = r / 16, kt = r % 16;
      const int col = win_col(nt * 64 + nn);
      const float* src = p.w_in + (size_t)l * 1024 * NIN;
#pragma unroll
      for (int i = 0; i < 16; ++i) { const int kk = (tid >> 6) + 4 * i; cur[i] = (col >= 0) ? src[(size_t)(kt * 64 + kk) * NIN + col] : 0.f; }
    }
    for (; task < T_WIN; task += gridDim.x) {
      const int tn = (task + (int)gridDim.x < T_WIN) ? task + (int)gridDim.x : task;
      {
        const int l = tn / (124 * 16), r = tn % (124 * 16), nt = r / 16, kt = r % 16;
        const int col = win_col(nt * 64 + nn);
        const float* src = p.w_in + (size_t)l * 1024 * NIN;
#pragma unroll
        for (int i = 0; i < 16; ++i) { const int kk = (tid >> 6) + 4 * i; nxt[i] = (col >= 0) ? src[(size_t)(kt * 64 + kk) * NIN + col] : 0.f; }
      }
      const int l = task / (124 * 16), r = task % (124 * 16), nt = r / 16, kt = r % 16;
      half_t* dst = WinT + (size_t)l * NPAD * WP;
#pragma unroll
      for (int i = 0; i < 16; ++i) T[((tid >> 6) + 4 * i) * 65 + nn] = cur[i];
      __syncthreads();
#pragma unroll
      for (int i = 0; i < 2; ++i) {
        const int n2 = (tid >> 3) + 32 * i, kc = tid & 7;
        h8 o;
#pragma unroll
        for (int q = 0; q < 8; ++q) o[q] = (half_t)T[(kc * 8 + q) * 65 + n2];
        *(h8*)(dst + (size_t)(nt * 64 + n2) * WP + kt * 64 + kc * 8) = o;
      }
      __syncthreads();
#pragma unroll
      for (int i = 0; i < 16; ++i) cur[i] = nxt[i];
    }
  }
  for (int task = blockIdx.x; task < total; task += gridDim.x) {
    int t = task;
    if (t < T_WIN) continue;
    if (t < T_WIN) {
      int l = t / (124 * 16); int r = t % (124 * 16); int nt = r / 16, kt = r % 16;
      transpose_tile(p.w_in + (size_t)l * 1024 * NIN, NIN, WinT + (size_t)l * NPAD * WP, WP, kt * 64, nt * 64, 1, lds);
      continue;
    }
    t -= T_WIN;
    if (t < T_WBR) {
      int lb = t / 128; int r = t % 128; int nt = r / 8, kt = r % 8;
      int l = lb / 3, b = lb % 3;
      const float* src = (b == 0 ? p.w_br_ret : (b == 1 ? p.w_br_dsa : p.w_br_gla)) + (size_t)l * 512 * 1024;
      transpose_tile(src, 1024, WbrT + (size_t)lb * 1024 * WBP, WBP, kt * 64, nt * 64, 0, lds);
      continue;
    }
    t -= T_WBR;
    if (t < T_WOUT) {
      int l = t / 256; int r = t % 256; int nt = r / 16, kt = r % 16;
      transpose_tile(p.w_out + (size_t)l * 1024 * 1024, 1024, WoutT + (size_t)l * 1024 * WP, WP, kt * 64, nt * 64, 0, lds);
      continue;
    }
    t -= T_WOUT;
    if (t < T_MOD) {
      int l = t / 48, jb = t % 48;
      int j = jb * 64 + (tid & 63);
      int ig = tid >> 6;
      float acc = 0.f;
      const float* aw = p.ada_w + (size_t)l * 1024 * 3072;
      for (int i = ig * 256; i < ig * 256 + 256; ++i) {
        float cv = p.c[i];
        float sc = cv / (1.f + expf(-cv));
        acc += sc * aw[(size_t)i * 3072 + j];
      }
      float* red = (float*)lds;
      red[tid] = acc;
      __syncthreads();
      if (tid < 64) {
        float s = red[tid] + red[tid + 64] + red[tid + 128] + red[tid + 192];
        MOD[l * 3072 + j] = s + p.ada_b[l * 3072 + j];
      }
      __syncthreads();
      continue;
    }
    t -= T_MOD;
    {
      int e = t * 256 + tid;
      int tok = e / 40, f = e % 40;
      float pf = (float)p.pos[tok];
      if (f < 32) {
        float fr = powf(10000.0f, -(float)f * 2.0f / 64.0f);
        float ang = pf * fr;
        RT[tok * 64 + f * 2] = cosf(ang);
        RT[tok * 64 + f * 2 + 1] = sinf(ang);
      } else {
        int g = f - 32;
        float fr = powf(500000.0f, -(float)g * 2.0f / 16.0f);
        float ang = pf * fr;
        DT[tok * 16 + g * 2] = cosf(ang);
        DT[tok * 16 + g * 2 + 1] = sinf(ang);
      }
    }
  }
}

__device__ __forceinline__ void write_h_row(const float (&xv)[16], const float* __restrict__ pre,
                                            const float* __restrict__ mod, half_t* __restrict__ hrow, int l) {
  float ss = 0.f;
#pragma unroll
  for (int i = 0; i < 16; ++i) ss += xv[i] * xv[i];
  ss = wave_sum(ss);
  float rs = rsqrtf(ss * (1.0f / 1024.0f) + 1e-6f);
#pragma unroll
  for (int i = 0; i < 4; ++i) {
    int c0 = i * 256 + l * 4;
    f4v pg = *(const f4v*)(pre + c0);
    f4v sh = *(const f4v*)(mod + c0);
    f4v sc = *(const f4v*)(mod + 1024 + c0);
    h4 o;
#pragma unroll
    for (int q = 0; q < 4; ++q) o[q] = (half_t)(xv[i * 4 + q] * rs * pg[q] * (1.f + sc[q]) + sh[q]);
    *(h4*)(hrow + c0) = o;
  }
}

__device__ void phase_h0(const Params& p) {
  const int w = otid() >> 6, l = otid() & 63;
  half_t* H = (half_t*)(p.ws + OFF_H);
  const float* MOD = (const float*)(p.ws + OFF_MOD);
  for (int row = blockIdx.x * 4 + w; row < S_LEN; row += gridDim.x * 4) {
    float xv[16];
#pragma unroll
    for (int i = 0; i < 4; ++i) {
      f4v v = *(const f4v*)(p.x + (size_t)row * 1024 + i * 256 + l * 4);
      xv[i * 4] = v[0]; xv[i * 4 + 1] = v[1]; xv[i * 4 + 2] = v[2]; xv[i * 4 + 3] = v[3];
    }
    write_h_row(xv, p.pre_norm, MOD, H + (size_t)row * HP, l);
  }
}

__device__ __forceinline__ void lds_barrier() {
  asm volatile("s_waitcnt lgkmcnt(0)" ::: "memory");
  __builtin_amdgcn_s_barrier();
  asm volatile("" ::: "memory");
}
#define GEMM_BUF 55296
#define GEMM_EOFF 110592
template <int NT>
__device__ __forceinline__ void gemm_step(f16v (&acc)[4][NT], h8 (&ra)[8], h8 (&rb)[2 * NT],
                                          const unsigned char* As, const unsigned char* Bs, unsigned char* Aw, unsigned char* Bw,
                                          const half_t* __restrict__ A, int lda, const half_t* __restrict__ B, int ldb, int kload,
                                          int wm, int wn, int l, int r0, int kc) {
  h8 af[2][4], bf[2][NT];
#pragma unroll
  for (int i = 0; i < 4; ++i) af[0][i] = *(const h8*)(As + (wm * 128 + i * 32 + (l & 31)) * 144 + (l >> 5) * 16);
#pragma unroll
  for (int j = 0; j < NT; ++j) bf[0][j] = *(const h8*)(Bs + (wn * 32 * NT + j * 32 + (l & 31)) * 144 + (l >> 5) * 16);
#pragma unroll
  for (int ks = 0; ks < 4; ++ks) {
    if (ks < 3) {
#pragma unroll
      for (int i = 0; i < 4; ++i) af[(ks + 1) & 1][i] = *(const h8*)(As + (wm * 128 + i * 32 + (l & 31)) * 144 + (ks + 1) * 32 + (l >> 5) * 16);
#pragma unroll
      for (int j = 0; j < NT; ++j) bf[(ks + 1) & 1][j] = *(const h8*)(Bs + (wn * 32 * NT + j * 32 + (l & 31)) * 144 + (ks + 1) * 32 + (l >> 5) * 16);
    }
    __builtin_amdgcn_sched_barrier(0);
#pragma unroll
    for (int i = 0; i < 4; ++i)
#pragma unroll
      for (int j = 0; j < NT; ++j) acc[i][j] = mfma16(af[ks & 1][i], bf[ks & 1][j], acc[i][j]);
#pragma unroll
    for (int i = 2 * ks; i < 2 * ks + 2; ++i) {
      *(h8*)(Aw + (r0 + 32 * i) * 144 + kc * 16) = ra[i];
      ra[i] = *(const h8*)(A + (size_t)(r0 + 32 * i) * lda + kload + kc * 8);
    }
    if (NT == 2) {
      *(h8*)(Bw + (r0 + 32 * ks) * 144 + kc * 16) = rb[ks];
      rb[ks] = *(const h8*)(B + (size_t)(r0 + 32 * ks) * ldb + kload + kc * 8);
    } else {
#pragma unroll
      for (int i = 2 * ks; i < 2 * ks + 2; ++i) {
        *(h8*)(Bw + (r0 + 32 * i) * 144 + kc * 16) = rb[i];
        rb[i] = *(const h8*)(B + (size_t)(r0 + 32 * i) * ldb + kload + kc * 8);
      }
    }
    __builtin_amdgcn_sched_barrier(0);
  }
}
template <int NT>
__device__ __forceinline__ void gemm_issue(h8 (&ra0)[8], h8 (&rb0)[2 * NT], h8 (&ra1)[8], h8 (&rb1)[2 * NT],
                                           const half_t* __restrict__ A, int lda, const half_t* __restrict__ B, int ldb) {
  const int tid = otid();
  const int kc = tid & 7, r0 = tid >> 3;
#pragma unroll
  for (int i = 0; i < 8; ++i) ra0[i] = *(const h8*)(A + (size_t)(r0 + 32 * i) * lda + kc * 8);
#pragma unroll
  for (int i = 0; i < 2 * NT; ++i) rb0[i] = *(const h8*)(B + (size_t)(r0 + 32 * i) * ldb + kc * 8);
#pragma unroll
  for (int i = 0; i < 8; ++i) ra1[i] = *(const h8*)(A + (size_t)(r0 + 32 * i) * lda + 64 + kc * 8);
#pragma unroll
  for (int i = 0; i < 2 * NT; ++i) rb1[i] = *(const h8*)(B + (size_t)(r0 + 32 * i) * ldb + 64 + kc * 8);
}
template <int NT>
__device__ __forceinline__ void gemm_run(f16v (&acc)[4][NT], h8 (&ra0)[8], h8 (&rb0)[2 * NT], h8 (&ra1)[8], h8 (&rb1)[2 * NT],
                                         const half_t* __restrict__ A, int lda, const half_t* __restrict__ B, int ldb, int K, unsigned char* lds) {
  const int tid = otid(), w = tid >> 6, l = tid & 63;
  constexpr int STAGE = 256 * 144 + 64 * NT * 144;
  unsigned char* A0 = lds;
  unsigned char* B0 = lds + 256 * 144;
  unsigned char* A1 = lds + STAGE;
  unsigned char* B1 = lds + STAGE + 256 * 144;
  const int wm = w >> 1, wn = w & 1;
  const int kc = tid & 7;
  const int r0 = tid >> 3;
  lds_barrier();
#pragma unroll
  for (int i = 0; i < 8; ++i) { *(h8*)(A0 + (r0 + 32 * i) * 144 + kc * 16) = ra0[i]; ra0[i] = *(const h8*)(A + (size_t)(r0 + 32 * i) * lda + 128 + kc * 8); }
#pragma unroll
  for (int i = 0; i < 2 * NT; ++i) { *(h8*)(B0 + (r0 + 32 * i) * 144 + kc * 16) = rb0[i]; rb0[i] = *(const h8*)(B + (size_t)(r0 + 32 * i) * ldb + 128 + kc * 8); }
  lds_barrier();
  const int nk = K / 64;
#pragma unroll 1
  for (int kt = 0; kt < nk; kt += 2) {
    gemm_step<NT>(acc, ra1, rb1, A0, B0, A1, B1, A, lda, B, ldb, (kt + 3 < nk) ? (kt + 3) * 64 : 0, wm, wn, l, r0, kc);
    lds_barrier();
    gemm_step<NT>(acc, ra0, rb0, A1, B1, A0, B0, A, lda, B, ldb, (kt + 4 < nk) ? (kt + 4) * 64 : 0, wm, wn, l, r0, kc);
    lds_barrier();
  }
}
template <int NT>
__device__ __forceinline__ void gemm_kloop(f16v (&acc)[4][NT], const half_t* __restrict__ A, int lda,
                                           const half_t* __restrict__ B, int ldb, int K, unsigned char* lds) {
  h8 ra0[8], rb0[2 * NT], ra1[8], rb1[2 * NT];
  gemm_issue<NT>(ra0, rb0, ra1, rb1, A, lda, B, ldb);
  gemm_run<NT>(acc, ra0, rb0, ra1, rb1, A, lda, B, ldb, K, lds);
}

template <int NT>
__device__ __forceinline__ void gemm_issue1(h8 (&ra)[8], h8 (&rb)[2 * NT], const half_t* __restrict__ A, int lda, const half_t* __restrict__ B, int ldb) {
  const int tid = otid();
  const int kc = tid & 7, r0 = tid >> 3;
#pragma unroll
  for (int i = 0; i < 8; ++i) ra[i] = *(const h8*)(A + (size_t)(r0 + 32 * i) * lda + kc * 8);
#pragma unroll
  for (int i = 0; i < 2 * NT; ++i) rb[i] = *(const h8*)(B + (size_t)(r0 + 32 * i) * ldb + kc * 8);
}
template <int NT>
__device__ __forceinline__ void gemm_run1(f16v (&acc)[4][NT], h8 (&ra)[8], h8 (&rb)[2 * NT],
                                          const half_t* __restrict__ A, int lda, const half_t* __restrict__ B, int ldb, int K, unsigned char* lds) {
  const int tid = otid(), w = tid >> 6, l = tid & 63;
  constexpr int STAGE = 256 * 144 + 64 * NT * 144;
  const int wm = w >> 1, wn = w & 1;
  const int kc = tid & 7;
  const int r0 = tid >> 3;
  lds_barrier();
#pragma unroll
  for (int i = 0; i < 8; ++i) { *(h8*)(lds + (r0 + 32 * i) * 144 + kc * 16) = ra[i]; ra[i] = *(const h8*)(A + (size_t)(r0 + 32 * i) * lda + 64 + kc * 8); }
#pragma unroll
  for (int i = 0; i < 2 * NT; ++i) { *(h8*)(lds + 256 * 144 + (r0 + 32 * i) * 144 + kc * 16) = rb[i]; rb[i] = *(const h8*)(B + (size_t)(r0 + 32 * i) * ldb + 64 + kc * 8); }
  lds_barrier();
  const int nk = K / 64;
#pragma unroll 1
  for (int kt = 0; kt < nk; ++kt) {
    unsigned char* cur = lds + (kt & 1) * STAGE;
    unsigned char* nxt = lds + ((kt + 1) & 1) * STAGE;
    gemm_step<NT>(acc, ra, rb, cur, cur + 256 * 144, nxt, nxt + 256 * 144, A, lda, B, ldb, (kt + 2 < nk) ? (kt + 2) * 64 : 0, wm, wn, l, r0, kc);
    lds_barrier();
  }
}

template <int NT>
__device__ __forceinline__ void zero_acc(f16v (&acc)[4][NT]) {
  float z = 0.f;
  asm volatile("" : "+v"(z));
#pragma unroll
  for (int i = 0; i < 4; ++i)
#pragma unroll
    for (int j = 0; j < NT; ++j)
#pragma unroll
      for (int r = 0; r < 16; ++r) acc[i][j][r] = z;
}

__device__ __forceinline__ void stage_pair(float* E, const f16v& a0, const f16v& a1, int l) {
#pragma unroll
  for (int r = 0; r < 16; ++r) {
    const int rr = crow(r, l);
    E[rr * 65 + (l & 31)] = a0[r];
    E[rr * 65 + 32 + (l & 31)] = a1[r];
  }
}

__device__ __forceinline__ int xcc_census(const unsigned* xcnt, int my_xcc) {
  unsigned sum = 0; bool ok = my_xcc < 8; int mine = 0;
#pragma unroll
  for (int j = 0; j < 16; ++j) {
    const unsigned c = __hip_atomic_load(xcnt + j, __ATOMIC_RELAXED, __HIP_MEMORY_SCOPE_AGENT);
    sum += c;
    if (j < 8 && c == 0u) ok = false;
    if (j >= 8 && c != 0u) ok = false;
    if (j == my_xcc) mine = (int)c;
  }
  if (sum != gridDim.x) ok = false;
  return ok ? mine : 0;
}

__device__ void phase_A(const Params& p, int layer, unsigned char* lds, int my_xcc, int my_loc, const unsigned* xcnt) {
  const int tid = otid(), w = tid >> 6, l = tid & 63;
  const half_t* H = (const half_t*)(p.ws + OFF_H);
  const half_t* Wt = (const half_t*)(p.ws + OFF_WINT) + (size_t)layer * NPAD * WP;
  half_t* P = (half_t*)(p.ws + OFF_P);
  float* GA = (float*)(p.ws + OFF_GA);
  float* IW = (float*)(p.ws + OFF_IW);
  const float* RT = (const float*)(p.ws + OFF_RT);
  const float* DT = (const float*)(p.ws + OFF_DT);
  const int wm = w >> 1, wn = w & 1;
  const int G = gridDim.x;
  const int ntiles = 64 * 31;
  const int nx = xcc_census(xcnt, my_xcc);
  int nmine;
  if (nx > 0) nmine = (my_loc < 248) ? (248 - my_loc + nx - 1) / nx : 0;
  else nmine = ((int)blockIdx.x < ntiles) ? (ntiles - (int)blockIdx.x + G - 1) / G : 0;
  h8 ra0[8], rb0[8];
  int mt = 0, nt = 0;
  if (nmine > 0) {
    if (nx > 0) { const int s0 = my_loc; mt = my_xcc * 8 + (s0 & 7); nt = s0 >> 3; }
    else { const int tix = blockIdx.x; mt = tix & 63; nt = tix >> 6; }
    gemm_issue1<4>(ra0, rb0, H + (size_t)mt * 256 * HP, HP, Wt + (size_t)nt * 256 * WP, WP);
  }
#pragma unroll 1
  for (int rnd = 0; rnd < nmine; ++rnd) {
    f16v acc[4][4];
    zero_acc<4>(acc);
    gemm_run1<4>(acc, ra0, rb0, H + (size_t)mt * 256 * HP, HP, Wt + (size_t)nt * 256 * WP, WP, 1024, lds);
    const int mt_cur = mt, nt_cur = nt;
    if (rnd + 1 < nmine) {
      if (nx > 0) { const int s1 = my_loc + nx * (rnd + 1); mt = my_xcc * 8 + (s1 & 7); nt = s1 >> 3; }
      else { const int tix = (rnd + 1) * G + blockIdx.x; mt = tix & 63; nt = tix >> 6; }
      gemm_issue1<4>(ra0, rb0, H + (size_t)mt * 256 * HP, HP, Wt + (size_t)nt * 256 * WP, WP);
    }
    const int m0w = mt_cur * 256 + wm * 128;
    const int n0w = nt_cur * 256 + wn * 128;
    float* E = (float*)(lds) + w * (32 * 65);
    const int prow = l >> 3, c0 = (l & 7) * 8;
#pragma unroll
    for (int jp = 0; jp < 2; ++jp) {
      const int nb2 = n0w + jp * 64;
      const int n0 = nb2 + c0;
      const bool rope64 = nb2 < 512;
      const bool rope16 = ((nb2 >= C_DSAQ && nb2 < C_DSAV) || (nb2 >= C_IDXQ && nb2 < C_GLAQ)) && (c0 < 16);
      float scale = 1.f;
      if (n0 < 256 || (n0 >= C_DSAQ && n0 < C_DSAK) || (n0 >= C_IDXQ && n0 < C_IDXK) || (n0 >= C_GLAQ && n0 < C_GLAK)) scale = 0.125f;
      int mode = 0;
      if ((n0 >= C_RETG && n0 < C_DSAQ) || (n0 >= C_DSAG && n0 < C_IDXQ) || (n0 >= C_GLAG && n0 < C_GLAA)) mode = 1;
      if (n0 >= C_MRG && n0 < C_END) mode = 2;
#pragma unroll
      for (int i = 0; i < 4; ++i) {
        stage_pair(E, acc[i][2 * jp], acc[i][2 * jp + 1], l);
#pragma unroll 1
        for (int ps = 0; ps < 4; ++ps) {
          const int rl = ps * 8 + prow;
          const int row = m0w + i * 32 + rl;
          float v[8], o[8];
#pragma unroll
          for (int q = 0; q < 8; ++q) { v[q] = E[rl * 65 + c0 + q]; o[q] = v[q]; }
          if (rope64) {
            const int cp = c0 ^ 32;
            const float* tb = RT + (size_t)row * 64 + (c0 & 31) * 2;
#pragma unroll
            for (int q = 0; q < 8; ++q) {
              const float pv = E[rl * 65 + cp + q];
              const float cs = tb[2 * q], sn = tb[2 * q + 1];
              o[q] = (c0 < 32) ? (v[q] * cs - pv * sn) : (v[q] * cs + pv * sn);
            }
          } else if (rope16) {
            const int cp = c0 ^ 8;
            const float* tb = DT + (size_t)row * 16;
#pragma unroll
            for (int q = 0; q < 8; ++q) {
              const float pv = E[rl * 65 + cp + q];
              const float cs = tb[2 * q], sn = tb[2 * q + 1];
              o[q] = (c0 < 8) ? (v[q] * cs - pv * sn) : (v[q] * cs + pv * sn);
            }
          }
          h8 ov;
#pragma unroll
          for (int q = 0; q < 8; ++q) {
            float t = o[q] * scale;
            if (mode == 1) t = t / (1.f + __expf(-t));
            else if (mode == 2) t = 1.f / (1.f + __expf(-t));
            ov[q] = (half_t)t;
          }
          if (n0 < C_END) __builtin_nontemporal_store(ov, (h8*)(P + (size_t)row * PP + n0));
          if (n0 >= C_GLAA && n0 < C_MRG) {
#pragma unroll
            for (int q = 0; q < 8; ++q) GA[(size_t)row * 16 + (n0 - C_GLAA) + q] = v[q];
          }
          if (n0 == C_IDXW) {
#pragma unroll
            for (int q = 0; q < 4; ++q) IW[(size_t)row * 4 + q] = 0.5f * v[q];
          }
        }
      }
    }
  }
}

#define LA_BC 0
#define LA_GAS 16640
#define LA_WL 20736
#define LA_QT 24832
#define LA_KT 34048
#define LA_AT 43264
#define LA_VT 52480
#define LA_SS 70912
#define LA_OS 89344
#define LA_SEG 123136

__device__ void la_bcum(const Params& p, int layer, int n, int Hh, unsigned char* lds) {
  const int tid = otid();
  float* Bc = (float*)(lds + LA_BC);
  const int d = tid & 63, q = tid >> 6;
  if (Hh < 4) {
    float lg = log1pf(-exp2f(-5.0f - (float)Hh));
#pragma unroll
    for (int jj = 0; jj < 16; ++jj) { int j = q * 16 + jj; Bc[j * 65 + d] = (float)(j + 1) * lg; }
    __syncthreads();
    return;
  }
  const int h = Hh - 4;
  float* GAs = (float*)(lds + LA_GAS);
  float* WL = (float*)(lds + LA_WL);
  float* SEG = (float*)(lds + LA_SEG);
  const float* GA = (const float*)(p.ws + OFF_GA);
#pragma unroll
  for (int i = 0; i < 4; ++i) {
    int e = tid + 256 * i;
    GAs[e] = GA[(size_t)n * 64 * 16 + e];
    int r = e >> 6, dd = e & 63;
    WL[e] = p.gla_w_lr[(size_t)layer * 16 * 256 + r * 256 + h * 64 + dd];
  }
  __syncthreads();
  float wl[16];
#pragma unroll
  for (int r = 0; r < 16; ++r) wl[r] = WL[r * 64 + d];
  const float bl = p.gla_b_lr[layer * 256 + h * 64 + d];
  float run = 0.f;
#pragma unroll
  for (int jj = 0; jj < 16; ++jj) {
    int j = q * 16 + jj;
    float z = bl;
#pragma unroll
    for (int r = 0; r < 16; ++r) z += GAs[j * 16 + r] * wl[r];
    float ls = fminf(z, 0.f) - log1pf(expf(-fabsf(z)));
    run += ls * (1.0f / 16.0f);
    Bc[j * 65 + d] = run;
  }
  SEG[q * 64 + d] = run;
  __syncthreads();
  float off = 0.f;
  for (int qq = 0; qq < q; ++qq) off += SEG[qq * 64 + d];
  if (q > 0) {
#pragma unroll
    for (int jj = 0; jj < 16; ++jj) { int j = q * 16 + jj; Bc[j * 65 + d] += off; }
  }
  __syncthreads();
}

__device__ __forceinline__ void la_load_v(const half_t* __restrict__ P, int t0, int vcol, h8 (&vr)[2][2]) {
  const int tid = otid(), w = tid >> 6, l = tid & 63;
  const int jp = l & 31, cgp = l >> 5;
#pragma unroll
  for (int it = 0; it < 2; ++it) {
    int c = it * 8 + w * 2 + cgp;
    vr[it][0] = *(const h8*)(P + (size_t)(t0 + 2 * jp) * PP + vcol + c * 8);
    vr[it][1] = *(const h8*)(P + (size_t)(t0 + 2 * jp + 1) * PP + vcol + c * 8);
  }
}
__device__ __forceinline__ void la_stage_vt(const h8 (&vr)[2][2], unsigned char* lds) {
  const int tid = otid(), w = tid >> 6, l = tid & 63;
  half_t* VT = (half_t*)(lds + LA_VT);
  const int jp = l & 31, cgp = l >> 5;
#pragma unroll
  for (int it = 0; it < 2; ++it) {
    int c = it * 8 + w * 2 + cgp;
#pragma unroll
    for (int q = 0; q < 8; ++q) {
      h2 pr; pr[0] = vr[it][0][q]; pr[1] = vr[it][1][q];
      *(h2*)(VT + (c * 8 + q) * 72 + 2 * jp) = pr;
    }
  }
}
__device__ void la_item_kv(const Params& p, int layer, int item, unsigned char* lds) {
  const int tid = otid(), w = tid >> 6, l = tid & 63;
  const int n = item >> 3, Hh = item & 7;
  const int t0 = n * 64;
  const half_t* P = (const half_t*)(p.ws + OFF_P);
  half_t* ST = (half_t*)(p.ws + OFF_ST);
  float* DEC = (float*)(p.ws + OFF_DEC);
  const int kcol = (Hh < 4) ? (C_RETK + Hh * 64) : (C_GLAK + (Hh - 4) * 64);
  const int vcol = (Hh < 4) ? (C_RETV + Hh * 128) : (C_GLAV + (Hh - 4) * 128);
  h8 vr[2][2];
  la_load_v(P, t0, vcol, vr);
  const h8 k0 = *(const h8*)(P + (size_t)(t0 + 2 * (l & 31)) * PP + kcol + (w * 2 + (l >> 5)) * 8);
  const h8 k1 = *(const h8*)(P + (size_t)(t0 + 2 * (l & 31) + 1) * PP + kcol + (w * 2 + (l >> 5)) * 8);
  __syncthreads();
  la_bcum(p, layer, n, Hh, lds);
  const float* Bc = (const float*)(lds + LA_BC);
  half_t* KhT = (half_t*)(lds + LA_KT);
  half_t* VT = (half_t*)(lds + LA_VT);
  {
    const int jp = l & 31, cgp = l >> 5;
    int c = w * 2 + cgp;
#pragma unroll
    for (int q = 0; q < 8; ++q) {
      int d = c * 8 + q;
      float bl = Bc[63 * 65 + d];
      h2 pr;
      pr[0] = (half_t)((float)k0[q] * __expf(bl - Bc[(2 * jp) * 65 + d]));
      pr[1] = (half_t)((float)k1[q] * __expf(bl - Bc[(2 * jp + 1) * 65 + d]));
      *(h2*)(KhT + d * 72 + 2 * jp) = pr;
    }
  }
  la_stage_vt(vr, lds);
  if (tid < 64) DEC[(size_t)item * 64 + tid] = __expf(Bc[63 * 65 + tid]);
  __syncthreads();
  f16v acc[2];
#pragma unroll
  for (int j = 0; j < 2; ++j)
#pragma unroll
    for (int r = 0; r < 16; ++r) acc[j][r] = ozero();
#pragma unroll
  for (int ks = 0; ks < 4; ++ks) {
    h8 a = *(const h8*)(VT + (32 * w + (l & 31)) * 72 + ks * 16 + (l >> 5) * 8);
#pragma unroll
    for (int j = 0; j < 2; ++j) {
      h8 b = *(const h8*)(KhT + (j * 32 + (l & 31)) * 72 + ks * 16 + (l >> 5) * 8);
      acc[j] = mfma16(a, b, acc[j]);
    }
  }
#pragma unroll
  for (int j = 0; j < 2; ++j)
#pragma unroll
    for (int r = 0; r < 16; ++r) {
      int e = 32 * w + crow(r, l);
      int d = j * 32 + (l & 31);
      ST[(size_t)item * 8192 + e * 64 + d] = (half_t)acc[j][r];
    }
}

__device__ void phase_scan(const Params& p) {
  half_t* ST = (half_t*)(p.ws + OFF_ST);
  const float* DEC = (const float*)(p.ws + OFF_DEC);
  for (int f2 = blockIdx.x * NTHREADS + otid(); f2 < 32768; f2 += gridDim.x * NTHREADS) {
    const int f = f2 * 2;
    const int Hh = f >> 13, d = f & 63;
    float s0 = 0.f, s1 = 0.f;
    for (int n0 = 0; n0 < 256; n0 += 16) {
      h2 kv[16]; float2 dc[16];
#pragma unroll
      for (int u = 0; u < 16; ++u) {
        kv[u] = *(const h2*)(ST + (size_t)(n0 + u) * 65536 + f);
        dc[u] = *(const float2*)(DEC + (size_t)((n0 + u) * 8 + Hh) * 64 + d);
      }
#pragma unroll
      for (int u = 0; u < 16; ++u) {
        h2 o; o[0] = (half_t)s0; o[1] = (half_t)s1;
        *(h2*)(ST + (size_t)(n0 + u) * 65536 + f) = o;
        s0 = dc[u].x * s0 + (float)kv[u][0];
        s1 = dc[u].y * s1 + (float)kv[u][1];
      }
    }
  }
}

__device__ void la_item_out(const Params& p, int layer, int item, unsigned char* lds) {
  const int tid = otid(), w = tid >> 6, l = tid & 63;
  const int n = item >> 3, Hh = item & 7;
  const int t0 = n * 64;
  const half_t* P = (const half_t*)(p.ws + OFF_P);
  const half_t* ST = (const half_t*)(p.ws + OFF_ST);
  half_t* BR = (half_t*)(p.ws + OFF_BR);
  const int qcol = (Hh < 4) ? (C_RETQ + Hh * 64) : (C_GLAQ + (Hh - 4) * 64);
  const int kcol = (Hh < 4) ? (C_RETK + Hh * 64) : (C_GLAK + (Hh - 4) * 64);
  const int vcol = (Hh < 4) ? (C_RETV + Hh * 128) : (C_GLAV + (Hh - 4) * 128);
  const int gcol = (Hh < 4) ? (C_RETG + Hh * 128) : (C_GLAG + (Hh - 4) * 128);
  const int ocol = (Hh < 4) ? (Hh * 128) : (1024 + (Hh - 4) * 128);
  h8 vr[2][2];
  la_load_v(P, t0, vcol, vr);
  h8 qr[2], kr[2], sr[4];
#pragma unroll
  for (int it = 0; it < 2; ++it) {
    const int c = tid + 256 * it;
    qr[it] = *(const h8*)(P + (size_t)(t0 + (c >> 3)) * PP + qcol + (c & 7) * 8);
    kr[it] = *(const h8*)(P + (size_t)(t0 + (c >> 3)) * PP + kcol + (c & 7) * 8);
  }
#pragma unroll
  for (int it = 0; it < 4; ++it) {
    const int c = tid + 256 * it;
    sr[it] = *(const h8*)(ST + (size_t)item * 8192 + (c >> 3) * 64 + (c & 7) * 8);
  }
  __syncthreads();
  la_bcum(p, layer, n, Hh, lds);
  const float* Bc = (const float*)(lds + LA_BC);
  half_t* Qt = (half_t*)(lds + LA_QT);
  half_t* Kt = (half_t*)(lds + LA_KT);
  half_t* AT = (half_t*)(lds + LA_AT);
  half_t* VT = (half_t*)(lds + LA_VT);
  half_t* SS = (half_t*)(lds + LA_SS);
  float* OS = (float*)(lds + LA_OS);
#pragma unroll
  for (int it = 0; it < 2; ++it) {
    int c = tid + 256 * it;
    int row = c >> 3, kc = c & 7;
    const h8 qv = qr[it];
    const h8 kv = kr[it];
    h8 qo, ko;
#pragma unroll
    for (int q = 0; q < 8; ++q) {
      float b = Bc[row * 65 + kc * 8 + q];
      qo[q] = (half_t)((float)qv[q] * __expf(b));
      ko[q] = (half_t)((float)kv[q] * __expf(-b));
    }
    *(h8*)(Qt + row * 72 + kc * 8) = qo;
    *(h8*)(Kt + row * 72 + kc * 8) = ko;
  }
  la_stage_vt(vr, lds);
#pragma unroll
  for (int it = 0; it < 4; ++it) {
    int c = tid + 256 * it;
    int e = c >> 3, kc = c & 7;
    *(h8*)(SS + e * 72 + kc * 8) = sr[it];
  }
  __syncthreads();
  {
    const int mi = w >> 1, nj = w & 1;
    f16v acc;
#pragma unroll
    for (int r = 0; r < 16; ++r) acc[r] = ozero();
#pragma unroll
    for (int ks = 0; ks < 4; ++ks) {
      h8 a = *(const h8*)(Qt + (mi * 32 + (l & 31)) * 72 + ks * 16 + (l >> 5) * 8);
      h8 b = *(const h8*)(Kt + (nj * 32 + (l & 31)) * 72 + ks * 16 + (l >> 5) * 8);
      acc = mfma16(a, b, acc);
    }
#pragma unroll
    for (int r = 0; r < 16; ++r) {
      int i = mi * 32 + crow(r, l);
      int j = nj * 32 + (l & 31);
      float v = (j <= i) ? acc[r] : 0.f;
      AT[i * 72 + j] = (half_t)v;
    }
  }
  __syncthreads();
  {
    const int mi = w >> 1, nh = w & 1;
    f16v acc[2];
#pragma unroll
    for (int j = 0; j < 2; ++j)
#pragma unroll
      for (int r = 0; r < 16; ++r) acc[j][r] = ozero();
#pragma unroll
    for (int ks = 0; ks < 4; ++ks) {
      h8 a1 = *(const h8*)(AT + (mi * 32 + (l & 31)) * 72 + ks * 16 + (l >> 5) * 8);
      h8 a2 = *(const h8*)(Qt + (mi * 32 + (l & 31)) * 72 + ks * 16 + (l >> 5) * 8);
#pragma unroll
      for (int j = 0; j < 2; ++j) {
        h8 b1 = *(const h8*)(VT + (nh * 64 + j * 32 + (l & 31)) * 72 + ks * 16 + (l >> 5) * 8);
        h8 b2 = *(const h8*)(SS + (nh * 64 + j * 32 + (l & 31)) * 72 + ks * 16 + (l >> 5) * 8);
        acc[j] = mfma16(a1, b1, acc[j]);
        acc[j] = mfma16(a2, b2, acc[j]);
      }
    }
#pragma unroll
    for (int j = 0; j < 2; ++j)
#pragma unroll
      for (int r = 0; r < 16; ++r) {
        int i = mi * 32 + crow(r, l);
        int e = nh * 64 + j * 32 + (l & 31);
        OS[i * 132 + e] = acc[j][r];
      }
  }
  __syncthreads();
  {
    const int i = tid >> 2, qd = tid & 3;
    float ov[32];
    float ss = 0.f;
#pragma unroll
    for (int c = 0; c < 8; ++c) {
      f4v v = *(const f4v*)(OS + i * 132 + qd * 32 + c * 4);
      ov[c * 4] = v[0]; ov[c * 4 + 1] = v[1]; ov[c * 4 + 2] = v[2]; ov[c * 4 + 3] = v[3];
      ss += v[0] * v[0] + v[1] * v[1] + v[2] * v[2] + v[3] * v[3];
    }
    ss += dppf<0xB1>(ss);
    ss += dppf<0x4E>(ss);
    float rs = rsqrtf(ss * (1.0f / 128.0f) + 1e-6f);
#pragma unroll
    for (int c = 0; c < 4; ++c) {
      h8 g = *(const h8*)(P + (size_t)(t0 + i) * PP + gcol + qd * 32 + c * 8);
      h8 o;
#pragma unroll
      for (int q = 0; q < 8; ++q) o[q] = (half_t)(ov[c * 8 + q] * rs * (float)g[q]);
      *(h8*)(BR + (size_t)(t0 + i) * 1536 + ocol + qd * 32 + c * 8) = o;
    }
  }
}

#define DS_CAP 640
#define DS_PRUNE_AT 512
#define NPL 10
#define DS_LS 0
#define DS_LI (32 * DS_CAP * 4)
#define DS_CNT (32 * DS_CAP * 6)
#define DS_THR (DS_CNT + 128)
#define DS_WQ (DS_CNT + 256)
#define DS_HIST (DS_CNT + 1024)
#define DS_PW (DS_CNT + 1024 + 4096)

__device__ __forceinline__ unsigned long long wave_or64(unsigned long long v) {
  const unsigned lo = wave_or((unsigned)v), hi = wave_or((unsigned)(v >> 32));
  return ((unsigned long long)hi << 32) | lo;
}
__device__ __forceinline__ void dsa_prune(float* LSm, unsigned short* LIm, int n, unsigned* hist, int* cntm, float* thrm, int l) {
  unsigned long long comp[NPL];
  bool act[NPL], val[NPL];
#pragma unroll
  for (int k = 0; k < NPL; ++k) {
    int e = l + 64 * k;
    val[k] = e < n;
    unsigned u = 0, li = 0;
    if (val[k]) { u = __float_as_uint(LSm[e]); li = LIm[e]; }
    const unsigned key = (u >> 31) ? ~u : (u | 0x80000000u);
    comp[k] = ((unsigned long long)key << 14) | (unsigned long long)(16383u - li);
    act[k] = val[k];
  }
  const unsigned long long c0 = ((unsigned long long)(unsigned)__builtin_amdgcn_readfirstlane((int)(unsigned)(comp[0] >> 32)) << 32) | (unsigned)__builtin_amdgcn_readfirstlane((int)(unsigned)comp[0]);
  unsigned long long x = 0;
#pragma unroll
  for (int k = 0; k < NPL; ++k) x |= val[k] ? (comp[k] ^ c0) : 0ull;
  x = wave_or64(x);
  int shift = (x == 0ull) ? 0 : (63 - __clzll((long long)x)) - 7;
  if (shift < 0) shift = 0;
  unsigned rank = 256;
#pragma unroll 1
  for (int rd = 0; rd < 8; ++rd) {
    *(uint4*)(hist + 4 * l) = make_uint4(0, 0, 0, 0);
    __threadfence_block();
    unsigned dk[NPL];
#pragma unroll
    for (int k = 0; k < NPL; ++k) {
      dk[k] = (unsigned)(comp[k] >> shift) & 255u;
      if (act[k]) atomicAdd(&hist[dk[k]], 1u);
    }
    __threadfence_block();
    uint4 hv; hv.x = hist[4 * l]; hv.y = hist[4 * l + 1]; hv.z = hist[4 * l + 2]; hv.w = hist[4 * l + 3];
    unsigned tl = hv.x + hv.y + hv.z + hv.w;
    const unsigned pin = wave_incl_scan(tl);
    const unsigned tot = (unsigned)__builtin_amdgcn_readlane((int)pin, 63);
    unsigned sx = tot - pin;
    bool mine = (sx < rank) && (rank <= sx + tl);
    unsigned dsel = 0, nr = 0, hsel = 0;
    if (mine) {
      unsigned c = sx;
      if (c + hv.w >= rank) { dsel = 4 * l + 3; nr = rank - c; hsel = hv.w; }
      else {
        c += hv.w;
        if (c + hv.z >= rank) { dsel = 4 * l + 2; nr = rank - c; hsel = hv.z; }
        else {
          c += hv.z;
          if (c + hv.y >= rank) { dsel = 4 * l + 1; nr = rank - c; hsel = hv.y; }
          else { c += hv.y; dsel = 4 * l; nr = rank - c; hsel = hv.x; }
        }
      }
    }
    unsigned long long mk = __ballot(mine);
    int src = (mk == 0ull) ? 0 : (__ffsll((long long)mk) - 1);
    dsel = (unsigned)__builtin_amdgcn_readlane((int)dsel, src);
    rank = (unsigned)__builtin_amdgcn_readlane((int)nr, src);
    hsel = (unsigned)__builtin_amdgcn_readlane((int)hsel, src);
#pragma unroll
    for (int k = 0; k < NPL; ++k) act[k] = act[k] && (dk[k] == dsel);
    if (hsel <= 1u || shift == 0) break;
    shift = (shift >= 8) ? (shift - 8) : 0;
  }
  unsigned long long tsel = 0;
#pragma unroll
  for (int k = 0; k < NPL; ++k) tsel |= act[k] ? comp[k] : 0ull;
  const unsigned long long T = wave_or64(tsel);
  bool keep[NPL];
  unsigned cntk = 0;
#pragma unroll
  for (int k = 0; k < NPL; ++k) {
    keep[k] = val[k] && (comp[k] >= T);
    cntk += keep[k] ? 1u : 0u;
  }
  unsigned pos = wave_incl_scan(cntk) - cntk;
  __threadfence_block();
#pragma unroll
  for (int k = 0; k < NPL; ++k) {
    if (keep[k]) {
      const unsigned kk = (unsigned)(comp[k] >> 14);
      const unsigned u = (kk & 0x80000000u) ? (kk & 0x7FFFFFFFu) : ~kk;
      LSm[pos] = __uint_as_float(u);
      LIm[pos] = (unsigned short)(16383u - ((unsigned)comp[k] & 16383u));
      ++pos;
    }
  }
  if (l == 0) {
    const unsigned T32 = (unsigned)(T >> 14);
    *cntm = 256;
    *thrm = __uint_as_float((T32 & 0x80000000u) ? (T32 & 0x7FFFFFFFu) : ~T32);
  }
  __threadfence_block();
}

__device__ void dsa_item(const Params& p, int qb, unsigned char* lds) {
  const int tid = otid(), w = tid >> 6, l = tid & 63;
  const int t0 = qb * 32;
  const half_t* P = (const half_t*)(p.ws + OFF_P);
  const float* IW = (const float*)(p.ws + OFF_IW);
  half_t* BR = (half_t*)(p.ws + OFF_BR);
  float* LS = (float*)(lds + DS_LS);
  unsigned short* LI = (unsigned short*)(lds + DS_LI);
  int* cnt = (int*)(lds + DS_CNT);
  float* thr = (float*)(lds + DS_THR);
  float* wq = (float*)(lds + DS_WQ);
  unsigned* hist = (unsigned*)(lds + DS_HIST) + w * 256;
  float* PW = (float*)(lds + DS_PW) + w * 1024;
  half_t* QS = (half_t*)(lds + DS_PW + 16384) + w * 512;
  for (int rep_sel = 0; rep_sel < REP_SEL; ++rep_sel) {
  __syncthreads();
  if (tid < 32) { cnt[tid] = 0; thr[tid] = -INFINITY; }
  if (tid < 128) wq[tid] = IW[(size_t)t0 * 4 + tid];
  __syncthreads();
  h8 aq[4][4];
#pragma unroll
  for (int h = 0; h < 4; ++h)
#pragma unroll
    for (int ks = 0; ks < 4; ++ks)
      aq[h][ks] = *(const h8*)(P + (size_t)(t0 + (l & 31)) * PP + C_IDXQ + h * 64 + ks * 16 + (l >> 5) * 8);
  const int nt = qb + 1;
  const int nr = (nt + 3) >> 2;
  f4v wqv[16];
#pragma unroll
  for (int r = 0; r < 16; ++r) wqv[r] = *(const f4v*)(wq + crow(r, l) * 4);
  float thv[16];
  { float ninf = -INFINITY; asm volatile("" : "+v"(ninf));
#pragma unroll
  for (int r = 0; r < 16; ++r) thv[r] = ninf; }
  h8 bk[4];
  {
    const int k0 = (w < nt) ? w : 0;
#pragma unroll
    for (int ks = 0; ks < 4; ++ks)
      bk[ks] = *(const h8*)(P + (size_t)(k0 * 32 + (l & 31)) * PP + C_IDXK + ks * 16 + (l >> 5) * 8);
  }
#pragma unroll 1
  for (int rd = 0; rd < nr; ++rd) {
    const int kt = 4 * rd + w;
    h8 bkn[4];
    {
      const int kn = (kt + 4 < nt) ? (kt + 4) : 0;
#pragma unroll
      for (int ks = 0; ks < 4; ++ks)
        bkn[ks] = *(const h8*)(P + (size_t)(kn * 32 + (l & 31)) * PP + C_IDXK + ks * 16 + (l >> 5) * 8);
    }
    if (kt < nt) {
      const int sbase = kt * 32;
      f16v acc[4];
#pragma unroll
      for (int h = 0; h < 4; ++h) {
#pragma unroll
        for (int r = 0; r < 16; ++r) acc[h][r] = ozero();
#pragma unroll
        for (int ks = 0; ks < 4; ++ks) acc[h] = mfma16(aq[h][ks], bk[ks], acc[h]);
      }
      const int s = sbase + (l & 31);
      float scv[16];
      unsigned pm = 0;
#pragma unroll
      for (int r = 0; r < 16; ++r) {
        const int m = crow(r, l);
        const f4v wv = wqv[r];
        float sc = wv[0] * relu_f(acc[0][r]) + wv[1] * relu_f(acc[1][r]) + wv[2] * relu_f(acc[2][r]) + wv[3] * relu_f(acc[3][r]);
        sc += 0.0f;
        scv[r] = sc;
      }
      if (kt == qb) {
#pragma unroll
        for (int r = 0; r < 16; ++r) if (s > t0 + crow(r, l)) scv[r] = -INFINITY;
      }
#pragma unroll
      for (int r = 0; r < 16; ++r) pm |= (scv[r] > thv[r]) ? (1u << r) : 0u;
      if (__ballot(pm != 0u) != 0ull) {
        unsigned long long mks[16];
        int mycnt = 0;
#pragma unroll
        for (int r = 0; r < 16; ++r) {
          const unsigned long long mk = __ballot(((pm >> r) & 1u) != 0u);
          mks[r] = mk;
          const unsigned hm = (l < 32) ? (unsigned)mk : (unsigned)(mk >> 32);
          if ((l & 31) == r) mycnt = __popc(hm);
        }
        int base = 0;
        if ((l & 31) < 16 && mycnt > 0) base = atomicAdd(&cnt[crow(l & 31, l)], mycnt);
#pragma unroll
        for (int r = 0; r < 16; ++r) {
          const unsigned long long mk = mks[r];
          if (mk != 0ull) {
            const unsigned hm = (l < 32) ? (unsigned)mk : (unsigned)(mk >> 32);
            const int b_lo = __builtin_amdgcn_readlane(base, r), b_hi = __builtin_amdgcn_readlane(base, 32 + r);
            const int bb = (l < 32) ? b_lo : b_hi;
            if ((pm >> r) & 1u) {
              const int m = crow(r, l);
              const int slot = bb + __popc(hm & ((1u << (l & 31)) - 1u));
              LS[m * DS_CAP + slot] = scv[r];
              LI[m * DS_CAP + slot] = (unsigned short)s;
            }
          }
        }
      }
    }
    __syncthreads();
    bool any_prune;
    {
      const int cv = (l < 32) ? cnt[l] : 0;
      unsigned pmask = (unsigned)__ballot(cv > DS_PRUNE_AT);
      any_prune = pmask != 0u;
      int j = 0;
      while (pmask != 0u) {
        const int m = __ffs((int)pmask) - 1;
        pmask &= pmask - 1u;
        if ((j & 3) == w) dsa_prune(LS + m * DS_CAP, LI + m * DS_CAP, cnt[m], hist, cnt + m, thr + m, l);
        ++j;
      }
    }
    __syncthreads();
    if (any_prune) {
#pragma unroll
      for (int r = 0; r < 16; ++r) thv[r] = thr[crow(r, l)];
    }
#pragma unroll
    for (int ks = 0; ks < 4; ++ks) bk[ks] = bkn[ks];
  }
  }
#pragma unroll 1
  for (int mm = 0; mm < 8; ++mm) {
    const int m = w * 8 + mm;
    const int c = cnt[m];
    if (c > 256) dsa_prune(LS + m * DS_CAP, LI + m * DS_CAP, c, hist, cnt + m, thr + m, l);
  }
  asm volatile("s_waitcnt lgkmcnt(0)" ::: "memory");
  for (int rep_att = 0; rep_att < REP_ATT; ++rep_att) {
  h8 kvr[4][8];
  {
    const int m = w * 8;
    const int c = min(cnt[m], 256);
    const unsigned short* LIm = LI + m * DS_CAP;
#pragma unroll
    for (int kk = 0; kk < 4; ++kk) {
      const int e = l + 64 * kk;
      const int s = (e < c) ? (int)LIm[e] : 0;
      const half_t* kr = P + (size_t)s * PP + C_DSAK;
#pragma unroll
      for (int ch = 0; ch < 8; ++ch) kvr[kk][ch] = *(const h8*)(kr + ch * 8);
    }
  }
  h8 qreg = *(const h8*)(P + (size_t)(t0 + w * 8) * PP + C_DSAQ + l * 8);
  const int dch = l & 7, ksub = l >> 3;
#pragma unroll 1
  for (int u = 0; u < 16; ++u) {
    const int mm = u >> 1, g = u & 1;
    const int m = w * 8 + mm;
    const int t = t0 + m;
    const int c = min(cnt[m], 256);
    const unsigned short* LIm = LI + m * DS_CAP;
    if (g == 0) {
      *(h8*)(QS + l * 8) = qreg;
      const int mq = (mm < 7) ? (m + 1) : m;
      qreg = *(const h8*)(P + (size_t)(t0 + mq) * PP + C_DSAQ + l * 8);
    }
    h8 gt[4];
#pragma unroll
    for (int hh = 0; hh < 4; ++hh) gt[hh] = *(const h8*)(P + (size_t)t * PP + C_DSAG + (g * 4 + hh) * 64 + dch * 8);
    h8 vv[16];
#pragma unroll
    for (int i = 0; i < 16; ++i) {
      const int e = i * 8 + ksub;
      const int s = (e < c) ? (int)LIm[e] : 0;
      vv[i] = *(const h8*)(P + (size_t)s * PP + C_DSAV + g * 64 + dch * 8);
    }
    asm volatile("s_waitcnt lgkmcnt(0)" ::: "memory");
    float lg[4][4];
#pragma unroll
    for (int hh = 0; hh < 4; ++hh) {
#pragma unroll
      for (int kk = 0; kk < 4; ++kk) lg[hh][kk] = ozero();
#pragma unroll
      for (int ch = 0; ch < 8; ++ch) {
        const h8 qq = *(const h8*)(QS + (g * 4 + hh) * 64 + ch * 8);
#pragma unroll
        for (int kk = 0; kk < 4; ++kk) {
          float a = lg[hh][kk];
          a = __builtin_amdgcn_fdot2(__builtin_shufflevector(qq, qq, 0, 1), __builtin_shufflevector(kvr[kk][ch], kvr[kk][ch], 0, 1), a, false);
          a = __builtin_amdgcn_fdot2(__builtin_shufflevector(qq, qq, 2, 3), __builtin_shufflevector(kvr[kk][ch], kvr[kk][ch], 2, 3), a, false);
          a = __builtin_amdgcn_fdot2(__builtin_shufflevector(qq, qq, 4, 5), __builtin_shufflevector(kvr[kk][ch], kvr[kk][ch], 4, 5), a, false);
          a = __builtin_amdgcn_fdot2(__builtin_shufflevector(qq, qq, 6, 7), __builtin_shufflevector(kvr[kk][ch], kvr[kk][ch], 6, 7), a, false);
          lg[hh][kk] = a;
        }
      }
#pragma unroll
      for (int kk = 0; kk < 4; ++kk) lg[hh][kk] = (l + 64 * kk < c) ? lg[hh][kk] : -INFINITY;
    }
    {
      const int un = (u < 15) ? (u + 1) : 15;
      const int mn = w * 8 + (un >> 1), gn = un & 1;
      const int cn = min(cnt[mn], 256);
      const unsigned short* LIn = LI + mn * DS_CAP;
#pragma unroll
      for (int kk = 0; kk < 4; ++kk) {
        const int e = l + 64 * kk;
        const int s = (e < cn) ? (int)LIn[e] : 0;
        const half_t* kr = P + (size_t)s * PP + C_DSAK + gn * 64;
#pragma unroll
        for (int ch = 0; ch < 8; ++ch) kvr[kk][ch] = *(const h8*)(kr + ch * 8);
      }
    }
#pragma unroll
    for (int hh = 0; hh < 4; ++hh) {
      float mx = fmaxf(fmaxf(lg[hh][0], lg[hh][1]), fmaxf(lg[hh][2], lg[hh][3]));
      mx = wave_max(mx);
      float ev[4]; float sm = 0.f;
#pragma unroll
      for (int kk = 0; kk < 4; ++kk) { ev[kk] = __expf(lg[hh][kk] - mx); sm += ev[kk]; }
      sm = wave_sum(sm);
      const float inv = 1.0f / sm;
#pragma unroll
      for (int kk = 0; kk < 4; ++kk) PW[(l + 64 * kk) * 4 + hh] = ev[kk] * inv;
    }
    asm volatile("s_waitcnt lgkmcnt(0)" ::: "memory");
    float o[4][8];
#pragma unroll
    for (int hh = 0; hh < 4; ++hh)
#pragma unroll
      for (int q = 0; q < 8; ++q) o[hh][q] = ozero();
    const int nit = (c + 7) >> 3;
#pragma unroll 1
    for (int it0 = 0; it0 < nit; it0 += 16) {
      if (it0 > 0) {
#pragma unroll
        for (int i = 0; i < 16; ++i) {
          const int e = (it0 + i) * 8 + ksub;
          const int s = (e < c) ? (int)LIm[e] : 0;
          vv[i] = *(const h8*)(P + (size_t)s * PP + C_DSAV + g * 64 + dch * 8);
        }
      }
#pragma unroll
      for (int i = 0; i < 16; ++i) {
        const int e = (it0 + i) * 8 + ksub;
        const f4v pv = *(const f4v*)(PW + e * 4);
#pragma unroll
        for (int hh = 0; hh < 4; ++hh)
#pragma unroll
          for (int q = 0; q < 8; ++q) o[hh][q] += pv[hh] * (float)vv[i][q];
      }
    }
#pragma unroll
    for (int hh = 0; hh < 4; ++hh)
#pragma unroll
      for (int q = 0; q < 8; ++q) {
        float v = o[hh][q];
        v += dppf<0x128>(v); v += xor16f(v); v += xor32f(v);
        o[hh][q] = v;
      }
    if (l < 8) {
#pragma unroll
      for (int hh = 0; hh < 4; ++hh) {
        const int col = (g * 4 + hh) * 64 + dch * 8;
        h8 ov;
#pragma unroll
        for (int q = 0; q < 8; ++q) ov[q] = (half_t)(o[hh][q] * (float)gt[hh][q]);
        *(h8*)(BR + (size_t)t * 1536 + 512 + col) = ov;
      }
    }
    asm volatile("s_waitcnt lgkmcnt(0)" ::: "memory");
  }
  }
}

__device__ void phase_B(const Params& p, int layer, unsigned char* lds) {
  const int G = gridDim.x;
  for (int j = 0; j * G < 512; ++j) {
    const int b = (j & 1) ? (G - 1 - (int)blockIdx.x) : (int)blockIdx.x;
    const int idx = j * G + b;
#ifndef NO_DSA
    if (idx < 512) dsa_item(p, 511 - idx, lds);
#endif
  }
  for (int rep = 0; rep < REP_KV; ++rep)
  for (int it = blockIdx.x; it < 2048; it += G) la_item_kv(p, layer, it, lds);
}

__device__ void phase_E1(const Params& p, int layer, unsigned char* lds, int my_xcc, int my_loc, const unsigned* xcnt) {
  const int tid = otid(), w = tid >> 6, l = tid & 63;
  const half_t* BR = (const half_t*)(p.ws + OFF_BR);
  const half_t* WbrT = (const half_t*)(p.ws + OFF_WBRT) + (size_t)layer * 3 * 1024 * WBP;
  const half_t* P = (const half_t*)(p.ws + OFF_P);
  half_t* Y1 = (half_t*)(p.ws + OFF_H);
  const int wm = w >> 1, wn = w & 1;
  float* E = (float*)(lds + GEMM_EOFF) + w * (32 * 65);
  const int prow = l >> 3, c0 = (l & 7) * 8;
  const int nx = xcc_census(xcnt, my_xcc);
  const int nrounds = (nx > 0) ? (64 + nx - 1) / nx : (512 + (int)gridDim.x - 1) / (int)gridDim.x;
  for (int rnd = 0; rnd < nrounds; ++rnd) {
    int mt, nt;
    if (nx > 0) {
      const int s = my_loc + nx * rnd;
      if (s >= 64) continue;
      mt = my_xcc * 8 + (s & 7); nt = s >> 3;
    } else {
      const int tix = rnd * (int)gridDim.x + (int)blockIdx.x;
      if (tix >= 512) continue;
      mt = tix & 63; nt = tix >> 6;
    }
    h8 tot[4][4];
#pragma unroll
    for (int i = 0; i < 4; ++i)
#pragma unroll
      for (int ps = 0; ps < 4; ++ps)
#pragma unroll
        for (int q = 0; q < 8; ++q) tot[i][ps][q] = (half_t)ozero();
    const int m0w = mt * 256 + wm * 128;
    const int n0 = nt * 128 + wn * 64 + c0;
#pragma unroll 1
    for (int b = 0; b < 3; ++b) {
      f16v acc[4][2];
      zero_acc<2>(acc);
      gemm_kloop<2>(acc, BR + (size_t)mt * 256 * 1536 + b * 512, 1536, WbrT + (size_t)b * 1024 * WBP + (size_t)nt * 128 * WBP, WBP, 512, lds);
#pragma unroll
      for (int i = 0; i < 4; ++i) {
        stage_pair(E, acc[i][0], acc[i][1], l);
#pragma unroll
        for (int ps = 0; ps < 4; ++ps) {
          const int rl = ps * 8 + prow;
          const int row = m0w + i * 32 + rl;
          const h8 g = *(const h8*)(P + (size_t)row * PP + C_MRG + b * 1024 + n0);
#pragma unroll
          for (int q = 0; q < 8; ++q) tot[i][ps][q] = (half_t)((float)tot[i][ps][q] + (float)g[q] * E[rl * 65 + c0 + q]);
        }
      }
    }
#pragma unroll
    for (int i = 0; i < 4; ++i)
#pragma unroll
      for (int ps = 0; ps < 4; ++ps) {
        const int row = m0w + i * 32 + ps * 8 + prow;
        *(h8*)(Y1 + (size_t)row * HP + n0) = tot[i][ps];
      }
  }
}

__device__ void phase_E2(const Params& p, int layer, unsigned char* lds, int my_xcc, int my_loc, const unsigned* xcnt) {
  const int tid = otid(), w = tid >> 6, l = tid & 63;
  const half_t* Y1 = (const half_t*)(p.ws + OFF_H);
  const half_t* Wo = (const half_t*)(p.ws + OFF_WOUTT) + (size_t)layer * 1024 * WP;
  float* Y = (float*)(p.ws + OFF_ST);
  const int wm = w >> 1, wn = w & 1;
  const int nx = xcc_census(xcnt, my_xcc);
  const int nrounds = (nx > 0) ? (64 + nx - 1) / nx : (512 + (int)gridDim.x - 1) / (int)gridDim.x;
  for (int rnd = 0; rnd < nrounds; ++rnd) {
    int mt, nt;
    if (nx > 0) {
      const int s = my_loc + nx * rnd;
      if (s >= 64) continue;
      mt = my_xcc * 8 + (s & 7); nt = s >> 3;
    } else {
      const int tix = rnd * (int)gridDim.x + (int)blockIdx.x;
      if (tix >= 512) continue;
      mt = tix & 63; nt = tix >> 6;
    }
    f16v acc[4][2];
    zero_acc<2>(acc);
    gemm_kloop<2>(acc, Y1 + (size_t)mt * 256 * HP, HP, Wo + (size_t)nt * 128 * WP, WP, 1024, lds);
    const int m0w = mt * 256 + wm * 128;
    const int n0w = nt * 128 + wn * 64;
#pragma unroll
    for (int i = 0; i < 4; ++i)
#pragma unroll
      for (int j = 0; j < 2; ++j)
#pragma unroll
        for (int r = 0; r < 16; ++r) {
          const int row = m0w + i * 32 + crow(r, l);
          const int n = n0w + j * 32 + (l & 31);
          Y[(size_t)row * 1024 + n] = acc[i][j][r];
        }
  }
}

__device__ void phase_E3(const Params& p, int layer) {
  const int w = otid() >> 6, l = otid() & 63;
  const float* Y = (const float*)(p.ws + OFF_ST);
  const float* MOD = (const float*)(p.ws + OFF_MOD);
  half_t* H = (half_t*)(p.ws + OFF_H);
  const float* xin = (layer == 0) ? p.x : p.out;
  const float* gate = MOD + layer * 3072 + 2048;
  const float* post = p.post_norm + layer * 1024;
  const int stride = gridDim.x * 4;
  int row = blockIdx.x * 4 + w;
  f4v yn[4], xn[4];
  if (row < S_LEN) {
#pragma unroll
    for (int i = 0; i < 4; ++i) {
      yn[i] = *(const f4v*)(Y + (size_t)row * 1024 + i * 256 + l * 4);
      xn[i] = *(const f4v*)(xin + (size_t)row * 1024 + i * 256 + l * 4);
    }
  }
  for (; row < S_LEN; row += stride) {
    float yv[16], xv[16];
    float ss = 0.f;
#pragma unroll
    for (int i = 0; i < 4; ++i)
#pragma unroll
      for (int q = 0; q < 4; ++q) { yv[i * 4 + q] = yn[i][q]; xv[i * 4 + q] = xn[i][q]; ss += yn[i][q] * yn[i][q]; }
    const int nrow = (row + stride < S_LEN) ? (row + stride) : row;
#pragma unroll
    for (int i = 0; i < 4; ++i) {
      yn[i] = *(const f4v*)(Y + (size_t)nrow * 1024 + i * 256 + l * 4);
      xn[i] = *(const f4v*)(xin + (size_t)nrow * 1024 + i * 256 + l * 4);
    }
    ss = wave_sum(ss);
    const float rs = rsqrtf(ss * (1.0f / 1024.0f) + 1e-6f);
#pragma unroll
    for (int i = 0; i < 4; ++i) {
      const int c0 = i * 256 + l * 4;
      f4v gt = *(const f4v*)(gate + c0);
      f4v pn = *(const f4v*)(post + c0);
      f4v o;
#pragma unroll
      for (int q = 0; q < 4; ++q) { o[q] = xv[i * 4 + q] + gt[q] * (yv[i * 4 + q] * rs * pn[q]); xv[i * 4 + q] = o[q]; }
      *(f4v*)(p.out + (size_t)row * 1024 + c0) = o;
    }
    if (layer + 1 < DEPTH)
      write_h_row(xv, p.pre_norm + (layer + 1) * 1024, MOD + (layer + 1) * 3072, H + (size_t)row * HP, l);
  }
}

#define XB_TMO      128
#define XB_XCNT(j)  (256  + 64 * (j))
#define XB_XSUB(j)  (1280 + 64 * (j))
#define XB_XGEN(j)  (2304 + 64 * (j))
#define XB_TOP      3328
#define XB_TOPGEN   3392
#define XCD_BAR_WORDS 3456
#define XB_SPIN_CAP (1u << 18)
#define LAS __attribute__((address_space(3)))

__device__ __forceinline__ unsigned xb_ld(unsigned* p)              { return __hip_atomic_load(p, __ATOMIC_RELAXED, __HIP_MEMORY_SCOPE_AGENT); }
__device__ __forceinline__ unsigned xb_add(unsigned* p, unsigned v) { return __hip_atomic_fetch_add(p, v, __ATOMIC_RELAXED, __HIP_MEMORY_SCOPE_AGENT); }
__device__ __forceinline__ unsigned xb_xcc_id() { return (unsigned)__builtin_amdgcn_s_getreg((3 << 11) | 20) & 0xFu; }
#define XB_SPIN(cond, bar) do { unsigned _sp = 0; while (cond) { __builtin_amdgcn_s_sleep(1); \
    if ((++_sp & 255u) == 0u) { if (xb_ld(&(bar)[XB_TMO])) break; if (_sp > XB_SPIN_CAP) { atomicAdd(&(bar)[XB_TMO], 1u); break; } } } } while (0)

struct XcdBarrier {
    unsigned* bar; unsigned x;
    volatile LAS unsigned* st;
};

__device__ __forceinline__ XcdBarrier xcd_barrier_post(unsigned* bar, volatile LAS unsigned* st) {
    XcdBarrier b; b.bar = bar; b.x = xb_xcc_id(); b.st = st;
    if (otid() == 0) (void)xb_add(&bar[XB_XCNT(b.x)], 1u);
    return b;
}
__device__ __forceinline__ void xcd_barrier_complete(unsigned* bar, unsigned x, unsigned& nloc, unsigned& nx) {
    const unsigned G = gridDim.x * gridDim.y * gridDim.z;
    unsigned sum, cnt, mine, sp = 0u;
    for (;;) {
        sum = 0u; cnt = 0u; mine = 0u;
#pragma unroll
        for (unsigned j = 0; j < 16; ++j) { const unsigned c = xb_ld(&bar[XB_XCNT(j)]); sum += c; cnt += (c > 0u) ? 1u : 0u; mine = (j == x) ? c : mine; }
        if (sum == G) break;
        __builtin_amdgcn_s_sleep(1);
        if ((++sp & 255u) == 0u) { if (xb_ld(&bar[XB_TMO])) break; if (sp > XB_SPIN_CAP) { atomicAdd(&bar[XB_TMO], 1u); break; } }
    }
    nloc = mine > 0u ? mine : 1u; nx = cnt > 0u ? cnt : 1u;
}

__device__ __forceinline__ void xcd_barrier(const XcdBarrier& b) {
    asm volatile("s_waitcnt vmcnt(0)" ::: "memory");
    __syncthreads();
    if (otid() == 0) {
        unsigned* bar = b.bar;
        __builtin_amdgcn_s_waitcnt(0);
        unsigned nloc = b.st[0], nx = b.st[1];
        if (nloc == 0u) { xcd_barrier_complete(bar, b.x, nloc, nx); b.st[0] = nloc; b.st[1] = nx; }
        const unsigned old = xb_add(&bar[XB_XSUB(b.x)], 1u);
        const unsigned gen = old / nloc;
        if (old + 1u == (gen + 1u) * nloc) {
            __builtin_amdgcn_fence(__ATOMIC_RELEASE, "agent");
            asm volatile("s_waitcnt vmcnt(0)" ::: "memory");
            const unsigned og = xb_add(&bar[XB_TOP], 1u);
            const unsigned tg = og / nx;
            if (og + 1u == (tg + 1u) * nx) xb_add(&bar[XB_TOPGEN], 1u);
            else XB_SPIN(xb_ld(&bar[XB_TOPGEN]) == tg, bar);
            __builtin_amdgcn_fence(__ATOMIC_ACQUIRE, "agent");
            xb_add(&bar[XB_XGEN(b.x)], 1u);
            asm volatile("s_waitcnt vmcnt(0)" ::: "memory");
        } else {
            XB_SPIN(xb_ld(&bar[XB_XGEN(b.x)]) == gen, bar);
            __builtin_amdgcn_fence(__ATOMIC_ACQUIRE, "agent");
            asm volatile("s_waitcnt vmcnt(0)" ::: "memory");
        }
    }
    __syncthreads();
}


};

#ifndef REP_D
#define REP_D 1
#endif
#ifndef REP_E
#define REP_E 1
#endif
#ifndef REP_A
#define REP_A 1
#endif
#ifndef REP_B
#define REP_B 1
#endif
#ifdef ONLY_PHASE
#define PH_EN(x) (ONLY_PHASE == (x))
#else
#define PH_EN(x) true
#endif
__global__ void __launch_bounds__(NTHREADS) fwd_megakernel(Params p) {
  extern __shared__ __attribute__((aligned(16))) unsigned char lds[];
  cg::grid_group grid = cg::this_grid();
  K k; k.wbase = __builtin_amdgcn_readfirstlane((int)__builtin_amdgcn_workitem_id_x()) & ~63;
  unsigned* bar = (unsigned*)(p.ws + WS_END);
  unsigned* xcnt = bar + 16;
  unsigned* xbar = (unsigned*)(p.ws + WS_END + 1024);
  if (blockIdx.x == 0) {
    if (k.otid() < 17) __hip_atomic_store(bar + (k.otid() == 16 ? 0 : 16 + k.otid()), 0u, __ATOMIC_RELAXED, __HIP_MEMORY_SCOPE_AGENT);
    for (int i = k.otid(); i < XCD_BAR_WORDS; i += NTHREADS) __hip_atomic_store(xbar + i, 0u, __ATOMIC_RELAXED, __HIP_MEMORY_SCOPE_AGENT);
  }
  volatile LAS unsigned* xst = (volatile LAS unsigned*)(lds + LDS_BYTES - 16);
  if (k.otid() == 0) { xst[0] = 0u; xst[1] = 0u; }
  __syncthreads();
  K::XcdBarrier xb; xb.bar = xbar; xb.x = 0; xb.st = xst;
  int my_xcc = 0, my_loc = 0;
  for (int ph = p.ph_lo; ph < p.ph_hi; ++ph) {
    if (ph == 0) { if (PH_EN(0)) for (int rep = 0; rep < REP_P; ++rep) { k.phase_prologue(p, lds); __syncthreads(); } }
    else if (ph == 1) {
      xb = k.xcd_barrier_post(xbar, xst);
      int* sh = (int*)lds;
      if (k.otid() == 0) {
        const int xc = (int)(__builtin_amdgcn_s_getreg((3 << 11) | 20) & 0xFu);
        sh[0] = xc;
        sh[1] = (int)__hip_atomic_fetch_add(xcnt + xc, 1u, __ATOMIC_RELAXED, __HIP_MEMORY_SCOPE_AGENT);
      }
      __syncthreads();
      my_xcc = __builtin_amdgcn_readfirstlane(sh[0]);
      my_loc = __builtin_amdgcn_readfirstlane(sh[1]);
      __syncthreads();
      if (PH_EN(1)) k.phase_h0(p);
    }
    else {
      const int layer = (ph - 2) / 7, sub = (ph - 2) % 7;
      if (sub == 0) { if (PH_EN(2)) for (int rep = 0; rep < REP_A; ++rep) { k.phase_A(p, layer, lds, my_xcc, my_loc, xcnt); __syncthreads(); } }
      else if (sub == 1) { if (PH_EN(3)) for (int rep = 0; rep < REP_B; ++rep) { k.phase_B(p, layer, lds); __syncthreads(); } }
      else if (sub == 2) { if (PH_EN(4)) k.phase_scan(p); }
      else if (sub == 3) { if (PH_EN(5)) for (int rep = 0; rep < REP_D; ++rep) { for (int it = blockIdx.x; it < 2048; it += gridDim.x) k.la_item_out(p, layer, it, lds); __syncthreads(); } }
      else if (sub == 4) { if (PH_EN(6)) for (int rep = 0; rep < REP_E; ++rep) { k.phase_E1(p, layer, lds, my_xcc, my_loc, xcnt); __syncthreads(); } }
      else if (sub == 5) { if (PH_EN(7)) for (int rep = 0; rep < REP_E; ++rep) { k.phase_E2(p, layer, lds, my_xcc, my_loc, xcnt); __syncthreads(); } }
      else { if (PH_EN(8)) k.phase_E3(p, layer); }
    }
    if (ph + 1 < p.ph_hi) {
      if (ph == p.ph_lo) grid.sync();
      else k.xcd_barrier(xb);
    }
  }
}

extern "C" void kernel_launch(void* const* d_in, const int* in_sizes, int n_in, void* d_out, int out_size,
                              void* d_ws, size_t ws_size, hipStream_t stream) {
  static int grid_blocks = 0;
  if (!grid_blocks) {
    int dev = 0, cus = 0, per_cu = 0;
    hipGetDevice(&dev);
    hipDeviceGetAttribute(&cus, hipDeviceAttributeMultiprocessorCount, dev);
    hipFuncSetAttribute((const void*)fwd_megakernel, hipFuncAttributeMaxDynamicSharedMemorySize, LDS_BYTES);
    hipOccupancyMaxActiveBlocksPerMultiprocessor(&per_cu, (const void*)fwd_megakernel, NTHREADS, LDS_BYTES);
    if (per_cu < 1) per_cu = 1;
    if (per_cu > 1) per_cu = 1;
    grid_blocks = cus * per_cu;
    if (ws_size < WS_END) fprintf(stderr, "workspace too small: %zu < %llu\n", ws_size, (unsigned long long)WS_END);
  }
  Params p{};
  p.x = (const float*)d_in[0]; p.c = (const float*)d_in[1]; p.pos = (const int*)d_in[2];
  p.ada_w = (const float*)d_in[3]; p.ada_b = (const float*)d_in[4];
  p.pre_norm = (const float*)d_in[5]; p.post_norm = (const float*)d_in[6];
  p.w_in = (const float*)d_in[7]; p.gla_w_lr = (const float*)d_in[8]; p.gla_b_lr = (const float*)d_in[9];
  p.w_br_ret = (const float*)d_in[10]; p.w_br_dsa = (const float*)d_in[11]; p.w_br_gla = (const float*)d_in[12];
  p.w_out = (const float*)d_in[13];
  p.out = (float*)d_out; p.ws = (unsigned char*)d_ws;
  p.ph_lo = 0; p.ph_hi = 2 + 7 * DEPTH;
  void* args[] = {&p};
  hipError_t e = hipLaunchCooperativeKernel((const void*)fwd_megakernel, dim3(grid_blocks), dim3(NTHREADS), args, LDS_BYTES, stream);
  if (e != hipSuccess) fprintf(stderr, "cooperative launch failed: %s (grid %d)\n", hipGetErrorString(e), grid_blocks);
}
```

```cpp
#include <hip/hip_runtime.h>
#include <hip/hip_cooperative_groups.h>
#include <stdint.h>
#include <cstdio>
namespace cg = cooperative_groups;
#ifndef REP_P
#define REP_P 1
#endif
#ifndef REP_KV
#define REP_KV 1
#endif
#ifndef REP_SEL
#define REP_SEL 1
#endif
#ifndef REP_ATT
#define REP_ATT 1
#endif

typedef _Float16 half_t;
typedef _Float16 h8 __attribute__((ext_vector_type(8)));
typedef _Float16 h4 __attribute__((ext_vector_type(4)));
typedef _Float16 h2 __attribute__((ext_vector_type(2)));
typedef float f16v __attribute__((ext_vector_type(16)));
typedef float f4v __attribute__((ext_vector_type(4)));

#define S_LEN 16384
#define DM 1024
#define NIN 7764
#define NPAD 7936
#define PP 7808
#define DEPTH 4
#define NTHREADS 256
#define HP 1088
#define WP 1088
#define WBP 576
#define LDS_BYTES 149504

#define C_RETQ 0
#define C_RETK 256
#define C_RETV 512
#define C_RETG 1024
#define C_DSAQ 1536
#define C_DSAK 2048
#define C_DSAV 2176
#define C_DSAG 2304
#define C_IDXQ 2816
#define C_IDXK 3072
#define C_GLAQ 3136
#define C_GLAK 3392
#define C_GLAV 3648
#define C_GLAG 4160
#define C_GLAA 4672
#define C_MRG 4688
#define C_END 7760
#define C_IDXW 7760

#define OFF_WINT 0ull
#define OFF_WBRT (OFF_WINT + 4ull * NPAD * WP * 2)
#define OFF_WOUTT (OFF_WBRT + 4ull * 3 * 1024 * WBP * 2)
#define OFF_MOD (OFF_WOUTT + 4ull * 1024 * WP * 2)
#define OFF_RT (OFF_MOD + 4ull * 3072 * 4)
#define OFF_DT (OFF_RT + 16384ull * 64 * 4)
#define OFF_H (OFF_DT + 16384ull * 16 * 4)
#define OFF_P (OFF_H + 16384ull * HP * 2)
#define OFF_GA (OFF_P + 16384ull * PP * 2)
#define OFF_IW (OFF_GA + 16384ull * 16 * 4)
#define OFF_ST (OFF_IW + 16384ull * 4 * 4)
#define OFF_DEC (OFF_ST + 256ull * 65536 * 4)
#define OFF_BR (OFF_DEC + 256ull * 8 * 64 * 4)
#define WS_END (OFF_BR + 16384ull * 1536 * 2)
static_assert(WS_END + 16384 <= 508821504ull, "workspace too large");

struct Params {
  const float* x; const float* c; const int* pos; const float* ada_w; const float* ada_b;
  const float* pre_norm; const float* post_norm; const float* w_in; const float* gla_w_lr;
  const float* gla_b_lr; const float* w_br_ret; const float* w_br_dsa; const float* w_br_gla;
  const float* w_out; float* out; unsigned char* ws;
  int ph_lo; int ph_hi;
};

struct K {
int wbase;
__device__ __forceinline__ int otid() const {
  int lane;
  asm volatile("v_mbcnt_lo_u32_b32 %0, -1, 0\n\tv_mbcnt_hi_u32_b32 %0, -1, %0" : "=v"(lane));
  return wbase | lane;
}
__device__ __forceinline__ static float ozero() { float z = 0.f; asm volatile("" : "+v"(z)); return z; }
template <int CTRL>
__device__ __forceinline__ float dppf(float v) {
  return __int_as_float(__builtin_amdgcn_update_dpp(0, __float_as_int(v), CTRL, 0xF, 0xF, true));
}
template <int CTRL>
__device__ __forceinline__ unsigned dppu(unsigned v) {
  return (unsigned)__builtin_amdgcn_update_dpp(0, (int)v, CTRL, 0xF, 0xF, true);
}
__device__ __forceinline__ int olane() { return otid() & 63; }
__device__ __forceinline__ float xor16f(float v) { return __int_as_float(__builtin_amdgcn_ds_bpermute((olane() ^ 16) << 2, __float_as_int(v))); }
__device__ __forceinline__ float xor32f(float v) { return __int_as_float(__builtin_amdgcn_ds_bpermute((olane() ^ 32) << 2, __float_as_int(v))); }
__device__ __forceinline__ unsigned xor16u(unsigned v) { return (unsigned)__builtin_amdgcn_ds_bpermute((olane() ^ 16) << 2, (int)v); }
__device__ __forceinline__ unsigned xor32u(unsigned v) { return (unsigned)__builtin_amdgcn_ds_bpermute((olane() ^ 32) << 2, (int)v); }
__device__ __forceinline__ float wave_sum(float v) {
  v += dppf<0xB1>(v); v += dppf<0x4E>(v); v += dppf<0x141>(v); v += dppf<0x140>(v);
  v += xor16f(v); v += xor32f(v);
  return v;
}
__device__ __forceinline__ float wave_max(float v) {
  v = fmaxf(v, dppf<0xB1>(v)); v = fmaxf(v, dppf<0x4E>(v)); v = fmaxf(v, dppf<0x141>(v)); v = fmaxf(v, dppf<0x140>(v));
  v = fmaxf(v, xor16f(v)); v = fmaxf(v, xor32f(v));
  return v;
}
__device__ __forceinline__ unsigned wave_or(unsigned v) {
  v |= dppu<0xB1>(v); v |= dppu<0x4E>(v); v |= dppu<0x141>(v); v |= dppu<0x140>(v);
  v |= xor16u(v); v |= xor32u(v);
  return v;
}
__device__ __forceinline__ unsigned wave_incl_scan(unsigned v) {
  v += (unsigned)__builtin_amdgcn_update_dpp(0, (int)v, 0x111, 0xF, 0xF, false);
  v += (unsigned)__builtin_amdgcn_update_dpp(0, (int)v, 0x112, 0xF, 0xF, false);
  v += (unsigned)__builtin_amdgcn_update_dpp(0, (int)v, 0x114, 0xF, 0xF, false);
  v += (unsigned)__builtin_amdgcn_update_dpp(0, (int)v, 0x118, 0xF, 0xF, false);
  v += (unsigned)__builtin_amdgcn_update_dpp(0, (int)v, 0x142, 0xA, 0xF, false);
  v += (unsigned)__builtin_amdgcn_update_dpp(0, (int)v, 0x143, 0xC, 0xF, false);
  return v;
}
__device__ __forceinline__ f16v mfma16(h8 a, h8 b, f16v c) {
  return __builtin_amdgcn_mfma_f32_32x32x16_f16(a, b, c, 0, 0, 0);
}
__device__ __forceinline__ float relu_f(float x) { return __int_as_float(max(__float_as_int(x), 0)); }
__device__ __forceinline__ int crow(int r, int l) { return (r & 3) + 8 * (r >> 2) + 4 * (l >> 5); }

__device__ __forceinline__ int win_col(int nv) {
  if (nv < 3136) return nv;
  if (nv < 7760) return nv + 4;
  if (nv < 7764) return nv - 7760 + 3136;
  return -1;
}
__device__ void transpose_tile(const float* __restrict__ src, int ldn, half_t* __restrict__ dst, int K,
                               int k0, int n0, int mapmode, unsigned char* lds) {
  float* T = (float*)lds;
  const int tid = otid();
  const int nn = tid & 63;
  int col = n0 + nn;
  if (mapmode) col = win_col(col);
#pragma unroll
  for (int i = 0; i < 16; ++i) {
    int kk = (tid >> 6) + 4 * i;
    float v = 0.f;
    if (col >= 0) v = src[(size_t)(k0 + kk) * ldn + col];
    T[kk * 65 + nn] = v;
  }
  __syncthreads();
#pragma unroll
  for (int i = 0; i < 2; ++i) {
    int n2 = (tid >> 3) + 32 * i;
    int kc = tid & 7;
    h8 o;
#pragma unroll
    for (int q = 0; q < 8; ++q) o[q] = (half_t)T[(kc * 8 + q) * 65 + n2];
    *(h8*)(dst + (size_t)(n0 + n2) * K + k0 + kc * 8) = o;
  }
  __syncthreads();
}

__device__ void phase_prologue(const Params& p, unsigned char* lds) {
  const int tid = otid();
  half_t* WinT = (half_t*)(p.ws + OFF_WINT);
  half_t* WbrT = (half_t*)(p.ws + OFF_WBRT);
  half_t* WoutT = (half_t*)(p.ws + OFF_WOUTT);
  float* MOD = (float*)(p.ws + OFF_MOD);
  float* RT = (float*)(p.ws + OFF_RT);
  float* DT = (float*)(p.ws + OFF_DT);
  const int T_WIN = 4 * 124 * 16;
  const int T_WBR = 12 * 16 * 8;
  const int T_WOUT = 4 * 16 * 16;
  const int T_MOD = 192;
  const int T_ROPE = 16384 * 40 / 256;
  const int total = T_WIN + T_WBR + T_WOUT + T_MOD + T_ROPE;
  {
    float* T = (float*)lds;
    const int nn = tid & 63;
    float cur[16], nxt[16];
    int task = blockIdx.x;
    if (task < T_WIN) {
      const int l = task / (124 * 16), r = task % (124 * 16), nt = r / 16, kt = r % 16;
      const int col = win_col(nt * 64 + nn);
      const float* src = p.w_in + (size_t)l * 1024 * NIN;
#pragma unroll
      for (int i = 0; i < 16; ++i) { const int kk = (tid >> 6) + 4 * i; cur[i] = (col >= 0) ? src[(size_t)(kt * 64 + kk) * NIN + col] : 0.f; }
    }
    for (; task < T_WIN; task += gridDim.x) {
      const int tn = (task + (int)gridDim.x < T_WIN) ? task + (int)gridDim.x : task;
      {
        const int l = tn / (124 * 16), r = tn % (124 * 16), nt = r / 16, kt = r % 16;
        const int col = win_col(nt * 64 + nn);
        const float* src = p.w_in + (size_t)l * 1024 * NIN;
#pragma unroll
        for (int i = 0; i < 16; ++i) { const int kk = (tid >> 6) + 4 * i; nxt[i] = (col >= 0) ? src[(size_t)(kt * 64 + kk) * NIN + col] : 0.f; }
      }
      const int l = task / (124 * 16), r = task % (124 * 16), nt = r / 16, kt = r % 16;
      half_t* dst = WinT + (size_t)l * NPAD * WP;
#pragma unroll
      for (int i = 0; i < 16; ++i) T[((tid >> 6) + 4 * i) * 65 + nn] = cur[i];
      __syncthreads();
#pragma unroll
      for (int i = 0; i < 2; ++i) {
        const int n2 = (tid >> 3) + 32 * i, kc = tid & 7;
        h8 o;
#pragma unroll
        for (int q = 0; q < 8; ++q) o[q] = (half_t)T[(kc * 8 + q) * 65 + n2];
        *(h8*)(dst + (size_t)(nt * 64 + n2) * WP + kt * 64 + kc * 8) = o;
      }
      __syncthreads();
#pragma unroll
      for (int i = 0; i < 16; ++i) cur[i] = nxt[i];
    }
  }
  for (int task = blockIdx.x; task < total; task += gridDim.x) {
    int t = task;
    if (t < T_WIN) continue;
    if (t < T_WIN) {
      int l = t / (124 * 16); int r = t % (124 * 16); int nt = r / 16, kt = r % 16;
      transpose_tile(p.w_in + (size_t)l * 1024 * NIN, NIN, WinT + (size_t)l * NPAD * WP, WP, kt * 64, nt * 64, 1, lds);
      continue;
    }
    t -= T_WIN;
    if (t < T_WBR) {
      int lb = t / 128; int r = t % 128; int nt = r / 8, kt = r % 8;
      int l = lb / 3, b = lb % 3;
      const float* src = (b == 0 ? p.w_br_ret : (b == 1 ? p.w_br_dsa : p.w_br_gla)) + (size_t)l * 512 * 1024;
      transpose_tile(src, 1024, WbrT + (size_t)lb * 1024 * WBP, WBP, kt * 64, nt * 64, 0, lds);
      continue;
    }
    t -= T_WBR;
    if (t < T_WOUT) {
      int l = t / 256; int r = t % 256; int nt = r / 16, kt = r % 16;
      transpose_tile(p.w_out + (size_t)l * 1024 * 1024, 1024, WoutT + (size_t)l * 1024 * WP, WP, kt * 64, nt * 64, 0, lds);
      continue;
    }
    t -= T_WOUT;
    if (t < T_MOD) {
      int l = t / 48, jb = t % 48;
      int j = jb * 64 + (tid & 63);
      int ig = tid >> 6;
      float acc = 0.f;
      const float* aw = p.ada_w + (size_t)l * 1024 * 3072;
      for (int i = ig * 256; i < ig * 256 + 256; ++i) {
        float cv = p.c[i];
        float sc = cv / (1.f + expf(-cv));
        acc += sc * aw[(size_t)i * 3072 + j];
      }
      float* red = (float*)lds;
      red[tid] = acc;
      __syncthreads();
      if (tid < 64) {
        float s = red[tid] + red[tid + 64] + red[tid + 128] + red[tid + 192];
        MOD[l * 3072 + j] = s + p.ada_b[l * 3072 + j];
      }
      __syncthreads();
      continue;
    }
    t -= T_MOD;
    {
      int e = t * 256 + tid;
      int tok = e / 40, f = e % 40;
      float pf = (float)p.pos[tok];
      if (f < 32) {
        float fr = powf(10000.0f, -(float)f * 2.0f / 64.0f);
        float ang = pf * fr;
        RT[tok * 64 + f * 2] = cosf(ang);
        RT[tok * 64 + f * 2 + 1] = sinf(ang);
      } else {
        int g = f - 32;
        float fr = powf(500000.0f, -(float)g * 2.0f / 16.0f);
        float ang = pf * fr;
        DT[tok * 16 + g * 2] = cosf(ang);
        DT[tok * 16 + g * 2 + 1] = sinf(ang);
      }
    }
  }
}

__device__ __forceinline__ void write_h_row(const float (&xv)[16], const float* __restrict__ pre,
                                            const float* __restrict__ mod, half_t* __restrict__ hrow, int l) {
  float ss = 0.f;
#pragma unroll
  for (int i = 0; i < 16; ++i) ss += xv[i] * xv[i];
  ss = wave_sum(ss);
  float rs = rsqrtf(ss * (1.0f / 1024.0f) + 1e-6f);
#pragma unroll
  for (int i = 0; i < 4; ++i) {
    int c0 = i * 256 + l * 4;
    f4v pg = *(const f4v*)(pre + c0);
    f4v sh = *(const f4v*)(mod + c0);
    f4v sc = *(const f4v*)(mod + 1024 + c0);
    h4 o;
#pragma unroll
    for (int q = 0; q < 4; ++q) o[q] = (half_t)(xv[i * 4 + q] * rs * pg[q] * (1.f + sc[q]) + sh[q]);
    *(h4*)(hrow + c0) = o;
  }
}

__device__ void phase_h0(const Params& p) {
  const int w = otid() >> 6, l = otid() & 63;
  half_t* H = (half_t*)(p.ws + OFF_H);
  const float* MOD = (const float*)(p.ws + OFF_MOD);
  for (int row = blockIdx.x * 4 + w; row < S_LEN; row += gridDim.x * 4) {
    float xv[16];
#pragma unroll
    for (int i = 0; i < 4; ++i) {
      f4v v = *(const f4v*)(p.x + (size_t)row * 1024 + i * 256 + l * 4);
      xv[i * 4] = v[0]; xv[i * 4 + 1] = v[1]; xv[i * 4 + 2] = v[2]; xv[i * 4 + 3] = v[3];
    }
    write_h_row(xv, p.pre_norm, MOD, H + (size_t)row * HP, l);
  }
}

__device__ __forceinline__ void lds_barrier() {
  asm volatile("s_waitcnt lgkmcnt(0)" ::: "memory");
  __builtin_amdgcn_s_barrier();
  asm volatile("" ::: "memory");
}
#define GEMM_BUF 55296
#define GEMM_EOFF 110592
template <int NT>
__device__ __forceinline__ void gemm_step(f16v (&acc)[4][NT], h8 (&ra)[8], h8 (&rb)[2 * NT],
                                          const unsigned char* As, const unsigned char* Bs, unsigned char* Aw, unsigned char* Bw,
                                          const half_t* __restrict__ A, int lda, const half_t* __restrict__ B, int ldb, int kload,
                                          int wm, int wn, int l, int r0, int kc) {
  h8 af[2][4], bf[2][NT];
#pragma unroll
  for (int i = 0; i < 4; ++i) af[0][i] = *(const h8*)(As + (wm * 128 + i * 32 + (l & 31)) * 144 + (l >> 5) * 16);
#pragma unroll
  for (int j = 0; j < NT; ++j) bf[0][j] = *(const h8*)(Bs + (wn * 32 * NT + j * 32 + (l & 31)) * 144 + (l >> 5) * 16);
#pragma unroll
  for (int ks = 0; ks < 4; ++ks) {
    if (ks < 3) {
#pragma unroll
      for (int i = 0; i < 4; ++i) af[(ks + 1) & 1][i] = *(const h8*)(As + (wm * 128 + i * 32 + (l & 31)) * 144 + (ks + 1) * 32 + (l >> 5) * 16);
#pragma unroll
      for (int j = 0; j < NT; ++j) bf[(ks + 1) & 1][j] = *(const h8*)(Bs + (wn * 32 * NT + j * 32 + (l & 31)) * 144 + (ks + 1) * 32 + (l >> 5) * 16);
    }
    __builtin_amdgcn_sched_barrier(0);
#pragma unroll
    for (int i = 0; i < 4; ++i)
#pragma unroll
      for (int j = 0; j < NT; ++j) acc[i][j] = mfma16(af[ks & 1][i], bf[ks & 1][j], acc[i][j]);
#pragma unroll
    for (int i = 2 * ks; i < 2 * ks + 2; ++i) {
      *(h8*)(Aw + (r0 + 32 * i) * 144 + kc * 16) = ra[i];
      ra[i] = *(const h8*)(A + (size_t)(r0 + 32 * i) * lda + kload + kc * 8);
    }
    if (NT == 2) {
      *(h8*)(Bw + (r0 + 32 * ks) * 144 + kc * 16) = rb[ks];
      rb[ks] = *(const h8*)(B + (size_t)(r0 + 32 * ks) * ldb + kload + kc * 8);
    } else {
#pragma unroll
      for (int i = 2 * ks; i < 2 * ks + 2; ++i) {
        *(h8*)(Bw + (r0 + 32 * i) * 144 + kc * 16) = rb[i];
        rb[i] = *(const h8*)(B + (size_t)(r0 + 32 * i) * ldb + kload + kc * 8);
      }
    }
    __builtin_amdgcn_sched_barrier(0);
  }
}
template <int NT>
__device__ __forceinline__ void gemm_issue(h8 (&ra0)[8], h8 (&rb0)[2 * NT], h8 (&ra1)[8], h8 (&rb1)[2 * NT],
                                           const half_t* __restrict__ A, int lda, const half_t* __restrict__ B, int ldb) {
  const int tid = otid();
  const int kc = tid & 7, r0 = tid >> 3;
#pragma unroll
  for (int i = 0; i < 8; ++i) ra0[i] = *(const h8*)(A + (size_t)(r0 + 32 * i) * lda + kc * 8);
#pragma unroll
  for (int i = 0; i < 2 * NT; ++i) rb0[i] = *(const h8*)(B + (size_t)(r0 + 32 * i) * ldb + kc * 8);
#pragma unroll
  for (int i = 0; i < 8; ++i) ra1[i] = *(const h8*)(A + (size_t)(r0 + 32 * i) * lda + 64 + kc * 8);
#pragma unroll
  for (int i = 0; i < 2 * NT; ++i) rb1[i] = *(const h8*)(B + (size_t)(r0 + 32 * i) * ldb + 64 + kc * 8);
}
template <int NT>
__device__ __forceinline__ void gemm_run(f16v (&acc)[4][NT], h8 (&ra0)[8], h8 (&rb0)[2 * NT], h8 (&ra1)[8], h8 (&rb1)[2 * NT],
                                         const half_t* __restrict__ A, int lda, const half_t* __restrict__ B, int ldb, int K, unsigned char* lds) {
  const int tid = otid(), w = tid >> 6, l = tid & 63;
  constexpr int STAGE = 256 * 144 + 64 * NT * 144;
  unsigned char* A0 = lds;
  unsigned char* B0 = lds + 256 * 144;
  unsigned char* A1 = lds + STAGE;
  unsigned char* B1 = lds + STAGE + 256 * 144;
  const int wm = w >> 1, wn = w & 1;
  const int kc = tid & 7;
  const int r0 = tid >> 3;
  lds_barrier();
#pragma unroll
  for (int i = 0; i < 8; ++i) { *(h8*)(A0 + (r0 + 32 * i) * 144 + kc * 16) = ra0[i]; ra0[i] = *(const h8*)(A + (size_t)(r0 + 32 * i) * lda + 128 + kc * 8); }
#pragma unroll
  for (int i = 0; i < 2 * NT; ++i) { *(h8*)(B0 + (r0 + 32 * i) * 144 + kc * 16) = rb0[i]; rb0[i] = *(const h8*)(B + (size_t)(r0 + 32 * i) * ldb + 128 + kc * 8); }
  lds_barrier();
  const int nk = K / 64;
#pragma unroll 1
  for (int kt = 0; kt < nk; kt += 2) {
    gemm_step<NT>(acc, ra1, rb1, A0, B0, A1, B1, A, lda, B, ldb, (kt + 3 < nk) ? (kt + 3) * 64 : 0, wm, wn, l, r0, kc);
    lds_barrier();
    gemm_step<NT>(acc, ra0, rb0, A1, B1, A0, B0, A, lda, B, ldb, (kt + 4 < nk) ? (kt + 4) * 64 : 0, wm, wn, l, r0, kc);
    lds_barrier();
  }
}
template <int NT>
__device__ __forceinline__ void gemm_kloop(f16v (&acc)[4][NT], const half_t* __restrict__ A, int lda,
                                           const half_t* __restrict__ B, int ldb, int K, unsigned char* lds) {
  h8 ra0[8], rb0[2 * NT], ra1[8], rb1[2 * NT];
  gemm_issue<NT>(ra0, rb0, ra1, rb1, A, lda, B, ldb);
  gemm_run<NT>(acc, ra0, rb0, ra1, rb1, A, lda, B, ldb, K, lds);
}

template <int NT>
__device__ __forceinline__ void gemm_issue1(h8 (&ra)[8], h8 (&rb)[2 * NT], const half_t* __restrict__ A, int lda, const half_t* __restrict__ B, int ldb) {
  const int tid = otid();
  const int kc = tid & 7, r0 = tid >> 3;
#pragma unroll
  for (int i = 0; i < 8; ++i) ra[i] = *(const h8*)(A + (size_t)(r0 + 32 * i) * lda + kc * 8);
#pragma unroll
  for (int i = 0; i < 2 * NT; ++i) rb[i] = *(const h8*)(B + (size_t)(r0 + 32 * i) * ldb + kc * 8);
}
template <int NT>
__device__ __forceinline__ void gemm_run1(f16v (&acc)[4][NT], h8 (&ra)[8], h8 (&rb)[2 * NT],
                                          const half_t* __restrict__ A, int lda, const half_t* __restrict__ B, int ldb, int K, unsigned char* lds) {
  const int tid = otid(), w = tid >> 6, l = tid & 63;
  constexpr int STAGE = 256 * 144 + 64 * NT * 144;
  const int wm = w >> 1, wn = w & 1;
  const int kc = tid & 7;
  const int r0 = tid >> 3;
  lds_barrier();
#pragma unroll
  for (int i = 0; i < 8; ++i) { *(h8*)(lds + (r0 + 32 * i) * 144 + kc * 16) = ra[i]; ra[i] = *(const h8*)(A + (size_t)(r0 + 32 * i) * lda + 64 + kc * 8); }
#pragma unroll
  for (int i = 0; i < 2 * NT; ++i) { *(h8*)(lds + 256 * 144 + (r0 + 32 * i) * 144 + kc * 16) = rb[i]; rb[i] = *(const h8*)(B + (size_t)(r0 + 32 * i) * ldb + 64 + kc * 8); }
  lds_barrier();
  const int nk = K / 64;
#pragma unroll 1
  for (int kt = 0; kt < nk; ++kt) {
    unsigned char* cur = lds + (kt & 1) * STAGE;
    unsigned char* nxt = lds + ((kt + 1) & 1) * STAGE;
    gemm_step<NT>(acc, ra, rb, cur, cur + 256 * 144, nxt, nxt + 256 * 144, A, lda, B, ldb, (kt + 2 < nk) ? (kt + 2) * 64 : 0, wm, wn, l, r0, kc);
    lds_barrier();
  }
}

template <int NT>
__device__ __forceinline__ void zero_acc(f16v (&acc)[4][NT]) {
  float z = 0.f;
  asm volatile("" : "+v"(z));
#pragma unroll
  for (int i = 0; i < 4; ++i)
#pragma unroll
    for (int j = 0; j < NT; ++j)
#pragma unroll
      for (int r = 0; r < 16; ++r) acc[i][j][r] = z;
}

#define EP 68
__device__ __forceinline__ void stage_pair(float* E, const f16v& a0, const f16v& a1, int l) {
#pragma unroll
  for (int r = 0; r < 16; ++r) {
    const int rr = crow(r, l);
    E[rr * EP + (l & 31)] = a0[r];
    E[rr * EP + 32 + (l & 31)] = a1[r];
  }
}
__device__ __forceinline__ void ld8(const float* p, float (&v)[8]) {
  const f4v a = *(const f4v*)p, b = *(const f4v*)(p + 4);
  v[0] = a[0]; v[1] = a[1]; v[2] = a[2]; v[3] = a[3]; v[4] = b[0]; v[5] = b[1]; v[6] = b[2]; v[7] = b[3];
}
__device__ __forceinline__ int xcc_census(const unsigned* xcnt, int my_xcc) {
  unsigned sum = 0; bool ok = my_xcc < 8; int mine = 0;
#pragma unroll
  for (int j = 0; j < 16; ++j) {
    const unsigned c = __hip_atomic_load(xcnt + j, __ATOMIC_RELAXED, __HIP_MEMORY_SCOPE_AGENT);
    sum += c;
    if (j < 8 && c == 0u) ok = false;
    if (j >= 8 && c != 0u) ok = false;
    if (j == my_xcc) mine = (int)c;
  }
  if (sum != gridDim.x) ok = false;
  return ok ? mine : 0;
}

__device__ void phase_A(const Params& p, int layer, unsigned char* lds, int my_xcc, int my_loc, const unsigned* xcnt) {
  const int tid = otid(), w = tid >> 6, l = tid & 63;
  const half_t* H = (const half_t*)(p.ws + OFF_H);
  const half_t* Wt = (const half_t*)(p.ws + OFF_WINT) + (size_t)layer * NPAD * WP;
  half_t* P = (half_t*)(p.ws + OFF_P);
  float* GA = (float*)(p.ws + OFF_GA);
  float* IW = (float*)(p.ws + OFF_IW);
  const float* RT = (const float*)(p.ws + OFF_RT);
  const float* DT = (const float*)(p.ws + OFF_DT);
  const int wm = w >> 1, wn = w & 1;
  const int G = gridDim.x;
  const int ntiles = 64 * 31;
  const int nx = xcc_census(xcnt, my_xcc);
  int nmine;
  if (nx > 0) nmine = (my_loc < 248) ? (248 - my_loc + nx - 1) / nx : 0;
  else nmine = ((int)blockIdx.x < ntiles) ? (ntiles - (int)blockIdx.x + G - 1) / G : 0;
  h8 ra0[8], rb0[8];
  int mt = 0, nt = 0;
  if (nmine > 0) {
    if (nx > 0) { const int s0 = my_loc; mt = my_xcc * 8 + (s0 & 7); nt = s0 >> 3; }
    else { const int tix = blockIdx.x; mt = tix & 63; nt = tix >> 6; }
    gemm_issue1<4>(ra0, rb0, H + (size_t)mt * 256 * HP, HP, Wt + (size_t)nt * 256 * WP, WP);
  }
#pragma unroll 1
  for (int rnd = 0; rnd < nmine; ++rnd) {
    f16v acc[4][4];
    zero_acc<4>(acc);
    gemm_run1<4>(acc, ra0, rb0, H + (size_t)mt * 256 * HP, HP, Wt + (size_t)nt * 256 * WP, WP, 1024, lds);
    const int mt_cur = mt, nt_cur = nt;
    if (rnd + 1 < nmine) {
      if (nx > 0) { const int s1 = my_loc + nx * (rnd + 1); mt = my_xcc * 8 + (s1 & 7); nt = s1 >> 3; }
      else { const int tix = (rnd + 1) * G + blockIdx.x; mt = tix & 63; nt = tix >> 6; }
      gemm_issue1<4>(ra0, rb0, H + (size_t)mt * 256 * HP, HP, Wt + (size_t)nt * 256 * WP, WP);
    }
    const int m0w = mt_cur * 256 + wm * 128;
    const int n0w = nt_cur * 256 + wn * 128;
    float* E = (float*)(lds) + w * (32 * EP);
    const int prow = l >> 3, c0 = (l & 7) * 8;
#pragma unroll
    for (int jp = 0; jp < 2; ++jp) {
      const int nb2 = n0w + jp * 64;
      const int n0 = nb2 + c0;
      const bool rope64 = nb2 < 512;
      const bool rope16 = ((nb2 >= C_DSAQ && nb2 < C_DSAV) || (nb2 >= C_IDXQ && nb2 < C_GLAQ)) && (c0 < 16);
      float scale = 1.f;
      if (n0 < 256 || (n0 >= C_DSAQ && n0 < C_DSAK) || (n0 >= C_IDXQ && n0 < C_IDXK) || (n0 >= C_GLAQ && n0 < C_GLAK)) scale = 0.125f;
      int mode = 0;
      if ((n0 >= C_RETG && n0 < C_DSAQ) || (n0 >= C_DSAG && n0 < C_IDXQ) || (n0 >= C_GLAG && n0 < C_GLAA)) mode = 1;
      if (n0 >= C_MRG && n0 < C_END) mode = 2;
#pragma unroll
      for (int i = 0; i < 4; ++i) {
        stage_pair(E, acc[i][2 * jp], acc[i][2 * jp + 1], l);
#pragma unroll 2
        for (int ps = 0; ps < 4; ++ps) {
          const int rl = ps * 8 + prow;
          const int row = m0w + i * 32 + rl;
          float v[8], o[8];
          ld8(E + rl * EP + c0, v);
#pragma unroll
          for (int q = 0; q < 8; ++q) o[q] = v[q];
          if (rope64) {
            float pv[8], tb[16];
            ld8(E + rl * EP + (c0 ^ 32), pv);
            const float* tp = RT + (size_t)row * 64 + (c0 & 31) * 2;
            ld8(tp, *(float(*)[8])&tb[0]); ld8(tp + 8, *(float(*)[8])&tb[8]);
#pragma unroll
            for (int q = 0; q < 8; ++q) o[q] = (c0 < 32) ? (v[q] * tb[2 * q] - pv[q] * tb[2 * q + 1]) : (v[q] * tb[2 * q] + pv[q] * tb[2 * q + 1]);
          } else if (rope16) {
            float pv[8], tb[16];
            ld8(E + rl * EP + (c0 ^ 8), pv);
            const float* tp = DT + (size_t)row * 16;
            ld8(tp, *(float(*)[8])&tb[0]); ld8(tp + 8, *(float(*)[8])&tb[8]);
#pragma unroll
            for (int q = 0; q < 8; ++q) o[q] = (c0 < 8) ? (v[q] * tb[2 * q] - pv[q] * tb[2 * q + 1]) : (v[q] * tb[2 * q] + pv[q] * tb[2 * q + 1]);
          }
          h8 ov;
#pragma unroll
          for (int q = 0; q < 8; ++q) {
            float t = o[q] * scale;
            if (mode != 0) {
              const float sg = __builtin_amdgcn_rcpf(1.f + __expf(-t));
              t = (mode == 1) ? t * sg : sg;
            }
            ov[q] = (half_t)t;
          }
          if (n0 < C_END) __builtin_nontemporal_store(ov, (h8*)(P + (size_t)row * PP + n0));
          if (n0 >= C_GLAA && n0 < C_MRG) {
#pragma unroll
            for (int q = 0; q < 8; ++q) GA[(size_t)row * 16 + (n0 - C_GLAA) + q] = v[q];
          }
          if (n0 == C_IDXW) {
#pragma unroll
            for (int q = 0; q < 4; ++q) IW[(size_t)row * 4 + q] = 0.5f * v[q];
          }
        }
      }
    }
  }
}

#define LA_BC 0
#define LA_GAS 16640
#define LA_WL 20736
#define LA_QT 24832
#define LA_KT 34048
#define LA_AT 43264
#define LA_VT 52480
#define LA_SS 70912
#define LA_OS 89344
#define LA_SEG 123136

__device__ void la_bcum(const Params& p, int layer, int n, int Hh, unsigned char* lds) {
  const int tid = otid();
  float* Bc = (float*)(lds + LA_BC);
  const int d = tid & 63, q = tid >> 6;
  if (Hh < 4) {
    float lg = log1pf(-exp2f(-5.0f - (float)Hh));
#pragma unroll
    for (int jj = 0; jj < 16; ++jj) { int j = q * 16 + jj; Bc[j * 65 + d] = (float)(j + 1) * lg; }
    __syncthreads();
    return;
  }
  const int h = Hh - 4;
  float* GAs = (float*)(lds + LA_GAS);
  float* WL = (float*)(lds + LA_WL);
  float* SEG = (float*)(lds + LA_SEG);
  const float* GA = (const float*)(p.ws + OFF_GA);
#pragma unroll
  for (int i = 0; i < 4; ++i) {
    int e = tid + 256 * i;
    GAs[e] = GA[(size_t)n * 64 * 16 + e];
    int r = e >> 6, dd = e & 63;
    WL[e] = p.gla_w_lr[(size_t)layer * 16 * 256 + r * 256 + h * 64 + dd];
  }
  __syncthreads();
  float wl[16];
#pragma unroll
  for (int r = 0; r < 16; ++r) wl[r] = WL[r * 64 + d];
  const float bl = p.gla_b_lr[layer * 256 + h * 64 + d];
  float run = 0.f;
#pragma unroll
  for (int jj = 0; jj < 16; ++jj) {
    int j = q * 16 + jj;
    float z = bl;
#pragma unroll
    for (int r = 0; r < 16; ++r) z += GAs[j * 16 + r] * wl[r];
    float ls = fminf(z, 0.f) - log1pf(expf(-fabsf(z)));
    run += ls * (1.0f / 16.0f);
    Bc[j * 65 + d] = run;
  }
  SEG[q * 64 + d] = run;
  __syncthreads();
  float off = 0.f;
  for (int qq = 0; qq < q; ++qq) off += SEG[qq * 64 + d];
  if (q > 0) {
#pragma unroll
    for (int jj = 0; jj < 16; ++jj) { int j = q * 16 + jj; Bc[j * 65 + d] += off; }
  }
  __syncthreads();
}

__device__ __forceinline__ void la_load_v(const half_t* __restrict__ P, int t0, int vcol, h8 (&vr)[2][2]) {
  const int tid = otid(), w = tid >> 6, l = tid & 63;
  const int jp = l & 31, cgp = l >> 5;
#pragma unroll
  for (int it = 0; it < 2; ++it) {
    int c = it * 8 + w * 2 + cgp;
    vr[it][0] = *(const h8*)(P + (size_t)(t0 + 2 * jp) * PP + vcol + c * 8);
    vr[it][1] = *(const h8*)(P + (size_t)(t0 + 2 * jp + 1) * PP + vcol + c * 8);
  }
}
__device__ __forceinline__ void la_stage_vt(const h8 (&vr)[2][2], unsigned char* lds) {
  const int tid = otid(), w = tid >> 6, l = tid & 63;
  half_t* VT = (half_t*)(lds + LA_VT);
  const int jp = l & 31, cgp = l >> 5;
#pragma unroll
  for (int it = 0; it < 2; ++it) {
    int c = it * 8 + w * 2 + cgp;
#pragma unroll
    for (int q = 0; q < 8; ++q) {
      h2 pr; pr[0] = vr[it][0][q]; pr[1] = vr[it][1][q];
      *(h2*)(VT + (c * 8 + q) * 72 + 2 * jp) = pr;
    }
  }
}
__device__ void la_item_kv(const Params& p, int layer, int item, unsigned char* lds) {
  const int tid = otid(), w = tid >> 6, l = tid & 63;
  const int n = item >> 3, Hh = item & 7;
  const int t0 = n * 64;
  const half_t* P = (const half_t*)(p.ws + OFF_P);
  half_t* ST = (half_t*)(p.ws + OFF_ST);
  float* DEC = (float*)(p.ws + OFF_DEC);
  const int kcol = (Hh < 4) ? (C_RETK + Hh * 64) : (C_GLAK + (Hh - 4) * 64);
  const int vcol = (Hh < 4) ? (C_RETV + Hh * 128) : (C_GLAV + (Hh - 4) * 128);
  h8 vr[2][2];
  la_load_v(P, t0, vcol, vr);
  const h8 k0 = *(const h8*)(P + (size_t)(t0 + 2 * (l & 31)) * PP + kcol + (w * 2 + (l >> 5)) * 8);
  const h8 k1 = *(const h8*)(P + (size_t)(t0 + 2 * (l & 31) + 1) * PP + kcol + (w * 2 + (l >> 5)) * 8);
  __syncthreads();
  la_bcum(p, layer, n, Hh, lds);
  const float* Bc = (const float*)(lds + LA_BC);
  half_t* KhT = (half_t*)(lds + LA_KT);
  half_t* VT = (half_t*)(lds + LA_VT);
  {
    const int jp = l & 31, cgp = l >> 5;
    int c = w * 2 + cgp;
#pragma unroll
    for (int q = 0; q < 8; ++q) {
      int d = c * 8 + q;
      float bl = Bc[63 * 65 + d];
      h2 pr;
      pr[0] = (half_t)((float)k0[q] * __expf(bl - Bc[(2 * jp) * 65 + d]));
      pr[1] = (half_t)((float)k1[q] * __expf(bl - Bc[(2 * jp + 1) * 65 + d]));
      *(h2*)(KhT + d * 72 + 2 * jp) = pr;
    }
  }
  la_stage_vt(vr, lds);
  if (tid < 64) DEC[(size_t)item * 64 + tid] = __expf(Bc[63 * 65 + tid]);
  __syncthreads();
  f16v acc[2];
#pragma unroll
  for (int j = 0; j < 2; ++j)
#pragma unroll
    for (int r = 0; r < 16; ++r) acc[j][r] = ozero();
#pragma unroll
  for (int ks = 0; ks < 4; ++ks) {
    h8 a = *(const h8*)(VT + (32 * w + (l & 31)) * 72 + ks * 16 + (l >> 5) * 8);
#pragma unroll
    for (int j = 0; j < 2; ++j) {
      h8 b = *(const h8*)(KhT + (j * 32 + (l & 31)) * 72 + ks * 16 + (l >> 5) * 8);
      acc[j] = mfma16(a, b, acc[j]);
    }
  }
#pragma unroll
  for (int j = 0; j < 2; ++j)
#pragma unroll
    for (int r = 0; r < 16; ++r) {
      int e = 32 * w + crow(r, l);
      int d = j * 32 + (l & 31);
      ST[(size_t)item * 8192 + e * 64 + d] = (half_t)acc[j][r];
    }
}

__device__ void phase_scan(const Params& p) {
  half_t* ST = (half_t*)(p.ws + OFF_ST);
  const float* DEC = (const float*)(p.ws + OFF_DEC);
  for (int f2 = blockIdx.x * NTHREADS + otid(); f2 < 32768; f2 += gridDim.x * NTHREADS) {
    const int f = f2 * 2;
    const int Hh = f >> 13, d = f & 63;
    float s0 = 0.f, s1 = 0.f;
    for (int n0 = 0; n0 < 256; n0 += 16) {
      h2 kv[16]; float2 dc[16];
#pragma unroll
      for (int u = 0; u < 16; ++u) {
        kv[u] = *(const h2*)(ST + (size_t)(n0 + u) * 65536 + f);
        dc[u] = *(const float2*)(DEC + (size_t)((n0 + u) * 8 + Hh) * 64 + d);
      }
#pragma unroll
      for (int u = 0; u < 16; ++u) {
        h2 o; o[0] = (half_t)s0; o[1] = (half_t)s1;
        *(h2*)(ST + (size_t)(n0 + u) * 65536 + f) = o;
        s0 = dc[u].x * s0 + (float)kv[u][0];
        s1 = dc[u].y * s1 + (float)kv[u][1];
      }
    }
  }
}

__device__ void la_item_out(const Params& p, int layer, int item, unsigned char* lds) {
  const int tid = otid(), w = tid >> 6, l = tid & 63;
  const int n = item >> 3, Hh = item & 7;
  const int t0 = n * 64;
  const half_t* P = (const half_t*)(p.ws + OFF_P);
  const half_t* ST = (const half_t*)(p.ws + OFF_ST);
  half_t* BR = (half_t*)(p.ws + OFF_BR);
  const int qcol = (Hh < 4) ? (C_RETQ + Hh * 64) : (C_GLAQ + (Hh - 4) * 64);
  const int kcol = (Hh < 4) ? (C_RETK + Hh * 64) : (C_GLAK + (Hh - 4) * 64);
  const int vcol = (Hh < 4) ? (C_RETV + Hh * 128) : (C_GLAV + (Hh - 4) * 128);
  const int gcol = (Hh < 4) ? (C_RETG + Hh * 128) : (C_GLAG + (Hh - 4) * 128);
  const int ocol = (Hh < 4) ? (Hh * 128) : (1024 + (Hh - 4) * 128);
  h8 vr[2][2];
  la_load_v(P, t0, vcol, vr);
  h8 qr[2], kr[2], sr[4];
#pragma unroll
  for (int it = 0; it < 2; ++it) {
    const int c = tid + 256 * it;
    qr[it] = *(const h8*)(P + (size_t)(t0 + (c >> 3)) * PP + qcol + (c & 7) * 8);
    kr[it] = *(const h8*)(P + (size_t)(t0 + (c >> 3)) * PP + kcol + (c & 7) * 8);
  }
#pragma unroll
  for (int it = 0; it < 4; ++it) {
    const int c = tid + 256 * it;
    sr[it] = *(const h8*)(ST + (size_t)item * 8192 + (c >> 3) * 64 + (c & 7) * 8);
  }
  __syncthreads();
  la_bcum(p, layer, n, Hh, lds);
  const float* Bc = (const float*)(lds + LA_BC);
  half_t* Qt = (half_t*)(lds + LA_QT);
  half_t* Kt = (half_t*)(lds + LA_KT);
  half_t* AT = (half_t*)(lds + LA_AT);
  half_t* VT = (half_t*)(lds + LA_VT);
  half_t* SS = (half_t*)(lds + LA_SS);
  float* OS = (float*)(lds + LA_OS);
#pragma unroll
  for (int it = 0; it < 2; ++it) {
    int c = tid + 256 * it;
    int row = c >> 3, kc = c & 7;
    const h8 qv = qr[it];
    const h8 kv = kr[it];
    h8 qo, ko;
#pragma unroll
    for (int q = 0; q < 8; ++q) {
      float b = Bc[row * 65 + kc * 8 + q];
      qo[q] = (half_t)((float)qv[q] * __expf(b));
      ko[q] = (half_t)((float)kv[q] * __expf(-b));
    }
    *(h8*)(Qt + row * 72 + kc * 8) = qo;
    *(h8*)(Kt + row * 72 + kc * 8) = ko;
  }
  la_stage_vt(vr, lds);
#pragma unroll
  for (int it = 0; it < 4; ++it) {
    int c = tid + 256 * it;
    int e = c >> 3, kc = c & 7;
    *(h8*)(SS + e * 72 + kc * 8) = sr[it];
  }
  __syncthreads();
  {
    const int mi = w >> 1, nj = w & 1;
    f16v acc;
#pragma unroll
    for (int r = 0; r < 16; ++r) acc[r] = ozero();
#pragma unroll
    for (int ks = 0; ks < 4; ++ks) {
      h8 a = *(const h8*)(Qt + (mi * 32 + (l & 31)) * 72 + ks * 16 + (l >> 5) * 8);
      h8 b = *(const h8*)(Kt + (nj * 32 + (l & 31)) * 72 + ks * 16 + (l >> 5) * 8);
      acc = mfma16(a, b, acc);
    }
#pragma unroll
    for (int r = 0; r < 16; ++r) {
      int i = mi * 32 + crow(r, l);
      int j = nj * 32 + (l & 31);
      float v = (j <= i) ? acc[r] : 0.f;
      AT[i * 72 + j] = (half_t)v;
    }
  }
  __syncthreads();
  {
    const int mi = w >> 1, nh = w & 1;
    f16v acc[2];
#pragma unroll
    for (int j = 0; j < 2; ++j)
#pragma unroll
      for (int r = 0; r < 16; ++r) acc[j][r] = ozero();
#pragma unroll
    for (int ks = 0; ks < 4; ++ks) {
      h8 a1 = *(const h8*)(AT + (mi * 32 + (l & 31)) * 72 + ks * 16 + (l >> 5) * 8);
      h8 a2 = *(const h8*)(Qt + (mi * 32 + (l & 31)) * 72 + ks * 16 + (l >> 5) * 8);
#pragma unroll
      for (int j = 0; j < 2; ++j) {
        h8 b1 = *(const h8*)(VT + (nh * 64 + j * 32 + (l & 31)) * 72 + ks * 16 + (l >> 5) * 8);
        h8 b2 = *(const h8*)(SS + (nh * 64 + j * 32 + (l & 31)) * 72 + ks * 16 + (l >> 5) * 8);
        acc[j] = mfma16(a1, b1, acc[j]);
        acc[j] = mfma16(a2, b2, acc[j]);
      }
    }
#pragma unroll
    for (int j = 0; j < 2; ++j)
#pragma unroll
      for (int r = 0; r < 16; ++r) {
        int i = mi * 32 + crow(r, l);
        int e = nh * 64 + j * 32 + (l & 31);
        OS[i * 132 + e] = acc[j][r];
      }
  }
  __syncthreads();
  {
    const int i = tid >> 2, qd = tid & 3;
    float ov[32];
    float ss = 0.f;
#pragma unroll
    for (int c = 0; c < 8; ++c) {
      f4v v = *(const f4v*)(OS + i * 132 + qd * 32 + c * 4);
      ov[c * 4] = v[0]; ov[c * 4 + 1] = v[1]; ov[c * 4 + 2] = v[2]; ov[c * 4 + 3] = v[3];
      ss += v[0] * v[0] + v[1] * v[1] + v[2] * v[2] + v[3] * v[3];
    }
    ss += dppf<0xB1>(ss);
    ss += dppf<0x4E>(ss);
    float rs = rsqrtf(ss * (1.0f / 128.0f) + 1e-6f);
#pragma unroll
    for (int c = 0; c < 4; ++c) {
      h8 g = *(const h8*)(P + (size_t)(t0 + i) * PP + gcol + qd * 32 + c * 8);
      h8 o;
#pragma unroll
      for (int q = 0; q < 8; ++q) o[q] = (half_t)(ov[c * 8 + q] * rs * (float)g[q]);
      *(h8*)(BR + (size_t)(t0 + i) * 1536 + ocol + qd * 32 + c * 8) = o;
    }
  }
}

#define DS_CAP 640
#define DS_PRUNE_AT 512
#define NPL 10
#define DS_LS 0
#define DS_LI (32 * DS_CAP * 4)
#define DS_CNT (32 * DS_CAP * 6)
#define DS_THR (DS_CNT + 128)
#define DS_WQ (DS_CNT + 256)
#define DS_HIST (DS_CNT + 1024)
#define DS_PW (DS_CNT + 1024 + 4096)

__device__ __forceinline__ unsigned long long wave_or64(unsigned long long v) {
  const unsigned lo = wave_or((unsigned)v), hi = wave_or((unsigned)(v >> 32));
  return ((unsigned long long)hi << 32) | lo;
}
__device__ __forceinline__ void dsa_prune(float* LSm, unsigned short* LIm, int n, unsigned* hist, int* cntm, float* thrm, int l) {
  unsigned long long comp[NPL];
  bool act[NPL], val[NPL];
#pragma unroll
  for (int k = 0; k < NPL; ++k) {
    int e = l + 64 * k;
    val[k] = e < n;
    unsigned u = 0, li = 0;
    if (val[k]) { u = __float_as_uint(LSm[e]); li = LIm[e]; }
    const unsigned key = (u >> 31) ? ~u : (u | 0x80000000u);
    comp[k] = ((unsigned long long)key << 14) | (unsigned long long)(16383u - li);
    act[k] = val[k];
  }
  const unsigned long long c0 = ((unsigned long long)(unsigned)__builtin_amdgcn_readfirstlane((int)(unsigned)(comp[0] >> 32)) << 32) | (unsigned)__builtin_amdgcn_readfirstlane((int)(unsigned)comp[0]);
  unsigned long long x = 0;
#pragma unroll
  for (int k = 0; k < NPL; ++k) x |= val[k] ? (comp[k] ^ c0) : 0ull;
  x = wave_or64(x);
  int shift = (x == 0ull) ? 0 : (63 - __clzll((long long)x)) - 7;
  if (shift < 0) shift = 0;
  unsigned rank = 256;
#pragma unroll 1
  for (int rd = 0; rd < 8; ++rd) {
    *(uint4*)(hist + 4 * l) = make_uint4(0, 0, 0, 0);
    __threadfence_block();
    unsigned dk[NPL];
#pragma unroll
    for (int k = 0; k < NPL; ++k) {
      dk[k] = (unsigned)(comp[k] >> shift) & 255u;
      if (act[k]) atomicAdd(&hist[dk[k]], 1u);
    }
    __threadfence_block();
    uint4 hv; hv.x = hist[4 * l]; hv.y = hist[4 * l + 1]; hv.z = hist[4 * l + 2]; hv.w = hist[4 * l + 3];
    unsigned tl = hv.x + hv.y + hv.z + hv.w;
    const unsigned pin = wave_incl_scan(tl);
    const unsigned tot = (unsigned)__builtin_amdgcn_readlane((int)pin, 63);
    unsigned sx = tot - pin;
    bool mine = (sx < rank) && (rank <= sx + tl);
    unsigned dsel = 0, nr = 0, hsel = 0;
    if (mine) {
      unsigned c = sx;
      if (c + hv.w >= rank) { dsel = 4 * l + 3; nr = rank - c; hsel = hv.w; }
      else {
        c += hv.w;
        if (c + hv.z >= rank) { dsel = 4 * l + 2; nr = rank - c; hsel = hv.z; }
        else {
          c += hv.z;
          if (c + hv.y >= rank) { dsel = 4 * l + 1; nr = rank - c; hsel = hv.y; }
          else { c += hv.y; dsel = 4 * l; nr = rank - c; hsel = hv.x; }
        }
      }
    }
    unsigned long long mk = __ballot(mine);
    int src = (mk == 0ull) ? 0 : (__ffsll((long long)mk) - 1);
    dsel = (unsigned)__builtin_amdgcn_readlane((int)dsel, src);
    rank = (unsigned)__builtin_amdgcn_readlane((int)nr, src);
    hsel = (unsigned)__builtin_amdgcn_readlane((int)hsel, src);
#pragma unroll
    for (int k = 0; k < NPL; ++k) act[k] = act[k] && (dk[k] == dsel);
    if (hsel <= 1u || shift == 0) break;
    shift = (shift >= 8) ? (shift - 8) : 0;
  }
  unsigned long long tsel = 0;
#pragma unroll
  for (int k = 0; k < NPL; ++k) tsel |= act[k] ? comp[k] : 0ull;
  const unsigned long long T = wave_or64(tsel);
  bool keep[NPL];
  unsigned cntk = 0;
#pragma unroll
  for (int k = 0; k < NPL; ++k) {
    keep[k] = val[k] && (comp[k] >= T);
    cntk += keep[k] ? 1u : 0u;
  }
  unsigned pos = wave_incl_scan(cntk) - cntk;
  __threadfence_block();
#pragma unroll
  for (int k = 0; k < NPL; ++k) {
    if (keep[k]) {
      const unsigned kk = (unsigned)(comp[k] >> 14);
      const unsigned u = (kk & 0x80000000u) ? (kk & 0x7FFFFFFFu) : ~kk;
      LSm[pos] = __uint_as_float(u);
      LIm[pos] = (unsigned short)(16383u - ((unsigned)comp[k] & 16383u));
      ++pos;
    }
  }
  if (l == 0) {
    const unsigned T32 = (unsigned)(T >> 14);
    *cntm = 256;
    *thrm = __uint_as_float((T32 & 0x80000000u) ? (T32 & 0x7FFFFFFFu) : ~T32);
  }
  __threadfence_block();
}

__device__ void dsa_item(const Params& p, int qb, unsigned char* lds) {
  const int tid = otid(), w = tid >> 6, l = tid & 63;
  const int t0 = qb * 32;
  const half_t* P = (const half_t*)(p.ws + OFF_P);
  const float* IW = (const float*)(p.ws + OFF_IW);
  half_t* BR = (half_t*)(p.ws + OFF_BR);
  float* LS = (float*)(lds + DS_LS);
  unsigned short* LI = (unsigned short*)(lds + DS_LI);
  int* cnt = (int*)(lds + DS_CNT);
  float* thr = (float*)(lds + DS_THR);
  float* wq = (float*)(lds + DS_WQ);
  unsigned* hist = (unsigned*)(lds + DS_HIST) + w * 256;
  float* PW = (float*)(lds + DS_PW) + w * 1024;
  half_t* QS = (half_t*)(lds + DS_PW + 16384) + w * 512;
  for (int rep_sel = 0; rep_sel < REP_SEL; ++rep_sel) {
  __syncthreads();
  if (tid < 32) { cnt[tid] = 0; thr[tid] = -INFINITY; }
  if (tid < 128) wq[tid] = IW[(size_t)t0 * 4 + tid];
  __syncthreads();
  h8 aq[4][4];
#pragma unroll
  for (int h = 0; h < 4; ++h)
#pragma unroll
    for (int ks = 0; ks < 4; ++ks)
      aq[h][ks] = *(const h8*)(P + (size_t)(t0 + (l & 31)) * PP + C_IDXQ + h * 64 + ks * 16 + (l >> 5) * 8);
  const int nt = qb + 1;
  const int nr = (nt + 3) >> 2;
  f4v wqv[16];
#pragma unroll
  for (int r = 0; r < 16; ++r) wqv[r] = *(const f4v*)(wq + crow(r, l) * 4);
  float thv[16];
  { float ninf = -INFINITY; asm volatile("" : "+v"(ninf));
#pragma unroll
  for (int r = 0; r < 16; ++r) thv[r] = ninf; }
  h8 bk[4];
  {
    const int k0 = (w < nt) ? w : 0;
#pragma unroll
    for (int ks = 0; ks < 4; ++ks)
      bk[ks] = *(const h8*)(P + (size_t)(k0 * 32 + (l & 31)) * PP + C_IDXK + ks * 16 + (l >> 5) * 8);
  }
#pragma unroll 1
  for (int rd = 0; rd < nr; ++rd) {
    const int kt = 4 * rd + w;
    h8 bkn[4];
    {
      const int kn = (kt + 4 < nt) ? (kt + 4) : 0;
#pragma unroll
      for (int ks = 0; ks < 4; ++ks)
        bkn[ks] = *(const h8*)(P + (size_t)(kn * 32 + (l & 31)) * PP + C_IDXK + ks * 16 + (l >> 5) * 8);
    }
    if (kt < nt) {
      const int sbase = kt * 32;
      f16v acc[4];
#pragma unroll
      for (int h = 0; h < 4; ++h) {
#pragma unroll
        for (int r = 0; r < 16; ++r) acc[h][r] = ozero();
#pragma unroll
        for (int ks = 0; ks < 4; ++ks) acc[h] = mfma16(aq[h][ks], bk[ks], acc[h]);
      }
      const int s = sbase + (l & 31);
      float scv[16];
      unsigned pm = 0;
#pragma unroll
      for (int r = 0; r < 16; ++r) {
        const int m = crow(r, l);
        const f4v wv = wqv[r];
        float sc = wv[0] * relu_f(acc[0][r]) + wv[1] * relu_f(acc[1][r]) + wv[2] * relu_f(acc[2][r]) + wv[3] * relu_f(acc[3][r]);
        sc += 0.0f;
        scv[r] = sc;
      }
      if (kt == qb) {
#pragma unroll
        for (int r = 0; r < 16; ++r) if (s > t0 + crow(r, l)) scv[r] = -INFINITY;
      }
#pragma unroll
      for (int r = 0; r < 16; ++r) pm |= (scv[r] > thv[r]) ? (1u << r) : 0u;
      if (__ballot(pm != 0u) != 0ull) {
        unsigned long long mks[16];
        int mycnt = 0;
#pragma unroll
        for (int r = 0; r < 16; ++r) {
          const unsigned long long mk = __ballot(((pm >> r) & 1u) != 0u);
          mks[r] = mk;
          const unsigned hm = (l < 32) ? (unsigned)mk : (unsigned)(mk >> 32);
          if ((l & 31) == r) mycnt = __popc(hm);
        }
        int base = 0;
        if ((l & 31) < 16 && mycnt > 0) base = atomicAdd(&cnt[crow(l & 31, l)], mycnt);
#pragma unroll
        for (int r = 0; r < 16; ++r) {
          const unsigned long long mk = mks[r];
          if (mk != 0ull) {
            const unsigned hm = (l < 32) ? (unsigned)mk : (unsigned)(mk >> 32);
            const int b_lo = __builtin_amdgcn_readlane(base, r), b_hi = __builtin_amdgcn_readlane(base, 32 + r);
            const int bb = (l < 32) ? b_lo : b_hi;
            if ((pm >> r) & 1u) {
              const int m = crow(r, l);
              const int slot = bb + __popc(hm & ((1u << (l & 31)) - 1u));
              LS[m * DS_CAP + slot] = scv[r];
              LI[m * DS_CAP + slot] = (unsigned short)s;
            }
          }
        }
      }
    }
    __syncthreads();
    bool any_prune;
    {
      const int cv = (l < 32) ? cnt[l] : 0;
      unsigned pmask = (unsigned)__ballot(cv > DS_PRUNE_AT);
      any_prune = pmask != 0u;
      int j = 0;
      while (pmask != 0u) {
        const int m = __ffs((int)pmask) - 1;
        pmask &= pmask - 1u;
        if ((j & 3) == w) dsa_prune(LS + m * DS_CAP, LI + m * DS_CAP, cnt[m], hist, cnt + m, thr + m, l);
        ++j;
      }
    }
    __syncthreads();
    if (any_prune) {
#pragma unroll
      for (int r = 0; r < 16; ++r) thv[r] = thr[crow(r, l)];
    }
#pragma unroll
    for (int ks = 0; ks < 4; ++ks) bk[ks] = bkn[ks];
  }
  }
#pragma unroll 1
  for (int mm = 0; mm < 8; ++mm) {
    const int m = w * 8 + mm;
    const int c = cnt[m];
    if (c > 256) dsa_prune(LS + m * DS_CAP, LI + m * DS_CAP, c, hist, cnt + m, thr + m, l);
  }
  asm volatile("s_waitcnt lgkmcnt(0)" ::: "memory");
  for (int rep_att = 0; rep_att < REP_ATT; ++rep_att) {
  h8 kvr[4][8];
  {
    const int m = w * 8;
    const int c = min(cnt[m], 256);
    const unsigned short* LIm = LI + m * DS_CAP;
#pragma unroll
    for (int kk = 0; kk < 4; ++kk) {
      const int e = l + 64 * kk;
      const int s = (e < c) ? (int)LIm[e] : 0;
      const half_t* kr = P + (size_t)s * PP + C_DSAK;
#pragma unroll
      for (int ch = 0; ch < 8; ++ch) kvr[kk][ch] = *(const h8*)(kr + ch * 8);
    }
  }
  h8 qreg = *(const h8*)(P + (size_t)(t0 + w * 8) * PP + C_DSAQ + l * 8);
  const int dch = l & 7, ksub = l >> 3;
#pragma unroll 1
  for (int u = 0; u < 16; ++u) {
    const int mm = u >> 1, g = u & 1;
    const int m = w * 8 + mm;
    const int t = t0 + m;
    const int c = min(cnt[m], 256);
    const unsigned short* LIm = LI + m * DS_CAP;
    if (g == 0) {
      *(h8*)(QS + l * 8) = qreg;
      const int mq = (mm < 7) ? (m + 1) : m;
      qreg = *(const h8*)(P + (size_t)(t0 + mq) * PP + C_DSAQ + l * 8);
    }
    h8 gt[4];
#pragma unroll
    for (int hh = 0; hh < 4; ++hh) gt[hh] = *(const h8*)(P + (size_t)t * PP + C_DSAG + (g * 4 + hh) * 64 + dch * 8);
    h8 vv[16];
#pragma unroll
    for (int i = 0; i < 16; ++i) {
      const int e = i * 8 + ksub;
      const int s = (e < c) ? (int)LIm[e] : 0;
      vv[i] = *(const h8*)(P + (size_t)s * PP + C_DSAV + g * 64 + dch * 8);
    }
    asm volatile("s_waitcnt lgkmcnt(0)" ::: "memory");
    float lg[4][4];
#pragma unroll
    for (int hh = 0; hh < 4; ++hh) {
#pragma unroll
      for (int kk = 0; kk < 4; ++kk) lg[hh][kk] = ozero();
#pragma unroll
      for (int ch = 0; ch < 8; ++ch) {
        const h8 qq = *(const h8*)(QS + (g * 4 + hh) * 64 + ch * 8);
#pragma unroll
        for (int kk = 0; kk < 4; ++kk) {
          float a = lg[hh][kk];
          a = __builtin_amdgcn_fdot2(__builtin_shufflevector(qq, qq, 0, 1), __builtin_shufflevector(kvr[kk][ch], kvr[kk][ch], 0, 1), a, false);
          a = __builtin_amdgcn_fdot2(__builtin_shufflevector(qq, qq, 2, 3), __builtin_shufflevector(kvr[kk][ch], kvr[kk][ch], 2, 3), a, false);
          a = __builtin_amdgcn_fdot2(__builtin_shufflevector(qq, qq, 4, 5), __builtin_shufflevector(kvr[kk][ch], kvr[kk][ch], 4, 5), a, false);
          a = __builtin_amdgcn_fdot2(__builtin_shufflevector(qq, qq, 6, 7), __builtin_shufflevector(kvr[kk][ch], kvr[kk][ch], 6, 7), a, false);
          lg[hh][kk] = a;
        }
      }
#pragma unroll
      for (int kk = 0; kk < 4; ++kk) lg[hh][kk] = (l + 64 * kk < c) ? lg[hh][kk] : -INFINITY;
    }
    {
      const int un = (u < 15) ? (u + 1) : 15;
      const int mn = w * 8 + (un >> 1), gn = un & 1;
      const int cn = min(cnt[mn], 256);
      const unsigned short* LIn = LI + mn * DS_CAP;
#pragma unroll
      for (int kk = 0; kk < 4; ++kk) {
        const int e = l + 64 * kk;
        const int s = (e < cn) ? (int)LIn[e] : 0;
        const half_t* kr = P + (size_t)s * PP + C_DSAK + gn * 64;
#pragma unroll
        for (int ch = 0; ch < 8; ++ch) kvr[kk][ch] = *(const h8*)(kr + ch * 8);
      }
    }
#pragma unroll
    for (int hh = 0; hh < 4; ++hh) {
      float mx = fmaxf(fmaxf(lg[hh][0], lg[hh][1]), fmaxf(lg[hh][2], lg[hh][3]));
      mx = wave_max(mx);
      float ev[4]; float sm = 0.f;
#pragma unroll
      for (int kk = 0; kk < 4; ++kk) { ev[kk] = __expf(lg[hh][kk] - mx); sm += ev[kk]; }
      sm = wave_sum(sm);
      const float inv = 1.0f / sm;
#pragma unroll
      for (int kk = 0; kk < 4; ++kk) PW[(l + 64 * kk) * 4 + hh] = ev[kk] * inv;
    }
    asm volatile("s_waitcnt lgkmcnt(0)" ::: "memory");
    float o[4][8];
#pragma unroll
    for (int hh = 0; hh < 4; ++hh)
#pragma unroll
      for (int q = 0; q < 8; ++q) o[hh][q] = ozero();
    const int nit = (c + 7) >> 3;
#pragma unroll 1
    for (int it0 = 0; it0 < nit; it0 += 16) {
      if (it0 > 0) {
#pragma unroll
        for (int i = 0; i < 16; ++i) {
          const int e = (it0 + i) * 8 + ksub;
          const int s = (e < c) ? (int)LIm[e] : 0;
          vv[i] = *(const h8*)(P + (size_t)s * PP + C_DSAV + g * 64 + dch * 8);
        }
      }
#pragma unroll
      for (int i = 0; i < 16; ++i) {
        const int e = (it0 + i) * 8 + ksub;
        const f4v pv = *(const f4v*)(PW + e * 4);
#pragma unroll
        for (int hh = 0; hh < 4; ++hh)
#pragma unroll
          for (int q = 0; q < 8; ++q) o[hh][q] += pv[hh] * (float)vv[i][q];
      }
    }
#pragma unroll
    for (int hh = 0; hh < 4; ++hh)
#pragma unroll
      for (int q = 0; q < 8; ++q) {
        float v = o[hh][q];
        v += dppf<0x128>(v); v += xor16f(v); v += xor32f(v);
        o[hh][q] = v;
      }
    if (l < 8) {
#pragma unroll
      for (int hh = 0; hh < 4; ++hh) {
        const int col = (g * 4 + hh) * 64 + dch * 8;
        h8 ov;
#pragma unroll
        for (int q = 0; q < 8; ++q) ov[q] = (half_t)(o[hh][q] * (float)gt[hh][q]);
        *(h8*)(BR + (size_t)t * 1536 + 512 + col) = ov;
      }
    }
    asm volatile("s_waitcnt lgkmcnt(0)" ::: "memory");
  }
  }
}

__device__ void phase_B(const Params& p, int layer, unsigned char* lds) {
  const int G = gridDim.x;
  for (int j = 0; j * G < 512; ++j) {
    const int b = (j & 1) ? (G - 1 - (int)blockIdx.x) : (int)blockIdx.x;
    const int idx = j * G + b;
#ifndef NO_DSA
    if (idx < 512) dsa_item(p, 511 - idx, lds);
#endif
  }
  for (int rep = 0; rep < REP_KV; ++rep)
  for (int it = blockIdx.x; it < 2048; it += G) la_item_kv(p, layer, it, lds);
}

__device__ void phase_E1(const Params& p, int layer, unsigned char* lds, int my_xcc, int my_loc, const unsigned* xcnt) {
  const int tid = otid(), w = tid >> 6, l = tid & 63;
  const half_t* BR = (const half_t*)(p.ws + OFF_BR);
  const half_t* WbrT = (const half_t*)(p.ws + OFF_WBRT) + (size_t)layer * 3 * 1024 * WBP;
  const half_t* P = (const half_t*)(p.ws + OFF_P);
  half_t* Y1 = (half_t*)(p.ws + OFF_H);
  const int wm = w >> 1, wn = w & 1;
  float* E = (float*)(lds + GEMM_EOFF) + w * (32 * EP);
  const int prow = l >> 3, c0 = (l & 7) * 8;
  const int nx = xcc_census(xcnt, my_xcc);
  const int nrounds = (nx > 0) ? (64 + nx - 1) / nx : (512 + (int)gridDim.x - 1) / (int)gridDim.x;
  for (int rnd = 0; rnd < nrounds; ++rnd) {
    int mt, nt;
    if (nx > 0) {
      const int s = my_loc + nx * rnd;
      if (s >= 64) continue;
      mt = my_xcc * 8 + (s & 7); nt = s >> 3;
    } else {
      const int tix = rnd * (int)gridDim.x + (int)blockIdx.x;
      if (tix >= 512) continue;
      mt = tix & 63; nt = tix >> 6;
    }
    h8 tot[4][4];
#pragma unroll
    for (int i = 0; i < 4; ++i)
#pragma unroll
      for (int ps = 0; ps < 4; ++ps)
#pragma unroll
        for (int q = 0; q < 8; ++q) tot[i][ps][q] = (half_t)ozero();
    const int m0w = mt * 256 + wm * 128;
    const int n0 = nt * 128 + wn * 64 + c0;
#pragma unroll 1
    for (int b = 0; b < 3; ++b) {
      f16v acc[4][2];
      zero_acc<2>(acc);
      gemm_kloop<2>(acc, BR + (size_t)mt * 256 * 1536 + b * 512, 1536, WbrT + (size_t)b * 1024 * WBP + (size_t)nt * 128 * WBP, WBP, 512, lds);
#pragma unroll
      for (int i = 0; i < 4; ++i) {
        stage_pair(E, acc[i][0], acc[i][1], l);
#pragma unroll
        for (int ps = 0; ps < 4; ++ps) {
          const int rl = ps * 8 + prow;
          const int row = m0w + i * 32 + rl;
          const h8 g = *(const h8*)(P + (size_t)row * PP + C_MRG + b * 1024 + n0);
          float ev[8];
          ld8(E + rl * EP + c0, ev);
#pragma unroll
          for (int q = 0; q < 8; ++q) tot[i][ps][q] = (half_t)((float)tot[i][ps][q] + (float)g[q] * ev[q]);
        }
      }
    }
#pragma unroll
    for (int i = 0; i < 4; ++i)
#pragma unroll
      for (int ps = 0; ps < 4; ++ps) {
        const int row = m0w + i * 32 + ps * 8 + prow;
        *(h8*)(Y1 + (size_t)row * HP + n0) = tot[i][ps];
      }
  }
}

__device__ void phase_E2(const Params& p, int layer, unsigned char* lds, int my_xcc, int my_loc, const unsigned* xcnt) {
  const int tid = otid(), w = tid >> 6, l = tid & 63;
  const half_t* Y1 = (const half_t*)(p.ws + OFF_H);
  const half_t* Wo = (const half_t*)(p.ws + OFF_WOUTT) + (size_t)layer * 1024 * WP;
  float* Y = (float*)(p.ws + OFF_ST);
  const int wm = w >> 1, wn = w & 1;
  const int nx = xcc_census(xcnt, my_xcc);
  const int nrounds = (nx > 0) ? (64 + nx - 1) / nx : (512 + (int)gridDim.x - 1) / (int)gridDim.x;
  for (int rnd = 0; rnd < nrounds; ++rnd) {
    int mt, nt;
    if (nx > 0) {
      const int s = my_loc + nx * rnd;
      if (s >= 64) continue;
      mt = my_xcc * 8 + (s & 7); nt = s >> 3;
    } else {
      const int tix = rnd * (int)gridDim.x + (int)blockIdx.x;
      if (tix >= 512) continue;
      mt = tix & 63; nt = tix >> 6;
    }
    f16v acc[4][2];
    zero_acc<2>(acc);
    gemm_kloop<2>(acc, Y1 + (size_t)mt * 256 * HP, HP, Wo + (size_t)nt * 128 * WP, WP, 1024, lds);
    const int m0w = mt * 256 + wm * 128;
    const int n0w = nt * 128 + wn * 64;
#pragma unroll
    for (int i = 0; i < 4; ++i)
#pragma unroll
      for (int j = 0; j < 2; ++j)
#pragma unroll
        for (int r = 0; r < 16; ++r) {
          const int row = m0w + i * 32 + crow(r, l);
          const int n = n0w + j * 32 + (l & 31);
          Y[(size_t)row * 1024 + n] = acc[i][j][r];
        }
  }
}

__device__ void phase_E3(const Params& p, int layer) {
  const int w = otid() >> 6, l = otid() & 63;
  const float* Y = (const float*)(p.ws + OFF_ST);
  const float* MOD = (const float*)(p.ws + OFF_MOD);
  half_t* H = (half_t*)(p.ws + OFF_H);
  const float* xin = (layer == 0) ? p.x : p.out;
  const float* gate = MOD + layer * 3072 + 2048;
  const float* post = p.post_norm + layer * 1024;
  const int stride = gridDim.x * 4;
  int row = blockIdx.x * 4 + w;
  f4v yn[4], xn[4];
  if (row < S_LEN) {
#pragma unroll
    for (int i = 0; i < 4; ++i) {
      yn[i] = *(const f4v*)(Y + (size_t)row * 1024 + i * 256 + l * 4);
      xn[i] = *(const f4v*)(xin + (size_t)row * 1024 + i * 256 + l * 4);
    }
  }
  for (; row < S_LEN; row += stride) {
    float yv[16], xv[16];
    float ss = 0.f;
#pragma unroll
    for (int i = 0; i < 4; ++i)
#pragma unroll
      for (int q = 0; q < 4; ++q) { yv[i * 4 + q] = yn[i][q]; xv[i * 4 + q] = xn[i][q]; ss += yn[i][q] * yn[i][q]; }
    const int nrow = (row + stride < S_LEN) ? (row + stride) : row;
#pragma unroll
    for (int i = 0; i < 4; ++i) {
      yn[i] = *(const f4v*)(Y + (size_t)nrow * 1024 + i * 256 + l * 4);
      xn[i] = *(const f4v*)(xin + (size_t)nrow * 1024 + i * 256 + l * 4);
    }
    ss = wave_sum(ss);
    const float rs = rsqrtf(ss * (1.0f / 1024.0f) + 1e-6f);
#pragma unroll
    for (int i = 0; i < 4; ++i) {
      const int c0 = i * 256 + l * 4;
      f4v gt = *(const f4v*)(gate + c0);
      f4v pn = *(const f4v*)(post + c0);
      f4v o;
#pragma unroll
      for (int q = 0; q < 4; ++q) { o[q] = xv[i * 4 + q] + gt[q] * (yv[i * 4 + q] * rs * pn[q]); xv[i * 4 + q] = o[q]; }
      *(f4v*)(p.out + (size_t)row * 1024 + c0) = o;
    }
    if (layer + 1 < DEPTH)
      write_h_row(xv, p.pre_norm + (layer + 1) * 1024, MOD + (layer + 1) * 3072, H + (size_t)row * HP, l);
  }
}

#define XB_TMO      128
#define XB_XCNT(j)  (256  + 64 * (j))
#define XB_XSUB(j)  (1280 + 64 * (j))
#define XB_XGEN(j)  (2304 + 64 * (j))
#define XB_TOP      3328
#define XB_TOPGEN   3392
#define XCD_BAR_WORDS 3456
#define XB_SPIN_CAP (1u << 18)
#define LAS __attribute__((address_space(3)))

__device__ __forceinline__ unsigned xb_ld(unsigned* p)              { return __hip_atomic_load(p, __ATOMIC_RELAXED, __HIP_MEMORY_SCOPE_AGENT); }
__device__ __forceinline__ unsigned xb_add(unsigned* p, unsigned v) { return __hip_atomic_fetch_add(p, v, __ATOMIC_RELAXED, __HIP_MEMORY_SCOPE_AGENT); }
__device__ __forceinline__ unsigned xb_xcc_id() { return (unsigned)__builtin_amdgcn_s_getreg((3 << 11) | 20) & 0xFu; }
#define XB_SPIN(cond, bar) do { unsigned _sp = 0; while (cond) { __builtin_amdgcn_s_sleep(1); \
    if ((++_sp & 255u) == 0u) { if (xb_ld(&(bar)[XB_TMO])) break; if (_sp > XB_SPIN_CAP) { atomicAdd(&(bar)[XB_TMO], 1u); break; } } } } while (0)

struct XcdBarrier {
    unsigned* bar; unsigned x;
    volatile LAS unsigned* st;
};

__device__ __forceinline__ XcdBarrier xcd_barrier_post(unsigned* bar, volatile LAS unsigned* st) {
    XcdBarrier b; b.bar = bar; b.x = xb_xcc_id(); b.st = st;
    if (otid() == 0) (void)xb_add(&bar[XB_XCNT(b.x)], 1u);
    return b;
}
__device__ __forceinline__ void xcd_barrier_complete(unsigned* bar, unsigned x, unsigned& nloc, unsigned& nx) {
    const unsigned G = gridDim.x * gridDim.y * gridDim.z;
    unsigned sum, cnt, mine, sp = 0u;
    for (;;) {
        sum = 0u; cnt = 0u; mine = 0u;
#pragma unroll
        for (unsigned j = 0; j < 16; ++j) { const unsigned c = xb_ld(&bar[XB_XCNT(j)]); sum += c; cnt += (c > 0u) ? 1u : 0u; mine = (j == x) ? c : mine; }
        if (sum == G) break;
        __builtin_amdgcn_s_sleep(1);
        if ((++sp & 255u) == 0u) { if (xb_ld(&bar[XB_TMO])) break; if (sp > XB_SPIN_CAP) { atomicAdd(&bar[XB_TMO], 1u); break; } }
    }
    nloc = mine > 0u ? mine : 1u; nx = cnt > 0u ? cnt : 1u;
}

__device__ __forceinline__ void xcd_barrier(const XcdBarrier& b) {
    asm volatile("s_waitcnt vmcnt(0)" ::: "memory");
    __syncthreads();
    if (otid() == 0) {
        unsigned* bar = b.bar;
        __builtin_amdgcn_s_waitcnt(0);
        unsigned nloc = b.st[0], nx = b.st[1];
        if (nloc == 0u) { xcd_barrier_complete(bar, b.x, nloc, nx); b.st[0] = nloc; b.st[1] = nx; }
        const unsigned old = xb_add(&bar[XB_XSUB(b.x)], 1u);
        const unsigned gen = old / nloc;
        if (old + 1u == (gen + 1u) * nloc) {
            __builtin_amdgcn_fence(__ATOMIC_RELEASE, "agent");
            asm volatile("s_waitcnt vmcnt(0)" ::: "memory");
            const unsigned og = xb_add(&bar[XB_TOP], 1u);
            const unsigned tg = og / nx;
            if (og + 1u == (tg + 1u) * nx) xb_add(&bar[XB_TOPGEN], 1u);
            else XB_SPIN(xb_ld(&bar[XB_TOPGEN]) == tg, bar);
            __builtin_amdgcn_fence(__ATOMIC_ACQUIRE, "agent");
            xb_add(&bar[XB_XGEN(b.x)], 1u);
            asm volatile("s_waitcnt vmcnt(0)" ::: "memory");
        } else {
            XB_SPIN(xb_ld(&bar[XB_XGEN(b.x)]) == gen, bar);
            __builtin_amdgcn_fence(__ATOMIC_ACQUIRE, "agent");
            asm volatile("s_waitcnt vmcnt(0)" ::: "memory");
        }
    }
    __syncthreads();
}


};

#ifndef REP_D
#define REP_D 1
#endif
#ifndef REP_E
#define REP_E 1
#endif
#ifndef REP_A
#define REP_A 1
#endif
#ifndef REP_B
#define REP_B 1
#endif
#ifdef ONLY_PHASE
#define PH_EN(x) (ONLY_PHASE == (x))
#else
#define PH_EN(x) true
#endif
__global__ void __launch_bounds__(NTHREADS) fwd_megakernel(Params p) {
  extern __shared__ __attribute__((aligned(16))) unsigned char lds[];
  cg::grid_group grid = cg::this_grid();
  K k; k.wbase = __builtin_amdgcn_readfirstlane((int)__builtin_amdgcn_workitem_id_x()) & ~63;
  unsigned* bar = (unsigned*)(p.ws + WS_END);
  unsigned* xcnt = bar + 16;
  unsigned* xbar = (unsigned*)(p.ws + WS_END + 1024);
  if (blockIdx.x == 0) {
    if (k.otid() < 17) __hip_atomic_store(bar + (k.otid() == 16 ? 0 : 16 + k.otid()), 0u, __ATOMIC_RELAXED, __HIP_MEMORY_SCOPE_AGENT);
    for (int i = k.otid(); i < XCD_BAR_WORDS; i += NTHREADS) __hip_atomic_store(xbar + i, 0u, __ATOMIC_RELAXED, __HIP_MEMORY_SCOPE_AGENT);
  }
  volatile LAS unsigned* xst = (volatile LAS unsigned*)(lds + LDS_BYTES - 16);
  if (k.otid() == 0) { xst[0] = 0u; xst[1] = 0u; }
  __syncthreads();
  K::XcdBarrier xb; xb.bar = xbar; xb.x = 0; xb.st = xst;
  int my_xcc = 0, my_loc = 0;
  for (int ph = p.ph_lo; ph < p.ph_hi; ++ph) {
    if (ph == 0) { if (PH_EN(0)) for (int rep = 0; rep < REP_P; ++rep) { k.phase_prologue(p, lds); __syncthreads(); } }
    else if (ph == 1) {
      xb = k.xcd_barrier_post(xbar, xst);
      int* sh = (int*)lds;
      if (k.otid() == 0) {
        const int xc = (int)(__builtin_amdgcn_s_getreg((3 << 11) | 20) & 0xFu);
        sh[0] = xc;
        sh[1] = (int)__hip_atomic_fetch_add(xcnt + xc, 1u, __ATOMIC_RELAXED, __HIP_MEMORY_SCOPE_AGENT);
      }
      __syncthreads();
      my_xcc = __builtin_amdgcn_readfirstlane(sh[0]);
      my_loc = __builtin_amdgcn_readfirstlane(sh[1]);
      __syncthreads();
      if (PH_EN(1)) k.phase_h0(p);
    }
    else {
      const int layer = (ph - 2) / 7, sub = (ph - 2) % 7;
      if (sub == 0) { if (PH_EN(2)) for (int rep = 0; rep < REP_A; ++rep) { k.phase_A(p, layer, lds, my_xcc, my_loc, xcnt); __syncthreads(); } }
      else if (sub == 1) { if (PH_EN(3)) for (int rep = 0; rep < REP_B; ++rep) { k.phase_B(p, layer, lds); __syncthreads(); } }
      else if (sub == 2) { if (PH_EN(4)) k.phase_scan(p); }
      else if (sub == 3) { if (PH_EN(5)) for (int rep = 0; rep < REP_D; ++rep) { for (int it = blockIdx.x; it < 2048; it += gridDim.x) k.la_item_out(p, layer, it, lds); __syncthreads(); } }
      else if (sub == 4) { if (PH_EN(6)) for (int rep = 0; rep < REP_E; ++rep) { k.phase_E1(p, layer, lds, my_xcc, my_loc, xcnt); __syncthreads(); } }
      else if (sub == 5) { if (PH_EN(7)) for (int rep = 0; rep < REP_E; ++rep) { k.phase_E2(p, layer, lds, my_xcc, my_loc, xcnt); __syncthreads(); } }
      else { if (PH_EN(8)) k.phase_E3(p, layer); }
    }
    if (ph + 1 < p.ph_hi) {
      if (ph == p.ph_lo) grid.sync();
      else k.xcd_barrier(xb);
    }
  }
}

extern "C" void kernel_launch(void* const* d_in, const int* in_sizes, int n_in, void* d_out, int out_size,
                              void* d_ws, size_t ws_size, hipStream_t stream) {
  static int grid_blocks = 0;
  if (!grid_blocks) {
    int dev = 0, cus = 0, per_cu = 0;
    hipGetDevice(&dev);
    hipDeviceGetAttribute(&cus, hipDeviceAttributeMultiprocessorCount, dev);
    hipFuncSetAttribute((const void*)fwd_megakernel, hipFuncAttributeMaxDynamicSharedMemorySize, LDS_BYTES);
    hipOccupancyMaxActiveBlocksPerMultiprocessor(&per_cu, (const void*)fwd_megakernel, NTHREADS, LDS_BYTES);
    if (per_cu < 1) per_cu = 1;
    if (per_cu > 1) per_cu = 1;
    grid_blocks = cus * per_cu;
    if (ws_size < WS_END) fprintf(stderr, "workspace too small: %zu < %llu\n", ws_size, (unsigned long long)WS_END);
  }
  Params p{};
  p.x = (const float*)d_in[0]; p.c = (const float*)d_in[1]; p.pos = (const int*)d_in[2];
  p.ada_w = (const float*)d_in[3]; p.ada_b = (const float*)d_in[4];
  p.pre_norm = (const float*)d_in[5]; p.post_norm = (const float*)d_in[6];
  p.w_in = (const float*)d_in[7]; p.gla_w_lr = (const float*)d_in[8]; p.gla_b_lr = (const float*)d_in[9];
  p.w_br_ret = (const float*)d_in[10]; p.w_br_dsa = (const float*)d_in[11]; p.w_br_gla = (const float*)d_in[12];
  p.w_out = (const float*)d_in[13];
  p.out = (float*)d_out; p.ws = (unsigned char*)d_ws;
  p.ph_lo = 0; p.ph_hi = 2 + 7 * DEPTH;
  void* args[] = {&p};
  hipError_t e = hipLaunchCooperativeKernel((const void*)fwd_megakernel, dim3(grid_blocks), dim3(NTHREADS), args, LDS_BYTES, stream);
  if (e != hipSuccess) fprintf(stderr, "cooperative launch failed: %s (grid %d)\n", hipGetErrorString(e), grid_blocks);
}
```

```cpp
#include <hip/hip_runtime.h>
#include <hip/hip_cooperative_groups.h>
#include <stdint.h>
#include <cstdio>
namespace cg = cooperative_groups;
#ifndef REP_P
#define REP_P 1
#endif
#ifndef REP_KV
#define REP_KV 1
#endif
#ifndef REP_SEL
#define REP_SEL 1
#endif
#ifndef REP_ATT
#define REP_ATT 1
#endif

typedef _Float16 half_t;
typedef _Float16 h8 __attribute__((ext_vector_type(8)));
typedef _Float16 h4 __attribute__((ext_vector_type(4)));
typedef _Float16 h2 __attribute__((ext_vector_type(2)));
typedef float f16v __attribute__((ext_vector_type(16)));
typedef float f4v __attribute__((ext_vector_type(4)));

#define S_LEN 16384
#define DM 1024
#define NIN 7764
#define NPAD 7936
#define PP 7808
#define DEPTH 4
#define NTHREADS 256
#define HP 1088
#define WP 1088
#define WBP 576
#define LDS_BYTES 149504

#define C_RETQ 0
#define C_RETK 256
#define C_RETV 512
#define C_RETG 1024
#define C_DSAQ 1536
#define C_DSAK 2048
#define C_DSAV 2176
#define C_DSAG 2304
#define C_IDXQ 2816
#define C_IDXK 3072
#define C_GLAQ 3136
#define C_GLAK 3392
#define C_GLAV 3648
#define C_GLAG 4160
#define C_GLAA 4672
#define C_MRG 4688
#define C_END 7760
#define C_IDXW 7760

#define OFF_WINT 0ull
#define OFF_WBRT (OFF_WINT + 4ull * NPAD * WP * 2)
#define OFF_WOUTT (OFF_WBRT + 4ull * 3 * 1024 * WBP * 2)
#define OFF_MOD (OFF_WOUTT + 4ull * 1024 * WP * 2)
#define OFF_RT (OFF_MOD + 4ull * 3072 * 4)
#define OFF_DT (OFF_RT + 16384ull * 64 * 4)
#define OFF_H (OFF_DT + 16384ull * 16 * 4)
#define OFF_P (OFF_H + 16384ull * HP * 2)
#define OFF_GA (OFF_P + 16384ull * PP * 2)
#define OFF_IW (OFF_GA + 16384ull * 16 * 4)
#define OFF_ST (OFF_IW + 16384ull * 4 * 4)
#define OFF_DEC (OFF_ST + 256ull * 65536 * 4)
#define OFF_BR (OFF_DEC + 256ull * 8 * 64 * 4)
#define WS_END (OFF_BR + 16384ull * 1536 * 2)
static_assert(WS_END + 16384 <= 508821504ull, "workspace too large");

struct Params {
  const float* x; const float* c; const int* pos; const float* ada_w; const float* ada_b;
  const float* pre_norm; const float* post_norm; const float* w_in; const float* gla_w_lr;
  const float* gla_b_lr; const float* w_br_ret; const float* w_br_dsa; const float* w_br_gla;
  const float* w_out; float* out; unsigned char* ws;
  int ph_lo; int ph_hi;
};

struct K {
int wbase;
__device__ __forceinline__ int otid() const {
  int lane;
  asm volatile("v_mbcnt_lo_u32_b32 %0, -1, 0\n\tv_mbcnt_hi_u32_b32 %0, -1, %0" : "=v"(lane));
  return wbase | lane;
}
__device__ __forceinline__ static float ozero() { float z = 0.f; asm volatile("" : "+v"(z)); return z; }
template <int CTRL>
__device__ __forceinline__ float dppf(float v) {
  return __int_as_float(__builtin_amdgcn_update_dpp(0, __float_as_int(v), CTRL, 0xF, 0xF, true));
}
template <int CTRL>
__device__ __forceinline__ unsigned dppu(unsigned v) {
  return (unsigned)__builtin_amdgcn_update_dpp(0, (int)v, CTRL, 0xF, 0xF, true);
}
__device__ __forceinline__ int olane() { return otid() & 63; }
__device__ __forceinline__ float xor16f(float v) { return __int_as_float(__builtin_amdgcn_ds_bpermute((olane() ^ 16) << 2, __float_as_int(v))); }
__device__ __forceinline__ float xor32f(float v) { return __int_as_float(__builtin_amdgcn_ds_bpermute((olane() ^ 32) << 2, __float_as_int(v))); }
__device__ __forceinline__ unsigned xor16u(unsigned v) { return (unsigned)__builtin_amdgcn_ds_bpermute((olane() ^ 16) << 2, (int)v); }
__device__ __forceinline__ unsigned xor32u(unsigned v) { return (unsigned)__builtin_amdgcn_ds_bpermute((olane() ^ 32) << 2, (int)v); }
__device__ __forceinline__ float rl_f(float v, int lane) { return __int_as_float(__builtin_amdgcn_readlane(__float_as_int(v), lane)); }
__device__ __forceinline__ float wave_sum(float v) {
  v += dppf<0xB1>(v); v += dppf<0x4E>(v); v += dppf<0x141>(v); v += dppf<0x140>(v);
  return (rl_f(v, 0) + rl_f(v, 16)) + (rl_f(v, 32) + rl_f(v, 48));
}
__device__ __forceinline__ float wave_max(float v) {
  v = fmaxf(v, dppf<0xB1>(v)); v = fmaxf(v, dppf<0x4E>(v)); v = fmaxf(v, dppf<0x141>(v)); v = fmaxf(v, dppf<0x140>(v));
  return fmaxf(fmaxf(rl_f(v, 0), rl_f(v, 16)), fmaxf(rl_f(v, 32), rl_f(v, 48)));
}
__device__ __forceinline__ unsigned wave_or(unsigned v) {
  v |= dppu<0xB1>(v); v |= dppu<0x4E>(v); v |= dppu<0x141>(v); v |= dppu<0x140>(v);
  return (unsigned)(__builtin_amdgcn_readlane((int)v, 0) | __builtin_amdgcn_readlane((int)v, 16) | __builtin_amdgcn_readlane((int)v, 32) | __builtin_amdgcn_readlane((int)v, 48));
}
__device__ __forceinline__ unsigned wave_incl_scan(unsigned v) {
  v += (unsigned)__builtin_amdgcn_update_dpp(0, (int)v, 0x111, 0xF, 0xF, false);
  v += (unsigned)__builtin_amdgcn_update_dpp(0, (int)v, 0x112, 0xF, 0xF, false);
  v += (unsigned)__builtin_amdgcn_update_dpp(0, (int)v, 0x114, 0xF, 0xF, false);
  v += (unsigned)__builtin_amdgcn_update_dpp(0, (int)v, 0x118, 0xF, 0xF, false);
  v += (unsigned)__builtin_amdgcn_update_dpp(0, (int)v, 0x142, 0xA, 0xF, false);
  v += (unsigned)__builtin_amdgcn_update_dpp(0, (int)v, 0x143, 0xC, 0xF, false);
  return v;
}
__device__ __forceinline__ f16v mfma16(h8 a, h8 b, f16v c) {
  return __builtin_amdgcn_mfma_f32_32x32x16_f16(a, b, c, 0, 0, 0);
}
__device__ __forceinline__ float relu_f(float x) { return __int_as_float(max(__float_as_int(x), 0)); }
__device__ __forceinline__ int crow(int r, int l) { return (r & 3) + 8 * (r >> 2) + 4 * (l >> 5); }

__device__ __forceinline__ int win_col(int nv) {
  if (nv < 3136) return nv;
  if (nv < 7760) return nv + 4;
  if (nv < 7764) return nv - 7760 + 3136;
  return -1;
}
__device__ void transpose_tile(const float* __restrict__ src, int ldn, half_t* __restrict__ dst, int K,
                               int k0, int n0, int mapmode, unsigned char* lds) {
  float* T = (float*)lds;
  const int tid = otid();
  const int nn = tid & 63;
  int col = n0 + nn;
  if (mapmode) col = win_col(col);
#pragma unroll
  for (int i = 0; i < 16; ++i) {
    int kk = (tid >> 6) + 4 * i;
    float v = 0.f;
    if (col >= 0) v = src[(size_t)(k0 + kk) * ldn + col];
    T[kk * 65 + nn] = v;
  }
  __syncthreads();
#pragma unroll
  for (int i = 0; i < 2; ++i) {
    int n2 = (tid >> 3) + 32 * i;
    int kc = tid & 7;
    h8 o;
#pragma unroll
    for (int q = 0; q < 8; ++q) o[q] = (half_t)T[(kc * 8 + q) * 65 + n2];
    *(h8*)(dst + (size_t)(n0 + n2) * K + k0 + kc * 8) = o;
  }
  __syncthreads();
}

__device__ void phase_prologue(const Params& p, unsigned char* lds) {
  const int tid = otid();
  half_t* WinT = (half_t*)(p.ws + OFF_WINT);
  half_t* WbrT = (half_t*)(p.ws + OFF_WBRT);
  half_t* WoutT = (half_t*)(p.ws + OFF_WOUTT);
  float* MOD = (float*)(p.ws + OFF_MOD);
  float* RT = (float*)(p.ws + OFF_RT);
  float* DT = (float*)(p.ws + OFF_DT);
  const int T_WIN = 4 * 124 * 16;
  const int T_WBR = 12 * 16 * 8;
  const int T_WOUT = 4 * 16 * 16;
  const int T_MOD = 192;
  const int T_ROPE = 16384 * 40 / 256;
  const int total = T_WIN + T_WBR + T_WOUT + T_MOD + T_ROPE;
  {
    float* T = (float*)lds;
    const int nn = tid & 63;
    float cur[16], nxt[16];
    int task = blockIdx.x;
    if (task < T_WIN) {
      const int l = task / (124 * 16), r = task % (124 * 16), nt = r / 16, kt = r % 16;
      const int col = win_col(nt * 64 + nn);
      const float* src = p.w_in + (size_t)l * 1024 * NIN;
#pragma unroll
      for (int i = 0; i < 16; ++i) { const int kk = (tid >> 6) + 4 * i; cur[i] = (col >= 0) ? src[(size_t)(kt * 64 + kk) * NIN + col] : 0.f; }
    }
    for (; task < T_WIN; task += gridDim.x) {
      const int tn = (task + (int)gridDim.x < T_WIN) ? task + (int)gridDim.x : task;
      {
        const int l = tn / (124 * 16), r = tn % (124 * 16), nt = r / 16, kt = r % 16;
        const int col = win_col(nt * 64 + nn);
        const float* src = p.w_in + (size_t)l * 1024 * NIN;
#pragma unroll
        for (int i = 0; i < 16; ++i) { const int kk = (tid >> 6) + 4 * i; nxt[i] = (col >= 0) ? src[(size_t)(kt * 64 + kk) * NIN + col] : 0.f; }
      }
      const int l = task / (124 * 16), r = task % (124 * 16), nt = r / 16, kt = r % 16;
      half_t* dst = WinT + (size_t)l * NPAD * WP;
#pragma unroll
      for (int i = 0; i < 16; ++i) T[((tid >> 6) + 4 * i) * 65 + nn] = cur[i];
      __syncthreads();
#pragma unroll
      for (int i = 0; i < 2; ++i) {
        const int n2 = (tid >> 3) + 32 * i, kc = tid & 7;
        h8 o;
#pragma unroll
        for (int q = 0; q < 8; ++q) o[q] = (half_t)T[(kc * 8 + q) * 65 + n2];
        *(h8*)(dst + (size_t)(nt * 64 + n2) * WP + kt * 64 + kc * 8) = o;
      }
      __syncthreads();
#pragma unroll
      for (int i = 0; i < 16; ++i) cur[i] = nxt[i];
    }
  }
  for (int task = blockIdx.x; task < total; task += gridDim.x) {
    int t = task;
    if (t < T_WIN) continue;
    if (t < T_WIN) {
      int l = t / (124 * 16); int r = t % (124 * 16); int nt = r / 16, kt = r % 16;
      transpose_tile(p.w_in + (size_t)l * 1024 * NIN, NIN, WinT + (size_t)l * NPAD * WP, WP, kt * 64, nt * 64, 1, lds);
      continue;
    }
    t -= T_WIN;
    if (t < T_WBR) {
      int lb = t / 128; int r = t % 128; int nt = r / 8, kt = r % 8;
      int l = lb / 3, b = lb % 3;
      const float* src = (b == 0 ? p.w_br_ret : (b == 1 ? p.w_br_dsa : p.w_br_gla)) + (size_t)l * 512 * 1024;
      transpose_tile(src, 1024, WbrT + (size_t)lb * 1024 * WBP, WBP, kt * 64, nt * 64, 0, lds);
      continue;
    }
    t -= T_WBR;
    if (t < T_WOUT) {
      int l = t / 256; int r = t % 256; int nt = r / 16, kt = r % 16;
      transpose_tile(p.w_out + (size_t)l * 1024 * 1024, 1024, WoutT + (size_t)l * 1024 * WP, WP, kt * 64, nt * 64, 0, lds);
      continue;
    }
    t -= T_WOUT;
    if (t < T_MOD) {
      int l = t / 48, jb = t % 48;
      int j = jb * 64 + (tid & 63);
      int ig = tid >> 6;
      float acc = 0.f;
      const float* aw = p.ada_w + (size_t)l * 1024 * 3072;
      for (int i = ig * 256; i < ig * 256 + 256; ++i) {
        float cv = p.c[i];
        float sc = cv / (1.f + expf(-cv));
        acc += sc * aw[(size_t)i * 3072 + j];
      }
      float* red = (float*)lds;
      red[tid] = acc;
      __syncthreads();
      if (tid < 64) {
        float s = red[tid] + red[tid + 64] + red[tid + 128] + red[tid + 192];
        MOD[l * 3072 + j] = s + p.ada_b[l * 3072 + j];
      }
      __syncthreads();
      continue;
    }
    t -= T_MOD;
    {
      int e = t * 256 + tid;
      int tok = e / 40, f = e % 40;
      float pf = (float)p.pos[tok];
      if (f < 32) {
        float fr = powf(10000.0f, -(float)f * 2.0f / 64.0f);
        float ang = pf * fr;
        RT[tok * 64 + f * 2] = cosf(ang);
        RT[tok * 64 + f * 2 + 1] = sinf(ang);
      } else {
        int g = f - 32;
        float fr = powf(500000.0f, -(float)g * 2.0f / 16.0f);
        float ang = pf * fr;
        DT[tok * 16 + g * 2] = cosf(ang);
        DT[tok * 16 + g * 2 + 1] = sinf(ang);
      }
    }
  }
}

__device__ __forceinline__ void write_h_row(const float (&xv)[16], const float* __restrict__ pre,
                                            const float* __restrict__ mod, half_t* __restrict__ hrow, int l) {
  float ss = 0.f;
#pragma unroll
  for (int i = 0; i < 16; ++i) ss += xv[i] * xv[i];
  ss = wave_sum(ss);
  float rs = rsqrtf(ss * (1.0f / 1024.0f) + 1e-6f);
#pragma unroll
  for (int i = 0; i < 4; ++i) {
    int c0 = i * 256 + l * 4;
    f4v pg = *(const f4v*)(pre + c0);
    f4v sh = *(const f4v*)(mod + c0);
    f4v sc = *(const f4v*)(mod + 1024 + c0);
    h4 o;
#pragma unroll
    for (int q = 0; q < 4; ++q) o[q] = (half_t)(xv[i * 4 + q] * rs * pg[q] * (1.f + sc[q]) + sh[q]);
    *(h4*)(hrow + c0) = o;
  }
}

__device__ void phase_h0(const Params& p) {
  const int w = otid() >> 6, l = otid() & 63;
  half_t* H = (half_t*)(p.ws + OFF_H);
  const float* MOD = (const float*)(p.ws + OFF_MOD);
  for (int row = blockIdx.x * 4 + w; row < S_LEN; row += gridDim.x * 4) {
    float xv[16];
#pragma unroll
    for (int i = 0; i < 4; ++i) {
      f4v v = *(const f4v*)(p.x + (size_t)row * 1024 + i * 256 + l * 4);
      xv[i * 4] = v[0]; xv[i * 4 + 1] = v[1]; xv[i * 4 + 2] = v[2]; xv[i * 4 + 3] = v[3];
    }
    write_h_row(xv, p.pre_norm, MOD, H + (size_t)row * HP, l);
  }
}

__device__ __forceinline__ void lds_barrier() {
  asm volatile("s_waitcnt lgkmcnt(0)" ::: "memory");
  __builtin_amdgcn_s_barrier();
  asm volatile("" ::: "memory");
}
#define GEMM_BUF 55296
#define GEMM_EOFF 110592
template <int NT>
__device__ __forceinline__ void gemm_step(f16v (&acc)[4][NT], h8 (&ra)[8], h8 (&rb)[2 * NT],
                                          const unsigned char* As, const unsigned char* Bs, unsigned char* Aw, unsigned char* Bw,
                                          const half_t* __restrict__ A, int lda, const half_t* __restrict__ B, int ldb, int kload,
                                          int wm, int wn, int l, int r0, int kc) {
  h8 af[2][4], bf[2][NT];
#pragma unroll
  for (int i = 0; i < 4; ++i) af[0][i] = *(const h8*)(As + (wm * 128 + i * 32 + (l & 31)) * 144 + (l >> 5) * 16);
#pragma unroll
  for (int j = 0; j < NT; ++j) bf[0][j] = *(const h8*)(Bs + (wn * 32 * NT + j * 32 + (l & 31)) * 144 + (l >> 5) * 16);
#pragma unroll
  for (int ks = 0; ks < 4; ++ks) {
    if (ks < 3) {
#pragma unroll
      for (int i = 0; i < 4; ++i) af[(ks + 1) & 1][i] = *(const h8*)(As + (wm * 128 + i * 32 + (l & 31)) * 144 + (ks + 1) * 32 + (l >> 5) * 16);
#pragma unroll
      for (int j = 0; j < NT; ++j) bf[(ks + 1) & 1][j] = *(const h8*)(Bs + (wn * 32 * NT + j * 32 + (l & 31)) * 144 + (ks + 1) * 32 + (l >> 5) * 16);
    }
    __builtin_amdgcn_sched_barrier(0);
#pragma unroll
    for (int i = 0; i < 4; ++i)
#pragma unroll
      for (int j = 0; j < NT; ++j) acc[i][j] = mfma16(af[ks & 1][i], bf[ks & 1][j], acc[i][j]);
#pragma unroll
    for (int i = 2 * ks; i < 2 * ks + 2; ++i) {
      *(h8*)(Aw + (r0 + 32 * i) * 144 + kc * 16) = ra[i];
      ra[i] = *(const h8*)(A + (size_t)(r0 + 32 * i) * lda + kload + kc * 8);
    }
    if (NT == 2) {
      *(h8*)(Bw + (r0 + 32 * ks) * 144 + kc * 16) = rb[ks];
      rb[ks] = *(const h8*)(B + (size_t)(r0 + 32 * ks) * ldb + kload + kc * 8);
    } else {
#pragma unroll
      for (int i = 2 * ks; i < 2 * ks + 2; ++i) {
        *(h8*)(Bw + (r0 + 32 * i) * 144 + kc * 16) = rb[i];
        rb[i] = *(const h8*)(B + (size_t)(r0 + 32 * i) * ldb + kload + kc * 8);
      }
    }
    __builtin_amdgcn_sched_barrier(0);
  }
}
template <int NT>
__device__ __forceinline__ void gemm_issue(h8 (&ra0)[8], h8 (&rb0)[2 * NT], h8 (&ra1)[8], h8 (&rb1)[2 * NT],
                                           const half_t* __restrict__ A, int lda, const half_t* __restrict__ B, int ldb) {
  const int tid = otid();
  const int kc = tid & 7, r0 = tid >> 3;
#pragma unroll
  for (int i = 0; i < 8; ++i) ra0[i] = *(const h8*)(A + (size_t)(r0 + 32 * i) * lda + kc * 8);
#pragma unroll
  for (int i = 0; i < 2 * NT; ++i) rb0[i] = *(const h8*)(B + (size_t)(r0 + 32 * i) * ldb + kc * 8);
#pragma unroll
  for (int i = 0; i < 8; ++i) ra1[i] = *(const h8*)(A + (size_t)(r0 + 32 * i) * lda + 64 + kc * 8);
#pragma unroll
  for (int i = 0; i < 2 * NT; ++i) rb1[i] = *(const h8*)(B + (size_t)(r0 + 32 * i) * ldb + 64 + kc * 8);
}
template <int NT>
__device__ __forceinline__ void gemm_run(f16v (&acc)[4][NT], h8 (&ra0)[8], h8 (&rb0)[2 * NT], h8 (&ra1)[8], h8 (&rb1)[2 * NT],
                                         const half_t* __restrict__ A, int lda, const half_t* __restrict__ B, int ldb, int K, unsigned char* lds) {
  const int tid = otid(), w = tid >> 6, l = tid & 63;
  constexpr int STAGE = 256 * 144 + 64 * NT * 144;
  unsigned char* A0 = lds;
  unsigned char* B0 = lds + 256 * 144;
  unsigned char* A1 = lds + STAGE;
  unsigned char* B1 = lds + STAGE + 256 * 144;
  const int wm = w >> 1, wn = w & 1;
  const int kc = tid & 7;
  const int r0 = tid >> 3;
  lds_barrier();
#pragma unroll
  for (int i = 0; i < 8; ++i) { *(h8*)(A0 + (r0 + 32 * i) * 144 + kc * 16) = ra0[i]; ra0[i] = *(const h8*)(A + (size_t)(r0 + 32 * i) * lda + 128 + kc * 8); }
#pragma unroll
  for (int i = 0; i < 2 * NT; ++i) { *(h8*)(B0 + (r0 + 32 * i) * 144 + kc * 16) = rb0[i]; rb0[i] = *(const h8*)(B + (size_t)(r0 + 32 * i) * ldb + 128 + kc * 8); }
  lds_barrier();
  const int nk = K / 64;
#pragma unroll 1
  for (int kt = 0; kt < nk; kt += 2) {
    gemm_step<NT>(acc, ra1, rb1, A0, B0, A1, B1, A, lda, B, ldb, (kt + 3 < nk) ? (kt + 3) * 64 : 0, wm, wn, l, r0, kc);
    lds_barrier();
    gemm_step<NT>(acc, ra0, rb0, A1, B1, A0, B0, A, lda, B, ldb, (kt + 4 < nk) ? (kt + 4) * 64 : 0, wm, wn, l, r0, kc);
    lds_barrier();
  }
}
template <int NT>
__device__ __forceinline__ void gemm_kloop(f16v (&acc)[4][NT], const half_t* __restrict__ A, int lda,
                                           const half_t* __restrict__ B, int ldb, int K, unsigned char* lds) {
  h8 ra0[8], rb0[2 * NT], ra1[8], rb1[2 * NT];
  gemm_issue<NT>(ra0, rb0, ra1, rb1, A, lda, B, ldb);
  gemm_run<NT>(acc, ra0, rb0, ra1, rb1, A, lda, B, ldb, K, lds);
}

template <int NT>
__device__ __forceinline__ void gemm_issue1(h8 (&ra)[8], h8 (&rb)[2 * NT], const half_t* __restrict__ A, int lda, const half_t* __restrict__ B, int ldb) {
  const int tid = otid();
  const int kc = tid & 7, r0 = tid >> 3;
#pragma unroll
  for (int i = 0; i < 8; ++i) ra[i] = *(const h8*)(A + (size_t)(r0 + 32 * i) * lda + kc * 8);
#pragma unroll
  for (int i = 0; i < 2 * NT; ++i) rb[i] = *(const h8*)(B + (size_t)(r0 + 32 * i) * ldb + kc * 8);
}
template <int NT>
__device__ __forceinline__ void gemm_run1(f16v (&acc)[4][NT], h8 (&ra)[8], h8 (&rb)[2 * NT],
                                          const half_t* __restrict__ A, int lda, const half_t* __restrict__ B, int ldb, int K, unsigned char* lds) {
  const int tid = otid(), w = tid >> 6, l = tid & 63;
  constexpr int STAGE = 256 * 144 + 64 * NT * 144;
  const int wm = w >> 1, wn = w & 1;
  const int kc = tid & 7;
  const int r0 = tid >> 3;
  lds_barrier();
#pragma unroll
  for (int i = 0; i < 8; ++i) { *(h8*)(lds + (r0 + 32 * i) * 144 + kc * 16) = ra[i]; ra[i] = *(const h8*)(A + (size_t)(r0 + 32 * i) * lda + 64 + kc * 8); }
#pragma unroll
  for (int i = 0; i < 2 * NT; ++i) { *(h8*)(lds + 256 * 144 + (r0 + 32 * i) * 144 + kc * 16) = rb[i]; rb[i] = *(const h8*)(B + (size_t)(r0 + 32 * i) * ldb + 64 + kc * 8); }
  lds_barrier();
  const int nk = K / 64;
#pragma unroll 1
  for (int kt = 0; kt < nk; ++kt) {
    unsigned char* cur = lds + (kt & 1) * STAGE;
    unsigned char* nxt = lds + ((kt + 1) & 1) * STAGE;
    gemm_step<NT>(acc, ra, rb, cur, cur + 256 * 144, nxt, nxt + 256 * 144, A, lda, B, ldb, (kt + 2 < nk) ? (kt + 2) * 64 : 0, wm, wn, l, r0, kc);
    lds_barrier();
  }
}

template <int NT>
__device__ __forceinline__ void zero_acc(f16v (&acc)[4][NT]) {
  float z = 0.f;
  asm volatile("" : "+v"(z));
#pragma unroll
  for (int i = 0; i < 4; ++i)
#pragma unroll
    for (int j = 0; j < NT; ++j)
#pragma unroll
      for (int r = 0; r < 16; ++r) acc[i][j][r] = z;
}

#define EP 68
__device__ __forceinline__ void stage_pair(float* E, const f16v& a0, const f16v& a1, int l) {
#pragma unroll
  for (int r = 0; r < 16; ++r) {
    const int rr = crow(r, l);
    E[rr * EP + (l & 31)] = a0[r];
    E[rr * EP + 32 + (l & 31)] = a1[r];
  }
}
__device__ __forceinline__ void ld8(const float* p, float (&v)[8]) {
  const f4v a = *(const f4v*)p, b = *(const f4v*)(p + 4);
  v[0] = a[0]; v[1] = a[1]; v[2] = a[2]; v[3] = a[3]; v[4] = b[0]; v[5] = b[1]; v[6] = b[2]; v[7] = b[3];
}
__device__ __forceinline__ int xcc_census(const unsigned* xcnt, int my_xcc) {
  unsigned sum = 0; bool ok = my_xcc < 8; int mine = 0;
#pragma unroll
  for (int j = 0; j < 16; ++j) {
    const unsigned c = __hip_atomic_load(xcnt + j, __ATOMIC_RELAXED, __HIP_MEMORY_SCOPE_AGENT);
    sum += c;
    if (j < 8 && c == 0u) ok = false;
    if (j >= 8 && c != 0u) ok = false;
    if (j == my_xcc) mine = (int)c;
  }
  if (sum != gridDim.x) ok = false;
  return ok ? mine : 0;
}

__device__ void phase_A(const Params& p, int layer, unsigned char* lds, int my_xcc, int my_loc, const unsigned* xcnt) {
  const int tid = otid(), w = tid >> 6, l = tid & 63;
  const half_t* H = (const half_t*)(p.ws + OFF_H);
  const half_t* Wt = (const half_t*)(p.ws + OFF_WINT) + (size_t)layer * NPAD * WP;
  half_t* P = (half_t*)(p.ws + OFF_P);
  float* GA = (float*)(p.ws + OFF_GA);
  float* IW = (float*)(p.ws + OFF_IW);
  const float* RT = (const float*)(p.ws + OFF_RT);
  const float* DT = (const float*)(p.ws + OFF_DT);
  const int wm = w >> 1, wn = w & 1;
  const int G = gridDim.x;
  const int ntiles = 64 * 31;
  const int nx = xcc_census(xcnt, my_xcc);
  int nmine;
  if (nx > 0) nmine = (my_loc < 248) ? (248 - my_loc + nx - 1) / nx : 0;
  else nmine = ((int)blockIdx.x < ntiles) ? (ntiles - (int)blockIdx.x + G - 1) / G : 0;
  h8 ra0[8], rb0[8];
  int mt = 0, nt = 0;
  if (nmine > 0) {
    if (nx > 0) { const int s0 = my_loc; mt = my_xcc * 8 + (s0 & 7); nt = s0 >> 3; }
    else { const int tix = blockIdx.x; mt = tix & 63; nt = tix >> 6; }
    gemm_issue1<4>(ra0, rb0, H + (size_t)mt * 256 * HP, HP, Wt + (size_t)nt * 256 * WP, WP);
  }
#pragma unroll 1
  for (int rnd = 0; rnd < nmine; ++rnd) {
    f16v acc[4][4];
    zero_acc<4>(acc);
    gemm_run1<4>(acc, ra0, rb0, H + (size_t)mt * 256 * HP, HP, Wt + (size_t)nt * 256 * WP, WP, 1024, lds);
    const int mt_cur = mt, nt_cur = nt;
    if (rnd + 1 < nmine) {
      if (nx > 0) { const int s1 = my_loc + nx * (rnd + 1); mt = my_xcc * 8 + (s1 & 7); nt = s1 >> 3; }
      else { const int tix = (rnd + 1) * G + blockIdx.x; mt = tix & 63; nt = tix >> 6; }
      gemm_issue1<4>(ra0, rb0, H + (size_t)mt * 256 * HP, HP, Wt + (size_t)nt * 256 * WP, WP);
    }
    const int m0w = mt_cur * 256 + wm * 128;
    const int n0w = nt_cur * 256 + wn * 128;
    float* E = (float*)(lds) + w * (32 * EP);
    const int prow = l >> 3, c0 = (l & 7) * 8;
#pragma unroll
    for (int jp = 0; jp < 2; ++jp) {
      const int nb2 = n0w + jp * 64;
      const int n0 = nb2 + c0;
      const bool rope64 = nb2 < 512;
      const bool rope16 = ((nb2 >= C_DSAQ && nb2 < C_DSAV) || (nb2 >= C_IDXQ && nb2 < C_GLAQ)) && (c0 < 16);
      float scale = 1.f;
      if (n0 < 256 || (n0 >= C_DSAQ && n0 < C_DSAK) || (n0 >= C_IDXQ && n0 < C_IDXK) || (n0 >= C_GLAQ && n0 < C_GLAK)) scale = 0.125f;
      int mode = 0;
      if ((n0 >= C_RETG && n0 < C_DSAQ) || (n0 >= C_DSAG && n0 < C_IDXQ) || (n0 >= C_GLAG && n0 < C_GLAA)) mode = 1;
      if (n0 >= C_MRG && n0 < C_END) mode = 2;
#pragma unroll
      for (int i = 0; i < 4; ++i) {
        stage_pair(E, acc[i][2 * jp], acc[i][2 * jp + 1], l);
#pragma unroll 2
        for (int ps = 0; ps < 4; ++ps) {
          const int rl = ps * 8 + prow;
          const int row = m0w + i * 32 + rl;
          float v[8], o[8];
          ld8(E + rl * EP + c0, v);
#pragma unroll
          for (int q = 0; q < 8; ++q) o[q] = v[q];
          if (rope64) {
            float pv[8], tb[16];
            ld8(E + rl * EP + (c0 ^ 32), pv);
            const float* tp = RT + (size_t)row * 64 + (c0 & 31) * 2;
            ld8(tp, *(float(*)[8])&tb[0]); ld8(tp + 8, *(float(*)[8])&tb[8]);
#pragma unroll
            for (int q = 0; q < 8; ++q) o[q] = (c0 < 32) ? (v[q] * tb[2 * q] - pv[q] * tb[2 * q + 1]) : (v[q] * tb[2 * q] + pv[q] * tb[2 * q + 1]);
          } else if (rope16) {
            float pv[8], tb[16];
            ld8(E + rl * EP + (c0 ^ 8), pv);
            const float* tp = DT + (size_t)row * 16;
            ld8(tp, *(float(*)[8])&tb[0]); ld8(tp + 8, *(float(*)[8])&tb[8]);
#pragma unroll
            for (int q = 0; q < 8; ++q) o[q] = (c0 < 8) ? (v[q] * tb[2 * q] - pv[q] * tb[2 * q + 1]) : (v[q] * tb[2 * q] + pv[q] * tb[2 * q + 1]);
          }
          h8 ov;
#pragma unroll
          for (int q = 0; q < 8; ++q) {
            float t = o[q] * scale;
            if (mode != 0) {
              const float sg = __builtin_amdgcn_rcpf(1.f + __expf(-t));
              t = (mode == 1) ? t * sg : sg;
            }
            ov[q] = (half_t)t;
          }
          if (n0 < C_END) __builtin_nontemporal_store(ov, (h8*)(P + (size_t)row * PP + n0));
          if (n0 >= C_GLAA && n0 < C_MRG) {
#pragma unroll
            for (int q = 0; q < 8; ++q) GA[(size_t)row * 16 + (n0 - C_GLAA) + q] = v[q];
          }
          if (n0 == C_IDXW) {
#pragma unroll
            for (int q = 0; q < 4; ++q) IW[(size_t)row * 4 + q] = 0.5f * v[q];
          }
        }
      }
    }
  }
}

#define LA_BC 0
#define LA_GAS 16640
#define LA_WL 20736
#define LA_QT 24832
#define LA_KT 34048
#define LA_AT 43264
#define LA_VT 52480
#define LA_SS 70912
#define LA_OS 89344
#define LA_SEG 123136

__device__ void la_bcum(const Params& p, int layer, int n, int Hh, unsigned char* lds) {
  const int tid = otid();
  float* Bc = (float*)(lds + LA_BC);
  const int d = tid & 63, q = tid >> 6;
  if (Hh < 4) {
    float lg = log1pf(-exp2f(-5.0f - (float)Hh));
#pragma unroll
    for (int jj = 0; jj < 16; ++jj) { int j = q * 16 + jj; Bc[j * 65 + d] = (float)(j + 1) * lg; }
    __syncthreads();
    return;
  }
  const int h = Hh - 4;
  float* GAs = (float*)(lds + LA_GAS);
  float* WL = (float*)(lds + LA_WL);
  float* SEG = (float*)(lds + LA_SEG);
  const float* GA = (const float*)(p.ws + OFF_GA);
#pragma unroll
  for (int i = 0; i < 4; ++i) {
    int e = tid + 256 * i;
    GAs[e] = GA[(size_t)n * 64 * 16 + e];
    int r = e >> 6, dd = e & 63;
    WL[e] = p.gla_w_lr[(size_t)layer * 16 * 256 + r * 256 + h * 64 + dd];
  }
  __syncthreads();
  float wl[16];
#pragma unroll
  for (int r = 0; r < 16; ++r) wl[r] = WL[r * 64 + d];
  const float bl = p.gla_b_lr[layer * 256 + h * 64 + d];
  float run = 0.f;
#pragma unroll
  for (int jj = 0; jj < 16; ++jj) {
    int j = q * 16 + jj;
    float z = bl;
#pragma unroll
    for (int r = 0; r < 16; ++r) z += GAs[j * 16 + r] * wl[r];
    float ls = fminf(z, 0.f) - log1pf(expf(-fabsf(z)));
    run += ls * (1.0f / 16.0f);
    Bc[j * 65 + d] = run;
  }
  SEG[q * 64 + d] = run;
  __syncthreads();
  float off = 0.f;
  for (int qq = 0; qq < q; ++qq) off += SEG[qq * 64 + d];
  if (q > 0) {
#pragma unroll
    for (int jj = 0; jj < 16; ++jj) { int j = q * 16 + jj; Bc[j * 65 + d] += off; }
  }
  __syncthreads();
}

__device__ __forceinline__ void la_load_v(const half_t* __restrict__ P, int t0, int vcol, h8 (&vr)[2][2]) {
  const int tid = otid(), w = tid >> 6, l = tid & 63;
  const int jp = l & 31, cgp = l >> 5;
#pragma unroll
  for (int it = 0; it < 2; ++it) {
    int c = it * 8 + w * 2 + cgp;
    vr[it][0] = *(const h8*)(P + (size_t)(t0 + 2 * jp) * PP + vcol + c * 8);
    vr[it][1] = *(const h8*)(P + (size_t)(t0 + 2 * jp + 1) * PP + vcol + c * 8);
  }
}
__device__ __forceinline__ void la_stage_vt(const h8 (&vr)[2][2], unsigned char* lds) {
  const int tid = otid(), w = tid >> 6, l = tid & 63;
  half_t* VT = (half_t*)(lds + LA_VT);
  const int jp = l & 31, cgp = l >> 5;
#pragma unroll
  for (int it = 0; it < 2; ++it) {
    int c = it * 8 + w * 2 + cgp;
#pragma unroll
    for (int q = 0; q < 8; ++q) {
      h2 pr; pr[0] = vr[it][0][q]; pr[1] = vr[it][1][q];
      *(h2*)(VT + (c * 8 + q) * 72 + 2 * jp) = pr;
    }
  }
}
__device__ void la_item_kv(const Params& p, int layer, int item, unsigned char* lds) {
  const int tid = otid(), w = tid >> 6, l = tid & 63;
  const int n = item >> 3, Hh = item & 7;
  const int t0 = n * 64;
  const half_t* P = (const half_t*)(p.ws + OFF_P);
  half_t* ST = (half_t*)(p.ws + OFF_ST);
  float* DEC = (float*)(p.ws + OFF_DEC);
  const int kcol = (Hh < 4) ? (C_RETK + Hh * 64) : (C_GLAK + (Hh - 4) * 64);
  const int vcol = (Hh < 4) ? (C_RETV + Hh * 128) : (C_GLAV + (Hh - 4) * 128);
  h8 vr[2][2];
  la_load_v(P, t0, vcol, vr);
  const h8 k0 = *(const h8*)(P + (size_t)(t0 + 2 * (l & 31)) * PP + kcol + (w * 2 + (l >> 5)) * 8);
  const h8 k1 = *(const h8*)(P + (size_t)(t0 + 2 * (l & 31) + 1) * PP + kcol + (w * 2 + (l >> 5)) * 8);
  __syncthreads();
  la_bcum(p, layer, n, Hh, lds);
  const float* Bc = (const float*)(lds + LA_BC);
  half_t* KhT = (half_t*)(lds + LA_KT);
  half_t* VT = (half_t*)(lds + LA_VT);
  {
    const int jp = l & 31, cgp = l >> 5;
    int c = w * 2 + cgp;
#pragma unroll
    for (int q = 0; q < 8; ++q) {
      int d = c * 8 + q;
      float bl = Bc[63 * 65 + d];
      h2 pr;
      pr[0] = (half_t)((float)k0[q] * __expf(bl - Bc[(2 * jp) * 65 + d]));
      pr[1] = (half_t)((float)k1[q] * __expf(bl - Bc[(2 * jp + 1) * 65 + d]));
      *(h2*)(KhT + d * 72 + 2 * jp) = pr;
    }
  }
  la_stage_vt(vr, lds);
  if (tid < 64) DEC[(size_t)item * 64 + tid] = __expf(Bc[63 * 65 + tid]);
  __syncthreads();
  f16v acc[2];
#pragma unroll
  for (int j = 0; j < 2; ++j)
#pragma unroll
    for (int r = 0; r < 16; ++r) acc[j][r] = ozero();
#pragma unroll
  for (int ks = 0; ks < 4; ++ks) {
    h8 a = *(const h8*)(VT + (32 * w + (l & 31)) * 72 + ks * 16 + (l >> 5) * 8);
#pragma unroll
    for (int j = 0; j < 2; ++j) {
      h8 b = *(const h8*)(KhT + (j * 32 + (l & 31)) * 72 + ks * 16 + (l >> 5) * 8);
      acc[j] = mfma16(a, b, acc[j]);
    }
  }
#pragma unroll
  for (int j = 0; j < 2; ++j)
#pragma unroll
    for (int r = 0; r < 16; ++r) {
      int e = 32 * w + crow(r, l);
      int d = j * 32 + (l & 31);
      ST[(size_t)item * 8192 + e * 64 + d] = (half_t)acc[j][r];
    }
}

__device__ void phase_scan(const Params& p) {
  half_t* ST = (half_t*)(p.ws + OFF_ST);
  const float* DEC = (const float*)(p.ws + OFF_DEC);
  for (int f2 = blockIdx.x * NTHREADS + otid(); f2 < 32768; f2 += gridDim.x * NTHREADS) {
    const int f = f2 * 2;
    const int Hh = f >> 13, d = f & 63;
    float s0 = 0.f, s1 = 0.f;
    for (int n0 = 0; n0 < 256; n0 += 16) {
      h2 kv[16]; float2 dc[16];
#pragma unroll
      for (int u = 0; u < 16; ++u) {
        kv[u] = *(const h2*)(ST + (size_t)(n0 + u) * 65536 + f);
        dc[u] = *(const float2*)(DEC + (size_t)((n0 + u) * 8 + Hh) * 64 + d);
      }
#pragma unroll
      for (int u = 0; u < 16; ++u) {
        h2 o; o[0] = (half_t)s0; o[1] = (half_t)s1;
        *(h2*)(ST + (size_t)(n0 + u) * 65536 + f) = o;
        s0 = dc[u].x * s0 + (float)kv[u][0];
        s1 = dc[u].y * s1 + (float)kv[u][1];
      }
    }
  }
}

__device__ void la_item_out(const Params& p, int layer, int item, unsigned char* lds) {
  const int tid = otid(), w = tid >> 6, l = tid & 63;
  const int n = item >> 3, Hh = item & 7;
  const int t0 = n * 64;
  const half_t* P = (const half_t*)(p.ws + OFF_P);
  const half_t* ST = (const half_t*)(p.ws + OFF_ST);
  half_t* BR = (half_t*)(p.ws + OFF_BR);
  const int qcol = (Hh < 4) ? (C_RETQ + Hh * 64) : (C_GLAQ + (Hh - 4) * 64);
  const int kcol = (Hh < 4) ? (C_RETK + Hh * 64) : (C_GLAK + (Hh - 4) * 64);
  const int vcol = (Hh < 4) ? (C_RETV + Hh * 128) : (C_GLAV + (Hh - 4) * 128);
  const int gcol = (Hh < 4) ? (C_RETG + Hh * 128) : (C_GLAG + (Hh - 4) * 128);
  const int ocol = (Hh < 4) ? (Hh * 128) : (1024 + (Hh - 4) * 128);
  h8 vr[2][2];
  la_load_v(P, t0, vcol, vr);
  h8 qr[2], kr[2], sr[4];
#pragma unroll
  for (int it = 0; it < 2; ++it) {
    const int c = tid + 256 * it;
    qr[it] = *(const h8*)(P + (size_t)(t0 + (c >> 3)) * PP + qcol + (c & 7) * 8);
    kr[it] = *(const h8*)(P + (size_t)(t0 + (c >> 3)) * PP + kcol + (c & 7) * 8);
  }
#pragma unroll
  for (int it = 0; it < 4; ++it) {
    const int c = tid + 256 * it;
    sr[it] = *(const h8*)(ST + (size_t)item * 8192 + (c >> 3) * 64 + (c & 7) * 8);
  }
  __syncthreads();
  la_bcum(p, layer, n, Hh, lds);
  const float* Bc = (const float*)(lds + LA_BC);
  half_t* Qt = (half_t*)(lds + LA_QT);
  half_t* Kt = (half_t*)(lds + LA_KT);
  half_t* AT = (half_t*)(lds + LA_AT);
  half_t* VT = (half_t*)(lds + LA_VT);
  half_t* SS = (half_t*)(lds + LA_SS);
  float* OS = (float*)(lds + LA_OS);
#pragma unroll
  for (int it = 0; it < 2; ++it) {
    int c = tid + 256 * it;
    int row = c >> 3, kc = c & 7;
    const h8 qv = qr[it];
    const h8 kv = kr[it];
    h8 qo, ko;
#pragma unroll
    for (int q = 0; q < 8; ++q) {
      float b = Bc[row * 65 + kc * 8 + q];
      qo[q] = (half_t)((float)qv[q] * __expf(b));
      ko[q] = (half_t)((float)kv[q] * __expf(-b));
    }
    *(h8*)(Qt + row * 72 + kc * 8) = qo;
    *(h8*)(Kt + row * 72 + kc * 8) = ko;
  }
  la_stage_vt(vr, lds);
#pragma unroll
  for (int it = 0; it < 4; ++it) {
    int c = tid + 256 * it;
    int e = c >> 3, kc = c & 7;
    *(h8*)(SS + e * 72 + kc * 8) = sr[it];
  }
  __syncthreads();
  {
    const int mi = w >> 1, nj = w & 1;
    f16v acc;
#pragma unroll
    for (int r = 0; r < 16; ++r) acc[r] = ozero();
#pragma unroll
    for (int ks = 0; ks < 4; ++ks) {
      h8 a = *(const h8*)(Qt + (mi * 32 + (l & 31)) * 72 + ks * 16 + (l >> 5) * 8);
      h8 b = *(const h8*)(Kt + (nj * 32 + (l & 31)) * 72 + ks * 16 + (l >> 5) * 8);
      acc = mfma16(a, b, acc);
    }
#pragma unroll
    for (int r = 0; r < 16; ++r) {
      int i = mi * 32 + crow(r, l);
      int j = nj * 32 + (l & 31);
      float v = (j <= i) ? acc[r] : 0.f;
      AT[i * 72 + j] = (half_t)v;
    }
  }
  __syncthreads();
  {
    const int mi = w >> 1, nh = w & 1;
    f16v acc[2];
#pragma unroll
    for (int j = 0; j < 2; ++j)
#pragma unroll
      for (int r = 0; r < 16; ++r) acc[j][r] = ozero();
#pragma unroll
    for (int ks = 0; ks < 4; ++ks) {
      h8 a1 = *(const h8*)(AT + (mi * 32 + (l & 31)) * 72 + ks * 16 + (l >> 5) * 8);
      h8 a2 = *(const h8*)(Qt + (mi * 32 + (l & 31)) * 72 + ks * 16 + (l >> 5) * 8);
#pragma unroll
      for (int j = 0; j < 2; ++j) {
        h8 b1 = *(const h8*)(VT + (nh * 64 + j * 32 + (l & 31)) * 72 + ks * 16 + (l >> 5) * 8);
        h8 b2 = *(const h8*)(SS + (nh * 64 + j * 32 + (l & 31)) * 72 + ks * 16 + (l >> 5) * 8);
        acc[j] = mfma16(a1, b1, acc[j]);
        acc[j] = mfma16(a2, b2, acc[j]);
      }
    }
#pragma unroll
    for (int j = 0; j < 2; ++j)
#pragma unroll
      for (int r = 0; r < 16; ++r) {
        int i = mi * 32 + crow(r, l);
        int e = nh * 64 + j * 32 + (l & 31);
        OS[i * 132 + e] = acc[j][r];
      }
  }
  __syncthreads();
  {
    const int i = tid >> 2, qd = tid & 3;
    float ov[32];
    float ss = 0.f;
#pragma unroll
    for (int c = 0; c < 8; ++c) {
      f4v v = *(const f4v*)(OS + i * 132 + qd * 32 + c * 4);
      ov[c * 4] = v[0]; ov[c * 4 + 1] = v[1]; ov[c * 4 + 2] = v[2]; ov[c * 4 + 3] = v[3];
      ss += v[0] * v[0] + v[1] * v[1] + v[2] * v[2] + v[3] * v[3];
    }
    ss += dppf<0xB1>(ss);
    ss += dppf<0x4E>(ss);
    float rs = rsqrtf(ss * (1.0f / 128.0f) + 1e-6f);
#pragma unroll
    for (int c = 0; c < 4; ++c) {
      h8 g = *(const h8*)(P + (size_t)(t0 + i) * PP + gcol + qd * 32 + c * 8);
      h8 o;
#pragma unroll
      for (int q = 0; q < 8; ++q) o[q] = (half_t)(ov[c * 8 + q] * rs * (float)g[q]);
      *(h8*)(BR + (size_t)(t0 + i) * 1536 + ocol + qd * 32 + c * 8) = o;
    }
  }
}

#define DS_CAP 640
#define DS_PRUNE_AT 512
#define NPL 10
#define DS_LS 0
#define DS_LI (32 * DS_CAP * 4)
#define DS_CNT (32 * DS_CAP * 6)
#define DS_THR (DS_CNT + 128)
#define DS_WQ (DS_CNT + 256)
#define DS_HIST (DS_CNT + 1024)
#define DS_PW (DS_CNT + 1024 + 4096)

__device__ __forceinline__ unsigned long long wave_or64(unsigned long long v) {
  const unsigned lo = wave_or((unsigned)v), hi = wave_or((unsigned)(v >> 32));
  return ((unsigned long long)hi << 32) | lo;
}
template <bool APPROX>
__device__ __forceinline__ void dsa_prune(float* LSm, unsigned short* LIm, int n, unsigned* hist, int* cntm, float* thrm, int l) {
  unsigned long long comp[NPL];
  bool act[NPL], val[NPL];
#pragma unroll
  for (int k = 0; k < NPL; ++k) {
    int e = l + 64 * k;
    val[k] = e < n;
    const int ec = val[k] ? e : 0;
    unsigned u = __float_as_uint(LSm[ec]), li = LIm[ec];
    if (!val[k]) { u = 0; li = 0; }
    const unsigned key = (u >> 31) ? ~u : (u | 0x80000000u);
    comp[k] = ((unsigned long long)key << 14) | (unsigned long long)(16383u - li);
    act[k] = val[k];
  }
  const unsigned long long c0 = ((unsigned long long)(unsigned)__builtin_amdgcn_readfirstlane((int)(unsigned)(comp[0] >> 32)) << 32) | (unsigned)__builtin_amdgcn_readfirstlane((int)(unsigned)comp[0]);
  unsigned long long x = 0;
#pragma unroll
  for (int k = 0; k < NPL; ++k) x |= val[k] ? (comp[k] ^ c0) : 0ull;
  x = wave_or64(x);
  int shift = (x == 0ull) ? 0 : (63 - __clzll((long long)x)) - 7;
  if (shift < 0) shift = 0;
  unsigned rank = 256;
  bool fast = false; unsigned fsel = 0, fcnt = 0; int fshift = 0;
#pragma unroll 1
  for (int rd = 0; rd < 8; ++rd) {
    *(uint4*)(hist + 4 * l) = make_uint4(0, 0, 0, 0);
    __threadfence_block();
    unsigned dk[NPL];
#pragma unroll
    for (int k = 0; k < NPL; ++k) {
      dk[k] = (unsigned)(comp[k] >> shift) & 255u;
      if (act[k]) atomicAdd(&hist[dk[k]], 1u);
    }
    __threadfence_block();
    uint4 hv; hv.x = hist[4 * l]; hv.y = hist[4 * l + 1]; hv.z = hist[4 * l + 2]; hv.w = hist[4 * l + 3];
    unsigned tl = hv.x + hv.y + hv.z + hv.w;
    const unsigned pin = wave_incl_scan(tl);
    const unsigned tot = (unsigned)__builtin_amdgcn_readlane((int)pin, 63);
    unsigned sx = tot - pin;
    bool mine = (sx < rank) && (rank <= sx + tl);
    unsigned dsel = 0, nr = 0, hsel = 0;
    if (mine) {
      unsigned c = sx;
      if (c + hv.w >= rank) { dsel = 4 * l + 3; nr = rank - c; hsel = hv.w; }
      else {
        c += hv.w;
        if (c + hv.z >= rank) { dsel = 4 * l + 2; nr = rank - c; hsel = hv.z; }
        else {
          c += hv.z;
          if (c + hv.y >= rank) { dsel = 4 * l + 1; nr = rank - c; hsel = hv.y; }
          else { c += hv.y; dsel = 4 * l; nr = rank - c; hsel = hv.x; }
        }
      }
    }
    unsigned long long mk = __ballot(mine);
    int src = (mk == 0ull) ? 0 : (__ffsll((long long)mk) - 1);
    dsel = (unsigned)__builtin_amdgcn_readlane((int)dsel, src);
    rank = (unsigned)__builtin_amdgcn_readlane((int)nr, src);
    hsel = (unsigned)__builtin_amdgcn_readlane((int)hsel, src);
    if (APPROX && rd == 0) {
      const unsigned kept = 256u - rank + hsel;
      if (kept <= 320u) { fast = true; fsel = dsel; fcnt = kept; fshift = shift; break; }
    }
#pragma unroll
    for (int k = 0; k < NPL; ++k) act[k] = act[k] && (dk[k] == dsel);
    if (hsel <= 1u || shift == 0) break;
    shift = (shift >= 8) ? (shift - 8) : 0;
  }
  unsigned long long tsel = 0;
#pragma unroll
  for (int k = 0; k < NPL; ++k) tsel |= act[k] ? comp[k] : 0ull;
  unsigned long long T = 0ull;
  if (!fast) T = wave_or64(tsel);
  else T = ((c0 >> (fshift + 8)) << (fshift + 8)) | ((unsigned long long)fsel << fshift);
  bool keep[NPL];
  unsigned cntk = 0;
#pragma unroll
  for (int k = 0; k < NPL; ++k) {
    keep[k] = val[k] && (comp[k] >= T);
    cntk += keep[k] ? 1u : 0u;
  }
  unsigned pos = wave_incl_scan(cntk) - cntk;
  __threadfence_block();
#pragma unroll
  for (int k = 0; k < NPL; ++k) {
    if (keep[k]) {
      const unsigned kk = (unsigned)(comp[k] >> 14);
      const unsigned u = (kk & 0x80000000u) ? (kk & 0x7FFFFFFFu) : ~kk;
      LSm[pos] = __uint_as_float(u);
      LIm[pos] = (unsigned short)(16383u - ((unsigned)comp[k] & 16383u));
      ++pos;
    }
  }
  if (l == 0) {
    const unsigned T32 = (unsigned)(T >> 14);
    *cntm = fast ? (int)fcnt : 256;
    *thrm = __uint_as_float((T32 & 0x80000000u) ? (T32 & 0x7FFFFFFFu) : ~T32);
  }
  __threadfence_block();
}

__device__ void dsa_item(const Params& p, int qb, unsigned char* lds) {
  const int tid = otid(), w = tid >> 6, l = tid & 63;
  const int t0 = qb * 32;
  const half_t* P = (const half_t*)(p.ws + OFF_P);
  const float* IW = (const float*)(p.ws + OFF_IW);
  half_t* BR = (half_t*)(p.ws + OFF_BR);
  float* LS = (float*)(lds + DS_LS);
  unsigned short* LI = (unsigned short*)(lds + DS_LI);
  int* cnt = (int*)(lds + DS_CNT);
  float* thr = (float*)(lds + DS_THR);
  float* wq = (float*)(lds + DS_WQ);
  unsigned* hist = (unsigned*)(lds + DS_HIST) + w * 256;
  float* PW = (float*)(lds + DS_PW) + w * 1024;
  half_t* QS = (half_t*)(lds + DS_PW + 16384) + w * 512;
  for (int rep_sel = 0; rep_sel < REP_SEL; ++rep_sel) {
  __syncthreads();
  if (tid < 32) { cnt[tid] = 0; thr[tid] = -INFINITY; }
  if (tid < 128) wq[tid] = IW[(size_t)t0 * 4 + tid];
  __syncthreads();
  h8 aq[4][4];
#pragma unroll
  for (int h = 0; h < 4; ++h)
#pragma unroll
    for (int ks = 0; ks < 4; ++ks)
      aq[h][ks] = *(const h8*)(P + (size_t)(t0 + (l & 31)) * PP + C_IDXQ + h * 64 + ks * 16 + (l >> 5) * 8);
  const int nt = qb + 1;
  const int nr = (nt + 3) >> 2;
  f4v wqv[16];
#pragma unroll
  for (int r = 0; r < 16; ++r) wqv[r] = *(const f4v*)(wq + crow(r, l) * 4);
  float thv[16];
  { float ninf = -INFINITY; asm volatile("" : "+v"(ninf));
#pragma unroll
  for (int r = 0; r < 16; ++r) thv[r] = ninf; }
  h8 bk[4];
  {
    const int k0 = (w < nt) ? w : 0;
#pragma unroll
    for (int ks = 0; ks < 4; ++ks)
      bk[ks] = *(const h8*)(P + (size_t)(k0 * 32 + (l & 31)) * PP + C_IDXK + ks * 16 + (l >> 5) * 8);
  }
#pragma unroll 1
  for (int rd = 0; rd < nr; ++rd) {
    const int kt = 4 * rd + w;
    h8 bkn[4];
    {
      const int kn = (kt + 4 < nt) ? (kt + 4) : 0;
#pragma unroll
      for (int ks = 0; ks < 4; ++ks)
        bkn[ks] = *(const h8*)(P + (size_t)(kn * 32 + (l & 31)) * PP + C_IDXK + ks * 16 + (l >> 5) * 8);
    }
    if (kt < nt) {
      const int sbase = kt * 32;
      f16v acc[4];
#pragma unroll
      for (int h = 0; h < 4; ++h) {
#pragma unroll
        for (int r = 0; r < 16; ++r) acc[h][r] = ozero();
#pragma unroll
        for (int ks = 0; ks < 4; ++ks) acc[h] = mfma16(aq[h][ks], bk[ks], acc[h]);
      }
      const int s = sbase + (l & 31);
      float scv[16];
      unsigned pm = 0;
#pragma unroll
      for (int r = 0; r < 16; ++r) {
        const int m = crow(r, l);
        const f4v wv = wqv[r];
        float sc = wv[0] * relu_f(acc[0][r]) + wv[1] * relu_f(acc[1][r]) + wv[2] * relu_f(acc[2][r]) + wv[3] * relu_f(acc[3][r]);
        sc += 0.0f;
        scv[r] = sc;
      }
      if (kt == qb) {
#pragma unroll
        for (int r = 0; r < 16; ++r) if (s > t0 + crow(r, l)) scv[r] = -INFINITY;
      }
#pragma unroll
      for (int r = 0; r < 16; ++r) pm |= (scv[r] > thv[r]) ? (1u << r) : 0u;
      if (__ballot(pm != 0u) != 0ull) {
        unsigned long long mks[16];
        int mycnt = 0;
#pragma unroll
        for (int r = 0; r < 16; ++r) {
          const unsigned long long mk = __ballot(((pm >> r) & 1u) != 0u);
          mks[r] = mk;
          const unsigned hm = (l < 32) ? (unsigned)mk : (unsigned)(mk >> 32);
          if ((l & 31) == r) mycnt = __popc(hm);
        }
        int base = 0;
        if ((l & 31) < 16 && mycnt > 0) base = atomicAdd(&cnt[crow(l & 31, l)], mycnt);
#pragma unroll
        for (int r = 0; r < 16; ++r) {
          const unsigned long long mk = mks[r];
          if (mk != 0ull) {
            const unsigned hm = (l < 32) ? (unsigned)mk : (unsigned)(mk >> 32);
            const int b_lo = __builtin_amdgcn_readlane(base, r), b_hi = __builtin_amdgcn_readlane(base, 32 + r);
            const int bb = (l < 32) ? b_lo : b_hi;
            if ((pm >> r) & 1u) {
              const int m = crow(r, l);
              const int slot = bb + __popc(hm & ((1u << (l & 31)) - 1u));
              LS[m * DS_CAP + slot] = scv[r];
              LI[m * DS_CAP + slot] = (unsigned short)s;
            }
          }
        }
      }
    }
    __syncthreads();
    bool any_prune;
    {
      const int cv = (l < 32) ? cnt[l] : 0;
      unsigned pmask = (unsigned)__ballot(cv > DS_PRUNE_AT);
      any_prune = pmask != 0u;
      int j = 0;
      while (pmask != 0u) {
        const int m = __ffs((int)pmask) - 1;
        pmask &= pmask - 1u;
        if ((j & 3) == w) dsa_prune<true>(LS + m * DS_CAP, LI + m * DS_CAP, cnt[m], hist, cnt + m, thr + m, l);
        ++j;
      }
    }
    __syncthreads();
    if (any_prune) {
#pragma unroll
      for (int r = 0; r < 16; ++r) thv[r] = thr[crow(r, l)];
    }
#pragma unroll
    for (int ks = 0; ks < 4; ++ks) bk[ks] = bkn[ks];
  }
  }
#pragma unroll 1
  for (int mm = 0; mm < 8; ++mm) {
    const int m = w * 8 + mm;
    const int c = cnt[m];
    if (c > 256) dsa_prune<false>(LS + m * DS_CAP, LI + m * DS_CAP, c, hist, cnt + m, thr + m, l);
  }
  asm volatile("s_waitcnt lgkmcnt(0)" ::: "memory");
  for (int rep_att = 0; rep_att < REP_ATT; ++rep_att) {
  h8 kvr[4][8];
  {
    const int m = w * 8;
    const int c = min(cnt[m], 256);
    const unsigned short* LIm = LI + m * DS_CAP;
#pragma unroll
    for (int kk = 0; kk < 4; ++kk) {
      const int e = l + 64 * kk;
      const int s = (int)LIm[(e < c) ? e : 0];
      const half_t* kr = P + (size_t)s * PP + C_DSAK;
#pragma unroll
      for (int ch = 0; ch < 8; ++ch) kvr[kk][ch] = *(const h8*)(kr + ch * 8);
    }
  }
  h8 qreg = *(const h8*)(P + (size_t)(t0 + w * 8) * PP + C_DSAQ + l * 8);
  const int dch = l & 7, ksub = l >> 3;
#pragma unroll 1
  for (int u = 0; u < 16; ++u) {
    const int mm = u >> 1, g = u & 1;
    const int m = w * 8 + mm;
    const int t = t0 + m;
    const int c = min(cnt[m], 256);
    const unsigned short* LIm = LI + m * DS_CAP;
    if (g == 0) {
      *(h8*)(QS + l * 8) = qreg;
      const int mq = (mm < 7) ? (m + 1) : m;
      qreg = *(const h8*)(P + (size_t)(t0 + mq) * PP + C_DSAQ + l * 8);
    }
    h8 gt[4];
#pragma unroll
    for (int hh = 0; hh < 4; ++hh) gt[hh] = *(const h8*)(P + (size_t)t * PP + C_DSAG + (g * 4 + hh) * 64 + dch * 8);
    h8 vv[16];
#pragma unroll
    for (int i = 0; i < 16; ++i) {
      const int e = i * 8 + ksub;
      const int s = (int)LIm[(e < c) ? e : 0];
      vv[i] = *(const h8*)(P + (size_t)s * PP + C_DSAV + g * 64 + dch * 8);
    }
    asm volatile("s_waitcnt lgkmcnt(0)" ::: "memory");
    float lg[4][4];
#pragma unroll
    for (int hh = 0; hh < 4; ++hh) {
#pragma unroll
      for (int kk = 0; kk < 4; ++kk) lg[hh][kk] = ozero();
#pragma unroll
      for (int ch = 0; ch < 8; ++ch) {
        const h8 qq = *(const h8*)(QS + (g * 4 + hh) * 64 + ch * 8);
#pragma unroll
        for (int kk = 0; kk < 4; ++kk) {
          float a = lg[hh][kk];
          a = __builtin_amdgcn_fdot2(__builtin_shufflevector(qq, qq, 0, 1), __builtin_shufflevector(kvr[kk][ch], kvr[kk][ch], 0, 1), a, false);
          a = __builtin_amdgcn_fdot2(__builtin_shufflevector(qq, qq, 2, 3), __builtin_shufflevector(kvr[kk][ch], kvr[kk][ch], 2, 3), a, false);
          a = __builtin_amdgcn_fdot2(__builtin_shufflevector(qq, qq, 4, 5), __builtin_shufflevector(kvr[kk][ch], kvr[kk][ch], 4, 5), a, false);
          a = __builtin_amdgcn_fdot2(__builtin_shufflevector(qq, qq, 6, 7), __builtin_shufflevector(kvr[kk][ch], kvr[kk][ch], 6, 7), a, false);
          lg[hh][kk] = a;
        }
      }
#pragma unroll
      for (int kk = 0; kk < 4; ++kk) lg[hh][kk] = (l + 64 * kk < c) ? lg[hh][kk] : -INFINITY;
    }
    {
      const int un = (u < 15) ? (u + 1) : 15;
      const int mn = w * 8 + (un >> 1), gn = un & 1;
      const int cn = min(cnt[mn], 256);
      const unsigned short* LIn = LI + mn * DS_CAP;
#pragma unroll
      for (int kk = 0; kk < 4; ++kk) {
        const int e = l + 64 * kk;
        const int s = (int)LIn[(e < cn) ? e : 0];
        const half_t* kr = P + (size_t)s * PP + C_DSAK + gn * 64;
#pragma unroll
        for (int ch = 0; ch < 8; ++ch) kvr[kk][ch] = *(const h8*)(kr + ch * 8);
      }
    }
#pragma unroll
    for (int hh = 0; hh < 4; ++hh) {
      float mx = fmaxf(fmaxf(lg[hh][0], lg[hh][1]), fmaxf(lg[hh][2], lg[hh][3]));
      mx = wave_max(mx);
      float ev[4]; float sm = 0.f;
#pragma unroll
      for (int kk = 0; kk < 4; ++kk) { ev[kk] = __expf(lg[hh][kk] - mx); sm += ev[kk]; }
      sm = wave_sum(sm);
      const float inv = 1.0f / sm;
#pragma unroll
      for (int kk = 0; kk < 4; ++kk) PW[(l + 64 * kk) * 4 + hh] = ev[kk] * inv;
    }
    asm volatile("s_waitcnt lgkmcnt(0)" ::: "memory");
    float o[4][8];
#pragma unroll
    for (int hh = 0; hh < 4; ++hh)
#pragma unroll
      for (int q = 0; q < 8; ++q) o[hh][q] = ozero();
    const int nit = (c + 7) >> 3;
#pragma unroll 1
    for (int it0 = 0; it0 < nit; it0 += 16) {
      if (it0 > 0) {
#pragma unroll
        for (int i = 0; i < 16; ++i) {
          const int e = (it0 + i) * 8 + ksub;
          const int s = (int)LIm[(e < c) ? e : 0];
          vv[i] = *(const h8*)(P + (size_t)s * PP + C_DSAV + g * 64 + dch * 8);
        }
      }
#pragma unroll
      for (int i = 0; i < 16; ++i) {
        const int e = (it0 + i) * 8 + ksub;
        const f4v pv = *(const f4v*)(PW + e * 4);
#pragma unroll
        for (int hh = 0; hh < 4; ++hh)
#pragma unroll
          for (int q = 0; q < 8; ++q) o[hh][q] += pv[hh] * (float)vv[i][q];
      }
    }
#pragma unroll
    for (int hh = 0; hh < 4; ++hh)
#pragma unroll
      for (int q = 0; q < 8; ++q) {
        float v = o[hh][q];
        v += dppf<0x128>(v); v += xor16f(v); v += xor32f(v);
        o[hh][q] = v;
      }
    if (l < 8) {
#pragma unroll
      for (int hh = 0; hh < 4; ++hh) {
        const int col = (g * 4 + hh) * 64 + dch * 8;
        h8 ov;
#pragma unroll
        for (int q = 0; q < 8; ++q) ov[q] = (half_t)(o[hh][q] * (float)gt[hh][q]);
        *(h8*)(BR + (size_t)t * 1536 + 512 + col) = ov;
      }
    }
    asm volatile("s_waitcnt lgkmcnt(0)" ::: "memory");
  }
  }
}

__device__ void phase_B(const Params& p, int layer, unsigned char* lds) {
  const int G = gridDim.x;
  for (int j = 0; j * G < 512; ++j) {
    const int b = (j & 1) ? (G - 1 - (int)blockIdx.x) : (int)blockIdx.x;
    const int idx = j * G + b;
#ifndef NO_DSA
    if (idx < 512) dsa_item(p, 511 - idx, lds);
#endif
  }
  for (int rep = 0; rep < REP_KV; ++rep)
  for (int it = blockIdx.x; it < 2048; it += G) la_item_kv(p, layer, it, lds);
}

__device__ void phase_E1(const Params& p, int layer, unsigned char* lds, int my_xcc, int my_loc, const unsigned* xcnt) {
  const int tid = otid(), w = tid >> 6, l = tid & 63;
  const half_t* BR = (const half_t*)(p.ws + OFF_BR);
  const half_t* WbrT = (const half_t*)(p.ws + OFF_WBRT) + (size_t)layer * 3 * 1024 * WBP;
  const half_t* P = (const half_t*)(p.ws + OFF_P);
  half_t* Y1 = (half_t*)(p.ws + OFF_H);
  const int wm = w >> 1, wn = w & 1;
  float* E = (float*)(lds + GEMM_EOFF) + w * (32 * EP);
  const int prow = l >> 3, c0 = (l & 7) * 8;
  const int nx = xcc_census(xcnt, my_xcc);
  const int nrounds = (nx > 0) ? (64 + nx - 1) / nx : (512 + (int)gridDim.x - 1) / (int)gridDim.x;
  for (int rnd = 0; rnd < nrounds; ++rnd) {
    int mt, nt;
    if (nx > 0) {
      const int s = my_loc + nx * rnd;
      if (s >= 64) continue;
      mt = my_xcc * 8 + (s & 7); nt = s >> 3;
    } else {
      const int tix = rnd * (int)gridDim.x + (int)blockIdx.x;
      if (tix >= 512) continue;
      mt = tix & 63; nt = tix >> 6;
    }
    h8 tot[4][4];
#pragma unroll
    for (int i = 0; i < 4; ++i)
#pragma unroll
      for (int ps = 0; ps < 4; ++ps)
#pragma unroll
        for (int q = 0; q < 8; ++q) tot[i][ps][q] = (half_t)ozero();
    const int m0w = mt * 256 + wm * 128;
    const int n0 = nt * 128 + wn * 64 + c0;
#pragma unroll 1
    for (int b = 0; b < 3; ++b) {
      f16v acc[4][2];
      zero_acc<2>(acc);
      gemm_kloop<2>(acc, BR + (size_t)mt * 256 * 1536 + b * 512, 1536, WbrT + (size_t)b * 1024 * WBP + (size_t)nt * 128 * WBP, WBP, 512, lds);
#pragma unroll
      for (int i = 0; i < 4; ++i) {
        stage_pair(E, acc[i][0], acc[i][1], l);
#pragma unroll
        for (int ps = 0; ps < 4; ++ps) {
          const int rl = ps * 8 + prow;
          const int row = m0w + i * 32 + rl;
          const h8 g = *(const h8*)(P + (size_t)row * PP + C_MRG + b * 1024 + n0);
          float ev[8];
          ld8(E + rl * EP + c0, ev);
#pragma unroll
          for (int q = 0; q < 8; ++q) tot[i][ps][q] = (half_t)((float)tot[i][ps][q] + (float)g[q] * ev[q]);
        }
      }
    }
#pragma unroll
    for (int i = 0; i < 4; ++i)
#pragma unroll
      for (int ps = 0; ps < 4; ++ps) {
        const int row = m0w + i * 32 + ps * 8 + prow;
        *(h8*)(Y1 + (size_t)row * HP + n0) = tot[i][ps];
      }
  }
}

__device__ void phase_E2(const Params& p, int layer, unsigned char* lds, int my_xcc, int my_loc, const unsigned* xcnt) {
  const int tid = otid(), w = tid >> 6, l = tid & 63;
  const half_t* Y1 = (const half_t*)(p.ws + OFF_H);
  const half_t* Wo = (const half_t*)(p.ws + OFF_WOUTT) + (size_t)layer * 1024 * WP;
  float* Y = (float*)(p.ws + OFF_ST);
  const int wm = w >> 1, wn = w & 1;
  const int nx = xcc_census(xcnt, my_xcc);
  const int nrounds = (nx > 0) ? (64 + nx - 1) / nx : (512 + (int)gridDim.x - 1) / (int)gridDim.x;
  for (int rnd = 0; rnd < nrounds; ++rnd) {
    int mt, nt;
    if (nx > 0) {
      const int s = my_loc + nx * rnd;
      if (s >= 64) continue;
      mt = my_xcc * 8 + (s & 7); nt = s >> 3;
    } else {
      const int tix = rnd * (int)gridDim.x + (int)blockIdx.x;
      if (tix >= 512) continue;
      mt = tix & 63; nt = tix >> 6;
    }
    f16v acc[4][2];
    zero_acc<2>(acc);
    gemm_kloop<2>(acc, Y1 + (size_t)mt * 256 * HP, HP, Wo + (size_t)nt * 128 * WP, WP, 1024, lds);
    const int m0w = mt * 256 + wm * 128;
    const int n0w = nt * 128 + wn * 64;
#pragma unroll
    for (int i = 0; i < 4; ++i)
#pragma unroll
      for (int j = 0; j < 2; ++j)
#pragma unroll
        for (int r = 0; r < 16; ++r) {
          const int row = m0w + i * 32 + crow(r, l);
          const int n = n0w + j * 32 + (l & 31);
          Y[(size_t)row * 1024 + n] = acc[i][j][r];
        }
  }
}

__device__ void phase_E3(const Params& p, int layer) {
  const int w = otid() >> 6, l = otid() & 63;
  const float* Y = (const float*)(p.ws + OFF_ST);
  const float* MOD = (const float*)(p.ws + OFF_MOD);
  half_t* H = (half_t*)(p.ws + OFF_H);
  const float* xin = (layer == 0) ? p.x : p.out;
  const float* gate = MOD + layer * 3072 + 2048;
  const float* post = p.post_norm + layer * 1024;
  const int stride = gridDim.x * 4;
  int row = blockIdx.x * 4 + w;
  f4v yn[4], xn[4];
  if (row < S_LEN) {
#pragma unroll
    for (int i = 0; i < 4; ++i) {
      yn[i] = *(const f4v*)(Y + (size_t)row * 1024 + i * 256 + l * 4);
      xn[i] = *(const f4v*)(xin + (size_t)row * 1024 + i * 256 + l * 4);
    }
  }
  for (; row < S_LEN; row += stride) {
    float yv[16], xv[16];
    float ss = 0.f;
#pragma unroll
    for (int i = 0; i < 4; ++i)
#pragma unroll
      for (int q = 0; q < 4; ++q) { yv[i * 4 + q] = yn[i][q]; xv[i * 4 + q] = xn[i][q]; ss += yn[i][q] * yn[i][q]; }
    const int nrow = (row + stride < S_LEN) ? (row + stride) : row;
#pragma unroll
    for (int i = 0; i < 4; ++i) {
      yn[i] = *(const f4v*)(Y + (size_t)nrow * 1024 + i * 256 + l * 4);
      xn[i] = *(const f4v*)(xin + (size_t)nrow * 1024 + i * 256 + l * 4);
    }
    ss = wave_sum(ss);
    const float rs = rsqrtf(ss * (1.0f / 1024.0f) + 1e-6f);
#pragma unroll
    for (int i = 0; i < 4; ++i) {
      const int c0 = i * 256 + l * 4;
      f4v gt = *(const f4v*)(gate + c0);
      f4v pn = *(const f4v*)(post + c0);
      f4v o;
#pragma unroll
      for (int q = 0; q < 4; ++q) { o[q] = xv[i * 4 + q] + gt[q] * (yv[i * 4 + q] * rs * pn[q]); xv[i * 4 + q] = o[q]; }
      *(f4v*)(p.out + (size_t)row * 1024 + c0) = o;
    }
    if (layer + 1 < DEPTH)
      write_h_row(xv, p.pre_norm + (layer + 1) * 1024, MOD + (layer + 1) * 3072, H + (size_t)row * HP, l);
  }
}

#define XB_TMO      128
#define XB_XCNT(j)  (256  + 64 * (j))
#define XB_XSUB(j)  (1280 + 64 * (j))
#define XB_XGEN(j)  (2304 + 64 * (j))
#define XB_TOP      3328
#define XB_TOPGEN   3392
#define XCD_BAR_WORDS 3456
#define XB_SPIN_CAP (1u << 18)
#define LAS __attribute__((address_space(3)))

__device__ __forceinline__ unsigned xb_ld(unsigned* p)              { return __hip_atomic_load(p, __ATOMIC_RELAXED, __HIP_MEMORY_SCOPE_AGENT); }
__device__ __forceinline__ unsigned xb_add(unsigned* p, unsigned v) { return __hip_atomic_fetch_add(p, v, __ATOMIC_RELAXED, __HIP_MEMORY_SCOPE_AGENT); }
__device__ __forceinline__ unsigned xb_xcc_id() { return (unsigned)__builtin_amdgcn_s_getreg((3 << 11) | 20) & 0xFu; }
#define XB_SPIN(cond, bar) do { unsigned _sp = 0; while (cond) { __builtin_amdgcn_s_sleep(1); \
    if ((++_sp & 255u) == 0u) { if (xb_ld(&(bar)[XB_TMO])) break; if (_sp > XB_SPIN_CAP) { atomicAdd(&(bar)[XB_TMO], 1u); break; } } } } while (0)

struct XcdBarrier {
    unsigned* bar; unsigned x;
    volatile LAS unsigned* st;
};

__device__ __forceinline__ XcdBarrier xcd_barrier_post(unsigned* bar, volatile LAS unsigned* st) {
    XcdBarrier b; b.bar = bar; b.x = xb_xcc_id(); b.st = st;
    if (otid() == 0) (void)xb_add(&bar[XB_XCNT(b.x)], 1u);
    return b;
}
__device__ __forceinline__ void xcd_barrier_complete(unsigned* bar, unsigned x, unsigned& nloc, unsigned& nx) {
    const unsigned G = gridDim.x * gridDim.y * gridDim.z;
    unsigned sum, cnt, mine, sp = 0u;
    for (;;) {
        sum = 0u; cnt = 0u; mine = 0u;
#pragma unroll
        for (unsigned j = 0; j < 16; ++j) { const unsigned c = xb_ld(&bar[XB_XCNT(j)]); sum += c; cnt += (c > 0u) ? 1u : 0u; mine = (j == x) ? c : mine; }
        if (sum == G) break;
        __builtin_amdgcn_s_sleep(1);
        if ((++sp & 255u) == 0u) { if (xb_ld(&bar[XB_TMO])) break; if (sp > XB_SPIN_CAP) { atomicAdd(&bar[XB_TMO], 1u); break; } }
    }
    nloc = mine > 0u ? mine : 1u; nx = cnt > 0u ? cnt : 1u;
}

__device__ __forceinline__ void xcd_barrier(const XcdBarrier& b) {
    asm volatile("s_waitcnt vmcnt(0)" ::: "memory");
    __syncthreads();
    if (otid() == 0) {
        unsigned* bar = b.bar;
        __builtin_amdgcn_s_waitcnt(0);
        unsigned nloc = b.st[0], nx = b.st[1];
        if (nloc == 0u) { xcd_barrier_complete(bar, b.x, nloc, nx); b.st[0] = nloc; b.st[1] = nx; }
        const unsigned old = xb_add(&bar[XB_XSUB(b.x)], 1u);
        const unsigned gen = old / nloc;
        if (old + 1u == (gen + 1u) * nloc) {
            __builtin_amdgcn_fence(__ATOMIC_RELEASE, "agent");
            asm volatile("s_waitcnt vmcnt(0)" ::: "memory");
            const unsigned og = xb_add(&bar[XB_TOP], 1u);
            const unsigned tg = og / nx;
            if (og + 1u == (tg + 1u) * nx) xb_add(&bar[XB_TOPGEN], 1u);
            else XB_SPIN(xb_ld(&bar[XB_TOPGEN]) == tg, bar);
            __builtin_amdgcn_fence(__ATOMIC_ACQUIRE, "agent");
            xb_add(&bar[XB_XGEN(b.x)], 1u);
            asm volatile("s_waitcnt vmcnt(0)" ::: "memory");
        } else {
            XB_SPIN(xb_ld(&bar[XB_XGEN(b.x)]) == gen, bar);
            __builtin_amdgcn_fence(__ATOMIC_ACQUIRE, "agent");
            asm volatile("s_waitcnt vmcnt(0)" ::: "memory");
        }
    }
    __syncthreads();
}


};

#ifndef REP_D
#define REP_D 1
#endif
#ifndef REP_E
#define REP_E 1
#endif
#ifndef REP_A
#define REP_A 1
#endif
#ifndef REP_B
#define REP_B 1
#endif
#ifdef ONLY_PHASE
#define PH_EN(x) (ONLY_PHASE == (x))
#else
#define PH_EN(x) true
#endif
__global__ void __launch_bounds__(NTHREADS) fwd_megakernel(Params p) {
  extern __shared__ __attribute__((aligned(16))) unsigned char lds[];
  cg::grid_group grid = cg::this_grid();
  K k; k.wbase = __builtin_amdgcn_readfirstlane((int)__builtin_amdgcn_workitem_id_x()) & ~63;
  unsigned* bar = (unsigned*)(p.ws + WS_END);
  unsigned* xcnt = bar + 16;
  unsigned* xbar = (unsigned*)(p.ws + WS_END + 1024);
  if (blockIdx.x == 0) {
    if (k.otid() < 17) __hip_atomic_store(bar + (k.otid() == 16 ? 0 : 16 + k.otid()), 0u, __ATOMIC_RELAXED, __HIP_MEMORY_SCOPE_AGENT);
    for (int i = k.otid(); i < XCD_BAR_WORDS; i += NTHREADS) __hip_atomic_store(xbar + i, 0u, __ATOMIC_RELAXED, __HIP_MEMORY_SCOPE_AGENT);
  }
  volatile LAS unsigned* xst = (volatile LAS unsigned*)(lds + LDS_BYTES - 16);
  if (k.otid() == 0) { xst[0] = 0u; xst[1] = 0u; }
  __syncthreads();
  K::XcdBarrier xb; xb.bar = xbar; xb.x = 0; xb.st = xst;
  int my_xcc = 0, my_loc = 0;
  for (int ph = p.ph_lo; ph < p.ph_hi; ++ph) {
    if (ph == 0) { if (PH_EN(0)) for (int rep = 0; rep < REP_P; ++rep) { k.phase_prologue(p, lds); __syncthreads(); } }
    else if (ph == 1) {
      xb = k.xcd_barrier_post(xbar, xst);
      int* sh = (int*)lds;
      if (k.otid() == 0) {
        const int xc = (int)(__builtin_amdgcn_s_getreg((3 << 11) | 20) & 0xFu);
        sh[0] = xc;
        sh[1] = (int)__hip_atomic_fetch_add(xcnt + xc, 1u, __ATOMIC_RELAXED, __HIP_MEMORY_SCOPE_AGENT);
      }
      __syncthreads();
      my_xcc = __builtin_amdgcn_readfirstlane(sh[0]);
      my_loc = __builtin_amdgcn_readfirstlane(sh[1]);
      __syncthreads();
      if (PH_EN(1)) k.phase_h0(p);
    }
    else {
      const int layer = (ph - 2) / 7, sub = (ph - 2) % 7;
      if (sub == 0) { if (PH_EN(2)) for (int rep = 0; rep < REP_A; ++rep) { k.phase_A(p, layer, lds, my_xcc, my_loc, xcnt); __syncthreads(); } }
      else if (sub == 1) { if (PH_EN(3)) for (int rep = 0; rep < REP_B; ++rep) { k.phase_B(p, layer, lds); __syncthreads(); } }
      else if (sub == 2) { if (PH_EN(4)) k.phase_scan(p); }
      else if (sub == 3) { if (PH_EN(5)) for (int rep = 0; rep < REP_D; ++rep) { for (int it = blockIdx.x; it < 2048; it += gridDim.x) k.la_item_out(p, layer, it, lds); __syncthreads(); } }
      else if (sub == 4) { if (PH_EN(6)) for (int rep = 0; rep < REP_E; ++rep) { k.phase_E1(p, layer, lds, my_xcc, my_loc, xcnt); __syncthreads(); } }
      else if (sub == 5) { if (PH_EN(7)) for (int rep = 0; rep < REP_E; ++rep) { k.phase_E2(p, layer, lds, my_xcc, my_loc, xcnt); __syncthreads(); } }
      else { if (PH_EN(8)) k.phase_E3(p, layer); }
    }
    if (ph + 1 < p.ph_hi) {
      if (ph == p.ph_lo) grid.sync();
      else k.xcd_barrier(xb);
    }
  }
}

extern "C" void kernel_launch(void* const* d_in, const int* in_sizes, int n_in, void* d_out, int out_size,
                              void* d_ws, size_t ws_size, hipStream_t stream) {
  static int grid_blocks = 0;
  if (!grid_blocks) {
    int dev = 0, cus = 0, per_cu = 0;
    hipGetDevice(&dev);
    hipDeviceGetAttribute(&cus, hipDeviceAttributeMultiprocessorCount, dev);
    hipFuncSetAttribute((const void*)fwd_megakernel, hipFuncAttributeMaxDynamicSharedMemorySize, LDS_BYTES);
    hipOccupancyMaxActiveBlocksPerMultiprocessor(&per_cu, (const void*)fwd_megakernel, NTHREADS, LDS_BYTES);
    if (per_cu < 1) per_cu = 1;
    if (per_cu > 1) per_cu = 1;
    grid_blocks = cus * per_cu;
    if (ws_size < WS_END) fprintf(stderr, "workspace too small: %zu < %llu\n", ws_size, (unsigned long long)WS_END);
  }
  Params p{};
  p.x = (const float*)d_in[0]; p.c = (const float*)d_in[1]; p.pos = (const int*)d_in[2];
  p.ada_w = (const float*)d_in[3]; p.ada_b = (const float*)d_in[4];
  p.pre_norm = (const float*)d_in[5]; p.post_norm = (const float*)d_in[6];
  p.w_in = (const float*)d_in[7]; p.gla_w_lr = (const float*)d_in[8]; p.gla_b_lr = (const float*)d_in[9];
  p.w_br_ret = (const float*)d_in[10]; p.w_br_dsa = (const float*)d_in[11]; p.w_br_gla = (const float*)d_in[12];
  p.w_out = (const float*)d_in[13];
  p.out = (float*)d_out; p.ws = (unsigned char*)d_ws;
  p.ph_lo = 0; p.ph_hi = 2 + 7 * DEPTH;
  void* args[] = {&p};
  hipError_t e = hipLaunchCooperativeKernel((const void*)fwd_megakernel, dim3(grid_blocks), dim3(NTHREADS), args, LDS_BYTES, stream);
  if (e != hipSuccess) fprintf(stderr, "cooperative launch failed: %s (grid %d)\n", hipGetErrorString(e), grid_blocks);
}
```

```cpp
#include <hip/hip_runtime.h>
#include <hip/hip_cooperative_groups.h>
#include <stdint.h>
#include <cstdio>
namespace cg = cooperative_groups;
#ifndef REP_P
#define REP_P 1
#endif
#ifndef REP_KV
#define REP_KV 1
#endif
#ifndef REP_SEL
#define REP_SEL 1
#endif
#ifndef REP_ATT
#define REP_ATT 1
#endif

typedef _Float16 half_t;
typedef _Float16 h8 __attribute__((ext_vector_type(8)));
typedef _Float16 h4 __attribute__((ext_vector_type(4)));
typedef _Float16 h2 __attribute__((ext_vector_type(2)));
typedef float f16v __attribute__((ext_vector_type(16)));
typedef float f4v __attribute__((ext_vector_type(4)));

#define S_LEN 16384
#define DM 1024
#define NIN 7764
#define NPAD 7936
#define PP 7808
#define DEPTH 4
#define NTHREADS 256
#define HP 1088
#define WP 1088
#define WBP 576
#define LDS_BYTES 149504

#define C_RETQ 0
#define C_RETK 256
#define C_RETV 512
#define C_RETG 1024
#define C_DSAQ 1536
#define C_DSAK 2048
#define C_DSAV 2176
#define C_DSAG 2304
#define C_IDXQ 2816
#define C_IDXK 3072
#define C_GLAQ 3136
#define C_GLAK 3392
#define C_GLAV 3648
#define C_GLAG 4160
#define C_GLAA 4672
#define C_MRG 4688
#define C_END 7760
#define C_IDXW 7760

#define OFF_WINT 0ull
#define OFF_WBRT (OFF_WINT + 4ull * NPAD * WP * 2)
#define OFF_WOUTT (OFF_WBRT + 4ull * 3 * 1024 * WBP * 2)
#define OFF_MOD (OFF_WOUTT + 4ull * 1024 * WP * 2)
#define OFF_RT (OFF_MOD + 4ull * 3072 * 4)
#define OFF_DT (OFF_RT + 16384ull * 64 * 4)
#define OFF_H (OFF_DT + 16384ull * 16 * 4)
#define OFF_P (OFF_H + 16384ull * HP * 2)
#define OFF_GA (OFF_P + 16384ull * PP * 2)
#define OFF_IW (OFF_GA + 16384ull * 16 * 4)
#define OFF_ST (OFF_IW + 16384ull * 4 * 4)
#define OFF_DEC (OFF_ST + 256ull * 65536 * 4)
#define OFF_BR (OFF_DEC + 256ull * 8 * 64 * 4)
#define WS_END (OFF_BR + 16384ull * 1536 * 2)
static_assert(WS_END + 16384 <= 508821504ull, "workspace too large");

struct Params {
  const float* x; const float* c; const int* pos; const float* ada_w; const float* ada_b;
  const float* pre_norm; const float* post_norm; const float* w_in; const float* gla_w_lr;
  const float* gla_b_lr; const float* w_br_ret; const float* w_br_dsa; const float* w_br_gla;
  const float* w_out; float* out; unsigned char* ws;
  int ph_lo; int ph_hi;
};

struct K {
int wbase;
__device__ __forceinline__ int otid() const {
  int lane;
  asm volatile("v_mbcnt_lo_u32_b32 %0, -1, 0\n\tv_mbcnt_hi_u32_b32 %0, -1, %0" : "=v"(lane));
  return wbase | lane;
}
__device__ __forceinline__ static float ozero() { float z = 0.f; asm volatile("" : "+v"(z)); return z; }
template <int CTRL>
__device__ __forceinline__ float dppf(float v) {
  return __int_as_float(__builtin_amdgcn_update_dpp(0, __float_as_int(v), CTRL, 0xF, 0xF, true));
}
template <int CTRL>
__device__ __forceinline__ unsigned dppu(unsigned v) {
  return (unsigned)__builtin_amdgcn_update_dpp(0, (int)v, CTRL, 0xF, 0xF, true);
}
__device__ __forceinline__ int olane() { return otid() & 63; }
__device__ __forceinline__ float xor16f(float v) { return __int_as_float(__builtin_amdgcn_ds_bpermute((olane() ^ 16) << 2, __float_as_int(v))); }
__device__ __forceinline__ float xor32f(float v) { return __int_as_float(__builtin_amdgcn_ds_bpermute((olane() ^ 32) << 2, __float_as_int(v))); }
__device__ __forceinline__ unsigned xor16u(unsigned v) { return (unsigned)__builtin_amdgcn_ds_bpermute((olane() ^ 16) << 2, (int)v); }
__device__ __forceinline__ unsigned xor32u(unsigned v) { return (unsigned)__builtin_amdgcn_ds_bpermute((olane() ^ 32) << 2, (int)v); }
__device__ __forceinline__ float rl_f(float v, int lane) { return __int_as_float(__builtin_amdgcn_readlane(__float_as_int(v), lane)); }
__device__ __forceinline__ float wave_sum(float v) {
  v += dppf<0xB1>(v); v += dppf<0x4E>(v); v += dppf<0x141>(v); v += dppf<0x140>(v);
  return (rl_f(v, 0) + rl_f(v, 16)) + (rl_f(v, 32) + rl_f(v, 48));
}
__device__ __forceinline__ float wave_max(float v) {
  v = fmaxf(v, dppf<0xB1>(v)); v = fmaxf(v, dppf<0x4E>(v)); v = fmaxf(v, dppf<0x141>(v)); v = fmaxf(v, dppf<0x140>(v));
  return fmaxf(fmaxf(rl_f(v, 0), rl_f(v, 16)), fmaxf(rl_f(v, 32), rl_f(v, 48)));
}
__device__ __forceinline__ unsigned wave_or(unsigned v) {
  v |= dppu<0xB1>(v); v |= dppu<0x4E>(v); v |= dppu<0x141>(v); v |= dppu<0x140>(v);
  return (unsigned)(__builtin_amdgcn_readlane((int)v, 0) | __builtin_amdgcn_readlane((int)v, 16) | __builtin_amdgcn_readlane((int)v, 32) | __builtin_amdgcn_readlane((int)v, 48));
}
__device__ __forceinline__ unsigned wave_incl_scan(unsigned v) {
  v += (unsigned)__builtin_amdgcn_update_dpp(0, (int)v, 0x111, 0xF, 0xF, false);
  v += (unsigned)__builtin_amdgcn_update_dpp(0, (int)v, 0x112, 0xF, 0xF, false);
  v += (unsigned)__builtin_amdgcn_update_dpp(0, (int)v, 0x114, 0xF, 0xF, false);
  v += (unsigned)__builtin_amdgcn_update_dpp(0, (int)v, 0x118, 0xF, 0xF, false);
  v += (unsigned)__builtin_amdgcn_update_dpp(0, (int)v, 0x142, 0xA, 0xF, false);
  v += (unsigned)__builtin_amdgcn_update_dpp(0, (int)v, 0x143, 0xC, 0xF, false);
  return v;
}
__device__ __forceinline__ f16v mfma16(h8 a, h8 b, f16v c) {
  return __builtin_amdgcn_mfma_f32_32x32x16_f16(a, b, c, 0, 0, 0);
}
__device__ __forceinline__ float relu_f(float x) { return __int_as_float(max(__float_as_int(x), 0)); }
__device__ __forceinline__ int crow(int r, int l) { return (r & 3) + 8 * (r >> 2) + 4 * (l >> 5); }

__device__ __forceinline__ int win_col(int nv) {
  if (nv < 3136) return nv;
  if (nv < 7760) return nv + 4;
  if (nv < 7764) return nv - 7760 + 3136;
  return -1;
}
__device__ void transpose_tile(const float* __restrict__ src, int ldn, half_t* __restrict__ dst, int K,
                               int k0, int n0, int mapmode, unsigned char* lds) {
  float* T = (float*)lds;
  const int tid = otid();
  const int nn = tid & 63;
  int col = n0 + nn;
  if (mapmode) col = win_col(col);
#pragma unroll
  for (int i = 0; i < 16; ++i) {
    int kk = (tid >> 6) + 4 * i;
    float v = 0.f;
    if (col >= 0) v = src[(size_t)(k0 + kk) * ldn + col];
    T[kk * 65 + nn] = v;
  }
  __syncthreads();
#pragma unroll
  for (int i = 0; i < 2; ++i) {
    int n2 = (tid >> 3) + 32 * i;
    int kc = tid & 7;
    h8 o;
#pragma unroll
    for (int q = 0; q < 8; ++q) o[q] = (half_t)T[(kc * 8 + q) * 65 + n2];
    *(h8*)(dst + (size_t)(n0 + n2) * K + k0 + kc * 8) = o;
  }
  __syncthreads();
}

__device__ void phase_prologue(const Params& p, unsigned char* lds) {
  const int tid = otid();
  half_t* WinT = (half_t*)(p.ws + OFF_WINT);
  half_t* WbrT = (half_t*)(p.ws + OFF_WBRT);
  half_t* WoutT = (half_t*)(p.ws + OFF_WOUTT);
  float* MOD = (float*)(p.ws + OFF_MOD);
  float* RT = (float*)(p.ws + OFF_RT);
  float* DT = (float*)(p.ws + OFF_DT);
  const int T_WIN = 4 * 124 * 16;
  const int T_WBR = 12 * 16 * 8;
  const int T_WOUT = 4 * 16 * 16;
  const int T_MOD = 192;
  const int T_ROPE = 16384 * 40 / 256;
  const int total = T_WIN + T_WBR + T_WOUT + T_MOD + T_ROPE;
  {
    float* T = (float*)lds;
    const int nn = tid & 63;
    float cur[16], nxt[16];
    int task = blockIdx.x;
    if (task < T_WIN) {
      const int l = task / (124 * 16), r = task % (124 * 16), nt = r / 16, kt = r % 16;
      const int col = win_col(nt * 64 + nn);
      const float* src = p.w_in + (size_t)l * 1024 * NIN;
#pragma unroll
      for (int i = 0; i < 16; ++i) { const int kk = (tid >> 6) + 4 * i; cur[i] = (col >= 0) ? src[(size_t)(kt * 64 + kk) * NIN + col] : 0.f; }
    }
    for (; task < T_WIN; task += gridDim.x) {
      const int tn = (task + (int)gridDim.x < T_WIN) ? task + (int)gridDim.x : task;
      {
        const int l = tn / (124 * 16), r = tn % (124 * 16), nt = r / 16, kt = r % 16;
        const int col = win_col(nt * 64 + nn);
        const float* src = p.w_in + (size_t)l * 1024 * NIN;
#pragma unroll
        for (int i = 0; i < 16; ++i) { const int kk = (tid >> 6) + 4 * i; nxt[i] = (col >= 0) ? src[(size_t)(kt * 64 + kk) * NIN + col] : 0.f; }
      }
      const int l = task / (124 * 16), r = task % (124 * 16), nt = r / 16, kt = r % 16;
      half_t* dst = WinT + (size_t)l * NPAD * WP;
#pragma unroll
      for (int i = 0; i < 16; ++i) T[((tid >> 6) + 4 * i) * 65 + nn] = cur[i];
      __syncthreads();
#pragma unroll
      for (int i = 0; i < 2; ++i) {
        const int n2 = (tid >> 3) + 32 * i, kc = tid & 7;
        h8 o;
#pragma unroll
        for (int q = 0; q < 8; ++q) o[q] = (half_t)T[(kc * 8 + q) * 65 + n2];
        *(h8*)(dst + (size_t)(nt * 64 + n2) * WP + kt * 64 + kc * 8) = o;
      }
      __syncthreads();
#pragma unroll
      for (int i = 0; i < 16; ++i) cur[i] = nxt[i];
    }
  }
  for (int task = blockIdx.x; task < total; task += gridDim.x) {
    int t = task;
    if (t < T_WIN) continue;
    if (t < T_WIN) {
      int l = t / (124 * 16); int r = t % (124 * 16); int nt = r / 16, kt = r % 16;
      transpose_tile(p.w_in + (size_t)l * 1024 * NIN, NIN, WinT + (size_t)l * NPAD * WP, WP, kt * 64, nt * 64, 1, lds);
      continue;
    }
    t -= T_WIN;
    if (t < T_WBR) {
      int lb = t / 128; int r = t % 128; int nt = r / 8, kt = r % 8;
      int l = lb / 3, b = lb % 3;
      const float* src = (b == 0 ? p.w_br_ret : (b == 1 ? p.w_br_dsa : p.w_br_gla)) + (size_t)l * 512 * 1024;
      transpose_tile(src, 1024, WbrT + (size_t)lb * 1024 * WBP, WBP, kt * 64, nt * 64, 0, lds);
      continue;
    }
    t -= T_WBR;
    if (t < T_WOUT) {
      int l = t / 256; int r = t % 256; int nt = r / 16, kt = r % 16;
      transpose_tile(p.w_out + (size_t)l * 1024 * 1024, 1024, WoutT + (size_t)l * 1024 * WP, WP, kt * 64, nt * 64, 0, lds);
      continue;
    }
    t -= T_WOUT;
    if (t < T_MOD) {
      int l = t / 48, jb = t % 48;
      int j = jb * 64 + (tid & 63);
      int ig = tid >> 6;
      float acc = 0.f;
      const float* aw = p.ada_w + (size_t)l * 1024 * 3072;
      for (int i = ig * 256; i < ig * 256 + 256; ++i) {
        float cv = p.c[i];
        float sc = cv / (1.f + expf(-cv));
        acc += sc * aw[(size_t)i * 3072 + j];
      }
      float* red = (float*)lds;
      red[tid] = acc;
      __syncthreads();
      if (tid < 64) {
        float s = red[tid] + red[tid + 64] + red[tid + 128] + red[tid + 192];
        MOD[l * 3072 + j] = s + p.ada_b[l * 3072 + j];
      }
      __syncthreads();
      continue;
    }
    t -= T_MOD;
    {
      int e = t * 256 + tid;
      int tok = e / 40, f = e % 40;
      float pf = (float)p.pos[tok];
      if (f < 32) {
        float fr = powf(10000.0f, -(float)f * 2.0f / 64.0f);
        float ang = pf * fr;
        RT[tok * 64 + f * 2] = cosf(ang);
        RT[tok * 64 + f * 2 + 1] = sinf(ang);
      } else {
        int g = f - 32;
        float fr = powf(500000.0f, -(float)g * 2.0f / 16.0f);
        float ang = pf * fr;
        DT[tok * 16 + g * 2] = cosf(ang);
        DT[tok * 16 + g * 2 + 1] = sinf(ang);
      }
    }
  }
}

__device__ __forceinline__ void write_h_row(const float (&xv)[16], const float* __restrict__ pre,
                                            const float* __restrict__ mod, half_t* __restrict__ hrow, int l) {
  float ss = 0.f;
#pragma unroll
  for (int i = 0; i < 16; ++i) ss += xv[i] * xv[i];
  ss = wave_sum(ss);
  float rs = rsqrtf(ss * (1.0f / 1024.0f) + 1e-6f);
#pragma unroll
  for (int i = 0; i < 4; ++i) {
    int c0 = i * 256 + l * 4;
    f4v pg = *(const f4v*)(pre + c0);
    f4v sh = *(const f4v*)(mod + c0);
    f4v sc = *(const f4v*)(mod + 1024 + c0);
    h4 o;
#pragma unroll
    for (int q = 0; q < 4; ++q) o[q] = (half_t)(xv[i * 4 + q] * rs * pg[q] * (1.f + sc[q]) + sh[q]);
    *(h4*)(hrow + c0) = o;
  }
}

__device__ void phase_h0(const Params& p) {
  const int w = otid() >> 6, l = otid() & 63;
  half_t* H = (half_t*)(p.ws + OFF_H);
  const float* MOD = (const float*)(p.ws + OFF_MOD);
  for (int row = blockIdx.x * 4 + w; row < S_LEN; row += gridDim.x * 4) {
    float xv[16];
#pragma unroll
    for (int i = 0; i < 4; ++i) {
      f4v v = *(const f4v*)(p.x + (size_t)row * 1024 + i * 256 + l * 4);
      xv[i * 4] = v[0]; xv[i * 4 + 1] = v[1]; xv[i * 4 + 2] = v[2]; xv[i * 4 + 3] = v[3];
    }
    write_h_row(xv, p.pre_norm, MOD, H + (size_t)row * HP, l);
  }
}

__device__ __forceinline__ void lds_barrier() {
  asm volatile("s_waitcnt lgkmcnt(0)" ::: "memory");
  __builtin_amdgcn_s_barrier();
  asm volatile("" ::: "memory");
}
#define GEMM_BUF 55296
#define GEMM_EOFF 110592
template <int NT>
__device__ __forceinline__ void gemm_step(f16v (&acc)[4][NT], h8 (&ra)[8], h8 (&rb)[2 * NT],
                                          const unsigned char* As, const unsigned char* Bs, unsigned char* Aw, unsigned char* Bw,
                                          const half_t* __restrict__ A, int lda, const half_t* __restrict__ B, int ldb, int kload,
                                          int wm, int wn, int l, int r0, int kc) {
  h8 af[2][4], bf[2][NT];
#pragma unroll
  for (int i = 0; i < 4; ++i) af[0][i] = *(const h8*)(As + (wm * 128 + i * 32 + (l & 31)) * 144 + (l >> 5) * 16);
#pragma unroll
  for (int j = 0; j < NT; ++j) bf[0][j] = *(const h8*)(Bs + (wn * 32 * NT + j * 32 + (l & 31)) * 144 + (l >> 5) * 16);
#pragma unroll
  for (int ks = 0; ks < 4; ++ks) {
    if (ks < 3) {
#pragma unroll
      for (int i = 0; i < 4; ++i) af[(ks + 1) & 1][i] = *(const h8*)(As + (wm * 128 + i * 32 + (l & 31)) * 144 + (ks + 1) * 32 + (l >> 5) * 16);
#pragma unroll
      for (int j = 0; j < NT; ++j) bf[(ks + 1) & 1][j] = *(const h8*)(Bs + (wn * 32 * NT + j * 32 + (l & 31)) * 144 + (ks + 1) * 32 + (l >> 5) * 16);
    }
    __builtin_amdgcn_sched_barrier(0);
#pragma unroll
    for (int i = 0; i < 4; ++i)
#pragma unroll
      for (int j = 0; j < NT; ++j) acc[i][j] = mfma16(af[ks & 1][i], bf[ks & 1][j], acc[i][j]);
#pragma unroll
    for (int i = 2 * ks; i < 2 * ks + 2; ++i) {
      *(h8*)(Aw + (r0 + 32 * i) * 144 + kc * 16) = ra[i];
      ra[i] = *(const h8*)(A + (size_t)(r0 + 32 * i) * lda + kload + kc * 8);
    }
    if (NT == 2) {
      *(h8*)(Bw + (r0 + 32 * ks) * 144 + kc * 16) = rb[ks];
      rb[ks] = *(const h8*)(B + (size_t)(r0 + 32 * ks) * ldb + kload + kc * 8);
    } else {
#pragma unroll
      for (int i = 2 * ks; i < 2 * ks + 2; ++i) {
        *(h8*)(Bw + (r0 + 32 * i) * 144 + kc * 16) = rb[i];
        rb[i] = *(const h8*)(B + (size_t)(r0 + 32 * i) * ldb + kload + kc * 8);
      }
    }
    __builtin_amdgcn_sched_barrier(0);
  }
}
template <int NT>
__device__ __forceinline__ void gemm_issue(h8 (&ra0)[8], h8 (&rb0)[2 * NT], h8 (&ra1)[8], h8 (&rb1)[2 * NT],
                                           const half_t* __restrict__ A, int lda, const half_t* __restrict__ B, int ldb) {
  const int tid = otid();
  const int kc = tid & 7, r0 = tid >> 3;
#pragma unroll
  for (int i = 0; i < 8; ++i) ra0[i] = *(const h8*)(A + (size_t)(r0 + 32 * i) * lda + kc * 8);
#pragma unroll
  for (int i = 0; i < 2 * NT; ++i) rb0[i] = *(const h8*)(B + (size_t)(r0 + 32 * i) * ldb + kc * 8);
#pragma unroll
  for (int i = 0; i < 8; ++i) ra1[i] = *(const h8*)(A + (size_t)(r0 + 32 * i) * lda + 64 + kc * 8);
#pragma unroll
  for (int i = 0; i < 2 * NT; ++i) rb1[i] = *(const h8*)(B + (size_t)(r0 + 32 * i) * ldb + 64 + kc * 8);
}
template <int NT>
__device__ __forceinline__ void gemm_run(f16v (&acc)[4][NT], h8 (&ra0)[8], h8 (&rb0)[2 * NT], h8 (&ra1)[8], h8 (&rb1)[2 * NT],
                                         const half_t* __restrict__ A, int lda, const half_t* __restrict__ B, int ldb, int K, unsigned char* lds) {
  const int tid = otid(), w = tid >> 6, l = tid & 63;
  constexpr int STAGE = 256 * 144 + 64 * NT * 144;
  unsigned char* A0 = lds;
  unsigned char* B0 = lds + 256 * 144;
  unsigned char* A1 = lds + STAGE;
  unsigned char* B1 = lds + STAGE + 256 * 144;
  const int wm = w >> 1, wn = w & 1;
  const int kc = tid & 7;
  const int r0 = tid >> 3;
  lds_barrier();
#pragma unroll
  for (int i = 0; i < 8; ++i) { *(h8*)(A0 + (r0 + 32 * i) * 144 + kc * 16) = ra0[i]; ra0[i] = *(const h8*)(A + (size_t)(r0 + 32 * i) * lda + 128 + kc * 8); }
#pragma unroll
  for (int i = 0; i < 2 * NT; ++i) { *(h8*)(B0 + (r0 + 32 * i) * 144 + kc * 16) = rb0[i]; rb0[i] = *(const h8*)(B + (size_t)(r0 + 32 * i) * ldb + 128 + kc * 8); }
  lds_barrier();
  const int nk = K / 64;
#pragma unroll 1
  for (int kt = 0; kt < nk; kt += 2) {
    gemm_step<NT>(acc, ra1, rb1, A0, B0, A1, B1, A, lda, B, ldb, (kt + 3 < nk) ? (kt + 3) * 64 : 0, wm, wn, l, r0, kc);
    lds_barrier();
    gemm_step<NT>(acc, ra0, rb0, A1, B1, A0, B0, A, lda, B, ldb, (kt + 4 < nk) ? (kt + 4) * 64 : 0, wm, wn, l, r0, kc);
    lds_barrier();
  }
}
template <int NT>
__device__ __forceinline__ void gemm_kloop(f16v (&acc)[4][NT], const half_t* __restrict__ A, int lda,
                                           const half_t* __restrict__ B, int ldb, int K, unsigned char* lds) {
  h8 ra0[8], rb0[2 * NT], ra1[8], rb1[2 * NT];
  gemm_issue<NT>(ra0, rb0, ra1, rb1, A, lda, B, ldb);
  gemm_run<NT>(acc, ra0, rb0, ra1, rb1, A, lda, B, ldb, K, lds);
}

template <int NT>
__device__ __forceinline__ void gemm_issue1(h8 (&ra)[8], h8 (&rb)[2 * NT], const half_t* __restrict__ A, int lda, const half_t* __restrict__ B, int ldb) {
  const int tid = otid();
  const int kc = tid & 7, r0 = tid >> 3;
#pragma unroll
  for (int i = 0; i < 8; ++i) ra[i] = *(const h8*)(A + (size_t)(r0 + 32 * i) * lda + kc * 8);
#pragma unroll
  for (int i = 0; i < 2 * NT; ++i) rb[i] = *(const h8*)(B + (size_t)(r0 + 32 * i) * ldb + kc * 8);
}
template <int NT>
__device__ __forceinline__ void gemm_run1(f16v (&acc)[4][NT], h8 (&ra)[8], h8 (&rb)[2 * NT],
                                          const half_t* __restrict__ A, int lda, const half_t* __restrict__ B, int ldb, int K, unsigned char* lds) {
  const int tid = otid(), w = tid >> 6, l = tid & 63;
  constexpr int STAGE = 256 * 144 + 64 * NT * 144;
  const int wm = w >> 1, wn = w & 1;
  const int kc = tid & 7;
  const int r0 = tid >> 3;
  lds_barrier();
#pragma unroll
  for (int i = 0; i < 8; ++i) { *(h8*)(lds + (r0 + 32 * i) * 144 + kc * 16) = ra[i]; ra[i] = *(const h8*)(A + (size_t)(r0 + 32 * i) * lda + 64 + kc * 8); }
#pragma unroll
  for (int i = 0; i < 2 * NT; ++i) { *(h8*)(lds + 256 * 144 + (r0 + 32 * i) * 144 + kc * 16) = rb[i]; rb[i] = *(const h8*)(B + (size_t)(r0 + 32 * i) * ldb + 64 + kc * 8); }
  lds_barrier();
  const int nk = K / 64;
#pragma unroll 1
  for (int kt = 0; kt < nk; ++kt) {
    unsigned char* cur = lds + (kt & 1) * STAGE;
    unsigned char* nxt = lds + ((kt + 1) & 1) * STAGE;
    gemm_step<NT>(acc, ra, rb, cur, cur + 256 * 144, nxt, nxt + 256 * 144, A, lda, B, ldb, (kt + 2 < nk) ? (kt + 2) * 64 : 0, wm, wn, l, r0, kc);
    lds_barrier();
  }
}

template <int NT>
__device__ __forceinline__ void zero_acc(f16v (&acc)[4][NT]) {
  float z = 0.f;
  asm volatile("" : "+v"(z));
#pragma unroll
  for (int i = 0; i < 4; ++i)
#pragma unroll
    for (int j = 0; j < NT; ++j)
#pragma unroll
      for (int r = 0; r < 16; ++r) acc[i][j][r] = z;
}

#define EP 68
__device__ __forceinline__ void stage_pair(float* E, const f16v& a0, const f16v& a1, int l) {
#pragma unroll
  for (int r = 0; r < 16; ++r) {
    const int rr = crow(r, l);
    E[rr * EP + (l & 31)] = a0[r];
    E[rr * EP + 32 + (l & 31)] = a1[r];
  }
}
__device__ __forceinline__ void ld8(const float* p, float (&v)[8]) {
  const f4v a = *(const f4v*)p, b = *(const f4v*)(p + 4);
  v[0] = a[0]; v[1] = a[1]; v[2] = a[2]; v[3] = a[3]; v[4] = b[0]; v[5] = b[1]; v[6] = b[2]; v[7] = b[3];
}
__device__ __forceinline__ int xcc_census(const unsigned* xcnt, int my_xcc) {
  unsigned sum = 0; bool ok = my_xcc < 8; int mine = 0;
#pragma unroll
  for (int j = 0; j < 16; ++j) {
    const unsigned c = __hip_atomic_load(xcnt + j, __ATOMIC_RELAXED, __HIP_MEMORY_SCOPE_AGENT);
    sum += c;
    if (j < 8 && c == 0u) ok = false;
    if (j >= 8 && c != 0u) ok = false;
    if (j == my_xcc) mine = (int)c;
  }
  if (sum != gridDim.x) ok = false;
  return ok ? mine : 0;
}

__device__ void phase_A(const Params& p, int layer, unsigned char* lds, int my_xcc, int my_loc, const unsigned* xcnt) {
  const int tid = otid(), w = tid >> 6, l = tid & 63;
  const half_t* H = (const half_t*)(p.ws + OFF_H);
  const half_t* Wt = (const half_t*)(p.ws + OFF_WINT) + (size_t)layer * NPAD * WP;
  half_t* P = (half_t*)(p.ws + OFF_P);
  float* GA = (float*)(p.ws + OFF_GA);
  float* IW = (float*)(p.ws + OFF_IW);
  const float* RT = (const float*)(p.ws + OFF_RT);
  const float* DT = (const float*)(p.ws + OFF_DT);
  const int wm = w >> 1, wn = w & 1;
  const int G = gridDim.x;
  const int ntiles = 64 * 31;
  const int nx = xcc_census(xcnt, my_xcc);
  int nmine;
  if (nx > 0) nmine = (my_loc < 248) ? (248 - my_loc + nx - 1) / nx : 0;
  else nmine = ((int)blockIdx.x < ntiles) ? (ntiles - (int)blockIdx.x + G - 1) / G : 0;
  h8 ra0[8], rb0[8];
  int mt = 0, nt = 0;
  if (nmine > 0) {
    if (nx > 0) { const int s0 = my_loc; mt = my_xcc * 8 + (s0 & 7); nt = s0 >> 3; }
    else { const int tix = blockIdx.x; mt = tix & 63; nt = tix >> 6; }
    gemm_issue1<4>(ra0, rb0, H + (size_t)mt * 256 * HP, HP, Wt + (size_t)nt * 256 * WP, WP);
  }
#pragma unroll 1
  for (int rnd = 0; rnd < nmine; ++rnd) {
    f16v acc[4][4];
    zero_acc<4>(acc);
    gemm_run1<4>(acc, ra0, rb0, H + (size_t)mt * 256 * HP, HP, Wt + (size_t)nt * 256 * WP, WP, 1024, lds);
    const int mt_cur = mt, nt_cur = nt;
    if (rnd + 1 < nmine) {
      if (nx > 0) { const int s1 = my_loc + nx * (rnd + 1); mt = my_xcc * 8 + (s1 & 7); nt = s1 >> 3; }
      else { const int tix = (rnd + 1) * G + blockIdx.x; mt = tix & 63; nt = tix >> 6; }
      gemm_issue1<4>(ra0, rb0, H + (size_t)mt * 256 * HP, HP, Wt + (size_t)nt * 256 * WP, WP);
    }
    const int m0w = mt_cur * 256 + wm * 128;
    const int n0w = nt_cur * 256 + wn * 128;
    float* E = (float*)(lds) + w * (32 * EP);
    const int prow = l >> 3, c0 = (l & 7) * 8;
#pragma unroll
    for (int jp = 0; jp < 2; ++jp) {
      const int nb2 = n0w + jp * 64;
      const int n0 = nb2 + c0;
      const bool rope64 = nb2 < 512;
      const bool rope16 = ((nb2 >= C_DSAQ && nb2 < C_DSAV) || (nb2 >= C_IDXQ && nb2 < C_GLAQ)) && (c0 < 16);
      float scale = 1.f;
      if (n0 < 256 || (n0 >= C_DSAQ && n0 < C_DSAK) || (n0 >= C_IDXQ && n0 < C_IDXK) || (n0 >= C_GLAQ && n0 < C_GLAK)) scale = 0.125f;
      int mode = 0;
      if ((n0 >= C_RETG && n0 < C_DSAQ) || (n0 >= C_DSAG && n0 < C_IDXQ) || (n0 >= C_GLAG && n0 < C_GLAA)) mode = 1;
      if (n0 >= C_MRG && n0 < C_END) mode = 2;
#pragma unroll
      for (int i = 0; i < 4; ++i) {
        stage_pair(E, acc[i][2 * jp], acc[i][2 * jp + 1], l);
#pragma unroll 2
        for (int ps = 0; ps < 4; ++ps) {
          const int rl = ps * 8 + prow;
          const int row = m0w + i * 32 + rl;
          float v[8], o[8];
          ld8(E + rl * EP + c0, v);
#pragma unroll
          for (int q = 0; q < 8; ++q) o[q] = v[q];
          if (rope64) {
            float pv[8], tb[16];
            ld8(E + rl * EP + (c0 ^ 32), pv);
            const float* tp = RT + (size_t)row * 64 + (c0 & 31) * 2;
            ld8(tp, *(float(*)[8])&tb[0]); ld8(tp + 8, *(float(*)[8])&tb[8]);
#pragma unroll
            for (int q = 0; q < 8; ++q) o[q] = (c0 < 32) ? (v[q] * tb[2 * q] - pv[q] * tb[2 * q + 1]) : (v[q] * tb[2 * q] + pv[q] * tb[2 * q + 1]);
          } else if (rope16) {
            float pv[8], tb[16];
            ld8(E + rl * EP + (c0 ^ 8), pv);
            const float* tp = DT + (size_t)row * 16;
            ld8(tp, *(float(*)[8])&tb[0]); ld8(tp + 8, *(float(*)[8])&tb[8]);
#pragma unroll
            for (int q = 0; q < 8; ++q) o[q] = (c0 < 8) ? (v[q] * tb[2 * q] - pv[q] * tb[2 * q + 1]) : (v[q] * tb[2 * q] + pv[q] * tb[2 * q + 1]);
          }
          h8 ov;
#pragma unroll
          for (int q = 0; q < 8; ++q) {
            float t = o[q] * scale;
            if (mode != 0) {
              const float sg = __builtin_amdgcn_rcpf(1.f + __expf(-t));
              t = (mode == 1) ? t * sg : sg;
            }
            ov[q] = (half_t)t;
          }
          if (n0 < C_END) __builtin_nontemporal_store(ov, (h8*)(P + (size_t)row * PP + n0));
          if (n0 >= C_GLAA && n0 < C_MRG) {
#pragma unroll
            for (int q = 0; q < 8; ++q) GA[(size_t)row * 16 + (n0 - C_GLAA) + q] = v[q];
          }
          if (n0 == C_IDXW) {
#pragma unroll
            for (int q = 0; q < 4; ++q) IW[(size_t)row * 4 + q] = 0.5f * v[q];
          }
        }
      }
    }
  }
}

#define LA_BC 0
#define LA_GAS 16640
#define LA_WL 20736
#define LA_QT 24832
#define LA_KT 34048
#define LA_AT 43264
#define LA_VT 52480
#define LA_SS 70912
#define LA_OS 89344
#define LA_SEG 123136

__device__ void la_bcum(const Params& p, int layer, int n, int Hh, unsigned char* lds) {
  const int tid = otid();
  float* Bc = (float*)(lds + LA_BC);
  const int d = tid & 63, q = tid >> 6;
  if (Hh < 4) {
    float lg = log1pf(-exp2f(-5.0f - (float)Hh));
#pragma unroll
    for (int jj = 0; jj < 16; ++jj) { int j = q * 16 + jj; Bc[j * 65 + d] = (float)(j + 1) * lg; }
    __syncthreads();
    return;
  }
  const int h = Hh - 4;
  float* GAs = (float*)(lds + LA_GAS);
  float* WL = (float*)(lds + LA_WL);
  float* SEG = (float*)(lds + LA_SEG);
  const float* GA = (const float*)(p.ws + OFF_GA);
#pragma unroll
  for (int i = 0; i < 4; ++i) {
    int e = tid + 256 * i;
    GAs[e] = GA[(size_t)n * 64 * 16 + e];
    int r = e >> 6, dd = e & 63;
    WL[e] = p.gla_w_lr[(size_t)layer * 16 * 256 + r * 256 + h * 64 + dd];
  }
  __syncthreads();
  float wl[16];
#pragma unroll
  for (int r = 0; r < 16; ++r) wl[r] = WL[r * 64 + d];
  const float bl = p.gla_b_lr[layer * 256 + h * 64 + d];
  float run = 0.f;
#pragma unroll
  for (int jj = 0; jj < 16; ++jj) {
    int j = q * 16 + jj;
    float z = bl;
#pragma unroll
    for (int r = 0; r < 16; ++r) z += GAs[j * 16 + r] * wl[r];
    float ls = fminf(z, 0.f) - log1pf(expf(-fabsf(z)));
    run += ls * (1.0f / 16.0f);
    Bc[j * 65 + d] = run;
  }
  SEG[q * 64 + d] = run;
  __syncthreads();
  float off = 0.f;
  for (int qq = 0; qq < q; ++qq) off += SEG[qq * 64 + d];
  if (q > 0) {
#pragma unroll
    for (int jj = 0; jj < 16; ++jj) { int j = q * 16 + jj; Bc[j * 65 + d] += off; }
  }
  __syncthreads();
}

__device__ __forceinline__ void la_load_v(const half_t* __restrict__ P, int t0, int vcol, h8 (&vr)[2][2]) {
  const int tid = otid(), w = tid >> 6, l = tid & 63;
  const int jp = l & 31, cgp = l >> 5;
#pragma unroll
  for (int it = 0; it < 2; ++it) {
    int c = it * 8 + w * 2 + cgp;
    vr[it][0] = *(const h8*)(P + (size_t)(t0 + 2 * jp) * PP + vcol + c * 8);
    vr[it][1] = *(const h8*)(P + (size_t)(t0 + 2 * jp + 1) * PP + vcol + c * 8);
  }
}
__device__ __forceinline__ void la_stage_vt(const h8 (&vr)[2][2], unsigned char* lds) {
  const int tid = otid(), w = tid >> 6, l = tid & 63;
  half_t* VT = (half_t*)(lds + LA_VT);
  const int jp = l & 31, cgp = l >> 5;
#pragma unroll
  for (int it = 0; it < 2; ++it) {
    int c = it * 8 + w * 2 + cgp;
#pragma unroll
    for (int q = 0; q < 8; ++q) {
      h2 pr; pr[0] = vr[it][0][q]; pr[1] = vr[it][1][q];
      *(h2*)(VT + (c * 8 + q) * 72 + 2 * jp) = pr;
    }
  }
}
__device__ void la_item_kv(const Params& p, int layer, int item, unsigned char* lds) {
  const int tid = otid(), w = tid >> 6, l = tid & 63;
  const int n = item >> 3, Hh = item & 7;
  const int t0 = n * 64;
  const half_t* P = (const half_t*)(p.ws + OFF_P);
  half_t* ST = (half_t*)(p.ws + OFF_ST);
  float* DEC = (float*)(p.ws + OFF_DEC);
  const int kcol = (Hh < 4) ? (C_RETK + Hh * 64) : (C_GLAK + (Hh - 4) * 64);
  const int vcol = (Hh < 4) ? (C_RETV + Hh * 128) : (C_GLAV + (Hh - 4) * 128);
  h8 vr[2][2];
  la_load_v(P, t0, vcol, vr);
  const h8 k0 = *(const h8*)(P + (size_t)(t0 + 2 * (l & 31)) * PP + kcol + (w * 2 + (l >> 5)) * 8);
  const h8 k1 = *(const h8*)(P + (size_t)(t0 + 2 * (l & 31) + 1) * PP + kcol + (w * 2 + (l >> 5)) * 8);
  __syncthreads();
  la_bcum(p, layer, n, Hh, lds);
  const float* Bc = (const float*)(lds + LA_BC);
  half_t* KhT = (half_t*)(lds + LA_KT);
  half_t* VT = (half_t*)(lds + LA_VT);
  {
    const int jp = l & 31, cgp = l >> 5;
    int c = w * 2 + cgp;
#pragma unroll
    for (int q = 0; q < 8; ++q) {
      int d = c * 8 + q;
      float bl = Bc[63 * 65 + d];
      h2 pr;
      pr[0] = (half_t)((float)k0[q] * __expf(bl - Bc[(2 * jp) * 65 + d]));
      pr[1] = (half_t)((float)k1[q] * __expf(bl - Bc[(2 * jp + 1) * 65 + d]));
      *(h2*)(KhT + d * 72 + 2 * jp) = pr;
    }
  }
  la_stage_vt(vr, lds);
  if (tid < 64) DEC[(size_t)item * 64 + tid] = __expf(Bc[63 * 65 + tid]);
  __syncthreads();
  f16v acc[2];
#pragma unroll
  for (int j = 0; j < 2; ++j)
#pragma unroll
    for (int r = 0; r < 16; ++r) acc[j][r] = ozero();
#pragma unroll
  for (int ks = 0; ks < 4; ++ks) {
    h8 a = *(const h8*)(VT + (32 * w + (l & 31)) * 72 + ks * 16 + (l >> 5) * 8);
#pragma unroll
    for (int j = 0; j < 2; ++j) {
      h8 b = *(const h8*)(KhT + (j * 32 + (l & 31)) * 72 + ks * 16 + (l >> 5) * 8);
      acc[j] = mfma16(a, b, acc[j]);
    }
  }
#pragma unroll
  for (int j = 0; j < 2; ++j)
#pragma unroll
    for (int r = 0; r < 16; ++r) {
      int e = 32 * w + crow(r, l);
      int d = j * 32 + (l & 31);
      ST[(size_t)item * 8192 + e * 64 + d] = (half_t)acc[j][r];
    }
}

__device__ void phase_scan(const Params& p) {
  half_t* ST = (half_t*)(p.ws + OFF_ST);
  const float* DEC = (const float*)(p.ws + OFF_DEC);
  for (int f2 = blockIdx.x * NTHREADS + otid(); f2 < 32768; f2 += gridDim.x * NTHREADS) {
    const int f = f2 * 2;
    const int Hh = f >> 13, d = f & 63;
    float s0 = 0.f, s1 = 0.f;
    for (int n0 = 0; n0 < 256; n0 += 16) {
      h2 kv[16]; float2 dc[16];
#pragma unroll
      for (int u = 0; u < 16; ++u) {
        kv[u] = *(const h2*)(ST + (size_t)(n0 + u) * 65536 + f);
        dc[u] = *(const float2*)(DEC + (size_t)((n0 + u) * 8 + Hh) * 64 + d);
      }
#pragma unroll
      for (int u = 0; u < 16; ++u) {
        h2 o; o[0] = (half_t)s0; o[1] = (half_t)s1;
        *(h2*)(ST + (size_t)(n0 + u) * 65536 + f) = o;
        s0 = dc[u].x * s0 + (float)kv[u][0];
        s1 = dc[u].y * s1 + (float)kv[u][1];
      }
    }
  }
}

__device__ void la_item_out(const Params& p, int layer, int item, unsigned char* lds) {
  const int tid = otid(), w = tid >> 6, l = tid & 63;
  const int n = item >> 3, Hh = item & 7;
  const int t0 = n * 64;
  const half_t* P = (const half_t*)(p.ws + OFF_P);
  const half_t* ST = (const half_t*)(p.ws + OFF_ST);
  half_t* BR = (half_t*)(p.ws + OFF_BR);
  const int qcol = (Hh < 4) ? (C_RETQ + Hh * 64) : (C_GLAQ + (Hh - 4) * 64);
  const int kcol = (Hh < 4) ? (C_RETK + Hh * 64) : (C_GLAK + (Hh - 4) * 64);
  const int vcol = (Hh < 4) ? (C_RETV + Hh * 128) : (C_GLAV + (Hh - 4) * 128);
  const int gcol = (Hh < 4) ? (C_RETG + Hh * 128) : (C_GLAG + (Hh - 4) * 128);
  const int ocol = (Hh < 4) ? (Hh * 128) : (1024 + (Hh - 4) * 128);
  h8 vr[2][2];
  la_load_v(P, t0, vcol, vr);
  h8 qr[2], kr[2], sr[4];
#pragma unroll
  for (int it = 0; it < 2; ++it) {
    const int c = tid + 256 * it;
    qr[it] = *(const h8*)(P + (size_t)(t0 + (c >> 3)) * PP + qcol + (c & 7) * 8);
    kr[it] = *(const h8*)(P + (size_t)(t0 + (c >> 3)) * PP + kcol + (c & 7) * 8);
  }
#pragma unroll
  for (int it = 0; it < 4; ++it) {
    const int c = tid + 256 * it;
    sr[it] = *(const h8*)(ST + (size_t)item * 8192 + (c >> 3) * 64 + (c & 7) * 8);
  }
  __syncthreads();
  la_bcum(p, layer, n, Hh, lds);
  const float* Bc = (const float*)(lds + LA_BC);
  half_t* Qt = (half_t*)(lds + LA_QT);
  half_t* Kt = (half_t*)(lds + LA_KT);
  half_t* AT = (half_t*)(lds + LA_AT);
  half_t* VT = (half_t*)(lds + LA_VT);
  half_t* SS = (half_t*)(lds + LA_SS);
  float* OS = (float*)(lds + LA_OS);
#pragma unroll
  for (int it = 0; it < 2; ++it) {
    int c = tid + 256 * it;
    int row = c >> 3, kc = c & 7;
    const h8 qv = qr[it];
    const h8 kv = kr[it];
    h8 qo, ko;
#pragma unroll
    for (int q = 0; q < 8; ++q) {
      float b = Bc[row * 65 + kc * 8 + q];
      qo[q] = (half_t)((float)qv[q] * __expf(b));
      ko[q] = (half_t)((float)kv[q] * __expf(-b));
    }
    *(h8*)(Qt + row * 72 + kc * 8) = qo;
    *(h8*)(Kt + row * 72 + kc * 8) = ko;
  }
  la_stage_vt(vr, lds);
#pragma unroll
  for (int it = 0; it < 4; ++it) {
    int c = tid + 256 * it;
    int e = c >> 3, kc = c & 7;
    *(h8*)(SS + e * 72 + kc * 8) = sr[it];
  }
  __syncthreads();
  {
    const int mi = w >> 1, nj = w & 1;
    f16v acc;
#pragma unroll
    for (int r = 0; r < 16; ++r) acc[r] = ozero();
#pragma unroll
    for (int ks = 0; ks < 4; ++ks) {
      h8 a = *(const h8*)(Qt + (mi * 32 + (l & 31)) * 72 + ks * 16 + (l >> 5) * 8);
      h8 b = *(const h8*)(Kt + (nj * 32 + (l & 31)) * 72 + ks * 16 + (l >> 5) * 8);
      acc = mfma16(a, b, acc);
    }
#pragma unroll
    for (int r = 0; r < 16; ++r) {
      int i = mi * 32 + crow(r, l);
      int j = nj * 32 + (l & 31);
      float v = (j <= i) ? acc[r] : 0.f;
      AT[i * 72 + j] = (half_t)v;
    }
  }
  __syncthreads();
  {
    const int mi = w >> 1, nh = w & 1;
    f16v acc[2];
#pragma unroll
    for (int j = 0; j < 2; ++j)
#pragma unroll
      for (int r = 0; r < 16; ++r) acc[j][r] = ozero();
#pragma unroll
    for (int ks = 0; ks < 4; ++ks) {
      h8 a1 = *(const h8*)(AT + (mi * 32 + (l & 31)) * 72 + ks * 16 + (l >> 5) * 8);
      h8 a2 = *(const h8*)(Qt + (mi * 32 + (l & 31)) * 72 + ks * 16 + (l >> 5) * 8);
#pragma unroll
      for (int j = 0; j < 2; ++j) {
        h8 b1 = *(const h8*)(VT + (nh * 64 + j * 32 + (l & 31)) * 72 + ks * 16 + (l >> 5) * 8);
        h8 b2 = *(const h8*)(SS + (nh * 64 + j * 32 + (l & 31)) * 72 + ks * 16 + (l >> 5) * 8);
        acc[j] = mfma16(a1, b1, acc[j]);
        acc[j] = mfma16(a2, b2, acc[j]);
      }
    }
#pragma unroll
    for (int j = 0; j < 2; ++j)
#pragma unroll
      for (int r = 0; r < 16; ++r) {
        int i = mi * 32 + crow(r, l);
        int e = nh * 64 + j * 32 + (l & 31);
        OS[i * 132 + e] = acc[j][r];
      }
  }
  __syncthreads();
  {
    const int i = tid >> 2, qd = tid & 3;
    float ov[32];
    float ss = 0.f;
#pragma unroll
    for (int c = 0; c < 8; ++c) {
      f4v v = *(const f4v*)(OS + i * 132 + qd * 32 + c * 4);
      ov[c * 4] = v[0]; ov[c * 4 + 1] = v[1]; ov[c * 4 + 2] = v[2]; ov[c * 4 + 3] = v[3];
      ss += v[0] * v[0] + v[1] * v[1] + v[2] * v[2] + v[3] * v[3];
    }
    ss += dppf<0xB1>(ss);
    ss += dppf<0x4E>(ss);
    float rs = rsqrtf(ss * (1.0f / 128.0f) + 1e-6f);
#pragma unroll
    for (int c = 0; c < 4; ++c) {
      h8 g = *(const h8*)(P + (size_t)(t0 + i) * PP + gcol + qd * 32 + c * 8);
      h8 o;
#pragma unroll
      for (int q = 0; q < 8; ++q) o[q] = (half_t)(ov[c * 8 + q] * rs * (float)g[q]);
      *(h8*)(BR + (size_t)(t0 + i) * 1536 + ocol + qd * 32 + c * 8) = o;
    }
  }
}

#define DS_CAP 640
#define DS_PRUNE_AT 512
#define NPL 10
#define DS_LS 0
#define DS_LI (32 * DS_CAP * 4)
#define DS_CNT (32 * DS_CAP * 6)
#define DS_THR (DS_CNT + 128)
#define DS_WQ (DS_CNT + 256)
#define DS_HIST (DS_CNT + 1024)
#define DS_PW (DS_CNT + 1024 + 4096)

__device__ __forceinline__ unsigned long long wave_or64(unsigned long long v) {
  const unsigned lo = wave_or((unsigned)v), hi = wave_or((unsigned)(v >> 32));
  return ((unsigned long long)hi << 32) | lo;
}
template <bool APPROX>
__device__ __forceinline__ void dsa_prune(float* LSm, unsigned short* LIm, int n, unsigned* hist, int* cntm, float* thrm, int l) {
  unsigned long long comp[NPL];
  bool act[NPL], val[NPL];
#pragma unroll
  for (int k = 0; k < NPL; ++k) {
    int e = l + 64 * k;
    val[k] = e < n;
    const int ec = val[k] ? e : 0;
    unsigned u = __float_as_uint(LSm[ec]), li = LIm[ec];
    if (!val[k]) { u = 0; li = 0; }
    const unsigned key = (u >> 31) ? ~u : (u | 0x80000000u);
    comp[k] = ((unsigned long long)key << 14) | (unsigned long long)(16383u - li);
    act[k] = val[k];
  }
  const unsigned long long c0 = ((unsigned long long)(unsigned)__builtin_amdgcn_readfirstlane((int)(unsigned)(comp[0] >> 32)) << 32) | (unsigned)__builtin_amdgcn_readfirstlane((int)(unsigned)comp[0]);
  unsigned long long x = 0;
#pragma unroll
  for (int k = 0; k < NPL; ++k) x |= val[k] ? (comp[k] ^ c0) : 0ull;
  x = wave_or64(x);
  int shift = (x == 0ull) ? 0 : (63 - __clzll((long long)x)) - 7;
  if (shift < 0) shift = 0;
  unsigned rank = 256;
  bool fast = false; unsigned fsel = 0, fcnt = 0; int fshift = 0;
#pragma unroll 1
  for (int rd = 0; rd < 8; ++rd) {
    *(uint4*)(hist + 4 * l) = make_uint4(0, 0, 0, 0);
    asm volatile("" ::: "memory");
    unsigned dk[NPL];
#pragma unroll
    for (int k = 0; k < NPL; ++k) {
      dk[k] = (unsigned)(comp[k] >> shift) & 255u;
      if (act[k]) atomicAdd(&hist[dk[k]], 1u);
    }
    asm volatile("" ::: "memory");
    uint4 hv; hv.x = hist[4 * l]; hv.y = hist[4 * l + 1]; hv.z = hist[4 * l + 2]; hv.w = hist[4 * l + 3];
    unsigned tl = hv.x + hv.y + hv.z + hv.w;
    const unsigned pin = wave_incl_scan(tl);
    const unsigned tot = (unsigned)__builtin_amdgcn_readlane((int)pin, 63);
    unsigned sx = tot - pin;
    bool mine = (sx < rank) && (rank <= sx + tl);
    unsigned dsel = 0, nr = 0, hsel = 0;
    if (mine) {
      unsigned c = sx;
      if (c + hv.w >= rank) { dsel = 4 * l + 3; nr = rank - c; hsel = hv.w; }
      else {
        c += hv.w;
        if (c + hv.z >= rank) { dsel = 4 * l + 2; nr = rank - c; hsel = hv.z; }
        else {
          c += hv.z;
          if (c + hv.y >= rank) { dsel = 4 * l + 1; nr = rank - c; hsel = hv.y; }
          else { c += hv.y; dsel = 4 * l; nr = rank - c; hsel = hv.x; }
        }
      }
    }
    unsigned long long mk = __ballot(mine);
    int src = (mk == 0ull) ? 0 : (__ffsll((long long)mk) - 1);
    dsel = (unsigned)__builtin_amdgcn_readlane((int)dsel, src);
    rank = (unsigned)__builtin_amdgcn_readlane((int)nr, src);
    hsel = (unsigned)__builtin_amdgcn_readlane((int)hsel, src);
    if (APPROX && rd == 0) {
      const unsigned kept = 256u - rank + hsel;
      if (kept <= 320u) { fast = true; fsel = dsel; fcnt = kept; fshift = shift; break; }
    }
#pragma unroll
    for (int k = 0; k < NPL; ++k) act[k] = act[k] && (dk[k] == dsel);
    if (hsel <= 1u || shift == 0) break;
    shift = (shift >= 8) ? (shift - 8) : 0;
  }
  unsigned long long tsel = 0;
#pragma unroll
  for (int k = 0; k < NPL; ++k) tsel |= act[k] ? comp[k] : 0ull;
  unsigned long long T = 0ull;
  if (!fast) T = wave_or64(tsel);
  else T = ((c0 >> (fshift + 8)) << (fshift + 8)) | ((unsigned long long)fsel << fshift);
  bool keep[NPL];
  unsigned cntk = 0;
#pragma unroll
  for (int k = 0; k < NPL; ++k) {
    keep[k] = val[k] && (comp[k] >= T);
    cntk += keep[k] ? 1u : 0u;
  }
  unsigned pos = wave_incl_scan(cntk) - cntk;
  asm volatile("" ::: "memory");
#pragma unroll
  for (int k = 0; k < NPL; ++k) {
    if (keep[k]) {
      const unsigned kk = (unsigned)(comp[k] >> 14);
      const unsigned u = (kk & 0x80000000u) ? (kk & 0x7FFFFFFFu) : ~kk;
      LSm[pos] = __uint_as_float(u);
      LIm[pos] = (unsigned short)(16383u - ((unsigned)comp[k] & 16383u));
      ++pos;
    }
  }
  if (l == 0) {
    const unsigned T32 = (unsigned)(T >> 14);
    *cntm = fast ? (int)fcnt : 256;
    *thrm = __uint_as_float((T32 & 0x80000000u) ? (T32 & 0x7FFFFFFFu) : ~T32);
  }
  asm volatile("" ::: "memory");
}

__device__ void dsa_item(const Params& p, int qb, unsigned char* lds) {
  const int tid = otid(), w = tid >> 6, l = tid & 63;
  const int t0 = qb * 32;
  const half_t* P = (const half_t*)(p.ws + OFF_P);
  const float* IW = (const float*)(p.ws + OFF_IW);
  half_t* BR = (half_t*)(p.ws + OFF_BR);
  float* LS = (float*)(lds + DS_LS);
  unsigned short* LI = (unsigned short*)(lds + DS_LI);
  int* cnt = (int*)(lds + DS_CNT);
  float* thr = (float*)(lds + DS_THR);
  float* wq = (float*)(lds + DS_WQ);
  unsigned* hist = (unsigned*)(lds + DS_HIST) + w * 256;
  float* PW = (float*)(lds + DS_PW) + w * 1024;
  half_t* QS = (half_t*)(lds + DS_PW + 16384) + w * 512;
  for (int rep_sel = 0; rep_sel < REP_SEL; ++rep_sel) {
  __syncthreads();
  if (tid < 32) { cnt[tid] = 0; thr[tid] = -INFINITY; }
  if (tid < 128) wq[tid] = IW[(size_t)t0 * 4 + tid];
  __syncthreads();
  h8 aq[4][4];
#pragma unroll
  for (int h = 0; h < 4; ++h)
#pragma unroll
    for (int ks = 0; ks < 4; ++ks)
      aq[h][ks] = *(const h8*)(P + (size_t)(t0 + (l & 31)) * PP + C_IDXQ + h * 64 + ks * 16 + (l >> 5) * 8);
  const int nt = qb + 1;
  const int nr = (nt + 3) >> 2;
  f4v wqv[16];
#pragma unroll
  for (int r = 0; r < 16; ++r) wqv[r] = *(const f4v*)(wq + crow(r, l) * 4);
  float thv[16];
  { float ninf = -INFINITY; asm volatile("" : "+v"(ninf));
#pragma unroll
  for (int r = 0; r < 16; ++r) thv[r] = ninf; }
  h8 bk[4];
  {
    const int k0 = (w < nt) ? w : 0;
#pragma unroll
    for (int ks = 0; ks < 4; ++ks)
      bk[ks] = *(const h8*)(P + (size_t)(k0 * 32 + (l & 31)) * PP + C_IDXK + ks * 16 + (l >> 5) * 8);
  }
#pragma unroll 1
  for (int rd = 0; rd < nr; ++rd) {
    const int kt = 4 * rd + w;
    h8 bkn[4];
    {
      const int kn = (kt + 4 < nt) ? (kt + 4) : 0;
#pragma unroll
      for (int ks = 0; ks < 4; ++ks)
        bkn[ks] = *(const h8*)(P + (size_t)(kn * 32 + (l & 31)) * PP + C_IDXK + ks * 16 + (l >> 5) * 8);
    }
    if (kt < nt) {
      const int sbase = kt * 32;
      f16v acc[4];
#pragma unroll
      for (int h = 0; h < 4; ++h) {
#pragma unroll
        for (int r = 0; r < 16; ++r) acc[h][r] = ozero();
#pragma unroll
        for (int ks = 0; ks < 4; ++ks) acc[h] = mfma16(aq[h][ks], bk[ks], acc[h]);
      }
      const int s = sbase + (l & 31);
      float scv[16];
      unsigned pm = 0;
#pragma unroll
      for (int r = 0; r < 16; ++r) {
        const int m = crow(r, l);
        const f4v wv = wqv[r];
        float sc = wv[0] * relu_f(acc[0][r]) + wv[1] * relu_f(acc[1][r]) + wv[2] * relu_f(acc[2][r]) + wv[3] * relu_f(acc[3][r]);
        sc += 0.0f;
        scv[r] = sc;
      }
      if (kt == qb) {
#pragma unroll
        for (int r = 0; r < 16; ++r) if (s > t0 + crow(r, l)) scv[r] = -INFINITY;
      }
#pragma unroll
      for (int r = 0; r < 16; ++r) pm |= (scv[r] > thv[r]) ? (1u << r) : 0u;
      if (__ballot(pm != 0u) != 0ull) {
        unsigned long long mks[16];
        int mycnt = 0;
#pragma unroll
        for (int r = 0; r < 16; ++r) {
          const unsigned long long mk = __ballot(((pm >> r) & 1u) != 0u);
          mks[r] = mk;
          const unsigned hm = (l < 32) ? (unsigned)mk : (unsigned)(mk >> 32);
          if ((l & 31) == r) mycnt = __popc(hm);
        }
        int base = 0;
        if ((l & 31) < 16 && mycnt > 0) base = atomicAdd(&cnt[crow(l & 31, l)], mycnt);
#pragma unroll
        for (int r = 0; r < 16; ++r) {
          const unsigned long long mk = mks[r];
          if (mk != 0ull) {
            const unsigned hm = (l < 32) ? (unsigned)mk : (unsigned)(mk >> 32);
            const int b_lo = __builtin_amdgcn_readlane(base, r), b_hi = __builtin_amdgcn_readlane(base, 32 + r);
            const int bb = (l < 32) ? b_lo : b_hi;
            if ((pm >> r) & 1u) {
              const int m = crow(r, l);
              const int slot = bb + __popc(hm & ((1u << (l & 31)) - 1u));
              LS[m * DS_CAP + slot] = scv[r];
              LI[m * DS_CAP + slot] = (unsigned short)s;
            }
          }
        }
      }
    }
    lds_barrier();
    bool any_prune;
    {
      const int cv = (l < 32) ? cnt[l] : 0;
      unsigned pmask = (unsigned)__ballot(cv > DS_PRUNE_AT);
      any_prune = pmask != 0u;
      int j = 0;
      while (pmask != 0u) {
        const int m = __ffs((int)pmask) - 1;
        pmask &= pmask - 1u;
        if ((j & 3) == w) dsa_prune<true>(LS + m * DS_CAP, LI + m * DS_CAP, cnt[m], hist, cnt + m, thr + m, l);
        ++j;
      }
    }
    lds_barrier();
    if (any_prune) {
#pragma unroll
      for (int r = 0; r < 16; ++r) thv[r] = thr[crow(r, l)];
    }
#pragma unroll
    for (int ks = 0; ks < 4; ++ks) bk[ks] = bkn[ks];
  }
  }
#pragma unroll 1
  for (int mm = 0; mm < 8; ++mm) {
    const int m = w * 8 + mm;
    const int c = cnt[m];
    if (c > 256) dsa_prune<false>(LS + m * DS_CAP, LI + m * DS_CAP, c, hist, cnt + m, thr + m, l);
  }
  asm volatile("s_waitcnt lgkmcnt(0)" ::: "memory");
  for (int rep_att = 0; rep_att < REP_ATT; ++rep_att) {
  h8 kvr[4][8];
  {
    const int m = w * 8;
    const int c = min(cnt[m], 256);
    const unsigned short* LIm = LI + m * DS_CAP;
#pragma unroll
    for (int kk = 0; kk < 4; ++kk) {
      const int e = l + 64 * kk;
      const int s = (int)LIm[(e < c) ? e : 0];
      const half_t* kr = P + (size_t)s * PP + C_DSAK;
#pragma unroll
      for (int ch = 0; ch < 8; ++ch) kvr[kk][ch] = *(const h8*)(kr + ch * 8);
    }
  }
  h8 qreg = *(const h8*)(P + (size_t)(t0 + w * 8) * PP + C_DSAQ + l * 8);
  const int dch = l & 7, ksub = l >> 3;
#pragma unroll 1
  for (int u = 0; u < 16; ++u) {
    const int mm = u >> 1, g = u & 1;
    const int m = w * 8 + mm;
    const int t = t0 + m;
    const int c = min(cnt[m], 256);
    const unsigned short* LIm = LI + m * DS_CAP;
    if (g == 0) {
      *(h8*)(QS + l * 8) = qreg;
      const int mq = (mm < 7) ? (m + 1) : m;
      qreg = *(const h8*)(P + (size_t)(t0 + mq) * PP + C_DSAQ + l * 8);
    }
    h8 gt[4];
#pragma unroll
    for (int hh = 0; hh < 4; ++hh) gt[hh] = *(const h8*)(P + (size_t)t * PP + C_DSAG + (g * 4 + hh) * 64 + dch * 8);
    h8 vv[16];
#pragma unroll
    for (int i = 0; i < 16; ++i) {
      const int e = i * 8 + ksub;
      const int s = (int)LIm[(e < c) ? e : 0];
      vv[i] = *(const h8*)(P + (size_t)s * PP + C_DSAV + g * 64 + dch * 8);
    }
    asm volatile("" ::: "memory");
    float lg[4][4];
#pragma unroll
    for (int hh = 0; hh < 4; ++hh) {
#pragma unroll
      for (int kk = 0; kk < 4; ++kk) lg[hh][kk] = ozero();
#pragma unroll
      for (int ch = 0; ch < 8; ++ch) {
        const h8 qq = *(const h8*)(QS + (g * 4 + hh) * 64 + ch * 8);
#pragma unroll
        for (int kk = 0; kk < 4; ++kk) {
          float a = lg[hh][kk];
          a = __builtin_amdgcn_fdot2(__builtin_shufflevector(qq, qq, 0, 1), __builtin_shufflevector(kvr[kk][ch], kvr[kk][ch], 0, 1), a, false);
          a = __builtin_amdgcn_fdot2(__builtin_shufflevector(qq, qq, 2, 3), __builtin_shufflevector(kvr[kk][ch], kvr[kk][ch], 2, 3), a, false);
          a = __builtin_amdgcn_fdot2(__builtin_shufflevector(qq, qq, 4, 5), __builtin_shufflevector(kvr[kk][ch], kvr[kk][ch], 4, 5), a, false);
          a = __builtin_amdgcn_fdot2(__builtin_shufflevector(qq, qq, 6, 7), __builtin_shufflevector(kvr[kk][ch], kvr[kk][ch], 6, 7), a, false);
          lg[hh][kk] = a;
        }
      }
#pragma unroll
      for (int kk = 0; kk < 4; ++kk) lg[hh][kk] = (l + 64 * kk < c) ? lg[hh][kk] : -INFINITY;
    }
    {
      const int un = (u < 15) ? (u + 1) : 15;
      const int mn = w * 8 + (un >> 1), gn = un & 1;
      const int cn = min(cnt[mn], 256);
      const unsigned short* LIn = LI + mn * DS_CAP;
#pragma unroll
      for (int kk = 0; kk < 4; ++kk) {
        const int e = l + 64 * kk;
        const int s = (int)LIn[(e < cn) ? e : 0];
        const half_t* kr = P + (size_t)s * PP + C_DSAK + gn * 64;
#pragma unroll
        for (int ch = 0; ch < 8; ++ch) kvr[kk][ch] = *(const h8*)(kr + ch * 8);
      }
    }
#pragma unroll
    for (int hh = 0; hh < 4; ++hh) {
      float mx = fmaxf(fmaxf(lg[hh][0], lg[hh][1]), fmaxf(lg[hh][2], lg[hh][3]));
      mx = wave_max(mx);
      float ev[4]; float sm = 0.f;
#pragma unroll
      for (int kk = 0; kk < 4; ++kk) { ev[kk] = __expf(lg[hh][kk] - mx); sm += ev[kk]; }
      sm = wave_sum(sm);
      const float inv = 1.0f / sm;
#pragma unroll
      for (int kk = 0; kk < 4; ++kk) PW[(l + 64 * kk) * 4 + hh] = ev[kk] * inv;
    }
    asm volatile("" ::: "memory");
    float o[4][8];
#pragma unroll
    for (int hh = 0; hh < 4; ++hh)
#pragma unroll
      for (int q = 0; q < 8; ++q) o[hh][q] = ozero();
    const int nit = (c + 7) >> 3;
#pragma unroll 1
    for (int it0 = 0; it0 < nit; it0 += 16) {
      if (it0 > 0) {
#pragma unroll
        for (int i = 0; i < 16; ++i) {
          const int e = (it0 + i) * 8 + ksub;
          const int s = (int)LIm[(e < c) ? e : 0];
          vv[i] = *(const h8*)(P + (size_t)s * PP + C_DSAV + g * 64 + dch * 8);
        }
      }
#pragma unroll
      for (int i = 0; i < 16; ++i) {
        const int e = (it0 + i) * 8 + ksub;
        const f4v pv = *(const f4v*)(PW + e * 4);
#pragma unroll
        for (int hh = 0; hh < 4; ++hh)
#pragma unroll
          for (int q = 0; q < 8; ++q) o[hh][q] += pv[hh] * (float)vv[i][q];
      }
    }
#pragma unroll
    for (int hh = 0; hh < 4; ++hh)
#pragma unroll
      for (int q = 0; q < 8; ++q) {
        float v = o[hh][q];
        v += dppf<0x128>(v); v += xor16f(v); v += xor32f(v);
        o[hh][q] = v;
      }
    if (l < 8) {
#pragma unroll
      for (int hh = 0; hh < 4; ++hh) {
        const int col = (g * 4 + hh) * 64 + dch * 8;
        h8 ov;
#pragma unroll
        for (int q = 0; q < 8; ++q) ov[q] = (half_t)(o[hh][q] * (float)gt[hh][q]);
        *(h8*)(BR + (size_t)t * 1536 + 512 + col) = ov;
      }
    }
    asm volatile("" ::: "memory");
  }
  }
}

__device__ void phase_B(const Params& p, int layer, unsigned char* lds) {
  const int G = gridDim.x;
  for (int j = 0; j * G < 512; ++j) {
    const int b = (j & 1) ? (G - 1 - (int)blockIdx.x) : (int)blockIdx.x;
    const int idx = j * G + b;
#ifndef NO_DSA
    if (idx < 512) dsa_item(p, 511 - idx, lds);
#endif
  }
  for (int rep = 0; rep < REP_KV; ++rep)
  for (int it = blockIdx.x; it < 2048; it += G) la_item_kv(p, layer, it, lds);
}

__device__ void phase_E1(const Params& p, int layer, unsigned char* lds, int my_xcc, int my_loc, const unsigned* xcnt) {
  const int tid = otid(), w = tid >> 6, l = tid & 63;
  const half_t* BR = (const half_t*)(p.ws + OFF_BR);
  const half_t* WbrT = (const half_t*)(p.ws + OFF_WBRT) + (size_t)layer * 3 * 1024 * WBP;
  const half_t* P = (const half_t*)(p.ws + OFF_P);
  half_t* Y1 = (half_t*)(p.ws + OFF_H);
  const int wm = w >> 1, wn = w & 1;
  float* E = (float*)(lds + GEMM_EOFF) + w * (32 * EP);
  const int prow = l >> 3, c0 = (l & 7) * 8;
  const int nx = xcc_census(xcnt, my_xcc);
  const int nrounds = (nx > 0) ? (64 + nx - 1) / nx : (512 + (int)gridDim.x - 1) / (int)gridDim.x;
  for (int rnd = 0; rnd < nrounds; ++rnd) {
    int mt, nt;
    if (nx > 0) {
      const int s = my_loc + nx * rnd;
      if (s >= 64) continue;
      mt = my_xcc * 8 + (s & 7); nt = s >> 3;
    } else {
      const int tix = rnd * (int)gridDim.x + (int)blockIdx.x;
      if (tix >= 512) continue;
      mt = tix & 63; nt = tix >> 6;
    }
    h8 tot[4][4];
#pragma unroll
    for (int i = 0; i < 4; ++i)
#pragma unroll
      for (int ps = 0; ps < 4; ++ps)
#pragma unroll
        for (int q = 0; q < 8; ++q) tot[i][ps][q] = (half_t)ozero();
    const int m0w = mt * 256 + wm * 128;
    const int n0 = nt * 128 + wn * 64 + c0;
#pragma unroll 1
    for (int b = 0; b < 3; ++b) {
      f16v acc[4][2];
      zero_acc<2>(acc);
      gemm_kloop<2>(acc, BR + (size_t)mt * 256 * 1536 + b * 512, 1536, WbrT + (size_t)b * 1024 * WBP + (size_t)nt * 128 * WBP, WBP, 512, lds);
#pragma unroll
      for (int i = 0; i < 4; ++i) {
        stage_pair(E, acc[i][0], acc[i][1], l);
#pragma unroll
        for (int ps = 0; ps < 4; ++ps) {
          const int rl = ps * 8 + prow;
          const int row = m0w + i * 32 + rl;
          const h8 g = *(const h8*)(P + (size_t)row * PP + C_MRG + b * 1024 + n0);
          float ev[8];
          ld8(E + rl * EP + c0, ev);
#pragma unroll
          for (int q = 0; q < 8; ++q) tot[i][ps][q] = (half_t)((float)tot[i][ps][q] + (float)g[q] * ev[q]);
        }
      }
    }
#pragma unroll
    for (int i = 0; i < 4; ++i)
#pragma unroll
      for (int ps = 0; ps < 4; ++ps) {
        const int row = m0w + i * 32 + ps * 8 + prow;
        *(h8*)(Y1 + (size_t)row * HP + n0) = tot[i][ps];
      }
  }
}

__device__ void phase_E2(const Params& p, int layer, unsigned char* lds, int my_xcc, int my_loc, const unsigned* xcnt) {
  const int tid = otid(), w = tid >> 6, l = tid & 63;
  const half_t* Y1 = (const half_t*)(p.ws + OFF_H);
  const half_t* Wo = (const half_t*)(p.ws + OFF_WOUTT) + (size_t)layer * 1024 * WP;
  float* Y = (float*)(p.ws + OFF_ST);
  const int wm = w >> 1, wn = w & 1;
  const int nx = xcc_census(xcnt, my_xcc);
  const int nrounds = (nx > 0) ? (64 + nx - 1) / nx : (512 + (int)gridDim.x - 1) / (int)gridDim.x;
  for (int rnd = 0; rnd < nrounds; ++rnd) {
    int mt, nt;
    if (nx > 0) {
      const int s = my_loc + nx * rnd;
      if (s >= 64) continue;
      mt = my_xcc * 8 + (s & 7); nt = s >> 3;
    } else {
      const int tix = rnd * (int)gridDim.x + (int)blockIdx.x;
      if (tix >= 512) continue;
      mt = tix & 63; nt = tix >> 6;
    }
    f16v acc[4][2];
    zero_acc<2>(acc);
    gemm_kloop<2>(acc, Y1 + (size_t)mt * 256 * HP, HP, Wo + (size_t)nt * 128 * WP, WP, 1024, lds);
    const int m0w = mt * 256 + wm * 128;
    const int n0w = nt * 128 + wn * 64;
#pragma unroll
    for (int i = 0; i < 4; ++i)
#pragma unroll
      for (int j = 0; j < 2; ++j)
#pragma unroll
        for (int r = 0; r < 16; ++r) {
          const int row = m0w + i * 32 + crow(r, l);
          const int n = n0w + j * 32 + (l & 31);
          Y[(size_t)row * 1024 + n] = acc[i][j][r];
        }
  }
}

__device__ void phase_E3(const Params& p, int layer) {
  const int w = otid() >> 6, l = otid() & 63;
  const float* Y = (const float*)(p.ws + OFF_ST);
  const float* MOD = (const float*)(p.ws + OFF_MOD);
  half_t* H = (half_t*)(p.ws + OFF_H);
  const float* xin = (layer == 0) ? p.x : p.out;
  const float* gate = MOD + layer * 3072 + 2048;
  const float* post = p.post_norm + layer * 1024;
  const int stride = gridDim.x * 4;
  int row = blockIdx.x * 4 + w;
  f4v yn[4], xn[4];
  if (row < S_LEN) {
#pragma unroll
    for (int i = 0; i < 4; ++i) {
      yn[i] = *(const f4v*)(Y + (size_t)row * 1024 + i * 256 + l * 4);
      xn[i] = *(const f4v*)(xin + (size_t)row * 1024 + i * 256 + l * 4);
    }
  }
  for (; row < S_LEN; row += stride) {
    float yv[16], xv[16];
    float ss = 0.f;
#pragma unroll
    for (int i = 0; i < 4; ++i)
#pragma unroll
      for (int q = 0; q < 4; ++q) { yv[i * 4 + q] = yn[i][q]; xv[i * 4 + q] = xn[i][q]; ss += yn[i][q] * yn[i][q]; }
    const int nrow = (row + stride < S_LEN) ? (row + stride) : row;
#pragma unroll
    for (int i = 0; i < 4; ++i) {
      yn[i] = *(const f4v*)(Y + (size_t)nrow * 1024 + i * 256 + l * 4);
      xn[i] = *(const f4v*)(xin + (size_t)nrow * 1024 + i * 256 + l * 4);
    }
    ss = wave_sum(ss);
    const float rs = rsqrtf(ss * (1.0f / 1024.0f) + 1e-6f);
#pragma unroll
    for (int i = 0; i < 4; ++i) {
      const int c0 = i * 256 + l * 4;
      f4v gt = *(const f4v*)(gate + c0);
      f4v pn = *(const f4v*)(post + c0);
      f4v o;
#pragma unroll
      for (int q = 0; q < 4; ++q) { o[q] = xv[i * 4 + q] + gt[q] * (yv[i * 4 + q] * rs * pn[q]); xv[i * 4 + q] = o[q]; }
      *(f4v*)(p.out + (size_t)row * 1024 + c0) = o;
    }
    if (layer + 1 < DEPTH)
      write_h_row(xv, p.pre_norm + (layer + 1) * 1024, MOD + (layer + 1) * 3072, H + (size_t)row * HP, l);
  }
}

#define XB_TMO      128
#define XB_XCNT(j)  (256  + 64 * (j))
#define XB_XSUB(j)  (1280 + 64 * (j))
#define XB_XGEN(j)  (2304 + 64 * (j))
#define XB_TOP      3328
#define XB_TOPGEN   3392
#define XCD_BAR_WORDS 3456
#define XB_SPIN_CAP (1u << 18)
#define LAS __attribute__((address_space(3)))

__device__ __forceinline__ unsigned xb_ld(unsigned* p)              { return __hip_atomic_load(p, __ATOMIC_RELAXED, __HIP_MEMORY_SCOPE_AGENT); }
__device__ __forceinline__ unsigned xb_add(unsigned* p, unsigned v) { return __hip_atomic_fetch_add(p, v, __ATOMIC_RELAXED, __HIP_MEMORY_SCOPE_AGENT); }
__device__ __forceinline__ unsigned xb_xcc_id() { return (unsigned)__builtin_amdgcn_s_getreg((3 << 11) | 20) & 0xFu; }
#define XB_SPIN(cond, bar) do { unsigned _sp = 0; while (cond) { __builtin_amdgcn_s_sleep(1); \
    if ((++_sp & 255u) == 0u) { if (xb_ld(&(bar)[XB_TMO])) break; if (_sp > XB_SPIN_CAP) { atomicAdd(&(bar)[XB_TMO], 1u); break; } } } } while (0)

struct XcdBarrier {
    unsigned* bar; unsigned x;
    volatile LAS unsigned* st;
};

__device__ __forceinline__ XcdBarrier xcd_barrier_post(unsigned* bar, volatile LAS unsigned* st) {
    XcdBarrier b; b.bar = bar; b.x = xb_xcc_id(); b.st = st;
    if (otid() == 0) (void)xb_add(&bar[XB_XCNT(b.x)], 1u);
    return b;
}
__device__ __forceinline__ void xcd_barrier_complete(unsigned* bar, unsigned x, unsigned& nloc, unsigned& nx) {
    const unsigned G = gridDim.x * gridDim.y * gridDim.z;
    unsigned sum, cnt, mine, sp = 0u;
    for (;;) {
        sum = 0u; cnt = 0u; mine = 0u;
#pragma unroll
        for (unsigned j = 0; j < 16; ++j) { const unsigned c = xb_ld(&bar[XB_XCNT(j)]); sum += c; cnt += (c > 0u) ? 1u : 0u; mine = (j == x) ? c : mine; }
        if (sum == G) break;
        __builtin_amdgcn_s_sleep(1);
        if ((++sp & 255u) == 0u) { if (xb_ld(&bar[XB_TMO])) break; if (sp > XB_SPIN_CAP) { atomicAdd(&bar[XB_TMO], 1u); break; } }
    }
    nloc = mine > 0u ? mine : 1u; nx = cnt > 0u ? cnt : 1u;
}

__device__ __forceinline__ void xcd_barrier(const XcdBarrier& b) {
    asm volatile("s_waitcnt vmcnt(0)" ::: "memory");
    __syncthreads();
    if (otid() == 0) {
        unsigned* bar = b.bar;
        __builtin_amdgcn_s_waitcnt(0);
        unsigned nloc = b.st[0], nx = b.st[1];
        if (nloc == 0u) { xcd_barrier_complete(bar, b.x, nloc, nx); b.st[0] = nloc; b.st[1] = nx; }
        const unsigned old = xb_add(&bar[XB_XSUB(b.x)], 1u);
        const unsigned gen = old / nloc;
        if (old + 1u == (gen + 1u) * nloc) {
            __builtin_amdgcn_fence(__ATOMIC_RELEASE, "agent");
            asm volatile("s_waitcnt vmcnt(0)" ::: "memory");
            const unsigned og = xb_add(&bar[XB_TOP], 1u);
            const unsigned tg = og / nx;
            if (og + 1u == (tg + 1u) * nx) xb_add(&bar[XB_TOPGEN], 1u);
            else XB_SPIN(xb_ld(&bar[XB_TOPGEN]) == tg, bar);
            __builtin_amdgcn_fence(__ATOMIC_ACQUIRE, "agent");
            xb_add(&bar[XB_XGEN(b.x)], 1u);
            asm volatile("s_waitcnt vmcnt(0)" ::: "memory");
        } else {
            XB_SPIN(xb_ld(&bar[XB_XGEN(b.x)]) == gen, bar);
            __builtin_amdgcn_fence(__ATOMIC_ACQUIRE, "agent");
            asm volatile("s_waitcnt vmcnt(0)" ::: "memory");
        }
    }
    __syncthreads();
}


};

#ifndef REP_D
#define REP_D 1
#endif
#ifndef REP_E
#define REP_E 1
#endif
#ifndef REP_A
#define REP_A 1
#endif
#ifndef REP_B
#define REP_B 1
#endif
#ifdef ONLY_PHASE
#define PH_EN(x) (ONLY_PHASE == (x))
#else
#define PH_EN(x) true
#endif
__global__ void __launch_bounds__(NTHREADS) fwd_megakernel(Params p) {
  extern __shared__ __attribute__((aligned(16))) unsigned char lds[];
  cg::grid_group grid = cg::this_grid();
  K k; k.wbase = __builtin_amdgcn_readfirstlane((int)__builtin_amdgcn_workitem_id_x()) & ~63;
  unsigned* bar = (unsigned*)(p.ws + WS_END);
  unsigned* xcnt = bar + 16;
  unsigned* xbar = (unsigned*)(p.ws + WS_END + 1024);
  if (blockIdx.x == 0) {
    if (k.otid() < 17) __hip_atomic_store(bar + (k.otid() == 16 ? 0 : 16 + k.otid()), 0u, __ATOMIC_RELAXED, __HIP_MEMORY_SCOPE_AGENT);
    for (int i = k.otid(); i < XCD_BAR_WORDS; i += NTHREADS) __hip_atomic_store(xbar + i, 0u, __ATOMIC_RELAXED, __HIP_MEMORY_SCOPE_AGENT);
  }
  volatile LAS unsigned* xst = (volatile LAS unsigned*)(lds + LDS_BYTES - 16);
  if (k.otid() == 0) { xst[0] = 0u; xst[1] = 0u; }
  __syncthreads();
  K::XcdBarrier xb; xb.bar = xbar; xb.x = 0; xb.st = xst;
  int my_xcc = 0, my_loc = 0;
  for (int ph = p.ph_lo; ph < p.ph_hi; ++ph) {
    if (ph == 0) { if (PH_EN(0)) for (int rep = 0; rep < REP_P; ++rep) { k.phase_prologue(p, lds); __syncthreads(); } }
    else if (ph == 1) {
      xb = k.xcd_barrier_post(xbar, xst);
      int* sh = (int*)lds;
      if (k.otid() == 0) {
        const int xc = (int)(__builtin_amdgcn_s_getreg((3 << 11) | 20) & 0xFu);
        sh[0] = xc;
        sh[1] = (int)__hip_atomic_fetch_add(xcnt + xc, 1u, __ATOMIC_RELAXED, __HIP_MEMORY_SCOPE_AGENT);
      }
      __syncthreads();
      my_xcc = __builtin_amdgcn_readfirstlane(sh[0]);
      my_loc = __builtin_amdgcn_readfirstlane(sh[1]);
      __syncthreads();
      if (PH_EN(1)) k.phase_h0(p);
    }
    else {
      const int layer = (ph - 2) / 7, sub = (ph - 2) % 7;
      if (sub == 0) { if (PH_EN(2)) for (int rep = 0; rep < REP_A; ++rep) { k.phase_A(p, layer, lds, my_xcc, my_loc, xcnt); __syncthreads(); } }
      else if (sub == 1) { if (PH_EN(3)) for (int rep = 0; rep < REP_B; ++rep) { k.phase_B(p, layer, lds); __syncthreads(); } }
      else if (sub == 2) { if (PH_EN(4)) k.phase_scan(p); }
      else if (sub == 3) { if (PH_EN(5)) for (int rep = 0; rep < REP_D; ++rep) { for (int it = blockIdx.x; it < 2048; it += gridDim.x) k.la_item_out(p, layer, it, lds); __syncthreads(); } }
      else if (sub == 4) { if (PH_EN(6)) for (int rep = 0; rep < REP_E; ++rep) { k.phase_E1(p, layer, lds, my_xcc, my_loc, xcnt); __syncthreads(); } }
      else if (sub == 5) { if (PH_EN(7)) for (int rep = 0; rep < REP_E; ++rep) { k.phase_E2(p, layer, lds, my_xcc, my_loc, xcnt); __syncthreads(); } }
      else { if (PH_EN(8)) k.phase_E3(p, layer); }
    }
    if (ph + 1 < p.ph_hi) {
      if (ph == p.ph_lo) grid.sync();
      else k.xcd_barrier(xb);
    }
  }
}

extern "C" void kernel_launch(void* const* d_in, const int* in_sizes, int n_in, void* d_out, int out_size,
                              void* d_ws, size_t ws_size, hipStream_t stream) {
  static int grid_blocks = 0;
  if (!grid_blocks) {
    int dev = 0, cus = 0, per_cu = 0;
    hipGetDevice(&dev);
    hipDeviceGetAttribute(&cus, hipDeviceAttributeMultiprocessorCount, dev);
    hipFuncSetAttribute((const void*)fwd_megakernel, hipFuncAttributeMaxDynamicSharedMemorySize, LDS_BYTES);
    hipOccupancyMaxActiveBlocksPerMultiprocessor(&per_cu, (const void*)fwd_megakernel, NTHREADS, LDS_BYTES);
    if (per_cu < 1) per_cu = 1;
    if (per_cu > 1) per_cu = 1;
    grid_blocks = cus * per_cu;
    if (ws_size < WS_END) fprintf(stderr, "workspace too small: %zu < %llu\n", ws_size, (unsigned long long)WS_END);
  }
  Params p{};
  p.x = (const float*)d_in[0]; p.c = (const float*)d_in[1]; p.pos = (const int*)d_in[2];
  p.ada_w = (const float*)d_in[3]; p.ada_b = (const float*)d_in[4];
  p.pre_norm = (const float*)d_in[5]; p.post_norm = (const float*)d_in[6];
  p.w_in = (const float*)d_in[7]; p.gla_w_lr = (const float*)d_in[8]; p.gla_b_lr = (const float*)d_in[9];
  p.w_br_ret = (const float*)d_in[10]; p.w_br_dsa = (const float*)d_in[11]; p.w_br_gla = (const float*)d_in[12];
  p.w_out = (const float*)d_in[13];
  p.out = (float*)d_out; p.ws = (unsigned char*)d_ws;
  p.ph_lo = 0; p.ph_hi = 2 + 7 * DEPTH;
  void* args[] = {&p};
  hipError_t e = hipLaunchCooperativeKernel((const void*)fwd_megakernel, dim3(grid_blocks), dim3(NTHREADS), args, LDS_BYTES, stream);
  if (e != hipSuccess) fprintf(stderr, "cooperative launch failed: %s (grid %d)\n", hipGetErrorString(e), grid_blocks);
}
```

```cpp
#include <hip/hip_runtime.h>
#include <hip/hip_cooperative_groups.h>
#include <stdint.h>
#include <cstdio>
namespace cg = cooperative_groups;
#ifndef REP_P
#define REP_P 1
#endif
#ifndef REP_KV
#define REP_KV 1
#endif
#ifndef REP_SEL
#define REP_SEL 1
#endif
#ifndef REP_ATT
#define REP_ATT 1
#endif

typedef _Float16 half_t;
typedef _Float16 h8 __attribute__((ext_vector_type(8)));
typedef _Float16 h4 __attribute__((ext_vector_type(4)));
typedef _Float16 h2 __attribute__((ext_vector_type(2)));
typedef float f16v __attribute__((ext_vector_type(16)));
typedef float f4v __attribute__((ext_vector_type(4)));

#define S_LEN 16384
#define DM 1024
#define NIN 7764
#define NPAD 7936
#define PP 7808
#define DEPTH 4
#define NTHREADS 256
#define HP 1088
#define WP 1088
#define WBP 576
#define LDS_BYTES 152704

#define C_RETQ 0
#define C_RETK 256
#define C_RETV 512
#define C_RETG 1024
#define C_DSAQ 1536
#define C_DSAK 2048
#define C_DSAV 2176
#define C_DSAG 2304
#define C_IDXQ 2816
#define C_IDXK 3072
#define C_GLAQ 3136
#define C_GLAK 3392
#define C_GLAV 3648
#define C_GLAG 4160
#define C_GLAA 4672
#define C_MRG 4688
#define C_END 7760
#define C_IDXW 7760

#define OFF_WINT 0ull
#define OFF_WBRT (OFF_WINT + 4ull * NPAD * WP * 2)
#define OFF_WOUTT (OFF_WBRT + 4ull * 3 * 1024 * WBP * 2)
#define OFF_MOD (OFF_WOUTT + 4ull * 1024 * WP * 2)
#define OFF_RT (OFF_MOD + 4ull * 3072 * 4)
#define OFF_DT (OFF_RT + 16384ull * 64 * 4)
#define OFF_H (OFF_DT + 16384ull * 16 * 4)
#define OFF_P (OFF_H + 16384ull * HP * 2)
#define OFF_GA (OFF_P + 16384ull * PP * 2)
#define OFF_IW (OFF_GA + 16384ull * 16 * 4)
#define OFF_ST (OFF_IW + 16384ull * 4 * 4)
#define OFF_DEC (OFF_ST + 256ull * 65536 * 4)
#define OFF_BR (OFF_DEC + 256ull * 8 * 64 * 4)
#define WS_END (OFF_BR + 16384ull * 1536 * 2)
static_assert(WS_END + 16384 <= 508821504ull, "workspace too large");

struct Params {
  const float* x; const float* c; const int* pos; const float* ada_w; const float* ada_b;
  const float* pre_norm; const float* post_norm; const float* w_in; const float* gla_w_lr;
  const float* gla_b_lr; const float* w_br_ret; const float* w_br_dsa; const float* w_br_gla;
  const float* w_out; float* out; unsigned char* ws;
  int ph_lo; int ph_hi;
};

struct K {
int wbase;
__device__ __forceinline__ int otid() const {
  int lane;
  asm volatile("v_mbcnt_lo_u32_b32 %0, -1, 0\n\tv_mbcnt_hi_u32_b32 %0, -1, %0" : "=v"(lane));
  return wbase | lane;
}
__device__ __forceinline__ static float ozero() { float z = 0.f; asm volatile("" : "+v"(z)); return z; }
template <int CTRL>
__device__ __forceinline__ float dppf(float v) {
  return __int_as_float(__builtin_amdgcn_update_dpp(0, __float_as_int(v), CTRL, 0xF, 0xF, true));
}
template <int CTRL>
__device__ __forceinline__ unsigned dppu(unsigned v) {
  return (unsigned)__builtin_amdgcn_update_dpp(0, (int)v, CTRL, 0xF, 0xF, true);
}
__device__ __forceinline__ int olane() { return otid() & 63; }
__device__ __forceinline__ float xor16f(float v) { return __int_as_float(__builtin_amdgcn_ds_bpermute((olane() ^ 16) << 2, __float_as_int(v))); }
__device__ __forceinline__ float xor32f(float v) { return __int_as_float(__builtin_amdgcn_ds_bpermute((olane() ^ 32) << 2, __float_as_int(v))); }
__device__ __forceinline__ unsigned xor16u(unsigned v) { return (unsigned)__builtin_amdgcn_ds_bpermute((olane() ^ 16) << 2, (int)v); }
__device__ __forceinline__ unsigned xor32u(unsigned v) { return (unsigned)__builtin_amdgcn_ds_bpermute((olane() ^ 32) << 2, (int)v); }
__device__ __forceinline__ float rl_f(float v, int lane) { return __int_as_float(__builtin_amdgcn_readlane(__float_as_int(v), lane)); }
__device__ __forceinline__ float wave_sum(float v) {
  v += dppf<0xB1>(v); v += dppf<0x4E>(v); v += dppf<0x141>(v); v += dppf<0x140>(v);
  return (rl_f(v, 0) + rl_f(v, 16)) + (rl_f(v, 32) + rl_f(v, 48));
}
__device__ __forceinline__ float wave_max(float v) {
  v = fmaxf(v, dppf<0xB1>(v)); v = fmaxf(v, dppf<0x4E>(v)); v = fmaxf(v, dppf<0x141>(v)); v = fmaxf(v, dppf<0x140>(v));
  return fmaxf(fmaxf(rl_f(v, 0), rl_f(v, 16)), fmaxf(rl_f(v, 32), rl_f(v, 48)));
}
__device__ __forceinline__ unsigned wave_or(unsigned v) {
  v |= dppu<0xB1>(v); v |= dppu<0x4E>(v); v |= dppu<0x141>(v); v |= dppu<0x140>(v);
  return (unsigned)(__builtin_amdgcn_readlane((int)v, 0) | __builtin_amdgcn_readlane((int)v, 16) | __builtin_amdgcn_readlane((int)v, 32) | __builtin_amdgcn_readlane((int)v, 48));
}
__device__ __forceinline__ unsigned wave_incl_scan(unsigned v) {
  v += (unsigned)__builtin_amdgcn_update_dpp(0, (int)v, 0x111, 0xF, 0xF, false);
  v += (unsigned)__builtin_amdgcn_update_dpp(0, (int)v, 0x112, 0xF, 0xF, false);
  v += (unsigned)__builtin_amdgcn_update_dpp(0, (int)v, 0x114, 0xF, 0xF, false);
  v += (unsigned)__builtin_amdgcn_update_dpp(0, (int)v, 0x118, 0xF, 0xF, false);
  v += (unsigned)__builtin_amdgcn_update_dpp(0, (int)v, 0x142, 0xA, 0xF, false);
  v += (unsigned)__builtin_amdgcn_update_dpp(0, (int)v, 0x143, 0xC, 0xF, false);
  return v;
}
__device__ __forceinline__ f16v mfma16(h8 a, h8 b, f16v c) {
  return __builtin_amdgcn_mfma_f32_32x32x16_f16(a, b, c, 0, 0, 0);
}
__device__ __forceinline__ float relu_f(float x) { return __int_as_float(max(__float_as_int(x), 0)); }
__device__ __forceinline__ int crow(int r, int l) { return (r & 3) + 8 * (r >> 2) + 4 * (l >> 5); }

__device__ __forceinline__ int win_col(int nv) {
  if (nv < 3136) return nv;
  if (nv < 7760) return nv + 4;
  if (nv < 7764) return nv - 7760 + 3136;
  return -1;
}
__device__ void transpose_tile(const float* __restrict__ src, int ldn, half_t* __restrict__ dst, int K,
                               int k0, int n0, int mapmode, unsigned char* lds) {
  float* T = (float*)lds;
  const int tid = otid();
  const int nn = tid & 63;
  int col = n0 + nn;
  if (mapmode) col = win_col(col);
#pragma unroll
  for (int i = 0; i < 16; ++i) {
    int kk = (tid >> 6) + 4 * i;
    float v = 0.f;
    if (col >= 0) v = src[(size_t)(k0 + kk) * ldn + col];
    T[kk * 65 + nn] = v;
  }
  __syncthreads();
#pragma unroll
  for (int i = 0; i < 2; ++i) {
    int n2 = (tid >> 3) + 32 * i;
    int kc = tid & 7;
    h8 o;
#pragma unroll
    for (int q = 0; q < 8; ++q) o[q] = (half_t)T[(kc * 8 + q) * 65 + n2];
    *(h8*)(dst + (size_t)(n0 + n2) * K + k0 + kc * 8) = o;
  }
  __syncthreads();
}

__device__ void phase_prologue(const Params& p, unsigned char* lds) {
  const int tid = otid();
  half_t* WinT = (half_t*)(p.ws + OFF_WINT);
  half_t* WbrT = (half_t*)(p.ws + OFF_WBRT);
  half_t* WoutT = (half_t*)(p.ws + OFF_WOUTT);
  float* MOD = (float*)(p.ws + OFF_MOD);
  float* RT = (float*)(p.ws + OFF_RT);
  float* DT = (float*)(p.ws + OFF_DT);
  const int T_WIN = 4 * 124 * 16;
  const int T_WBR = 12 * 16 * 8;
  const int T_WOUT = 4 * 16 * 16;
  const int T_MOD = 192;
  const int T_ROPE = 16384 * 40 / 256;
  const int total = T_WIN + T_WBR + T_WOUT + T_MOD + T_ROPE;
  {
    float* T = (float*)lds;
    const int nn = tid & 63;
    float cur[16], nxt[16];
    int task = blockIdx.x;
    if (task < T_WIN) {
      const int l = task / (124 * 16), r = task % (124 * 16), nt = r / 16, kt = r % 16;
      const int col = win_col(nt * 64 + nn);
      const float* src = p.w_in + (size_t)l * 1024 * NIN;
#pragma unroll
      for (int i = 0; i < 16; ++i) { const int kk = (tid >> 6) + 4 * i; cur[i] = (col >= 0) ? src[(size_t)(kt * 64 + kk) * NIN + col] : 0.f; }
    }
    for (; task < T_WIN; task += gridDim.x) {
      const int tn = (task + (int)gridDim.x < T_WIN) ? task + (int)gridDim.x : task;
      {
        const int l = tn / (124 * 16), r = tn % (124 * 16), nt = r / 16, kt = r % 16;
        const int col = win_col(nt * 64 + nn);
        const float* src = p.w_in + (size_t)l * 1024 * NIN;
#pragma unroll
        for (int i = 0; i < 16; ++i) { const int kk = (tid >> 6) + 4 * i; nxt[i] = (col >= 0) ? src[(size_t)(kt * 64 + kk) * NIN + col] : 0.f; }
      }
      const int l = task / (124 * 16), r = task % (124 * 16), nt = r / 16, kt = r % 16;
      half_t* dst = WinT + (size_t)l * NPAD * WP;
#pragma unroll
      for (int i = 0; i < 16; ++i) T[((tid >> 6) + 4 * i) * 65 + nn] = cur[i];
      __syncthreads();
#pragma unroll
      for (int i = 0; i < 2; ++i) {
        const int n2 = (tid >> 3) + 32 * i, kc = tid & 7;
        h8 o;
#pragma unroll
        for (int q = 0; q < 8; ++q) o[q] = (half_t)T[(kc * 8 + q) * 65 + n2];
        *(h8*)(dst + (size_t)(nt * 64 + n2) * WP + kt * 64 + kc * 8) = o;
      }
      __syncthreads();
#pragma unroll
      for (int i = 0; i < 16; ++i) cur[i] = nxt[i];
    }
  }
  for (int task = blockIdx.x; task < total; task += gridDim.x) {
    int t = task;
    if (t < T_WIN) continue;
    if (t < T_WIN) {
      int l = t / (124 * 16); int r = t % (124 * 16); int nt = r / 16, kt = r % 16;
      transpose_tile(p.w_in + (size_t)l * 1024 * NIN, NIN, WinT + (size_t)l * NPAD * WP, WP, kt * 64, nt * 64, 1, lds);
      continue;
    }
    t -= T_WIN;
    if (t < T_WBR) {
      int lb = t / 128; int r = t % 128; int nt = r / 8, kt = r % 8;
      int l = lb / 3, b = lb % 3;
      const float* src = (b == 0 ? p.w_br_ret : (b == 1 ? p.w_br_dsa : p.w_br_gla)) + (size_t)l * 512 * 1024;
      transpose_tile(src, 1024, WbrT + (size_t)lb * 1024 * WBP, WBP, kt * 64, nt * 64, 0, lds);
      continue;
    }
    t -= T_WBR;
    if (t < T_WOUT) {
      int l = t / 256; int r = t % 256; int nt = r / 16, kt = r % 16;
      transpose_tile(p.w_out + (size_t)l * 1024 * 1024, 1024, WoutT + (size_t)l * 1024 * WP, WP, kt * 64, nt * 64, 0, lds);
      continue;
    }
    t -= T_WOUT;
    if (t < T_MOD) {
      int l = t / 48, jb = t % 48;
      int j = jb * 64 + (tid & 63);
      int ig = tid >> 6;
      float acc = 0.f;
      const float* aw = p.ada_w + (size_t)l * 1024 * 3072;
      for (int i = ig * 256; i < ig * 256 + 256; ++i) {
        float cv = p.c[i];
        float sc = cv / (1.f + expf(-cv));
        acc += sc * aw[(size_t)i * 3072 + j];
      }
      float* red = (float*)lds;
      red[tid] = acc;
      __syncthreads();
      if (tid < 64) {
        float s = red[tid] + red[tid + 64] + red[tid + 128] + red[tid + 192];
        MOD[l * 3072 + j] = s + p.ada_b[l * 3072 + j];
      }
      __syncthreads();
      continue;
    }
    t -= T_MOD;
    {
      int e = t * 256 + tid;
      int tok = e / 40, f = e % 40;
      float pf = (float)p.pos[tok];
      if (f < 32) {
        float fr = powf(10000.0f, -(float)f * 2.0f / 64.0f);
        float ang = pf * fr;
        RT[tok * 64 + f * 2] = cosf(ang);
        RT[tok * 64 + f * 2 + 1] = sinf(ang);
      } else {
        int g = f - 32;
        float fr = powf(500000.0f, -(float)g * 2.0f / 16.0f);
        float ang = pf * fr;
        DT[tok * 16 + g * 2] = cosf(ang);
        DT[tok * 16 + g * 2 + 1] = sinf(ang);
      }
    }
  }
}

__device__ __forceinline__ void write_h_row(const float (&xv)[16], const float* __restrict__ pre,
                                            const float* __restrict__ mod, half_t* __restrict__ hrow, int l) {
  float ss = 0.f;
#pragma unroll
  for (int i = 0; i < 16; ++i) ss += xv[i] * xv[i];
  ss = wave_sum(ss);
  float rs = rsqrtf(ss * (1.0f / 1024.0f) + 1e-6f);
#pragma unroll
  for (int i = 0; i < 4; ++i) {
    int c0 = i * 256 + l * 4;
    f4v pg = *(const f4v*)(pre + c0);
    f4v sh = *(const f4v*)(mod + c0);
    f4v sc = *(const f4v*)(mod + 1024 + c0);
    h4 o;
#pragma unroll
    for (int q = 0; q < 4; ++q) o[q] = (half_t)(xv[i * 4 + q] * rs * pg[q] * (1.f + sc[q]) + sh[q]);
    *(h4*)(hrow + c0) = o;
  }
}

__device__ void phase_h0(const Params& p) {
  const int w = otid() >> 6, l = otid() & 63;
  half_t* H = (half_t*)(p.ws + OFF_H);
  const float* MOD = (const float*)(p.ws + OFF_MOD);
  for (int row = blockIdx.x * 4 + w; row < S_LEN; row += gridDim.x * 4) {
    float xv[16];
#pragma unroll
    for (int i = 0; i < 4; ++i) {
      f4v v = *(const f4v*)(p.x + (size_t)row * 1024 + i * 256 + l * 4);
      xv[i * 4] = v[0]; xv[i * 4 + 1] = v[1]; xv[i * 4 + 2] = v[2]; xv[i * 4 + 3] = v[3];
    }
    write_h_row(xv, p.pre_norm, MOD, H + (size_t)row * HP, l);
  }
}

__device__ __forceinline__ void lds_barrier() {
  asm volatile("s_waitcnt lgkmcnt(0)" ::: "memory");
  __builtin_amdgcn_s_barrier();
  asm volatile("" ::: "memory");
}
#define GEMM_BUF 55296
#define GEMM_EOFF 110592
template <int NT>
__device__ __forceinline__ void gemm_step(f16v (&acc)[4][NT], h8 (&ra)[8], h8 (&rb)[2 * NT],
                                          const unsigned char* As, const unsigned char* Bs, unsigned char* Aw, unsigned char* Bw,
                                          const half_t* __restrict__ A, int lda, const half_t* __restrict__ B, int ldb, int kload,
                                          int wm, int wn, int l, int r0, int kc) {
  h8 af[2][4], bf[2][NT];
#pragma unroll
  for (int i = 0; i < 4; ++i) af[0][i] = *(const h8*)(As + (wm * 128 + i * 32 + (l & 31)) * 144 + (l >> 5) * 16);
#pragma unroll
  for (int j = 0; j < NT; ++j) bf[0][j] = *(const h8*)(Bs + (wn * 32 * NT + j * 32 + (l & 31)) * 144 + (l >> 5) * 16);
#pragma unroll
  for (int ks = 0; ks < 4; ++ks) {
    if (ks < 3) {
#pragma unroll
      for (int i = 0; i < 4; ++i) af[(ks + 1) & 1][i] = *(const h8*)(As + (wm * 128 + i * 32 + (l & 31)) * 144 + (ks + 1) * 32 + (l >> 5) * 16);
#pragma unroll
      for (int j = 0; j < NT; ++j) bf[(ks + 1) & 1][j] = *(const h8*)(Bs + (wn * 32 * NT + j * 32 + (l & 31)) * 144 + (ks + 1) * 32 + (l >> 5) * 16);
    }
    __builtin_amdgcn_sched_barrier(0);
#pragma unroll
    for (int i = 0; i < 4; ++i)
#pragma unroll
      for (int j = 0; j < NT; ++j) acc[i][j] = mfma16(af[ks & 1][i], bf[ks & 1][j], acc[i][j]);
#pragma unroll
    for (int i = 2 * ks; i < 2 * ks + 2; ++i) {
      *(h8*)(Aw + (r0 + 32 * i) * 144 + kc * 16) = ra[i];
      ra[i] = *(const h8*)(A + (size_t)(r0 + 32 * i) * lda + kload + kc * 8);
    }
    if (NT == 2) {
      *(h8*)(Bw + (r0 + 32 * ks) * 144 + kc * 16) = rb[ks];
      rb[ks] = *(const h8*)(B + (size_t)(r0 + 32 * ks) * ldb + kload + kc * 8);
    } else {
#pragma unroll
      for (int i = 2 * ks; i < 2 * ks + 2; ++i) {
        *(h8*)(Bw + (r0 + 32 * i) * 144 + kc * 16) = rb[i];
        rb[i] = *(const h8*)(B + (size_t)(r0 + 32 * i) * ldb + kload + kc * 8);
      }
    }
    __builtin_amdgcn_sched_barrier(0);
  }
}
template <int NT>
__device__ __forceinline__ void gemm_issue(h8 (&ra0)[8], h8 (&rb0)[2 * NT], h8 (&ra1)[8], h8 (&rb1)[2 * NT],
                                           const half_t* __restrict__ A, int lda, const half_t* __restrict__ B, int ldb) {
  const int tid = otid();
  const int kc = tid & 7, r0 = tid >> 3;
#pragma unroll
  for (int i = 0; i < 8; ++i) ra0[i] = *(const h8*)(A + (size_t)(r0 + 32 * i) * lda + kc * 8);
#pragma unroll
  for (int i = 0; i < 2 * NT; ++i) rb0[i] = *(const h8*)(B + (size_t)(r0 + 32 * i) * ldb + kc * 8);
#pragma unroll
  for (int i = 0; i < 8; ++i) ra1[i] = *(const h8*)(A + (size_t)(r0 + 32 * i) * lda + 64 + kc * 8);
#pragma unroll
  for (int i = 0; i < 2 * NT; ++i) rb1[i] = *(const h8*)(B + (size_t)(r0 + 32 * i) * ldb + 64 + kc * 8);
}
template <int NT>
__device__ __forceinline__ void gemm_run(f16v (&acc)[4][NT], h8 (&ra0)[8], h8 (&rb0)[2 * NT], h8 (&ra1)[8], h8 (&rb1)[2 * NT],
                                         const half_t* __restrict__ A, int lda, const half_t* __restrict__ B, int ldb, int K, unsigned char* lds) {
  const int tid = otid(), w = tid >> 6, l = tid & 63;
  constexpr int STAGE = 256 * 144 + 64 * NT * 144;
  unsigned char* A0 = lds;
  unsigned char* B0 = lds + 256 * 144;
  unsigned char* A1 = lds + STAGE;
  unsigned char* B1 = lds + STAGE + 256 * 144;
  const int wm = w >> 1, wn = w & 1;
  const int kc = tid & 7;
  const int r0 = tid >> 3;
  lds_barrier();
#pragma unroll
  for (int i = 0; i < 8; ++i) { *(h8*)(A0 + (r0 + 32 * i) * 144 + kc * 16) = ra0[i]; ra0[i] = *(const h8*)(A + (size_t)(r0 + 32 * i) * lda + 128 + kc * 8); }
#pragma unroll
  for (int i = 0; i < 2 * NT; ++i) { *(h8*)(B0 + (r0 + 32 * i) * 144 + kc * 16) = rb0[i]; rb0[i] = *(const h8*)(B + (size_t)(r0 + 32 * i) * ldb + 128 + kc * 8); }
  lds_barrier();
  const int nk = K / 64;
#pragma unroll 1
  for (int kt = 0; kt < nk; kt += 2) {
    gemm_step<NT>(acc, ra1, rb1, A0, B0, A1, B1, A, lda, B, ldb, (kt + 3 < nk) ? (kt + 3) * 64 : 0, wm, wn, l, r0, kc);
    lds_barrier();
    gemm_step<NT>(acc, ra0, rb0, A1, B1, A0, B0, A, lda, B, ldb, (kt + 4 < nk) ? (kt + 4) * 64 : 0, wm, wn, l, r0, kc);
    lds_barrier();
  }
}
template <int NT>
__device__ __forceinline__ void gemm_kloop(f16v (&acc)[4][NT], const half_t* __restrict__ A, int lda,
                                           const half_t* __restrict__ B, int ldb, int K, unsigned char* lds) {
  h8 ra0[8], rb0[2 * NT], ra1[8], rb1[2 * NT];
  gemm_issue<NT>(ra0, rb0, ra1, rb1, A, lda, B, ldb);
  gemm_run<NT>(acc, ra0, rb0, ra1, rb1, A, lda, B, ldb, K, lds);
}

template <int NT>
__device__ __forceinline__ void gemm_issue1(h8 (&ra)[8], h8 (&rb)[2 * NT], const half_t* __restrict__ A, int lda, const half_t* __restrict__ B, int ldb) {
  const int tid = otid();
  const int kc = tid & 7, r0 = tid >> 3;
#pragma unroll
  for (int i = 0; i < 8; ++i) ra[i] = *(const h8*)(A + (size_t)(r0 + 32 * i) * lda + kc * 8);
#pragma unroll
  for (int i = 0; i < 2 * NT; ++i) rb[i] = *(const h8*)(B + (size_t)(r0 + 32 * i) * ldb + kc * 8);
}
template <int NT>
__device__ __forceinline__ void gemm_run1(f16v (&acc)[4][NT], h8 (&ra)[8], h8 (&rb)[2 * NT],
                                          const half_t* __restrict__ A, int lda, const half_t* __restrict__ B, int ldb, int K, unsigned char* lds) {
  const int tid = otid(), w = tid >> 6, l = tid & 63;
  constexpr int STAGE = 256 * 144 + 64 * NT * 144;
  const int wm = w >> 1, wn = w & 1;
  const int kc = tid & 7;
  const int r0 = tid >> 3;
  lds_barrier();
#pragma unroll
  for (int i = 0; i < 8; ++i) { *(h8*)(lds + (r0 + 32 * i) * 144 + kc * 16) = ra[i]; ra[i] = *(const h8*)(A + (size_t)(r0 + 32 * i) * lda + 64 + kc * 8); }
#pragma unroll
  for (int i = 0; i < 2 * NT; ++i) { *(h8*)(lds + 256 * 144 + (r0 + 32 * i) * 144 + kc * 16) = rb[i]; rb[i] = *(const h8*)(B + (size_t)(r0 + 32 * i) * ldb + 64 + kc * 8); }
  lds_barrier();
  const int nk = K / 64;
#pragma unroll 1
  for (int kt = 0; kt < nk; ++kt) {
    unsigned char* cur = lds + (kt & 1) * STAGE;
    unsigned char* nxt = lds + ((kt + 1) & 1) * STAGE;
    gemm_step<NT>(acc, ra, rb, cur, cur + 256 * 144, nxt, nxt + 256 * 144, A, lda, B, ldb, (kt + 2 < nk) ? (kt + 2) * 64 : 0, wm, wn, l, r0, kc);
    lds_barrier();
  }
}

template <int NT>
__device__ __forceinline__ void zero_acc(f16v (&acc)[4][NT]) {
  float z = 0.f;
  asm volatile("" : "+v"(z));
#pragma unroll
  for (int i = 0; i < 4; ++i)
#pragma unroll
    for (int j = 0; j < NT; ++j)
#pragma unroll
      for (int r = 0; r < 16; ++r) acc[i][j][r] = z;
}

#define EP 68
__device__ __forceinline__ void stage_pair(float* E, const f16v& a0, const f16v& a1, int l) {
#pragma unroll
  for (int r = 0; r < 16; ++r) {
    const int rr = crow(r, l);
    E[rr * EP + (l & 31)] = a0[r];
    E[rr * EP + 32 + (l & 31)] = a1[r];
  }
}
__device__ __forceinline__ void ld8(const float* p, float (&v)[8]) {
  const f4v a = *(const f4v*)p, b = *(const f4v*)(p + 4);
  v[0] = a[0]; v[1] = a[1]; v[2] = a[2]; v[3] = a[3]; v[4] = b[0]; v[5] = b[1]; v[6] = b[2]; v[7] = b[3];
}
__device__ __forceinline__ int xcc_census(const unsigned* xcnt, int my_xcc) {
  unsigned sum = 0; bool ok = my_xcc < 8; int mine = 0;
#pragma unroll
  for (int j = 0; j < 16; ++j) {
    const unsigned c = __hip_atomic_load(xcnt + j, __ATOMIC_RELAXED, __HIP_MEMORY_SCOPE_AGENT);
    sum += c;
    if (j < 8 && c == 0u) ok = false;
    if (j >= 8 && c != 0u) ok = false;
    if (j == my_xcc) mine = (int)c;
  }
  if (sum != gridDim.x) ok = false;
  return ok ? mine : 0;
}

__device__ void phase_A(const Params& p, int layer, unsigned char* lds, int my_xcc, int my_loc, const unsigned* xcnt) {
  const int tid = otid(), w = tid >> 6, l = tid & 63;
  const half_t* H = (const half_t*)(p.ws + OFF_H);
  const half_t* Wt = (const half_t*)(p.ws + OFF_WINT) + (size_t)layer * NPAD * WP;
  half_t* P = (half_t*)(p.ws + OFF_P);
  float* GA = (float*)(p.ws + OFF_GA);
  float* IW = (float*)(p.ws + OFF_IW);
  const float* RT = (const float*)(p.ws + OFF_RT);
  const float* DT = (const float*)(p.ws + OFF_DT);
  const int wm = w >> 1, wn = w & 1;
  const int G = gridDim.x;
  const int ntiles = 64 * 31;
  const int nx = xcc_census(xcnt, my_xcc);
  int nmine;
  if (nx > 0) nmine = (my_loc < 248) ? (248 - my_loc + nx - 1) / nx : 0;
  else nmine = ((int)blockIdx.x < ntiles) ? (ntiles - (int)blockIdx.x + G - 1) / G : 0;
  h8 ra0[8], rb0[8];
  int mt = 0, nt = 0;
  if (nmine > 0) {
    if (nx > 0) { const int s0 = my_loc; mt = my_xcc * 8 + (s0 & 7); nt = s0 >> 3; }
    else { const int tix = blockIdx.x; mt = tix & 63; nt = tix >> 6; }
    gemm_issue1<4>(ra0, rb0, H + (size_t)mt * 256 * HP, HP, Wt + (size_t)nt * 256 * WP, WP);
  }
#pragma unroll 1
  for (int rnd = 0; rnd < nmine; ++rnd) {
    f16v acc[4][4];
    zero_acc<4>(acc);
    gemm_run1<4>(acc, ra0, rb0, H + (size_t)mt * 256 * HP, HP, Wt + (size_t)nt * 256 * WP, WP, 1024, lds);
    const int mt_cur = mt, nt_cur = nt;
    if (rnd + 1 < nmine) {
      if (nx > 0) { const int s1 = my_loc + nx * (rnd + 1); mt = my_xcc * 8 + (s1 & 7); nt = s1 >> 3; }
      else { const int tix = (rnd + 1) * G + blockIdx.x; mt = tix & 63; nt = tix >> 6; }
      gemm_issue1<4>(ra0, rb0, H + (size_t)mt * 256 * HP, HP, Wt + (size_t)nt * 256 * WP, WP);
    }
    const int m0w = mt_cur * 256 + wm * 128;
    const int n0w = nt_cur * 256 + wn * 128;
    float* E = (float*)(lds) + w * (32 * EP);
    const int prow = l >> 3, c0 = (l & 7) * 8;
#pragma unroll
    for (int jp = 0; jp < 2; ++jp) {
      const int nb2 = n0w + jp * 64;
      const int n0 = nb2 + c0;
      const bool rope64 = nb2 < 512;
      const bool rope16 = ((nb2 >= C_DSAQ && nb2 < C_DSAV) || (nb2 >= C_IDXQ && nb2 < C_GLAQ)) && (c0 < 16);
      float scale = 1.f;
      if (n0 < 256 || (n0 >= C_DSAQ && n0 < C_DSAK) || (n0 >= C_IDXQ && n0 < C_IDXK) || (n0 >= C_GLAQ && n0 < C_GLAK)) scale = 0.125f;
      int mode = 0;
      if ((n0 >= C_RETG && n0 < C_DSAQ) || (n0 >= C_DSAG && n0 < C_IDXQ) || (n0 >= C_GLAG && n0 < C_GLAA)) mode = 1;
      if (n0 >= C_MRG && n0 < C_END) mode = 2;
#pragma unroll
      for (int i = 0; i < 4; ++i) {
        stage_pair(E, acc[i][2 * jp], acc[i][2 * jp + 1], l);
#pragma unroll 2
        for (int ps = 0; ps < 4; ++ps) {
          const int rl = ps * 8 + prow;
          const int row = m0w + i * 32 + rl;
          float v[8], o[8];
          ld8(E + rl * EP + c0, v);
#pragma unroll
          for (int q = 0; q < 8; ++q) o[q] = v[q];
          if (rope64) {
            float pv[8], tb[16];
            ld8(E + rl * EP + (c0 ^ 32), pv);
            const float* tp = RT + (size_t)row * 64 + (c0 & 31) * 2;
            ld8(tp, *(float(*)[8])&tb[0]); ld8(tp + 8, *(float(*)[8])&tb[8]);
#pragma unroll
            for (int q = 0; q < 8; ++q) o[q] = (c0 < 32) ? (v[q] * tb[2 * q] - pv[q] * tb[2 * q + 1]) : (v[q] * tb[2 * q] + pv[q] * tb[2 * q + 1]);
          } else if (rope16) {
            float pv[8], tb[16];
            ld8(E + rl * EP + (c0 ^ 8), pv);
            const float* tp = DT + (size_t)row * 16;
            ld8(tp, *(float(*)[8])&tb[0]); ld8(tp + 8, *(float(*)[8])&tb[8]);
#pragma unroll
            for (int q = 0; q < 8; ++q) o[q] = (c0 < 8) ? (v[q] * tb[2 * q] - pv[q] * tb[2 * q + 1]) : (v[q] * tb[2 * q] + pv[q] * tb[2 * q + 1]);
          }
          h8 ov;
#pragma unroll
          for (int q = 0; q < 8; ++q) {
            float t = o[q] * scale;
            if (mode != 0) {
              const float sg = __builtin_amdgcn_rcpf(1.f + __expf(-t));
              t = (mode == 1) ? t * sg : sg;
            }
            ov[q] = (half_t)t;
          }
          if (n0 < C_END) __builtin_nontemporal_store(ov, (h8*)(P + (size_t)row * PP + n0));
          if (n0 >= C_GLAA && n0 < C_MRG) {
#pragma unroll
            for (int q = 0; q < 8; ++q) GA[(size_t)row * 16 + (n0 - C_GLAA) + q] = v[q];
          }
          if (n0 == C_IDXW) {
#pragma unroll
            for (int q = 0; q < 4; ++q) IW[(size_t)row * 4 + q] = 0.5f * v[q];
          }
        }
      }
    }
  }
}

#define LA_BC 0
#define LA_GAS 16640
#define LA_WL 20736
#define LA_QT 24832
#define LA_KT 34048
#define LA_AT 43264
#define LA_VT 52480
#define LA_SS 70912
#define LA_OS 89344
#define LA_SEG 123136

__device__ void la_bcum(const Params& p, int layer, int n, int Hh, unsigned char* lds) {
  const int tid = otid();
  float* Bc = (float*)(lds + LA_BC);
  const int d = tid & 63, q = tid >> 6;
  if (Hh < 4) {
    float lg = log1pf(-exp2f(-5.0f - (float)Hh));
#pragma unroll
    for (int jj = 0; jj < 16; ++jj) { int j = q * 16 + jj; Bc[j * 65 + d] = (float)(j + 1) * lg; }
    __syncthreads();
    return;
  }
  const int h = Hh - 4;
  float* GAs = (float*)(lds + LA_GAS);
  float* WL = (float*)(lds + LA_WL);
  float* SEG = (float*)(lds + LA_SEG);
  const float* GA = (const float*)(p.ws + OFF_GA);
#pragma unroll
  for (int i = 0; i < 4; ++i) {
    int e = tid + 256 * i;
    GAs[e] = GA[(size_t)n * 64 * 16 + e];
    int r = e >> 6, dd = e & 63;
    WL[e] = p.gla_w_lr[(size_t)layer * 16 * 256 + r * 256 + h * 64 + dd];
  }
  __syncthreads();
  float wl[16];
#pragma unroll
  for (int r = 0; r < 16; ++r) wl[r] = WL[r * 64 + d];
  const float bl = p.gla_b_lr[layer * 256 + h * 64 + d];
  float run = 0.f;
#pragma unroll
  for (int jj = 0; jj < 16; ++jj) {
    int j = q * 16 + jj;
    float z = bl;
#pragma unroll
    for (int r = 0; r < 16; ++r) z += GAs[j * 16 + r] * wl[r];
    float ls = fminf(z, 0.f) - log1pf(expf(-fabsf(z)));
    run += ls * (1.0f / 16.0f);
    Bc[j * 65 + d] = run;
  }
  SEG[q * 64 + d] = run;
  __syncthreads();
  float off = 0.f;
  for (int qq = 0; qq < q; ++qq) off += SEG[qq * 64 + d];
  if (q > 0) {
#pragma unroll
    for (int jj = 0; jj < 16; ++jj) { int j = q * 16 + jj; Bc[j * 65 + d] += off; }
  }
  __syncthreads();
}

__device__ __forceinline__ void la_load_v(const half_t* __restrict__ P, int t0, int vcol, h8 (&vr)[2][2]) {
  const int tid = otid(), w = tid >> 6, l = tid & 63;
  const int jp = l & 31, cgp = l >> 5;
#pragma unroll
  for (int it = 0; it < 2; ++it) {
    int c = it * 8 + w * 2 + cgp;
    vr[it][0] = *(const h8*)(P + (size_t)(t0 + 2 * jp) * PP + vcol + c * 8);
    vr[it][1] = *(const h8*)(P + (size_t)(t0 + 2 * jp + 1) * PP + vcol + c * 8);
  }
}
__device__ __forceinline__ void la_stage_vt(const h8 (&vr)[2][2], unsigned char* lds) {
  const int tid = otid(), w = tid >> 6, l = tid & 63;
  half_t* VT = (half_t*)(lds + LA_VT);
  const int jp = l & 31, cgp = l >> 5;
#pragma unroll
  for (int it = 0; it < 2; ++it) {
    int c = it * 8 + w * 2 + cgp;
#pragma unroll
    for (int q = 0; q < 8; ++q) {
      h2 pr; pr[0] = vr[it][0][q]; pr[1] = vr[it][1][q];
      *(h2*)(VT + (c * 8 + q) * 72 + 2 * jp) = pr;
    }
  }
}
__device__ void la_item_kv(const Params& p, int layer, int item, unsigned char* lds) {
  const int tid = otid(), w = tid >> 6, l = tid & 63;
  const int n = item >> 3, Hh = item & 7;
  const int t0 = n * 64;
  const half_t* P = (const half_t*)(p.ws + OFF_P);
  half_t* ST = (half_t*)(p.ws + OFF_ST);
  float* DEC = (float*)(p.ws + OFF_DEC);
  const int kcol = (Hh < 4) ? (C_RETK + Hh * 64) : (C_GLAK + (Hh - 4) * 64);
  const int vcol = (Hh < 4) ? (C_RETV + Hh * 128) : (C_GLAV + (Hh - 4) * 128);
  h8 vr[2][2];
  la_load_v(P, t0, vcol, vr);
  const h8 k0 = *(const h8*)(P + (size_t)(t0 + 2 * (l & 31)) * PP + kcol + (w * 2 + (l >> 5)) * 8);
  const h8 k1 = *(const h8*)(P + (size_t)(t0 + 2 * (l & 31) + 1) * PP + kcol + (w * 2 + (l >> 5)) * 8);
  __syncthreads();
  la_bcum(p, layer, n, Hh, lds);
  const float* Bc = (const float*)(lds + LA_BC);
  half_t* KhT = (half_t*)(lds + LA_KT);
  half_t* VT = (half_t*)(lds + LA_VT);
  {
    const int jp = l & 31, cgp = l >> 5;
    int c = w * 2 + cgp;
#pragma unroll
    for (int q = 0; q < 8; ++q) {
      int d = c * 8 + q;
      float bl = Bc[63 * 65 + d];
      h2 pr;
      pr[0] = (half_t)((float)k0[q] * __expf(bl - Bc[(2 * jp) * 65 + d]));
      pr[1] = (half_t)((float)k1[q] * __expf(bl - Bc[(2 * jp + 1) * 65 + d]));
      *(h2*)(KhT + d * 72 + 2 * jp) = pr;
    }
  }
  la_stage_vt(vr, lds);
  if (tid < 64) DEC[(size_t)item * 64 + tid] = __expf(Bc[63 * 65 + tid]);
  __syncthreads();
  f16v acc[2];
#pragma unroll
  for (int j = 0; j < 2; ++j)
#pragma unroll
    for (int r = 0; r < 16; ++r) acc[j][r] = ozero();
#pragma unroll
  for (int ks = 0; ks < 4; ++ks) {
    h8 a = *(const h8*)(VT + (32 * w + (l & 31)) * 72 + ks * 16 + (l >> 5) * 8);
#pragma unroll
    for (int j = 0; j < 2; ++j) {
      h8 b = *(const h8*)(KhT + (j * 32 + (l & 31)) * 72 + ks * 16 + (l >> 5) * 8);
      acc[j] = mfma16(a, b, acc[j]);
    }
  }
#pragma unroll
  for (int j = 0; j < 2; ++j)
#pragma unroll
    for (int r = 0; r < 16; ++r) {
      int e = 32 * w + crow(r, l);
      int d = j * 32 + (l & 31);
      ST[(size_t)item * 8192 + e * 64 + d] = (half_t)acc[j][r];
    }
}

__device__ void phase_scan(const Params& p) {
  half_t* ST = (half_t*)(p.ws + OFF_ST);
  const float* DEC = (const float*)(p.ws + OFF_DEC);
  for (int f2 = blockIdx.x * NTHREADS + otid(); f2 < 32768; f2 += gridDim.x * NTHREADS) {
    const int f = f2 * 2;
    const int Hh = f >> 13, d = f & 63;
    float s0 = 0.f, s1 = 0.f;
    for (int n0 = 0; n0 < 256; n0 += 16) {
      h2 kv[16]; float2 dc[16];
#pragma unroll
      for (int u = 0; u < 16; ++u) {
        kv[u] = *(const h2*)(ST + (size_t)(n0 + u) * 65536 + f);
        dc[u] = *(const float2*)(DEC + (size_t)((n0 + u) * 8 + Hh) * 64 + d);
      }
#pragma unroll
      for (int u = 0; u < 16; ++u) {
        h2 o; o[0] = (half_t)s0; o[1] = (half_t)s1;
        *(h2*)(ST + (size_t)(n0 + u) * 65536 + f) = o;
        s0 = dc[u].x * s0 + (float)kv[u][0];
        s1 = dc[u].y * s1 + (float)kv[u][1];
      }
    }
  }
}

__device__ void la_item_out(const Params& p, int layer, int item, unsigned char* lds) {
  const int tid = otid(), w = tid >> 6, l = tid & 63;
  const int n = item >> 3, Hh = item & 7;
  const int t0 = n * 64;
  const half_t* P = (const half_t*)(p.ws + OFF_P);
  const half_t* ST = (const half_t*)(p.ws + OFF_ST);
  half_t* BR = (half_t*)(p.ws + OFF_BR);
  const int qcol = (Hh < 4) ? (C_RETQ + Hh * 64) : (C_GLAQ + (Hh - 4) * 64);
  const int kcol = (Hh < 4) ? (C_RETK + Hh * 64) : (C_GLAK + (Hh - 4) * 64);
  const int vcol = (Hh < 4) ? (C_RETV + Hh * 128) : (C_GLAV + (Hh - 4) * 128);
  const int gcol = (Hh < 4) ? (C_RETG + Hh * 128) : (C_GLAG + (Hh - 4) * 128);
  const int ocol = (Hh < 4) ? (Hh * 128) : (1024 + (Hh - 4) * 128);
  h8 vr[2][2];
  la_load_v(P, t0, vcol, vr);
  h8 qr[2], kr[2], sr[4];
#pragma unroll
  for (int it = 0; it < 2; ++it) {
    const int c = tid + 256 * it;
    qr[it] = *(const h8*)(P + (size_t)(t0 + (c >> 3)) * PP + qcol + (c & 7) * 8);
    kr[it] = *(const h8*)(P + (size_t)(t0 + (c >> 3)) * PP + kcol + (c & 7) * 8);
  }
#pragma unroll
  for (int it = 0; it < 4; ++it) {
    const int c = tid + 256 * it;
    sr[it] = *(const h8*)(ST + (size_t)item * 8192 + (c >> 3) * 64 + (c & 7) * 8);
  }
  __syncthreads();
  la_bcum(p, layer, n, Hh, lds);
  const float* Bc = (const float*)(lds + LA_BC);
  half_t* Qt = (half_t*)(lds + LA_QT);
  half_t* Kt = (half_t*)(lds + LA_KT);
  half_t* AT = (half_t*)(lds + LA_AT);
  half_t* VT = (half_t*)(lds + LA_VT);
  half_t* SS = (half_t*)(lds + LA_SS);
  float* OS = (float*)(lds + LA_OS);
#pragma unroll
  for (int it = 0; it < 2; ++it) {
    int c = tid + 256 * it;
    int row = c >> 3, kc = c & 7;
    const h8 qv = qr[it];
    const h8 kv = kr[it];
    h8 qo, ko;
#pragma unroll
    for (int q = 0; q < 8; ++q) {
      float b = Bc[row * 65 + kc * 8 + q];
      qo[q] = (half_t)((float)qv[q] * __expf(b));
      ko[q] = (half_t)((float)kv[q] * __expf(-b));
    }
    *(h8*)(Qt + row * 72 + kc * 8) = qo;
    *(h8*)(Kt + row * 72 + kc * 8) = ko;
  }
  la_stage_vt(vr, lds);
#pragma unroll
  for (int it = 0; it < 4; ++it) {
    int c = tid + 256 * it;
    int e = c >> 3, kc = c & 7;
    *(h8*)(SS + e * 72 + kc * 8) = sr[it];
  }
  __syncthreads();
  {
    const int mi = w >> 1, nj = w & 1;
    f16v acc;
#pragma unroll
    for (int r = 0; r < 16; ++r) acc[r] = ozero();
#pragma unroll
    for (int ks = 0; ks < 4; ++ks) {
      h8 a = *(const h8*)(Qt + (mi * 32 + (l & 31)) * 72 + ks * 16 + (l >> 5) * 8);
      h8 b = *(const h8*)(Kt + (nj * 32 + (l & 31)) * 72 + ks * 16 + (l >> 5) * 8);
      acc = mfma16(a, b, acc);
    }
#pragma unroll
    for (int r = 0; r < 16; ++r) {
      int i = mi * 32 + crow(r, l);
      int j = nj * 32 + (l & 31);
      float v = (j <= i) ? acc[r] : 0.f;
      AT[i * 72 + j] = (half_t)v;
    }
  }
  __syncthreads();
  {
    const int mi = w >> 1, nh = w & 1;
    f16v acc[2];
#pragma unroll
    for (int j = 0; j < 2; ++j)
#pragma unroll
      for (int r = 0; r < 16; ++r) acc[j][r] = ozero();
#pragma unroll
    for (int ks = 0; ks < 4; ++ks) {
      h8 a1 = *(const h8*)(AT + (mi * 32 + (l & 31)) * 72 + ks * 16 + (l >> 5) * 8);
      h8 a2 = *(const h8*)(Qt + (mi * 32 + (l & 31)) * 72 + ks * 16 + (l >> 5) * 8);
#pragma unroll
      for (int j = 0; j < 2; ++j) {
        h8 b1 = *(const h8*)(VT + (nh * 64 + j * 32 + (l & 31)) * 72 + ks * 16 + (l >> 5) * 8);
        h8 b2 = *(const h8*)(SS + (nh * 64 + j * 32 + (l & 31)) * 72 + ks * 16 + (l >> 5) * 8);
        acc[j] = mfma16(a1, b1, acc[j]);
        acc[j] = mfma16(a2, b2, acc[j]);
      }
    }
#pragma unroll
    for (int j = 0; j < 2; ++j)
#pragma unroll
      for (int r = 0; r < 16; ++r) {
        int i = mi * 32 + crow(r, l);
        int e = nh * 64 + j * 32 + (l & 31);
        OS[i * 132 + e] = acc[j][r];
      }
  }
  __syncthreads();
  {
    const int i = tid >> 2, qd = tid & 3;
    float ov[32];
    float ss = 0.f;
#pragma unroll
    for (int c = 0; c < 8; ++c) {
      f4v v = *(const f4v*)(OS + i * 132 + qd * 32 + c * 4);
      ov[c * 4] = v[0]; ov[c * 4 + 1] = v[1]; ov[c * 4 + 2] = v[2]; ov[c * 4 + 3] = v[3];
      ss += v[0] * v[0] + v[1] * v[1] + v[2] * v[2] + v[3] * v[3];
    }
    ss += dppf<0xB1>(ss);
    ss += dppf<0x4E>(ss);
    float rs = rsqrtf(ss * (1.0f / 128.0f) + 1e-6f);
#pragma unroll
    for (int c = 0; c < 4; ++c) {
      h8 g = *(const h8*)(P + (size_t)(t0 + i) * PP + gcol + qd * 32 + c * 8);
      h8 o;
#pragma unroll
      for (int q = 0; q < 8; ++q) o[q] = (half_t)(ov[c * 8 + q] * rs * (float)g[q]);
      *(h8*)(BR + (size_t)(t0 + i) * 1536 + ocol + qd * 32 + c * 8) = o;
    }
  }
}

#define DS_CAP 768
#define DS_PRUNE_AT 640
#define NPL 12
#define DS_LS 0
#define DS_LI (32 * DS_CAP * 4)
#define DS_CNT (32 * DS_CAP * 6)
#define DS_THR (DS_CNT + 128)
#define DS_WQ (DS_CNT + 256)
#define DS_HIST (DS_CNT + 1024)

__device__ __forceinline__ unsigned long long wave_or64(unsigned long long v) {
  const unsigned lo = wave_or((unsigned)v), hi = wave_or((unsigned)(v >> 32));
  return ((unsigned long long)hi << 32) | lo;
}
template <bool APPROX>
__device__ __forceinline__ void dsa_prune(float* LSm, unsigned short* LIm, int n, unsigned* hist, int* cntm, float* thrm, int l) {
  unsigned long long comp[NPL];
  bool act[NPL], val[NPL];
#pragma unroll
  for (int k = 0; k < NPL; ++k) {
    int e = l + 64 * k;
    val[k] = e < n;
    const int ec = val[k] ? e : 0;
    unsigned u = __float_as_uint(LSm[ec]), li = LIm[ec];
    if (!val[k]) { u = 0; li = 0; }
    const unsigned key = (u >> 31) ? ~u : (u | 0x80000000u);
    comp[k] = ((unsigned long long)key << 14) | (unsigned long long)(16383u - li);
    act[k] = val[k];
  }
  const unsigned long long c0 = ((unsigned long long)(unsigned)__builtin_amdgcn_readfirstlane((int)(unsigned)(comp[0] >> 32)) << 32) | (unsigned)__builtin_amdgcn_readfirstlane((int)(unsigned)comp[0]);
  unsigned long long x = 0;
#pragma unroll
  for (int k = 0; k < NPL; ++k) x |= val[k] ? (comp[k] ^ c0) : 0ull;
  x = wave_or64(x);
  int shift = (x == 0ull) ? 0 : (63 - __clzll((long long)x)) - 7;
  if (shift < 0) shift = 0;
  unsigned rank = 256;
  bool fast = false; unsigned fsel = 0, fcnt = 0; int fshift = 0;
#pragma unroll 1
  for (int rd = 0; rd < 8; ++rd) {
    *(uint4*)(hist + 4 * l) = make_uint4(0, 0, 0, 0);
    asm volatile("" ::: "memory");
    unsigned dk[NPL];
#pragma unroll
    for (int k = 0; k < NPL; ++k) {
      dk[k] = (unsigned)(comp[k] >> shift) & 255u;
      if (act[k]) atomicAdd(&hist[dk[k]], 1u);
    }
    asm volatile("" ::: "memory");
    uint4 hv; hv.x = hist[4 * l]; hv.y = hist[4 * l + 1]; hv.z = hist[4 * l + 2]; hv.w = hist[4 * l + 3];
    unsigned tl = hv.x + hv.y + hv.z + hv.w;
    const unsigned pin = wave_incl_scan(tl);
    const unsigned tot = (unsigned)__builtin_amdgcn_readlane((int)pin, 63);
    unsigned sx = tot - pin;
    bool mine = (sx < rank) && (rank <= sx + tl);
    unsigned dsel = 0, nr = 0, hsel = 0;
    if (mine) {
      unsigned c = sx;
      if (c + hv.w >= rank) { dsel = 4 * l + 3; nr = rank - c; hsel = hv.w; }
      else {
        c += hv.w;
        if (c + hv.z >= rank) { dsel = 4 * l + 2; nr = rank - c; hsel = hv.z; }
        else {
          c += hv.z;
          if (c + hv.y >= rank) { dsel = 4 * l + 1; nr = rank - c; hsel = hv.y; }
          else { c += hv.y; dsel = 4 * l; nr = rank - c; hsel = hv.x; }
        }
      }
    }
    unsigned long long mk = __ballot(mine);
    int src = (mk == 0ull) ? 0 : (__ffsll((long long)mk) - 1);
    dsel = (unsigned)__builtin_amdgcn_readlane((int)dsel, src);
    rank = (unsigned)__builtin_amdgcn_readlane((int)nr, src);
    hsel = (unsigned)__builtin_amdgcn_readlane((int)hsel, src);
    if (APPROX && rd == 0) {
      const unsigned kept = 256u - rank + hsel;
      if (kept <= 320u) { fast = true; fsel = dsel; fcnt = kept; fshift = shift; break; }
    }
#pragma unroll
    for (int k = 0; k < NPL; ++k) act[k] = act[k] && (dk[k] == dsel);
    if (hsel <= 1u || shift == 0) break;
    shift = (shift >= 8) ? (shift - 8) : 0;
  }
  unsigned long long tsel = 0;
#pragma unroll
  for (int k = 0; k < NPL; ++k) tsel |= act[k] ? comp[k] : 0ull;
  unsigned long long T = 0ull;
  if (!fast) T = wave_or64(tsel);
  else T = ((c0 >> (fshift + 8)) << (fshift + 8)) | ((unsigned long long)fsel << fshift);
  bool keep[NPL];
  unsigned cntk = 0;
#pragma unroll
  for (int k = 0; k < NPL; ++k) {
    keep[k] = val[k] && (comp[k] >= T);
    cntk += keep[k] ? 1u : 0u;
  }
  unsigned pos = wave_incl_scan(cntk) - cntk;
  asm volatile("" ::: "memory");
#pragma unroll
  for (int k = 0; k < NPL; ++k) {
    if (keep[k]) {
      const unsigned kk = (unsigned)(comp[k] >> 14);
      const unsigned u = (kk & 0x80000000u) ? (kk & 0x7FFFFFFFu) : ~kk;
      LSm[pos] = __uint_as_float(u);
      LIm[pos] = (unsigned short)(16383u - ((unsigned)comp[k] & 16383u));
      ++pos;
    }
  }
  if (l == 0) {
    const unsigned T32 = (unsigned)(T >> 14);
    *cntm = fast ? (int)fcnt : 256;
    *thrm = __uint_as_float((T32 & 0x80000000u) ? (T32 & 0x7FFFFFFFu) : ~T32);
  }
  asm volatile("" ::: "memory");
}

__device__ void dsa_item(const Params& p, int qb, unsigned char* lds) {
  const int tid = otid(), w = tid >> 6, l = tid & 63;
  const int t0 = qb * 32;
  const half_t* P = (const half_t*)(p.ws + OFF_P);
  const float* IW = (const float*)(p.ws + OFF_IW);
  half_t* BR = (half_t*)(p.ws + OFF_BR);
  float* LS = (float*)(lds + DS_LS);
  unsigned short* LI = (unsigned short*)(lds + DS_LI);
  int* cnt = (int*)(lds + DS_CNT);
  float* thr = (float*)(lds + DS_THR);
  float* wq = (float*)(lds + DS_WQ);
  unsigned* hist = (unsigned*)(lds + DS_HIST) + w * 256;
  float* PWa = LS + (w * 8) * DS_CAP + 256;
  float* PWb = LS + (w * 8 + 1) * DS_CAP + 256;
  half_t* QS = (half_t*)(LI + (w * 8) * DS_CAP + 256);
  for (int rep_sel = 0; rep_sel < REP_SEL; ++rep_sel) {
  __syncthreads();
  if (tid < 32) { cnt[tid] = 0; thr[tid] = -INFINITY; }
  if (tid < 128) wq[tid] = IW[(size_t)t0 * 4 + tid];
  __syncthreads();
  h8 aq[4][4];
#pragma unroll
  for (int h = 0; h < 4; ++h)
#pragma unroll
    for (int ks = 0; ks < 4; ++ks)
      aq[h][ks] = *(const h8*)(P + (size_t)(t0 + (l & 31)) * PP + C_IDXQ + h * 64 + ks * 16 + (l >> 5) * 8);
  const int nt = qb + 1;
  const int nr = (nt + 3) >> 2;
  f4v wqv[16];
#pragma unroll
  for (int r = 0; r < 16; ++r) wqv[r] = *(const f4v*)(wq + crow(r, l) * 4);
  float thv[16];
  { float ninf = -INFINITY; asm volatile("" : "+v"(ninf));
#pragma unroll
  for (int r = 0; r < 16; ++r) thv[r] = ninf; }
  h8 bk[4];
  {
    const int k0 = (w < nt) ? w : 0;
#pragma unroll
    for (int ks = 0; ks < 4; ++ks)
      bk[ks] = *(const h8*)(P + (size_t)(k0 * 32 + (l & 31)) * PP + C_IDXK + ks * 16 + (l >> 5) * 8);
  }
#pragma unroll 1
  for (int rd = 0; rd < nr; ++rd) {
    const int kt = 4 * rd + w;
    h8 bkn[4];
    {
      const int kn = (kt + 4 < nt) ? (kt + 4) : 0;
#pragma unroll
      for (int ks = 0; ks < 4; ++ks)
        bkn[ks] = *(const h8*)(P + (size_t)(kn * 32 + (l & 31)) * PP + C_IDXK + ks * 16 + (l >> 5) * 8);
    }
    if (kt < nt) {
      const int sbase = kt * 32;
      f16v acc[4];
#pragma unroll
      for (int h = 0; h < 4; ++h) {
#pragma unroll
        for (int r = 0; r < 16; ++r) acc[h][r] = ozero();
#pragma unroll
        for (int ks = 0; ks < 4; ++ks) acc[h] = mfma16(aq[h][ks], bk[ks], acc[h]);
      }
      const int s = sbase + (l & 31);
      float scv[16];
      unsigned pm = 0;
#pragma unroll
      for (int r = 0; r < 16; ++r) {
        const int m = crow(r, l);
        const f4v wv = wqv[r];
        float sc = wv[0] * relu_f(acc[0][r]) + wv[1] * relu_f(acc[1][r]) + wv[2] * relu_f(acc[2][r]) + wv[3] * relu_f(acc[3][r]);
        sc += 0.0f;
        scv[r] = sc;
      }
      if (kt == qb) {
#pragma unroll
        for (int r = 0; r < 16; ++r) if (s > t0 + crow(r, l)) scv[r] = -INFINITY;
      }
#pragma unroll
      for (int r = 0; r < 16; ++r) pm |= (scv[r] > thv[r]) ? (1u << r) : 0u;
      if (__ballot(pm != 0u) != 0ull) {
        unsigned long long mks[16];
        int mycnt = 0;
#pragma unroll
        for (int r = 0; r < 16; ++r) {
          const unsigned long long mk = __ballot(((pm >> r) & 1u) != 0u);
          mks[r] = mk;
          const unsigned hm = (l < 32) ? (unsigned)mk : (unsigned)(mk >> 32);
          if ((l & 31) == r) mycnt = __popc(hm);
        }
        int base = 0;
        if ((l & 31) < 16 && mycnt > 0) base = atomicAdd(&cnt[crow(l & 31, l)], mycnt);
#pragma unroll
        for (int r = 0; r < 16; ++r) {
          const unsigned long long mk = mks[r];
          if (mk != 0ull) {
            const unsigned hm = (l < 32) ? (unsigned)mk : (unsigned)(mk >> 32);
            const int b_lo = __builtin_amdgcn_readlane(base, r), b_hi = __builtin_amdgcn_readlane(base, 32 + r);
            const int bb = (l < 32) ? b_lo : b_hi;
            if ((pm >> r) & 1u) {
              const int m = crow(r, l);
              const int slot = bb + __popc(hm & ((1u << (l & 31)) - 1u));
              LS[m * DS_CAP + slot] = scv[r];
              LI[m * DS_CAP + slot] = (unsigned short)s;
            }
          }
        }
      }
    }
    lds_barrier();
    bool any_prune;
    {
      const int cv = (l < 32) ? cnt[l] : 0;
      unsigned pmask = (unsigned)__ballot(cv > DS_PRUNE_AT);
      any_prune = pmask != 0u;
      int j = 0;
      while (pmask != 0u) {
        const int m = __ffs((int)pmask) - 1;
        pmask &= pmask - 1u;
        if ((j & 3) == w) dsa_prune<true>(LS + m * DS_CAP, LI + m * DS_CAP, cnt[m], hist, cnt + m, thr + m, l);
        ++j;
      }
    }
    lds_barrier();
    if (any_prune) {
#pragma unroll
      for (int r = 0; r < 16; ++r) thv[r] = thr[crow(r, l)];
    }
#pragma unroll
    for (int ks = 0; ks < 4; ++ks) bk[ks] = bkn[ks];
  }
  }
#pragma unroll 1
  for (int mm = 0; mm < 8; ++mm) {
    const int m = w * 8 + mm;
    const int c = cnt[m];
    if (c > 256) dsa_prune<false>(LS + m * DS_CAP, LI + m * DS_CAP, c, hist, cnt + m, thr + m, l);
  }
  asm volatile("s_waitcnt lgkmcnt(0)" ::: "memory");
  for (int rep_att = 0; rep_att < REP_ATT; ++rep_att) {
  h8 kvr[4][8];
  {
    const int m = w * 8;
    const int c = min(cnt[m], 256);
    const unsigned short* LIm = LI + m * DS_CAP;
#pragma unroll
    for (int kk = 0; kk < 4; ++kk) {
      const int e = l + 64 * kk;
      const int s = (int)LIm[(e < c) ? e : 0];
      const half_t* kr = P + (size_t)s * PP + C_DSAK;
#pragma unroll
      for (int ch = 0; ch < 8; ++ch) kvr[kk][ch] = *(const h8*)(kr + ch * 8);
    }
  }
  h8 qreg = *(const h8*)(P + (size_t)(t0 + w * 8) * PP + C_DSAQ + l * 8);
  const int dch = l & 7, ksub = l >> 3;
#pragma unroll 1
  for (int u = 0; u < 16; ++u) {
    const int mm = u >> 1, g = u & 1;
    const int m = w * 8 + mm;
    const int t = t0 + m;
    const int c = min(cnt[m], 256);
    const unsigned short* LIm = LI + m * DS_CAP;
    if (g == 0) {
      *(h8*)(QS + l * 8) = qreg;
      const int mq = (mm < 7) ? (m + 1) : m;
      qreg = *(const h8*)(P + (size_t)(t0 + mq) * PP + C_DSAQ + l * 8);
    }
    h8 gt[4];
#pragma unroll
    for (int hh = 0; hh < 4; ++hh) gt[hh] = *(const h8*)(P + (size_t)t * PP + C_DSAG + (g * 4 + hh) * 64 + dch * 8);
    h8 vv[16];
#pragma unroll
    for (int i = 0; i < 16; ++i) {
      const int e = i * 8 + ksub;
      const int s = (int)LIm[(e < c) ? e : 0];
      vv[i] = *(const h8*)(P + (size_t)s * PP + C_DSAV + g * 64 + dch * 8);
    }
    asm volatile("" ::: "memory");
    float lg[4][4];
#pragma unroll
    for (int hh = 0; hh < 4; ++hh) {
#pragma unroll
      for (int kk = 0; kk < 4; ++kk) lg[hh][kk] = ozero();
#pragma unroll
      for (int ch = 0; ch < 8; ++ch) {
        const h8 qq = *(const h8*)(QS + (g * 4 + hh) * 64 + ch * 8);
#pragma unroll
        for (int kk = 0; kk < 4; ++kk) {
          float a = lg[hh][kk];
          a = __builtin_amdgcn_fdot2(__builtin_shufflevector(qq, qq, 0, 1), __builtin_shufflevector(kvr[kk][ch], kvr[kk][ch], 0, 1), a, false);
          a = __builtin_amdgcn_fdot2(__builtin_shufflevector(qq, qq, 2, 3), __builtin_shufflevector(kvr[kk][ch], kvr[kk][ch], 2, 3), a, false);
          a = __builtin_amdgcn_fdot2(__builtin_shufflevector(qq, qq, 4, 5), __builtin_shufflevector(kvr[kk][ch], kvr[kk][ch], 4, 5), a, false);
          a = __builtin_amdgcn_fdot2(__builtin_shufflevector(qq, qq, 6, 7), __builtin_shufflevector(kvr[kk][ch], kvr[kk][ch], 6, 7), a, false);
          lg[hh][kk] = a;
        }
      }
#pragma unroll
      for (int kk = 0; kk < 4; ++kk) lg[hh][kk] = (l + 64 * kk < c) ? lg[hh][kk] : -INFINITY;
    }
    {
      const int un = (u < 15) ? (u + 1) : 15;
      const int mn = w * 8 + (un >> 1), gn = un & 1;
      const int cn = min(cnt[mn], 256);
      const unsigned short* LIn = LI + mn * DS_CAP;
#pragma unroll
      for (int kk = 0; kk < 4; ++kk) {
        const int e = l + 64 * kk;
        const int s = (int)LIn[(e < cn) ? e : 0];
        const half_t* kr = P + (size_t)s * PP + C_DSAK + gn * 64;
#pragma unroll
        for (int ch = 0; ch < 8; ++ch) kvr[kk][ch] = *(const h8*)(kr + ch * 8);
      }
    }
#pragma unroll
    for (int hh = 0; hh < 4; ++hh) {
      float mx = fmaxf(fmaxf(lg[hh][0], lg[hh][1]), fmaxf(lg[hh][2], lg[hh][3]));
      mx = wave_max(mx);
      float ev[4]; float sm = 0.f;
#pragma unroll
      for (int kk = 0; kk < 4; ++kk) { ev[kk] = __expf(lg[hh][kk] - mx); sm += ev[kk]; }
      sm = wave_sum(sm);
      const float inv = 1.0f / sm;
#pragma unroll
      for (int kk = 0; kk < 4; ++kk) ((kk < 2) ? PWa : PWb)[(l + 64 * (kk & 1)) * 4 + hh] = ev[kk] * inv;
    }
    asm volatile("" ::: "memory");
    float o[4][8];
#pragma unroll
    for (int hh = 0; hh < 4; ++hh)
#pragma unroll
      for (int q = 0; q < 8; ++q) o[hh][q] = ozero();
    const int nit = (c + 7) >> 3;
#pragma unroll 1
    for (int it0 = 0; it0 < nit; it0 += 16) {
      if (it0 > 0) {
#pragma unroll
        for (int i = 0; i < 16; ++i) {
          const int e = (it0 + i) * 8 + ksub;
          const int s = (int)LIm[(e < c) ? e : 0];
          vv[i] = *(const h8*)(P + (size_t)s * PP + C_DSAV + g * 64 + dch * 8);
        }
      }
#pragma unroll
      for (int i = 0; i < 16; ++i) {
        const int e = (it0 + i) * 8 + ksub;
        const f4v pv = *(const f4v*)(((e < 128) ? PWa : PWb) + (e & 127) * 4);
#pragma unroll
        for (int hh = 0; hh < 4; ++hh)
#pragma unroll
          for (int q = 0; q < 8; ++q) o[hh][q] += pv[hh] * (float)vv[i][q];
      }
    }
#pragma unroll
    for (int hh = 0; hh < 4; ++hh)
#pragma unroll
      for (int q = 0; q < 8; ++q) {
        float v = o[hh][q];
        v += dppf<0x128>(v); v += xor16f(v); v += xor32f(v);
        o[hh][q] = v;
      }
    if (l < 8) {
#pragma unroll
      for (int hh = 0; hh < 4; ++hh) {
        const int col = (g * 4 + hh) * 64 + dch * 8;
        h8 ov;
#pragma unroll
        for (int q = 0; q < 8; ++q) ov[q] = (half_t)(o[hh][q] * (float)gt[hh][q]);
        *(h8*)(BR + (size_t)t * 1536 + 512 + col) = ov;
      }
    }
    asm volatile("" ::: "memory");
  }
  }
}

__device__ void phase_B(const Params& p, int layer, unsigned char* lds) {
  const int G = gridDim.x;
  for (int j = 0; j * G < 512; ++j) {
    const int b = (j & 1) ? (G - 1 - (int)blockIdx.x) : (int)blockIdx.x;
    const int idx = j * G + b;
#ifndef NO_DSA
    if (idx < 512) dsa_item(p, 511 - idx, lds);
#endif
  }
  for (int rep = 0; rep < REP_KV; ++rep)
  for (int it = blockIdx.x; it < 2048; it += G) la_item_kv(p, layer, it, lds);
}

__device__ void phase_E1(const Params& p, int layer, unsigned char* lds, int my_xcc, int my_loc, const unsigned* xcnt) {
  const int tid = otid(), w = tid >> 6, l = tid & 63;
  const half_t* BR = (const half_t*)(p.ws + OFF_BR);
  const half_t* WbrT = (const half_t*)(p.ws + OFF_WBRT) + (size_t)layer * 3 * 1024 * WBP;
  const half_t* P = (const half_t*)(p.ws + OFF_P);
  half_t* Y1 = (half_t*)(p.ws + OFF_H);
  const int wm = w >> 1, wn = w & 1;
  float* E = (float*)(lds + GEMM_EOFF) + w * (32 * EP);
  const int prow = l >> 3, c0 = (l & 7) * 8;
  const int nx = xcc_census(xcnt, my_xcc);
  const int nrounds = (nx > 0) ? (64 + nx - 1) / nx : (512 + (int)gridDim.x - 1) / (int)gridDim.x;
  for (int rnd = 0; rnd < nrounds; ++rnd) {
    int mt, nt;
    if (nx > 0) {
      const int s = my_loc + nx * rnd;
      if (s >= 64) continue;
      mt = my_xcc * 8 + (s & 7); nt = s >> 3;
    } else {
      const int tix = rnd * (int)gridDim.x + (int)blockIdx.x;
      if (tix >= 512) continue;
      mt = tix & 63; nt = tix >> 6;
    }
    h8 tot[4][4];
#pragma unroll
    for (int i = 0; i < 4; ++i)
#pragma unroll
      for (int ps = 0; ps < 4; ++ps)
#pragma unroll
        for (int q = 0; q < 8; ++q) tot[i][ps][q] = (half_t)ozero();
    const int m0w = mt * 256 + wm * 128;
    const int n0 = nt * 128 + wn * 64 + c0;
#pragma unroll 1
    for (int b = 0; b < 3; ++b) {
      f16v acc[4][2];
      zero_acc<2>(acc);
      gemm_kloop<2>(acc, BR + (size_t)mt * 256 * 1536 + b * 512, 1536, WbrT + (size_t)b * 1024 * WBP + (size_t)nt * 128 * WBP, WBP, 512, lds);
#pragma unroll
      for (int i = 0; i < 4; ++i) {
        stage_pair(E, acc[i][0], acc[i][1], l);
#pragma unroll
        for (int ps = 0; ps < 4; ++ps) {
          const int rl = ps * 8 + prow;
          const int row = m0w + i * 32 + rl;
          const h8 g = *(const h8*)(P + (size_t)row * PP + C_MRG + b * 1024 + n0);
          float ev[8];
          ld8(E + rl * EP + c0, ev);
#pragma unroll
          for (int q = 0; q < 8; ++q) tot[i][ps][q] = (half_t)((float)tot[i][ps][q] + (float)g[q] * ev[q]);
        }
      }
    }
#pragma unroll
    for (int i = 0; i < 4; ++i)
#pragma unroll
      for (int ps = 0; ps < 4; ++ps) {
        const int row = m0w + i * 32 + ps * 8 + prow;
        *(h8*)(Y1 + (size_t)row * HP + n0) = tot[i][ps];
      }
  }
}

__device__ void phase_E2(const Params& p, int layer, unsigned char* lds, int my_xcc, int my_loc, const unsigned* xcnt) {
  const int tid = otid(), w = tid >> 6, l = tid & 63;
  const half_t* Y1 = (const half_t*)(p.ws + OFF_H);
  const half_t* Wo = (const half_t*)(p.ws + OFF_WOUTT) + (size_t)layer * 1024 * WP;
  float* Y = (float*)(p.ws + OFF_ST);
  const int wm = w >> 1, wn = w & 1;
  const int nx = xcc_census(xcnt, my_xcc);
  const int nrounds = (nx > 0) ? (64 + nx - 1) / nx : (512 + (int)gridDim.x - 1) / (int)gridDim.x;
  for (int rnd = 0; rnd < nrounds; ++rnd) {
    int mt, nt;
    if (nx > 0) {
      const int s = my_loc + nx * rnd;
      if (s >= 64) continue;
      mt = my_xcc * 8 + (s & 7); nt = s >> 3;
    } else {
      const int tix = rnd * (int)gridDim.x + (int)blockIdx.x;
      if (tix >= 512) continue;
      mt = tix & 63; nt = tix >> 6;
    }
    f16v acc[4][2];
    zero_acc<2>(acc);
    gemm_kloop<2>(acc, Y1 + (size_t)mt * 256 * HP, HP, Wo + (size_t)nt * 128 * WP, WP, 1024, lds);
    const int m0w = mt * 256 + wm * 128;
    const int n0w = nt * 128 + wn * 64;
#pragma unroll
    for (int i = 0; i < 4; ++i)
#pragma unroll
      for (int j = 0; j < 2; ++j)
#pragma unroll
        for (int r = 0; r < 16; ++r) {
          const int row = m0w + i * 32 + crow(r, l);
          const int n = n0w + j * 32 + (l & 31);
          Y[(size_t)row * 1024 + n] = acc[i][j][r];
        }
  }
}

__device__ void phase_E3(const Params& p, int layer) {
  const int w = otid() >> 6, l = otid() & 63;
  const float* Y = (const float*)(p.ws + OFF_ST);
  const float* MOD = (const float*)(p.ws + OFF_MOD);
  half_t* H = (half_t*)(p.ws + OFF_H);
  const float* xin = (layer == 0) ? p.x : p.out;
  const float* gate = MOD + layer * 3072 + 2048;
  const float* post = p.post_norm + layer * 1024;
  const int stride = gridDim.x * 4;
  int row = blockIdx.x * 4 + w;
  f4v yn[4], xn[4];
  if (row < S_LEN) {
#pragma unroll
    for (int i = 0; i < 4; ++i) {
      yn[i] = *(const f4v*)(Y + (size_t)row * 1024 + i * 256 + l * 4);
      xn[i] = *(const f4v*)(xin + (size_t)row * 1024 + i * 256 + l * 4);
    }
  }
  for (; row < S_LEN; row += stride) {
    float yv[16], xv[16];
    float ss = 0.f;
#pragma unroll
    for (int i = 0; i < 4; ++i)
#pragma unroll
      for (int q = 0; q < 4; ++q) { yv[i * 4 + q] = yn[i][q]; xv[i * 4 + q] = xn[i][q]; ss += yn[i][q] * yn[i][q]; }
    const int nrow = (row + stride < S_LEN) ? (row + stride) : row;
#pragma unroll
    for (int i = 0; i < 4; ++i) {
      yn[i] = *(const f4v*)(Y + (size_t)nrow * 1024 + i * 256 + l * 4);
      xn[i] = *(const f4v*)(xin + (size_t)nrow * 1024 + i * 256 + l * 4);
    }
    ss = wave_sum(ss);
    const float rs = rsqrtf(ss * (1.0f / 1024.0f) + 1e-6f);
#pragma unroll
    for (int i = 0; i < 4; ++i) {
      const int c0 = i * 256 + l * 4;
      f4v gt = *(const f4v*)(gate + c0);
      f4v pn = *(const f4v*)(post + c0);
      f4v o;
#pragma unroll
      for (int q = 0; q < 4; ++q) { o[q] = xv[i * 4 + q] + gt[q] * (yv[i * 4 + q] * rs * pn[q]); xv[i * 4 + q] = o[q]; }
      *(f4v*)(p.out + (size_t)row * 1024 + c0) = o;
    }
    if (layer + 1 < DEPTH)
      write_h_row(xv, p.pre_norm + (layer + 1) * 1024, MOD + (layer + 1) * 3072, H + (size_t)row * HP, l);
  }
}

#define XB_TMO      128
#define XB_XCNT(j)  (256  + 64 * (j))
#define XB_XSUB(j)  (1280 + 64 * (j))
#define XB_XGEN(j)  (2304 + 64 * (j))
#define XB_TOP      3328
#define XB_TOPGEN   3392
#define XCD_BAR_WORDS 3456
#define XB_SPIN_CAP (1u << 18)
#define LAS __attribute__((address_space(3)))

__device__ __forceinline__ unsigned xb_ld(unsigned* p)              { return __hip_atomic_load(p, __ATOMIC_RELAXED, __HIP_MEMORY_SCOPE_AGENT); }
__device__ __forceinline__ unsigned xb_add(unsigned* p, unsigned v) { return __hip_atomic_fetch_add(p, v, __ATOMIC_RELAXED, __HIP_MEMORY_SCOPE_AGENT); }
__device__ __forceinline__ unsigned xb_xcc_id() { return (unsigned)__builtin_amdgcn_s_getreg((3 << 11) | 20) & 0xFu; }
#define XB_SPIN(cond, bar) do { unsigned _sp = 0; while (cond) { __builtin_amdgcn_s_sleep(1); \
    if ((++_sp & 255u) == 0u) { if (xb_ld(&(bar)[XB_TMO])) break; if (_sp > XB_SPIN_CAP) { atomicAdd(&(bar)[XB_TMO], 1u); break; } } } } while (0)

struct XcdBarrier {
    unsigned* bar; unsigned x;
    volatile LAS unsigned* st;
};

__device__ __forceinline__ XcdBarrier xcd_barrier_post(unsigned* bar, volatile LAS unsigned* st) {
    XcdBarrier b; b.bar = bar; b.x = xb_xcc_id(); b.st = st;
    if (otid() == 0) (void)xb_add(&bar[XB_XCNT(b.x)], 1u);
    return b;
}
__device__ __forceinline__ void xcd_barrier_complete(unsigned* bar, unsigned x, unsigned& nloc, unsigned& nx) {
    const unsigned G = gridDim.x * gridDim.y * gridDim.z;
    unsigned sum, cnt, mine, sp = 0u;
    for (;;) {
        sum = 0u; cnt = 0u; mine = 0u;
#pragma unroll
        for (unsigned j = 0; j < 16; ++j) { const unsigned c = xb_ld(&bar[XB_XCNT(j)]); sum += c; cnt += (c > 0u) ? 1u : 0u; mine = (j == x) ? c : mine; }
        if (sum == G) break;
        __builtin_amdgcn_s_sleep(1);
        if ((++sp & 255u) == 0u) { if (xb_ld(&bar[XB_TMO])) break; if (sp > XB_SPIN_CAP) { atomicAdd(&bar[XB_TMO], 1u); break; } }
    }
    nloc = mine > 0u ? mine : 1u; nx = cnt > 0u ? cnt : 1u;
}

__device__ __forceinline__ void xcd_barrier(const XcdBarrier& b) {
    asm volatile("s_waitcnt vmcnt(0)" ::: "memory");
    __syncthreads();
    if (otid() == 0) {
        unsigned* bar = b.bar;
        __builtin_amdgcn_s_waitcnt(0);
        unsigned nloc = b.st[0], nx = b.st[1];
        if (nloc == 0u) { xcd_barrier_complete(bar, b.x, nloc, nx); b.st[0] = nloc; b.st[1] = nx; }
        const unsigned old = xb_add(&bar[XB_XSUB(b.x)], 1u);
        const unsigned gen = old / nloc;
        if (old + 1u == (gen + 1u) * nloc) {
            __builtin_amdgcn_fence(__ATOMIC_RELEASE, "agent");
            asm volatile("s_waitcnt vmcnt(0)" ::: "memory");
            const unsigned og = xb_add(&bar[XB_TOP], 1u);
            const unsigned tg = og / nx;
            if (og + 1u == (tg + 1u) * nx) xb_add(&bar[XB_TOPGEN], 1u);
            else XB_SPIN(xb_ld(&bar[XB_TOPGEN]) == tg, bar);
            __builtin_amdgcn_fence(__ATOMIC_ACQUIRE, "agent");
            xb_add(&bar[XB_XGEN(b.x)], 1u);
            asm volatile("s_waitcnt vmcnt(0)" ::: "memory");
        } else {
            XB_SPIN(xb_ld(&bar[XB_XGEN(b.x)]) == gen, bar);
            __builtin_amdgcn_fence(__ATOMIC_ACQUIRE, "agent");
            asm volatile("s_waitcnt vmcnt(0)" ::: "memory");
        }
    }
    __syncthreads();
}


};

#ifndef REP_D
#define REP_D 1
#endif
#ifndef REP_E
#define REP_E 1
#endif
#ifndef REP_A
#define REP_A 1
#endif
#ifndef REP_B
#define REP_B 1
#endif
#ifdef ONLY_PHASE
#define PH_EN(x) (ONLY_PHASE == (x))
#else
#define PH_EN(x) true
#endif
__global__ void __launch_bounds__(NTHREADS) fwd_megakernel(Params p) {
  extern __shared__ __attribute__((aligned(16))) unsigned char lds[];
  cg::grid_group grid = cg::this_grid();
  K k; k.wbase = __builtin_amdgcn_readfirstlane((int)__builtin_amdgcn_workitem_id_x()) & ~63;
  unsigned* bar = (unsigned*)(p.ws + WS_END);
  unsigned* xcnt = bar + 16;
  unsigned* xbar = (unsigned*)(p.ws + WS_END + 1024);
  if (blockIdx.x == 0) {
    if (k.otid() < 17) __hip_atomic_store(bar + (k.otid() == 16 ? 0 : 16 + k.otid()), 0u, __ATOMIC_RELAXED, __HIP_MEMORY_SCOPE_AGENT);
    for (int i = k.otid(); i < XCD_BAR_WORDS; i += NTHREADS) __hip_atomic_store(xbar + i, 0u, __ATOMIC_RELAXED, __HIP_MEMORY_SCOPE_AGENT);
  }
  volatile LAS unsigned* xst = (volatile LAS unsigned*)(lds + LDS_BYTES - 16);
  if (k.otid() == 0) { xst[0] = 0u; xst[1] = 0u; }
  __syncthreads();
  K::XcdBarrier xb; xb.bar = xbar; xb.x = 0; xb.st = xst;
  int my_xcc = 0, my_loc = 0;
  for (int ph = p.ph_lo; ph < p.ph_hi; ++ph) {
    if (ph == 0) { if (PH_EN(0)) for (int rep = 0; rep < REP_P; ++rep) { k.phase_prologue(p, lds); __syncthreads(); } }
    else if (ph == 1) {
      xb = k.xcd_barrier_post(xbar, xst);
      int* sh = (int*)lds;
      if (k.otid() == 0) {
        const int xc = (int)(__builtin_amdgcn_s_getreg((3 << 11) | 20) & 0xFu);
        sh[0] = xc;
        sh[1] = (int)__hip_atomic_fetch_add(xcnt + xc, 1u, __ATOMIC_RELAXED, __HIP_MEMORY_SCOPE_AGENT);
      }
      __syncthreads();
      my_xcc = __builtin_amdgcn_readfirstlane(sh[0]);
      my_loc = __builtin_amdgcn_readfirstlane(sh[1]);
      __syncthreads();
      if (PH_EN(1)) k.phase_h0(p);
    }
    else {
      const int layer = (ph - 2) / 7, sub = (ph - 2) % 7;
      if (sub == 0) { if (PH_EN(2)) for (int rep = 0; rep < REP_A; ++rep) { k.phase_A(p, layer, lds, my_xcc, my_loc, xcnt); __syncthreads(); } }
      else if (sub == 1) { if (PH_EN(3)) for (int rep = 0; rep < REP_B; ++rep) { k.phase_B(p, layer, lds); __syncthreads(); } }
      else if (sub == 2) { if (PH_EN(4)) k.phase_scan(p); }
      else if (sub == 3) { if (PH_EN(5)) for (int rep = 0; rep < REP_D; ++rep) { for (int it = blockIdx.x; it < 2048; it += gridDim.x) k.la_item_out(p, layer, it, lds); __syncthreads(); } }
      else if (sub == 4) { if (PH_EN(6)) for (int rep = 0; rep < REP_E; ++rep) { k.phase_E1(p, layer, lds, my_xcc, my_loc, xcnt); __syncthreads(); } }
      else if (sub == 5) { if (PH_EN(7)) for (int rep = 0; rep < REP_E; ++rep) { k.phase_E2(p, layer, lds, my_xcc, my_loc, xcnt); __syncthreads(); } }
      else { if (PH_EN(8)) k.phase_E3(p, layer); }
    }
    if (ph + 1 < p.ph_hi) {
      if (ph == p.ph_lo) grid.sync();
      else k.xcd_barrier(xb);
    }
  }
}

extern "C" void kernel_launch(void* const* d_in, const int* in_sizes, int n_in, void* d_out, int out_size,
                              void* d_ws, size_t ws_size, hipStream_t stream) {
  static int grid_blocks = 0;
  if (!grid_blocks) {
    int dev = 0, cus = 0, per_cu = 0;
    hipGetDevice(&dev);
    hipDeviceGetAttribute(&cus, hipDeviceAttributeMultiprocessorCount, dev);
    hipFuncSetAttribute((const void*)fwd_megakernel, hipFuncAttributeMaxDynamicSharedMemorySize, LDS_BYTES);
    hipOccupancyMaxActiveBlocksPerMultiprocessor(&per_cu, (const void*)fwd_megakernel, NTHREADS, LDS_BYTES);
    if (per_cu < 1) per_cu = 1;
    if (per_cu > 1) per_cu = 1;
    grid_blocks = cus * per_cu;
    if (ws_size < WS_END) fprintf(stderr, "workspace too small: %zu < %llu\n", ws_size, (unsigned long long)WS_END);
  }
  Params p{};
  p.x = (const float*)d_in[0]; p.c = (const float*)d_in[1]; p.pos = (const int*)d_in[2];
  p.ada_w = (const float*)d_in[3]; p.ada_b = (const float*)d_in[4];
  p.pre_norm = (const float*)d_in[5]; p.post_norm = (const float*)d_in[6];
  p.w_in = (const float*)d_in[7]; p.gla_w_lr = (const float*)d_in[8]; p.gla_b_lr = (const float*)d_in[9];
  p.w_br_ret = (const float*)d_in[10]; p.w_br_dsa = (const float*)d_in[11]; p.w_br_gla = (const float*)d_in[12];
  p.w_out = (const float*)d_in[13];
  p.out = (float*)d_out; p.ws = (unsigned char*)d_ws;
  p.ph_lo = 0; p.ph_hi = 2 + 7 * DEPTH;
  void* args[] = {&p};
  hipError_t e = hipLaunchCooperativeKernel((const void*)fwd_megakernel, dim3(grid_blocks), dim3(NTHREADS), args, LDS_BYTES, stream);
  if (e != hipSuccess) fprintf(stderr, "cooperative launch failed: %s (grid %d)\n", hipGetErrorString(e), grid_blocks);
}
```

```cpp
#include <hip/hip_runtime.h>
#include <hip/hip_cooperative_groups.h>
#include <stdint.h>
#include <cstdio>
namespace cg = cooperative_groups;
#ifndef REP_P
#define REP_P 1
#endif
#ifndef REP_KV
#define REP_KV 1
#endif
#ifndef REP_SEL
#define REP_SEL 1
#endif
#ifndef REP_ATT
#define REP_ATT 1
#endif

typedef _Float16 half_t;
typedef _Float16 h8 __attribute__((ext_vector_type(8)));
typedef _Float16 h4 __attribute__((ext_vector_type(4)));
typedef _Float16 h2 __attribute__((ext_vector_type(2)));
typedef float f16v __attribute__((ext_vector_type(16)));
typedef float f4v __attribute__((ext_vector_type(4)));

#define S_LEN 16384
#define DM 1024
#define NIN 7764
#define NPAD 7936
#define PP 7808
#define DEPTH 4
#define NTHREADS 256
#define HP 1088
#define WP 1088
#define WBP 576
#define LDS_BYTES 152704

#define C_RETQ 0
#define C_RETK 256
#define C_RETV 512
#define C_RETG 1024
#define C_DSAQ 1536
#define C_DSAK 2048
#define C_DSAV 2176
#define C_DSAG 2304
#define C_IDXQ 2816
#define C_IDXK 3072
#define C_GLAQ 3136
#define C_GLAK 3392
#define C_GLAV 3648
#define C_GLAG 4160
#define C_GLAA 4672
#define C_MRG 4688
#define C_END 7760
#define C_IDXW 7760

#define OFF_WINT 0ull
#define OFF_WBRT (OFF_WINT + 4ull * NPAD * WP * 2)
#define OFF_WOUTT (OFF_WBRT + 4ull * 3 * 1024 * WBP * 2)
#define OFF_MOD (OFF_WOUTT + 4ull * 1024 * WP * 2)
#define OFF_RT (OFF_MOD + 4ull * 3072 * 4)
#define OFF_DT (OFF_RT + 16384ull * 64 * 4)
#define OFF_H (OFF_DT + 16384ull * 16 * 4)
#define OFF_P (OFF_H + 16384ull * HP * 2)
#define OFF_GA (OFF_P + 16384ull * PP * 2)
#define OFF_IW (OFF_GA + 16384ull * 16 * 4)
#define OFF_ST (OFF_IW + 16384ull * 4 * 4)
#define OFF_DEC (OFF_ST + 256ull * 65536 * 4)
#define OFF_BR (OFF_DEC + 256ull * 8 * 64 * 4)
#define WS_END (OFF_BR + 16384ull * 1536 * 2)
static_assert(WS_END + 16384 <= 508821504ull, "workspace too large");

struct Params {
  const float* x; const float* c; const int* pos; const float* ada_w; const float* ada_b;
  const float* pre_norm; const float* post_norm; const float* w_in; const float* gla_w_lr;
  const float* gla_b_lr; const float* w_br_ret; const float* w_br_dsa; const float* w_br_gla;
  const float* w_out; float* out; unsigned char* ws;
  int ph_lo; int ph_hi;
};

struct K {
int wbase;
__device__ __forceinline__ int otid() const {
  int lane;
  asm volatile("v_mbcnt_lo_u32_b32 %0, -1, 0\n\tv_mbcnt_hi_u32_b32 %0, -1, %0" : "=v"(lane));
  return wbase | lane;
}
__device__ __forceinline__ static float ozero() { float z = 0.f; asm volatile("" : "+v"(z)); return z; }
template <int CTRL>
__device__ __forceinline__ float dppf(float v) {
  return __int_as_float(__builtin_amdgcn_update_dpp(0, __float_as_int(v), CTRL, 0xF, 0xF, true));
}
template <int CTRL>
__device__ __forceinline__ unsigned dppu(unsigned v) {
  return (unsigned)__builtin_amdgcn_update_dpp(0, (int)v, CTRL, 0xF, 0xF, true);
}
__device__ __forceinline__ int olane() { return otid() & 63; }
__device__ __forceinline__ float xor16f(float v) { return __int_as_float(__builtin_amdgcn_ds_bpermute((olane() ^ 16) << 2, __float_as_int(v))); }
__device__ __forceinline__ float xor32f(float v) { return __int_as_float(__builtin_amdgcn_ds_bpermute((olane() ^ 32) << 2, __float_as_int(v))); }
__device__ __forceinline__ unsigned xor16u(unsigned v) { return (unsigned)__builtin_amdgcn_ds_bpermute((olane() ^ 16) << 2, (int)v); }
__device__ __forceinline__ unsigned xor32u(unsigned v) { return (unsigned)__builtin_amdgcn_ds_bpermute((olane() ^ 32) << 2, (int)v); }
__device__ __forceinline__ float rl_f(float v, int lane) { return __int_as_float(__builtin_amdgcn_readlane(__float_as_int(v), lane)); }
__device__ __forceinline__ float wave_sum(float v) {
  v += dppf<0xB1>(v); v += dppf<0x4E>(v); v += dppf<0x141>(v); v += dppf<0x140>(v);
  return (rl_f(v, 0) + rl_f(v, 16)) + (rl_f(v, 32) + rl_f(v, 48));
}
__device__ __forceinline__ float wave_max(float v) {
  v = fmaxf(v, dppf<0xB1>(v)); v = fmaxf(v, dppf<0x4E>(v)); v = fmaxf(v, dppf<0x141>(v)); v = fmaxf(v, dppf<0x140>(v));
  return fmaxf(fmaxf(rl_f(v, 0), rl_f(v, 16)), fmaxf(rl_f(v, 32), rl_f(v, 48)));
}
__device__ __forceinline__ unsigned wave_or(unsigned v) {
  v |= dppu<0xB1>(v); v |= dppu<0x4E>(v); v |= dppu<0x141>(v); v |= dppu<0x140>(v);
  return (unsigned)(__builtin_amdgcn_readlane((int)v, 0) | __builtin_amdgcn_readlane((int)v, 16) | __builtin_amdgcn_readlane((int)v, 32) | __builtin_amdgcn_readlane((int)v, 48));
}
__device__ __forceinline__ unsigned wave_incl_scan(unsigned v) {
  v += (unsigned)__builtin_amdgcn_update_dpp(0, (int)v, 0x111, 0xF, 0xF, false);
  v += (unsigned)__builtin_amdgcn_update_dpp(0, (int)v, 0x112, 0xF, 0xF, false);
  v += (unsigned)__builtin_amdgcn_update_dpp(0, (int)v, 0x114, 0xF, 0xF, false);
  v += (unsigned)__builtin_amdgcn_update_dpp(0, (int)v, 0x118, 0xF, 0xF, false);
  v += (unsigned)__builtin_amdgcn_update_dpp(0, (int)v, 0x142, 0xA, 0xF, false);
  v += (unsigned)__builtin_amdgcn_update_dpp(0, (int)v, 0x143, 0xC, 0xF, false);
  return v;
}
__device__ __forceinline__ f16v mfma16(h8 a, h8 b, f16v c) {
  return __builtin_amdgcn_mfma_f32_32x32x16_f16(a, b, c, 0, 0, 0);
}
__device__ __forceinline__ float relu_f(float x) { return __int_as_float(max(__float_as_int(x), 0)); }
__device__ __forceinline__ int crow(int r, int l) { return (r & 3) + 8 * (r >> 2) + 4 * (l >> 5); }

__device__ __forceinline__ int win_col(int nv) {
  if (nv < 3136) return nv;
  if (nv < 7760) return nv + 4;
  if (nv < 7764) return nv - 7760 + 3136;
  return -1;
}
__device__ void transpose_tile(const float* __restrict__ src, int ldn, half_t* __restrict__ dst, int K,
                               int k0, int n0, int mapmode, unsigned char* lds) {
  float* T = (float*)lds;
  const int tid = otid();
  const int nn = tid & 63;
  int col = n0 + nn;
  if (mapmode) col = win_col(col);
#pragma unroll
  for (int i = 0; i < 16; ++i) {
    int kk = (tid >> 6) + 4 * i;
    float v = 0.f;
    if (col >= 0) v = src[(size_t)(k0 + kk) * ldn + col];
    T[kk * 65 + nn] = v;
  }
  __syncthreads();
#pragma unroll
  for (int i = 0; i < 2; ++i) {
    int n2 = (tid >> 3) + 32 * i;
    int kc = tid & 7;
    h8 o;
#pragma unroll
    for (int q = 0; q < 8; ++q) o[q] = (half_t)T[(kc * 8 + q) * 65 + n2];
    *(h8*)(dst + (size_t)(n0 + n2) * K + k0 + kc * 8) = o;
  }
  __syncthreads();
}

__device__ void phase_prologue(const Params& p, unsigned char* lds) {
  const int tid = otid();
  half_t* WinT = (half_t*)(p.ws + OFF_WINT);
  half_t* WbrT = (half_t*)(p.ws + OFF_WBRT);
  half_t* WoutT = (half_t*)(p.ws + OFF_WOUTT);
  float* MOD = (float*)(p.ws + OFF_MOD);
  float* RT = (float*)(p.ws + OFF_RT);
  float* DT = (float*)(p.ws + OFF_DT);
  const int T_WIN = 4 * 124 * 16;
  const int T_WBR = 12 * 16 * 8;
  const int T_WOUT = 4 * 16 * 16;
  const int T_MOD = 192;
  const int T_ROPE = 16384 * 40 / 256;
  const int total = T_WIN + T_WBR + T_WOUT + T_MOD + T_ROPE;
  {
    float* T = (float*)lds;
    const int nn = tid & 63;
    float cur[16], nxt[16];
    int task = blockIdx.x;
    if (task < T_WIN) {
      const int l = task / (124 * 16), r = task % (124 * 16), nt = r / 16, kt = r % 16;
      const int col = win_col(nt * 64 + nn);
      const float* src = p.w_in + (size_t)l * 1024 * NIN;
#pragma unroll
      for (int i = 0; i < 16; ++i) { const int kk = (tid >> 6) + 4 * i; cur[i] = (col >= 0) ? src[(size_t)(kt * 64 + kk) * NIN + col] : 0.f; }
    }
    for (; task < T_WIN; task += gridDim.x) {
      const int tn = (task + (int)gridDim.x < T_WIN) ? task + (int)gridDim.x : task;
      {
        const int l = tn / (124 * 16), r = tn % (124 * 16), nt = r / 16, kt = r % 16;
        const int col = win_col(nt * 64 + nn);
        const float* src = p.w_in + (size_t)l * 1024 * NIN;
#pragma unroll
        for (int i = 0; i < 16; ++i) { const int kk = (tid >> 6) + 4 * i; nxt[i] = (col >= 0) ? src[(size_t)(kt * 64 + kk) * NIN + col] : 0.f; }
      }
      const int l = task / (124 * 16), r = task % (124 * 16), nt = r / 16, kt = r % 16;
      half_t* dst = WinT + (size_t)l * NPAD * WP;
#pragma unroll
      for (int i = 0; i < 16; ++i) T[((tid >> 6) + 4 * i) * 65 + nn] = cur[i];
      __syncthreads();
#pragma unroll
      for (int i = 0; i < 2; ++i) {
        const int n2 = (tid >> 3) + 32 * i, kc = tid & 7;
        h8 o;
#pragma unroll
        for (int q = 0; q < 8; ++q) o[q] = (half_t)T[(kc * 8 + q) * 65 + n2];
        *(h8*)(dst + (size_t)(nt * 64 + n2) * WP + kt * 64 + kc * 8) = o;
      }
      __syncthreads();
#pragma unroll
      for (int i = 0; i < 16; ++i) cur[i] = nxt[i];
    }
  }
  for (int task = blockIdx.x; task < total; task += gridDim.x) {
    int t = task;
    if (t < T_WIN) continue;
    if (t < T_WIN) {
      int l = t / (124 * 16); int r = t % (124 * 16); int nt = r / 16, kt = r % 16;
      transpose_tile(p.w_in + (size_t)l * 1024 * NIN, NIN, WinT + (size_t)l * NPAD * WP, WP, kt * 64, nt * 64, 1, lds);
      continue;
    }
    t -= T_WIN;
    if (t < T_WBR) {
      int lb = t / 128; int r = t % 128; int nt = r / 8, kt = r % 8;
      int l = lb / 3, b = lb % 3;
      const float* src = (b == 0 ? p.w_br_ret : (b == 1 ? p.w_br_dsa : p.w_br_gla)) + (size_t)l * 512 * 1024;
      transpose_tile(src, 1024, WbrT + (size_t)lb * 1024 * WBP, WBP, kt * 64, nt * 64, 0, lds);
      continue;
    }
    t -= T_WBR;
    if (t < T_WOUT) {
      int l = t / 256; int r = t % 256; int nt = r / 16, kt = r % 16;
      transpose_tile(p.w_out + (size_t)l * 1024 * 1024, 1024, WoutT + (size_t)l * 1024 * WP, WP, kt * 64, nt * 64, 0, lds);
      continue;
    }
    t -= T_WOUT;
    if (t < T_MOD) {
      int l = t / 48, jb = t % 48;
      int j = jb * 64 + (tid & 63);
      int ig = tid >> 6;
      float acc = 0.f;
      const float* aw = p.ada_w + (size_t)l * 1024 * 3072;
      for (int i = ig * 256; i < ig * 256 + 256; ++i) {
        float cv = p.c[i];
        float sc = cv / (1.f + expf(-cv));
        acc += sc * aw[(size_t)i * 3072 + j];
      }
      float* red = (float*)lds;
      red[tid] = acc;
      __syncthreads();
      if (tid < 64) {
        float s = red[tid] + red[tid + 64] + red[tid + 128] + red[tid + 192];
        MOD[l * 3072 + j] = s + p.ada_b[l * 3072 + j];
      }
      __syncthreads();
      continue;
    }
    t -= T_MOD;
    {
      int e = t * 256 + tid;
      int tok = e / 40, f = e % 40;
      float pf = (float)p.pos[tok];
      if (f < 32) {
        float fr = powf(10000.0f, -(float)f * 2.0f / 64.0f);
        float ang = pf * fr;
        RT[tok * 64 + f * 2] = cosf(ang);
        RT[tok * 64 + f * 2 + 1] = sinf(ang);
      } else {
        int g = f - 32;
        float fr = powf(500000.0f, -(float)g * 2.0f / 16.0f);
        float ang = pf * fr;
        DT[tok * 16 + g * 2] = cosf(ang);
        DT[tok * 16 + g * 2 + 1] = sinf(ang);
      }
    }
  }
}

__device__ __forceinline__ void write_h_row(const float (&xv)[16], const float* __restrict__ pre,
                                            const float* __restrict__ mod, half_t* __restrict__ hrow, int l) {
  float ss = 0.f;
#pragma unroll
  for (int i = 0; i < 16; ++i) ss += xv[i] * xv[i];
  ss = wave_sum(ss);
  float rs = rsqrtf(ss * (1.0f / 1024.0f) + 1e-6f);
#pragma unroll
  for (int i = 0; i < 4; ++i) {
    int c0 = i * 256 + l * 4;
    f4v pg = *(const f4v*)(pre + c0);
    f4v sh = *(const f4v*)(mod + c0);
    f4v sc = *(const f4v*)(mod + 1024 + c0);
    h4 o;
#pragma unroll
    for (int q = 0; q < 4; ++q) o[q] = (half_t)(xv[i * 4 + q] * rs * pg[q] * (1.f + sc[q]) + sh[q]);
    *(h4*)(hrow + c0) = o;
  }
}

__device__ void phase_h0(const Params& p) {
  const int w = otid() >> 6, l = otid() & 63;
  half_t* H = (half_t*)(p.ws + OFF_H);
  const float* MOD = (const float*)(p.ws + OFF_MOD);
  for (int row = blockIdx.x * 4 + w; row < S_LEN; row += gridDim.x * 4) {
    float xv[16];
#pragma unroll
    for (int i = 0; i < 4; ++i) {
      f4v v = *(const f4v*)(p.x + (size_t)row * 1024 + i * 256 + l * 4);
      xv[i * 4] = v[0]; xv[i * 4 + 1] = v[1]; xv[i * 4 + 2] = v[2]; xv[i * 4 + 3] = v[3];
    }
    write_h_row(xv, p.pre_norm, MOD, H + (size_t)row * HP, l);
  }
}

__device__ __forceinline__ void lds_barrier() {
  asm volatile("s_waitcnt lgkmcnt(0)" ::: "memory");
  __builtin_amdgcn_s_barrier();
  asm volatile("" ::: "memory");
}
#define GEMM_BUF 55296
#define GEMM_EOFF 110592
template <int NT>
__device__ __forceinline__ void gemm_step(f16v (&acc)[4][NT], h8 (&ra)[8], h8 (&rb)[2 * NT],
                                          const unsigned char* As, const unsigned char* Bs, unsigned char* Aw, unsigned char* Bw,
                                          const half_t* __restrict__ A, int lda, const half_t* __restrict__ B, int ldb, int kload,
                                          int wm, int wn, int l, int r0, int kc) {
  h8 af[2][4], bf[2][NT];
#pragma unroll
  for (int i = 0; i < 4; ++i) af[0][i] = *(const h8*)(As + (wm * 128 + i * 32 + (l & 31)) * 144 + (l >> 5) * 16);
#pragma unroll
  for (int j = 0; j < NT; ++j) bf[0][j] = *(const h8*)(Bs + (wn * 32 * NT + j * 32 + (l & 31)) * 144 + (l >> 5) * 16);
#pragma unroll
  for (int ks = 0; ks < 4; ++ks) {
    if (ks < 3) {
#pragma unroll
      for (int i = 0; i < 4; ++i) af[(ks + 1) & 1][i] = *(const h8*)(As + (wm * 128 + i * 32 + (l & 31)) * 144 + (ks + 1) * 32 + (l >> 5) * 16);
#pragma unroll
      for (int j = 0; j < NT; ++j) bf[(ks + 1) & 1][j] = *(const h8*)(Bs + (wn * 32 * NT + j * 32 + (l & 31)) * 144 + (ks + 1) * 32 + (l >> 5) * 16);
    }
    __builtin_amdgcn_sched_barrier(0);
#pragma unroll
    for (int i = 0; i < 4; ++i)
#pragma unroll
      for (int j = 0; j < NT; ++j) acc[i][j] = mfma16(af[ks & 1][i], bf[ks & 1][j], acc[i][j]);
#pragma unroll
    for (int i = 2 * ks; i < 2 * ks + 2; ++i) {
      *(h8*)(Aw + (r0 + 32 * i) * 144 + kc * 16) = ra[i];
      ra[i] = *(const h8*)(A + (size_t)(r0 + 32 * i) * lda + kload + kc * 8);
    }
    if (NT == 2) {
      *(h8*)(Bw + (r0 + 32 * ks) * 144 + kc * 16) = rb[ks];
      rb[ks] = *(const h8*)(B + (size_t)(r0 + 32 * ks) * ldb + kload + kc * 8);
    } else {
#pragma unroll
      for (int i = 2 * ks; i < 2 * ks + 2; ++i) {
        *(h8*)(Bw + (r0 + 32 * i) * 144 + kc * 16) = rb[i];
        rb[i] = *(const h8*)(B + (size_t)(r0 + 32 * i) * ldb + kload + kc * 8);
      }
    }
    __builtin_amdgcn_sched_barrier(0);
  }
}
template <int NT>
__device__ __forceinline__ void gemm_issue(h8 (&ra0)[8], h8 (&rb0)[2 * NT], h8 (&ra1)[8], h8 (&rb1)[2 * NT],
                                           const half_t* __restrict__ A, int lda, const half_t* __restrict__ B, int ldb) {
  const int tid = otid();
  const int kc = tid & 7, r0 = tid >> 3;
#pragma unroll
  for (int i = 0; i < 8; ++i) ra0[i] = *(const h8*)(A + (size_t)(r0 + 32 * i) * lda + kc * 8);
#pragma unroll
  for (int i = 0; i < 2 * NT; ++i) rb0[i] = *(const h8*)(B + (size_t)(r0 + 32 * i) * ldb + kc * 8);
#pragma unroll
  for (int i = 0; i < 8; ++i) ra1[i] = *(const h8*)(A + (size_t)(r0 + 32 * i) * lda + 64 + kc * 8);
#pragma unroll
  for (int i = 0; i < 2 * NT; ++i) rb1[i] = *(const h8*)(B + (size_t)(r0 + 32 * i) * ldb + 64 + kc * 8);
}
template <int NT>
__device__ __forceinline__ void gemm_run(f16v (&acc)[4][NT], h8 (&ra0)[8], h8 (&rb0)[2 * NT], h8 (&ra1)[8], h8 (&rb1)[2 * NT],
                                         const half_t* __restrict__ A, int lda, const half_t* __restrict__ B, int ldb, int K, unsigned char* lds) {
  const int tid = otid(), w = tid >> 6, l = tid & 63;
  constexpr int STAGE = 256 * 144 + 64 * NT * 144;
  unsigned char* A0 = lds;
  unsigned char* B0 = lds + 256 * 144;
  unsigned char* A1 = lds + STAGE;
  unsigned char* B1 = lds + STAGE + 256 * 144;
  const int wm = w >> 1, wn = w & 1;
  const int kc = tid & 7;
  const int r0 = tid >> 3;
  lds_barrier();
#pragma unroll
  for (int i = 0; i < 8; ++i) { *(h8*)(A0 + (r0 + 32 * i) * 144 + kc * 16) = ra0[i]; ra0[i] = *(const h8*)(A + (size_t)(r0 + 32 * i) * lda + 128 + kc * 8); }
#pragma unroll
  for (int i = 0; i < 2 * NT; ++i) { *(h8*)(B0 + (r0 + 32 * i) * 144 + kc * 16) = rb0[i]; rb0[i] = *(const h8*)(B + (size_t)(r0 + 32 * i) * ldb + 128 + kc * 8); }
  lds_barrier();
  const int nk = K / 64;
#pragma unroll 1
  for (int kt = 0; kt < nk; kt += 2) {
    gemm_step<NT>(acc, ra1, rb1, A0, B0, A1, B1, A, lda, B, ldb, (kt + 3 < nk) ? (kt + 3) * 64 : 0, wm, wn, l, r0, kc);
    lds_barrier();
    gemm_step<NT>(acc, ra0, rb0, A1, B1, A0, B0, A, lda, B, ldb, (kt + 4 < nk) ? (kt + 4) * 64 : 0, wm, wn, l, r0, kc);
    lds_barrier();
  }
}
template <int NT>
__device__ __forceinline__ void gemm_kloop(f16v (&acc)[4][NT], const half_t* __restrict__ A, int lda,
                                           const half_t* __restrict__ B, int ldb, int K, unsigned char* lds) {
  h8 ra0[8], rb0[2 * NT], ra1[8], rb1[2 * NT];
  gemm_issue<NT>(ra0, rb0, ra1, rb1, A, lda, B, ldb);
  gemm_run<NT>(acc, ra0, rb0, ra1, rb1, A, lda, B, ldb, K, lds);
}

template <int NT>
__device__ __forceinline__ void gemm_issue1(h8 (&ra)[8], h8 (&rb)[2 * NT], const half_t* __restrict__ A, int lda, const half_t* __restrict__ B, int ldb) {
  const int tid = otid();
  const int kc = tid & 7, r0 = tid >> 3;
#pragma unroll
  for (int i = 0; i < 8; ++i) ra[i] = *(const h8*)(A + (size_t)(r0 + 32 * i) * lda + kc * 8);
#pragma unroll
  for (int i = 0; i < 2 * NT; ++i) rb[i] = *(const h8*)(B + (size_t)(r0 + 32 * i) * ldb + kc * 8);
}
template <int NT>
__device__ __forceinline__ void gemm_run1(f16v (&acc)[4][NT], h8 (&ra)[8], h8 (&rb)[2 * NT],
                                          const half_t* __restrict__ A, int lda, const half_t* __restrict__ B, int ldb, int K, unsigned char* lds) {
  const int tid = otid(), w = tid >> 6, l = tid & 63;
  constexpr int STAGE = 256 * 144 + 64 * NT * 144;
  const int wm = w >> 1, wn = w & 1;
  const int kc = tid & 7;
  const int r0 = tid >> 3;
  lds_barrier();
#pragma unroll
  for (int i = 0; i < 8; ++i) { *(h8*)(lds + (r0 + 32 * i) * 144 + kc * 16) = ra[i]; ra[i] = *(const h8*)(A + (size_t)(r0 + 32 * i) * lda + 64 + kc * 8); }
#pragma unroll
  for (int i = 0; i < 2 * NT; ++i) { *(h8*)(lds + 256 * 144 + (r0 + 32 * i) * 144 + kc * 16) = rb[i]; rb[i] = *(const h8*)(B + (size_t)(r0 + 32 * i) * ldb + 64 + kc * 8); }
  lds_barrier();
  const int nk = K / 64;
#pragma unroll 1
  for (int kt = 0; kt < nk; ++kt) {
    unsigned char* cur = lds + (kt & 1) * STAGE;
    unsigned char* nxt = lds + ((kt + 1) & 1) * STAGE;
    gemm_step<NT>(acc, ra, rb, cur, cur + 256 * 144, nxt, nxt + 256 * 144, A, lda, B, ldb, (kt + 2 < nk) ? (kt + 2) * 64 : 0, wm, wn, l, r0, kc);
    lds_barrier();
  }
}

template <int NT>
__device__ __forceinline__ void zero_acc(f16v (&acc)[4][NT]) {
  float z = 0.f;
  asm volatile("" : "+v"(z));
#pragma unroll
  for (int i = 0; i < 4; ++i)
#pragma unroll
    for (int j = 0; j < NT; ++j)
#pragma unroll
      for (int r = 0; r < 16; ++r) acc[i][j][r] = z;
}

#define EP 68
__device__ __forceinline__ void stage_pair(float* E, const f16v& a0, const f16v& a1, int l) {
#pragma unroll
  for (int r = 0; r < 16; ++r) {
    const int rr = crow(r, l);
    E[rr * EP + (l & 31)] = a0[r];
    E[rr * EP + 32 + (l & 31)] = a1[r];
  }
}
__device__ __forceinline__ void ld8(const float* p, float (&v)[8]) {
  const f4v a = *(const f4v*)p, b = *(const f4v*)(p + 4);
  v[0] = a[0]; v[1] = a[1]; v[2] = a[2]; v[3] = a[3]; v[4] = b[0]; v[5] = b[1]; v[6] = b[2]; v[7] = b[3];
}
__device__ __forceinline__ int xcc_census(const unsigned* xcnt, int my_xcc) {
  unsigned sum = 0; bool ok = my_xcc < 8; int mine = 0;
#pragma unroll
  for (int j = 0; j < 16; ++j) {
    const unsigned c = __hip_atomic_load(xcnt + j, __ATOMIC_RELAXED, __HIP_MEMORY_SCOPE_AGENT);
    sum += c;
    if (j < 8 && c == 0u) ok = false;
    if (j >= 8 && c != 0u) ok = false;
    if (j == my_xcc) mine = (int)c;
  }
  if (sum != gridDim.x) ok = false;
  return ok ? mine : 0;
}

__device__ void phase_A(const Params& p, int layer, unsigned char* lds, int my_xcc, int my_loc, const unsigned* xcnt) {
  const int tid = otid(), w = tid >> 6, l = tid & 63;
  const half_t* H = (const half_t*)(p.ws + OFF_H);
  const half_t* Wt = (const half_t*)(p.ws + OFF_WINT) + (size_t)layer * NPAD * WP;
  half_t* P = (half_t*)(p.ws + OFF_P);
  float* GA = (float*)(p.ws + OFF_GA);
  float* IW = (float*)(p.ws + OFF_IW);
  const float* RT = (const float*)(p.ws + OFF_RT);
  const float* DT = (const float*)(p.ws + OFF_DT);
  const int wm = w >> 1, wn = w & 1;
  const int G = gridDim.x;
  const int ntiles = 64 * 31;
  const int nx = xcc_census(xcnt, my_xcc);
  int nmine;
  if (nx > 0) nmine = (my_loc < 248) ? (248 - my_loc + nx - 1) / nx : 0;
  else nmine = ((int)blockIdx.x < ntiles) ? (ntiles - (int)blockIdx.x + G - 1) / G : 0;
  h8 ra0[8], rb0[8];
  int mt = 0, nt = 0;
  if (nmine > 0) {
    if (nx > 0) { const int s0 = my_loc; mt = my_xcc * 8 + (s0 & 7); nt = s0 >> 3; }
    else { const int tix = blockIdx.x; mt = tix & 63; nt = tix >> 6; }
    gemm_issue1<4>(ra0, rb0, H + (size_t)mt * 256 * HP, HP, Wt + (size_t)nt * 256 * WP, WP);
  }
#pragma unroll 1
  for (int rnd = 0; rnd < nmine; ++rnd) {
    f16v acc[4][4];
    zero_acc<4>(acc);
    gemm_run1<4>(acc, ra0, rb0, H + (size_t)mt * 256 * HP, HP, Wt + (size_t)nt * 256 * WP, WP, 1024, lds);
    const int mt_cur = mt, nt_cur = nt;
    if (rnd + 1 < nmine) {
      if (nx > 0) { const int s1 = my_loc + nx * (rnd + 1); mt = my_xcc * 8 + (s1 & 7); nt = s1 >> 3; }
      else { const int tix = (rnd + 1) * G + blockIdx.x; mt = tix & 63; nt = tix >> 6; }
      gemm_issue1<4>(ra0, rb0, H + (size_t)mt * 256 * HP, HP, Wt + (size_t)nt * 256 * WP, WP);
    }
    const int m0w = mt_cur * 256 + wm * 128;
    const int n0w = nt_cur * 256 + wn * 128;
    float* E = (float*)(lds) + w * (32 * EP);
    const int prow = l >> 3, c0 = (l & 7) * 8;
#pragma unroll
    for (int jp = 0; jp < 2; ++jp) {
      const int nb2 = n0w + jp * 64;
      const int n0 = nb2 + c0;
      const bool rope64 = nb2 < 512;
      const bool rope16 = ((nb2 >= C_DSAQ && nb2 < C_DSAV) || (nb2 >= C_IDXQ && nb2 < C_GLAQ)) && (c0 < 16);
      float scale = 1.f;
      if (n0 < 256 || (n0 >= C_DSAQ && n0 < C_DSAK) || (n0 >= C_IDXQ && n0 < C_IDXK) || (n0 >= C_GLAQ && n0 < C_GLAK)) scale = 0.125f;
      int mode = 0;
      if ((n0 >= C_RETG && n0 < C_DSAQ) || (n0 >= C_DSAG && n0 < C_IDXQ) || (n0 >= C_GLAG && n0 < C_GLAA)) mode = 1;
      if (n0 >= C_MRG && n0 < C_END) mode = 2;
#pragma unroll
      for (int i = 0; i < 4; ++i) {
        stage_pair(E, acc[i][2 * jp], acc[i][2 * jp + 1], l);
#pragma unroll 2
        for (int ps = 0; ps < 4; ++ps) {
          const int rl = ps * 8 + prow;
          const int row = m0w + i * 32 + rl;
          float v[8], o[8];
          ld8(E + rl * EP + c0, v);
#pragma unroll
          for (int q = 0; q < 8; ++q) o[q] = v[q];
          if (rope64) {
            float pv[8], tb[16];
            ld8(E + rl * EP + (c0 ^ 32), pv);
            const float* tp = RT + (size_t)row * 64 + (c0 & 31) * 2;
            ld8(tp, *(float(*)[8])&tb[0]); ld8(tp + 8, *(float(*)[8])&tb[8]);
#pragma unroll
            for (int q = 0; q < 8; ++q) o[q] = (c0 < 32) ? (v[q] * tb[2 * q] - pv[q] * tb[2 * q + 1]) : (v[q] * tb[2 * q] + pv[q] * tb[2 * q + 1]);
          } else if (rope16) {
            float pv[8], tb[16];
            ld8(E + rl * EP + (c0 ^ 8), pv);
            const float* tp = DT + (size_t)row * 16;
            ld8(tp, *(float(*)[8])&tb[0]); ld8(tp + 8, *(float(*)[8])&tb[8]);
#pragma unroll
            for (int q = 0; q < 8; ++q) o[q] = (c0 < 8) ? (v[q] * tb[2 * q] - pv[q] * tb[2 * q + 1]) : (v[q] * tb[2 * q] + pv[q] * tb[2 * q + 1]);
          }
          h8 ov;
#pragma unroll
          for (int q = 0; q < 8; ++q) {
            float t = o[q] * scale;
            if (mode != 0) {
              const float sg = __builtin_amdgcn_rcpf(1.f + __expf(-t));
              t = (mode == 1) ? t * sg : sg;
            }
            ov[q] = (half_t)t;
          }
          if (n0 < C_END) __builtin_nontemporal_store(ov, (h8*)(P + (size_t)row * PP + n0));
          if (n0 >= C_GLAA && n0 < C_MRG) {
#pragma unroll
            for (int q = 0; q < 8; ++q) GA[(size_t)row * 16 + (n0 - C_GLAA) + q] = v[q];
          }
          if (n0 == C_IDXW) {
#pragma unroll
            for (int q = 0; q < 4; ++q) IW[(size_t)row * 4 + q] = 0.5f * v[q];
          }
        }
      }
    }
  }
}

#define LA_BC 0
#define LA_GAS 16640
#define LA_WL 20736
#define LA_QT 24832
#define LA_KT 34048
#define LA_AT 43264
#define LA_VT 52480
#define LA_SS 70912
#define LA_OS 89344
#define LA_SEG 123136

__device__ void la_bcum(const Params& p, int layer, int n, int Hh, unsigned char* lds) {
  const int tid = otid();
  float* Bc = (float*)(lds + LA_BC);
  const int d = tid & 63, q = tid >> 6;
  if (Hh < 4) {
    float lg = log1pf(-exp2f(-5.0f - (float)Hh));
#pragma unroll
    for (int jj = 0; jj < 16; ++jj) { int j = q * 16 + jj; Bc[j * 65 + d] = (float)(j + 1) * lg; }
    __syncthreads();
    return;
  }
  const int h = Hh - 4;
  float* GAs = (float*)(lds + LA_GAS);
  float* WL = (float*)(lds + LA_WL);
  float* SEG = (float*)(lds + LA_SEG);
  const float* GA = (const float*)(p.ws + OFF_GA);
#pragma unroll
  for (int i = 0; i < 4; ++i) {
    int e = tid + 256 * i;
    GAs[e] = GA[(size_t)n * 64 * 16 + e];
    int r = e >> 6, dd = e & 63;
    WL[e] = p.gla_w_lr[(size_t)layer * 16 * 256 + r * 256 + h * 64 + dd];
  }
  __syncthreads();
  float wl[16];
#pragma unroll
  for (int r = 0; r < 16; ++r) wl[r] = WL[r * 64 + d];
  const float bl = p.gla_b_lr[layer * 256 + h * 64 + d];
  float run = 0.f;
#pragma unroll
  for (int jj = 0; jj < 16; ++jj) {
    int j = q * 16 + jj;
    float z = bl;
#pragma unroll
    for (int r = 0; r < 16; ++r) z += GAs[j * 16 + r] * wl[r];
    float ls = fminf(z, 0.f) - __logf(1.f + __expf(-fabsf(z)));
    run += ls * (1.0f / 16.0f);
    Bc[j * 65 + d] = run;
  }
  SEG[q * 64 + d] = run;
  __syncthreads();
  float off = 0.f;
  for (int qq = 0; qq < q; ++qq) off += SEG[qq * 64 + d];
  if (q > 0) {
#pragma unroll
    for (int jj = 0; jj < 16; ++jj) { int j = q * 16 + jj; Bc[j * 65 + d] += off; }
  }
  __syncthreads();
}

__device__ __forceinline__ void la_load_v(const half_t* __restrict__ P, int t0, int vcol, h8 (&vr)[2][2]) {
  const int tid = otid(), w = tid >> 6, l = tid & 63;
  const int jp = l & 31, cgp = l >> 5;
#pragma unroll
  for (int it = 0; it < 2; ++it) {
    int c = it * 8 + w * 2 + cgp;
    vr[it][0] = *(const h8*)(P + (size_t)(t0 + 2 * jp) * PP + vcol + c * 8);
    vr[it][1] = *(const h8*)(P + (size_t)(t0 + 2 * jp + 1) * PP + vcol + c * 8);
  }
}
__device__ __forceinline__ void la_stage_vt(const h8 (&vr)[2][2], unsigned char* lds) {
  const int tid = otid(), w = tid >> 6, l = tid & 63;
  half_t* VT = (half_t*)(lds + LA_VT);
  const int jp = l & 31, cgp = l >> 5;
#pragma unroll
  for (int it = 0; it < 2; ++it) {
    int c = it * 8 + w * 2 + cgp;
#pragma unroll
    for (int q = 0; q < 8; ++q) {
      h2 pr; pr[0] = vr[it][0][q]; pr[1] = vr[it][1][q];
      *(h2*)(VT + (c * 8 + q) * 72 + 2 * jp) = pr;
    }
  }
}
__device__ void la_item_kv(const Params& p, int layer, int item, unsigned char* lds) {
  const int tid = otid(), w = tid >> 6, l = tid & 63;
  const int n = item >> 3, Hh = item & 7;
  const int t0 = n * 64;
  const half_t* P = (const half_t*)(p.ws + OFF_P);
  half_t* ST = (half_t*)(p.ws + OFF_ST);
  float* DEC = (float*)(p.ws + OFF_DEC);
  const int kcol = (Hh < 4) ? (C_RETK + Hh * 64) : (C_GLAK + (Hh - 4) * 64);
  const int vcol = (Hh < 4) ? (C_RETV + Hh * 128) : (C_GLAV + (Hh - 4) * 128);
  h8 vr[2][2];
  la_load_v(P, t0, vcol, vr);
  const h8 k0 = *(const h8*)(P + (size_t)(t0 + 2 * (l & 31)) * PP + kcol + (w * 2 + (l >> 5)) * 8);
  const h8 k1 = *(const h8*)(P + (size_t)(t0 + 2 * (l & 31) + 1) * PP + kcol + (w * 2 + (l >> 5)) * 8);
  __syncthreads();
  la_bcum(p, layer, n, Hh, lds);
  const float* Bc = (const float*)(lds + LA_BC);
  half_t* KhT = (half_t*)(lds + LA_KT);
  half_t* VT = (half_t*)(lds + LA_VT);
  {
    const int jp = l & 31, cgp = l >> 5;
    int c = w * 2 + cgp;
#pragma unroll
    for (int q = 0; q < 8; ++q) {
      int d = c * 8 + q;
      float bl = Bc[63 * 65 + d];
      h2 pr;
      pr[0] = (half_t)((float)k0[q] * __expf(bl - Bc[(2 * jp) * 65 + d]));
      pr[1] = (half_t)((float)k1[q] * __expf(bl - Bc[(2 * jp + 1) * 65 + d]));
      *(h2*)(KhT + d * 72 + 2 * jp) = pr;
    }
  }
  la_stage_vt(vr, lds);
  if (tid < 64) DEC[(size_t)item * 64 + tid] = __expf(Bc[63 * 65 + tid]);
  __syncthreads();
  f16v acc[2];
#pragma unroll
  for (int j = 0; j < 2; ++j)
#pragma unroll
    for (int r = 0; r < 16; ++r) acc[j][r] = ozero();
#pragma unroll
  for (int ks = 0; ks < 4; ++ks) {
    h8 a = *(const h8*)(VT + (32 * w + (l & 31)) * 72 + ks * 16 + (l >> 5) * 8);
#pragma unroll
    for (int j = 0; j < 2; ++j) {
      h8 b = *(const h8*)(KhT + (j * 32 + (l & 31)) * 72 + ks * 16 + (l >> 5) * 8);
      acc[j] = mfma16(a, b, acc[j]);
    }
  }
#pragma unroll
  for (int j = 0; j < 2; ++j)
#pragma unroll
    for (int r = 0; r < 16; ++r) {
      int e = 32 * w + crow(r, l);
      int d = j * 32 + (l & 31);
      ST[(size_t)item * 8192 + e * 64 + d] = (half_t)acc[j][r];
    }
}

__device__ void phase_scan(const Params& p) {
  half_t* ST = (half_t*)(p.ws + OFF_ST);
  const float* DEC = (const float*)(p.ws + OFF_DEC);
  for (int f2 = blockIdx.x * NTHREADS + otid(); f2 < 32768; f2 += gridDim.x * NTHREADS) {
    const int f = f2 * 2;
    const int Hh = f >> 13, d = f & 63;
    float s0 = 0.f, s1 = 0.f;
    for (int n0 = 0; n0 < 256; n0 += 16) {
      h2 kv[16]; float2 dc[16];
#pragma unroll
      for (int u = 0; u < 16; ++u) {
        kv[u] = *(const h2*)(ST + (size_t)(n0 + u) * 65536 + f);
        dc[u] = *(const float2*)(DEC + (size_t)((n0 + u) * 8 + Hh) * 64 + d);
      }
#pragma unroll
      for (int u = 0; u < 16; ++u) {
        h2 o; o[0] = (half_t)s0; o[1] = (half_t)s1;
        *(h2*)(ST + (size_t)(n0 + u) * 65536 + f) = o;
        s0 = dc[u].x * s0 + (float)kv[u][0];
        s1 = dc[u].y * s1 + (float)kv[u][1];
      }
    }
  }
}

__device__ void la_item_out(const Params& p, int layer, int item, unsigned char* lds) {
  const int tid = otid(), w = tid >> 6, l = tid & 63;
  const int n = item >> 3, Hh = item & 7;
  const int t0 = n * 64;
  const half_t* P = (const half_t*)(p.ws + OFF_P);
  const half_t* ST = (const half_t*)(p.ws + OFF_ST);
  half_t* BR = (half_t*)(p.ws + OFF_BR);
  const int qcol = (Hh < 4) ? (C_RETQ + Hh * 64) : (C_GLAQ + (Hh - 4) * 64);
  const int kcol = (Hh < 4) ? (C_RETK + Hh * 64) : (C_GLAK + (Hh - 4) * 64);
  const int vcol = (Hh < 4) ? (C_RETV + Hh * 128) : (C_GLAV + (Hh - 4) * 128);
  const int gcol = (Hh < 4) ? (C_RETG + Hh * 128) : (C_GLAG + (Hh - 4) * 128);
  const int ocol = (Hh < 4) ? (Hh * 128) : (1024 + (Hh - 4) * 128);
  h8 vr[2][2];
  la_load_v(P, t0, vcol, vr);
  h8 qr[2], kr[2], sr[4];
#pragma unroll
  for (int it = 0; it < 2; ++it) {
    const int c = tid + 256 * it;
    qr[it] = *(const h8*)(P + (size_t)(t0 + (c >> 3)) * PP + qcol + (c & 7) * 8);
    kr[it] = *(const h8*)(P + (size_t)(t0 + (c >> 3)) * PP + kcol + (c & 7) * 8);
  }
#pragma unroll
  for (int it = 0; it < 4; ++it) {
    const int c = tid + 256 * it;
    sr[it] = *(const h8*)(ST + (size_t)item * 8192 + (c >> 3) * 64 + (c & 7) * 8);
  }
  __syncthreads();
  la_bcum(p, layer, n, Hh, lds);
  const float* Bc = (const float*)(lds + LA_BC);
  half_t* Qt = (half_t*)(lds + LA_QT);
  half_t* Kt = (half_t*)(lds + LA_KT);
  half_t* AT = (half_t*)(lds + LA_AT);
  half_t* VT = (half_t*)(lds + LA_VT);
  half_t* SS = (half_t*)(lds + LA_SS);
  float* OS = (float*)(lds + LA_OS);
#pragma unroll
  for (int it = 0; it < 2; ++it) {
    int c = tid + 256 * it;
    int row = c >> 3, kc = c & 7;
    const h8 qv = qr[it];
    const h8 kv = kr[it];
    h8 qo, ko;
#pragma unroll
    for (int q = 0; q < 8; ++q) {
      float b = Bc[row * 65 + kc * 8 + q];
      qo[q] = (half_t)((float)qv[q] * __expf(b));
      ko[q] = (half_t)((float)kv[q] * __expf(-b));
    }
    *(h8*)(Qt + row * 72 + kc * 8) = qo;
    *(h8*)(Kt + row * 72 + kc * 8) = ko;
  }
  la_stage_vt(vr, lds);
#pragma unroll
  for (int it = 0; it < 4; ++it) {
    int c = tid + 256 * it;
    int e = c >> 3, kc = c & 7;
    *(h8*)(SS + e * 72 + kc * 8) = sr[it];
  }
  __syncthreads();
  {
    const int mi = w >> 1, nj = w & 1;
    f16v acc;
#pragma unroll
    for (int r = 0; r < 16; ++r) acc[r] = ozero();
#pragma unroll
    for (int ks = 0; ks < 4; ++ks) {
      h8 a = *(const h8*)(Qt + (mi * 32 + (l & 31)) * 72 + ks * 16 + (l >> 5) * 8);
      h8 b = *(const h8*)(Kt + (nj * 32 + (l & 31)) * 72 + ks * 16 + (l >> 5) * 8);
      acc = mfma16(a, b, acc);
    }
#pragma unroll
    for (int r = 0; r < 16; ++r) {
      int i = mi * 32 + crow(r, l);
      int j = nj * 32 + (l & 31);
      float v = (j <= i) ? acc[r] : 0.f;
      AT[i * 72 + j] = (half_t)v;
    }
  }
  __syncthreads();
  {
    const int mi = w >> 1, nh = w & 1;
    f16v acc[2];
#pragma unroll
    for (int j = 0; j < 2; ++j)
#pragma unroll
      for (int r = 0; r < 16; ++r) acc[j][r] = ozero();
#pragma unroll
    for (int ks = 0; ks < 4; ++ks) {
      h8 a1 = *(const h8*)(AT + (mi * 32 + (l & 31)) * 72 + ks * 16 + (l >> 5) * 8);
      h8 a2 = *(const h8*)(Qt + (mi * 32 + (l & 31)) * 72 + ks * 16 + (l >> 5) * 8);
#pragma unroll
      for (int j = 0; j < 2; ++j) {
        h8 b1 = *(const h8*)(VT + (nh * 64 + j * 32 + (l & 31)) * 72 + ks * 16 + (l >> 5) * 8);
        h8 b2 = *(const h8*)(SS + (nh * 64 + j * 32 + (l & 31)) * 72 + ks * 16 + (l >> 5) * 8);
        acc[j] = mfma16(a1, b1, acc[j]);
        acc[j] = mfma16(a2, b2, acc[j]);
      }
    }
#pragma unroll
    for (int j = 0; j < 2; ++j)
#pragma unroll
      for (int r = 0; r < 16; ++r) {
        int i = mi * 32 + crow(r, l);
        int e = nh * 64 + j * 32 + (l & 31);
        OS[i * 132 + e] = acc[j][r];
      }
  }
  __syncthreads();
  {
    const int i = tid >> 2, qd = tid & 3;
    float ov[32];
    float ss = 0.f;
#pragma unroll
    for (int c = 0; c < 8; ++c) {
      f4v v = *(const f4v*)(OS + i * 132 + qd * 32 + c * 4);
      ov[c * 4] = v[0]; ov[c * 4 + 1] = v[1]; ov[c * 4 + 2] = v[2]; ov[c * 4 + 3] = v[3];
      ss += v[0] * v[0] + v[1] * v[1] + v[2] * v[2] + v[3] * v[3];
    }
    ss += dppf<0xB1>(ss);
    ss += dppf<0x4E>(ss);
    float rs = rsqrtf(ss * (1.0f / 128.0f) + 1e-6f);
#pragma unroll
    for (int c = 0; c < 4; ++c) {
      h8 g = *(const h8*)(P + (size_t)(t0 + i) * PP + gcol + qd * 32 + c * 8);
      h8 o;
#pragma unroll
      for (int q = 0; q < 8; ++q) o[q] = (half_t)(ov[c * 8 + q] * rs * (float)g[q]);
      *(h8*)(BR + (size_t)(t0 + i) * 1536 + ocol + qd * 32 + c * 8) = o;
    }
  }
}

#define DS_CAP 768
#define DS_PRUNE_AT 640
#define NPL 12
#define DS_LS 0
#define DS_LI (32 * DS_CAP * 4)
#define DS_CNT (32 * DS_CAP * 6)
#define DS_THR (DS_CNT + 128)
#define DS_WQ (DS_CNT + 256)
#define DS_HIST (DS_CNT + 1024)

__device__ __forceinline__ unsigned long long wave_or64(unsigned long long v) {
  const unsigned lo = wave_or((unsigned)v), hi = wave_or((unsigned)(v >> 32));
  return ((unsigned long long)hi << 32) | lo;
}
template <bool APPROX>
__device__ __forceinline__ void dsa_prune(float* LSm, unsigned short* LIm, int n, unsigned* hist, int* cntm, float* thrm, int l) {
  unsigned long long comp[NPL];
  bool act[NPL], val[NPL];
#pragma unroll
  for (int k = 0; k < NPL; ++k) {
    int e = l + 64 * k;
    val[k] = e < n;
    const int ec = val[k] ? e : 0;
    unsigned u = __float_as_uint(LSm[ec]), li = LIm[ec];
    if (!val[k]) { u = 0; li = 0; }
    const unsigned key = (u >> 31) ? ~u : (u | 0x80000000u);
    comp[k] = ((unsigned long long)key << 14) | (unsigned long long)(16383u - li);
    act[k] = val[k];
  }
  const unsigned long long c0 = ((unsigned long long)(unsigned)__builtin_amdgcn_readfirstlane((int)(unsigned)(comp[0] >> 32)) << 32) | (unsigned)__builtin_amdgcn_readfirstlane((int)(unsigned)comp[0]);
  unsigned long long x = 0;
#pragma unroll
  for (int k = 0; k < NPL; ++k) x |= val[k] ? (comp[k] ^ c0) : 0ull;
  x = wave_or64(x);
  int shift = (x == 0ull) ? 0 : (63 - __clzll((long long)x)) - 7;
  if (shift < 0) shift = 0;
  unsigned rank = 256;
  bool fast = false; unsigned fsel = 0, fcnt = 0; int fshift = 0;
#pragma unroll 1
  for (int rd = 0; rd < 8; ++rd) {
    *(uint4*)(hist + 4 * l) = make_uint4(0, 0, 0, 0);
    asm volatile("" ::: "memory");
    unsigned dk[NPL];
#pragma unroll
    for (int k = 0; k < NPL; ++k) {
      dk[k] = (unsigned)(comp[k] >> shift) & 255u;
      if (act[k]) atomicAdd(&hist[dk[k]], 1u);
    }
    asm volatile("" ::: "memory");
    uint4 hv; hv.x = hist[4 * l]; hv.y = hist[4 * l + 1]; hv.z = hist[4 * l + 2]; hv.w = hist[4 * l + 3];
    unsigned tl = hv.x + hv.y + hv.z + hv.w;
    const unsigned pin = wave_incl_scan(tl);
    const unsigned tot = (unsigned)__builtin_amdgcn_readlane((int)pin, 63);
    unsigned sx = tot - pin;
    bool mine = (sx < rank) && (rank <= sx + tl);
    unsigned dsel = 0, nr = 0, hsel = 0;
    if (mine) {
      unsigned c = sx;
      if (c + hv.w >= rank) { dsel = 4 * l + 3; nr = rank - c; hsel = hv.w; }
      else {
        c += hv.w;
        if (c + hv.z >= rank) { dsel = 4 * l + 2; nr = rank - c; hsel = hv.z; }
        else {
          c += hv.z;
          if (c + hv.y >= rank) { dsel = 4 * l + 1; nr = rank - c; hsel = hv.y; }
          else { c += hv.y; dsel = 4 * l; nr = rank - c; hsel = hv.x; }
        }
      }
    }
    unsigned long long mk = __ballot(mine);
    int src = (mk == 0ull) ? 0 : (__ffsll((long long)mk) - 1);
    dsel = (unsigned)__builtin_amdgcn_readlane((int)dsel, src);
    rank = (unsigned)__builtin_amdgcn_readlane((int)nr, src);
    hsel = (unsigned)__builtin_amdgcn_readlane((int)hsel, src);
    if (APPROX && rd == 0) {
      const unsigned kept = 256u - rank + hsel;
      if (kept <= 320u) { fast = true; fsel = dsel; fcnt = kept; fshift = shift; break; }
    }
#pragma unroll
    for (int k = 0; k < NPL; ++k) act[k] = act[k] && (dk[k] == dsel);
    if (hsel <= 1u || shift == 0) break;
    shift = (shift >= 8) ? (shift - 8) : 0;
  }
  unsigned long long tsel = 0;
#pragma unroll
  for (int k = 0; k < NPL; ++k) tsel |= act[k] ? comp[k] : 0ull;
  unsigned long long T = 0ull;
  if (!fast) T = wave_or64(tsel);
  else T = ((c0 >> (fshift + 8)) << (fshift + 8)) | ((unsigned long long)fsel << fshift);
  bool keep[NPL];
  unsigned cntk = 0;
#pragma unroll
  for (int k = 0; k < NPL; ++k) {
    keep[k] = val[k] && (comp[k] >= T);
    cntk += keep[k] ? 1u : 0u;
  }
  unsigned pos = wave_incl_scan(cntk) - cntk;
  asm volatile("" ::: "memory");
#pragma unroll
  for (int k = 0; k < NPL; ++k) {
    if (keep[k]) {
      const unsigned kk = (unsigned)(comp[k] >> 14);
      const unsigned u = (kk & 0x80000000u) ? (kk & 0x7FFFFFFFu) : ~kk;
      LSm[pos] = __uint_as_float(u);
      LIm[pos] = (unsigned short)(16383u - ((unsigned)comp[k] & 16383u));
      ++pos;
    }
  }
  if (l == 0) {
    const unsigned T32 = (unsigned)(T >> 14);
    *cntm = fast ? (int)fcnt : 256;
    *thrm = __uint_as_float((T32 & 0x80000000u) ? (T32 & 0x7FFFFFFFu) : ~T32);
  }
  asm volatile("" ::: "memory");
}

__device__ void dsa_item(const Params& p, int qb, unsigned char* lds) {
  const int tid = otid(), w = tid >> 6, l = tid & 63;
  const int t0 = qb * 32;
  const half_t* P = (const half_t*)(p.ws + OFF_P);
  const float* IW = (const float*)(p.ws + OFF_IW);
  half_t* BR = (half_t*)(p.ws + OFF_BR);
  float* LS = (float*)(lds + DS_LS);
  unsigned short* LI = (unsigned short*)(lds + DS_LI);
  int* cnt = (int*)(lds + DS_CNT);
  float* thr = (float*)(lds + DS_THR);
  float* wq = (float*)(lds + DS_WQ);
  unsigned* hist = (unsigned*)(lds + DS_HIST) + w * 256;
  float* PWa = LS + (w * 8) * DS_CAP + 256;
  float* PWb = LS + (w * 8 + 1) * DS_CAP + 256;
  half_t* QS = (half_t*)(LI + (w * 8) * DS_CAP + 256);
  for (int rep_sel = 0; rep_sel < REP_SEL; ++rep_sel) {
  __syncthreads();
  if (tid < 32) { cnt[tid] = 0; thr[tid] = -INFINITY; }
  if (tid < 128) wq[tid] = IW[(size_t)t0 * 4 + tid];
  __syncthreads();
  h8 aq[4][4];
#pragma unroll
  for (int h = 0; h < 4; ++h)
#pragma unroll
    for (int ks = 0; ks < 4; ++ks)
      aq[h][ks] = *(const h8*)(P + (size_t)(t0 + (l & 31)) * PP + C_IDXQ + h * 64 + ks * 16 + (l >> 5) * 8);
  const int nt = qb + 1;
  const int nr = (nt + 3) >> 2;
  f4v wqv[16];
#pragma unroll
  for (int r = 0; r < 16; ++r) wqv[r] = *(const f4v*)(wq + crow(r, l) * 4);
  float thv[16];
  { float ninf = -INFINITY; asm volatile("" : "+v"(ninf));
#pragma unroll
  for (int r = 0; r < 16; ++r) thv[r] = ninf; }
  h8 bk[4];
  {
    const int k0 = (w < nt) ? w : 0;
#pragma unroll
    for (int ks = 0; ks < 4; ++ks)
      bk[ks] = *(const h8*)(P + (size_t)(k0 * 32 + (l & 31)) * PP + C_IDXK + ks * 16 + (l >> 5) * 8);
  }
#pragma unroll 1
  for (int rd = 0; rd < nr; ++rd) {
    const int kt = 4 * rd + w;
    h8 bkn[4];
    {
      const int kn = (kt + 4 < nt) ? (kt + 4) : 0;
#pragma unroll
      for (int ks = 0; ks < 4; ++ks)
        bkn[ks] = *(const h8*)(P + (size_t)(kn * 32 + (l & 31)) * PP + C_IDXK + ks * 16 + (l >> 5) * 8);
    }
    if (kt < nt) {
      const int sbase = kt * 32;
      f16v acc[4];
#pragma unroll
      for (int h = 0; h < 4; ++h) {
#pragma unroll
        for (int r = 0; r < 16; ++r) acc[h][r] = ozero();
#pragma unroll
        for (int ks = 0; ks < 4; ++ks) acc[h] = mfma16(aq[h][ks], bk[ks], acc[h]);
      }
      const int s = sbase + (l & 31);
      float scv[16];
      unsigned pm = 0;
#pragma unroll
      for (int r = 0; r < 16; ++r) {
        const int m = crow(r, l);
        const f4v wv = wqv[r];
        float sc = wv[0] * relu_f(acc[0][r]) + wv[1] * relu_f(acc[1][r]) + wv[2] * relu_f(acc[2][r]) + wv[3] * relu_f(acc[3][r]);
        sc += 0.0f;
        scv[r] = sc;
      }
      if (kt == qb) {
#pragma unroll
        for (int r = 0; r < 16; ++r) if (s > t0 + crow(r, l)) scv[r] = -INFINITY;
      }
#pragma unroll
      for (int r = 0; r < 16; ++r) pm |= (scv[r] > thv[r]) ? (1u << r) : 0u;
      if (__ballot(pm != 0u) != 0ull) {
        unsigned long long mks[16];
        int mycnt = 0;
#pragma unroll
        for (int r = 0; r < 16; ++r) {
          const unsigned long long mk = __ballot(((pm >> r) & 1u) != 0u);
          mks[r] = mk;
          const unsigned hm = (l < 32) ? (unsigned)mk : (unsigned)(mk >> 32);
          if ((l & 31) == r) mycnt = __popc(hm);
        }
        int base = 0;
        if ((l & 31) < 16 && mycnt > 0) base = atomicAdd(&cnt[crow(l & 31, l)], mycnt);
#pragma unroll
        for (int r = 0; r < 16; ++r) {
          const unsigned long long mk = mks[r];
          if (mk != 0ull) {
            const unsigned hm = (l < 32) ? (unsigned)mk : (unsigned)(mk >> 32);
            const int b_lo = __builtin_amdgcn_readlane(base, r), b_hi = __builtin_amdgcn_readlane(base, 32 + r);
            const int bb = (l < 32) ? b_lo : b_hi;
            if ((pm >> r) & 1u) {
              const int m = crow(r, l);
              const int slot = bb + __popc(hm & ((1u << (l & 31)) - 1u));
              LS[m * DS_CAP + slot] = scv[r];
              LI[m * DS_CAP + slot] = (unsigned short)s;
            }
          }
        }
      }
    }
    lds_barrier();
    bool any_prune;
    {
      const int cv = (l < 32) ? cnt[l] : 0;
      unsigned pmask = (unsigned)__ballot(cv > DS_PRUNE_AT);
      any_prune = pmask != 0u;
      int j = 0;
      while (pmask != 0u) {
        const int m = __ffs((int)pmask) - 1;
        pmask &= pmask - 1u;
        if ((j & 3) == w) dsa_prune<true>(LS + m * DS_CAP, LI + m * DS_CAP, cnt[m], hist, cnt + m, thr + m, l);
        ++j;
      }
    }
    lds_barrier();
    if (any_prune) {
#pragma unroll
      for (int r = 0; r < 16; ++r) thv[r] = thr[crow(r, l)];
    }
#pragma unroll
    for (int ks = 0; ks < 4; ++ks) bk[ks] = bkn[ks];
  }
  }
#pragma unroll 1
  for (int mm = 0; mm < 8; ++mm) {
    const int m = w * 8 + mm;
    const int c = cnt[m];
    if (c > 256) dsa_prune<false>(LS + m * DS_CAP, LI + m * DS_CAP, c, hist, cnt + m, thr + m, l);
  }
  asm volatile("s_waitcnt lgkmcnt(0)" ::: "memory");
  for (int rep_att = 0; rep_att < REP_ATT; ++rep_att) {
  h8 kvr[4][8];
  {
    const int m = w * 8;
    const int c = min(cnt[m], 256);
    const unsigned short* LIm = LI + m * DS_CAP;
#pragma unroll
    for (int kk = 0; kk < 4; ++kk) {
      const int e = l + 64 * kk;
      const int s = (int)LIm[(e < c) ? e : 0];
      const half_t* kr = P + (size_t)s * PP + C_DSAK;
#pragma unroll
      for (int ch = 0; ch < 8; ++ch) kvr[kk][ch] = *(const h8*)(kr + ch * 8);
    }
  }
  h8 qreg = *(const h8*)(P + (size_t)(t0 + w * 8) * PP + C_DSAQ + l * 8);
  const int dch = l & 7, ksub = l >> 3;
#pragma unroll 1
  for (int u = 0; u < 16; ++u) {
    const int mm = u >> 1, g = u & 1;
    const int m = w * 8 + mm;
    const int t = t0 + m;
    const int c = min(cnt[m], 256);
    const unsigned short* LIm = LI + m * DS_CAP;
    if (g == 0) {
      *(h8*)(QS + l * 8) = qreg;
      const int mq = (mm < 7) ? (m + 1) : m;
      qreg = *(const h8*)(P + (size_t)(t0 + mq) * PP + C_DSAQ + l * 8);
    }
    h8 gt[4];
#pragma unroll
    for (int hh = 0; hh < 4; ++hh) gt[hh] = *(const h8*)(P + (size_t)t * PP + C_DSAG + (g * 4 + hh) * 64 + dch * 8);
    h8 vv[16];
#pragma unroll
    for (int i = 0; i < 16; ++i) {
      const int e = i * 8 + ksub;
      const int s = (int)LIm[(e < c) ? e : 0];
      vv[i] = *(const h8*)(P + (size_t)s * PP + C_DSAV + g * 64 + dch * 8);
    }
    asm volatile("" ::: "memory");
    float lg[4][4];
#pragma unroll
    for (int hh = 0; hh < 4; ++hh) {
#pragma unroll
      for (int kk = 0; kk < 4; ++kk) lg[hh][kk] = ozero();
#pragma unroll
      for (int ch = 0; ch < 8; ++ch) {
        const h8 qq = *(const h8*)(QS + (g * 4 + hh) * 64 + ch * 8);
#pragma unroll
        for (int kk = 0; kk < 4; ++kk) {
          float a = lg[hh][kk];
          a = __builtin_amdgcn_fdot2(__builtin_shufflevector(qq, qq, 0, 1), __builtin_shufflevector(kvr[kk][ch], kvr[kk][ch], 0, 1), a, false);
          a = __builtin_amdgcn_fdot2(__builtin_shufflevector(qq, qq, 2, 3), __builtin_shufflevector(kvr[kk][ch], kvr[kk][ch], 2, 3), a, false);
          a = __builtin_amdgcn_fdot2(__builtin_shufflevector(qq, qq, 4, 5), __builtin_shufflevector(kvr[kk][ch], kvr[kk][ch], 4, 5), a, false);
          a = __builtin_amdgcn_fdot2(__builtin_shufflevector(qq, qq, 6, 7), __builtin_shufflevector(kvr[kk][ch], kvr[kk][ch], 6, 7), a, false);
          lg[hh][kk] = a;
        }
      }
#pragma unroll
      for (int kk = 0; kk < 4; ++kk) lg[hh][kk] = (l + 64 * kk < c) ? lg[hh][kk] : -INFINITY;
    }
    {
      const int un = (u < 15) ? (u + 1) : 15;
      const int mn = w * 8 + (un >> 1), gn = un & 1;
      const int cn = min(cnt[mn], 256);
      const unsigned short* LIn = LI + mn * DS_CAP;
#pragma unroll
      for (int kk = 0; kk < 4; ++kk) {
        const int e = l + 64 * kk;
        const int s = (int)LIn[(e < cn) ? e : 0];
        const half_t* kr = P + (size_t)s * PP + C_DSAK + gn * 64;
#pragma unroll
        for (int ch = 0; ch < 8; ++ch) kvr[kk][ch] = *(const h8*)(kr + ch * 8);
      }
    }
#pragma unroll
    for (int hh = 0; hh < 4; ++hh) {
      float mx = fmaxf(fmaxf(lg[hh][0], lg[hh][1]), fmaxf(lg[hh][2], lg[hh][3]));
      mx = wave_max(mx);
      float ev[4]; float sm = 0.f;
#pragma unroll
      for (int kk = 0; kk < 4; ++kk) { ev[kk] = __expf(lg[hh][kk] - mx); sm += ev[kk]; }
      sm = wave_sum(sm);
      const float inv = 1.0f / sm;
#pragma unroll
      for (int kk = 0; kk < 4; ++kk) ((kk < 2) ? PWa : PWb)[(l + 64 * (kk & 1)) * 4 + hh] = ev[kk] * inv;
    }
    asm volatile("" ::: "memory");
    float o[4][8];
#pragma unroll
    for (int hh = 0; hh < 4; ++hh)
#pragma unroll
      for (int q = 0; q < 8; ++q) o[hh][q] = ozero();
    const int nit = (c + 7) >> 3;
#pragma unroll 1
    for (int it0 = 0; it0 < nit; it0 += 16) {
      if (it0 > 0) {
#pragma unroll
        for (int i = 0; i < 16; ++i) {
          const int e = (it0 + i) * 8 + ksub;
          const int s = (int)LIm[(e < c) ? e : 0];
          vv[i] = *(const h8*)(P + (size_t)s * PP + C_DSAV + g * 64 + dch * 8);
        }
      }
#pragma unroll
      for (int i = 0; i < 16; ++i) {
        const int e = (it0 + i) * 8 + ksub;
        const f4v pv = *(const f4v*)(((e < 128) ? PWa : PWb) + (e & 127) * 4);
#pragma unroll
        for (int hh = 0; hh < 4; ++hh)
#pragma unroll
          for (int q = 0; q < 8; ++q) o[hh][q] += pv[hh] * (float)vv[i][q];
      }
    }
#pragma unroll
    for (int hh = 0; hh < 4; ++hh)
#pragma unroll
      for (int q = 0; q < 8; ++q) {
        float v = o[hh][q];
        v += dppf<0x128>(v); v += xor16f(v); v += xor32f(v);
        o[hh][q] = v;
      }
    if (l < 8) {
#pragma unroll
      for (int hh = 0; hh < 4; ++hh) {
        const int col = (g * 4 + hh) * 64 + dch * 8;
        h8 ov;
#pragma unroll
        for (int q = 0; q < 8; ++q) ov[q] = (half_t)(o[hh][q] * (float)gt[hh][q]);
        *(h8*)(BR + (size_t)t * 1536 + 512 + col) = ov;
      }
    }
    asm volatile("" ::: "memory");
  }
  }
}

__device__ void phase_B(const Params& p, int layer, unsigned char* lds) {
  const int G = gridDim.x;
  for (int j = 0; j * G < 512; ++j) {
    const int b = (j & 1) ? (G - 1 - (int)blockIdx.x) : (int)blockIdx.x;
    const int idx = j * G + b;
#ifndef NO_DSA
    if (idx < 512) dsa_item(p, 511 - idx, lds);
#endif
  }
  for (int rep = 0; rep < REP_KV; ++rep)
  for (int it = blockIdx.x; it < 2048; it += G) la_item_kv(p, layer, it, lds);
}

__device__ void phase_E1(const Params& p, int layer, unsigned char* lds, int my_xcc, int my_loc, const unsigned* xcnt) {
  const int tid = otid(), w = tid >> 6, l = tid & 63;
  const half_t* BR = (const half_t*)(p.ws + OFF_BR);
  const half_t* WbrT = (const half_t*)(p.ws + OFF_WBRT) + (size_t)layer * 3 * 1024 * WBP;
  const half_t* P = (const half_t*)(p.ws + OFF_P);
  half_t* Y1 = (half_t*)(p.ws + OFF_H);
  const int wm = w >> 1, wn = w & 1;
  float* E = (float*)(lds + GEMM_EOFF) + w * (32 * EP);
  const int prow = l >> 3, c0 = (l & 7) * 8;
  const int nx = xcc_census(xcnt, my_xcc);
  const int nrounds = (nx > 0) ? (64 + nx - 1) / nx : (512 + (int)gridDim.x - 1) / (int)gridDim.x;
  for (int rnd = 0; rnd < nrounds; ++rnd) {
    int mt, nt;
    if (nx > 0) {
      const int s = my_loc + nx * rnd;
      if (s >= 64) continue;
      mt = my_xcc * 8 + (s & 7); nt = s >> 3;
    } else {
      const int tix = rnd * (int)gridDim.x + (int)blockIdx.x;
      if (tix >= 512) continue;
      mt = tix & 63; nt = tix >> 6;
    }
    h8 tot[4][4];
#pragma unroll
    for (int i = 0; i < 4; ++i)
#pragma unroll
      for (int ps = 0; ps < 4; ++ps)
#pragma unroll
        for (int q = 0; q < 8; ++q) tot[i][ps][q] = (half_t)ozero();
    const int m0w = mt * 256 + wm * 128;
    const int n0 = nt * 128 + wn * 64 + c0;
#pragma unroll 1
    for (int b = 0; b < 3; ++b) {
      f16v acc[4][2];
      zero_acc<2>(acc);
      gemm_kloop<2>(acc, BR + (size_t)mt * 256 * 1536 + b * 512, 1536, WbrT + (size_t)b * 1024 * WBP + (size_t)nt * 128 * WBP, WBP, 512, lds);
#pragma unroll
      for (int i = 0; i < 4; ++i) {
        stage_pair(E, acc[i][0], acc[i][1], l);
#pragma unroll
        for (int ps = 0; ps < 4; ++ps) {
          const int rl = ps * 8 + prow;
          const int row = m0w + i * 32 + rl;
          const h8 g = *(const h8*)(P + (size_t)row * PP + C_MRG + b * 1024 + n0);
          float ev[8];
          ld8(E + rl * EP + c0, ev);
#pragma unroll
          for (int q = 0; q < 8; ++q) tot[i][ps][q] = (half_t)((float)tot[i][ps][q] + (float)g[q] * ev[q]);
        }
      }
    }
#pragma unroll
    for (int i = 0; i < 4; ++i)
#pragma unroll
      for (int ps = 0; ps < 4; ++ps) {
        const int row = m0w + i * 32 + ps * 8 + prow;
        *(h8*)(Y1 + (size_t)row * HP + n0) = tot[i][ps];
      }
  }
}

__device__ void phase_E2(const Params& p, int layer, unsigned char* lds, int my_xcc, int my_loc, const unsigned* xcnt) {
  const int tid = otid(), w = tid >> 6, l = tid & 63;
  const half_t* Y1 = (const half_t*)(p.ws + OFF_H);
  const half_t* Wo = (const half_t*)(p.ws + OFF_WOUTT) + (size_t)layer * 1024 * WP;
  float* Y = (float*)(p.ws + OFF_ST);
  const int wm = w >> 1, wn = w & 1;
  const int nx = xcc_census(xcnt, my_xcc);
  const int nrounds = (nx > 0) ? (64 + nx - 1) / nx : (512 + (int)gridDim.x - 1) / (int)gridDim.x;
  for (int rnd = 0; rnd < nrounds; ++rnd) {
    int mt, nt;
    if (nx > 0) {
      const int s = my_loc + nx * rnd;
      if (s >= 64) continue;
      mt = my_xcc * 8 + (s & 7); nt = s >> 3;
    } else {
      const int tix = rnd * (int)gridDim.x + (int)blockIdx.x;
      if (tix >= 512) continue;
      mt = tix & 63; nt = tix >> 6;
    }
    f16v acc[4][2];
    zero_acc<2>(acc);
    gemm_kloop<2>(acc, Y1 + (size_t)mt * 256 * HP, HP, Wo + (size_t)nt * 128 * WP, WP, 1024, lds);
    const int m0w = mt * 256 + wm * 128;
    const int n0w = nt * 128 + wn * 64;
    float* E = (float*)(lds + GEMM_EOFF) + w * (32 * EP);
    const int prow = l >> 3, c0 = (l & 7) * 8;
#pragma unroll
    for (int i = 0; i < 4; ++i) {
      stage_pair(E, acc[i][0], acc[i][1], l);
#pragma unroll
      for (int ps = 0; ps < 4; ++ps) {
        const int rl = ps * 8 + prow;
        const int row = m0w + i * 32 + rl;
        const f4v a = *(const f4v*)(E + rl * EP + c0), b = *(const f4v*)(E + rl * EP + c0 + 4);
        *(f4v*)(Y + (size_t)row * 1024 + n0w + c0) = a;
        *(f4v*)(Y + (size_t)row * 1024 + n0w + c0 + 4) = b;
      }
    }
  }
}

__device__ void phase_E3(const Params& p, int layer) {
  const int w = otid() >> 6, l = otid() & 63;
  const float* Y = (const float*)(p.ws + OFF_ST);
  const float* MOD = (const float*)(p.ws + OFF_MOD);
  half_t* H = (half_t*)(p.ws + OFF_H);
  const float* xin = (layer == 0) ? p.x : p.out;
  const float* gate = MOD + layer * 3072 + 2048;
  const float* post = p.post_norm + layer * 1024;
  const int stride = gridDim.x * 4;
  int row = blockIdx.x * 4 + w;
  f4v yn[4], xn[4];
  if (row < S_LEN) {
#pragma unroll
    for (int i = 0; i < 4; ++i) {
      yn[i] = *(const f4v*)(Y + (size_t)row * 1024 + i * 256 + l * 4);
      xn[i] = *(const f4v*)(xin + (size_t)row * 1024 + i * 256 + l * 4);
    }
  }
  for (; row < S_LEN; row += stride) {
    float yv[16], xv[16];
    float ss = 0.f;
#pragma unroll
    for (int i = 0; i < 4; ++i)
#pragma unroll
      for (int q = 0; q < 4; ++q) { yv[i * 4 + q] = yn[i][q]; xv[i * 4 + q] = xn[i][q]; ss += yn[i][q] * yn[i][q]; }
    const int nrow = (row + stride < S_LEN) ? (row + stride) : row;
#pragma unroll
    for (int i = 0; i < 4; ++i) {
      yn[i] = *(const f4v*)(Y + (size_t)nrow * 1024 + i * 256 + l * 4);
      xn[i] = *(const f4v*)(xin + (size_t)nrow * 1024 + i * 256 + l * 4);
    }
    ss = wave_sum(ss);
    const float rs = rsqrtf(ss * (1.0f / 1024.0f) + 1e-6f);
#pragma unroll
    for (int i = 0; i < 4; ++i) {
      const int c0 = i * 256 + l * 4;
      f4v gt = *(const f4v*)(gate + c0);
      f4v pn = *(const f4v*)(post + c0);
      f4v o;
#pragma unroll
      for (int q = 0; q < 4; ++q) { o[q] = xv[i * 4 + q] + gt[q] * (yv[i * 4 + q] * rs * pn[q]); xv[i * 4 + q] = o[q]; }
      *(f4v*)(p.out + (size_t)row * 1024 + c0) = o;
    }
    if (layer + 1 < DEPTH)
      write_h_row(xv, p.pre_norm + (layer + 1) * 1024, MOD + (layer + 1) * 3072, H + (size_t)row * HP, l);
  }
}

#define XB_TMO      128
#define XB_XCNT(j)  (256  + 64 * (j))
#define XB_XSUB(j)  (1280 + 64 * (j))
#define XB_XGEN(j)  (2304 + 64 * (j))
#define XB_TOP      3328
#define XB_TOPGEN   3392
#define XCD_BAR_WORDS 3456
#define XB_SPIN_CAP (1u << 18)
#define LAS __attribute__((address_space(3)))

__device__ __forceinline__ unsigned xb_ld(unsigned* p)              { return __hip_atomic_load(p, __ATOMIC_RELAXED, __HIP_MEMORY_SCOPE_AGENT); }
__device__ __forceinline__ unsigned xb_add(unsigned* p, unsigned v) { return __hip_atomic_fetch_add(p, v, __ATOMIC_RELAXED, __HIP_MEMORY_SCOPE_AGENT); }
__device__ __forceinline__ unsigned xb_xcc_id() { return (unsigned)__builtin_amdgcn_s_getreg((3 << 11) | 20) & 0xFu; }
#define XB_SPIN(cond, bar) do { unsigned _sp = 0; while (cond) { __builtin_amdgcn_s_sleep(1); \
    if ((++_sp & 255u) == 0u) { if (xb_ld(&(bar)[XB_TMO])) break; if (_sp > XB_SPIN_CAP) { atomicAdd(&(bar)[XB_TMO], 1u); break; } } } } while (0)

struct XcdBarrier {
    unsigned* bar; unsigned x;
    volatile LAS unsigned* st;
};

__device__ __forceinline__ XcdBarrier xcd_barrier_post(unsigned* bar, volatile LAS unsigned* st) {
    XcdBarrier b; b.bar = bar; b.x = xb_xcc_id(); b.st = st;
    if (otid() == 0) (void)xb_add(&bar[XB_XCNT(b.x)], 1u);
    return b;
}
__device__ __forceinline__ void xcd_barrier_complete(unsigned* bar, unsigned x, unsigned& nloc, unsigned& nx) {
    const unsigned G = gridDim.x * gridDim.y * gridDim.z;
    unsigned sum, cnt, mine, sp = 0u;
    for (;;) {
        sum = 0u; cnt = 0u; mine = 0u;
#pragma unroll
        for (unsigned j = 0; j < 16; ++j) { const unsigned c = xb_ld(&bar[XB_XCNT(j)]); sum += c; cnt += (c > 0u) ? 1u : 0u; mine = (j == x) ? c : mine; }
        if (sum == G) break;
        __builtin_amdgcn_s_sleep(1);
        if ((++sp & 255u) == 0u) { if (xb_ld(&bar[XB_TMO])) break; if (sp > XB_SPIN_CAP) { atomicAdd(&bar[XB_TMO], 1u); break; } }
    }
    nloc = mine > 0u ? mine : 1u; nx = cnt > 0u ? cnt : 1u;
}

__device__ __forceinline__ void xcd_barrier(const XcdBarrier& b) {
    asm volatile("s_waitcnt vmcnt(0)" ::: "memory");
    __syncthreads();
    if (otid() == 0) {
        unsigned* bar = b.bar;
        __builtin_amdgcn_s_waitcnt(0);
        unsigned nloc = b.st[0], nx = b.st[1];
        if (nloc == 0u) { xcd_barrier_complete(bar, b.x, nloc, nx); b.st[0] = nloc; b.st[1] = nx; }
        const unsigned old = xb_add(&bar[XB_XSUB(b.x)], 1u);
        const unsigned gen = old / nloc;
        if (old + 1u == (gen + 1u) * nloc) {
            __builtin_amdgcn_fence(__ATOMIC_RELEASE, "agent");
            asm volatile("s_waitcnt vmcnt(0)" ::: "memory");
            const unsigned og = xb_add(&bar[XB_TOP], 1u);
            const unsigned tg = og / nx;
            if (og + 1u == (tg + 1u) * nx) xb_add(&bar[XB_TOPGEN], 1u);
            else XB_SPIN(xb_ld(&bar[XB_TOPGEN]) == tg, bar);
            __builtin_amdgcn_fence(__ATOMIC_ACQUIRE, "agent");
            xb_add(&bar[XB_XGEN(b.x)], 1u);
            asm volatile("s_waitcnt vmcnt(0)" ::: "memory");
        } else {
            XB_SPIN(xb_ld(&bar[XB_XGEN(b.x)]) == gen, bar);
            __builtin_amdgcn_fence(__ATOMIC_ACQUIRE, "agent");
            asm volatile("s_waitcnt vmcnt(0)" ::: "memory");
        }
    }
    __syncthreads();
}


};

#ifndef REP_D
#define REP_D 1
#endif
#ifndef REP_E
#define REP_E 1
#endif
#ifndef REP_A
#define REP_A 1
#endif
#ifndef REP_B
#define REP_B 1
#endif
#ifdef ONLY_PHASE
#define PH_EN(x) (ONLY_PHASE == (x))
#else
#define PH_EN(x) true
#endif
__global__ void __launch_bounds__(NTHREADS) fwd_megakernel(Params p) {
  extern __shared__ __attribute__((aligned(16))) unsigned char lds[];
  cg::grid_group grid = cg::this_grid();
  K k; k.wbase = __builtin_amdgcn_readfirstlane((int)__builtin_amdgcn_workitem_id_x()) & ~63;
  unsigned* bar = (unsigned*)(p.ws + WS_END);
  unsigned* xcnt = bar + 16;
  unsigned* xbar = (unsigned*)(p.ws + WS_END + 1024);
  if (blockIdx.x == 0) {
    if (k.otid() < 17) __hip_atomic_store(bar + (k.otid() == 16 ? 0 : 16 + k.otid()), 0u, __ATOMIC_RELAXED, __HIP_MEMORY_SCOPE_AGENT);
    for (int i = k.otid(); i < XCD_BAR_WORDS; i += NTHREADS) __hip_atomic_store(xbar + i, 0u, __ATOMIC_RELAXED, __HIP_MEMORY_SCOPE_AGENT);
  }
  volatile LAS unsigned* xst = (volatile LAS unsigned*)(lds + LDS_BYTES - 16);
  if (k.otid() == 0) { xst[0] = 0u; xst[1] = 0u; }
  __syncthreads();
  K::XcdBarrier xb; xb.bar = xbar; xb.x = 0; xb.st = xst;
  int my_xcc = 0, my_loc = 0;
  for (int ph = p.ph_lo; ph < p.ph_hi; ++ph) {
    if (ph == 0) { if (PH_EN(0)) for (int rep = 0; rep < REP_P; ++rep) { k.phase_prologue(p, lds); __syncthreads(); } }
    else if (ph == 1) {
      xb = k.xcd_barrier_post(xbar, xst);
      int* sh = (int*)lds;
      if (k.otid() == 0) {
        const int xc = (int)(__builtin_amdgcn_s_getreg((3 << 11) | 20) & 0xFu);
        sh[0] = xc;
        sh[1] = (int)__hip_atomic_fetch_add(xcnt + xc, 1u, __ATOMIC_RELAXED, __HIP_MEMORY_SCOPE_AGENT);
      }
      __syncthreads();
      my_xcc = __builtin_amdgcn_readfirstlane(sh[0]);
      my_loc = __builtin_amdgcn_readfirstlane(sh[1]);
      __syncthreads();
      if (PH_EN(1)) k.phase_h0(p);
    }
    else {
      const int layer = (ph - 2) / 7, sub = (ph - 2) % 7;
      if (sub == 0) { if (PH_EN(2)) for (int rep = 0; rep < REP_A; ++rep) { k.phase_A(p, layer, lds, my_xcc, my_loc, xcnt); __syncthreads(); } }
      else if (sub == 1) { if (PH_EN(3)) for (int rep = 0; rep < REP_B; ++rep) { k.phase_B(p, layer, lds); __syncthreads(); } }
      else if (sub == 2) { if (PH_EN(4)) k.phase_scan(p); }
      else if (sub == 3) { if (PH_EN(5)) for (int rep = 0; rep < REP_D; ++rep) { for (int it = blockIdx.x; it < 2048; it += gridDim.x) k.la_item_out(p, layer, it, lds); __syncthreads(); } }
      else if (sub == 4) { if (PH_EN(6)) for (int rep = 0; rep < REP_E; ++rep) { k.phase_E1(p, layer, lds, my_xcc, my_loc, xcnt); __syncthreads(); } }
      else if (sub == 5) { if (PH_EN(7)) for (int rep = 0; rep < REP_E; ++rep) { k.phase_E2(p, layer, lds, my_xcc, my_loc, xcnt); __syncthreads(); } }
      else { if (PH_EN(8)) k.phase_E3(p, layer); }
    }
    if (ph + 1 < p.ph_hi) {
      if (ph == p.ph_lo) grid.sync();
      else k.xcd_barrier(xb);
    }
  }
}

extern "C" void kernel_launch(void* const* d_in, const int* in_sizes, int n_in, void* d_out, int out_size,
                              void* d_ws, size_t ws_size, hipStream_t stream) {
  static int grid_blocks = 0;
  if (!grid_blocks) {
    int dev = 0, cus = 0, per_cu = 0;
    hipGetDevice(&dev);
    hipDeviceGetAttribute(&cus, hipDeviceAttributeMultiprocessorCount, dev);
    hipFuncSetAttribute((const void*)fwd_megakernel, hipFuncAttributeMaxDynamicSharedMemorySize, LDS_BYTES);
    hipOccupancyMaxActiveBlocksPerMultiprocessor(&per_cu, (const void*)fwd_megakernel, NTHREADS, LDS_BYTES);
    if (per_cu < 1) per_cu = 1;
    if (per_cu > 1) per_cu = 1;
    grid_blocks = cus * per_cu;
    if (ws_size < WS_END) fprintf(stderr, "workspace too small: %zu < %llu\n", ws_size, (unsigned long long)WS_END);
  }
  Params p{};
  p.x = (const float*)d_in[0]; p.c = (const float*)d_in[1]; p.pos = (const int*)d_in[2];
  p.ada_w = (const float*)d_in[3]; p.ada_b = (const float*)d_in[4];
  p.pre_norm = (const float*)d_in[5]; p.post_norm = (const float*)d_in[6];
  p.w_in = (const float*)d_in[7]; p.gla_w_lr = (const float*)d_in[8]; p.gla_b_lr = (const float*)d_in[9];
  p.w_br_ret = (const float*)d_in[10]; p.w_br_dsa = (const float*)d_in[11]; p.w_br_gla = (const float*)d_in[12];
  p.w_out = (const float*)d_in[13];
  p.out = (float*)d_out; p.ws = (unsigned char*)d_ws;
  p.ph_lo = 0; p.ph_hi = 2 + 7 * DEPTH;
  void* args[] = {&p};
  hipError_t e = hipLaunchCooperativeKernel((const void*)fwd_megakernel, dim3(grid_blocks), dim3(NTHREADS), args, LDS_BYTES, stream);
  if (e != hipSuccess) fprintf(stderr, "cooperative launch failed: %s (grid %d)\n", hipGetErrorString(e), grid_blocks);
}
```

```cpp
#include <hip/hip_runtime.h>
#include <hip/hip_cooperative_groups.h>
#include <stdint.h>
#include <cstdio>
namespace cg = cooperative_groups;
#ifndef REP_P
#define REP_P 1
#endif
#ifndef REP_KV
#define REP_KV 1
#endif
#ifndef REP_SEL
#define REP_SEL 1
#endif
#ifndef REP_ATT
#define REP_ATT 1
#endif

typedef _Float16 half_t;
typedef _Float16 h8 __attribute__((ext_vector_type(8)));
typedef _Float16 h4 __attribute__((ext_vector_type(4)));
typedef _Float16 h2 __attribute__((ext_vector_type(2)));
typedef float f16v __attribute__((ext_vector_type(16)));
typedef float f4v __attribute__((ext_vector_type(4)));

#define S_LEN 16384
#define DM 1024
#define NIN 7764
#define NPAD 7936
#define PP 7808
#define DEPTH 4
#define NTHREADS 256
#define HP 1088
#define WP 1088
#define WBP 576
#define LDS_BYTES 152704

#define C_RETQ 0
#define C_RETK 256
#define C_RETV 512
#define C_RETG 1024
#define C_DSAQ 1536
#define C_DSAK 2048
#define C_DSAV 2176
#define C_DSAG 2304
#define C_IDXQ 2816
#define C_IDXK 3072
#define C_GLAQ 3136
#define C_GLAK 3392
#define C_GLAV 3648
#define C_GLAG 4160
#define C_GLAA 4672
#define C_MRG 4688
#define C_END 7760
#define C_IDXW 7760

#define OFF_WINT 0ull
#define OFF_WBRT (OFF_WINT + 4ull * NPAD * WP * 2)
#define OFF_WOUTT (OFF_WBRT + 4ull * 3 * 1024 * WBP * 2)
#define OFF_MOD (OFF_WOUTT + 4ull * 1024 * WP * 2)
#define OFF_RT (OFF_MOD + 4ull * 3072 * 4)
#define OFF_DT (OFF_RT + 16384ull * 64 * 4)
#define OFF_H (OFF_DT + 16384ull * 16 * 4)
#define OFF_P (OFF_H + 16384ull * HP * 2)
#define OFF_GA (OFF_P + 16384ull * PP * 2)
#define OFF_IW (OFF_GA + 16384ull * 16 * 4)
#define OFF_ST (OFF_IW + 16384ull * 4 * 4)
#define OFF_DEC (OFF_ST + 256ull * 65536 * 4)
#define OFF_BR (OFF_DEC + 256ull * 8 * 64 * 4)
#define WS_END (OFF_BR + 16384ull * 1536 * 2)
static_assert(WS_END + 16384 <= 508821504ull, "workspace too large");

struct Params {
  const float* x; const float* c; const int* pos; const float* ada_w; const float* ada_b;
  const float* pre_norm; const float* post_norm; const float* w_in; const float* gla_w_lr;
  const float* gla_b_lr; const float* w_br_ret; const float* w_br_dsa; const float* w_br_gla;
  const float* w_out; float* out; unsigned char* ws;
  int ph_lo; int ph_hi;
};

struct K {
int wbase;
__device__ __forceinline__ int otid() const {
  int lane;
  asm volatile("v_mbcnt_lo_u32_b32 %0, -1, 0\n\tv_mbcnt_hi_u32_b32 %0, -1, %0" : "=v"(lane));
  return wbase | lane;
}
__device__ __forceinline__ static float ozero() { float z = 0.f; asm volatile("" : "+v"(z)); return z; }
template <int CTRL>
__device__ __forceinline__ float dppf(float v) {
  return __int_as_float(__builtin_amdgcn_update_dpp(0, __float_as_int(v), CTRL, 0xF, 0xF, true));
}
template <int CTRL>
__device__ __forceinline__ unsigned dppu(unsigned v) {
  return (unsigned)__builtin_amdgcn_update_dpp(0, (int)v, CTRL, 0xF, 0xF, true);
}
__device__ __forceinline__ int olane() { return otid() & 63; }
__device__ __forceinline__ float xor16f(float v) { return __int_as_float(__builtin_amdgcn_ds_bpermute((olane() ^ 16) << 2, __float_as_int(v))); }
__device__ __forceinline__ float xor32f(float v) { return __int_as_float(__builtin_amdgcn_ds_bpermute((olane() ^ 32) << 2, __float_as_int(v))); }
__device__ __forceinline__ unsigned xor16u(unsigned v) { return (unsigned)__builtin_amdgcn_ds_bpermute((olane() ^ 16) << 2, (int)v); }
__device__ __forceinline__ unsigned xor32u(unsigned v) { return (unsigned)__builtin_amdgcn_ds_bpermute((olane() ^ 32) << 2, (int)v); }
__device__ __forceinline__ float rl_f(float v, int lane) { return __int_as_float(__builtin_amdgcn_readlane(__float_as_int(v), lane)); }
__device__ __forceinline__ float wave_sum(float v) {
  v += dppf<0xB1>(v); v += dppf<0x4E>(v); v += dppf<0x141>(v); v += dppf<0x140>(v);
  return (rl_f(v, 0) + rl_f(v, 16)) + (rl_f(v, 32) + rl_f(v, 48));
}
__device__ __forceinline__ float wave_max(float v) {
  v = fmaxf(v, dppf<0xB1>(v)); v = fmaxf(v, dppf<0x4E>(v)); v = fmaxf(v, dppf<0x141>(v)); v = fmaxf(v, dppf<0x140>(v));
  return fmaxf(fmaxf(rl_f(v, 0), rl_f(v, 16)), fmaxf(rl_f(v, 32), rl_f(v, 48)));
}
__device__ __forceinline__ unsigned wave_or(unsigned v) {
  v |= dppu<0xB1>(v); v |= dppu<0x4E>(v); v |= dppu<0x141>(v); v |= dppu<0x140>(v);
  return (unsigned)(__builtin_amdgcn_readlane((int)v, 0) | __builtin_amdgcn_readlane((int)v, 16) | __builtin_amdgcn_readlane((int)v, 32) | __builtin_amdgcn_readlane((int)v, 48));
}
__device__ __forceinline__ unsigned wave_incl_scan(unsigned v) {
  v += (unsigned)__builtin_amdgcn_update_dpp(0, (int)v, 0x111, 0xF, 0xF, false);
  v += (unsigned)__builtin_amdgcn_update_dpp(0, (int)v, 0x112, 0xF, 0xF, false);
  v += (unsigned)__builtin_amdgcn_update_dpp(0, (int)v, 0x114, 0xF, 0xF, false);
  v += (unsigned)__builtin_amdgcn_update_dpp(0, (int)v, 0x118, 0xF, 0xF, false);
  v += (unsigned)__builtin_amdgcn_update_dpp(0, (int)v, 0x142, 0xA, 0xF, false);
  v += (unsigned)__builtin_amdgcn_update_dpp(0, (int)v, 0x143, 0xC, 0xF, false);
  return v;
}
__device__ __forceinline__ f16v mfma16(h8 a, h8 b, f16v c) {
  return __builtin_amdgcn_mfma_f32_32x32x16_f16(a, b, c, 0, 0, 0);
}
__device__ __forceinline__ float relu_f(float x) { return __int_as_float(max(__float_as_int(x), 0)); }
__device__ __forceinline__ int crow(int r, int l) { return (r & 3) + 8 * (r >> 2) + 4 * (l >> 5); }

__device__ __forceinline__ int win_col(int nv) {
  if (nv < 3136) return nv;
  if (nv < 7760) return nv + 4;
  if (nv < 7764) return nv - 7760 + 3136;
  return -1;
}
__device__ void transpose_tile(const float* __restrict__ src, int ldn, half_t* __restrict__ dst, int K,
                               int k0, int n0, int mapmode, unsigned char* lds) {
  float* T = (float*)lds;
  const int tid = otid();
  const int nn = tid & 63;
  int col = n0 + nn;
  if (mapmode) col = win_col(col);
#pragma unroll
  for (int i = 0; i < 16; ++i) {
    int kk = (tid >> 6) + 4 * i;
    float v = 0.f;
    if (col >= 0) v = src[(size_t)(k0 + kk) * ldn + col];
    T[kk * 65 + nn] = v;
  }
  __syncthreads();
#pragma unroll
  for (int i = 0; i < 2; ++i) {
    int n2 = (tid >> 3) + 32 * i;
    int kc = tid & 7;
    h8 o;
#pragma unroll
    for (int q = 0; q < 8; ++q) o[q] = (half_t)T[(kc * 8 + q) * 65 + n2];
    *(h8*)(dst + (size_t)(n0 + n2) * K + k0 + kc * 8) = o;
  }
  __syncthreads();
}

__device__ void phase_prologue(const Params& p, unsigned char* lds) {
  const int tid = otid();
  half_t* WinT = (half_t*)(p.ws + OFF_WINT);
  half_t* WbrT = (half_t*)(p.ws + OFF_WBRT);
  half_t* WoutT = (half_t*)(p.ws + OFF_WOUTT);
  float* MOD = (float*)(p.ws + OFF_MOD);
  float* RT = (float*)(p.ws + OFF_RT);
  float* DT = (float*)(p.ws + OFF_DT);
  const int T_WIN = 4 * 124 * 16;
  const int T_WBR = 12 * 16 * 8;
  const int T_WOUT = 4 * 16 * 16;
  const int T_MOD = 192;
  const int T_ROPE = 16384 * 40 / 256;
  const int total = T_WIN + T_WBR + T_WOUT + T_MOD + T_ROPE;
  {
    float* T = (float*)lds;
    const int nn = tid & 63;
    float cur[16], nxt[16];
    int task = blockIdx.x;
    if (task < T_WIN) {
      const int l = task / (124 * 16), r = task % (124 * 16), nt = r / 16, kt = r % 16;
      const int col = win_col(nt * 64 + nn);
      const float* src = p.w_in + (size_t)l * 1024 * NIN;
#pragma unroll
      for (int i = 0; i < 16; ++i) { const int kk = (tid >> 6) + 4 * i; cur[i] = (col >= 0) ? src[(size_t)(kt * 64 + kk) * NIN + col] : 0.f; }
    }
    for (; task < T_WIN; task += gridDim.x) {
      const int tn = (task + (int)gridDim.x < T_WIN) ? task + (int)gridDim.x : task;
      {
        const int l = tn / (124 * 16), r = tn % (124 * 16), nt = r / 16, kt = r % 16;
        const int col = win_col(nt * 64 + nn);
        const float* src = p.w_in + (size_t)l * 1024 * NIN;
#pragma unroll
        for (int i = 0; i < 16; ++i) { const int kk = (tid >> 6) + 4 * i; nxt[i] = (col >= 0) ? src[(size_t)(kt * 64 + kk) * NIN + col] : 0.f; }
      }
      const int l = task / (124 * 16), r = task % (124 * 16), nt = r / 16, kt = r % 16;
      half_t* dst = WinT + (size_t)l * NPAD * WP;
#pragma unroll
      for (int i = 0; i < 16; ++i) T[((tid >> 6) + 4 * i) * 65 + nn] = cur[i];
      __syncthreads();
#pragma unroll
      for (int i = 0; i < 2; ++i) {
        const int n2 = (tid >> 3) + 32 * i, kc = tid & 7;
        h8 o;
#pragma unroll
        for (int q = 0; q < 8; ++q) o[q] = (half_t)T[(kc * 8 + q) * 65 + n2];
        *(h8*)(dst + (size_t)(nt * 64 + n2) * WP + kt * 64 + kc * 8) = o;
      }
      __syncthreads();
#pragma unroll
      for (int i = 0; i < 16; ++i) cur[i] = nxt[i];
    }
  }
  for (int task = blockIdx.x; task < total; task += gridDim.x) {
    int t = task;
    if (t < T_WIN) continue;
    if (t < T_WIN) {
      int l = t / (124 * 16); int r = t % (124 * 16); int nt = r / 16, kt = r % 16;
      transpose_tile(p.w_in + (size_t)l * 1024 * NIN, NIN, WinT + (size_t)l * NPAD * WP, WP, kt * 64, nt * 64, 1, lds);
      continue;
    }
    t -= T_WIN;
    if (t < T_WBR) {
      int lb = t / 128; int r = t % 128; int nt = r / 8, kt = r % 8;
      int l = lb / 3, b = lb % 3;
      const float* src = (b == 0 ? p.w_br_ret : (b == 1 ? p.w_br_dsa : p.w_br_gla)) + (size_t)l * 512 * 1024;
      transpose_tile(src, 1024, WbrT + (size_t)lb * 1024 * WBP, WBP, kt * 64, nt * 64, 0, lds);
      continue;
    }
    t -= T_WBR;
    if (t < T_WOUT) {
      int l = t / 256; int r = t % 256; int nt = r / 16, kt = r % 16;
      transpose_tile(p.w_out + (size_t)l * 1024 * 1024, 1024, WoutT + (size_t)l * 1024 * WP, WP, kt * 64, nt * 64, 0, lds);
      continue;
    }
    t -= T_WOUT;
    if (t < T_MOD) {
      int l = t / 48, jb = t % 48;
      int j = jb * 64 + (tid & 63);
      int ig = tid >> 6;
      float acc = 0.f;
      const float* aw = p.ada_w + (size_t)l * 1024 * 3072;
      for (int i = ig * 256; i < ig * 256 + 256; ++i) {
        float cv = p.c[i];
        float sc = cv / (1.f + expf(-cv));
        acc += sc * aw[(size_t)i * 3072 + j];
      }
      float* red = (float*)lds;
      red[tid] = acc;
      __syncthreads();
      if (tid < 64) {
        float s = red[tid] + red[tid + 64] + red[tid + 128] + red[tid + 192];
        MOD[l * 3072 + j] = s + p.ada_b[l * 3072 + j];
      }
      __syncthreads();
      continue;
    }
    t -= T_MOD;
    {
      int e = t * 256 + tid;
      int tok = e / 40, f = e % 40;
      float pf = (float)p.pos[tok];
      if (f < 32) {
        float fr = powf(10000.0f, -(float)f * 2.0f / 64.0f);
        float ang = pf * fr;
        RT[tok * 64 + f * 2] = cosf(ang);
        RT[tok * 64 + f * 2 + 1] = sinf(ang);
      } else {
        int g = f - 32;
        float fr = powf(500000.0f, -(float)g * 2.0f / 16.0f);
        float ang = pf * fr;
        DT[tok * 16 + g * 2] = cosf(ang);
        DT[tok * 16 + g * 2 + 1] = sinf(ang);
      }
    }
  }
}

__device__ __forceinline__ void write_h_row(const float (&xv)[16], const float* __restrict__ pre,
                                            const float* __restrict__ mod, half_t* __restrict__ hrow, int l) {
  float ss = 0.f;
#pragma unroll
  for (int i = 0; i < 16; ++i) ss += xv[i] * xv[i];
  ss = wave_sum(ss);
  float rs = rsqrtf(ss * (1.0f / 1024.0f) + 1e-6f);
#pragma unroll
  for (int i = 0; i < 4; ++i) {
    int c0 = i * 256 + l * 4;
    f4v pg = *(const f4v*)(pre + c0);
    f4v sh = *(const f4v*)(mod + c0);
    f4v sc = *(const f4v*)(mod + 1024 + c0);
    h4 o;
#pragma unroll
    for (int q = 0; q < 4; ++q) o[q] = (half_t)(xv[i * 4 + q] * rs * pg[q] * (1.f + sc[q]) + sh[q]);
    *(h4*)(hrow + c0) = o;
  }
}

__device__ void phase_h0(const Params& p) {
  const int w = otid() >> 6, l = otid() & 63;
  half_t* H = (half_t*)(p.ws + OFF_H);
  const float* MOD = (const float*)(p.ws + OFF_MOD);
  for (int row = blockIdx.x * 4 + w; row < S_LEN; row += gridDim.x * 4) {
    float xv[16];
#pragma unroll
    for (int i = 0; i < 4; ++i) {
      f4v v = *(const f4v*)(p.x + (size_t)row * 1024 + i * 256 + l * 4);
      xv[i * 4] = v[0]; xv[i * 4 + 1] = v[1]; xv[i * 4 + 2] = v[2]; xv[i * 4 + 3] = v[3];
    }
    write_h_row(xv, p.pre_norm, MOD, H + (size_t)row * HP, l);
  }
}

__device__ __forceinline__ void lds_barrier() {
  asm volatile("s_waitcnt lgkmcnt(0)" ::: "memory");
  __builtin_amdgcn_s_barrier();
  asm volatile("" ::: "memory");
}
#define GEMM_BUF 55296
#define GEMM_EOFF 110592
template <int NT>
__device__ __forceinline__ void gemm_step(f16v (&acc)[4][NT], h8 (&ra)[8], h8 (&rb)[2 * NT],
                                          const unsigned char* As, const unsigned char* Bs, unsigned char* Aw, unsigned char* Bw,
                                          const half_t* __restrict__ A, int lda, const half_t* __restrict__ B, int ldb, int kload,
                                          int wm, int wn, int l, int r0, int kc) {
  h8 af[2][4], bf[2][NT];
#pragma unroll
  for (int i = 0; i < 4; ++i) af[0][i] = *(const h8*)(As + (wm * 128 + i * 32 + (l & 31)) * 144 + (l >> 5) * 16);
#pragma unroll
  for (int j = 0; j < NT; ++j) bf[0][j] = *(const h8*)(Bs + (wn * 32 * NT + j * 32 + (l & 31)) * 144 + (l >> 5) * 16);
#pragma unroll
  for (int ks = 0; ks < 4; ++ks) {
    if (ks < 3) {
#pragma unroll
      for (int i = 0; i < 4; ++i) af[(ks + 1) & 1][i] = *(const h8*)(As + (wm * 128 + i * 32 + (l & 31)) * 144 + (ks + 1) * 32 + (l >> 5) * 16);
#pragma unroll
      for (int j = 0; j < NT; ++j) bf[(ks + 1) & 1][j] = *(const h8*)(Bs + (wn * 32 * NT + j * 32 + (l & 31)) * 144 + (ks + 1) * 32 + (l >> 5) * 16);
    }
    __builtin_amdgcn_sched_barrier(0);
#pragma unroll
    for (int i = 0; i < 4; ++i)
#pragma unroll
      for (int j = 0; j < NT; ++j) acc[i][j] = mfma16(af[ks & 1][i], bf[ks & 1][j], acc[i][j]);
#pragma unroll
    for (int i = 2 * ks; i < 2 * ks + 2; ++i) {
      *(h8*)(Aw + (r0 + 32 * i) * 144 + kc * 16) = ra[i];
      ra[i] = *(const h8*)(A + (size_t)(r0 + 32 * i) * lda + kload + kc * 8);
    }
    if (NT == 2) {
      *(h8*)(Bw + (r0 + 32 * ks) * 144 + kc * 16) = rb[ks];
      rb[ks] = *(const h8*)(B + (size_t)(r0 + 32 * ks) * ldb + kload + kc * 8);
    } else {
#pragma unroll
      for (int i = 2 * ks; i < 2 * ks + 2; ++i) {
        *(h8*)(Bw + (r0 + 32 * i) * 144 + kc * 16) = rb[i];
        rb[i] = *(const h8*)(B + (size_t)(r0 + 32 * i) * ldb + kload + kc * 8);
      }
    }
    __builtin_amdgcn_sched_barrier(0);
  }
}
template <int NT>
__device__ __forceinline__ void gemm_issue(h8 (&ra0)[8], h8 (&rb0)[2 * NT], h8 (&ra1)[8], h8 (&rb1)[2 * NT],
                                           const half_t* __restrict__ A, int lda, const half_t* __restrict__ B, int ldb) {
  const int tid = otid();
  const int kc = tid & 7, r0 = tid >> 3;
#pragma unroll
  for (int i = 0; i < 8; ++i) ra0[i] = *(const h8*)(A + (size_t)(r0 + 32 * i) * lda + kc * 8);
#pragma unroll
  for (int i = 0; i < 2 * NT; ++i) rb0[i] = *(const h8*)(B + (size_t)(r0 + 32 * i) * ldb + kc * 8);
#pragma unroll
  for (int i = 0; i < 8; ++i) ra1[i] = *(const h8*)(A + (size_t)(r0 + 32 * i) * lda + 64 + kc * 8);
#pragma unroll
  for (int i = 0; i < 2 * NT; ++i) rb1[i] = *(const h8*)(B + (size_t)(r0 + 32 * i) * ldb + 64 + kc * 8);
}
template <int NT>
__device__ __forceinline__ void gemm_run(f16v (&acc)[4][NT], h8 (&ra0)[8], h8 (&rb0)[2 * NT], h8 (&ra1)[8], h8 (&rb1)[2 * NT],
                                         const half_t* __restrict__ A, int lda, const half_t* __restrict__ B, int ldb, int K, unsigned char* lds) {
  const int tid = otid(), w = tid >> 6, l = tid & 63;
  constexpr int STAGE = 256 * 144 + 64 * NT * 144;
  unsigned char* A0 = lds;
  unsigned char* B0 = lds + 256 * 144;
  unsigned char* A1 = lds + STAGE;
  unsigned char* B1 = lds + STAGE + 256 * 144;
  const int wm = w >> 1, wn = w & 1;
  const int kc = tid & 7;
  const int r0 = tid >> 3;
  lds_barrier();
#pragma unroll
  for (int i = 0; i < 8; ++i) { *(h8*)(A0 + (r0 + 32 * i) * 144 + kc * 16) = ra0[i]; ra0[i] = *(const h8*)(A + (size_t)(r0 + 32 * i) * lda + 128 + kc * 8); }
#pragma unroll
  for (int i = 0; i < 2 * NT; ++i) { *(h8*)(B0 + (r0 + 32 * i) * 144 + kc * 16) = rb0[i]; rb0[i] = *(const h8*)(B + (size_t)(r0 + 32 * i) * ldb + 128 + kc * 8); }
  lds_barrier();
  const int nk = K / 64;
#pragma unroll 1
  for (int kt = 0; kt < nk; kt += 2) {
    gemm_step<NT>(acc, ra1, rb1, A0, B0, A1, B1, A, lda, B, ldb, (kt + 3 < nk) ? (kt + 3) * 64 : 0, wm, wn, l, r0, kc);
    lds_barrier();
    gemm_step<NT>(acc, ra0, rb0, A1, B1, A0, B0, A, lda, B, ldb, (kt + 4 < nk) ? (kt + 4) * 64 : 0, wm, wn, l, r0, kc);
    lds_barrier();
  }
}
template <int NT>
__device__ __forceinline__ void gemm_kloop(f16v (&acc)[4][NT], const half_t* __restrict__ A, int lda,
                                           const half_t* __restrict__ B, int ldb, int K, unsigned char* lds) {
  h8 ra0[8], rb0[2 * NT], ra1[8], rb1[2 * NT];
  gemm_issue<NT>(ra0, rb0, ra1, rb1, A, lda, B, ldb);
  gemm_run<NT>(acc, ra0, rb0, ra1, rb1, A, lda, B, ldb, K, lds);
}

template <int NT>
__device__ __forceinline__ void gemm_issue1(h8 (&ra)[8], h8 (&rb)[2 * NT], const half_t* __restrict__ A, int lda, const half_t* __restrict__ B, int ldb) {
  const int tid = otid();
  const int kc = tid & 7, r0 = tid >> 3;
#pragma unroll
  for (int i = 0; i < 8; ++i) ra[i] = *(const h8*)(A + (size_t)(r0 + 32 * i) * lda + kc * 8);
#pragma unroll
  for (int i = 0; i < 2 * NT; ++i) rb[i] = *(const h8*)(B + (size_t)(r0 + 32 * i) * ldb + kc * 8);
}
template <int NT>
__device__ __forceinline__ void gemm_run1(f16v (&acc)[4][NT], h8 (&ra)[8], h8 (&rb)[2 * NT],
                                          const half_t* __restrict__ A, int lda, const half_t* __restrict__ B, int ldb, int K, unsigned char* lds) {
  const int tid = otid(), w = tid >> 6, l = tid & 63;
  constexpr int STAGE = 256 * 144 + 64 * NT * 144;
  const int wm = w >> 1, wn = w & 1;
  const int kc = tid & 7;
  const int r0 = tid >> 3;
  lds_barrier();
#pragma unroll
  for (int i = 0; i < 8; ++i) { *(h8*)(lds + (r0 + 32 * i) * 144 + kc * 16) = ra[i]; ra[i] = *(const h8*)(A + (size_t)(r0 + 32 * i) * lda + 64 + kc * 8); }
#pragma unroll
  for (int i = 0; i < 2 * NT; ++i) { *(h8*)(lds + 256 * 144 + (r0 + 32 * i) * 144 + kc * 16) = rb[i]; rb[i] = *(const h8*)(B + (size_t)(r0 + 32 * i) * ldb + 64 + kc * 8); }
  lds_barrier();
  const int nk = K / 64;
#pragma unroll 1
  for (int kt = 0; kt < nk; ++kt) {
    unsigned char* cur = lds + (kt & 1) * STAGE;
    unsigned char* nxt = lds + ((kt + 1) & 1) * STAGE;
    gemm_step<NT>(acc, ra, rb, cur, cur + 256 * 144, nxt, nxt + 256 * 144, A, lda, B, ldb, (kt + 2 < nk) ? (kt + 2) * 64 : 0, wm, wn, l, r0, kc);
    lds_barrier();
  }
}

template <int NT>
__device__ __forceinline__ void zero_acc(f16v (&acc)[4][NT]) {
  float z = 0.f;
  asm volatile("" : "+v"(z));
#pragma unroll
  for (int i = 0; i < 4; ++i)
#pragma unroll
    for (int j = 0; j < NT; ++j)
#pragma unroll
      for (int r = 0; r < 16; ++r) acc[i][j][r] = z;
}

#define EP 68
__device__ __forceinline__ void stage_pair(float* E, const f16v& a0, const f16v& a1, int l) {
#pragma unroll
  for (int r = 0; r < 16; ++r) {
    const int rr = crow(r, l);
    E[rr * EP + (l & 31)] = a0[r];
    E[rr * EP + 32 + (l & 31)] = a1[r];
  }
}
__device__ __forceinline__ void ld8(const float* p, float (&v)[8]) {
  const f4v a = *(const f4v*)p, b = *(const f4v*)(p + 4);
  v[0] = a[0]; v[1] = a[1]; v[2] = a[2]; v[3] = a[3]; v[4] = b[0]; v[5] = b[1]; v[6] = b[2]; v[7] = b[3];
}
__device__ __forceinline__ int xcc_census(const unsigned* xcnt, int my_xcc) {
  unsigned sum = 0; bool ok = my_xcc < 8; int mine = 0;
#pragma unroll
  for (int j = 0; j < 16; ++j) {
    const unsigned c = __hip_atomic_load(xcnt + j, __ATOMIC_RELAXED, __HIP_MEMORY_SCOPE_AGENT);
    sum += c;
    if (j < 8 && c == 0u) ok = false;
    if (j >= 8 && c != 0u) ok = false;
    if (j == my_xcc) mine = (int)c;
  }
  if (sum != gridDim.x) ok = false;
  return ok ? mine : 0;
}

__device__ void phase_A(const Params& p, int layer, unsigned char* lds, int my_xcc, int my_loc, const unsigned* xcnt) {
  const int tid = otid(), w = tid >> 6, l = tid & 63;
  const half_t* H = (const half_t*)(p.ws + OFF_H);
  const half_t* Wt = (const half_t*)(p.ws + OFF_WINT) + (size_t)layer * NPAD * WP;
  half_t* P = (half_t*)(p.ws + OFF_P);
  float* GA = (float*)(p.ws + OFF_GA);
  float* IW = (float*)(p.ws + OFF_IW);
  const float* RT = (const float*)(p.ws + OFF_RT);
  const float* DT = (const float*)(p.ws + OFF_DT);
  const int wm = w >> 1, wn = w & 1;
  const int G = gridDim.x;
  const int ntiles = 64 * 31;
  const int nx = xcc_census(xcnt, my_xcc);
  int nmine;
  if (nx > 0) nmine = (my_loc < 248) ? (248 - my_loc + nx - 1) / nx : 0;
  else nmine = ((int)blockIdx.x < ntiles) ? (ntiles - (int)blockIdx.x + G - 1) / G : 0;
  h8 ra0[8], rb0[8];
  int mt = 0, nt = 0;
  if (nmine > 0) {
    if (nx > 0) { const int s0 = my_loc; mt = my_xcc * 8 + (s0 & 7); nt = s0 >> 3; }
    else { const int tix = blockIdx.x; mt = tix & 63; nt = tix >> 6; }
    gemm_issue1<4>(ra0, rb0, H + (size_t)mt * 256 * HP, HP, Wt + (size_t)nt * 256 * WP, WP);
  }
#pragma unroll 1
  for (int rnd = 0; rnd < nmine; ++rnd) {
    f16v acc[4][4];
    zero_acc<4>(acc);
    gemm_run1<4>(acc, ra0, rb0, H + (size_t)mt * 256 * HP, HP, Wt + (size_t)nt * 256 * WP, WP, 1024, lds);
    const int mt_cur = mt, nt_cur = nt;
    if (rnd + 1 < nmine) {
      if (nx > 0) { const int s1 = my_loc + nx * (rnd + 1); mt = my_xcc * 8 + (s1 & 7); nt = s1 >> 3; }
      else { const int tix = (rnd + 1) * G + blockIdx.x; mt = tix & 63; nt = tix >> 6; }
      gemm_issue1<4>(ra0, rb0, H + (size_t)mt * 256 * HP, HP, Wt + (size_t)nt * 256 * WP, WP);
    }
    const int m0w = mt_cur * 256 + wm * 128;
    const int n0w = nt_cur * 256 + wn * 128;
    float* E = (float*)(lds) + w * (32 * EP);
    const int prow = l >> 3, c0 = (l & 7) * 8;
#pragma unroll
    for (int jp = 0; jp < 2; ++jp) {
      const int nb2 = n0w + jp * 64;
      const int n0 = nb2 + c0;
      const bool rope64 = nb2 < 512;
      const bool rope16 = ((nb2 >= C_DSAQ && nb2 < C_DSAV) || (nb2 >= C_IDXQ && nb2 < C_GLAQ)) && (c0 < 16);
      float scale = 1.f;
      if (n0 < 256 || (n0 >= C_DSAQ && n0 < C_DSAK) || (n0 >= C_IDXQ && n0 < C_IDXK) || (n0 >= C_GLAQ && n0 < C_GLAK)) scale = 0.125f;
      int mode = 0;
      if ((n0 >= C_RETG && n0 < C_DSAQ) || (n0 >= C_DSAG && n0 < C_IDXQ) || (n0 >= C_GLAG && n0 < C_GLAA)) mode = 1;
      if (n0 >= C_MRG && n0 < C_END) mode = 2;
#pragma unroll
      for (int i = 0; i < 4; ++i) {
        stage_pair(E, acc[i][2 * jp], acc[i][2 * jp + 1], l);
#pragma unroll 2
        for (int ps = 0; ps < 4; ++ps) {
          const int rl = ps * 8 + prow;
          const int row = m0w + i * 32 + rl;
          float v[8], o[8];
          ld8(E + rl * EP + c0, v);
#pragma unroll
          for (int q = 0; q < 8; ++q) o[q] = v[q];
          if (rope64) {
            float pv[8], tb[16];
            ld8(E + rl * EP + (c0 ^ 32), pv);
            const float* tp = RT + (size_t)row * 64 + (c0 & 31) * 2;
            ld8(tp, *(float(*)[8])&tb[0]); ld8(tp + 8, *(float(*)[8])&tb[8]);
#pragma unroll
            for (int q = 0; q < 8; ++q) o[q] = (c0 < 32) ? (v[q] * tb[2 * q] - pv[q] * tb[2 * q + 1]) : (v[q] * tb[2 * q] + pv[q] * tb[2 * q + 1]);
          } else if (rope16) {
            float pv[8], tb[16];
            ld8(E + rl * EP + (c0 ^ 8), pv);
            const float* tp = DT + (size_t)row * 16;
            ld8(tp, *(float(*)[8])&tb[0]); ld8(tp + 8, *(float(*)[8])&tb[8]);
#pragma unroll
            for (int q = 0; q < 8; ++q) o[q] = (c0 < 8) ? (v[q] * tb[2 * q] - pv[q] * tb[2 * q + 1]) : (v[q] * tb[2 * q] + pv[q] * tb[2 * q + 1]);
          }
          h8 ov;
#pragma unroll
          for (int q = 0; q < 8; ++q) {
            float t = o[q] * scale;
            if (mode != 0) {
              const float sg = __builtin_amdgcn_rcpf(1.f + __expf(-t));
              t = (mode == 1) ? t * sg : sg;
            }
            ov[q] = (half_t)t;
          }
          if (n0 < C_END) __builtin_nontemporal_store(ov, (h8*)(P + (size_t)row * PP + n0));
          if (n0 >= C_GLAA && n0 < C_MRG) {
#pragma unroll
            for (int q = 0; q < 8; ++q) GA[(size_t)row * 16 + (n0 - C_GLAA) + q] = v[q];
          }
          if (n0 == C_IDXW) {
#pragma unroll
            for (int q = 0; q < 4; ++q) IW[(size_t)row * 4 + q] = 0.5f * v[q];
          }
        }
      }
    }
  }
}

#define LA_BC 0
#define LA_GAS 16640
#define LA_WL 20736
#define LA_QT 24832
#define LA_KT 34048
#define LA_AT 43264
#define LA_VT 52480
#define LA_SS 70912
#define LA_OS 89344
#define LA_SEG 123136

__device__ void la_bcum(const Params& p, int layer, int n, int Hh, unsigned char* lds) {
  const int tid = otid();
  float* Bc = (float*)(lds + LA_BC);
  const int d = tid & 63, q = tid >> 6;
  if (Hh < 4) {
    float lg = log1pf(-exp2f(-5.0f - (float)Hh));
#pragma unroll
    for (int jj = 0; jj < 16; ++jj) { int j = q * 16 + jj; Bc[j * 65 + d] = (float)(j + 1) * lg; }
    __syncthreads();
    return;
  }
  const int h = Hh - 4;
  float* GAs = (float*)(lds + LA_GAS);
  float* WL = (float*)(lds + LA_WL);
  float* SEG = (float*)(lds + LA_SEG);
  const float* GA = (const float*)(p.ws + OFF_GA);
#pragma unroll
  for (int i = 0; i < 4; ++i) {
    int e = tid + 256 * i;
    GAs[e] = GA[(size_t)n * 64 * 16 + e];
    int r = e >> 6, dd = e & 63;
    WL[e] = p.gla_w_lr[(size_t)layer * 16 * 256 + r * 256 + h * 64 + dd];
  }
  __syncthreads();
  float wl[16];
#pragma unroll
  for (int r = 0; r < 16; ++r) wl[r] = WL[r * 64 + d];
  const float bl = p.gla_b_lr[layer * 256 + h * 64 + d];
  float run = 0.f;
#pragma unroll
  for (int jj = 0; jj < 16; ++jj) {
    int j = q * 16 + jj;
    float z = bl;
#pragma unroll
    for (int r = 0; r < 16; ++r) z += GAs[j * 16 + r] * wl[r];
    float ls = fminf(z, 0.f) - __logf(1.f + __expf(-fabsf(z)));
    run += ls * (1.0f / 16.0f);
    Bc[j * 65 + d] = run;
  }
  SEG[q * 64 + d] = run;
  __syncthreads();
  float off = 0.f;
  for (int qq = 0; qq < q; ++qq) off += SEG[qq * 64 + d];
  if (q > 0) {
#pragma unroll
    for (int jj = 0; jj < 16; ++jj) { int j = q * 16 + jj; Bc[j * 65 + d] += off; }
  }
  __syncthreads();
}

__device__ __forceinline__ void la_load_v(const half_t* __restrict__ P, int t0, int vcol, h8 (&vr)[2][2]) {
  const int tid = otid(), w = tid >> 6, l = tid & 63;
  const int jp = l & 31, cgp = l >> 5;
#pragma unroll
  for (int it = 0; it < 2; ++it) {
    int c = it * 8 + w * 2 + cgp;
    vr[it][0] = *(const h8*)(P + (size_t)(t0 + 2 * jp) * PP + vcol + c * 8);
    vr[it][1] = *(const h8*)(P + (size_t)(t0 + 2 * jp + 1) * PP + vcol + c * 8);
  }
}
__device__ __forceinline__ void la_stage_vt(const h8 (&vr)[2][2], unsigned char* lds) {
  const int tid = otid(), w = tid >> 6, l = tid & 63;
  half_t* VT = (half_t*)(lds + LA_VT);
  const int jp = l & 31, cgp = l >> 5;
#pragma unroll
  for (int it = 0; it < 2; ++it) {
    int c = it * 8 + w * 2 + cgp;
#pragma unroll
    for (int q = 0; q < 8; ++q) {
      h2 pr; pr[0] = vr[it][0][q]; pr[1] = vr[it][1][q];
      *(h2*)(VT + (c * 8 + q) * 72 + 2 * jp) = pr;
    }
  }
}
__device__ void la_item_kv(const Params& p, int layer, int item, unsigned char* lds) {
  const int tid = otid(), w = tid >> 6, l = tid & 63;
  const int n = item >> 3, Hh = item & 7;
  const int t0 = n * 64;
  const half_t* P = (const half_t*)(p.ws + OFF_P);
  half_t* ST = (half_t*)(p.ws + OFF_ST);
  float* DEC = (float*)(p.ws + OFF_DEC);
  const int kcol = (Hh < 4) ? (C_RETK + Hh * 64) : (C_GLAK + (Hh - 4) * 64);
  const int vcol = (Hh < 4) ? (C_RETV + Hh * 128) : (C_GLAV + (Hh - 4) * 128);
  h8 vr[2][2];
  la_load_v(P, t0, vcol, vr);
  const h8 k0 = *(const h8*)(P + (size_t)(t0 + 2 * (l & 31)) * PP + kcol + (w * 2 + (l >> 5)) * 8);
  const h8 k1 = *(const h8*)(P + (size_t)(t0 + 2 * (l & 31) + 1) * PP + kcol + (w * 2 + (l >> 5)) * 8);
  __syncthreads();
  la_bcum(p, layer, n, Hh, lds);
  const float* Bc = (const float*)(lds + LA_BC);
  half_t* KhT = (half_t*)(lds + LA_KT);
  half_t* VT = (half_t*)(lds + LA_VT);
  {
    const int jp = l & 31, cgp = l >> 5;
    int c = w * 2 + cgp;
#pragma unroll
    for (int q = 0; q < 8; ++q) {
      int d = c * 8 + q;
      float bl = Bc[63 * 65 + d];
      h2 pr;
      pr[0] = (half_t)((float)k0[q] * __expf(bl - Bc[(2 * jp) * 65 + d]));
      pr[1] = (half_t)((float)k1[q] * __expf(bl - Bc[(2 * jp + 1) * 65 + d]));
      *(h2*)(KhT + d * 72 + 2 * jp) = pr;
    }
  }
  la_stage_vt(vr, lds);
  if (tid < 64) DEC[(size_t)item * 64 + tid] = __expf(Bc[63 * 65 + tid]);
  __syncthreads();
  f16v acc[2];
#pragma unroll
  for (int j = 0; j < 2; ++j)
#pragma unroll
    for (int r = 0; r < 16; ++r) acc[j][r] = ozero();
#pragma unroll
  for (int ks = 0; ks < 4; ++ks) {
    h8 a = *(const h8*)(VT + (32 * w + (l & 31)) * 72 + ks * 16 + (l >> 5) * 8);
#pragma unroll
    for (int j = 0; j < 2; ++j) {
      h8 b = *(const h8*)(KhT + (j * 32 + (l & 31)) * 72 + ks * 16 + (l >> 5) * 8);
      acc[j] = mfma16(a, b, acc[j]);
    }
  }
#pragma unroll
  for (int j = 0; j < 2; ++j)
#pragma unroll
    for (int r = 0; r < 16; ++r) {
      int e = 32 * w + crow(r, l);
      int d = j * 32 + (l & 31);
      ST[(size_t)item * 8192 + e * 64 + d] = (half_t)acc[j][r];
    }
}

__device__ void phase_scan(const Params& p) {
  half_t* ST = (half_t*)(p.ws + OFF_ST);
  const float* DEC = (const float*)(p.ws + OFF_DEC);
  for (int f2 = blockIdx.x * NTHREADS + otid(); f2 < 32768; f2 += gridDim.x * NTHREADS) {
    const int f = f2 * 2;
    const int Hh = f >> 13, d = f & 63;
    float s0 = 0.f, s1 = 0.f;
    for (int n0 = 0; n0 < 256; n0 += 16) {
      h2 kv[16]; float2 dc[16];
#pragma unroll
      for (int u = 0; u < 16; ++u) {
        kv[u] = *(const h2*)(ST + (size_t)(n0 + u) * 65536 + f);
        dc[u] = *(const float2*)(DEC + (size_t)((n0 + u) * 8 + Hh) * 64 + d);
      }
#pragma unroll
      for (int u = 0; u < 16; ++u) {
        h2 o; o[0] = (half_t)s0; o[1] = (half_t)s1;
        *(h2*)(ST + (size_t)(n0 + u) * 65536 + f) = o;
        s0 = dc[u].x * s0 + (float)kv[u][0];
        s1 = dc[u].y * s1 + (float)kv[u][1];
      }
    }
  }
}

__device__ void la_item_out(const Params& p, int layer, int item, unsigned char* lds) {
  const int tid = otid(), w = tid >> 6, l = tid & 63;
  const int n = item >> 3, Hh = item & 7;
  const int t0 = n * 64;
  const half_t* P = (const half_t*)(p.ws + OFF_P);
  const half_t* ST = (const half_t*)(p.ws + OFF_ST);
  half_t* BR = (half_t*)(p.ws + OFF_BR);
  const int qcol = (Hh < 4) ? (C_RETQ + Hh * 64) : (C_GLAQ + (Hh - 4) * 64);
  const int kcol = (Hh < 4) ? (C_RETK + Hh * 64) : (C_GLAK + (Hh - 4) * 64);
  const int vcol = (Hh < 4) ? (C_RETV + Hh * 128) : (C_GLAV + (Hh - 4) * 128);
  const int gcol = (Hh < 4) ? (C_RETG + Hh * 128) : (C_GLAG + (Hh - 4) * 128);
  const int ocol = (Hh < 4) ? (Hh * 128) : (1024 + (Hh - 4) * 128);
  h8 vr[2][2];
  la_load_v(P, t0, vcol, vr);
  h8 qr[2], kr[2], sr[4];
#pragma unroll
  for (int it = 0; it < 2; ++it) {
    const int c = tid + 256 * it;
    qr[it] = *(const h8*)(P + (size_t)(t0 + (c >> 3)) * PP + qcol + (c & 7) * 8);
    kr[it] = *(const h8*)(P + (size_t)(t0 + (c >> 3)) * PP + kcol + (c & 7) * 8);
  }
#pragma unroll
  for (int it = 0; it < 4; ++it) {
    const int c = tid + 256 * it;
    sr[it] = *(const h8*)(ST + (size_t)item * 8192 + (c >> 3) * 64 + (c & 7) * 8);
  }
  __syncthreads();
  la_bcum(p, layer, n, Hh, lds);
  const float* Bc = (const float*)(lds + LA_BC);
  half_t* Qt = (half_t*)(lds + LA_QT);
  half_t* Kt = (half_t*)(lds + LA_KT);
  half_t* AT = (half_t*)(lds + LA_AT);
  half_t* VT = (half_t*)(lds + LA_VT);
  half_t* SS = (half_t*)(lds + LA_SS);
  float* OS = (float*)(lds + LA_OS);
#pragma unroll
  for (int it = 0; it < 2; ++it) {
    int c = tid + 256 * it;
    int row = c >> 3, kc = c & 7;
    const h8 qv = qr[it];
    const h8 kv = kr[it];
    h8 qo, ko;
#pragma unroll
    for (int q = 0; q < 8; ++q) {
      float b = Bc[row * 65 + kc * 8 + q];
      qo[q] = (half_t)((float)qv[q] * __expf(b));
      ko[q] = (half_t)((float)kv[q] * __expf(-b));
    }
    *(h8*)(Qt + row * 72 + kc * 8) = qo;
    *(h8*)(Kt + row * 72 + kc * 8) = ko;
  }
  la_stage_vt(vr, lds);
#pragma unroll
  for (int it = 0; it < 4; ++it) {
    int c = tid + 256 * it;
    int e = c >> 3, kc = c & 7;
    *(h8*)(SS + e * 72 + kc * 8) = sr[it];
  }
  __syncthreads();
  {
    const int mi = w >> 1, nj = w & 1;
    f16v acc;
#pragma unroll
    for (int r = 0; r < 16; ++r) acc[r] = ozero();
#pragma unroll
    for (int ks = 0; ks < 4; ++ks) {
      h8 a = *(const h8*)(Qt + (mi * 32 + (l & 31)) * 72 + ks * 16 + (l >> 5) * 8);
      h8 b = *(const h8*)(Kt + (nj * 32 + (l & 31)) * 72 + ks * 16 + (l >> 5) * 8);
      acc = mfma16(a, b, acc);
    }
#pragma unroll
    for (int r = 0; r < 16; ++r) {
      int i = mi * 32 + crow(r, l);
      int j = nj * 32 + (l & 31);
      float v = (j <= i) ? acc[r] : 0.f;
      AT[i * 72 + j] = (half_t)v;
    }
  }
  __syncthreads();
  {
    const int mi = w >> 1, nh = w & 1;
    f16v acc[2];
#pragma unroll
    for (int j = 0; j < 2; ++j)
#pragma unroll
      for (int r = 0; r < 16; ++r) acc[j][r] = ozero();
#pragma unroll
    for (int ks = 0; ks < 4; ++ks) {
      h8 a1 = *(const h8*)(AT + (mi * 32 + (l & 31)) * 72 + ks * 16 + (l >> 5) * 8);
      h8 a2 = *(const h8*)(Qt + (mi * 32 + (l & 31)) * 72 + ks * 16 + (l >> 5) * 8);
#pragma unroll
      for (int j = 0; j < 2; ++j) {
        h8 b1 = *(const h8*)(VT + (nh * 64 + j * 32 + (l & 31)) * 72 + ks * 16 + (l >> 5) * 8);
        h8 b2 = *(const h8*)(SS + (nh * 64 + j * 32 + (l & 31)) * 72 + ks * 16 + (l >> 5) * 8);
        acc[j] = mfma16(a1, b1, acc[j]);
        acc[j] = mfma16(a2, b2, acc[j]);
      }
    }
#pragma unroll
    for (int j = 0; j < 2; ++j)
#pragma unroll
      for (int r = 0; r < 16; ++r) {
        int i = mi * 32 + crow(r, l);
        int e = nh * 64 + j * 32 + (l & 31);
        OS[i * 132 + e] = acc[j][r];
      }
  }
  __syncthreads();
  {
    const int i = tid >> 2, qd = tid & 3;
    float ov[32];
    float ss = 0.f;
#pragma unroll
    for (int c = 0; c < 8; ++c) {
      f4v v = *(const f4v*)(OS + i * 132 + qd * 32 + c * 4);
      ov[c * 4] = v[0]; ov[c * 4 + 1] = v[1]; ov[c * 4 + 2] = v[2]; ov[c * 4 + 3] = v[3];
      ss += v[0] * v[0] + v[1] * v[1] + v[2] * v[2] + v[3] * v[3];
    }
    ss += dppf<0xB1>(ss);
    ss += dppf<0x4E>(ss);
    float rs = rsqrtf(ss * (1.0f / 128.0f) + 1e-6f);
#pragma unroll
    for (int c = 0; c < 4; ++c) {
      h8 g = *(const h8*)(P + (size_t)(t0 + i) * PP + gcol + qd * 32 + c * 8);
      h8 o;
#pragma unroll
      for (int q = 0; q < 8; ++q) o[q] = (half_t)(ov[c * 8 + q] * rs * (float)g[q]);
      *(h8*)(BR + (size_t)(t0 + i) * 1536 + ocol + qd * 32 + c * 8) = o;
    }
  }
}

#define DS_CAP 768
#define DS_PRUNE_AT 640
#define NPL 12
#define DS_LS 0
#define DS_LI (32 * DS_CAP * 4)
#define DS_CNT (32 * DS_CAP * 6)
#define DS_THR (DS_CNT + 128)
#define DS_WQ (DS_CNT + 256)
#define DS_HIST (DS_CNT + 1024)

__device__ __forceinline__ unsigned long long wave_or64(unsigned long long v) {
  const unsigned lo = wave_or((unsigned)v), hi = wave_or((unsigned)(v >> 32));
  return ((unsigned long long)hi << 32) | lo;
}
template <bool APPROX>
__device__ __forceinline__ void dsa_prune(float* LSm, unsigned short* LIm, int n, unsigned* hist, int* cntm, float* thrm, int l) {
  unsigned long long comp[NPL];
  bool act[NPL], val[NPL];
#pragma unroll
  for (int k = 0; k < NPL; ++k) {
    int e = l + 64 * k;
    val[k] = e < n;
    const int ec = val[k] ? e : 0;
    unsigned u = __float_as_uint(LSm[ec]), li = LIm[ec];
    if (!val[k]) { u = 0; li = 0; }
    const unsigned key = (u >> 31) ? ~u : (u | 0x80000000u);
    comp[k] = ((unsigned long long)key << 14) | (unsigned long long)(16383u - li);
    act[k] = val[k];
  }
  const unsigned long long c0 = ((unsigned long long)(unsigned)__builtin_amdgcn_readfirstlane((int)(unsigned)(comp[0] >> 32)) << 32) | (unsigned)__builtin_amdgcn_readfirstlane((int)(unsigned)comp[0]);
  unsigned long long x = 0;
#pragma unroll
  for (int k = 0; k < NPL; ++k) x |= val[k] ? (comp[k] ^ c0) : 0ull;
  x = wave_or64(x);
  int shift = (x == 0ull) ? 0 : (63 - __clzll((long long)x)) - 7;
  if (shift < 0) shift = 0;
  unsigned rank = 256;
  bool fast = false; unsigned fsel = 0, fcnt = 0; int fshift = 0;
#pragma unroll 1
  for (int rd = 0; rd < 8; ++rd) {
    *(uint4*)(hist + 4 * l) = make_uint4(0, 0, 0, 0);
    asm volatile("" ::: "memory");
    unsigned dk[NPL];
#pragma unroll
    for (int k = 0; k < NPL; ++k) {
      dk[k] = (unsigned)(comp[k] >> shift) & 255u;
      if (act[k]) atomicAdd(&hist[dk[k]], 1u);
    }
    asm volatile("" ::: "memory");
    uint4 hv; hv.x = hist[4 * l]; hv.y = hist[4 * l + 1]; hv.z = hist[4 * l + 2]; hv.w = hist[4 * l + 3];
    unsigned tl = hv.x + hv.y + hv.z + hv.w;
    const unsigned pin = wave_incl_scan(tl);
    const unsigned tot = (unsigned)__builtin_amdgcn_readlane((int)pin, 63);
    unsigned sx = tot - pin;
    bool mine = (sx < rank) && (rank <= sx + tl);
    unsigned dsel = 0, nr = 0, hsel = 0;
    if (mine) {
      unsigned c = sx;
      if (c + hv.w >= rank) { dsel = 4 * l + 3; nr = rank - c; hsel = hv.w; }
      else {
        c += hv.w;
        if (c + hv.z >= rank) { dsel = 4 * l + 2; nr = rank - c; hsel = hv.z; }
        else {
          c += hv.z;
          if (c + hv.y >= rank) { dsel = 4 * l + 1; nr = rank - c; hsel = hv.y; }
          else { c += hv.y; dsel = 4 * l; nr = rank - c; hsel = hv.x; }
        }
      }
    }
    unsigned long long mk = __ballot(mine);
    int src = (mk == 0ull) ? 0 : (__ffsll((long long)mk) - 1);
    dsel = (unsigned)__builtin_amdgcn_readlane((int)dsel, src);
    rank = (unsigned)__builtin_amdgcn_readlane((int)nr, src);
    hsel = (unsigned)__builtin_amdgcn_readlane((int)hsel, src);
    if (APPROX && rd == 0) {
      const unsigned kept = 256u - rank + hsel;
      if (kept <= 320u) { fast = true; fsel = dsel; fcnt = kept; fshift = shift; break; }
    }
#pragma unroll
    for (int k = 0; k < NPL; ++k) act[k] = act[k] && (dk[k] == dsel);
    if (hsel <= 1u || shift == 0) break;
    shift = (shift >= 8) ? (shift - 8) : 0;
  }
  unsigned long long tsel = 0;
#pragma unroll
  for (int k = 0; k < NPL; ++k) tsel |= act[k] ? comp[k] : 0ull;
  unsigned long long T = 0ull;
  if (!fast) T = wave_or64(tsel);
  else T = ((c0 >> (fshift + 8)) << (fshift + 8)) | ((unsigned long long)fsel << fshift);
  bool keep[NPL];
  unsigned cntk = 0;
#pragma unroll
  for (int k = 0; k < NPL; ++k) {
    keep[k] = val[k] && (comp[k] >= T);
    cntk += keep[k] ? 1u : 0u;
  }
  unsigned pos = wave_incl_scan(cntk) - cntk;
  asm volatile("" ::: "memory");
#pragma unroll
  for (int k = 0; k < NPL; ++k) {
    if (keep[k]) {
      const unsigned kk = (unsigned)(comp[k] >> 14);
      const unsigned u = (kk & 0x80000000u) ? (kk & 0x7FFFFFFFu) : ~kk;
      LSm[pos] = __uint_as_float(u);
      LIm[pos] = (unsigned short)(16383u - ((unsigned)comp[k] & 16383u));
      ++pos;
    }
  }
  if (l == 0) {
    const unsigned T32 = (unsigned)(T >> 14);
    *cntm = fast ? (int)fcnt : 256;
    *thrm = __uint_as_float((T32 & 0x80000000u) ? (T32 & 0x7FFFFFFFu) : ~T32);
  }
  asm volatile("" ::: "memory");
}

__device__ void dsa_item(const Params& p, int qb, unsigned char* lds) {
  const int tid = otid(), w = tid >> 6, l = tid & 63;
  const int t0 = qb * 32;
  const half_t* P = (const half_t*)(p.ws + OFF_P);
  const float* IW = (const float*)(p.ws + OFF_IW);
  half_t* BR = (half_t*)(p.ws + OFF_BR);
  float* LS = (float*)(lds + DS_LS);
  unsigned short* LI = (unsigned short*)(lds + DS_LI);
  int* cnt = (int*)(lds + DS_CNT);
  float* thr = (float*)(lds + DS_THR);
  float* wq = (float*)(lds + DS_WQ);
  unsigned* hist = (unsigned*)(lds + DS_HIST) + w * 256;
  float* PWa = LS + (w * 8) * DS_CAP + 256;
  float* PWb = LS + (w * 8 + 1) * DS_CAP + 256;
  half_t* QS = (half_t*)(LI + (w * 8) * DS_CAP + 256);
  for (int rep_sel = 0; rep_sel < REP_SEL; ++rep_sel) {
  __syncthreads();
  if (tid < 32) { cnt[tid] = 0; thr[tid] = -INFINITY; }
  if (tid < 128) wq[tid] = IW[(size_t)t0 * 4 + tid];
  __syncthreads();
  h8 aq[4][4];
#pragma unroll
  for (int h = 0; h < 4; ++h)
#pragma unroll
    for (int ks = 0; ks < 4; ++ks)
      aq[h][ks] = *(const h8*)(P + (size_t)(t0 + (l & 31)) * PP + C_IDXQ + h * 64 + ks * 16 + (l >> 5) * 8);
  const int nt = qb + 1;
  const int nr = (nt + 3) >> 2;
  f4v wqv[16];
#pragma unroll
  for (int r = 0; r < 16; ++r) wqv[r] = *(const f4v*)(wq + crow(r, l) * 4);
  float thv[16];
  { float ninf = -INFINITY; asm volatile("" : "+v"(ninf));
#pragma unroll
  for (int r = 0; r < 16; ++r) thv[r] = ninf; }
  h8 bk[4];
  {
    const int k0 = (w < nt) ? w : 0;
#pragma unroll
    for (int ks = 0; ks < 4; ++ks)
      bk[ks] = *(const h8*)(P + (size_t)(k0 * 32 + (l & 31)) * PP + C_IDXK + ks * 16 + (l >> 5) * 8);
  }
#pragma unroll 1
  for (int rd = 0; rd < nr; ++rd) {
    const int kt = 4 * rd + w;
    h8 bkn[4];
    {
      const int kn = (kt + 4 < nt) ? (kt + 4) : 0;
#pragma unroll
      for (int ks = 0; ks < 4; ++ks)
        bkn[ks] = *(const h8*)(P + (size_t)(kn * 32 + (l & 31)) * PP + C_IDXK + ks * 16 + (l >> 5) * 8);
    }
    if (kt < nt) {
      const int sbase = kt * 32;
      f16v acc[4];
#pragma unroll
      for (int h = 0; h < 4; ++h) {
#pragma unroll
        for (int r = 0; r < 16; ++r) acc[h][r] = ozero();
#pragma unroll
        for (int ks = 0; ks < 4; ++ks) acc[h] = mfma16(aq[h][ks], bk[ks], acc[h]);
      }
      const int s = sbase + (l & 31);
      float scv[16];
      unsigned pm = 0;
#pragma unroll
      for (int r = 0; r < 16; ++r) {
        const int m = crow(r, l);
        const f4v wv = wqv[r];
        float sc = wv[0] * relu_f(acc[0][r]) + wv[1] * relu_f(acc[1][r]) + wv[2] * relu_f(acc[2][r]) + wv[3] * relu_f(acc[3][r]);
        sc += 0.0f;
        scv[r] = sc;
      }
      if (kt == qb) {
#pragma unroll
        for (int r = 0; r < 16; ++r) if (s > t0 + crow(r, l)) scv[r] = -INFINITY;
      }
#pragma unroll
      for (int r = 0; r < 16; ++r) pm |= (scv[r] > thv[r]) ? (1u << r) : 0u;
      if (__ballot(pm != 0u) != 0ull) {
        unsigned long long mks[16];
        int mycnt = 0;
#pragma unroll
        for (int r = 0; r < 16; ++r) {
          const unsigned long long mk = __ballot(((pm >> r) & 1u) != 0u);
          mks[r] = mk;
          const unsigned hm = (l < 32) ? (unsigned)mk : (unsigned)(mk >> 32);
          if ((l & 31) == r) mycnt = __popc(hm);
        }
        int base = 0;
        if ((l & 31) < 16 && mycnt > 0) base = atomicAdd(&cnt[crow(l & 31, l)], mycnt);
#pragma unroll
        for (int r = 0; r < 16; ++r) {
          const unsigned long long mk = mks[r];
          if (mk != 0ull) {
            const unsigned hm = (l < 32) ? (unsigned)mk : (unsigned)(mk >> 32);
            const int b_lo = __builtin_amdgcn_readlane(base, r), b_hi = __builtin_amdgcn_readlane(base, 32 + r);
            const int bb = (l < 32) ? b_lo : b_hi;
            if ((pm >> r) & 1u) {
              const int m = crow(r, l);
              const int slot = bb + __popc(hm & ((1u << (l & 31)) - 1u));
              LS[m * DS_CAP + slot] = scv[r];
              LI[m * DS_CAP + slot] = (unsigned short)s;
            }
          }
        }
      }
    }
    lds_barrier();
    bool any_prune;
    {
      const int cv = (l < 32) ? cnt[l] : 0;
      unsigned pmask = (unsigned)__ballot(cv > DS_PRUNE_AT);
      any_prune = pmask != 0u;
      int j = 0;
      while (pmask != 0u) {
        const int m = __ffs((int)pmask) - 1;
        pmask &= pmask - 1u;
        if ((j & 3) == w) dsa_prune<true>(LS + m * DS_CAP, LI + m * DS_CAP, cnt[m], hist, cnt + m, thr + m, l);
        ++j;
      }
    }
    lds_barrier();
    if (any_prune) {
#pragma unroll
      for (int r = 0; r < 16; ++r) thv[r] = thr[crow(r, l)];
    }
#pragma unroll
    for (int ks = 0; ks < 4; ++ks) bk[ks] = bkn[ks];
  }
  }
#pragma unroll 1
  for (int mm = 0; mm < 8; ++mm) {
    const int m = w * 8 + mm;
    const int c = cnt[m];
    if (c > 256) dsa_prune<false>(LS + m * DS_CAP, LI + m * DS_CAP, c, hist, cnt + m, thr + m, l);
  }
  asm volatile("s_waitcnt lgkmcnt(0)" ::: "memory");
  for (int rep_att = 0; rep_att < REP_ATT; ++rep_att) {
  h8 kvr[4][8];
  {
    const int m = w * 8;
    const int c = min(cnt[m], 256);
    const unsigned short* LIm = LI + m * DS_CAP;
#pragma unroll
    for (int kk = 0; kk < 4; ++kk) {
      const int e = l + 64 * kk;
      const int s = (int)LIm[(e < c) ? e : 0];
      const half_t* kr = P + (size_t)s * PP + C_DSAK;
#pragma unroll
      for (int ch = 0; ch < 8; ++ch) kvr[kk][ch] = *(const h8*)(kr + ch * 8);
    }
  }
  h8 qreg = *(const h8*)(P + (size_t)(t0 + w * 8) * PP + C_DSAQ + l * 8);
  const int dch = l & 7, ksub = l >> 3;
#pragma unroll 1
  for (int u = 0; u < 16; ++u) {
    const int mm = u >> 1, g = u & 1;
    const int m = w * 8 + mm;
    const int t = t0 + m;
    const int c = min(cnt[m], 256);
    const unsigned short* LIm = LI + m * DS_CAP;
    if (g == 0) {
      *(h8*)(QS + l * 8) = qreg;
      const int mq = (mm < 7) ? (m + 1) : m;
      qreg = *(const h8*)(P + (size_t)(t0 + mq) * PP + C_DSAQ + l * 8);
    }
    h8 gt[4];
#pragma unroll
    for (int hh = 0; hh < 4; ++hh) gt[hh] = *(const h8*)(P + (size_t)t * PP + C_DSAG + (g * 4 + hh) * 64 + dch * 8);
    h8 vv[16];
#pragma unroll
    for (int i = 0; i < 16; ++i) {
      const int e = i * 8 + ksub;
      const int s = (int)LIm[(e < c) ? e : 0];
      vv[i] = *(const h8*)(P + (size_t)s * PP + C_DSAV + g * 64 + dch * 8);
    }
    asm volatile("" ::: "memory");
    float lg[4][4];
#pragma unroll
    for (int hh = 0; hh < 4; ++hh) {
#pragma unroll
      for (int kk = 0; kk < 4; ++kk) lg[hh][kk] = ozero();
#pragma unroll
      for (int ch = 0; ch < 8; ++ch) {
        const h8 qq = *(const h8*)(QS + (g * 4 + hh) * 64 + ch * 8);
#pragma unroll
        for (int kk = 0; kk < 4; ++kk) {
          float a = lg[hh][kk];
          a = __builtin_amdgcn_fdot2(__builtin_shufflevector(qq, qq, 0, 1), __builtin_shufflevector(kvr[kk][ch], kvr[kk][ch], 0, 1), a, false);
          a = __builtin_amdgcn_fdot2(__builtin_shufflevector(qq, qq, 2, 3), __builtin_shufflevector(kvr[kk][ch], kvr[kk][ch], 2, 3), a, false);
          a = __builtin_amdgcn_fdot2(__builtin_shufflevector(qq, qq, 4, 5), __builtin_shufflevector(kvr[kk][ch], kvr[kk][ch], 4, 5), a, false);
          a = __builtin_amdgcn_fdot2(__builtin_shufflevector(qq, qq, 6, 7), __builtin_shufflevector(kvr[kk][ch], kvr[kk][ch], 6, 7), a, false);
          lg[hh][kk] = a;
        }
      }
#pragma unroll
      for (int kk = 0; kk < 4; ++kk) lg[hh][kk] = (l + 64 * kk < c) ? lg[hh][kk] : -INFINITY;
    }
    {
      const int un = (u < 15) ? (u + 1) : 15;
      const int mn = w * 8 + (un >> 1), gn = un & 1;
      const int cn = min(cnt[mn], 256);
      const unsigned short* LIn = LI + mn * DS_CAP;
#pragma unroll
      for (int kk = 0; kk < 4; ++kk) {
        const int e = l + 64 * kk;
        const int s = (int)LIn[(e < cn) ? e : 0];
        const half_t* kr = P + (size_t)s * PP + C_DSAK + gn * 64;
#pragma unroll
        for (int ch = 0; ch < 8; ++ch) kvr[kk][ch] = *(const h8*)(kr + ch * 8);
      }
    }
#pragma unroll
    for (int hh = 0; hh < 4; ++hh) {
      float mx = fmaxf(fmaxf(lg[hh][0], lg[hh][1]), fmaxf(lg[hh][2], lg[hh][3]));
      mx = wave_max(mx);
      float ev[4]; float sm = 0.f;
#pragma unroll
      for (int kk = 0; kk < 4; ++kk) { ev[kk] = __expf(lg[hh][kk] - mx); sm += ev[kk]; }
      sm = wave_sum(sm);
      const float inv = 1.0f / sm;
#pragma unroll
      for (int kk = 0; kk < 4; ++kk) ((kk < 2) ? PWa : PWb)[(l + 64 * (kk & 1)) * 4 + hh] = ev[kk] * inv;
    }
    asm volatile("" ::: "memory");
    float o[4][8];
#pragma unroll
    for (int hh = 0; hh < 4; ++hh)
#pragma unroll
      for (int q = 0; q < 8; ++q) o[hh][q] = ozero();
    const int nit = (c + 7) >> 3;
#pragma unroll 1
    for (int it0 = 0; it0 < nit; it0 += 16) {
      if (it0 > 0) {
#pragma unroll
        for (int i = 0; i < 16; ++i) {
          const int e = (it0 + i) * 8 + ksub;
          const int s = (int)LIm[(e < c) ? e : 0];
          vv[i] = *(const h8*)(P + (size_t)s * PP + C_DSAV + g * 64 + dch * 8);
        }
      }
#pragma unroll
      for (int i = 0; i < 16; ++i) {
        const int e = (it0 + i) * 8 + ksub;
        const f4v pv = *(const f4v*)(((e < 128) ? PWa : PWb) + (e & 127) * 4);
#pragma unroll
        for (int hh = 0; hh < 4; ++hh)
#pragma unroll
          for (int q = 0; q < 8; ++q) o[hh][q] += pv[hh] * (float)vv[i][q];
      }
    }
#pragma unroll
    for (int hh = 0; hh < 4; ++hh)
#pragma unroll
      for (int q = 0; q < 8; ++q) {
        float v = o[hh][q];
        v += dppf<0x128>(v); v += xor16f(v); v += xor32f(v);
        o[hh][q] = v;
      }
    if (l < 8) {
#pragma unroll
      for (int hh = 0; hh < 4; ++hh) {
        const int col = (g * 4 + hh) * 64 + dch * 8;
        h8 ov;
#pragma unroll
        for (int q = 0; q < 8; ++q) ov[q] = (half_t)(o[hh][q] * (float)gt[hh][q]);
        *(h8*)(BR + (size_t)t * 1536 + 512 + col) = ov;
      }
    }
    asm volatile("" ::: "memory");
  }
  }
}

__device__ void phase_B(const Params& p, int layer, unsigned char* lds) {
  const int G = gridDim.x;
  for (int j = 0; j * G < 512; ++j) {
    const int b = (j & 1) ? (G - 1 - (int)blockIdx.x) : (int)blockIdx.x;
    const int idx = j * G + b;
#ifndef NO_DSA
    if (idx < 512) dsa_item(p, 511 - idx, lds);
#endif
  }
  for (int rep = 0; rep < REP_KV; ++rep)
  for (int it = blockIdx.x; it < 2048; it += G) la_item_kv(p, layer, it, lds);
}

__device__ void phase_E1(const Params& p, int layer, unsigned char* lds, int my_xcc, int my_loc, const unsigned* xcnt) {
  const int tid = otid(), w = tid >> 6, l = tid & 63;
  const half_t* BR = (const half_t*)(p.ws + OFF_BR);
  const half_t* WbrT = (const half_t*)(p.ws + OFF_WBRT) + (size_t)layer * 3 * 1024 * WBP;
  const half_t* P = (const half_t*)(p.ws + OFF_P);
  half_t* Y1 = (half_t*)(p.ws + OFF_H);
  const int wm = w >> 1, wn = w & 1;
  float* E = (float*)(lds + GEMM_EOFF) + w * (32 * EP);
  const int prow = l >> 3, c0 = (l & 7) * 8;
  const int nx = xcc_census(xcnt, my_xcc);
  const int nrounds = (nx > 0) ? (64 + nx - 1) / nx : (512 + (int)gridDim.x - 1) / (int)gridDim.x;
  for (int rnd = 0; rnd < nrounds; ++rnd) {
    int mt, nt;
    if (nx > 0) {
      const int s = my_loc + nx * rnd;
      if (s >= 64) continue;
      mt = my_xcc * 8 + (s & 7); nt = s >> 3;
    } else {
      const int tix = rnd * (int)gridDim.x + (int)blockIdx.x;
      if (tix >= 512) continue;
      mt = tix & 63; nt = tix >> 6;
    }
    h8 tot[4][4];
#pragma unroll
    for (int i = 0; i < 4; ++i)
#pragma unroll
      for (int ps = 0; ps < 4; ++ps)
#pragma unroll
        for (int q = 0; q < 8; ++q) tot[i][ps][q] = (half_t)ozero();
    const int m0w = mt * 256 + wm * 128;
    const int n0 = nt * 128 + wn * 64 + c0;
#pragma unroll 1
    for (int b = 0; b < 3; ++b) {
      f16v acc[4][2];
      zero_acc<2>(acc);
      gemm_kloop<2>(acc, BR + (size_t)mt * 256 * 1536 + b * 512, 1536, WbrT + (size_t)b * 1024 * WBP + (size_t)nt * 128 * WBP, WBP, 512, lds);
#pragma unroll
      for (int i = 0; i < 4; ++i) {
        h8 g[4];
#pragma unroll
        for (int ps = 0; ps < 4; ++ps) g[ps] = *(const h8*)(P + (size_t)(m0w + i * 32 + ps * 8 + prow) * PP + C_MRG + b * 1024 + n0);
        stage_pair(E, acc[i][0], acc[i][1], l);
#pragma unroll
        for (int ps = 0; ps < 4; ++ps) {
          const int rl = ps * 8 + prow;
          float ev[8];
          ld8(E + rl * EP + c0, ev);
#pragma unroll
          for (int q = 0; q < 8; ++q) tot[i][ps][q] = (half_t)((float)tot[i][ps][q] + (float)g[ps][q] * ev[q]);
        }
      }
    }
#pragma unroll
    for (int i = 0; i < 4; ++i)
#pragma unroll
      for (int ps = 0; ps < 4; ++ps) {
        const int row = m0w + i * 32 + ps * 8 + prow;
        *(h8*)(Y1 + (size_t)row * HP + n0) = tot[i][ps];
      }
  }
}

__device__ void phase_E2(const Params& p, int layer, unsigned char* lds, int my_xcc, int my_loc, const unsigned* xcnt) {
  const int tid = otid(), w = tid >> 6, l = tid & 63;
  const half_t* Y1 = (const half_t*)(p.ws + OFF_H);
  const half_t* Wo = (const half_t*)(p.ws + OFF_WOUTT) + (size_t)layer * 1024 * WP;
  float* Y = (float*)(p.ws + OFF_ST);
  const int wm = w >> 1, wn = w & 1;
  const int nx = xcc_census(xcnt, my_xcc);
  const int nrounds = (nx > 0) ? (64 + nx - 1) / nx : (512 + (int)gridDim.x - 1) / (int)gridDim.x;
  for (int rnd = 0; rnd < nrounds; ++rnd) {
    int mt, nt;
    if (nx > 0) {
      const int s = my_loc + nx * rnd;
      if (s >= 64) continue;
      mt = my_xcc * 8 + (s & 7); nt = s >> 3;
    } else {
      const int tix = rnd * (int)gridDim.x + (int)blockIdx.x;
      if (tix >= 512) continue;
      mt = tix & 63; nt = tix >> 6;
    }
    f16v acc[4][2];
    zero_acc<2>(acc);
    gemm_kloop<2>(acc, Y1 + (size_t)mt * 256 * HP, HP, Wo + (size_t)nt * 128 * WP, WP, 1024, lds);
    const int m0w = mt * 256 + wm * 128;
    const int n0w = nt * 128 + wn * 64;
    float* E = (float*)(lds + GEMM_EOFF) + w * (32 * EP);
    const int prow = l >> 3, c0 = (l & 7) * 8;
#pragma unroll
    for (int i = 0; i < 4; ++i) {
      stage_pair(E, acc[i][0], acc[i][1], l);
#pragma unroll
      for (int ps = 0; ps < 4; ++ps) {
        const int rl = ps * 8 + prow;
        const int row = m0w + i * 32 + rl;
        const f4v a = *(const f4v*)(E + rl * EP + c0), b = *(const f4v*)(E + rl * EP + c0 + 4);
        *(f4v*)(Y + (size_t)row * 1024 + n0w + c0) = a;
        *(f4v*)(Y + (size_t)row * 1024 + n0w + c0 + 4) = b;
      }
    }
  }
}

__device__ void phase_E3(const Params& p, int layer) {
  const int w = otid() >> 6, l = otid() & 63;
  const float* Y = (const float*)(p.ws + OFF_ST);
  const float* MOD = (const float*)(p.ws + OFF_MOD);
  half_t* H = (half_t*)(p.ws + OFF_H);
  const float* xin = (layer == 0) ? p.x : p.out;
  const float* gate = MOD + layer * 3072 + 2048;
  const float* post = p.post_norm + layer * 1024;
  const int stride = gridDim.x * 4;
  int row = blockIdx.x * 4 + w;
  f4v yn[4], xn[4];
  if (row < S_LEN) {
#pragma unroll
    for (int i = 0; i < 4; ++i) {
      yn[i] = *(const f4v*)(Y + (size_t)row * 1024 + i * 256 + l * 4);
      xn[i] = *(const f4v*)(xin + (size_t)row * 1024 + i * 256 + l * 4);
    }
  }
  for (; row < S_LEN; row += stride) {
    float yv[16], xv[16];
    float ss = 0.f;
#pragma unroll
    for (int i = 0; i < 4; ++i)
#pragma unroll
      for (int q = 0; q < 4; ++q) { yv[i * 4 + q] = yn[i][q]; xv[i * 4 + q] = xn[i][q]; ss += yn[i][q] * yn[i][q]; }
    const int nrow = (row + stride < S_LEN) ? (row + stride) : row;
#pragma unroll
    for (int i = 0; i < 4; ++i) {
      yn[i] = *(const f4v*)(Y + (size_t)nrow * 1024 + i * 256 + l * 4);
      xn[i] = *(const f4v*)(xin + (size_t)nrow * 1024 + i * 256 + l * 4);
    }
    ss = wave_sum(ss);
    const float rs = rsqrtf(ss * (1.0f / 1024.0f) + 1e-6f);
#pragma unroll
    for (int i = 0; i < 4; ++i) {
      const int c0 = i * 256 + l * 4;
      f4v gt = *(const f4v*)(gate + c0);
      f4v pn = *(const f4v*)(post + c0);
      f4v o;
#pragma unroll
      for (int q = 0; q < 4; ++q) { o[q] = xv[i * 4 + q] + gt[q] * (yv[i * 4 + q] * rs * pn[q]); xv[i * 4 + q] = o[q]; }
      *(f4v*)(p.out + (size_t)row * 1024 + c0) = o;
    }
    if (layer + 1 < DEPTH)
      write_h_row(xv, p.pre_norm + (layer + 1) * 1024, MOD + (layer + 1) * 3072, H + (size_t)row * HP, l);
  }
}

#define XB_TMO      128
#define XB_XCNT(j)  (256  + 64 * (j))
#define XB_XSUB(j)  (1280 + 64 * (j))
#define XB_XGEN(j)  (2304 + 64 * (j))
#define XB_TOP      3328
#define XB_TOPGEN   3392
#define XCD_BAR_WORDS 3456
#define XB_SPIN_CAP (1u << 18)
#define LAS __attribute__((address_space(3)))

__device__ __forceinline__ unsigned xb_ld(unsigned* p)              { return __hip_atomic_load(p, __ATOMIC_RELAXED, __HIP_MEMORY_SCOPE_AGENT); }
__device__ __forceinline__ unsigned xb_add(unsigned* p, unsigned v) { return __hip_atomic_fetch_add(p, v, __ATOMIC_RELAXED, __HIP_MEMORY_SCOPE_AGENT); }
__device__ __forceinline__ unsigned xb_xcc_id() { return (unsigned)__builtin_amdgcn_s_getreg((3 << 11) | 20) & 0xFu; }
#define XB_SPIN(cond, bar) do { unsigned _sp = 0; while (cond) { __builtin_amdgcn_s_sleep(1); \
    if ((++_sp & 255u) == 0u) { if (xb_ld(&(bar)[XB_TMO])) break; if (_sp > XB_SPIN_CAP) { atomicAdd(&(bar)[XB_TMO], 1u); break; } } } } while (0)

struct XcdBarrier {
    unsigned* bar; unsigned x;
    volatile LAS unsigned* st;
};

__device__ __forceinline__ XcdBarrier xcd_barrier_post(unsigned* bar, volatile LAS unsigned* st) {
    XcdBarrier b; b.bar = bar; b.x = xb_xcc_id(); b.st = st;
    if (otid() == 0) (void)xb_add(&bar[XB_XCNT(b.x)], 1u);
    return b;
}
__device__ __forceinline__ void xcd_barrier_complete(unsigned* bar, unsigned x, unsigned& nloc, unsigned& nx) {
    const unsigned G = gridDim.x * gridDim.y * gridDim.z;
    unsigned sum, cnt, mine, sp = 0u;
    for (;;) {
        sum = 0u; cnt = 0u; mine = 0u;
#pragma unroll
        for (unsigned j = 0; j < 16; ++j) { const unsigned c = xb_ld(&bar[XB_XCNT(j)]); sum += c; cnt += (c > 0u) ? 1u : 0u; mine = (j == x) ? c : mine; }
        if (sum == G) break;
        __builtin_amdgcn_s_sleep(1);
        if ((++sp & 255u) == 0u) { if (xb_ld(&bar[XB_TMO])) break; if (sp > XB_SPIN_CAP) { atomicAdd(&bar[XB_TMO], 1u); break; } }
    }
    nloc = mine > 0u ? mine : 1u; nx = cnt > 0u ? cnt : 1u;
}

__device__ __forceinline__ void xcd_barrier(const XcdBarrier& b) {
    asm volatile("s_waitcnt vmcnt(0)" ::: "memory");
    __syncthreads();
    if (otid() == 0) {
        unsigned* bar = b.bar;
        __builtin_amdgcn_s_waitcnt(0);
        unsigned nloc = b.st[0], nx = b.st[1];
        if (nloc == 0u) { xcd_barrier_complete(bar, b.x, nloc, nx); b.st[0] = nloc; b.st[1] = nx; }
        const unsigned old = xb_add(&bar[XB_XSUB(b.x)], 1u);
        const unsigned gen = old / nloc;
        if (old + 1u == (gen + 1u) * nloc) {
            __builtin_amdgcn_fence(__ATOMIC_RELEASE, "agent");
            asm volatile("s_waitcnt vmcnt(0)" ::: "memory");
            const unsigned og = xb_add(&bar[XB_TOP], 1u);
            const unsigned tg = og / nx;
            if (og + 1u == (tg + 1u) * nx) xb_add(&bar[XB_TOPGEN], 1u);
            else XB_SPIN(xb_ld(&bar[XB_TOPGEN]) == tg, bar);
            __builtin_amdgcn_fence(__ATOMIC_ACQUIRE, "agent");
            xb_add(&bar[XB_XGEN(b.x)], 1u);
            asm volatile("s_waitcnt vmcnt(0)" ::: "memory");
        } else {
            XB_SPIN(xb_ld(&bar[XB_XGEN(b.x)]) == gen, bar);
            __builtin_amdgcn_fence(__ATOMIC_ACQUIRE, "agent");
            asm volatile("s_waitcnt vmcnt(0)" ::: "memory");
        }
    }
    __syncthreads();
}


};

#ifndef REP_D
#define REP_D 1
#endif
#ifndef REP_E
#define REP_E 1
#endif
#ifndef REP_A
#define REP_A 1
#endif
#ifndef REP_B
#define REP_B 1
#endif
#ifdef ONLY_PHASE
#define PH_EN(x) (ONLY_PHASE == (x))
#else
#define PH_EN(x) true
#endif
__global__ void __launch_bounds__(NTHREADS) fwd_megakernel(Params p) {
  extern __shared__ __attribute__((aligned(16))) unsigned char lds[];
  cg::grid_group grid = cg::this_grid();
  K k; k.wbase = __builtin_amdgcn_readfirstlane((int)__builtin_amdgcn_workitem_id_x()) & ~63;
  unsigned* bar = (unsigned*)(p.ws + WS_END);
  unsigned* xcnt = bar + 16;
  unsigned* xbar = (unsigned*)(p.ws + WS_END + 1024);
  if (blockIdx.x == 0) {
    if (k.otid() < 17) __hip_atomic_store(bar + (k.otid() == 16 ? 0 : 16 + k.otid()), 0u, __ATOMIC_RELAXED, __HIP_MEMORY_SCOPE_AGENT);
    for (int i = k.otid(); i < XCD_BAR_WORDS; i += NTHREADS) __hip_atomic_store(xbar + i, 0u, __ATOMIC_RELAXED, __HIP_MEMORY_SCOPE_AGENT);
  }
  volatile LAS unsigned* xst = (volatile LAS unsigned*)(lds + LDS_BYTES - 16);
  if (k.otid() == 0) { xst[0] = 0u; xst[1] = 0u; }
  __syncthreads();
  K::XcdBarrier xb; xb.bar = xbar; xb.x = 0; xb.st = xst;
  int my_xcc = 0, my_loc = 0;
  for (int ph = p.ph_lo; ph < p.ph_hi; ++ph) {
    if (ph == 0) { if (PH_EN(0)) for (int rep = 0; rep < REP_P; ++rep) { k.phase_prologue(p, lds); __syncthreads(); } }
    else if (ph == 1) {
      xb = k.xcd_barrier_post(xbar, xst);
      int* sh = (int*)lds;
      if (k.otid() == 0) {
        const int xc = (int)(__builtin_amdgcn_s_getreg((3 << 11) | 20) & 0xFu);
        sh[0] = xc;
        sh[1] = (int)__hip_atomic_fetch_add(xcnt + xc, 1u, __ATOMIC_RELAXED, __HIP_MEMORY_SCOPE_AGENT);
      }
      __syncthreads();
      my_xcc = __builtin_amdgcn_readfirstlane(sh[0]);
      my_loc = __builtin_amdgcn_readfirstlane(sh[1]);
      __syncthreads();
      if (PH_EN(1)) k.phase_h0(p);
    }
    else {
      const int layer = (ph - 2) / 7, sub = (ph - 2) % 7;
      if (sub == 0) { if (PH_EN(2)) for (int rep = 0; rep < REP_A; ++rep) { k.phase_A(p, layer, lds, my_xcc, my_loc, xcnt); __syncthreads(); } }
      else if (sub == 1) { if (PH_EN(3)) for (int rep = 0; rep < REP_B; ++rep) { k.phase_B(p, layer, lds); __syncthreads(); } }
      else if (sub == 2) { if (PH_EN(4)) k.phase_scan(p); }
      else if (sub == 3) { if (PH_EN(5)) for (int rep = 0; rep < REP_D; ++rep) { for (int it = blockIdx.x; it < 2048; it += gridDim.x) k.la_item_out(p, layer, it, lds); __syncthreads(); } }
      else if (sub == 4) { if (PH_EN(6)) for (int rep = 0; rep < REP_E; ++rep) { k.phase_E1(p, layer, lds, my_xcc, my_loc, xcnt); __syncthreads(); } }
      else if (sub == 5) { if (PH_EN(7)) for (int rep = 0; rep < REP_E; ++rep) { k.phase_E2(p, layer, lds, my_xcc, my_loc, xcnt); __syncthreads(); } }
      else { if (PH_EN(8)) k.phase_E3(p, layer); }
    }
    if (ph + 1 < p.ph_hi) {
      if (ph == p.ph_lo) grid.sync();
      else k.xcd_barrier(xb);
    }
  }
}

extern "C" void kernel_launch(void* const* d_in, const int* in_sizes, int n_in, void* d_out, int out_size,
                              void* d_ws, size_t ws_size, hipStream_t stream) {
  static int grid_blocks = 0;
  if (!grid_blocks) {
    int dev = 0, cus = 0, per_cu = 0;
    hipGetDevice(&dev);
    hipDeviceGetAttribute(&cus, hipDeviceAttributeMultiprocessorCount, dev);
    hipFuncSetAttribute((const void*)fwd_megakernel, hipFuncAttributeMaxDynamicSharedMemorySize, LDS_BYTES);
    hipOccupancyMaxActiveBlocksPerMultiprocessor(&per_cu, (const void*)fwd_megakernel, NTHREADS, LDS_BYTES);
    if (per_cu < 1) per_cu = 1;
    if (per_cu > 1) per_cu = 1;
    grid_blocks = cus * per_cu;
    if (ws_size < WS_END) fprintf(stderr, "workspace too small: %zu < %llu\n", ws_size, (unsigned long long)WS_END);
  }
  Params p{};
  p.x = (const float*)d_in[0]; p.c = (const float*)d_in[1]; p.pos = (const int*)d_in[2];
  p.ada_w = (const float*)d_in[3]; p.ada_b = (const float*)d_in[4];
  p.pre_norm = (const float*)d_in[5]; p.post_norm = (const float*)d_in[6];
  p.w_in = (const float*)d_in[7]; p.gla_w_lr = (const float*)d_in[8]; p.gla_b_lr = (const float*)d_in[9];
  p.w_br_ret = (const float*)d_in[10]; p.w_br_dsa = (const float*)d_in[11]; p.w_br_gla = (const float*)d_in[12];
  p.w_out = (const float*)d_in[13];
  p.out = (float*)d_out; p.ws = (unsigned char*)d_ws;
  p.ph_lo = 0; p.ph_hi = 2 + 7 * DEPTH;
  void* args[] = {&p};
  hipError_t e = hipLaunchCooperativeKernel((const void*)fwd_megakernel, dim3(grid_blocks), dim3(NTHREADS), args, LDS_BYTES, stream);
  if (e != hipSuccess) fprintf(stderr, "cooperative launch failed: %s (grid %d)\n", hipGetErrorString(e), grid_blocks);
}
```

```cpp
#include <hip/hip_runtime.h>
#include <hip/hip_cooperative_groups.h>
#include <stdint.h>
#include <cstdio>
namespace cg = cooperative_groups;
#ifndef REP_P
#define REP_P 1
#endif
#ifndef REP_KV
#define REP_KV 1
#endif
#ifndef REP_SEL
#define REP_SEL 1
#endif
#ifndef REP_ATT
#define REP_ATT 1
#endif

typedef _Float16 half_t;
typedef _Float16 h8 __attribute__((ext_vector_type(8)));
typedef _Float16 h4 __attribute__((ext_vector_type(4)));
typedef _Float16 h2 __attribute__((ext_vector_type(2)));
typedef float f16v __attribute__((ext_vector_type(16)));
typedef float f4v __attribute__((ext_vector_type(4)));

#define S_LEN 16384
#define DM 1024
#define NIN 7764
#define NPAD 7936
#define PP 7808
#define DEPTH 4
#define NTHREADS 256
#define HP 1088
#define WP 1088
#define WBP 576
#define LDS_BYTES 152704

#define C_RETQ 0
#define C_RETK 256
#define C_RETV 512
#define C_RETG 1024
#define C_DSAQ 1536
#define C_DSAK 2048
#define C_DSAV 2176
#define C_DSAG 2304
#define C_IDXQ 2816
#define C_IDXK 3072
#define C_GLAQ 3136
#define C_GLAK 3392
#define C_GLAV 3648
#define C_GLAG 4160
#define C_GLAA 4672
#define C_MRG 4688
#define C_END 7760
#define C_IDXW 7760

#define OFF_WINT 0ull
#define OFF_WBRT (OFF_WINT + 4ull * NPAD * WP * 2)
#define OFF_WOUTT (OFF_WBRT + 4ull * 3 * 1024 * WBP * 2)
#define OFF_MOD (OFF_WOUTT + 4ull * 1024 * WP * 2)
#define OFF_RT (OFF_MOD + 4ull * 3072 * 4)
#define OFF_DT (OFF_RT + 16384ull * 64 * 4)
#define OFF_H (OFF_DT + 16384ull * 16 * 4)
#define OFF_P (OFF_H + 16384ull * HP * 2)
#define OFF_GA (OFF_P + 16384ull * PP * 2)
#define OFF_IW (OFF_GA + 16384ull * 16 * 4)
#define OFF_ST (OFF_IW + 16384ull * 4 * 4)
#define OFF_DEC (OFF_ST + 256ull * 65536 * 4)
#define OFF_BR (OFF_DEC + 256ull * 8 * 64 * 4)
#define WS_END (OFF_BR + 16384ull * 1536 * 2)
static_assert(WS_END + 16384 <= 508821504ull, "workspace too large");

struct Params {
  const float* x; const float* c; const int* pos; const float* ada_w; const float* ada_b;
  const float* pre_norm; const float* post_norm; const float* w_in; const float* gla_w_lr;
  const float* gla_b_lr; const float* w_br_ret; const float* w_br_dsa; const float* w_br_gla;
  const float* w_out; float* out; unsigned char* ws;
  int ph_lo; int ph_hi;
};

struct K {
int wbase;
__device__ __forceinline__ int otid() const {
  int lane;
  asm volatile("v_mbcnt_lo_u32_b32 %0, -1, 0\n\tv_mbcnt_hi_u32_b32 %0, -1, %0" : "=v"(lane));
  return wbase | lane;
}
__device__ __forceinline__ static float ozero() { float z = 0.f; asm volatile("" : "+v"(z)); return z; }
template <int CTRL>
__device__ __forceinline__ float dppf(float v) {
  return __int_as_float(__builtin_amdgcn_update_dpp(0, __float_as_int(v), CTRL, 0xF, 0xF, true));
}
template <int CTRL>
__device__ __forceinline__ unsigned dppu(unsigned v) {
  return (unsigned)__builtin_amdgcn_update_dpp(0, (int)v, CTRL, 0xF, 0xF, true);
}
__device__ __forceinline__ int olane() { return otid() & 63; }
__device__ __forceinline__ float xor16f(float v) { return __int_as_float(__builtin_amdgcn_ds_bpermute((olane() ^ 16) << 2, __float_as_int(v))); }
__device__ __forceinline__ float xor32f(float v) { return __int_as_float(__builtin_amdgcn_ds_bpermute((olane() ^ 32) << 2, __float_as_int(v))); }
__device__ __forceinline__ unsigned xor16u(unsigned v) { return (unsigned)__builtin_amdgcn_ds_bpermute((olane() ^ 16) << 2, (int)v); }
__device__ __forceinline__ unsigned xor32u(unsigned v) { return (unsigned)__builtin_amdgcn_ds_bpermute((olane() ^ 32) << 2, (int)v); }
__device__ __forceinline__ float rl_f(float v, int lane) { return __int_as_float(__builtin_amdgcn_readlane(__float_as_int(v), lane)); }
__device__ __forceinline__ float wave_sum(float v) {
  v += dppf<0xB1>(v); v += dppf<0x4E>(v); v += dppf<0x141>(v); v += dppf<0x140>(v);
  return (rl_f(v, 0) + rl_f(v, 16)) + (rl_f(v, 32) + rl_f(v, 48));
}
__device__ __forceinline__ float wave_max(float v) {
  v = fmaxf(v, dppf<0xB1>(v)); v = fmaxf(v, dppf<0x4E>(v)); v = fmaxf(v, dppf<0x141>(v)); v = fmaxf(v, dppf<0x140>(v));
  return fmaxf(fmaxf(rl_f(v, 0), rl_f(v, 16)), fmaxf(rl_f(v, 32), rl_f(v, 48)));
}
__device__ __forceinline__ unsigned wave_or(unsigned v) {
  v |= dppu<0xB1>(v); v |= dppu<0x4E>(v); v |= dppu<0x141>(v); v |= dppu<0x140>(v);
  return (unsigned)(__builtin_amdgcn_readlane((int)v, 0) | __builtin_amdgcn_readlane((int)v, 16) | __builtin_amdgcn_readlane((int)v, 32) | __builtin_amdgcn_readlane((int)v, 48));
}
__device__ __forceinline__ unsigned wave_incl_scan(unsigned v) {
  v += (unsigned)__builtin_amdgcn_update_dpp(0, (int)v, 0x111, 0xF, 0xF, false);
  v += (unsigned)__builtin_amdgcn_update_dpp(0, (int)v, 0x112, 0xF, 0xF, false);
  v += (unsigned)__builtin_amdgcn_update_dpp(0, (int)v, 0x114, 0xF, 0xF, false);
  v += (unsigned)__builtin_amdgcn_update_dpp(0, (int)v, 0x118, 0xF, 0xF, false);
  v += (unsigned)__builtin_amdgcn_update_dpp(0, (int)v, 0x142, 0xA, 0xF, false);
  v += (unsigned)__builtin_amdgcn_update_dpp(0, (int)v, 0x143, 0xC, 0xF, false);
  return v;
}
__device__ __forceinline__ f16v mfma16(h8 a, h8 b, f16v c) {
  return __builtin_amdgcn_mfma_f32_32x32x16_f16(a, b, c, 0, 0, 0);
}
__device__ __forceinline__ float relu_f(float x) { return __int_as_float(max(__float_as_int(x), 0)); }
__device__ __forceinline__ int crow(int r, int l) { return (r & 3) + 8 * (r >> 2) + 4 * (l >> 5); }

__device__ __forceinline__ int win_col(int nv) {
  if (nv < 3136) return nv;
  if (nv < 7760) return nv + 4;
  if (nv < 7764) return nv - 7760 + 3136;
  return -1;
}
__device__ void transpose_tile(const float* __restrict__ src, int ldn, half_t* __restrict__ dst, int K,
                               int k0, int n0, int mapmode, unsigned char* lds) {
  float* T = (float*)lds;
  const int tid = otid();
  const int nn = tid & 63;
  int col = n0 + nn;
  if (mapmode) col = win_col(col);
#pragma unroll
  for (int i = 0; i < 16; ++i) {
    int kk = (tid >> 6) + 4 * i;
    float v = 0.f;
    if (col >= 0) v = src[(size_t)(k0 + kk) * ldn + col];
    T[kk * 65 + nn] = v;
  }
  __syncthreads();
#pragma unroll
  for (int i = 0; i < 2; ++i) {
    int n2 = (tid >> 3) + 32 * i;
    int kc = tid & 7;
    h8 o;
#pragma unroll
    for (int q = 0; q < 8; ++q) o[q] = (half_t)T[(kc * 8 + q) * 65 + n2];
    *(h8*)(dst + (size_t)(n0 + n2) * K + k0 + kc * 8) = o;
  }
  __syncthreads();
}

__device__ void phase_prologue(const Params& p, unsigned char* lds) {
  const int tid = otid();
  half_t* WinT = (half_t*)(p.ws + OFF_WINT);
  half_t* WbrT = (half_t*)(p.ws + OFF_WBRT);
  half_t* WoutT = (half_t*)(p.ws + OFF_WOUTT);
  float* MOD = (float*)(p.ws + OFF_MOD);
  float* RT = (float*)(p.ws + OFF_RT);
  float* DT = (float*)(p.ws + OFF_DT);
  const int T_WIN = 4 * 124 * 16;
  const int T_WBR = 12 * 16 * 8;
  const int T_WOUT = 4 * 16 * 16;
  const int T_MOD = 192;
  const int T_ROPE = 16384 * 40 / 256;
  const int total = T_WIN + T_WBR + T_WOUT + T_MOD + T_ROPE;
  {
    float* T = (float*)lds;
    const int nn = tid & 63;
    float cur[16], nxt[16];
    int task = blockIdx.x;
    if (task < T_WIN) {
      const int l = task / (124 * 16), r = task % (124 * 16), nt = r / 16, kt = r % 16;
      const int col = win_col(nt * 64 + nn);
      const float* src = p.w_in + (size_t)l * 1024 * NIN;
#pragma unroll
      for (int i = 0; i < 16; ++i) { const int kk = (tid >> 6) + 4 * i; cur[i] = (col >= 0) ? src[(size_t)(kt * 64 + kk) * NIN + col] : 0.f; }
    }
    for (; task < T_WIN; task += gridDim.x) {
      const int tn = (task + (int)gridDim.x < T_WIN) ? task + (int)gridDim.x : task;
      {
        const int l = tn / (124 * 16), r = tn % (124 * 16), nt = r / 16, kt = r % 16;
        const int col = win_col(nt * 64 + nn);
        const float* src = p.w_in + (size_t)l * 1024 * NIN;
#pragma unroll
        for (int i = 0; i < 16; ++i) { const int kk = (tid >> 6) + 4 * i; nxt[i] = (col >= 0) ? src[(size_t)(kt * 64 + kk) * NIN + col] : 0.f; }
      }
      const int l = task / (124 * 16), r = task % (124 * 16), nt = r / 16, kt = r % 16;
      half_t* dst = WinT + (size_t)l * NPAD * WP;
#pragma unroll
      for (int i = 0; i < 16; ++i) T[((tid >> 6) + 4 * i) * 65 + nn] = cur[i];
      __syncthreads();
#pragma unroll
      for (int i = 0; i < 2; ++i) {
        const int n2 = (tid >> 3) + 32 * i, kc = tid & 7;
        h8 o;
#pragma unroll
        for (int q = 0; q < 8; ++q) o[q] = (half_t)T[(kc * 8 + q) * 65 + n2];
        *(h8*)(dst + (size_t)(nt * 64 + n2) * WP + kt * 64 + kc * 8) = o;
      }
      __syncthreads();
#pragma unroll
      for (int i = 0; i < 16; ++i) cur[i] = nxt[i];
    }
  }
  for (int task = blockIdx.x; task < total; task += gridDim.x) {
    int t = task;
    if (t < T_WIN) continue;
    if (t < T_WIN) {
      int l = t / (124 * 16); int r = t % (124 * 16); int nt = r / 16, kt = r % 16;
      transpose_tile(p.w_in + (size_t)l * 1024 * NIN, NIN, WinT + (size_t)l * NPAD * WP, WP, kt * 64, nt * 64, 1, lds);
      continue;
    }
    t -= T_WIN;
    if (t < T_WBR) {
      int lb = t / 128; int r = t % 128; int nt = r / 8, kt = r % 8;
      int l = lb / 3, b = lb % 3;
      const float* src = (b == 0 ? p.w_br_ret : (b == 1 ? p.w_br_dsa : p.w_br_gla)) + (size_t)l * 512 * 1024;
      transpose_tile(src, 1024, WbrT + (size_t)lb * 1024 * WBP, WBP, kt * 64, nt * 64, 0, lds);
      continue;
    }
    t -= T_WBR;
    if (t < T_WOUT) {
      int l = t / 256; int r = t % 256; int nt = r / 16, kt = r % 16;
      transpose_tile(p.w_out + (size_t)l * 1024 * 1024, 1024, WoutT + (size_t)l * 1024 * WP, WP, kt * 64, nt * 64, 0, lds);
      continue;
    }
    t -= T_WOUT;
    if (t < T_MOD) {
      int l = t / 48, jb = t % 48;
      int j = jb * 64 + (tid & 63);
      int ig = tid >> 6;
      float acc = 0.f;
      const float* aw = p.ada_w + (size_t)l * 1024 * 3072;
      for (int i = ig * 256; i < ig * 256 + 256; ++i) {
        float cv = p.c[i];
        float sc = cv / (1.f + expf(-cv));
        acc += sc * aw[(size_t)i * 3072 + j];
      }
      float* red = (float*)lds;
      red[tid] = acc;
      __syncthreads();
      if (tid < 64) {
        float s = red[tid] + red[tid + 64] + red[tid + 128] + red[tid + 192];
        MOD[l * 3072 + j] = s + p.ada_b[l * 3072 + j];
      }
      __syncthreads();
      continue;
    }
    t -= T_MOD;
    {
      int e = t * 256 + tid;
      int tok = e / 40, f = e % 40;
      float pf = (float)p.pos[tok];
      if (f < 32) {
        float fr = powf(10000.0f, -(float)f * 2.0f / 64.0f);
        float ang = pf * fr;
        RT[tok * 64 + f * 2] = cosf(ang);
        RT[tok * 64 + f * 2 + 1] = sinf(ang);
      } else {
        int g = f - 32;
        float fr = powf(500000.0f, -(float)g * 2.0f / 16.0f);
        float ang = pf * fr;
        DT[tok * 16 + g * 2] = cosf(ang);
        DT[tok * 16 + g * 2 + 1] = sinf(ang);
      }
    }
  }
}

__device__ __forceinline__ void write_h_row(const float (&xv)[16], const float* __restrict__ pre,
                                            const float* __restrict__ mod, half_t* __restrict__ hrow, int l) {
  float ss = 0.f;
#pragma unroll
  for (int i = 0; i < 16; ++i) ss += xv[i] * xv[i];
  ss = wave_sum(ss);
  float rs = rsqrtf(ss * (1.0f / 1024.0f) + 1e-6f);
#pragma unroll
  for (int i = 0; i < 4; ++i) {
    int c0 = i * 256 + l * 4;
    f4v pg = *(const f4v*)(pre + c0);
    f4v sh = *(const f4v*)(mod + c0);
    f4v sc = *(const f4v*)(mod + 1024 + c0);
    h4 o;
#pragma unroll
    for (int q = 0; q < 4; ++q) o[q] = (half_t)(xv[i * 4 + q] * rs * pg[q] * (1.f + sc[q]) + sh[q]);
    *(h4*)(hrow + c0) = o;
  }
}

__device__ void phase_h0(const Params& p) {
  const int w = otid() >> 6, l = otid() & 63;
  half_t* H = (half_t*)(p.ws + OFF_H);
  const float* MOD = (const float*)(p.ws + OFF_MOD);
  for (int row = blockIdx.x * 4 + w; row < S_LEN; row += gridDim.x * 4) {
    float xv[16];
#pragma unroll
    for (int i = 0; i < 4; ++i) {
      f4v v = *(const f4v*)(p.x + (size_t)row * 1024 + i * 256 + l * 4);
      xv[i * 4] = v[0]; xv[i * 4 + 1] = v[1]; xv[i * 4 + 2] = v[2]; xv[i * 4 + 3] = v[3];
    }
    write_h_row(xv, p.pre_norm, MOD, H + (size_t)row * HP, l);
  }
}

__device__ __forceinline__ void lds_barrier() {
  asm volatile("s_waitcnt lgkmcnt(0)" ::: "memory");
  __builtin_amdgcn_s_barrier();
  asm volatile("" ::: "memory");
}
#define GEMM_BUF 55296
#define GEMM_EOFF 110592
template <int NT>
__device__ __forceinline__ void gemm_step(f16v (&acc)[4][NT], h8 (&ra)[8], h8 (&rb)[2 * NT],
                                          const unsigned char* As, const unsigned char* Bs, unsigned char* Aw, unsigned char* Bw,
                                          const half_t* __restrict__ A, int lda, const half_t* __restrict__ B, int ldb, int kload,
                                          int wm, int wn, int l, int r0, int kc) {
  h8 af[2][4], bf[2][NT];
#pragma unroll
  for (int i = 0; i < 4; ++i) af[0][i] = *(const h8*)(As + (wm * 128 + i * 32 + (l & 31)) * 144 + (l >> 5) * 16);
#pragma unroll
  for (int j = 0; j < NT; ++j) bf[0][j] = *(const h8*)(Bs + (wn * 32 * NT + j * 32 + (l & 31)) * 144 + (l >> 5) * 16);
#pragma unroll
  for (int ks = 0; ks < 4; ++ks) {
    if (ks < 3) {
#pragma unroll
      for (int i = 0; i < 4; ++i) af[(ks + 1) & 1][i] = *(const h8*)(As + (wm * 128 + i * 32 + (l & 31)) * 144 + (ks + 1) * 32 + (l >> 5) * 16);
#pragma unroll
      for (int j = 0; j < NT; ++j) bf[(ks + 1) & 1][j] = *(const h8*)(Bs + (wn * 32 * NT + j * 32 + (l & 31)) * 144 + (ks + 1) * 32 + (l >> 5) * 16);
    }
    __builtin_amdgcn_sched_barrier(0);
#pragma unroll
    for (int i = 0; i < 4; ++i)
#pragma unroll
      for (int j = 0; j < NT; ++j) acc[i][j] = mfma16(af[ks & 1][i], bf[ks & 1][j], acc[i][j]);
#pragma unroll
    for (int i = 2 * ks; i < 2 * ks + 2; ++i) {
      *(h8*)(Aw + (r0 + 32 * i) * 144 + kc * 16) = ra[i];
      ra[i] = *(const h8*)(A + (size_t)(r0 + 32 * i) * lda + kload + kc * 8);
    }
    if (NT == 2) {
      *(h8*)(Bw + (r0 + 32 * ks) * 144 + kc * 16) = rb[ks];
      rb[ks] = *(const h8*)(B + (size_t)(r0 + 32 * ks) * ldb + kload + kc * 8);
    } else {
#pragma unroll
      for (int i = 2 * ks; i < 2 * ks + 2; ++i) {
        *(h8*)(Bw + (r0 + 32 * i) * 144 + kc * 16) = rb[i];
        rb[i] = *(const h8*)(B + (size_t)(r0 + 32 * i) * ldb + kload + kc * 8);
      }
    }
    __builtin_amdgcn_sched_barrier(0);
  }
}
template <int NT>
__device__ __forceinline__ void gemm_issue(h8 (&ra0)[8], h8 (&rb0)[2 * NT], h8 (&ra1)[8], h8 (&rb1)[2 * NT],
                                           const half_t* __restrict__ A, int lda, const half_t* __restrict__ B, int ldb) {
  const int tid = otid();
  const int kc = tid & 7, r0 = tid >> 3;
#pragma unroll
  for (int i = 0; i < 8; ++i) ra0[i] = *(const h8*)(A + (size_t)(r0 + 32 * i) * lda + kc * 8);
#pragma unroll
  for (int i = 0; i < 2 * NT; ++i) rb0[i] = *(const h8*)(B + (size_t)(r0 + 32 * i) * ldb + kc * 8);
#pragma unroll
  for (int i = 0; i < 8; ++i) ra1[i] = *(const h8*)(A + (size_t)(r0 + 32 * i) * lda + 64 + kc * 8);
#pragma unroll
  for (int i = 0; i < 2 * NT; ++i) rb1[i] = *(const h8*)(B + (size_t)(r0 + 32 * i) * ldb + 64 + kc * 8);
}
template <int NT>
__device__ __forceinline__ void gemm_run(f16v (&acc)[4][NT], h8 (&ra0)[8], h8 (&rb0)[2 * NT], h8 (&ra1)[8], h8 (&rb1)[2 * NT],
                                         const half_t* __restrict__ A, int lda, const half_t* __restrict__ B, int ldb, int K, unsigned char* lds) {
  const int tid = otid(), w = tid >> 6, l = tid & 63;
  constexpr int STAGE = 256 * 144 + 64 * NT * 144;
  unsigned char* A0 = lds;
  unsigned char* B0 = lds + 256 * 144;
  unsigned char* A1 = lds + STAGE;
  unsigned char* B1 = lds + STAGE + 256 * 144;
  const int wm = w >> 1, wn = w & 1;
  const int kc = tid & 7;
  const int r0 = tid >> 3;
  lds_barrier();
#pragma unroll
  for (int i = 0; i < 8; ++i) { *(h8*)(A0 + (r0 + 32 * i) * 144 + kc * 16) = ra0[i]; ra0[i] = *(const h8*)(A + (size_t)(r0 + 32 * i) * lda + 128 + kc * 8); }
#pragma unroll
  for (int i = 0; i < 2 * NT; ++i) { *(h8*)(B0 + (r0 + 32 * i) * 144 + kc * 16) = rb0[i]; rb0[i] = *(const h8*)(B + (size_t)(r0 + 32 * i) * ldb + 128 + kc * 8); }
  lds_barrier();
  const int nk = K / 64;
#pragma unroll 1
  for (int kt = 0; kt < nk; kt += 2) {
    gemm_step<NT>(acc, ra1, rb1, A0, B0, A1, B1, A, lda, B, ldb, (kt + 3 < nk) ? (kt + 3) * 64 : 0, wm, wn, l, r0, kc);
    lds_barrier();
    gemm_step<NT>(acc, ra0, rb0, A1, B1, A0, B0, A, lda, B, ldb, (kt + 4 < nk) ? (kt + 4) * 64 : 0, wm, wn, l, r0, kc);
    lds_barrier();
  }
}
template <int NT>
__device__ __forceinline__ void gemm_kloop(f16v (&acc)[4][NT], const half_t* __restrict__ A, int lda,
                                           const half_t* __restrict__ B, int ldb, int K, unsigned char* lds) {
  h8 ra0[8], rb0[2 * NT], ra1[8], rb1[2 * NT];
  gemm_issue<NT>(ra0, rb0, ra1, rb1, A, lda, B, ldb);
  gemm_run<NT>(acc, ra0, rb0, ra1, rb1, A, lda, B, ldb, K, lds);
}

template <int NT>
__device__ __forceinline__ void gemm_issue1(h8 (&ra)[8], h8 (&rb)[2 * NT], const half_t* __restrict__ A, int lda, const half_t* __restrict__ B, int ldb) {
  const int tid = otid();
  const int kc = tid & 7, r0 = tid >> 3;
#pragma unroll
  for (int i = 0; i < 8; ++i) ra[i] = *(const h8*)(A + (size_t)(r0 + 32 * i) * lda + kc * 8);
#pragma unroll
  for (int i = 0; i < 2 * NT; ++i) rb[i] = *(const h8*)(B + (size_t)(r0 + 32 * i) * ldb + kc * 8);
}
template <int NT>
__device__ __forceinline__ void gemm_run1(f16v (&acc)[4][NT], h8 (&ra)[8], h8 (&rb)[2 * NT],
                                          const half_t* __restrict__ A, int lda, const half_t* __restrict__ B, int ldb, int K, unsigned char* lds) {
  const int tid = otid(), w = tid >> 6, l = tid & 63;
  constexpr int STAGE = 256 * 144 + 64 * NT * 144;
  const int wm = w >> 1, wn = w & 1;
  const int kc = tid & 7;
  const int r0 = tid >> 3;
  lds_barrier();
#pragma unroll
  for (int i = 0; i < 8; ++i) { *(h8*)(lds + (r0 + 32 * i) * 144 + kc * 16) = ra[i]; ra[i] = *(const h8*)(A + (size_t)(r0 + 32 * i) * lda + 64 + kc * 8); }
#pragma unroll
  for (int i = 0; i < 2 * NT; ++i) { *(h8*)(lds + 256 * 144 + (r0 + 32 * i) * 144 + kc * 16) = rb[i]; rb[i] = *(const h8*)(B + (size_t)(r0 + 32 * i) * ldb + 64 + kc * 8); }
  lds_barrier();
  const int nk = K / 64;
#pragma unroll 1
  for (int kt = 0; kt < nk; ++kt) {
    unsigned char* cur = lds + (kt & 1) * STAGE;
    unsigned char* nxt = lds + ((kt + 1) & 1) * STAGE;
    gemm_step<NT>(acc, ra, rb, cur, cur + 256 * 144, nxt, nxt + 256 * 144, A, lda, B, ldb, (kt + 2 < nk) ? (kt + 2) * 64 : 0, wm, wn, l, r0, kc);
    lds_barrier();
  }
}

template <int NT>
__device__ __forceinline__ void zero_acc(f16v (&acc)[4][NT]) {
  float z = 0.f;
  asm volatile("" : "+v"(z));
#pragma unroll
  for (int i = 0; i < 4; ++i)
#pragma unroll
    for (int j = 0; j < NT; ++j)
#pragma unroll
      for (int r = 0; r < 16; ++r) acc[i][j][r] = z;
}

#define EP 68
__device__ __forceinline__ void stage_pair(float* E, const f16v& a0, const f16v& a1, int l) {
#pragma unroll
  for (int r = 0; r < 16; ++r) {
    const int rr = crow(r, l);
    E[rr * EP + (l & 31)] = a0[r];
    E[rr * EP + 32 + (l & 31)] = a1[r];
  }
}
__device__ __forceinline__ void ld8(const float* p, float (&v)[8]) {
  const f4v a = *(const f4v*)p, b = *(const f4v*)(p + 4);
  v[0] = a[0]; v[1] = a[1]; v[2] = a[2]; v[3] = a[3]; v[4] = b[0]; v[5] = b[1]; v[6] = b[2]; v[7] = b[3];
}
__device__ __forceinline__ int xcc_census(const unsigned* xcnt, int my_xcc) {
  unsigned sum = 0; bool ok = my_xcc < 8; int mine = 0;
#pragma unroll
  for (int j = 0; j < 16; ++j) {
    const unsigned c = __hip_atomic_load(xcnt + j, __ATOMIC_RELAXED, __HIP_MEMORY_SCOPE_AGENT);
    sum += c;
    if (j < 8 && c == 0u) ok = false;
    if (j >= 8 && c != 0u) ok = false;
    if (j == my_xcc) mine = (int)c;
  }
  if (sum != gridDim.x) ok = false;
  return ok ? mine : 0;
}

__device__ void phase_A(const Params& p, int layer, unsigned char* lds, int my_xcc, int my_loc, const unsigned* xcnt) {
  const int tid = otid(), w = tid >> 6, l = tid & 63;
  const half_t* H = (const half_t*)(p.ws + OFF_H);
  const half_t* Wt = (const half_t*)(p.ws + OFF_WINT) + (size_t)layer * NPAD * WP;
  half_t* P = (half_t*)(p.ws + OFF_P);
  float* GA = (float*)(p.ws + OFF_GA);
  float* IW = (float*)(p.ws + OFF_IW);
  const float* RT = (const float*)(p.ws + OFF_RT);
  const float* DT = (const float*)(p.ws + OFF_DT);
  const int wm = w >> 1, wn = w & 1;
  const int G = gridDim.x;
  const int ntiles = 64 * 31;
  const int nx = xcc_census(xcnt, my_xcc);
  int nmine;
  if (nx > 0) nmine = (my_loc < 248) ? (248 - my_loc + nx - 1) / nx : 0;
  else nmine = ((int)blockIdx.x < ntiles) ? (ntiles - (int)blockIdx.x + G - 1) / G : 0;
  h8 ra0[8], rb0[8];
  int mt = 0, nt = 0;
  if (nmine > 0) {
    if (nx > 0) { const int s0 = my_loc; mt = my_xcc * 8 + (s0 & 7); nt = s0 >> 3; }
    else { const int tix = blockIdx.x; mt = tix & 63; nt = tix >> 6; }
    gemm_issue1<4>(ra0, rb0, H + (size_t)mt * 256 * HP, HP, Wt + (size_t)nt * 256 * WP, WP);
  }
#pragma unroll 1
  for (int rnd = 0; rnd < nmine; ++rnd) {
    f16v acc[4][4];
    zero_acc<4>(acc);
    gemm_run1<4>(acc, ra0, rb0, H + (size_t)mt * 256 * HP, HP, Wt + (size_t)nt * 256 * WP, WP, 1024, lds);
    const int mt_cur = mt, nt_cur = nt;
    if (rnd + 1 < nmine) {
      if (nx > 0) { const int s1 = my_loc + nx * (rnd + 1); mt = my_xcc * 8 + (s1 & 7); nt = s1 >> 3; }
      else { const int tix = (rnd + 1) * G + blockIdx.x; mt = tix & 63; nt = tix >> 6; }
      gemm_issue1<4>(ra0, rb0, H + (size_t)mt * 256 * HP, HP, Wt + (size_t)nt * 256 * WP, WP);
    }
    const int m0w = mt_cur * 256 + wm * 128;
    const int n0w = nt_cur * 256 + wn * 128;
    float* E = (float*)(lds) + w * (32 * EP);
    const int prow = l >> 3, c0 = (l & 7) * 8;
#pragma unroll
    for (int jp = 0; jp < 2; ++jp) {
      const int nb2 = n0w + jp * 64;
      const int n0 = nb2 + c0;
      const bool rope64 = nb2 < 512;
      const bool rope16 = ((nb2 >= C_DSAQ && nb2 < C_DSAV) || (nb2 >= C_IDXQ && nb2 < C_GLAQ)) && (c0 < 16);
      float scale = 1.f;
      if (n0 < 256 || (n0 >= C_DSAQ && n0 < C_DSAK) || (n0 >= C_IDXQ && n0 < C_IDXK) || (n0 >= C_GLAQ && n0 < C_GLAK)) scale = 0.125f;
      int mode = 0;
      if ((n0 >= C_RETG && n0 < C_DSAQ) || (n0 >= C_DSAG && n0 < C_IDXQ) || (n0 >= C_GLAG && n0 < C_GLAA)) mode = 1;
      if (n0 >= C_MRG && n0 < C_END) mode = 2;
#pragma unroll
      for (int i = 0; i < 4; ++i) {
        stage_pair(E, acc[i][2 * jp], acc[i][2 * jp + 1], l);
#pragma unroll 2
        for (int ps = 0; ps < 4; ++ps) {
          const int rl = ps * 8 + prow;
          const int row = m0w + i * 32 + rl;
          float v[8], o[8];
          ld8(E + rl * EP + c0, v);
#pragma unroll
          for (int q = 0; q < 8; ++q) o[q] = v[q];
          if (rope64) {
            float pv[8], tb[16];
            ld8(E + rl * EP + (c0 ^ 32), pv);
            const float* tp = RT + (size_t)row * 64 + (c0 & 31) * 2;
            ld8(tp, *(float(*)[8])&tb[0]); ld8(tp + 8, *(float(*)[8])&tb[8]);
#pragma unroll
            for (int q = 0; q < 8; ++q) o[q] = (c0 < 32) ? (v[q] * tb[2 * q] - pv[q] * tb[2 * q + 1]) : (v[q] * tb[2 * q] + pv[q] * tb[2 * q + 1]);
          } else if (rope16) {
            float pv[8], tb[16];
            ld8(E + rl * EP + (c0 ^ 8), pv);
            const float* tp = DT + (size_t)row * 16;
            ld8(tp, *(float(*)[8])&tb[0]); ld8(tp + 8, *(float(*)[8])&tb[8]);
#pragma unroll
            for (int q = 0; q < 8; ++q) o[q] = (c0 < 8) ? (v[q] * tb[2 * q] - pv[q] * tb[2 * q + 1]) : (v[q] * tb[2 * q] + pv[q] * tb[2 * q + 1]);
          }
          h8 ov;
#pragma unroll
          for (int q = 0; q < 8; ++q) {
            float t = o[q] * scale;
            if (mode != 0) {
              const float sg = __builtin_amdgcn_rcpf(1.f + __expf(-t));
              t = (mode == 1) ? t * sg : sg;
            }
            ov[q] = (half_t)t;
          }
          if (n0 < C_END) __builtin_nontemporal_store(ov, (h8*)(P + (size_t)row * PP + n0));
          if (n0 >= C_GLAA && n0 < C_MRG) {
#pragma unroll
            for (int q = 0; q < 8; ++q) GA[(size_t)row * 16 + (n0 - C_GLAA) + q] = v[q];
          }
          if (n0 == C_IDXW) {
#pragma unroll
            for (int q = 0; q < 4; ++q) IW[(size_t)row * 4 + q] = 0.5f * v[q];
          }
        }
      }
    }
  }
}

#define LA_BC 0
#define LA_GAS 16640
#define LA_WL 20736
#define LA_QT 24832
#define LA_KT 34048
#define LA_AT 43264
#define LA_VT 52480
#define LA_SS 70912
#define LA_OS 89344
#define LA_SEG 123136

__device__ void la_bcum(const Params& p, int layer, int n, int Hh, unsigned char* lds) {
  const int tid = otid();
  float* Bc = (float*)(lds + LA_BC);
  const int d = tid & 63, q = tid >> 6;
  if (Hh < 4) {
    float lg = log1pf(-exp2f(-5.0f - (float)Hh));
#pragma unroll
    for (int jj = 0; jj < 16; ++jj) { int j = q * 16 + jj; Bc[j * 65 + d] = (float)(j + 1) * lg; }
    __syncthreads();
    return;
  }
  const int h = Hh - 4;
  float* GAs = (float*)(lds + LA_GAS);
  float* WL = (float*)(lds + LA_WL);
  float* SEG = (float*)(lds + LA_SEG);
  const float* GA = (const float*)(p.ws + OFF_GA);
#pragma unroll
  for (int i = 0; i < 4; ++i) {
    int e = tid + 256 * i;
    GAs[e] = GA[(size_t)n * 64 * 16 + e];
    int r = e >> 6, dd = e & 63;
    WL[e] = p.gla_w_lr[(size_t)layer * 16 * 256 + r * 256 + h * 64 + dd];
  }
  __syncthreads();
  float wl[16];
#pragma unroll
  for (int r = 0; r < 16; ++r) wl[r] = WL[r * 64 + d];
  const float bl = p.gla_b_lr[layer * 256 + h * 64 + d];
  float run = 0.f;
#pragma unroll
  for (int jj = 0; jj < 16; ++jj) {
    int j = q * 16 + jj;
    float z = bl;
#pragma unroll
    for (int r = 0; r < 16; ++r) z += GAs[j * 16 + r] * wl[r];
    float ls = fminf(z, 0.f) - __logf(1.f + __expf(-fabsf(z)));
    run += ls * (1.0f / 16.0f);
    Bc[j * 65 + d] = run;
  }
  SEG[q * 64 + d] = run;
  __syncthreads();
  float off = 0.f;
  for (int qq = 0; qq < q; ++qq) off += SEG[qq * 64 + d];
  if (q > 0) {
#pragma unroll
    for (int jj = 0; jj < 16; ++jj) { int j = q * 16 + jj; Bc[j * 65 + d] += off; }
  }
  __syncthreads();
}

__device__ __forceinline__ void la_load_v(const half_t* __restrict__ P, int t0, int vcol, h8 (&vr)[2][2]) {
  const int tid = otid(), w = tid >> 6, l = tid & 63;
  const int jp = l & 31, cgp = l >> 5;
#pragma unroll
  for (int it = 0; it < 2; ++it) {
    int c = it * 8 + w * 2 + cgp;
    vr[it][0] = *(const h8*)(P + (size_t)(t0 + 2 * jp) * PP + vcol + c * 8);
    vr[it][1] = *(const h8*)(P + (size_t)(t0 + 2 * jp + 1) * PP + vcol + c * 8);
  }
}
__device__ __forceinline__ void la_stage_vt(const h8 (&vr)[2][2], unsigned char* lds) {
  const int tid = otid(), w = tid >> 6, l = tid & 63;
  half_t* VT = (half_t*)(lds + LA_VT);
  const int jp = l & 31, cgp = l >> 5;
#pragma unroll
  for (int it = 0; it < 2; ++it) {
    int c = it * 8 + w * 2 + cgp;
#pragma unroll
    for (int q = 0; q < 8; ++q) {
      h2 pr; pr[0] = vr[it][0][q]; pr[1] = vr[it][1][q];
      *(h2*)(VT + (c * 8 + q) * 72 + 2 * jp) = pr;
    }
  }
}
__device__ void la_item_kv(const Params& p, int layer, int item, unsigned char* lds) {
  const int tid = otid(), w = tid >> 6, l = tid & 63;
  const int n = item >> 3, Hh = item & 7;
  const int t0 = n * 64;
  const half_t* P = (const half_t*)(p.ws + OFF_P);
  half_t* ST = (half_t*)(p.ws + OFF_ST);
  float* DEC = (float*)(p.ws + OFF_DEC);
  const int kcol = (Hh < 4) ? (C_RETK + Hh * 64) : (C_GLAK + (Hh - 4) * 64);
  const int vcol = (Hh < 4) ? (C_RETV + Hh * 128) : (C_GLAV + (Hh - 4) * 128);
  h8 vr[2][2];
  la_load_v(P, t0, vcol, vr);
  const h8 k0 = *(const h8*)(P + (size_t)(t0 + 2 * (l & 31)) * PP + kcol + (w * 2 + (l >> 5)) * 8);
  const h8 k1 = *(const h8*)(P + (size_t)(t0 + 2 * (l & 31) + 1) * PP + kcol + (w * 2 + (l >> 5)) * 8);
  __syncthreads();
  la_bcum(p, layer, n, Hh, lds);
  const float* Bc = (const float*)(lds + LA_BC);
  half_t* KhT = (half_t*)(lds + LA_KT);
  half_t* VT = (half_t*)(lds + LA_VT);
  {
    const int jp = l & 31, cgp = l >> 5;
    int c = w * 2 + cgp;
#pragma unroll
    for (int q = 0; q < 8; ++q) {
      int d = c * 8 + q;
      float bl = Bc[63 * 65 + d];
      h2 pr;
      pr[0] = (half_t)((float)k0[q] * __expf(bl - Bc[(2 * jp) * 65 + d]));
      pr[1] = (half_t)((float)k1[q] * __expf(bl - Bc[(2 * jp + 1) * 65 + d]));
      *(h2*)(KhT + d * 72 + 2 * jp) = pr;
    }
  }
  la_stage_vt(vr, lds);
  if (tid < 64) DEC[(size_t)item * 64 + tid] = __expf(Bc[63 * 65 + tid]);
  __syncthreads();
  f16v acc[2];
#pragma unroll
  for (int j = 0; j < 2; ++j)
#pragma unroll
    for (int r = 0; r < 16; ++r) acc[j][r] = ozero();
#pragma unroll
  for (int ks = 0; ks < 4; ++ks) {
    h8 a = *(const h8*)(VT + (32 * w + (l & 31)) * 72 + ks * 16 + (l >> 5) * 8);
#pragma unroll
    for (int j = 0; j < 2; ++j) {
      h8 b = *(const h8*)(KhT + (j * 32 + (l & 31)) * 72 + ks * 16 + (l >> 5) * 8);
      acc[j] = mfma16(a, b, acc[j]);
    }
  }
#pragma unroll
  for (int j = 0; j < 2; ++j)
#pragma unroll
    for (int r = 0; r < 16; ++r) {
      int e = 32 * w + crow(r, l);
      int d = j * 32 + (l & 31);
      ST[(size_t)item * 8192 + e * 64 + d] = (half_t)acc[j][r];
    }
}

__device__ void phase_scan(const Params& p) {
  half_t* ST = (half_t*)(p.ws + OFF_ST);
  const float* DEC = (const float*)(p.ws + OFF_DEC);
  for (int f2 = blockIdx.x * NTHREADS + otid(); f2 < 32768; f2 += gridDim.x * NTHREADS) {
    const int f = f2 * 2;
    const int Hh = f >> 13, d = f & 63;
    float s0 = 0.f, s1 = 0.f;
    for (int n0 = 0; n0 < 256; n0 += 16) {
      h2 kv[16]; float2 dc[16];
#pragma unroll
      for (int u = 0; u < 16; ++u) {
        kv[u] = *(const h2*)(ST + (size_t)(n0 + u) * 65536 + f);
        dc[u] = *(const float2*)(DEC + (size_t)((n0 + u) * 8 + Hh) * 64 + d);
      }
#pragma unroll
      for (int u = 0; u < 16; ++u) {
        h2 o; o[0] = (half_t)s0; o[1] = (half_t)s1;
        *(h2*)(ST + (size_t)(n0 + u) * 65536 + f) = o;
        s0 = dc[u].x * s0 + (float)kv[u][0];
        s1 = dc[u].y * s1 + (float)kv[u][1];
      }
    }
  }
}

__device__ void la_item_out(const Params& p, int layer, int item, unsigned char* lds) {
  const int tid = otid(), w = tid >> 6, l = tid & 63;
  const int n = item >> 3, Hh = item & 7;
  const int t0 = n * 64;
  const half_t* P = (const half_t*)(p.ws + OFF_P);
  const half_t* ST = (const half_t*)(p.ws + OFF_ST);
  half_t* BR = (half_t*)(p.ws + OFF_BR);
  const int qcol = (Hh < 4) ? (C_RETQ + Hh * 64) : (C_GLAQ + (Hh - 4) * 64);
  const int kcol = (Hh < 4) ? (C_RETK + Hh * 64) : (C_GLAK + (Hh - 4) * 64);
  const int vcol = (Hh < 4) ? (C_RETV + Hh * 128) : (C_GLAV + (Hh - 4) * 128);
  const int gcol = (Hh < 4) ? (C_RETG + Hh * 128) : (C_GLAG + (Hh - 4) * 128);
  const int ocol = (Hh < 4) ? (Hh * 128) : (1024 + (Hh - 4) * 128);
  h8 vr[2][2];
  la_load_v(P, t0, vcol, vr);
  h8 qr[2], kr[2], sr[4];
#pragma unroll
  for (int it = 0; it < 2; ++it) {
    const int c = tid + 256 * it;
    qr[it] = *(const h8*)(P + (size_t)(t0 + (c >> 3)) * PP + qcol + (c & 7) * 8);
    kr[it] = *(const h8*)(P + (size_t)(t0 + (c >> 3)) * PP + kcol + (c & 7) * 8);
  }
#pragma unroll
  for (int it = 0; it < 4; ++it) {
    const int c = tid + 256 * it;
    sr[it] = *(const h8*)(ST + (size_t)item * 8192 + (c >> 3) * 64 + (c & 7) * 8);
  }
  __syncthreads();
  la_bcum(p, layer, n, Hh, lds);
  const float* Bc = (const float*)(lds + LA_BC);
  half_t* Qt = (half_t*)(lds + LA_QT);
  half_t* Kt = (half_t*)(lds + LA_KT);
  half_t* AT = (half_t*)(lds + LA_AT);
  half_t* VT = (half_t*)(lds + LA_VT);
  half_t* SS = (half_t*)(lds + LA_SS);
  float* OS = (float*)(lds + LA_OS);
#pragma unroll
  for (int it = 0; it < 2; ++it) {
    int c = tid + 256 * it;
    int row = c >> 3, kc = c & 7;
    const h8 qv = qr[it];
    const h8 kv = kr[it];
    h8 qo, ko;
#pragma unroll
    for (int q = 0; q < 8; ++q) {
      float b = Bc[row * 65 + kc * 8 + q];
      qo[q] = (half_t)((float)qv[q] * __expf(b));
      ko[q] = (half_t)((float)kv[q] * __expf(-b));
    }
    *(h8*)(Qt + row * 72 + kc * 8) = qo;
    *(h8*)(Kt + row * 72 + kc * 8) = ko;
  }
  la_stage_vt(vr, lds);
#pragma unroll
  for (int it = 0; it < 4; ++it) {
    int c = tid + 256 * it;
    int e = c >> 3, kc = c & 7;
    *(h8*)(SS + e * 72 + kc * 8) = sr[it];
  }
  __syncthreads();
  {
    const int mi = w >> 1, nj = w & 1;
    f16v acc;
#pragma unroll
    for (int r = 0; r < 16; ++r) acc[r] = ozero();
#pragma unroll
    for (int ks = 0; ks < 4; ++ks) {
      h8 a = *(const h8*)(Qt + (mi * 32 + (l & 31)) * 72 + ks * 16 + (l >> 5) * 8);
      h8 b = *(const h8*)(Kt + (nj * 32 + (l & 31)) * 72 + ks * 16 + (l >> 5) * 8);
      acc = mfma16(a, b, acc);
    }
#pragma unroll
    for (int r = 0; r < 16; ++r) {
      int i = mi * 32 + crow(r, l);
      int j = nj * 32 + (l & 31);
      float v = (j <= i) ? acc[r] : 0.f;
      AT[i * 72 + j] = (half_t)v;
    }
  }
  __syncthreads();
  {
    const int mi = w >> 1, nh = w & 1;
    f16v acc[2];
#pragma unroll
    for (int j = 0; j < 2; ++j)
#pragma unroll
      for (int r = 0; r < 16; ++r) acc[j][r] = ozero();
#pragma unroll
    for (int ks = 0; ks < 4; ++ks) {
      h8 a1 = *(const h8*)(AT + (mi * 32 + (l & 31)) * 72 + ks * 16 + (l >> 5) * 8);
      h8 a2 = *(const h8*)(Qt + (mi * 32 + (l & 31)) * 72 + ks * 16 + (l >> 5) * 8);
#pragma unroll
      for (int j = 0; j < 2; ++j) {
        h8 b1 = *(const h8*)(VT + (nh * 64 + j * 32 + (l & 31)) * 72 + ks * 16 + (l >> 5) * 8);
        h8 b2 = *(const h8*)(SS + (nh * 64 + j * 32 + (l & 31)) * 72 + ks * 16 + (l >> 5) * 8);
        acc[j] = mfma16(a1, b1, acc[j]);
        acc[j] = mfma16(a2, b2, acc[j]);
      }
    }
#pragma unroll
    for (int j = 0; j < 2; ++j)
#pragma unroll
      for (int r = 0; r < 16; ++r) {
        int i = mi * 32 + crow(r, l);
        int e = nh * 64 + j * 32 + (l & 31);
        OS[i * 132 + e] = acc[j][r];
      }
  }
  __syncthreads();
  {
    const int i = tid >> 2, qd = tid & 3;
    float ov[32];
    float ss = 0.f;
#pragma unroll
    for (int c = 0; c < 8; ++c) {
      f4v v = *(const f4v*)(OS + i * 132 + qd * 32 + c * 4);
      ov[c * 4] = v[0]; ov[c * 4 + 1] = v[1]; ov[c * 4 + 2] = v[2]; ov[c * 4 + 3] = v[3];
      ss += v[0] * v[0] + v[1] * v[1] + v[2] * v[2] + v[3] * v[3];
    }
    ss += dppf<0xB1>(ss);
    ss += dppf<0x4E>(ss);
    float rs = rsqrtf(ss * (1.0f / 128.0f) + 1e-6f);
#pragma unroll
    for (int c = 0; c < 4; ++c) {
      h8 g = *(const h8*)(P + (size_t)(t0 + i) * PP + gcol + qd * 32 + c * 8);
      h8 o;
#pragma unroll
      for (int q = 0; q < 8; ++q) o[q] = (half_t)(ov[c * 8 + q] * rs * (float)g[q]);
      *(h8*)(BR + (size_t)(t0 + i) * 1536 + ocol + qd * 32 + c * 8) = o;
    }
  }
}

#define DS_CAP 768
#define DS_PRUNE_AT 640
#define NPL 12
#define DS_LS 0
#define DS_LI (32 * DS_CAP * 4)
#define DS_CNT (32 * DS_CAP * 6)
#define DS_THR (DS_CNT + 128)
#define DS_WQ (DS_CNT + 256)
#define DS_HIST (DS_CNT + 1024)

__device__ __forceinline__ unsigned long long wave_or64(unsigned long long v) {
  const unsigned lo = wave_or((unsigned)v), hi = wave_or((unsigned)(v >> 32));
  return ((unsigned long long)hi << 32) | lo;
}
template <bool APPROX>
__device__ __forceinline__ void dsa_prune(float* LSm, unsigned short* LIm, int n, unsigned* hist, int* cntm, float* thrm, int l) {
  unsigned long long comp[NPL];
  bool act[NPL], val[NPL];
#pragma unroll
  for (int k = 0; k < NPL; ++k) {
    int e = l + 64 * k;
    val[k] = e < n;
    const int ec = val[k] ? e : 0;
    unsigned u = __float_as_uint(LSm[ec]), li = LIm[ec];
    if (!val[k]) { u = 0; li = 0; }
    const unsigned key = (u >> 31) ? ~u : (u | 0x80000000u);
    comp[k] = ((unsigned long long)key << 14) | (unsigned long long)(16383u - li);
    act[k] = val[k];
  }
  const unsigned long long c0 = ((unsigned long long)(unsigned)__builtin_amdgcn_readfirstlane((int)(unsigned)(comp[0] >> 32)) << 32) | (unsigned)__builtin_amdgcn_readfirstlane((int)(unsigned)comp[0]);
  unsigned long long x = 0;
#pragma unroll
  for (int k = 0; k < NPL; ++k) x |= val[k] ? (comp[k] ^ c0) : 0ull;
  x = wave_or64(x);
  int shift = (x == 0ull) ? 0 : (63 - __clzll((long long)x)) - 7;
  if (shift < 0) shift = 0;
  unsigned rank = 256;
  bool fast = false; unsigned fsel = 0, fcnt = 0; int fshift = 0;
#pragma unroll 1
  for (int rd = 0; rd < 8; ++rd) {
    *(uint4*)(hist + 4 * l) = make_uint4(0, 0, 0, 0);
    asm volatile("" ::: "memory");
    unsigned dk[NPL];
#pragma unroll
    for (int k = 0; k < NPL; ++k) {
      dk[k] = (unsigned)(comp[k] >> shift) & 255u;
      if (act[k]) atomicAdd(&hist[dk[k]], 1u);
    }
    asm volatile("" ::: "memory");
    uint4 hv; hv.x = hist[4 * l]; hv.y = hist[4 * l + 1]; hv.z = hist[4 * l + 2]; hv.w = hist[4 * l + 3];
    unsigned tl = hv.x + hv.y + hv.z + hv.w;
    const unsigned pin = wave_incl_scan(tl);
    const unsigned tot = (unsigned)__builtin_amdgcn_readlane((int)pin, 63);
    unsigned sx = tot - pin;
    bool mine = (sx < rank) && (rank <= sx + tl);
    unsigned dsel = 0, nr = 0, hsel = 0;
    if (mine) {
      unsigned c = sx;
      if (c + hv.w >= rank) { dsel = 4 * l + 3; nr = rank - c; hsel = hv.w; }
      else {
        c += hv.w;
        if (c + hv.z >= rank) { dsel = 4 * l + 2; nr = rank - c; hsel = hv.z; }
        else {
          c += hv.z;
          if (c + hv.y >= rank) { dsel = 4 * l + 1; nr = rank - c; hsel = hv.y; }
          else { c += hv.y; dsel = 4 * l; nr = rank - c; hsel = hv.x; }
        }
      }
    }
    unsigned long long mk = __ballot(mine);
    int src = (mk == 0ull) ? 0 : (__ffsll((long long)mk) - 1);
    dsel = (unsigned)__builtin_amdgcn_readlane((int)dsel, src);
    rank = (unsigned)__builtin_amdgcn_readlane((int)nr, src);
    hsel = (unsigned)__builtin_amdgcn_readlane((int)hsel, src);
    if (APPROX && rd == 0) {
      const unsigned kept = 256u - rank + hsel;
      if (kept <= 320u) { fast = true; fsel = dsel; fcnt = kept; fshift = shift; break; }
    }
#pragma unroll
    for (int k = 0; k < NPL; ++k) act[k] = act[k] && (dk[k] == dsel);
    if (hsel <= 1u || shift == 0) break;
    shift = (shift >= 8) ? (shift - 8) : 0;
  }
  unsigned long long tsel = 0;
#pragma unroll
  for (int k = 0; k < NPL; ++k) tsel |= act[k] ? comp[k] : 0ull;
  unsigned long long T = 0ull;
  if (!fast) T = wave_or64(tsel);
  else T = ((c0 >> (fshift + 8)) << (fshift + 8)) | ((unsigned long long)fsel << fshift);
  bool keep[NPL];
  unsigned cntk = 0;
#pragma unroll
  for (int k = 0; k < NPL; ++k) {
    keep[k] = val[k] && (comp[k] >= T);
    cntk += keep[k] ? 1u : 0u;
  }
  unsigned pos = wave_incl_scan(cntk) - cntk;
  asm volatile("" ::: "memory");
#pragma unroll
  for (int k = 0; k < NPL; ++k) {
    if (keep[k]) {
      const unsigned kk = (unsigned)(comp[k] >> 14);
      const unsigned u = (kk & 0x80000000u) ? (kk & 0x7FFFFFFFu) : ~kk;
      LSm[pos] = __uint_as_float(u);
      LIm[pos] = (unsigned short)(16383u - ((unsigned)comp[k] & 16383u));
      ++pos;
    }
  }
  if (l == 0) {
    const unsigned T32 = (unsigned)(T >> 14);
    *cntm = fast ? (int)fcnt : 256;
    *thrm = __uint_as_float((T32 & 0x80000000u) ? (T32 & 0x7FFFFFFFu) : ~T32);
  }
  asm volatile("" ::: "memory");
}

__device__ void dsa_item(const Params& p, int qb, unsigned char* lds) {
  const int tid = otid(), w = tid >> 6, l = tid & 63;
  const int t0 = qb * 32;
  const half_t* P = (const half_t*)(p.ws + OFF_P);
  const float* IW = (const float*)(p.ws + OFF_IW);
  half_t* BR = (half_t*)(p.ws + OFF_BR);
  float* LS = (float*)(lds + DS_LS);
  unsigned short* LI = (unsigned short*)(lds + DS_LI);
  int* cnt = (int*)(lds + DS_CNT);
  float* thr = (float*)(lds + DS_THR);
  float* wq = (float*)(lds + DS_WQ);
  unsigned* hist = (unsigned*)(lds + DS_HIST) + w * 256;
  float* PWa = LS + (w * 8) * DS_CAP + 256;
  float* PWb = LS + (w * 8 + 1) * DS_CAP + 256;
  half_t* QS = (half_t*)(LI + (w * 8) * DS_CAP + 256);
  for (int rep_sel = 0; rep_sel < REP_SEL; ++rep_sel) {
  __syncthreads();
  if (tid < 32) { cnt[tid] = 0; thr[tid] = -INFINITY; }
  if (tid < 128) wq[tid] = IW[(size_t)t0 * 4 + tid];
  __syncthreads();
  h8 aq[4][4];
#pragma unroll
  for (int h = 0; h < 4; ++h)
#pragma unroll
    for (int ks = 0; ks < 4; ++ks)
      aq[h][ks] = *(const h8*)(P + (size_t)(t0 + (l & 31)) * PP + C_IDXQ + h * 64 + ks * 16 + (l >> 5) * 8);
  const int nt = qb + 1;
  const int nr = (nt + 3) >> 2;
  const int mq = l & 31;
  const f4v wv = *(const f4v*)(wq + mq * 4);
  float th = -INFINITY; asm volatile("" : "+v"(th));
  h8 bk[4];
  {
    const int k0 = (w < nt) ? w : 0;
#pragma unroll
    for (int ks = 0; ks < 4; ++ks)
      bk[ks] = *(const h8*)(P + (size_t)(k0 * 32 + (l & 31)) * PP + C_IDXK + ks * 16 + (l >> 5) * 8);
  }
#pragma unroll 1
  for (int rd = 0; rd < nr; ++rd) {
    const int kt = 4 * rd + w;
    h8 bkn[4];
    {
      const int kn = (kt + 4 < nt) ? (kt + 4) : 0;
#pragma unroll
      for (int ks = 0; ks < 4; ++ks)
        bkn[ks] = *(const h8*)(P + (size_t)(kn * 32 + (l & 31)) * PP + C_IDXK + ks * 16 + (l >> 5) * 8);
    }
    if (kt < nt) {
      const int sbase = kt * 32;
      f16v acc[4];
#pragma unroll
      for (int h = 0; h < 4; ++h) {
#pragma unroll
        for (int r = 0; r < 16; ++r) acc[h][r] = ozero();
#pragma unroll
        for (int ks = 0; ks < 4; ++ks) acc[h] = mfma16(bk[ks], aq[h][ks], acc[h]);
      }
      float scv[16];
#pragma unroll
      for (int r = 0; r < 16; ++r) {
        float sc = wv[0] * relu_f(acc[0][r]) + wv[1] * relu_f(acc[1][r]) + wv[2] * relu_f(acc[2][r]) + wv[3] * relu_f(acc[3][r]);
        sc += 0.0f;
        scv[r] = sc;
      }
      if (kt == qb) {
#pragma unroll
        for (int r = 0; r < 16; ++r) if (sbase + crow(r, l) > t0 + mq) scv[r] = -INFINITY;
      }
      unsigned pm = 0;
#pragma unroll
      for (int r = 0; r < 16; ++r) pm |= (scv[r] > th) ? (1u << r) : 0u;
      const int np = __popc(pm);
      if (__ballot(np > 0) != 0ull) {
        int base = 0;
        if (np > 0) base = atomicAdd(&cnt[mq], np);
#pragma unroll
        for (int r = 0; r < 16; ++r) {
          if ((pm >> r) & 1u) {
            const int slot = base + __popc(pm & ((1u << r) - 1u));
            LS[mq * DS_CAP + slot] = scv[r];
            LI[mq * DS_CAP + slot] = (unsigned short)(sbase + crow(r, l));
          }
        }
      }
    }
    lds_barrier();
    bool any_prune;
    {
      const int cv = (l < 32) ? cnt[l] : 0;
      unsigned pmask = (unsigned)__ballot(cv > DS_PRUNE_AT);
      any_prune = pmask != 0u;
      int j = 0;
      while (pmask != 0u) {
        const int m = __ffs((int)pmask) - 1;
        pmask &= pmask - 1u;
        if ((j & 3) == w) dsa_prune<true>(LS + m * DS_CAP, LI + m * DS_CAP, cnt[m], hist, cnt + m, thr + m, l);
        ++j;
      }
    }
    lds_barrier();
    if (any_prune) th = thr[mq];
#pragma unroll
    for (int ks = 0; ks < 4; ++ks) bk[ks] = bkn[ks];
  }
  }
#pragma unroll 1
  for (int mm = 0; mm < 8; ++mm) {
    const int m = w * 8 + mm;
    const int c = cnt[m];
    if (c > 256) dsa_prune<false>(LS + m * DS_CAP, LI + m * DS_CAP, c, hist, cnt + m, thr + m, l);
  }
  asm volatile("s_waitcnt lgkmcnt(0)" ::: "memory");
  for (int rep_att = 0; rep_att < REP_ATT; ++rep_att) {
  h8 kvr[4][8];
  {
    const int m = w * 8;
    const int c = min(cnt[m], 256);
    const unsigned short* LIm = LI + m * DS_CAP;
#pragma unroll
    for (int kk = 0; kk < 4; ++kk) {
      const int e = l + 64 * kk;
      const int s = (int)LIm[(e < c) ? e : 0];
      const half_t* kr = P + (size_t)s * PP + C_DSAK;
#pragma unroll
      for (int ch = 0; ch < 8; ++ch) kvr[kk][ch] = *(const h8*)(kr + ch * 8);
    }
  }
  h8 qreg = *(const h8*)(P + (size_t)(t0 + w * 8) * PP + C_DSAQ + l * 8);
  const int dch = l & 7, ksub = l >> 3;
#pragma unroll 1
  for (int u = 0; u < 16; ++u) {
    const int mm = u >> 1, g = u & 1;
    const int m = w * 8 + mm;
    const int t = t0 + m;
    const int c = min(cnt[m], 256);
    const unsigned short* LIm = LI + m * DS_CAP;
    if (g == 0) {
      *(h8*)(QS + l * 8) = qreg;
      const int mq = (mm < 7) ? (m + 1) : m;
      qreg = *(const h8*)(P + (size_t)(t0 + mq) * PP + C_DSAQ + l * 8);
    }
    h8 gt[4];
#pragma unroll
    for (int hh = 0; hh < 4; ++hh) gt[hh] = *(const h8*)(P + (size_t)t * PP + C_DSAG + (g * 4 + hh) * 64 + dch * 8);
    h8 vv[16];
#pragma unroll
    for (int i = 0; i < 16; ++i) {
      const int e = i * 8 + ksub;
      const int s = (int)LIm[(e < c) ? e : 0];
      vv[i] = *(const h8*)(P + (size_t)s * PP + C_DSAV + g * 64 + dch * 8);
    }
    asm volatile("" ::: "memory");
    float lg[4][4];
#pragma unroll
    for (int hh = 0; hh < 4; ++hh) {
#pragma unroll
      for (int kk = 0; kk < 4; ++kk) lg[hh][kk] = ozero();
#pragma unroll
      for (int ch = 0; ch < 8; ++ch) {
        const h8 qq = *(const h8*)(QS + (g * 4 + hh) * 64 + ch * 8);
#pragma unroll
        for (int kk = 0; kk < 4; ++kk) {
          float a = lg[hh][kk];
          a = __builtin_amdgcn_fdot2(__builtin_shufflevector(qq, qq, 0, 1), __builtin_shufflevector(kvr[kk][ch], kvr[kk][ch], 0, 1), a, false);
          a = __builtin_amdgcn_fdot2(__builtin_shufflevector(qq, qq, 2, 3), __builtin_shufflevector(kvr[kk][ch], kvr[kk][ch], 2, 3), a, false);
          a = __builtin_amdgcn_fdot2(__builtin_shufflevector(qq, qq, 4, 5), __builtin_shufflevector(kvr[kk][ch], kvr[kk][ch], 4, 5), a, false);
          a = __builtin_amdgcn_fdot2(__builtin_shufflevector(qq, qq, 6, 7), __builtin_shufflevector(kvr[kk][ch], kvr[kk][ch], 6, 7), a, false);
          lg[hh][kk] = a;
        }
      }
#pragma unroll
      for (int kk = 0; kk < 4; ++kk) lg[hh][kk] = (l + 64 * kk < c) ? lg[hh][kk] : -INFINITY;
    }
    {
      const int un = (u < 15) ? (u + 1) : 15;
      const int mn = w * 8 + (un >> 1), gn = un & 1;
      const int cn = min(cnt[mn], 256);
      const unsigned short* LIn = LI + mn * DS_CAP;
#pragma unroll
      for (int kk = 0; kk < 4; ++kk) {
        const int e = l + 64 * kk;
        const int s = (int)LIn[(e < cn) ? e : 0];
        const half_t* kr = P + (size_t)s * PP + C_DSAK + gn * 64;
#pragma unroll
        for (int ch = 0; ch < 8; ++ch) kvr[kk][ch] = *(const h8*)(kr + ch * 8);
      }
    }
#pragma unroll
    for (int hh = 0; hh < 4; ++hh) {
      float mx = fmaxf(fmaxf(lg[hh][0], lg[hh][1]), fmaxf(lg[hh][2], lg[hh][3]));
      mx = wave_max(mx);
      float ev[4]; float sm = 0.f;
#pragma unroll
      for (int kk = 0; kk < 4; ++kk) { ev[kk] = __expf(lg[hh][kk] - mx); sm += ev[kk]; }
      sm = wave_sum(sm);
      const float inv = 1.0f / sm;
#pragma unroll
      for (int kk = 0; kk < 4; ++kk) ((kk < 2) ? PWa : PWb)[(l + 64 * (kk & 1)) * 4 + hh] = ev[kk] * inv;
    }
    asm volatile("" ::: "memory");
    float o[4][8];
#pragma unroll
    for (int hh = 0; hh < 4; ++hh)
#pragma unroll
      for (int q = 0; q < 8; ++q) o[hh][q] = ozero();
    const int nit = (c + 7) >> 3;
#pragma unroll 1
    for (int it0 = 0; it0 < nit; it0 += 16) {
      if (it0 > 0) {
#pragma unroll
        for (int i = 0; i < 16; ++i) {
          const int e = (it0 + i) * 8 + ksub;
          const int s = (int)LIm[(e < c) ? e : 0];
          vv[i] = *(const h8*)(P + (size_t)s * PP + C_DSAV + g * 64 + dch * 8);
        }
      }
#pragma unroll
      for (int i = 0; i < 16; ++i) {
        const int e = (it0 + i) * 8 + ksub;
        const f4v pv = *(const f4v*)(((e < 128) ? PWa : PWb) + (e & 127) * 4);
#pragma unroll
        for (int hh = 0; hh < 4; ++hh)
#pragma unroll
          for (int q = 0; q < 8; ++q) o[hh][q] += pv[hh] * (float)vv[i][q];
      }
    }
#pragma unroll
    for (int hh = 0; hh < 4; ++hh)
#pragma unroll
      for (int q = 0; q < 8; ++q) {
        float v = o[hh][q];
        v += dppf<0x128>(v); v += xor16f(v); v += xor32f(v);
        o[hh][q] = v;
      }
    if (l < 8) {
#pragma unroll
      for (int hh = 0; hh < 4; ++hh) {
        const int col = (g * 4 + hh) * 64 + dch * 8;
        h8 ov;
#pragma unroll
        for (int q = 0; q < 8; ++q) ov[q] = (half_t)(o[hh][q] * (float)gt[hh][q]);
        *(h8*)(BR + (size_t)t * 1536 + 512 + col) = ov;
      }
    }
    asm volatile("" ::: "memory");
  }
  }
}

__device__ void phase_B(const Params& p, int layer, unsigned char* lds) {
  const int G = gridDim.x;
  for (int j = 0; j * G < 512; ++j) {
    const int b = (j & 1) ? (G - 1 - (int)blockIdx.x) : (int)blockIdx.x;
    const int idx = j * G + b;
#ifndef NO_DSA
    if (idx < 512) dsa_item(p, 511 - idx, lds);
#endif
  }
  for (int rep = 0; rep < REP_KV; ++rep)
  for (int it = blockIdx.x; it < 2048; it += G) la_item_kv(p, layer, it, lds);
}

__device__ void phase_E1(const Params& p, int layer, unsigned char* lds, int my_xcc, int my_loc, const unsigned* xcnt) {
  const int tid = otid(), w = tid >> 6, l = tid & 63;
  const half_t* BR = (const half_t*)(p.ws + OFF_BR);
  const half_t* WbrT = (const half_t*)(p.ws + OFF_WBRT) + (size_t)layer * 3 * 1024 * WBP;
  const half_t* P = (const half_t*)(p.ws + OFF_P);
  half_t* Y1 = (half_t*)(p.ws + OFF_H);
  const int wm = w >> 1, wn = w & 1;
  float* E = (float*)(lds + GEMM_EOFF) + w * (32 * EP);
  const int prow = l >> 3, c0 = (l & 7) * 8;
  const int nx = xcc_census(xcnt, my_xcc);
  const int nrounds = (nx > 0) ? (64 + nx - 1) / nx : (512 + (int)gridDim.x - 1) / (int)gridDim.x;
  for (int rnd = 0; rnd < nrounds; ++rnd) {
    int mt, nt;
    if (nx > 0) {
      const int s = my_loc + nx * rnd;
      if (s >= 64) continue;
      mt = my_xcc * 8 + (s & 7); nt = s >> 3;
    } else {
      const int tix = rnd * (int)gridDim.x + (int)blockIdx.x;
      if (tix >= 512) continue;
      mt = tix & 63; nt = tix >> 6;
    }
    h8 tot[4][4];
#pragma unroll
    for (int i = 0; i < 4; ++i)
#pragma unroll
      for (int ps = 0; ps < 4; ++ps)
#pragma unroll
        for (int q = 0; q < 8; ++q) tot[i][ps][q] = (half_t)ozero();
    const int m0w = mt * 256 + wm * 128;
    const int n0 = nt * 128 + wn * 64 + c0;
#pragma unroll 1
    for (int b = 0; b < 3; ++b) {
      f16v acc[4][2];
      zero_acc<2>(acc);
      gemm_kloop<2>(acc, BR + (size_t)mt * 256 * 1536 + b * 512, 1536, WbrT + (size_t)b * 1024 * WBP + (size_t)nt * 128 * WBP, WBP, 512, lds);
#pragma unroll
      for (int i = 0; i < 4; ++i) {
        h8 g[4];
#pragma unroll
        for (int ps = 0; ps < 4; ++ps) g[ps] = *(const h8*)(P + (size_t)(m0w + i * 32 + ps * 8 + prow) * PP + C_MRG + b * 1024 + n0);
        stage_pair(E, acc[i][0], acc[i][1], l);
#pragma unroll
        for (int ps = 0; ps < 4; ++ps) {
          const int rl = ps * 8 + prow;
          float ev[8];
          ld8(E + rl * EP + c0, ev);
#pragma unroll
          for (int q = 0; q < 8; ++q) tot[i][ps][q] = (half_t)((float)tot[i][ps][q] + (float)g[ps][q] * ev[q]);
        }
      }
    }
#pragma unroll
    for (int i = 0; i < 4; ++i)
#pragma unroll
      for (int ps = 0; ps < 4; ++ps) {
        const int row = m0w + i * 32 + ps * 8 + prow;
        *(h8*)(Y1 + (size_t)row * HP + n0) = tot[i][ps];
      }
  }
}

__device__ void phase_E2(const Params& p, int layer, unsigned char* lds, int my_xcc, int my_loc, const unsigned* xcnt) {
  const int tid = otid(), w = tid >> 6, l = tid & 63;
  const half_t* Y1 = (const half_t*)(p.ws + OFF_H);
  const half_t* Wo = (const half_t*)(p.ws + OFF_WOUTT) + (size_t)layer * 1024 * WP;
  float* Y = (float*)(p.ws + OFF_ST);
  const int wm = w >> 1, wn = w & 1;
  const int nx = xcc_census(xcnt, my_xcc);
  const int nrounds = (nx > 0) ? (64 + nx - 1) / nx : (512 + (int)gridDim.x - 1) / (int)gridDim.x;
  for (int rnd = 0; rnd < nrounds; ++rnd) {
    int mt, nt;
    if (nx > 0) {
      const int s = my_loc + nx * rnd;
      if (s >= 64) continue;
      mt = my_xcc * 8 + (s & 7); nt = s >> 3;
    } else {
      const int tix = rnd * (int)gridDim.x + (int)blockIdx.x;
      if (tix >= 512) continue;
      mt = tix & 63; nt = tix >> 6;
    }
    f16v acc[4][2];
    zero_acc<2>(acc);
    gemm_kloop<2>(acc, Y1 + (size_t)mt * 256 * HP, HP, Wo + (size_t)nt * 128 * WP, WP, 1024, lds);
    const int m0w = mt * 256 + wm * 128;
    const int n0w = nt * 128 + wn * 64;
    float* E = (float*)(lds + GEMM_EOFF) + w * (32 * EP);
    const int prow = l >> 3, c0 = (l & 7) * 8;
#pragma unroll
    for (int i = 0; i < 4; ++i) {
      stage_pair(E, acc[i][0], acc[i][1], l);
#pragma unroll
      for (int ps = 0; ps < 4; ++ps) {
        const int rl = ps * 8 + prow;
        const int row = m0w + i * 32 + rl;
        const f4v a = *(const f4v*)(E + rl * EP + c0), b = *(const f4v*)(E + rl * EP + c0 + 4);
        *(f4v*)(Y + (size_t)row * 1024 + n0w + c0) = a;
        *(f4v*)(Y + (size_t)row * 1024 + n0w + c0 + 4) = b;
      }
    }
  }
}

__device__ void phase_E3(const Params& p, int layer) {
  const int w = otid() >> 6, l = otid() & 63;
  const float* Y = (const float*)(p.ws + OFF_ST);
  const float* MOD = (const float*)(p.ws + OFF_MOD);
  half_t* H = (half_t*)(p.ws + OFF_H);
  const float* xin = (layer == 0) ? p.x : p.out;
  const float* gate = MOD + layer * 3072 + 2048;
  const float* post = p.post_norm + layer * 1024;
  const int stride = gridDim.x * 4;
  int row = blockIdx.x * 4 + w;
  f4v yn[4], xn[4];
  if (row < S_LEN) {
#pragma unroll
    for (int i = 0; i < 4; ++i) {
      yn[i] = *(const f4v*)(Y + (size_t)row * 1024 + i * 256 + l * 4);
      xn[i] = *(const f4v*)(xin + (size_t)row * 1024 + i * 256 + l * 4);
    }
  }
  for (; row < S_LEN; row += stride) {
    float yv[16], xv[16];
    float ss = 0.f;
#pragma unroll
    for (int i = 0; i < 4; ++i)
#pragma unroll
      for (int q = 0; q < 4; ++q) { yv[i * 4 + q] = yn[i][q]; xv[i * 4 + q] = xn[i][q]; ss += yn[i][q] * yn[i][q]; }
    const int nrow = (row + stride < S_LEN) ? (row + stride) : row;
#pragma unroll
    for (int i = 0; i < 4; ++i) {
      yn[i] = *(const f4v*)(Y + (size_t)nrow * 1024 + i * 256 + l * 4);
      xn[i] = *(const f4v*)(xin + (size_t)nrow * 1024 + i * 256 + l * 4);
    }
    ss = wave_sum(ss);
    const float rs = rsqrtf(ss * (1.0f / 1024.0f) + 1e-6f);
#pragma unroll
    for (int i = 0; i < 4; ++i) {
      const int c0 = i * 256 + l * 4;
      f4v gt = *(const f4v*)(gate + c0);
      f4v pn = *(const f4v*)(post + c0);
      f4v o;
#pragma unroll
      for (int q = 0; q < 4; ++q) { o[q] = xv[i * 4 + q] + gt[q] * (yv[i * 4 + q] * rs * pn[q]); xv[i * 4 + q] = o[q]; }
      *(f4v*)(p.out + (size_t)row * 1024 + c0) = o;
    }
    if (layer + 1 < DEPTH)
      write_h_row(xv, p.pre_norm + (layer + 1) * 1024, MOD + (layer + 1) * 3072, H + (size_t)row * HP, l);
  }
}

#define XB_TMO      128
#define XB_XCNT(j)  (256  + 64 * (j))
#define XB_XSUB(j)  (1280 + 64 * (j))
#define XB_XGEN(j)  (2304 + 64 * (j))
#define XB_TOP      3328
#define XB_TOPGEN   3392
#define XCD_BAR_WORDS 3456
#define XB_SPIN_CAP (1u << 18)
#define LAS __attribute__((address_space(3)))

__device__ __forceinline__ unsigned xb_ld(unsigned* p)              { return __hip_atomic_load(p, __ATOMIC_RELAXED, __HIP_MEMORY_SCOPE_AGENT); }
__device__ __forceinline__ unsigned xb_add(unsigned* p, unsigned v) { return __hip_atomic_fetch_add(p, v, __ATOMIC_RELAXED, __HIP_MEMORY_SCOPE_AGENT); }
__device__ __forceinline__ unsigned xb_xcc_id() { return (unsigned)__builtin_amdgcn_s_getreg((3 << 11) | 20) & 0xFu; }
#define XB_SPIN(cond, bar) do { unsigned _sp = 0; while (cond) { __builtin_amdgcn_s_sleep(1); \
    if ((++_sp & 255u) == 0u) { if (xb_ld(&(bar)[XB_TMO])) break; if (_sp > XB_SPIN_CAP) { atomicAdd(&(bar)[XB_TMO], 1u); break; } } } } while (0)

struct XcdBarrier {
    unsigned* bar; unsigned x;
    volatile LAS unsigned* st;
};

__device__ __forceinline__ XcdBarrier xcd_barrier_post(unsigned* bar, volatile LAS unsigned* st) {
    XcdBarrier b; b.bar = bar; b.x = xb_xcc_id(); b.st = st;
    if (otid() == 0) (void)xb_add(&bar[XB_XCNT(b.x)], 1u);
    return b;
}
__device__ __forceinline__ void xcd_barrier_complete(unsigned* bar, unsigned x, unsigned& nloc, unsigned& nx) {
    const unsigned G = gridDim.x * gridDim.y * gridDim.z;
    unsigned sum, cnt, mine, sp = 0u;
    for (;;) {
        sum = 0u; cnt = 0u; mine = 0u;
#pragma unroll
        for (unsigned j = 0; j < 16; ++j) { const unsigned c = xb_ld(&bar[XB_XCNT(j)]); sum += c; cnt += (c > 0u) ? 1u : 0u; mine = (j == x) ? c : mine; }
        if (sum == G) break;
        __builtin_amdgcn_s_sleep(1);
        if ((++sp & 255u) == 0u) { if (xb_ld(&bar[XB_TMO])) break; if (sp > XB_SPIN_CAP) { atomicAdd(&bar[XB_TMO], 1u); break; } }
    }
    nloc = mine > 0u ? mine : 1u; nx = cnt > 0u ? cnt : 1u;
}

__device__ __forceinline__ void xcd_barrier(const XcdBarrier& b) {
    asm volatile("s_waitcnt vmcnt(0)" ::: "memory");
    __syncthreads();
    if (otid() == 0) {
        unsigned* bar = b.bar;
        __builtin_amdgcn_s_waitcnt(0);
        unsigned nloc = b.st[0], nx = b.st[1];
        if (nloc == 0u) { xcd_barrier_complete(bar, b.x, nloc, nx); b.st[0] = nloc; b.st[1] = nx; }
        const unsigned old = xb_add(&bar[XB_XSUB(b.x)], 1u);
        const unsigned gen = old / nloc;
        if (old + 1u == (gen + 1u) * nloc) {
            __builtin_amdgcn_fence(__ATOMIC_RELEASE, "agent");
            asm volatile("s_waitcnt vmcnt(0)" ::: "memory");
            const unsigned og = xb_add(&bar[XB_TOP], 1u);
            const unsigned tg = og / nx;
            if (og + 1u == (tg + 1u) * nx) xb_add(&bar[XB_TOPGEN], 1u);
            else XB_SPIN(xb_ld(&bar[XB_TOPGEN]) == tg, bar);
            __builtin_amdgcn_fence(__ATOMIC_ACQUIRE, "agent");
            xb_add(&bar[XB_XGEN(b.x)], 1u);
            asm volatile("s_waitcnt vmcnt(0)" ::: "memory");
        } else {
            XB_SPIN(xb_ld(&bar[XB_XGEN(b.x)]) == gen, bar);
            __builtin_amdgcn_fence(__ATOMIC_ACQUIRE, "agent");
            asm volatile("s_waitcnt vmcnt(0)" ::: "memory");
        }
    }
    __syncthreads();
}


};

#ifndef REP_D
#define REP_D 1
#endif
#ifndef REP_E
#define REP_E 1
#endif
#ifndef REP_A
#define REP_A 1
#endif
#ifndef REP_B
#define REP_B 1
#endif
#ifdef ONLY_PHASE
#define PH_EN(x) (ONLY_PHASE == (x))
#else
#define PH_EN(x) true
#endif
__global__ void __launch_bounds__(NTHREADS) fwd_megakernel(Params p) {
  extern __shared__ __attribute__((aligned(16))) unsigned char lds[];
  cg::grid_group grid = cg::this_grid();
  K k; k.wbase = __builtin_amdgcn_readfirstlane((int)__builtin_amdgcn_workitem_id_x()) & ~63;
  unsigned* bar = (unsigned*)(p.ws + WS_END);
  unsigned* xcnt = bar + 16;
  unsigned* xbar = (unsigned*)(p.ws + WS_END + 1024);
  if (blockIdx.x == 0) {
    if (k.otid() < 17) __hip_atomic_store(bar + (k.otid() == 16 ? 0 : 16 + k.otid()), 0u, __ATOMIC_RELAXED, __HIP_MEMORY_SCOPE_AGENT);
    for (int i = k.otid(); i < XCD_BAR_WORDS; i += NTHREADS) __hip_atomic_store(xbar + i, 0u, __ATOMIC_RELAXED, __HIP_MEMORY_SCOPE_AGENT);
  }
  volatile LAS unsigned* xst = (volatile LAS unsigned*)(lds + LDS_BYTES - 16);
  if (k.otid() == 0) { xst[0] = 0u; xst[1] = 0u; }
  __syncthreads();
  K::XcdBarrier xb; xb.bar = xbar; xb.x = 0; xb.st = xst;
  int my_xcc = 0, my_loc = 0;
  for (int ph = p.ph_lo; ph < p.ph_hi; ++ph) {
    if (ph == 0) { if (PH_EN(0)) for (int rep = 0; rep < REP_P; ++rep) { k.phase_prologue(p, lds); __syncthreads(); } }
    else if (ph == 1) {
      xb = k.xcd_barrier_post(xbar, xst);
      int* sh = (int*)lds;
      if (k.otid() == 0) {
        const int xc = (int)(__builtin_amdgcn_s_getreg((3 << 11) | 20) & 0xFu);
        sh[0] = xc;
        sh[1] = (int)__hip_atomic_fetch_add(xcnt + xc, 1u, __ATOMIC_RELAXED, __HIP_MEMORY_SCOPE_AGENT);
      }
      __syncthreads();
      my_xcc = __builtin_amdgcn_readfirstlane(sh[0]);
      my_loc = __builtin_amdgcn_readfirstlane(sh[1]);
      __syncthreads();
      if (PH_EN(1)) k.phase_h0(p);
    }
    else {
      const int layer = (ph - 2) / 7, sub = (ph - 2) % 7;
      if (sub == 0) { if (PH_EN(2)) for (int rep = 0; rep < REP_A; ++rep) { k.phase_A(p, layer, lds, my_xcc, my_loc, xcnt); __syncthreads(); } }
      else if (sub == 1) { if (PH_EN(3)) for (int rep = 0; rep < REP_B; ++rep) { k.phase_B(p, layer, lds); __syncthreads(); } }
      else if (sub == 2) { if (PH_EN(4)) k.phase_scan(p); }
      else if (sub == 3) { if (PH_EN(5)) for (int rep = 0; rep < REP_D; ++rep) { for (int it = blockIdx.x; it < 2048; it += gridDim.x) k.la_item_out(p, layer, it, lds); __syncthreads(); } }
      else if (sub == 4) { if (PH_EN(6)) for (int rep = 0; rep < REP_E; ++rep) { k.phase_E1(p, layer, lds, my_xcc, my_loc, xcnt); __syncthreads(); } }
      else if (sub == 5) { if (PH_EN(7)) for (int rep = 0; rep < REP_E; ++rep) { k.phase_E2(p, layer, lds, my_xcc, my_loc, xcnt); __syncthreads(); } }
      else { if (PH_EN(8)) k.phase_E3(p, layer); }
    }
    if (ph + 1 < p.ph_hi) {
      if (ph == p.ph_lo) grid.sync();
      else k.xcd_barrier(xb);
    }
  }
}

extern "C" void kernel_launch(void* const* d_in, const int* in_sizes, int n_in, void* d_out, int out_size,
                              void* d_ws, size_t ws_size, hipStream_t stream) {
  static int grid_blocks = 0;
  if (!grid_blocks) {
    int dev = 0, cus = 0, per_cu = 0;
    hipGetDevice(&dev);
    hipDeviceGetAttribute(&cus, hipDeviceAttributeMultiprocessorCount, dev);
    hipFuncSetAttribute((const void*)fwd_megakernel, hipFuncAttributeMaxDynamicSharedMemorySize, LDS_BYTES);
    hipOccupancyMaxActiveBlocksPerMultiprocessor(&per_cu, (const void*)fwd_megakernel, NTHREADS, LDS_BYTES);
    if (per_cu < 1) per_cu = 1;
    if (per_cu > 1) per_cu = 1;
    grid_blocks = cus * per_cu;
    if (ws_size < WS_END) fprintf(stderr, "workspace too small: %zu < %llu\n", ws_size, (unsigned long long)WS_END);
  }
  Params p{};
  p.x = (const float*)d_in[0]; p.c = (const float*)d_in[1]; p.pos = (const int*)d_in[2];
  p.ada_w = (const float*)d_in[3]; p.ada_b = (const float*)d_in[4];
  p.pre_norm = (const float*)d_in[5]; p.post_norm = (const float*)d_in[6];
  p.w_in = (const float*)d_in[7]; p.gla_w_lr = (const float*)d_in[8]; p.gla_b_lr = (const float*)d_in[9];
  p.w_br_ret = (const float*)d_in[10]; p.w_br_dsa = (const float*)d_in[11]; p.w_br_gla = (const float*)d_in[12];
  p.w_out = (const float*)d_in[13];
  p.out = (float*)d_out; p.ws = (unsigned char*)d_ws;
  p.ph_lo = 0; p.ph_hi = 2 + 7 * DEPTH;
  void* args[] = {&p};
  hipError_t e = hipLaunchCooperativeKernel((const void*)fwd_megakernel, dim3(grid_blocks), dim3(NTHREADS), args, LDS_BYTES, stream);
  if (e != hipSuccess) fprintf(stderr, "cooperative launch failed: %s (grid %d)\n", hipGetErrorString(e), grid_blocks);
}
```

```cpp
#include <hip/hip_runtime.h>
#include <hip/hip_cooperative_groups.h>
#include <stdint.h>
#include <cstdio>
namespace cg = cooperative_groups;
#ifndef REP_P
#define REP_P 1
#endif
#ifndef REP_KV
#define REP_KV 1
#endif
#ifndef REP_SEL
#define REP_SEL 1
#endif
#ifndef REP_ATT
#define REP_ATT 1
#endif

typedef _Float16 half_t;
typedef _Float16 h8 __attribute__((ext_vector_type(8)));
typedef _Float16 h4 __attribute__((ext_vector_type(4)));
typedef _Float16 h2 __attribute__((ext_vector_type(2)));
typedef float f16v __attribute__((ext_vector_type(16)));
typedef float f4v __attribute__((ext_vector_type(4)));

#define S_LEN 16384
#define DM 1024
#define NIN 7764
#define NPAD 7936
#define PP 7808
#define DEPTH 4
#define NTHREADS 256
#define HP 1088
#define WP 1088
#define WBP 576
#define LDS_BYTES 152704

#define C_RETQ 0
#define C_RETK 256
#define C_RETV 512
#define C_RETG 1024
#define C_DSAQ 1536
#define C_DSAK 2048
#define C_DSAV 2176
#define C_DSAG 2304
#define C_IDXQ 2816
#define C_IDXK 3072
#define C_GLAQ 3136
#define C_GLAK 3392
#define C_GLAV 3648
#define C_GLAG 4160
#define C_GLAA 4672
#define C_MRG 4688
#define C_END 7760
#define C_IDXW 7760

#define OFF_WINT 0ull
#define OFF_WBRT (OFF_WINT + 4ull * NPAD * WP * 2)
#define OFF_WOUTT (OFF_WBRT + 4ull * 3 * 1024 * WBP * 2)
#define OFF_MOD (OFF_WOUTT + 4ull * 1024 * WP * 2)
#define OFF_RT (OFF_MOD + 4ull * 3072 * 4)
#define OFF_DT (OFF_RT + 16384ull * 64 * 4)
#define OFF_H (OFF_DT + 16384ull * 16 * 4)
#define OFF_P (OFF_H + 16384ull * HP * 2)
#define OFF_GA (OFF_P + 16384ull * PP * 2)
#define OFF_IW (OFF_GA + 16384ull * 16 * 4)
#define OFF_ST (OFF_IW + 16384ull * 4 * 4)
#define OFF_DEC (OFF_ST + 256ull * 65536 * 4)
#define OFF_BR (OFF_DEC + 256ull * 8 * 64 * 4)
#define WS_END (OFF_BR + 16384ull * 1536 * 2)
static_assert(WS_END + 16384 <= 508821504ull, "workspace too large");

struct Params {
  const float* x; const float* c; const int* pos; const float* ada_w; const float* ada_b;
  const float* pre_norm; const float* post_norm; const float* w_in; const float* gla_w_lr;
  const float* gla_b_lr; const float* w_br_ret; const float* w_br_dsa; const float* w_br_gla;
  const float* w_out; float* out; unsigned char* ws;
  int ph_lo; int ph_hi;
};

struct K {
int wbase;
__device__ __forceinline__ int otid() const {
  int lane;
  asm volatile("v_mbcnt_lo_u32_b32 %0, -1, 0\n\tv_mbcnt_hi_u32_b32 %0, -1, %0" : "=v"(lane));
  return wbase | lane;
}
__device__ __forceinline__ static float ozero() { float z = 0.f; asm volatile("" : "+v"(z)); return z; }
template <int CTRL>
__device__ __forceinline__ float dppf(float v) {
  return __int_as_float(__builtin_amdgcn_update_dpp(0, __float_as_int(v), CTRL, 0xF, 0xF, true));
}
template <int CTRL>
__device__ __forceinline__ unsigned dppu(unsigned v) {
  return (unsigned)__builtin_amdgcn_update_dpp(0, (int)v, CTRL, 0xF, 0xF, true);
}
__device__ __forceinline__ int olane() { return otid() & 63; }
__device__ __forceinline__ float xor16f(float v) { return __int_as_float(__builtin_amdgcn_ds_bpermute((olane() ^ 16) << 2, __float_as_int(v))); }
__device__ __forceinline__ float xor32f(float v) { return __int_as_float(__builtin_amdgcn_ds_bpermute((olane() ^ 32) << 2, __float_as_int(v))); }
__device__ __forceinline__ unsigned xor16u(unsigned v) { return (unsigned)__builtin_amdgcn_ds_bpermute((olane() ^ 16) << 2, (int)v); }
__device__ __forceinline__ unsigned xor32u(unsigned v) { return (unsigned)__builtin_amdgcn_ds_bpermute((olane() ^ 32) << 2, (int)v); }
__device__ __forceinline__ float rl_f(float v, int lane) { return __int_as_float(__builtin_amdgcn_readlane(__float_as_int(v), lane)); }
__device__ __forceinline__ float wave_sum(float v) {
  v += dppf<0xB1>(v); v += dppf<0x4E>(v); v += dppf<0x141>(v); v += dppf<0x140>(v);
  return (rl_f(v, 0) + rl_f(v, 16)) + (rl_f(v, 32) + rl_f(v, 48));
}
__device__ __forceinline__ float wave_max(float v) {
  v = fmaxf(v, dppf<0xB1>(v)); v = fmaxf(v, dppf<0x4E>(v)); v = fmaxf(v, dppf<0x141>(v)); v = fmaxf(v, dppf<0x140>(v));
  return fmaxf(fmaxf(rl_f(v, 0), rl_f(v, 16)), fmaxf(rl_f(v, 32), rl_f(v, 48)));
}
__device__ __forceinline__ unsigned wave_or(unsigned v) {
  v |= dppu<0xB1>(v); v |= dppu<0x4E>(v); v |= dppu<0x141>(v); v |= dppu<0x140>(v);
  return (unsigned)(__builtin_amdgcn_readlane((int)v, 0) | __builtin_amdgcn_readlane((int)v, 16) | __builtin_amdgcn_readlane((int)v, 32) | __builtin_amdgcn_readlane((int)v, 48));
}
__device__ __forceinline__ unsigned wave_incl_scan(unsigned v) {
  v += (unsigned)__builtin_amdgcn_update_dpp(0, (int)v, 0x111, 0xF, 0xF, false);
  v += (unsigned)__builtin_amdgcn_update_dpp(0, (int)v, 0x112, 0xF, 0xF, false);
  v += (unsigned)__builtin_amdgcn_update_dpp(0, (int)v, 0x114, 0xF, 0xF, false);
  v += (unsigned)__builtin_amdgcn_update_dpp(0, (int)v, 0x118, 0xF, 0xF, false);
  v += (unsigned)__builtin_amdgcn_update_dpp(0, (int)v, 0x142, 0xA, 0xF, false);
  v += (unsigned)__builtin_amdgcn_update_dpp(0, (int)v, 0x143, 0xC, 0xF, false);
  return v;
}
__device__ __forceinline__ f16v mfma16(h8 a, h8 b, f16v c) {
  return __builtin_amdgcn_mfma_f32_32x32x16_f16(a, b, c, 0, 0, 0);
}
__device__ __forceinline__ float relu_f(float x) { return __int_as_float(max(__float_as_int(x), 0)); }
__device__ __forceinline__ int crow(int r, int l) { return (r & 3) + 8 * (r >> 2) + 4 * (l >> 5); }

__device__ __forceinline__ int win_col(int nv) {
  if (nv < 3136) return nv;
  if (nv < 7760) return nv + 4;
  if (nv < 7764) return nv - 7760 + 3136;
  return -1;
}
__device__ void transpose_tile(const float* __restrict__ src, int ldn, half_t* __restrict__ dst, int K,
                               int k0, int n0, int mapmode, unsigned char* lds) {
  float* T = (float*)lds;
  const int tid = otid();
  const int nn = tid & 63;
  int col = n0 + nn;
  if (mapmode) col = win_col(col);
#pragma unroll
  for (int i = 0; i < 16; ++i) {
    int kk = (tid >> 6) + 4 * i;
    float v = 0.f;
    if (col >= 0) v = src[(size_t)(k0 + kk) * ldn + col];
    T[kk * 65 + nn] = v;
  }
  __syncthreads();
#pragma unroll
  for (int i = 0; i < 2; ++i) {
    int n2 = (tid >> 3) + 32 * i;
    int kc = tid & 7;
    h8 o;
#pragma unroll
    for (int q = 0; q < 8; ++q) o[q] = (half_t)T[(kc * 8 + q) * 65 + n2];
    *(h8*)(dst + (size_t)(n0 + n2) * K + k0 + kc * 8) = o;
  }
  __syncthreads();
}

__device__ void phase_prologue(const Params& p, unsigned char* lds) {
  const int tid = otid();
  half_t* WinT = (half_t*)(p.ws + OFF_WINT);
  half_t* WbrT = (half_t*)(p.ws + OFF_WBRT);
  half_t* WoutT = (half_t*)(p.ws + OFF_WOUTT);
  float* MOD = (float*)(p.ws + OFF_MOD);
  float* RT = (float*)(p.ws + OFF_RT);
  float* DT = (float*)(p.ws + OFF_DT);
  const int T_WIN = 4 * 124 * 16;
  const int T_WBR = 12 * 16 * 8;
  const int T_WOUT = 4 * 16 * 16;
  const int T_MOD = 192;
  const int T_ROPE = 16384 * 40 / 256;
  const int total = T_WIN + T_WBR + T_WOUT + T_MOD + T_ROPE;
  {
    float* T = (float*)lds;
    const int nn = tid & 63;
    float cur[16], nxt[16];
    int task = blockIdx.x;
    if (task < T_WIN) {
      const int l = task / (124 * 16), r = task % (124 * 16), nt = r / 16, kt = r % 16;
      const int col = win_col(nt * 64 + nn);
      const float* src = p.w_in + (size_t)l * 1024 * NIN;
#pragma unroll
      for (int i = 0; i < 16; ++i) { const int kk = (tid >> 6) + 4 * i; cur[i] = (col >= 0) ? src[(size_t)(kt * 64 + kk) * NIN + col] : 0.f; }
    }
    for (; task < T_WIN; task += gridDim.x) {
      const int tn = (task + (int)gridDim.x < T_WIN) ? task + (int)gridDim.x : task;
      {
        const int l = tn / (124 * 16), r = tn % (124 * 16), nt = r / 16, kt = r % 16;
        const int col = win_col(nt * 64 + nn);
        const float* src = p.w_in + (size_t)l * 1024 * NIN;
#pragma unroll
        for (int i = 0; i < 16; ++i) { const int kk = (tid >> 6) + 4 * i; nxt[i] = (col >= 0) ? src[(size_t)(kt * 64 + kk) * NIN + col] : 0.f; }
      }
      const int l = task / (124 * 16), r = task % (124 * 16), nt = r / 16, kt = r % 16;
      half_t* dst = WinT + (size_t)l * NPAD * WP;
#pragma unroll
      for (int i = 0; i < 16; ++i) T[((tid >> 6) + 4 * i) * 65 + nn] = cur[i];
      __syncthreads();
#pragma unroll
      for (int i = 0; i < 2; ++i) {
        const int n2 = (tid >> 3) + 32 * i, kc = tid & 7;
        h8 o;
#pragma unroll
        for (int q = 0; q < 8; ++q) o[q] = (half_t)T[(kc * 8 + q) * 65 + n2];
        *(h8*)(dst + (size_t)(nt * 64 + n2) * WP + kt * 64 + kc * 8) = o;
      }
      __syncthreads();
#pragma unroll
      for (int i = 0; i < 16; ++i) cur[i] = nxt[i];
    }
  }
  for (int task = blockIdx.x; task < total; task += gridDim.x) {
    int t = task;
    if (t < T_WIN) continue;
    if (t < T_WIN) {
      int l = t / (124 * 16); int r = t % (124 * 16); int nt = r / 16, kt = r % 16;
      transpose_tile(p.w_in + (size_t)l * 1024 * NIN, NIN, WinT + (size_t)l * NPAD * WP, WP, kt * 64, nt * 64, 1, lds);
      continue;
    }
    t -= T_WIN;
    if (t < T_WBR) {
      int lb = t / 128; int r = t % 128; int nt = r / 8, kt = r % 8;
      int l = lb / 3, b = lb % 3;
      const float* src = (b == 0 ? p.w_br_ret : (b == 1 ? p.w_br_dsa : p.w_br_gla)) + (size_t)l * 512 * 1024;
      transpose_tile(src, 1024, WbrT + (size_t)lb * 1024 * WBP, WBP, kt * 64, nt * 64, 0, lds);
      continue;
    }
    t -= T_WBR;
    if (t < T_WOUT) {
      int l = t / 256; int r = t % 256; int nt = r / 16, kt = r % 16;
      transpose_tile(p.w_out + (size_t)l * 1024 * 1024, 1024, WoutT + (size_t)l * 1024 * WP, WP, kt * 64, nt * 64, 0, lds);
      continue;
    }
    t -= T_WOUT;
    if (t < T_MOD) {
      int l = t / 48, jb = t % 48;
      int j = jb * 64 + (tid & 63);
      int ig = tid >> 6;
      float acc = 0.f;
      const float* aw = p.ada_w + (size_t)l * 1024 * 3072;
      for (int i = ig * 256; i < ig * 256 + 256; ++i) {
        float cv = p.c[i];
        float sc = cv / (1.f + expf(-cv));
        acc += sc * aw[(size_t)i * 3072 + j];
      }
      float* red = (float*)lds;
      red[tid] = acc;
      __syncthreads();
      if (tid < 64) {
        float s = red[tid] + red[tid + 64] + red[tid + 128] + red[tid + 192];
        MOD[l * 3072 + j] = s + p.ada_b[l * 3072 + j];
      }
      __syncthreads();
      continue;
    }
    t -= T_MOD;
    {
      int e = t * 256 + tid;
      int tok = e / 40, f = e % 40;
      float pf = (float)p.pos[tok];
      if (f < 32) {
        float fr = powf(10000.0f, -(float)f * 2.0f / 64.0f);
        float ang = pf * fr;
        RT[tok * 64 + f * 2] = cosf(ang);
        RT[tok * 64 + f * 2 + 1] = sinf(ang);
      } else {
        int g = f - 32;
        float fr = powf(500000.0f, -(float)g * 2.0f / 16.0f);
        float ang = pf * fr;
        DT[tok * 16 + g * 2] = cosf(ang);
        DT[tok * 16 + g * 2 + 1] = sinf(ang);
      }
    }
  }
}

__device__ __forceinline__ void write_h_row(const float (&xv)[16], const float* __restrict__ pre,
                                            const float* __restrict__ mod, half_t* __restrict__ hrow, int l) {
  float ss = 0.f;
#pragma unroll
  for (int i = 0; i < 16; ++i) ss += xv[i] * xv[i];
  ss = wave_sum(ss);
  float rs = rsqrtf(ss * (1.0f / 1024.0f) + 1e-6f);
#pragma unroll
  for (int i = 0; i < 4; ++i) {
    int c0 = i * 256 + l * 4;
    f4v pg = *(const f4v*)(pre + c0);
    f4v sh = *(const f4v*)(mod + c0);
    f4v sc = *(const f4v*)(mod + 1024 + c0);
    h4 o;
#pragma unroll
    for (int q = 0; q < 4; ++q) o[q] = (half_t)(xv[i * 4 + q] * rs * pg[q] * (1.f + sc[q]) + sh[q]);
    *(h4*)(hrow + c0) = o;
  }
}

__device__ void phase_h0(const Params& p) {
  const int w = otid() >> 6, l = otid() & 63;
  half_t* H = (half_t*)(p.ws + OFF_H);
  const float* MOD = (const float*)(p.ws + OFF_MOD);
  for (int row = blockIdx.x * 4 + w; row < S_LEN; row += gridDim.x * 4) {
    float xv[16];
#pragma unroll
    for (int i = 0; i < 4; ++i) {
      f4v v = *(const f4v*)(p.x + (size_t)row * 1024 + i * 256 + l * 4);
      xv[i * 4] = v[0]; xv[i * 4 + 1] = v[1]; xv[i * 4 + 2] = v[2]; xv[i * 4 + 3] = v[3];
    }
    write_h_row(xv, p.pre_norm, MOD, H + (size_t)row * HP, l);
  }
}

__device__ __forceinline__ void lds_barrier() {
  asm volatile("s_waitcnt lgkmcnt(0)" ::: "memory");
  __builtin_amdgcn_s_barrier();
  asm volatile("" ::: "memory");
}
#define GEMM_BUF 55296
#define GEMM_EOFF 110592
template <int NT>
__device__ __forceinline__ void gemm_step(f16v (&acc)[4][NT], h8 (&ra)[8], h8 (&rb)[2 * NT],
                                          const unsigned char* As, const unsigned char* Bs, unsigned char* Aw, unsigned char* Bw,
                                          const half_t* __restrict__ A, int lda, const half_t* __restrict__ B, int ldb, int kload,
                                          int wm, int wn, int l, int r0, int kc) {
  h8 af[2][4], bf[2][NT];
#pragma unroll
  for (int i = 0; i < 4; ++i) af[0][i] = *(const h8*)(As + (wm * 128 + i * 32 + (l & 31)) * 144 + (l >> 5) * 16);
#pragma unroll
  for (int j = 0; j < NT; ++j) bf[0][j] = *(const h8*)(Bs + (wn * 32 * NT + j * 32 + (l & 31)) * 144 + (l >> 5) * 16);
#pragma unroll
  for (int ks = 0; ks < 4; ++ks) {
    if (ks < 3) {
#pragma unroll
      for (int i = 0; i < 4; ++i) af[(ks + 1) & 1][i] = *(const h8*)(As + (wm * 128 + i * 32 + (l & 31)) * 144 + (ks + 1) * 32 + (l >> 5) * 16);
#pragma unroll
      for (int j = 0; j < NT; ++j) bf[(ks + 1) & 1][j] = *(const h8*)(Bs + (wn * 32 * NT + j * 32 + (l & 31)) * 144 + (ks + 1) * 32 + (l >> 5) * 16);
    }
    __builtin_amdgcn_sched_barrier(0);
#pragma unroll
    for (int i = 0; i < 4; ++i)
#pragma unroll
      for (int j = 0; j < NT; ++j) acc[i][j] = mfma16(af[ks & 1][i], bf[ks & 1][j], acc[i][j]);
#pragma unroll
    for (int i = 2 * ks; i < 2 * ks + 2; ++i) {
      *(h8*)(Aw + (r0 + 32 * i) * 144 + kc * 16) = ra[i];
      ra[i] = *(const h8*)(A + (size_t)(r0 + 32 * i) * lda + kload + kc * 8);
    }
    if (NT == 2) {
      *(h8*)(Bw + (r0 + 32 * ks) * 144 + kc * 16) = rb[ks];
      rb[ks] = *(const h8*)(B + (size_t)(r0 + 32 * ks) * ldb + kload + kc * 8);
    } else {
#pragma unroll
      for (int i = 2 * ks; i < 2 * ks + 2; ++i) {
        *(h8*)(Bw + (r0 + 32 * i) * 144 + kc * 16) = rb[i];
        rb[i] = *(const h8*)(B + (size_t)(r0 + 32 * i) * ldb + kload + kc * 8);
      }
    }
    __builtin_amdgcn_sched_barrier(0);
  }
}
template <int NT>
__device__ __forceinline__ void gemm_issue(h8 (&ra0)[8], h8 (&rb0)[2 * NT], h8 (&ra1)[8], h8 (&rb1)[2 * NT],
                                           const half_t* __restrict__ A, int lda, const half_t* __restrict__ B, int ldb) {
  const int tid = otid();
  const int kc = tid & 7, r0 = tid >> 3;
#pragma unroll
  for (int i = 0; i < 8; ++i) ra0[i] = *(const h8*)(A + (size_t)(r0 + 32 * i) * lda + kc * 8);
#pragma unroll
  for (int i = 0; i < 2 * NT; ++i) rb0[i] = *(const h8*)(B + (size_t)(r0 + 32 * i) * ldb + kc * 8);
#pragma unroll
  for (int i = 0; i < 8; ++i) ra1[i] = *(const h8*)(A + (size_t)(r0 + 32 * i) * lda + 64 + kc * 8);
#pragma unroll
  for (int i = 0; i < 2 * NT; ++i) rb1[i] = *(const h8*)(B + (size_t)(r0 + 32 * i) * ldb + 64 + kc * 8);
}
template <int NT>
__device__ __forceinline__ void gemm_run(f16v (&acc)[4][NT], h8 (&ra0)[8], h8 (&rb0)[2 * NT], h8 (&ra1)[8], h8 (&rb1)[2 * NT],
                                         const half_t* __restrict__ A, int lda, const half_t* __restrict__ B, int ldb, int K, unsigned char* lds) {
  const int tid = otid(), w = tid >> 6, l = tid & 63;
  constexpr int STAGE = 256 * 144 + 64 * NT * 144;
  unsigned char* A0 = lds;
  unsigned char* B0 = lds + 256 * 144;
  unsigned char* A1 = lds + STAGE;
  unsigned char* B1 = lds + STAGE + 256 * 144;
  const int wm = w >> 1, wn = w & 1;
  const int kc = tid & 7;
  const int r0 = tid >> 3;
  lds_barrier();
#pragma unroll
  for (int i = 0; i < 8; ++i) { *(h8*)(A0 + (r0 + 32 * i) * 144 + kc * 16) = ra0[i]; ra0[i] = *(const h8*)(A + (size_t)(r0 + 32 * i) * lda + 128 + kc * 8); }
#pragma unroll
  for (int i = 0; i < 2 * NT; ++i) { *(h8*)(B0 + (r0 + 32 * i) * 144 + kc * 16) = rb0[i]; rb0[i] = *(const h8*)(B + (size_t)(r0 + 32 * i) * ldb + 128 + kc * 8); }
  lds_barrier();
  const int nk = K / 64;
#pragma unroll 1
  for (int kt = 0; kt < nk; kt += 2) {
    gemm_step<NT>(acc, ra1, rb1, A0, B0, A1, B1, A, lda, B, ldb, (kt + 3 < nk) ? (kt + 3) * 64 : 0, wm, wn, l, r0, kc);
    lds_barrier();
    gemm_step<NT>(acc, ra0, rb0, A1, B1, A0, B0, A, lda, B, ldb, (kt + 4 < nk) ? (kt + 4) * 64 : 0, wm, wn, l, r0, kc);
    lds_barrier();
  }
}
template <int NT>
__device__ __forceinline__ void gemm_kloop(f16v (&acc)[4][NT], const half_t* __restrict__ A, int lda,
                                           const half_t* __restrict__ B, int ldb, int K, unsigned char* lds) {
  h8 ra0[8], rb0[2 * NT], ra1[8], rb1[2 * NT];
  gemm_issue<NT>(ra0, rb0, ra1, rb1, A, lda, B, ldb);
  gemm_run<NT>(acc, ra0, rb0, ra1, rb1, A, lda, B, ldb, K, lds);
}

template <int NT>
__device__ __forceinline__ void gemm_issue1(h8 (&ra)[8], h8 (&rb)[2 * NT], const half_t* __restrict__ A, int lda, const half_t* __restrict__ B, int ldb) {
  const int tid = otid();
  const int kc = tid & 7, r0 = tid >> 3;
#pragma unroll
  for (int i = 0; i < 8; ++i) ra[i] = *(const h8*)(A + (size_t)(r0 + 32 * i) * lda + kc * 8);
#pragma unroll
  for (int i = 0; i < 2 * NT; ++i) rb[i] = *(const h8*)(B + (size_t)(r0 + 32 * i) * ldb + kc * 8);
}
template <int NT>
__device__ __forceinline__ void gemm_run1(f16v (&acc)[4][NT], h8 (&ra)[8], h8 (&rb)[2 * NT],
                                          const half_t* __restrict__ A, int lda, const half_t* __restrict__ B, int ldb, int K, unsigned char* lds) {
  const int tid = otid(), w = tid >> 6, l = tid & 63;
  constexpr int STAGE = 256 * 144 + 64 * NT * 144;
  const int wm = w >> 1, wn = w & 1;
  const int kc = tid & 7;
  const int r0 = tid >> 3;
  lds_barrier();
#pragma unroll
  for (int i = 0; i < 8; ++i) { *(h8*)(lds + (r0 + 32 * i) * 144 + kc * 16) = ra[i]; ra[i] = *(const h8*)(A + (size_t)(r0 + 32 * i) * lda + 64 + kc * 8); }
#pragma unroll
  for (int i = 0; i < 2 * NT; ++i) { *(h8*)(lds + 256 * 144 + (r0 + 32 * i) * 144 + kc * 16) = rb[i]; rb[i] = *(const h8*)(B + (size_t)(r0 + 32 * i) * ldb + 64 + kc * 8); }
  lds_barrier();
  const int nk = K / 64;
#pragma unroll 1
  for (int kt = 0; kt < nk; ++kt) {
    unsigned char* cur = lds + (kt & 1) * STAGE;
    unsigned char* nxt = lds + ((kt + 1) & 1) * STAGE;
    gemm_step<NT>(acc, ra, rb, cur, cur + 256 * 144, nxt, nxt + 256 * 144, A, lda, B, ldb, (kt + 2 < nk) ? (kt + 2) * 64 : 0, wm, wn, l, r0, kc);
    lds_barrier();
  }
}

template <int NT>
__device__ __forceinline__ void zero_acc(f16v (&acc)[4][NT]) {
  float z = 0.f;
  asm volatile("" : "+v"(z));
#pragma unroll
  for (int i = 0; i < 4; ++i)
#pragma unroll
    for (int j = 0; j < NT; ++j)
#pragma unroll
      for (int r = 0; r < 16; ++r) acc[i][j][r] = z;
}

#define EP 68
__device__ __forceinline__ void stage_pair(float* E, const f16v& a0, const f16v& a1, int l) {
#pragma unroll
  for (int r = 0; r < 16; ++r) {
    const int rr = crow(r, l);
    E[rr * EP + (l & 31)] = a0[r];
    E[rr * EP + 32 + (l & 31)] = a1[r];
  }
}
__device__ __forceinline__ void ld8(const float* p, float (&v)[8]) {
  const f4v a = *(const f4v*)p, b = *(const f4v*)(p + 4);
  v[0] = a[0]; v[1] = a[1]; v[2] = a[2]; v[3] = a[3]; v[4] = b[0]; v[5] = b[1]; v[6] = b[2]; v[7] = b[3];
}
__device__ __forceinline__ int xcc_census(const unsigned* xcnt, int my_xcc) {
  unsigned sum = 0; bool ok = my_xcc < 8; int mine = 0;
#pragma unroll
  for (int j = 0; j < 16; ++j) {
    const unsigned c = __hip_atomic_load(xcnt + j, __ATOMIC_RELAXED, __HIP_MEMORY_SCOPE_AGENT);
    sum += c;
    if (j < 8 && c == 0u) ok = false;
    if (j >= 8 && c != 0u) ok = false;
    if (j == my_xcc) mine = (int)c;
  }
  if (sum != gridDim.x) ok = false;
  return ok ? mine : 0;
}

__device__ void phase_A(const Params& p, int layer, unsigned char* lds, int my_xcc, int my_loc, const unsigned* xcnt) {
  const int tid = otid(), w = tid >> 6, l = tid & 63;
  const half_t* H = (const half_t*)(p.ws + OFF_H);
  const half_t* Wt = (const half_t*)(p.ws + OFF_WINT) + (size_t)layer * NPAD * WP;
  half_t* P = (half_t*)(p.ws + OFF_P);
  float* GA = (float*)(p.ws + OFF_GA);
  float* IW = (float*)(p.ws + OFF_IW);
  const float* RT = (const float*)(p.ws + OFF_RT);
  const float* DT = (const float*)(p.ws + OFF_DT);
  const int wm = w >> 1, wn = w & 1;
  const int G = gridDim.x;
  const int ntiles = 64 * 31;
  const int nx = xcc_census(xcnt, my_xcc);
  int nmine;
  if (nx > 0) nmine = (my_loc < 248) ? (248 - my_loc + nx - 1) / nx : 0;
  else nmine = ((int)blockIdx.x < ntiles) ? (ntiles - (int)blockIdx.x + G - 1) / G : 0;
  h8 ra0[8], rb0[8];
  int mt = 0, nt = 0;
  if (nmine > 0) {
    if (nx > 0) { const int s0 = my_loc; mt = my_xcc * 8 + (s0 & 7); nt = s0 >> 3; }
    else { const int tix = blockIdx.x; mt = tix & 63; nt = tix >> 6; }
    gemm_issue1<4>(ra0, rb0, H + (size_t)mt * 256 * HP, HP, Wt + (size_t)nt * 256 * WP, WP);
  }
#pragma unroll 1
  for (int rnd = 0; rnd < nmine; ++rnd) {
    f16v acc[4][4];
    zero_acc<4>(acc);
    gemm_run1<4>(acc, ra0, rb0, H + (size_t)mt * 256 * HP, HP, Wt + (size_t)nt * 256 * WP, WP, 1024, lds);
    const int mt_cur = mt, nt_cur = nt;
    if (rnd + 1 < nmine) {
      if (nx > 0) { const int s1 = my_loc + nx * (rnd + 1); mt = my_xcc * 8 + (s1 & 7); nt = s1 >> 3; }
      else { const int tix = (rnd + 1) * G + blockIdx.x; mt = tix & 63; nt = tix >> 6; }
      gemm_issue1<4>(ra0, rb0, H + (size_t)mt * 256 * HP, HP, Wt + (size_t)nt * 256 * WP, WP);
    }
    const int m0w = mt_cur * 256 + wm * 128;
    const int n0w = nt_cur * 256 + wn * 128;
    float* E = (float*)(lds) + w * (32 * EP);
    const int prow = l >> 3, c0 = (l & 7) * 8;
#pragma unroll
    for (int jp = 0; jp < 2; ++jp) {
      const int nb2 = n0w + jp * 64;
      const int n0 = nb2 + c0;
      const bool rope64 = nb2 < 512;
      const bool rope16 = ((nb2 >= C_DSAQ && nb2 < C_DSAV) || (nb2 >= C_IDXQ && nb2 < C_GLAQ)) && (c0 < 16);
      float scale = 1.f;
      if (n0 < 256 || (n0 >= C_DSAQ && n0 < C_DSAK) || (n0 >= C_IDXQ && n0 < C_IDXK) || (n0 >= C_GLAQ && n0 < C_GLAK)) scale = 0.125f;
      int mode = 0;
      if ((n0 >= C_RETG && n0 < C_DSAQ) || (n0 >= C_DSAG && n0 < C_IDXQ) || (n0 >= C_GLAG && n0 < C_GLAA)) mode = 1;
      if (n0 >= C_MRG && n0 < C_END) mode = 2;
#pragma unroll
      for (int i = 0; i < 4; ++i) {
        stage_pair(E, acc[i][2 * jp], acc[i][2 * jp + 1], l);
#pragma unroll 2
        for (int ps = 0; ps < 4; ++ps) {
          const int rl = ps * 8 + prow;
          const int row = m0w + i * 32 + rl;
          float v[8], o[8];
          ld8(E + rl * EP + c0, v);
#pragma unroll
          for (int q = 0; q < 8; ++q) o[q] = v[q];
          if (rope64) {
            float pv[8], tb[16];
            ld8(E + rl * EP + (c0 ^ 32), pv);
            const float* tp = RT + (size_t)row * 64 + (c0 & 31) * 2;
            ld8(tp, *(float(*)[8])&tb[0]); ld8(tp + 8, *(float(*)[8])&tb[8]);
#pragma unroll
            for (int q = 0; q < 8; ++q) o[q] = (c0 < 32) ? (v[q] * tb[2 * q] - pv[q] * tb[2 * q + 1]) : (v[q] * tb[2 * q] + pv[q] * tb[2 * q + 1]);
          } else if (rope16) {
            float pv[8], tb[16];
            ld8(E + rl * EP + (c0 ^ 8), pv);
            const float* tp = DT + (size_t)row * 16;
            ld8(tp, *(float(*)[8])&tb[0]); ld8(tp + 8, *(float(*)[8])&tb[8]);
#pragma unroll
            for (int q = 0; q < 8; ++q) o[q] = (c0 < 8) ? (v[q] * tb[2 * q] - pv[q] * tb[2 * q + 1]) : (v[q] * tb[2 * q] + pv[q] * tb[2 * q + 1]);
          }
          h8 ov;
#pragma unroll
          for (int q = 0; q < 8; ++q) {
            float t = o[q] * scale;
            if (mode != 0) {
              const float sg = __builtin_amdgcn_rcpf(1.f + __expf(-t));
              t = (mode == 1) ? t * sg : sg;
            }
            ov[q] = (half_t)t;
          }
          if (n0 < C_END) __builtin_nontemporal_store(ov, (h8*)(P + (size_t)row * PP + n0));
          if (n0 >= C_GLAA && n0 < C_MRG) {
#pragma unroll
            for (int q = 0; q < 8; ++q) GA[(size_t)row * 16 + (n0 - C_GLAA) + q] = v[q];
          }
          if (n0 == C_IDXW) {
#pragma unroll
            for (int q = 0; q < 4; ++q) IW[(size_t)row * 4 + q] = 0.5f * v[q];
          }
        }
      }
    }
  }
}

#define LA_BC 0
#define LA_GAS 16640
#define LA_WL 20736
#define LA_QT 24832
#define LA_KT 34048
#define LA_AT 43264
#define LA_VT 52480
#define LA_SS 70912
#define LA_OS 89344
#define LA_SEG 123136

__device__ void la_bcum(const Params& p, int layer, int n, int Hh, unsigned char* lds) {
  const int tid = otid();
  float* Bc = (float*)(lds + LA_BC);
  const int d = tid & 63, q = tid >> 6;
  if (Hh < 4) {
    float lg = log1pf(-exp2f(-5.0f - (float)Hh));
#pragma unroll
    for (int jj = 0; jj < 16; ++jj) { int j = q * 16 + jj; Bc[j * 65 + d] = (float)(j + 1) * lg; }
    __syncthreads();
    return;
  }
  const int h = Hh - 4;
  float* GAs = (float*)(lds + LA_GAS);
  float* WL = (float*)(lds + LA_WL);
  float* SEG = (float*)(lds + LA_SEG);
  const float* GA = (const float*)(p.ws + OFF_GA);
#pragma unroll
  for (int i = 0; i < 4; ++i) {
    int e = tid + 256 * i;
    GAs[e] = GA[(size_t)n * 64 * 16 + e];
    int r = e >> 6, dd = e & 63;
    WL[e] = p.gla_w_lr[(size_t)layer * 16 * 256 + r * 256 + h * 64 + dd];
  }
  __syncthreads();
  float wl[16];
#pragma unroll
  for (int r = 0; r < 16; ++r) wl[r] = WL[r * 64 + d];
  const float bl = p.gla_b_lr[layer * 256 + h * 64 + d];
  float run = 0.f;
#pragma unroll
  for (int jj = 0; jj < 16; ++jj) {
    int j = q * 16 + jj;
    float z = bl;
#pragma unroll
    for (int r = 0; r < 16; ++r) z += GAs[j * 16 + r] * wl[r];
    float ls = fminf(z, 0.f) - __logf(1.f + __expf(-fabsf(z)));
    run += ls * (1.0f / 16.0f);
    Bc[j * 65 + d] = run;
  }
  SEG[q * 64 + d] = run;
  __syncthreads();
  float off = 0.f;
  for (int qq = 0; qq < q; ++qq) off += SEG[qq * 64 + d];
  if (q > 0) {
#pragma unroll
    for (int jj = 0; jj < 16; ++jj) { int j = q * 16 + jj; Bc[j * 65 + d] += off; }
  }
  __syncthreads();
}

__device__ __forceinline__ void la_load_v(const half_t* __restrict__ P, int t0, int vcol, h8 (&vr)[2][2]) {
  const int tid = otid(), w = tid >> 6, l = tid & 63;
  const int jp = l & 31, cgp = l >> 5;
#pragma unroll
  for (int it = 0; it < 2; ++it) {
    int c = it * 8 + w * 2 + cgp;
    vr[it][0] = *(const h8*)(P + (size_t)(t0 + 2 * jp) * PP + vcol + c * 8);
    vr[it][1] = *(const h8*)(P + (size_t)(t0 + 2 * jp + 1) * PP + vcol + c * 8);
  }
}
__device__ __forceinline__ void la_stage_vt(const h8 (&vr)[2][2], unsigned char* lds) {
  const int tid = otid(), w = tid >> 6, l = tid & 63;
  half_t* VT = (half_t*)(lds + LA_VT);
  const int jp = l & 31, cgp = l >> 5;
#pragma unroll
  for (int it = 0; it < 2; ++it) {
    int c = it * 8 + w * 2 + cgp;
#pragma unroll
    for (int q = 0; q < 8; ++q) {
      h2 pr; pr[0] = vr[it][0][q]; pr[1] = vr[it][1][q];
      *(h2*)(VT + (c * 8 + q) * 72 + 2 * jp) = pr;
    }
  }
}
__device__ void la_item_kv(const Params& p, int layer, int item, unsigned char* lds) {
  const int tid = otid(), w = tid >> 6, l = tid & 63;
  const int n = item >> 3, Hh = item & 7;
  const int t0 = n * 64;
  const half_t* P = (const half_t*)(p.ws + OFF_P);
  half_t* ST = (half_t*)(p.ws + OFF_ST);
  float* DEC = (float*)(p.ws + OFF_DEC);
  const int kcol = (Hh < 4) ? (C_RETK + Hh * 64) : (C_GLAK + (Hh - 4) * 64);
  const int vcol = (Hh < 4) ? (C_RETV + Hh * 128) : (C_GLAV + (Hh - 4) * 128);
  h8 vr[2][2];
  la_load_v(P, t0, vcol, vr);
  const h8 k0 = *(const h8*)(P + (size_t)(t0 + 2 * (l & 31)) * PP + kcol + (w * 2 + (l >> 5)) * 8);
  const h8 k1 = *(const h8*)(P + (size_t)(t0 + 2 * (l & 31) + 1) * PP + kcol + (w * 2 + (l >> 5)) * 8);
  __syncthreads();
  la_bcum(p, layer, n, Hh, lds);
  const float* Bc = (const float*)(lds + LA_BC);
  half_t* KhT = (half_t*)(lds + LA_KT);
  half_t* VT = (half_t*)(lds + LA_VT);
  {
    const int jp = l & 31, cgp = l >> 5;
    int c = w * 2 + cgp;
#pragma unroll
    for (int q = 0; q < 8; ++q) {
      int d = c * 8 + q;
      float bl = Bc[63 * 65 + d];
      h2 pr;
      pr[0] = (half_t)((float)k0[q] * __expf(bl - Bc[(2 * jp) * 65 + d]));
      pr[1] = (half_t)((float)k1[q] * __expf(bl - Bc[(2 * jp + 1) * 65 + d]));
      *(h2*)(KhT + d * 72 + 2 * jp) = pr;
    }
  }
  la_stage_vt(vr, lds);
  if (tid < 64) DEC[(size_t)item * 64 + tid] = __expf(Bc[63 * 65 + tid]);
  __syncthreads();
  f16v acc[2];
#pragma unroll
  for (int j = 0; j < 2; ++j)
#pragma unroll
    for (int r = 0; r < 16; ++r) acc[j][r] = ozero();
#pragma unroll
  for (int ks = 0; ks < 4; ++ks) {
    h8 a = *(const h8*)(VT + (32 * w + (l & 31)) * 72 + ks * 16 + (l >> 5) * 8);
#pragma unroll
    for (int j = 0; j < 2; ++j) {
      h8 b = *(const h8*)(KhT + (j * 32 + (l & 31)) * 72 + ks * 16 + (l >> 5) * 8);
      acc[j] = mfma16(a, b, acc[j]);
    }
  }
#pragma unroll
  for (int j = 0; j < 2; ++j)
#pragma unroll
    for (int r = 0; r < 16; ++r) {
      int e = 32 * w + crow(r, l);
      int d = j * 32 + (l & 31);
      ST[(size_t)item * 8192 + e * 64 + d] = (half_t)acc[j][r];
    }
}

__device__ void phase_scan(const Params& p) {
  half_t* ST = (half_t*)(p.ws + OFF_ST);
  const float* DEC = (const float*)(p.ws + OFF_DEC);
  for (int f2 = blockIdx.x * NTHREADS + otid(); f2 < 32768; f2 += gridDim.x * NTHREADS) {
    const int f = f2 * 2;
    const int Hh = f >> 13, d = f & 63;
    float s0 = 0.f, s1 = 0.f;
    for (int n0 = 0; n0 < 256; n0 += 16) {
      h2 kv[16]; float2 dc[16];
#pragma unroll
      for (int u = 0; u < 16; ++u) {
        kv[u] = *(const h2*)(ST + (size_t)(n0 + u) * 65536 + f);
        dc[u] = *(const float2*)(DEC + (size_t)((n0 + u) * 8 + Hh) * 64 + d);
      }
#pragma unroll
      for (int u = 0; u < 16; ++u) {
        h2 o; o[0] = (half_t)s0; o[1] = (half_t)s1;
        *(h2*)(ST + (size_t)(n0 + u) * 65536 + f) = o;
        s0 = dc[u].x * s0 + (float)kv[u][0];
        s1 = dc[u].y * s1 + (float)kv[u][1];
      }
    }
  }
}

__device__ void la_item_out(const Params& p, int layer, int item, unsigned char* lds) {
  const int tid = otid(), w = tid >> 6, l = tid & 63;
  const int n = item >> 3, Hh = item & 7;
  const int t0 = n * 64;
  const half_t* P = (const half_t*)(p.ws + OFF_P);
  const half_t* ST = (const half_t*)(p.ws + OFF_ST);
  half_t* BR = (half_t*)(p.ws + OFF_BR);
  const int qcol = (Hh < 4) ? (C_RETQ + Hh * 64) : (C_GLAQ + (Hh - 4) * 64);
  const int kcol = (Hh < 4) ? (C_RETK + Hh * 64) : (C_GLAK + (Hh - 4) * 64);
  const int vcol = (Hh < 4) ? (C_RETV + Hh * 128) : (C_GLAV + (Hh - 4) * 128);
  const int gcol = (Hh < 4) ? (C_RETG + Hh * 128) : (C_GLAG + (Hh - 4) * 128);
  const int ocol = (Hh < 4) ? (Hh * 128) : (1024 + (Hh - 4) * 128);
  h8 vr[2][2];
  la_load_v(P, t0, vcol, vr);
  h8 qr[2], kr[2], sr[4];
#pragma unroll
  for (int it = 0; it < 2; ++it) {
    const int c = tid + 256 * it;
    qr[it] = *(const h8*)(P + (size_t)(t0 + (c >> 3)) * PP + qcol + (c & 7) * 8);
    kr[it] = *(const h8*)(P + (size_t)(t0 + (c >> 3)) * PP + kcol + (c & 7) * 8);
  }
#pragma unroll
  for (int it = 0; it < 4; ++it) {
    const int c = tid + 256 * it;
    sr[it] = *(const h8*)(ST + (size_t)item * 8192 + (c >> 3) * 64 + (c & 7) * 8);
  }
  __syncthreads();
  la_bcum(p, layer, n, Hh, lds);
  const float* Bc = (const float*)(lds + LA_BC);
  half_t* Qt = (half_t*)(lds + LA_QT);
  half_t* Kt = (half_t*)(lds + LA_KT);
  half_t* AT = (half_t*)(lds + LA_AT);
  half_t* VT = (half_t*)(lds + LA_VT);
  half_t* SS = (half_t*)(lds + LA_SS);
  float* OS = (float*)(lds + LA_OS);
#pragma unroll
  for (int it = 0; it < 2; ++it) {
    int c = tid + 256 * it;
    int row = c >> 3, kc = c & 7;
    const h8 qv = qr[it];
    const h8 kv = kr[it];
    h8 qo, ko;
#pragma unroll
    for (int q = 0; q < 8; ++q) {
      float b = Bc[row * 65 + kc * 8 + q];
      qo[q] = (half_t)((float)qv[q] * __expf(b));
      ko[q] = (half_t)((float)kv[q] * __expf(-b));
    }
    *(h8*)(Qt + row * 72 + kc * 8) = qo;
    *(h8*)(Kt + row * 72 + kc * 8) = ko;
  }
  la_stage_vt(vr, lds);
#pragma unroll
  for (int it = 0; it < 4; ++it) {
    int c = tid + 256 * it;
    int e = c >> 3, kc = c & 7;
    *(h8*)(SS + e * 72 + kc * 8) = sr[it];
  }
  __syncthreads();
  {
    const int mi = w >> 1, nj = w & 1;
    f16v acc;
#pragma unroll
    for (int r = 0; r < 16; ++r) acc[r] = ozero();
#pragma unroll
    for (int ks = 0; ks < 4; ++ks) {
      h8 a = *(const h8*)(Qt + (mi * 32 + (l & 31)) * 72 + ks * 16 + (l >> 5) * 8);
      h8 b = *(const h8*)(Kt + (nj * 32 + (l & 31)) * 72 + ks * 16 + (l >> 5) * 8);
      acc = mfma16(a, b, acc);
    }
#pragma unroll
    for (int r = 0; r < 16; ++r) {
      int i = mi * 32 + crow(r, l);
      int j = nj * 32 + (l & 31);
      float v = (j <= i) ? acc[r] : 0.f;
      AT[i * 72 + j] = (half_t)v;
    }
  }
  __syncthreads();
  {
    const int mi = w >> 1, nh = w & 1;
    f16v acc[2];
#pragma unroll
    for (int j = 0; j < 2; ++j)
#pragma unroll
      for (int r = 0; r < 16; ++r) acc[j][r] = ozero();
#pragma unroll
    for (int ks = 0; ks < 4; ++ks) {
      h8 a1 = *(const h8*)(AT + (mi * 32 + (l & 31)) * 72 + ks * 16 + (l >> 5) * 8);
      h8 a2 = *(const h8*)(Qt + (mi * 32 + (l & 31)) * 72 + ks * 16 + (l >> 5) * 8);
#pragma unroll
      for (int j = 0; j < 2; ++j) {
        h8 b1 = *(const h8*)(VT + (nh * 64 + j * 32 + (l & 31)) * 72 + ks * 16 + (l >> 5) * 8);
        h8 b2 = *(const h8*)(SS + (nh * 64 + j * 32 + (l & 31)) * 72 + ks * 16 + (l >> 5) * 8);
        acc[j] = mfma16(a1, b1, acc[j]);
        acc[j] = mfma16(a2, b2, acc[j]);
      }
    }
#pragma unroll
    for (int j = 0; j < 2; ++j)
#pragma unroll
      for (int r = 0; r < 16; ++r) {
        int i = mi * 32 + crow(r, l);
        int e = nh * 64 + j * 32 + (l & 31);
        OS[i * 132 + e] = acc[j][r];
      }
  }
  __syncthreads();
  {
    const int i = tid >> 2, qd = tid & 3;
    float ov[32];
    float ss = 0.f;
#pragma unroll
    for (int c = 0; c < 8; ++c) {
      f4v v = *(const f4v*)(OS + i * 132 + qd * 32 + c * 4);
      ov[c * 4] = v[0]; ov[c * 4 + 1] = v[1]; ov[c * 4 + 2] = v[2]; ov[c * 4 + 3] = v[3];
      ss += v[0] * v[0] + v[1] * v[1] + v[2] * v[2] + v[3] * v[3];
    }
    ss += dppf<0xB1>(ss);
    ss += dppf<0x4E>(ss);
    float rs = rsqrtf(ss * (1.0f / 128.0f) + 1e-6f);
#pragma unroll
    for (int c = 0; c < 4; ++c) {
      h8 g = *(const h8*)(P + (size_t)(t0 + i) * PP + gcol + qd * 32 + c * 8);
      h8 o;
#pragma unroll
      for (int q = 0; q < 8; ++q) o[q] = (half_t)(ov[c * 8 + q] * rs * (float)g[q]);
      *(h8*)(BR + (size_t)(t0 + i) * 1536 + ocol + qd * 32 + c * 8) = o;
    }
  }
}

#define DS_CAP 768
#define DS_PRUNE_AT 640
#define NPL 12
#define DS_LS 0
#define DS_LI (32 * DS_CAP * 4)
#define DS_CNT (32 * DS_CAP * 6)
#define DS_THR (DS_CNT + 128)
#define DS_WQ (DS_CNT + 256)
#define DS_HIST (DS_CNT + 1024)

__device__ __forceinline__ unsigned long long wave_or64(unsigned long long v) {
  const unsigned lo = wave_or((unsigned)v), hi = wave_or((unsigned)(v >> 32));
  return ((unsigned long long)hi << 32) | lo;
}
template <bool APPROX>
__device__ __forceinline__ void dsa_prune(float* LSm, unsigned short* LIm, int n, unsigned* hist, int* cntm, float* thrm, int l) {
  unsigned long long comp[NPL];
  bool act[NPL], val[NPL];
#pragma unroll
  for (int k = 0; k < NPL; ++k) {
    int e = l + 64 * k;
    val[k] = e < n;
    const int ec = val[k] ? e : 0;
    unsigned u = __float_as_uint(LSm[ec]), li = LIm[ec];
    if (!val[k]) { u = 0; li = 0; }
    const unsigned key = (u >> 31) ? ~u : (u | 0x80000000u);
    comp[k] = ((unsigned long long)key << 14) | (unsigned long long)(16383u - li);
    act[k] = val[k];
  }
  const unsigned long long c0 = ((unsigned long long)(unsigned)__builtin_amdgcn_readfirstlane((int)(unsigned)(comp[0] >> 32)) << 32) | (unsigned)__builtin_amdgcn_readfirstlane((int)(unsigned)comp[0]);
  unsigned long long x = 0;
#pragma unroll
  for (int k = 0; k < NPL; ++k) x |= val[k] ? (comp[k] ^ c0) : 0ull;
  x = wave_or64(x);
  int shift = (x == 0ull) ? 0 : (63 - __clzll((long long)x)) - 7;
  if (shift < 0) shift = 0;
  unsigned rank = 256;
  bool fast = false; unsigned fsel = 0, fcnt = 0; int fshift = 0;
#pragma unroll 1
  for (int rd = 0; rd < 8; ++rd) {
    *(uint4*)(hist + 4 * l) = make_uint4(0, 0, 0, 0);
    asm volatile("" ::: "memory");
    unsigned dk[NPL];
#pragma unroll
    for (int k = 0; k < NPL; ++k) {
      dk[k] = (unsigned)(comp[k] >> shift) & 255u;
      if (act[k]) atomicAdd(&hist[dk[k]], 1u);
    }
    asm volatile("" ::: "memory");
    uint4 hv; hv.x = hist[4 * l]; hv.y = hist[4 * l + 1]; hv.z = hist[4 * l + 2]; hv.w = hist[4 * l + 3];
    unsigned tl = hv.x + hv.y + hv.z + hv.w;
    const unsigned pin = wave_incl_scan(tl);
    const unsigned tot = (unsigned)__builtin_amdgcn_readlane((int)pin, 63);
    unsigned sx = tot - pin;
    bool mine = (sx < rank) && (rank <= sx + tl);
    unsigned dsel = 0, nr = 0, hsel = 0;
    if (mine) {
      unsigned c = sx;
      if (c + hv.w >= rank) { dsel = 4 * l + 3; nr = rank - c; hsel = hv.w; }
      else {
        c += hv.w;
        if (c + hv.z >= rank) { dsel = 4 * l + 2; nr = rank - c; hsel = hv.z; }
        else {
          c += hv.z;
          if (c + hv.y >= rank) { dsel = 4 * l + 1; nr = rank - c; hsel = hv.y; }
          else { c += hv.y; dsel = 4 * l; nr = rank - c; hsel = hv.x; }
        }
      }
    }
    unsigned long long mk = __ballot(mine);
    int src = (mk == 0ull) ? 0 : (__ffsll((long long)mk) - 1);
    dsel = (unsigned)__builtin_amdgcn_readlane((int)dsel, src);
    rank = (unsigned)__builtin_amdgcn_readlane((int)nr, src);
    hsel = (unsigned)__builtin_amdgcn_readlane((int)hsel, src);
    if (APPROX && rd == 0) {
      const unsigned kept = 256u - rank + hsel;
      if (kept <= 320u) { fast = true; fsel = dsel; fcnt = kept; fshift = shift; break; }
    }
#pragma unroll
    for (int k = 0; k < NPL; ++k) act[k] = act[k] && (dk[k] == dsel);
    if (hsel <= 1u || shift == 0) break;
    shift = (shift >= 8) ? (shift - 8) : 0;
  }
  unsigned long long tsel = 0;
#pragma unroll
  for (int k = 0; k < NPL; ++k) tsel |= act[k] ? comp[k] : 0ull;
  unsigned long long T = 0ull;
  if (!fast) T = wave_or64(tsel);
  else T = ((c0 >> (fshift + 8)) << (fshift + 8)) | ((unsigned long long)fsel << fshift);
  bool keep[NPL];
  unsigned cntk = 0;
#pragma unroll
  for (int k = 0; k < NPL; ++k) {
    keep[k] = val[k] && (comp[k] >= T);
    cntk += keep[k] ? 1u : 0u;
  }
  unsigned pos = wave_incl_scan(cntk) - cntk;
  asm volatile("" ::: "memory");
#pragma unroll
  for (int k = 0; k < NPL; ++k) {
    if (keep[k]) {
      const unsigned kk = (unsigned)(comp[k] >> 14);
      const unsigned u = (kk & 0x80000000u) ? (kk & 0x7FFFFFFFu) : ~kk;
      LSm[pos] = __uint_as_float(u);
      LIm[pos] = (unsigned short)(16383u - ((unsigned)comp[k] & 16383u));
      ++pos;
    }
  }
  if (l == 0) {
    const unsigned T32 = (unsigned)(T >> 14);
    *cntm = fast ? (int)fcnt : 256;
    *thrm = __uint_as_float((T32 & 0x80000000u) ? (T32 & 0x7FFFFFFFu) : ~T32);
  }
  asm volatile("" ::: "memory");
}

__device__ void dsa_item(const Params& p, int qb, unsigned char* lds) {
  const int tid = otid(), w = tid >> 6, l = tid & 63;
  const int t0 = qb * 32;
  const half_t* P = (const half_t*)(p.ws + OFF_P);
  const float* IW = (const float*)(p.ws + OFF_IW);
  half_t* BR = (half_t*)(p.ws + OFF_BR);
  float* LS = (float*)(lds + DS_LS);
  unsigned short* LI = (unsigned short*)(lds + DS_LI);
  int* cnt = (int*)(lds + DS_CNT);
  float* thr = (float*)(lds + DS_THR);
  float* wq = (float*)(lds + DS_WQ);
  unsigned* hist = (unsigned*)(lds + DS_HIST) + w * 256;
  float* PWa = LS + (w * 8) * DS_CAP + 256;
  float* PWb = LS + (w * 8 + 1) * DS_CAP + 256;
  half_t* QS = (half_t*)(LI + (w * 8) * DS_CAP + 256);
  for (int rep_sel = 0; rep_sel < REP_SEL; ++rep_sel) {
  __syncthreads();
  if (tid < 32) { cnt[tid] = 0; thr[tid] = -INFINITY; }
  if (tid < 128) wq[tid] = IW[(size_t)t0 * 4 + tid];
  __syncthreads();
  h8 aq[4][4];
#pragma unroll
  for (int h = 0; h < 4; ++h)
#pragma unroll
    for (int ks = 0; ks < 4; ++ks)
      aq[h][ks] = *(const h8*)(P + (size_t)(t0 + (l & 31)) * PP + C_IDXQ + h * 64 + ks * 16 + (l >> 5) * 8);
  const int nt = qb + 1;
  const int nr = (nt + 3) >> 2;
  const int mq = l & 31;
  const f4v wv = *(const f4v*)(wq + mq * 4);
  float th = -INFINITY; asm volatile("" : "+v"(th));
  h8 bk[4];
  {
    const int k0 = (w < nt) ? w : 0;
#pragma unroll
    for (int ks = 0; ks < 4; ++ks)
      bk[ks] = *(const h8*)(P + (size_t)(k0 * 32 + (l & 31)) * PP + C_IDXK + ks * 16 + (l >> 5) * 8);
  }
#pragma unroll 1
  for (int rd = 0; rd < nr; ++rd) {
    const int kt = 4 * rd + w;
    h8 bkn[4];
    {
      const int kn = (kt + 4 < nt) ? (kt + 4) : 0;
#pragma unroll
      for (int ks = 0; ks < 4; ++ks)
        bkn[ks] = *(const h8*)(P + (size_t)(kn * 32 + (l & 31)) * PP + C_IDXK + ks * 16 + (l >> 5) * 8);
    }
    if (kt < nt) {
      const int sbase = kt * 32;
      f16v acc[4];
#pragma unroll
      for (int h = 0; h < 4; ++h) {
#pragma unroll
        for (int r = 0; r < 16; ++r) acc[h][r] = ozero();
#pragma unroll
        for (int ks = 0; ks < 4; ++ks) acc[h] = mfma16(bk[ks], aq[h][ks], acc[h]);
      }
      float scv[16];
#pragma unroll
      for (int r = 0; r < 16; ++r) {
        float sc = wv[0] * relu_f(acc[0][r]) + wv[1] * relu_f(acc[1][r]) + wv[2] * relu_f(acc[2][r]) + wv[3] * relu_f(acc[3][r]);
        sc += 0.0f;
        scv[r] = sc;
      }
      if (kt == qb) {
#pragma unroll
        for (int r = 0; r < 16; ++r) if (sbase + crow(r, l) > t0 + mq) scv[r] = -INFINITY;
      }
      unsigned pm = 0;
#pragma unroll
      for (int r = 0; r < 16; ++r) pm |= (scv[r] > th) ? (1u << r) : 0u;
      const int np = __popc(pm);
      if (__ballot(np > 0) != 0ull) {
        int base = 0;
        if (np > 0) base = atomicAdd(&cnt[mq], np);
#pragma unroll
        for (int r = 0; r < 16; ++r) {
          if ((pm >> r) & 1u) {
            const int slot = base + __popc(pm & ((1u << r) - 1u));
            LS[mq * DS_CAP + slot] = scv[r];
            LI[mq * DS_CAP + slot] = (unsigned short)(sbase + crow(r, l));
          }
        }
      }
    }
    lds_barrier();
    bool any_prune;
    {
      const int cv = (l < 32) ? cnt[l] : 0;
      unsigned pmask = (unsigned)__ballot(cv > DS_PRUNE_AT);
      any_prune = pmask != 0u;
      int j = 0;
      while (pmask != 0u) {
        const int m = __ffs((int)pmask) - 1;
        pmask &= pmask - 1u;
        if ((j & 3) == w) dsa_prune<true>(LS + m * DS_CAP, LI + m * DS_CAP, cnt[m], hist, cnt + m, thr + m, l);
        ++j;
      }
    }
    lds_barrier();
    if (any_prune) th = thr[mq];
#pragma unroll
    for (int ks = 0; ks < 4; ++ks) bk[ks] = bkn[ks];
  }
  }
#pragma unroll 1
  for (int mm = 0; mm < 8; ++mm) {
    const int m = w * 8 + mm;
    const int c = cnt[m];
    if (c > 256) dsa_prune<false>(LS + m * DS_CAP, LI + m * DS_CAP, c, hist, cnt + m, thr + m, l);
  }
  asm volatile("s_waitcnt lgkmcnt(0)" ::: "memory");
  for (int rep_att = 0; rep_att < REP_ATT; ++rep_att) {
  h8 kvr[4][8];
  {
    const int m = w * 8;
    const int c = min(cnt[m], 256);
    const unsigned short* LIm = LI + m * DS_CAP;
#pragma unroll
    for (int kk = 0; kk < 4; ++kk) {
      const int e = l + 64 * kk;
      const int s = (int)LIm[(e < c) ? e : 0];
      const half_t* kr = P + (size_t)s * PP + C_DSAK;
#pragma unroll
      for (int ch = 0; ch < 8; ++ch) kvr[kk][ch] = *(const h8*)(kr + ch * 8);
    }
  }
  h8 qreg = *(const h8*)(P + (size_t)(t0 + w * 8) * PP + C_DSAQ + l * 8);
  const int dch = l >> 3, ksub = l & 7;
#pragma unroll 1
  for (int u = 0; u < 16; ++u) {
    const int mm = u >> 1, g = u & 1;
    const int m = w * 8 + mm;
    const int t = t0 + m;
    const int c = min(cnt[m], 256);
    const unsigned short* LIm = LI + m * DS_CAP;
    if (g == 0) {
      *(h8*)(QS + l * 8) = qreg;
      const int mq = (mm < 7) ? (m + 1) : m;
      qreg = *(const h8*)(P + (size_t)(t0 + mq) * PP + C_DSAQ + l * 8);
    }
    h8 gt[4];
#pragma unroll
    for (int hh = 0; hh < 4; ++hh) gt[hh] = *(const h8*)(P + (size_t)t * PP + C_DSAG + (g * 4 + hh) * 64 + dch * 8);
    h8 vv[16];
#pragma unroll
    for (int i = 0; i < 16; ++i) {
      const int e = i * 8 + ksub;
      const int s = (int)LIm[(e < c) ? e : 0];
      vv[i] = *(const h8*)(P + (size_t)s * PP + C_DSAV + g * 64 + dch * 8);
    }
    asm volatile("" ::: "memory");
    float lg[4][4];
#pragma unroll
    for (int hh = 0; hh < 4; ++hh) {
#pragma unroll
      for (int kk = 0; kk < 4; ++kk) lg[hh][kk] = ozero();
#pragma unroll
      for (int ch = 0; ch < 8; ++ch) {
        const h8 qq = *(const h8*)(QS + (g * 4 + hh) * 64 + ch * 8);
#pragma unroll
        for (int kk = 0; kk < 4; ++kk) {
          float a = lg[hh][kk];
          a = __builtin_amdgcn_fdot2(__builtin_shufflevector(qq, qq, 0, 1), __builtin_shufflevector(kvr[kk][ch], kvr[kk][ch], 0, 1), a, false);
          a = __builtin_amdgcn_fdot2(__builtin_shufflevector(qq, qq, 2, 3), __builtin_shufflevector(kvr[kk][ch], kvr[kk][ch], 2, 3), a, false);
          a = __builtin_amdgcn_fdot2(__builtin_shufflevector(qq, qq, 4, 5), __builtin_shufflevector(kvr[kk][ch], kvr[kk][ch], 4, 5), a, false);
          a = __builtin_amdgcn_fdot2(__builtin_shufflevector(qq, qq, 6, 7), __builtin_shufflevector(kvr[kk][ch], kvr[kk][ch], 6, 7), a, false);
          lg[hh][kk] = a;
        }
      }
#pragma unroll
      for (int kk = 0; kk < 4; ++kk) lg[hh][kk] = (l + 64 * kk < c) ? lg[hh][kk] : -INFINITY;
    }
    {
      const int un = (u < 15) ? (u + 1) : 15;
      const int mn = w * 8 + (un >> 1), gn = un & 1;
      const int cn = min(cnt[mn], 256);
      const unsigned short* LIn = LI + mn * DS_CAP;
#pragma unroll
      for (int kk = 0; kk < 4; ++kk) {
        const int e = l + 64 * kk;
        const int s = (int)LIn[(e < cn) ? e : 0];
        const half_t* kr = P + (size_t)s * PP + C_DSAK + gn * 64;
#pragma unroll
        for (int ch = 0; ch < 8; ++ch) kvr[kk][ch] = *(const h8*)(kr + ch * 8);
      }
    }
#pragma unroll
    for (int hh = 0; hh < 4; ++hh) {
      float mx = fmaxf(fmaxf(lg[hh][0], lg[hh][1]), fmaxf(lg[hh][2], lg[hh][3]));
      mx = wave_max(mx);
      float ev[4]; float sm = 0.f;
#pragma unroll
      for (int kk = 0; kk < 4; ++kk) { ev[kk] = __expf(lg[hh][kk] - mx); sm += ev[kk]; }
      sm = wave_sum(sm);
      const float inv = 1.0f / sm;
#pragma unroll
      for (int kk = 0; kk < 4; ++kk) ((kk < 2) ? PWa : PWb)[(l + 64 * (kk & 1)) * 4 + hh] = ev[kk] * inv;
    }
    asm volatile("" ::: "memory");
    float o[4][8];
#pragma unroll
    for (int hh = 0; hh < 4; ++hh)
#pragma unroll
      for (int q = 0; q < 8; ++q) o[hh][q] = ozero();
    const int nit = (c + 7) >> 3;
#pragma unroll 1
    for (int it0 = 0; it0 < nit; it0 += 16) {
      if (it0 > 0) {
#pragma unroll
        for (int i = 0; i < 16; ++i) {
          const int e = (it0 + i) * 8 + ksub;
          const int s = (int)LIm[(e < c) ? e : 0];
          vv[i] = *(const h8*)(P + (size_t)s * PP + C_DSAV + g * 64 + dch * 8);
        }
      }
#pragma unroll
      for (int i = 0; i < 16; ++i) {
        const int e = (it0 + i) * 8 + ksub;
        const f4v pv = *(const f4v*)(((e < 128) ? PWa : PWb) + (e & 127) * 4);
#pragma unroll
        for (int hh = 0; hh < 4; ++hh)
#pragma unroll
          for (int q = 0; q < 8; ++q) o[hh][q] += pv[hh] * (float)vv[i][q];
      }
    }
#pragma unroll
    for (int hh = 0; hh < 4; ++hh)
#pragma unroll
      for (int q = 0; q < 8; ++q) {
        float v = o[hh][q];
        v += dppf<0xB1>(v); v += dppf<0x4E>(v); v += dppf<0x141>(v);
        o[hh][q] = v;
      }
    if ((l & 7) == 0) {
#pragma unroll
      for (int hh = 0; hh < 4; ++hh) {
        const int col = (g * 4 + hh) * 64 + dch * 8;
        h8 ov;
#pragma unroll
        for (int q = 0; q < 8; ++q) ov[q] = (half_t)(o[hh][q] * (float)gt[hh][q]);
        *(h8*)(BR + (size_t)t * 1536 + 512 + col) = ov;
      }
    }
    asm volatile("" ::: "memory");
  }
  }
}

__device__ void phase_B(const Params& p, int layer, unsigned char* lds) {
  const int G = gridDim.x;
  for (int j = 0; j * G < 512; ++j) {
    const int b = (j & 1) ? (G - 1 - (int)blockIdx.x) : (int)blockIdx.x;
    const int idx = j * G + b;
#ifndef NO_DSA
    if (idx < 512) dsa_item(p, 511 - idx, lds);
#endif
  }
  for (int rep = 0; rep < REP_KV; ++rep)
  for (int it = blockIdx.x; it < 2048; it += G) la_item_kv(p, layer, it, lds);
}

__device__ void phase_E1(const Params& p, int layer, unsigned char* lds, int my_xcc, int my_loc, const unsigned* xcnt) {
  const int tid = otid(), w = tid >> 6, l = tid & 63;
  const half_t* BR = (const half_t*)(p.ws + OFF_BR);
  const half_t* WbrT = (const half_t*)(p.ws + OFF_WBRT) + (size_t)layer * 3 * 1024 * WBP;
  const half_t* P = (const half_t*)(p.ws + OFF_P);
  half_t* Y1 = (half_t*)(p.ws + OFF_H);
  const int wm = w >> 1, wn = w & 1;
  float* E = (float*)(lds + GEMM_EOFF) + w * (32 * EP);
  const int prow = l >> 3, c0 = (l & 7) * 8;
  const int nx = xcc_census(xcnt, my_xcc);
  const int nrounds = (nx > 0) ? (64 + nx - 1) / nx : (512 + (int)gridDim.x - 1) / (int)gridDim.x;
  for (int rnd = 0; rnd < nrounds; ++rnd) {
    int mt, nt;
    if (nx > 0) {
      const int s = my_loc + nx * rnd;
      if (s >= 64) continue;
      mt = my_xcc * 8 + (s & 7); nt = s >> 3;
    } else {
      const int tix = rnd * (int)gridDim.x + (int)blockIdx.x;
      if (tix >= 512) continue;
      mt = tix & 63; nt = tix >> 6;
    }
    h8 tot[4][4];
#pragma unroll
    for (int i = 0; i < 4; ++i)
#pragma unroll
      for (int ps = 0; ps < 4; ++ps)
#pragma unroll
        for (int q = 0; q < 8; ++q) tot[i][ps][q] = (half_t)ozero();
    const int m0w = mt * 256 + wm * 128;
    const int n0 = nt * 128 + wn * 64 + c0;
#pragma unroll 1
    for (int b = 0; b < 3; ++b) {
      f16v acc[4][2];
      zero_acc<2>(acc);
      gemm_kloop<2>(acc, BR + (size_t)mt * 256 * 1536 + b * 512, 1536, WbrT + (size_t)b * 1024 * WBP + (size_t)nt * 128 * WBP, WBP, 512, lds);
#pragma unroll
      for (int i = 0; i < 4; ++i) {
        h8 g[4];
#pragma unroll
        for (int ps = 0; ps < 4; ++ps) g[ps] = *(const h8*)(P + (size_t)(m0w + i * 32 + ps * 8 + prow) * PP + C_MRG + b * 1024 + n0);
        stage_pair(E, acc[i][0], acc[i][1], l);
#pragma unroll
        for (int ps = 0; ps < 4; ++ps) {
          const int rl = ps * 8 + prow;
          float ev[8];
          ld8(E + rl * EP + c0, ev);
#pragma unroll
          for (int q = 0; q < 8; ++q) tot[i][ps][q] = (half_t)((float)tot[i][ps][q] + (float)g[ps][q] * ev[q]);
        }
      }
    }
#pragma unroll
    for (int i = 0; i < 4; ++i)
#pragma unroll
      for (int ps = 0; ps < 4; ++ps) {
        const int row = m0w + i * 32 + ps * 8 + prow;
        *(h8*)(Y1 + (size_t)row * HP + n0) = tot[i][ps];
      }
  }
}

__device__ void phase_E2(const Params& p, int layer, unsigned char* lds, int my_xcc, int my_loc, const unsigned* xcnt) {
  const int tid = otid(), w = tid >> 6, l = tid & 63;
  const half_t* Y1 = (const half_t*)(p.ws + OFF_H);
  const half_t* Wo = (const half_t*)(p.ws + OFF_WOUTT) + (size_t)layer * 1024 * WP;
  float* Y = (float*)(p.ws + OFF_ST);
  const int wm = w >> 1, wn = w & 1;
  const int nx = xcc_census(xcnt, my_xcc);
  const int nrounds = (nx > 0) ? (64 + nx - 1) / nx : (512 + (int)gridDim.x - 1) / (int)gridDim.x;
  for (int rnd = 0; rnd < nrounds; ++rnd) {
    int mt, nt;
    if (nx > 0) {
      const int s = my_loc + nx * rnd;
      if (s >= 64) continue;
      mt = my_xcc * 8 + (s & 7); nt = s >> 3;
    } else {
      const int tix = rnd * (int)gridDim.x + (int)blockIdx.x;
      if (tix >= 512) continue;
      mt = tix & 63; nt = tix >> 6;
    }
    f16v acc[4][2];
    zero_acc<2>(acc);
    gemm_kloop<2>(acc, Y1 + (size_t)mt * 256 * HP, HP, Wo + (size_t)nt * 128 * WP, WP, 1024, lds);
    const int m0w = mt * 256 + wm * 128;
    const int n0w = nt * 128 + wn * 64;
    float* E = (float*)(lds + GEMM_EOFF) + w * (32 * EP);
    const int prow = l >> 3, c0 = (l & 7) * 8;
#pragma unroll
    for (int i = 0; i < 4; ++i) {
      stage_pair(E, acc[i][0], acc[i][1], l);
#pragma unroll
      for (int ps = 0; ps < 4; ++ps) {
        const int rl = ps * 8 + prow;
        const int row = m0w + i * 32 + rl;
        const f4v a = *(const f4v*)(E + rl * EP + c0), b = *(const f4v*)(E + rl * EP + c0 + 4);
        *(f4v*)(Y + (size_t)row * 1024 + n0w + c0) = a;
        *(f4v*)(Y + (size_t)row * 1024 + n0w + c0 + 4) = b;
      }
    }
  }
}

__device__ void phase_E3(const Params& p, int layer) {
  const int w = otid() >> 6, l = otid() & 63;
  const float* Y = (const float*)(p.ws + OFF_ST);
  const float* MOD = (const float*)(p.ws + OFF_MOD);
  half_t* H = (half_t*)(p.ws + OFF_H);
  const float* xin = (layer == 0) ? p.x : p.out;
  const float* gate = MOD + layer * 3072 + 2048;
  const float* post = p.post_norm + layer * 1024;
  const int stride = gridDim.x * 4;
  int row = blockIdx.x * 4 + w;
  f4v yn[4], xn[4];
  if (row < S_LEN) {
#pragma unroll
    for (int i = 0; i < 4; ++i) {
      yn[i] = *(const f4v*)(Y + (size_t)row * 1024 + i * 256 + l * 4);
      xn[i] = *(const f4v*)(xin + (size_t)row * 1024 + i * 256 + l * 4);
    }
  }
  for (; row < S_LEN; row += stride) {
    float yv[16], xv[16];
    float ss = 0.f;
#pragma unroll
    for (int i = 0; i < 4; ++i)
#pragma unroll
      for (int q = 0; q < 4; ++q) { yv[i * 4 + q] = yn[i][q]; xv[i * 4 + q] = xn[i][q]; ss += yn[i][q] * yn[i][q]; }
    const int nrow = (row + stride < S_LEN) ? (row + stride) : row;
#pragma unroll
    for (int i = 0; i < 4; ++i) {
      yn[i] = *(const f4v*)(Y + (size_t)nrow * 1024 + i * 256 + l * 4);
      xn[i] = *(const f4v*)(xin + (size_t)nrow * 1024 + i * 256 + l * 4);
    }
    ss = wave_sum(ss);
    const float rs = rsqrtf(ss * (1.0f / 1024.0f) + 1e-6f);
#pragma unroll
    for (int i = 0; i < 4; ++i) {
      const int c0 = i * 256 + l * 4;
      f4v gt = *(const f4v*)(gate + c0);
      f4v pn = *(const f4v*)(post + c0);
      f4v o;
#pragma unroll
      for (int q = 0; q < 4; ++q) { o[q] = xv[i * 4 + q] + gt[q] * (yv[i * 4 + q] * rs * pn[q]); xv[i * 4 + q] = o[q]; }
      *(f4v*)(p.out + (size_t)row * 1024 + c0) = o;
    }
    if (layer + 1 < DEPTH)
      write_h_row(xv, p.pre_norm + (layer + 1) * 1024, MOD + (layer + 1) * 3072, H + (size_t)row * HP, l);
  }
}

#define XB_TMO      128
#define XB_XCNT(j)  (256  + 64 * (j))
#define XB_XSUB(j)  (1280 + 64 * (j))
#define XB_XGEN(j)  (2304 + 64 * (j))
#define XB_TOP      3328
#define XB_TOPGEN   3392
#define XCD_BAR_WORDS 3456
#define XB_SPIN_CAP (1u << 18)
#define LAS __attribute__((address_space(3)))

__device__ __forceinline__ unsigned xb_ld(unsigned* p)              { return __hip_atomic_load(p, __ATOMIC_RELAXED, __HIP_MEMORY_SCOPE_AGENT); }
__device__ __forceinline__ unsigned xb_add(unsigned* p, unsigned v) { return __hip_atomic_fetch_add(p, v, __ATOMIC_RELAXED, __HIP_MEMORY_SCOPE_AGENT); }
__device__ __forceinline__ unsigned xb_xcc_id() { return (unsigned)__builtin_amdgcn_s_getreg((3 << 11) | 20) & 0xFu; }
#define XB_SPIN(cond, bar) do { unsigned _sp = 0; while (cond) { __builtin_amdgcn_s_sleep(1); \
    if ((++_sp & 255u) == 0u) { if (xb_ld(&(bar)[XB_TMO])) break; if (_sp > XB_SPIN_CAP) { atomicAdd(&(bar)[XB_TMO], 1u); break; } } } } while (0)

struct XcdBarrier {
    unsigned* bar; unsigned x;
    volatile LAS unsigned* st;
};

__device__ __forceinline__ XcdBarrier xcd_barrier_post(unsigned* bar, volatile LAS unsigned* st) {
    XcdBarrier b; b.bar = bar; b.x = xb_xcc_id(); b.st = st;
    if (otid() == 0) (void)xb_add(&bar[XB_XCNT(b.x)], 1u);
    return b;
}
__device__ __forceinline__ void xcd_barrier_complete(unsigned* bar, unsigned x, unsigned& nloc, unsigned& nx) {
    const unsigned G = gridDim.x * gridDim.y * gridDim.z;
    unsigned sum, cnt, mine, sp = 0u;
    for (;;) {
        sum = 0u; cnt = 0u; mine = 0u;
#pragma unroll
        for (unsigned j = 0; j < 16; ++j) { const unsigned c = xb_ld(&bar[XB_XCNT(j)]); sum += c; cnt += (c > 0u) ? 1u : 0u; mine = (j == x) ? c : mine; }
        if (sum == G) break;
        __builtin_amdgcn_s_sleep(1);
        if ((++sp & 255u) == 0u) { if (xb_ld(&bar[XB_TMO])) break; if (sp > XB_SPIN_CAP) { atomicAdd(&bar[XB_TMO], 1u); break; } }
    }
    nloc = mine > 0u ? mine : 1u; nx = cnt > 0u ? cnt : 1u;
}

__device__ __forceinline__ void xcd_barrier(const XcdBarrier& b) {
    asm volatile("s_waitcnt vmcnt(0)" ::: "memory");
    __syncthreads();
    if (otid() == 0) {
        unsigned* bar = b.bar;
        __builtin_amdgcn_s_waitcnt(0);
        unsigned nloc = b.st[0], nx = b.st[1];
        if (nloc == 0u) { xcd_barrier_complete(bar, b.x, nloc, nx); b.st[0] = nloc; b.st[1] = nx; }
        const unsigned old = xb_add(&bar[XB_XSUB(b.x)], 1u);
        const unsigned gen = old / nloc;
        if (old + 1u == (gen + 1u) * nloc) {
            __builtin_amdgcn_fence(__ATOMIC_RELEASE, "agent");
            asm volatile("s_waitcnt vmcnt(0)" ::: "memory");
            const unsigned og = xb_add(&bar[XB_TOP], 1u);
            const unsigned tg = og / nx;
            if (og + 1u == (tg + 1u) * nx) xb_add(&bar[XB_TOPGEN], 1u);
            else XB_SPIN(xb_ld(&bar[XB_TOPGEN]) == tg, bar);
            __builtin_amdgcn_fence(__ATOMIC_ACQUIRE, "agent");
            xb_add(&bar[XB_XGEN(b.x)], 1u);
            asm volatile("s_waitcnt vmcnt(0)" ::: "memory");
        } else {
            XB_SPIN(xb_ld(&bar[XB_XGEN(b.x)]) == gen, bar);
            __builtin_amdgcn_fence(__ATOMIC_ACQUIRE, "agent");
            asm volatile("s_waitcnt vmcnt(0)" ::: "memory");
        }
    }
    __syncthreads();
}


};

#ifndef REP_D
#define REP_D 1
#endif
#ifndef REP_E
#define REP_E 1
#endif
#ifndef REP_A
#define REP_A 1
#endif
#ifndef REP_B
#define REP_B 1
#endif
#ifdef ONLY_PHASE
#define PH_EN(x) (ONLY_PHASE == (x))
#else
#define PH_EN(x) true
#endif
__global__ void __launch_bounds__(NTHREADS) fwd_megakernel(Params p) {
  extern __shared__ __attribute__((aligned(16))) unsigned char lds[];
  cg::grid_group grid = cg::this_grid();
  K k; k.wbase = __builtin_amdgcn_readfirstlane((int)__builtin_amdgcn_workitem_id_x()) & ~63;
  unsigned* bar = (unsigned*)(p.ws + WS_END);
  unsigned* xcnt = bar + 16;
  unsigned* xbar = (unsigned*)(p.ws + WS_END + 1024);
  if (blockIdx.x == 0) {
    if (k.otid() < 17) __hip_atomic_store(bar + (k.otid() == 16 ? 0 : 16 + k.otid()), 0u, __ATOMIC_RELAXED, __HIP_MEMORY_SCOPE_AGENT);
    for (int i = k.otid(); i < XCD_BAR_WORDS; i += NTHREADS) __hip_atomic_store(xbar + i, 0u, __ATOMIC_RELAXED, __HIP_MEMORY_SCOPE_AGENT);
  }
  volatile LAS unsigned* xst = (volatile LAS unsigned*)(lds + LDS_BYTES - 16);
  if (k.otid() == 0) { xst[0] = 0u; xst[1] = 0u; }
  __syncthreads();
  K::XcdBarrier xb; xb.bar = xbar; xb.x = 0; xb.st = xst;
  int my_xcc = 0, my_loc = 0;
  for (int ph = p.ph_lo; ph < p.ph_hi; ++ph) {
    if (ph == 0) { if (PH_EN(0)) for (int rep = 0; rep < REP_P; ++rep) { k.phase_prologue(p, lds); __syncthreads(); } }
    else if (ph == 1) {
      xb = k.xcd_barrier_post(xbar, xst);
      int* sh = (int*)lds;
      if (k.otid() == 0) {
        const int xc = (int)(__builtin_amdgcn_s_getreg((3 << 11) | 20) & 0xFu);
        sh[0] = xc;
        sh[1] = (int)__hip_atomic_fetch_add(xcnt + xc, 1u, __ATOMIC_RELAXED, __HIP_MEMORY_SCOPE_AGENT);
      }
      __syncthreads();
      my_xcc = __builtin_amdgcn_readfirstlane(sh[0]);
      my_loc = __builtin_amdgcn_readfirstlane(sh[1]);
      __syncthreads();
      if (PH_EN(1)) k.phase_h0(p);
    }
    else {
      const int layer = (ph - 2) / 7, sub = (ph - 2) % 7;
      if (sub == 0) { if (PH_EN(2)) for (int rep = 0; rep < REP_A; ++rep) { k.phase_A(p, layer, lds, my_xcc, my_loc, xcnt); __syncthreads(); } }
      else if (sub == 1) { if (PH_EN(3)) for (int rep = 0; rep < REP_B; ++rep) { k.phase_B(p, layer, lds); __syncthreads(); } }
      else if (sub == 2) { if (PH_EN(4)) k.phase_scan(p); }
      else if (sub == 3) { if (PH_EN(5)) for (int rep = 0; rep < REP_D; ++rep) { for (int it = blockIdx.x; it < 2048; it += gridDim.x) k.la_item_out(p, layer, it, lds); __syncthreads(); } }
      else if (sub == 4) { if (PH_EN(6)) for (int rep = 0; rep < REP_E; ++rep) { k.phase_E1(p, layer, lds, my_xcc, my_loc, xcnt); __syncthreads(); } }
      else if (sub == 5) { if (PH_EN(7)) for (int rep = 0; rep < REP_E; ++rep) { k.phase_E2(p, layer, lds, my_xcc, my_loc, xcnt); __syncthreads(); } }
      else { if (PH_EN(8)) k.phase_E3(p, layer); }
    }
    if (ph + 1 < p.ph_hi) {
      if (ph == p.ph_lo) grid.sync();
      else k.xcd_barrier(xb);
    }
  }
}

extern "C" void kernel_launch(void* const* d_in, const int* in_sizes, int n_in, void* d_out, int out_size,
                              void* d_ws, size_t ws_size, hipStream_t stream) {
  static int grid_blocks = 0;
  if (!grid_blocks) {
    int dev = 0, cus = 0, per_cu = 0;
    hipGetDevice(&dev);
    hipDeviceGetAttribute(&cus, hipDeviceAttributeMultiprocessorCount, dev);
    hipFuncSetAttribute((const void*)fwd_megakernel, hipFuncAttributeMaxDynamicSharedMemorySize, LDS_BYTES);
    hipOccupancyMaxActiveBlocksPerMultiprocessor(&per_cu, (const void*)fwd_megakernel, NTHREADS, LDS_BYTES);
    if (per_cu < 1) per_cu = 1;
    if (per_cu > 1) per_cu = 1;
    grid_blocks = cus * per_cu;
    if (ws_size < WS_END) fprintf(stderr, "workspace too small: %zu < %llu\n", ws_size, (unsigned long long)WS_END);
  }
  Params p{};
  p.x = (const float*)d_in[0]; p.c = (const float*)d_in[1]; p.pos = (const int*)d_in[2];
  p.ada_w = (const float*)d_in[3]; p.ada_b = (const float*)d_in[4];
  p.pre_norm = (const float*)d_in[5]; p.post_norm = (const float*)d_in[6];
  p.w_in = (const float*)d_in[7]; p.gla_w_lr = (const float*)d_in[8]; p.gla_b_lr = (const float*)d_in[9];
  p.w_br_ret = (const float*)d_in[10]; p.w_br_dsa = (const float*)d_in[11]; p.w_br_gla = (const float*)d_in[12];
  p.w_out = (const float*)d_in[13];
  p.out = (float*)d_out; p.ws = (unsigned char*)d_ws;
  p.ph_lo = 0; p.ph_hi = 2 + 7 * DEPTH;
  void* args[] = {&p};
  hipError_t e = hipLaunchCooperativeKernel((const void*)fwd_megakernel, dim3(grid_blocks), dim3(NTHREADS), args, LDS_BYTES, stream);
  if (e != hipSuccess) fprintf(stderr, "cooperative launch failed: %s (grid %d)\n", hipGetErrorString(e), grid_blocks);
}
```

```cpp
#include <hip/hip_runtime.h>
#include <hip/hip_cooperative_groups.h>
#include <stdint.h>
#include <cstdio>
namespace cg = cooperative_groups;
#ifndef REP_P
#define REP_P 1
#endif
#ifndef REP_KV
#define REP_KV 1
#endif
#ifndef REP_SEL
#define REP_SEL 1
#endif
#ifndef REP_ATT
#define REP_ATT 1
#endif

typedef _Float16 half_t;
typedef _Float16 h8 __attribute__((ext_vector_type(8)));
typedef _Float16 h4 __attribute__((ext_vector_type(4)));
typedef _Float16 h2 __attribute__((ext_vector_type(2)));
typedef float f16v __attribute__((ext_vector_type(16)));
typedef float f4v __attribute__((ext_vector_type(4)));

#define S_LEN 16384
#define DM 1024
#define NIN 7764
#define NPAD 7936
#define PP 7808
#define DEPTH 4
#define NTHREADS 256
#define HP 1088
#define WP 1088
#define WBP 576
#define LDS_BYTES 152704

#define C_RETQ 0
#define C_RETK 256
#define C_RETV 512
#define C_RETG 1024
#define C_DSAQ 1536
#define C_DSAK 2048
#define C_DSAV 2176
#define C_DSAG 2304
#define C_IDXQ 2816
#define C_IDXK 3072
#define C_GLAQ 3136
#define C_GLAK 3392
#define C_GLAV 3648
#define C_GLAG 4160
#define C_GLAA 4672
#define C_MRG 4688
#define C_END 7760
#define C_IDXW 7760

#define OFF_WINT 0ull
#define OFF_WBRT (OFF_WINT + 4ull * NPAD * WP * 2)
#define OFF_WOUTT (OFF_WBRT + 4ull * 3 * 1024 * WBP * 2)
#define OFF_MOD (OFF_WOUTT + 4ull * 1024 * WP * 2)
#define OFF_RT (OFF_MOD + 4ull * 3072 * 4)
#define OFF_DT (OFF_RT + 16384ull * 64 * 4)
#define OFF_H (OFF_DT + 16384ull * 16 * 4)
#define OFF_P (OFF_H + 16384ull * HP * 2)
#define OFF_GA (OFF_P + 16384ull * PP * 2)
#define OFF_IW (OFF_GA + 16384ull * 16 * 4)
#define OFF_ST (OFF_IW + 16384ull * 4 * 4)
#define OFF_DEC (OFF_ST + 256ull * 65536 * 4)
#define OFF_BR (OFF_DEC + 256ull * 8 * 64 * 4)
#define WS_END (OFF_BR + 16384ull * 1536 * 2)
static_assert(WS_END + 16384 <= 508821504ull, "workspace too large");

struct Params {
  const float* x; const float* c; const int* pos; const float* ada_w; const float* ada_b;
  const float* pre_norm; const float* post_norm; const float* w_in; const float* gla_w_lr;
  const float* gla_b_lr; const float* w_br_ret; const float* w_br_dsa; const float* w_br_gla;
  const float* w_out; float* out; unsigned char* ws;
  int ph_lo; int ph_hi;
};

struct K {
int wbase;
__device__ __forceinline__ int otid() const {
  int lane;
  asm volatile("v_mbcnt_lo_u32_b32 %0, -1, 0\n\tv_mbcnt_hi_u32_b32 %0, -1, %0" : "=v"(lane));
  return wbase | lane;
}
__device__ __forceinline__ static float ozero() { float z = 0.f; asm volatile("" : "+v"(z)); return z; }
template <int CTRL>
__device__ __forceinline__ float dppf(float v) {
  return __int_as_float(__builtin_amdgcn_update_dpp(0, __float_as_int(v), CTRL, 0xF, 0xF, true));
}
template <int CTRL>
__device__ __forceinline__ unsigned dppu(unsigned v) {
  return (unsigned)__builtin_amdgcn_update_dpp(0, (int)v, CTRL, 0xF, 0xF, true);
}
__device__ __forceinline__ int olane() { return otid() & 63; }
__device__ __forceinline__ float xor16f(float v) { return __int_as_float(__builtin_amdgcn_ds_bpermute((olane() ^ 16) << 2, __float_as_int(v))); }
__device__ __forceinline__ float xor32f(float v) { return __int_as_float(__builtin_amdgcn_ds_bpermute((olane() ^ 32) << 2, __float_as_int(v))); }
__device__ __forceinline__ unsigned xor16u(unsigned v) { return (unsigned)__builtin_amdgcn_ds_bpermute((olane() ^ 16) << 2, (int)v); }
__device__ __forceinline__ unsigned xor32u(unsigned v) { return (unsigned)__builtin_amdgcn_ds_bpermute((olane() ^ 32) << 2, (int)v); }
__device__ __forceinline__ float rl_f(float v, int lane) { return __int_as_float(__builtin_amdgcn_readlane(__float_as_int(v), lane)); }
__device__ __forceinline__ float wave_sum(float v) {
  v += dppf<0xB1>(v); v += dppf<0x4E>(v); v += dppf<0x141>(v); v += dppf<0x140>(v);
  return (rl_f(v, 0) + rl_f(v, 16)) + (rl_f(v, 32) + rl_f(v, 48));
}
__device__ __forceinline__ float wave_max(float v) {
  v = fmaxf(v, dppf<0xB1>(v)); v = fmaxf(v, dppf<0x4E>(v)); v = fmaxf(v, dppf<0x141>(v)); v = fmaxf(v, dppf<0x140>(v));
  return fmaxf(fmaxf(rl_f(v, 0), rl_f(v, 16)), fmaxf(rl_f(v, 32), rl_f(v, 48)));
}
__device__ __forceinline__ unsigned wave_or(unsigned v) {
  v |= dppu<0xB1>(v); v |= dppu<0x4E>(v); v |= dppu<0x141>(v); v |= dppu<0x140>(v);
  return (unsigned)(__builtin_amdgcn_readlane((int)v, 0) | __builtin_amdgcn_readlane((int)v, 16) | __builtin_amdgcn_readlane((int)v, 32) | __builtin_amdgcn_readlane((int)v, 48));
}
__device__ __forceinline__ unsigned wave_incl_scan(unsigned v) {
  v += (unsigned)__builtin_amdgcn_update_dpp(0, (int)v, 0x111, 0xF, 0xF, false);
  v += (unsigned)__builtin_amdgcn_update_dpp(0, (int)v, 0x112, 0xF, 0xF, false);
  v += (unsigned)__builtin_amdgcn_update_dpp(0, (int)v, 0x114, 0xF, 0xF, false);
  v += (unsigned)__builtin_amdgcn_update_dpp(0, (int)v, 0x118, 0xF, 0xF, false);
  v += (unsigned)__builtin_amdgcn_update_dpp(0, (int)v, 0x142, 0xA, 0xF, false);
  v += (unsigned)__builtin_amdgcn_update_dpp(0, (int)v, 0x143, 0xC, 0xF, false);
  return v;
}
__device__ __forceinline__ f16v mfma16(h8 a, h8 b, f16v c) {
  return __builtin_amdgcn_mfma_f32_32x32x16_f16(a, b, c, 0, 0, 0);
}
__device__ __forceinline__ float relu_f(float x) { return __int_as_float(max(__float_as_int(x), 0)); }
__device__ __forceinline__ int crow(int r, int l) { return (r & 3) + 8 * (r >> 2) + 4 * (l >> 5); }

__device__ __forceinline__ int win_col(int nv) {
  if (nv < 3136) return nv;
  if (nv < 7760) return nv + 4;
  if (nv < 7764) return nv - 7760 + 3136;
  return -1;
}
__device__ void transpose_tile(const float* __restrict__ src, int ldn, half_t* __restrict__ dst, int K,
                               int k0, int n0, int mapmode, unsigned char* lds) {
  float* T = (float*)lds;
  const int tid = otid();
  const int nn = tid & 63;
  int col = n0 + nn;
  if (mapmode) col = win_col(col);
#pragma unroll
  for (int i = 0; i < 16; ++i) {
    int kk = (tid >> 6) + 4 * i;
    float v = 0.f;
    if (col >= 0) v = src[(size_t)(k0 + kk) * ldn + col];
    T[kk * 65 + nn] = v;
  }
  __syncthreads();
#pragma unroll
  for (int i = 0; i < 2; ++i) {
    int n2 = (tid >> 3) + 32 * i;
    int kc = tid & 7;
    h8 o;
#pragma unroll
    for (int q = 0; q < 8; ++q) o[q] = (half_t)T[(kc * 8 + q) * 65 + n2];
    *(h8*)(dst + (size_t)(n0 + n2) * K + k0 + kc * 8) = o;
  }
  __syncthreads();
}

__device__ void phase_prologue(const Params& p, unsigned char* lds) {
  const int tid = otid();
  half_t* WinT = (half_t*)(p.ws + OFF_WINT);
  half_t* WbrT = (half_t*)(p.ws + OFF_WBRT);
  half_t* WoutT = (half_t*)(p.ws + OFF_WOUTT);
  float* MOD = (float*)(p.ws + OFF_MOD);
  float* RT = (float*)(p.ws + OFF_RT);
  float* DT = (float*)(p.ws + OFF_DT);
  const int T_WIN = 4 * 124 * 16;
  const int T_WBR = 12 * 16 * 8;
  const int T_WOUT = 4 * 16 * 16;
  const int T_MOD = 192;
  const int T_ROPE = 16384 * 40 / 256;
  const int total = T_WIN + T_WBR + T_WOUT + T_MOD + T_ROPE;
  {
    float* T = (float*)lds;
    const int nn = tid & 63;
    float cur[16], nxt[16];
    int task = blockIdx.x;
    if (task < T_WIN) {
      const int l = task / (124 * 16), r = task % (124 * 16), nt = r / 16, kt = r % 16;
      const int col = win_col(nt * 64 + nn);
      const float* src = p.w_in + (size_t)l * 1024 * NIN;
#pragma unroll
      for (int i = 0; i < 16; ++i) { const int kk = (tid >> 6) + 4 * i; cur[i] = (col >= 0) ? src[(size_t)(kt * 64 + kk) * NIN + col] : 0.f; }
    }
    for (; task < T_WIN; task += gridDim.x) {
      const int tn = (task + (int)gridDim.x < T_WIN) ? task + (int)gridDim.x : task;
      {
        const int l = tn / (124 * 16), r = tn % (124 * 16), nt = r / 16, kt = r % 16;
        const int col = win_col(nt * 64 + nn);
        const float* src = p.w_in + (size_t)l * 1024 * NIN;
#pragma unroll
        for (int i = 0; i < 16; ++i) { const int kk = (tid >> 6) + 4 * i; nxt[i] = (col >= 0) ? src[(size_t)(kt * 64 + kk) * NIN + col] : 0.f; }
      }
      const int l = task / (124 * 16), r = task % (124 * 16), nt = r / 16, kt = r % 16;
      half_t* dst = WinT + (size_t)l * NPAD * WP;
#pragma unroll
      for (int i = 0; i < 16; ++i) T[((tid >> 6) + 4 * i) * 65 + nn] = cur[i];
      __syncthreads();
#pragma unroll
      for (int i = 0; i < 2; ++i) {
        const int n2 = (tid >> 3) + 32 * i, kc = tid & 7;
        h8 o;
#pragma unroll
        for (int q = 0; q < 8; ++q) o[q] = (half_t)T[(kc * 8 + q) * 65 + n2];
        *(h8*)(dst + (size_t)(nt * 64 + n2) * WP + kt * 64 + kc * 8) = o;
      }
      __syncthreads();
#pragma unroll
      for (int i = 0; i < 16; ++i) cur[i] = nxt[i];
    }
  }
  for (int task = blockIdx.x; task < total; task += gridDim.x) {
    int t = task;
    if (t < T_WIN) continue;
    if (t < T_WIN) {
      int l = t / (124 * 16); int r = t % (124 * 16); int nt = r / 16, kt = r % 16;
      transpose_tile(p.w_in + (size_t)l * 1024 * NIN, NIN, WinT + (size_t)l * NPAD * WP, WP, kt * 64, nt * 64, 1, lds);
      continue;
    }
    t -= T_WIN;
    if (t < T_WBR) {
      int lb = t / 128; int r = t % 128; int nt = r / 8, kt = r % 8;
      int l = lb / 3, b = lb % 3;
      const float* src = (b == 0 ? p.w_br_ret : (b == 1 ? p.w_br_dsa : p.w_br_gla)) + (size_t)l * 512 * 1024;
      transpose_tile(src, 1024, WbrT + (size_t)lb * 1024 * WBP, WBP, kt * 64, nt * 64, 0, lds);
      continue;
    }
    t -= T_WBR;
    if (t < T_WOUT) {
      int l = t / 256; int r = t % 256; int nt = r / 16, kt = r % 16;
      transpose_tile(p.w_out + (size_t)l * 1024 * 1024, 1024, WoutT + (size_t)l * 1024 * WP, WP, kt * 64, nt * 64, 0, lds);
      continue;
    }
    t -= T_WOUT;
    if (t < T_MOD) {
      int l = t / 48, jb = t % 48;
      int j = jb * 64 + (tid & 63);
      int ig = tid >> 6;
      float acc = 0.f;
      const float* aw = p.ada_w + (size_t)l * 1024 * 3072;
      for (int i = ig * 256; i < ig * 256 + 256; ++i) {
        float cv = p.c[i];
        float sc = cv / (1.f + expf(-cv));
        acc += sc * aw[(size_t)i * 3072 + j];
      }
      float* red = (float*)lds;
      red[tid] = acc;
      __syncthreads();
      if (tid < 64) {
        float s = red[tid] + red[tid + 64] + red[tid + 128] + red[tid + 192];
        MOD[l * 3072 + j] = s + p.ada_b[l * 3072 + j];
      }
      __syncthreads();
      continue;
    }
    t -= T_MOD;
    {
      int e = t * 256 + tid;
      int tok = e / 40, f = e % 40;
      float pf = (float)p.pos[tok];
      if (f < 32) {
        float fr = powf(10000.0f, -(float)f * 2.0f / 64.0f);
        float ang = pf * fr;
        RT[tok * 64 + f * 2] = cosf(ang);
        RT[tok * 64 + f * 2 + 1] = sinf(ang);
      } else {
        int g = f - 32;
        float fr = powf(500000.0f, -(float)g * 2.0f / 16.0f);
        float ang = pf * fr;
        DT[tok * 16 + g * 2] = cosf(ang);
        DT[tok * 16 + g * 2 + 1] = sinf(ang);
      }
    }
  }
}

__device__ __forceinline__ void write_h_row(const float (&xv)[16], const float* __restrict__ pre,
                                            const float* __restrict__ mod, half_t* __restrict__ hrow, int l) {
  float ss = 0.f;
#pragma unroll
  for (int i = 0; i < 16; ++i) ss += xv[i] * xv[i];
  ss = wave_sum(ss);
  float rs = rsqrtf(ss * (1.0f / 1024.0f) + 1e-6f);
#pragma unroll
  for (int i = 0; i < 4; ++i) {
    int c0 = i * 256 + l * 4;
    f4v pg = *(const f4v*)(pre + c0);
    f4v sh = *(const f4v*)(mod + c0);
    f4v sc = *(const f4v*)(mod + 1024 + c0);
    h4 o;
#pragma unroll
    for (int q = 0; q < 4; ++q) o[q] = (half_t)(xv[i * 4 + q] * rs * pg[q] * (1.f + sc[q]) + sh[q]);
    *(h4*)(hrow + c0) = o;
  }
}

__device__ void phase_h0(const Params& p) {
  const int w = otid() >> 6, l = otid() & 63;
  half_t* H = (half_t*)(p.ws + OFF_H);
  const float* MOD = (const float*)(p.ws + OFF_MOD);
  for (int row = blockIdx.x * 4 + w; row < S_LEN; row += gridDim.x * 4) {
    float xv[16];
#pragma unroll
    for (int i = 0; i < 4; ++i) {
      f4v v = *(const f4v*)(p.x + (size_t)row * 1024 + i * 256 + l * 4);
      xv[i * 4] = v[0]; xv[i * 4 + 1] = v[1]; xv[i * 4 + 2] = v[2]; xv[i * 4 + 3] = v[3];
    }
    write_h_row(xv, p.pre_norm, MOD, H + (size_t)row * HP, l);
  }
}

__device__ __forceinline__ void lds_barrier() {
  asm volatile("s_waitcnt lgkmcnt(0)" ::: "memory");
  __builtin_amdgcn_s_barrier();
  asm volatile("" ::: "memory");
}
#define GEMM_BUF 55296
#define GEMM_EOFF 110592
template <int NT>
__device__ __forceinline__ void gemm_step(f16v (&acc)[4][NT], h8 (&ra)[8], h8 (&rb)[2 * NT],
                                          const unsigned char* As, const unsigned char* Bs, unsigned char* Aw, unsigned char* Bw,
                                          const half_t* __restrict__ A, int lda, const half_t* __restrict__ B, int ldb, int kload,
                                          int wm, int wn, int l, int r0, int kc) {
  h8 af[2][4], bf[2][NT];
#pragma unroll
  for (int i = 0; i < 4; ++i) af[0][i] = *(const h8*)(As + (wm * 128 + i * 32 + (l & 31)) * 144 + (l >> 5) * 16);
#pragma unroll
  for (int j = 0; j < NT; ++j) bf[0][j] = *(const h8*)(Bs + (wn * 32 * NT + j * 32 + (l & 31)) * 144 + (l >> 5) * 16);
#pragma unroll
  for (int ks = 0; ks < 4; ++ks) {
    if (ks < 3) {
#pragma unroll
      for (int i = 0; i < 4; ++i) af[(ks + 1) & 1][i] = *(const h8*)(As + (wm * 128 + i * 32 + (l & 31)) * 144 + (ks + 1) * 32 + (l >> 5) * 16);
#pragma unroll
      for (int j = 0; j < NT; ++j) bf[(ks + 1) & 1][j] = *(const h8*)(Bs + (wn * 32 * NT + j * 32 + (l & 31)) * 144 + (ks + 1) * 32 + (l >> 5) * 16);
    }
    __builtin_amdgcn_sched_barrier(0);
#pragma unroll
    for (int i = 0; i < 4; ++i)
#pragma unroll
      for (int j = 0; j < NT; ++j) acc[i][j] = mfma16(af[ks & 1][i], bf[ks & 1][j], acc[i][j]);
#pragma unroll
    for (int i = 2 * ks; i < 2 * ks + 2; ++i) {
      *(h8*)(Aw + (r0 + 32 * i) * 144 + kc * 16) = ra[i];
      ra[i] = *(const h8*)(A + (size_t)(r0 + 32 * i) * lda + kload + kc * 8);
    }
    if (NT == 2) {
      *(h8*)(Bw + (r0 + 32 * ks) * 144 + kc * 16) = rb[ks];
      rb[ks] = *(const h8*)(B + (size_t)(r0 + 32 * ks) * ldb + kload + kc * 8);
    } else {
#pragma unroll
      for (int i = 2 * ks; i < 2 * ks + 2; ++i) {
        *(h8*)(Bw + (r0 + 32 * i) * 144 + kc * 16) = rb[i];
        rb[i] = *(const h8*)(B + (size_t)(r0 + 32 * i) * ldb + kload + kc * 8);
      }
    }
    __builtin_amdgcn_sched_barrier(0);
  }
}
template <int NT>
__device__ __forceinline__ void gemm_issue(h8 (&ra0)[8], h8 (&rb0)[2 * NT], h8 (&ra1)[8], h8 (&rb1)[2 * NT],
                                           const half_t* __restrict__ A, int lda, const half_t* __restrict__ B, int ldb) {
  const int tid = otid();
  const int kc = tid & 7, r0 = tid >> 3;
#pragma unroll
  for (int i = 0; i < 8; ++i) ra0[i] = *(const h8*)(A + (size_t)(r0 + 32 * i) * lda + kc * 8);
#pragma unroll
  for (int i = 0; i < 2 * NT; ++i) rb0[i] = *(const h8*)(B + (size_t)(r0 + 32 * i) * ldb + kc * 8);
#pragma unroll
  for (int i = 0; i < 8; ++i) ra1[i] = *(const h8*)(A + (size_t)(r0 + 32 * i) * lda + 64 + kc * 8);
#pragma unroll
  for (int i = 0; i < 2 * NT; ++i) rb1[i] = *(const h8*)(B + (size_t)(r0 + 32 * i) * ldb + 64 + kc * 8);
}
template <int NT>
__device__ __forceinline__ void gemm_run(f16v (&acc)[4][NT], h8 (&ra0)[8], h8 (&rb0)[2 * NT], h8 (&ra1)[8], h8 (&rb1)[2 * NT],
                                         const half_t* __restrict__ A, int lda, const half_t* __restrict__ B, int ldb, int K, unsigned char* lds) {
  const int tid = otid(), w = tid >> 6, l = tid & 63;
  constexpr int STAGE = 256 * 144 + 64 * NT * 144;
  unsigned char* A0 = lds;
  unsigned char* B0 = lds + 256 * 144;
  unsigned char* A1 = lds + STAGE;
  unsigned char* B1 = lds + STAGE + 256 * 144;
  const int wm = w >> 1, wn = w & 1;
  const int kc = tid & 7;
  const int r0 = tid >> 3;
  lds_barrier();
#pragma unroll
  for (int i = 0; i < 8; ++i) { *(h8*)(A0 + (r0 + 32 * i) * 144 + kc * 16) = ra0[i]; ra0[i] = *(const h8*)(A + (size_t)(r0 + 32 * i) * lda + 128 + kc * 8); }
#pragma unroll
  for (int i = 0; i < 2 * NT; ++i) { *(h8*)(B0 + (r0 + 32 * i) * 144 + kc * 16) = rb0[i]; rb0[i] = *(const h8*)(B + (size_t)(r0 + 32 * i) * ldb + 128 + kc * 8); }
  lds_barrier();
  const int nk = K / 64;
#pragma unroll 1
  for (int kt = 0; kt < nk; kt += 2) {
    gemm_step<NT>(acc, ra1, rb1, A0, B0, A1, B1, A, lda, B, ldb, (kt + 3 < nk) ? (kt + 3) * 64 : 0, wm, wn, l, r0, kc);
    lds_barrier();
    gemm_step<NT>(acc, ra0, rb0, A1, B1, A0, B0, A, lda, B, ldb, (kt + 4 < nk) ? (kt + 4) * 64 : 0, wm, wn, l, r0, kc);
    lds_barrier();
  }
}
template <int NT>
__device__ __forceinline__ void gemm_kloop(f16v (&acc)[4][NT], const half_t* __restrict__ A, int lda,
                                           const half_t* __restrict__ B, int ldb, int K, unsigned char* lds) {
  h8 ra0[8], rb0[2 * NT], ra1[8], rb1[2 * NT];
  gemm_issue<NT>(ra0, rb0, ra1, rb1, A, lda, B, ldb);
  gemm_run<NT>(acc, ra0, rb0, ra1, rb1, A, lda, B, ldb, K, lds);
}

template <int NT>
__device__ __forceinline__ void gemm_issue1(h8 (&ra)[8], h8 (&rb)[2 * NT], const half_t* __restrict__ A, int lda, const half_t* __restrict__ B, int ldb) {
  const int tid = otid();
  const int kc = tid & 7, r0 = tid >> 3;
#pragma unroll
  for (int i = 0; i < 8; ++i) ra[i] = *(const h8*)(A + (size_t)(r0 + 32 * i) * lda + kc * 8);
#pragma unroll
  for (int i = 0; i < 2 * NT; ++i) rb[i] = *(const h8*)(B + (size_t)(r0 + 32 * i) * ldb + kc * 8);
}
template <int NT>
__device__ __forceinline__ void gemm_run1(f16v (&acc)[4][NT], h8 (&ra)[8], h8 (&rb)[2 * NT],
                                          const half_t* __restrict__ A, int lda, const half_t* __restrict__ B, int ldb, int K, unsigned char* lds) {
  const int tid = otid(), w = tid >> 6, l = tid & 63;
  constexpr int STAGE = 256 * 144 + 64 * NT * 144;
  const int wm = w >> 1, wn = w & 1;
  const int kc = tid & 7;
  const int r0 = tid >> 3;
  lds_barrier();
#pragma unroll
  for (int i = 0; i < 8; ++i) { *(h8*)(lds + (r0 + 32 * i) * 144 + kc * 16) = ra[i]; ra[i] = *(const h8*)(A + (size_t)(r0 + 32 * i) * lda + 64 + kc * 8); }
#pragma unroll
  for (int i = 0; i < 2 * NT; ++i) { *(h8*)(lds + 256 * 144 + (r0 + 32 * i) * 144 + kc * 16) = rb[i]; rb[i] = *(const h8*)(B + (size_t)(r0 + 32 * i) * ldb + 64 + kc * 8); }
  lds_barrier();
  const int nk = K / 64;
#pragma unroll 1
  for (int kt = 0; kt < nk; ++kt) {
    unsigned char* cur = lds + (kt & 1) * STAGE;
    unsigned char* nxt = lds + ((kt + 1) & 1) * STAGE;
    gemm_step<NT>(acc, ra, rb, cur, cur + 256 * 144, nxt, nxt + 256 * 144, A, lda, B, ldb, (kt + 2 < nk) ? (kt + 2) * 64 : 0, wm, wn, l, r0, kc);
    lds_barrier();
  }
}

template <int NT>
__device__ __forceinline__ void zero_acc(f16v (&acc)[4][NT]) {
  float z = 0.f;
  asm volatile("" : "+v"(z));
#pragma unroll
  for (int i = 0; i < 4; ++i)
#pragma unroll
    for (int j = 0; j < NT; ++j)
#pragma unroll
      for (int r = 0; r < 16; ++r) acc[i][j][r] = z;
}

#define EP 68
__device__ __forceinline__ void stage_pair(float* E, const f16v& a0, const f16v& a1, int l) {
#pragma unroll
  for (int r = 0; r < 16; ++r) {
    const int rr = crow(r, l);
    E[rr * EP + (l & 31)] = a0[r];
    E[rr * EP + 32 + (l & 31)] = a1[r];
  }
}
__device__ __forceinline__ void ld8(const float* p, float (&v)[8]) {
  const f4v a = *(const f4v*)p, b = *(const f4v*)(p + 4);
  v[0] = a[0]; v[1] = a[1]; v[2] = a[2]; v[3] = a[3]; v[4] = b[0]; v[5] = b[1]; v[6] = b[2]; v[7] = b[3];
}
__device__ __forceinline__ int xcc_census(const unsigned* xcnt, int my_xcc) {
  unsigned sum = 0; bool ok = my_xcc < 8; int mine = 0;
#pragma unroll
  for (int j = 0; j < 16; ++j) {
    const unsigned c = __hip_atomic_load(xcnt + j, __ATOMIC_RELAXED, __HIP_MEMORY_SCOPE_AGENT);
    sum += c;
    if (j < 8 && c == 0u) ok = false;
    if (j >= 8 && c != 0u) ok = false;
    if (j == my_xcc) mine = (int)c;
  }
  if (sum != gridDim.x) ok = false;
  return ok ? mine : 0;
}

__device__ void phase_A(const Params& p, int layer, unsigned char* lds, int my_xcc, int my_loc, const unsigned* xcnt) {
  const int tid = otid(), w = tid >> 6, l = tid & 63;
  const half_t* H = (const half_t*)(p.ws + OFF_H);
  const half_t* Wt = (const half_t*)(p.ws + OFF_WINT) + (size_t)layer * NPAD * WP;
  half_t* P = (half_t*)(p.ws + OFF_P);
  float* GA = (float*)(p.ws + OFF_GA);
  float* IW = (float*)(p.ws + OFF_IW);
  half_t* BRc = (half_t*)(p.ws + OFF_BR);
  const float* RT = (const float*)(p.ws + OFF_RT);
  const float* DT = (const float*)(p.ws + OFF_DT);
  const int wm = w >> 1, wn = w & 1;
  const int G = gridDim.x;
  const int ntiles = 64 * 31;
  const int nx = xcc_census(xcnt, my_xcc);
  int nmine;
  if (nx > 0) nmine = (my_loc < 248) ? (248 - my_loc + nx - 1) / nx : 0;
  else nmine = ((int)blockIdx.x < ntiles) ? (ntiles - (int)blockIdx.x + G - 1) / G : 0;
  h8 ra0[8], rb0[8];
  int mt = 0, nt = 0;
  if (nmine > 0) {
    if (nx > 0) { const int s0 = my_loc; mt = my_xcc * 8 + (s0 & 7); nt = s0 >> 3; }
    else { const int tix = blockIdx.x; mt = tix & 63; nt = tix >> 6; }
    gemm_issue1<4>(ra0, rb0, H + (size_t)mt * 256 * HP, HP, Wt + (size_t)nt * 256 * WP, WP);
  }
#pragma unroll 1
  for (int rnd = 0; rnd < nmine; ++rnd) {
    f16v acc[4][4];
    zero_acc<4>(acc);
    gemm_run1<4>(acc, ra0, rb0, H + (size_t)mt * 256 * HP, HP, Wt + (size_t)nt * 256 * WP, WP, 1024, lds);
    const int mt_cur = mt, nt_cur = nt;
    if (rnd + 1 < nmine) {
      if (nx > 0) { const int s1 = my_loc + nx * (rnd + 1); mt = my_xcc * 8 + (s1 & 7); nt = s1 >> 3; }
      else { const int tix = (rnd + 1) * G + blockIdx.x; mt = tix & 63; nt = tix >> 6; }
      gemm_issue1<4>(ra0, rb0, H + (size_t)mt * 256 * HP, HP, Wt + (size_t)nt * 256 * WP, WP);
    }
    const int m0w = mt_cur * 256 + wm * 128;
    const int n0w = nt_cur * 256 + wn * 128;
    float* E = (float*)(lds) + w * (32 * EP);
    const int prow = l >> 3, c0 = (l & 7) * 8;
#pragma unroll
    for (int jp = 0; jp < 2; ++jp) {
      const int nb2 = n0w + jp * 64;
      const int n0 = nb2 + c0;
      const bool rope64 = nb2 < 512;
      const bool rope16 = ((nb2 >= C_DSAQ && nb2 < C_DSAV) || (nb2 >= C_IDXQ && nb2 < C_GLAQ)) && (c0 < 16);
      float scale = 1.f;
      if (n0 < 256 || (n0 >= C_DSAQ && n0 < C_DSAK) || (n0 >= C_IDXQ && n0 < C_IDXK) || (n0 >= C_GLAQ && n0 < C_GLAK)) scale = 0.125f;
      int mode = 0;
      if ((n0 >= C_RETG && n0 < C_DSAQ) || (n0 >= C_DSAG && n0 < C_IDXQ) || (n0 >= C_GLAG && n0 < C_GLAA)) mode = 1;
      if (n0 >= C_MRG && n0 < C_END) mode = 2;
#pragma unroll
      for (int i = 0; i < 4; ++i) {
        stage_pair(E, acc[i][2 * jp], acc[i][2 * jp + 1], l);
#pragma unroll 2
        for (int ps = 0; ps < 4; ++ps) {
          const int rl = ps * 8 + prow;
          const int row = m0w + i * 32 + rl;
          float v[8], o[8];
          ld8(E + rl * EP + c0, v);
#pragma unroll
          for (int q = 0; q < 8; ++q) o[q] = v[q];
          if (rope64) {
            float pv[8], tb[16];
            ld8(E + rl * EP + (c0 ^ 32), pv);
            const float* tp = RT + (size_t)row * 64 + (c0 & 31) * 2;
            ld8(tp, *(float(*)[8])&tb[0]); ld8(tp + 8, *(float(*)[8])&tb[8]);
#pragma unroll
            for (int q = 0; q < 8; ++q) o[q] = (c0 < 32) ? (v[q] * tb[2 * q] - pv[q] * tb[2 * q + 1]) : (v[q] * tb[2 * q] + pv[q] * tb[2 * q + 1]);
          } else if (rope16) {
            float pv[8], tb[16];
            ld8(E + rl * EP + (c0 ^ 8), pv);
            const float* tp = DT + (size_t)row * 16;
            ld8(tp, *(float(*)[8])&tb[0]); ld8(tp + 8, *(float(*)[8])&tb[8]);
#pragma unroll
            for (int q = 0; q < 8; ++q) o[q] = (c0 < 8) ? (v[q] * tb[2 * q] - pv[q] * tb[2 * q + 1]) : (v[q] * tb[2 * q] + pv[q] * tb[2 * q + 1]);
          }
          h8 ov;
#pragma unroll
          for (int q = 0; q < 8; ++q) {
            float t = o[q] * scale;
            if (mode != 0) {
              const float sg = __builtin_amdgcn_rcpf(1.f + __expf(-t));
              t = (mode == 1) ? t * sg : sg;
            }
            ov[q] = (half_t)t;
          }
          if (n0 < C_END) __builtin_nontemporal_store(ov, (h8*)(P + (size_t)row * PP + n0));
          if (n0 >= C_DSAK && n0 < C_DSAG) *(h8*)(BRc + (size_t)row * 1536 + (n0 - C_DSAK)) = ov;
          if (n0 >= C_IDXK && n0 < C_GLAQ) *(h8*)(BRc + (size_t)row * 1536 + 256 + (n0 - C_IDXK)) = ov;
          if (n0 >= C_GLAA && n0 < C_MRG) {
#pragma unroll
            for (int q = 0; q < 8; ++q) GA[(size_t)row * 16 + (n0 - C_GLAA) + q] = v[q];
          }
          if (n0 == C_IDXW) {
#pragma unroll
            for (int q = 0; q < 4; ++q) IW[(size_t)row * 4 + q] = 0.5f * v[q];
          }
        }
      }
    }
  }
}

#define LA_BC 0
#define LA_GAS 16640
#define LA_WL 20736
#define LA_QT 24832
#define LA_KT 34048
#define LA_AT 43264
#define LA_VT 52480
#define LA_SS 70912
#define LA_OS 89344
#define LA_SEG 123136

__device__ void la_bcum(const Params& p, int layer, int n, int Hh, unsigned char* lds) {
  const int tid = otid();
  float* Bc = (float*)(lds + LA_BC);
  const int d = tid & 63, q = tid >> 6;
  if (Hh < 4) {
    float lg = log1pf(-exp2f(-5.0f - (float)Hh));
#pragma unroll
    for (int jj = 0; jj < 16; ++jj) { int j = q * 16 + jj; Bc[j * 65 + d] = (float)(j + 1) * lg; }
    __syncthreads();
    return;
  }
  const int h = Hh - 4;
  float* GAs = (float*)(lds + LA_GAS);
  float* WL = (float*)(lds + LA_WL);
  float* SEG = (float*)(lds + LA_SEG);
  const float* GA = (const float*)(p.ws + OFF_GA);
#pragma unroll
  for (int i = 0; i < 4; ++i) {
    int e = tid + 256 * i;
    GAs[e] = GA[(size_t)n * 64 * 16 + e];
    int r = e >> 6, dd = e & 63;
    WL[e] = p.gla_w_lr[(size_t)layer * 16 * 256 + r * 256 + h * 64 + dd];
  }
  __syncthreads();
  float wl[16];
#pragma unroll
  for (int r = 0; r < 16; ++r) wl[r] = WL[r * 64 + d];
  const float bl = p.gla_b_lr[layer * 256 + h * 64 + d];
  float run = 0.f;
#pragma unroll
  for (int jj = 0; jj < 16; ++jj) {
    int j = q * 16 + jj;
    float z = bl;
#pragma unroll
    for (int r = 0; r < 16; ++r) z += GAs[j * 16 + r] * wl[r];
    float ls = fminf(z, 0.f) - __logf(1.f + __expf(-fabsf(z)));
    run += ls * (1.0f / 16.0f);
    Bc[j * 65 + d] = run;
  }
  SEG[q * 64 + d] = run;
  __syncthreads();
  float off = 0.f;
  for (int qq = 0; qq < q; ++qq) off += SEG[qq * 64 + d];
  if (q > 0) {
#pragma unroll
    for (int jj = 0; jj < 16; ++jj) { int j = q * 16 + jj; Bc[j * 65 + d] += off; }
  }
  __syncthreads();
}

__device__ __forceinline__ void la_load_v(const half_t* __restrict__ P, int t0, int vcol, h8 (&vr)[2][2]) {
  const int tid = otid(), w = tid >> 6, l = tid & 63;
  const int jp = l & 31, cgp = l >> 5;
#pragma unroll
  for (int it = 0; it < 2; ++it) {
    int c = it * 8 + w * 2 + cgp;
    vr[it][0] = *(const h8*)(P + (size_t)(t0 + 2 * jp) * PP + vcol + c * 8);
    vr[it][1] = *(const h8*)(P + (size_t)(t0 + 2 * jp + 1) * PP + vcol + c * 8);
  }
}
__device__ __forceinline__ void la_stage_vt(const h8 (&vr)[2][2], unsigned char* lds) {
  const int tid = otid(), w = tid >> 6, l = tid & 63;
  half_t* VT = (half_t*)(lds + LA_VT);
  const int jp = l & 31, cgp = l >> 5;
#pragma unroll
  for (int it = 0; it < 2; ++it) {
    int c = it * 8 + w * 2 + cgp;
#pragma unroll
    for (int q = 0; q < 8; ++q) {
      h2 pr; pr[0] = vr[it][0][q]; pr[1] = vr[it][1][q];
      *(h2*)(VT + (c * 8 + q) * 72 + 2 * jp) = pr;
    }
  }
}
__device__ void la_item_kv(const Params& p, int layer, int item, unsigned char* lds) {
  const int tid = otid(), w = tid >> 6, l = tid & 63;
  const int n = item >> 3, Hh = item & 7;
  const int t0 = n * 64;
  const half_t* P = (const half_t*)(p.ws + OFF_P);
  half_t* ST = (half_t*)(p.ws + OFF_ST);
  float* DEC = (float*)(p.ws + OFF_DEC);
  const int kcol = (Hh < 4) ? (C_RETK + Hh * 64) : (C_GLAK + (Hh - 4) * 64);
  const int vcol = (Hh < 4) ? (C_RETV + Hh * 128) : (C_GLAV + (Hh - 4) * 128);
  h8 vr[2][2];
  la_load_v(P, t0, vcol, vr);
  const h8 k0 = *(const h8*)(P + (size_t)(t0 + 2 * (l & 31)) * PP + kcol + (w * 2 + (l >> 5)) * 8);
  const h8 k1 = *(const h8*)(P + (size_t)(t0 + 2 * (l & 31) + 1) * PP + kcol + (w * 2 + (l >> 5)) * 8);
  __syncthreads();
  la_bcum(p, layer, n, Hh, lds);
  const float* Bc = (const float*)(lds + LA_BC);
  half_t* KhT = (half_t*)(lds + LA_KT);
  half_t* VT = (half_t*)(lds + LA_VT);
  {
    const int jp = l & 31, cgp = l >> 5;
    int c = w * 2 + cgp;
#pragma unroll
    for (int q = 0; q < 8; ++q) {
      int d = c * 8 + q;
      float bl = Bc[63 * 65 + d];
      h2 pr;
      pr[0] = (half_t)((float)k0[q] * __expf(bl - Bc[(2 * jp) * 65 + d]));
      pr[1] = (half_t)((float)k1[q] * __expf(bl - Bc[(2 * jp + 1) * 65 + d]));
      *(h2*)(KhT + d * 72 + 2 * jp) = pr;
    }
  }
  la_stage_vt(vr, lds);
  if (tid < 64) DEC[(size_t)item * 64 + tid] = __expf(Bc[63 * 65 + tid]);
  __syncthreads();
  f16v acc[2];
#pragma unroll
  for (int j = 0; j < 2; ++j)
#pragma unroll
    for (int r = 0; r < 16; ++r) acc[j][r] = ozero();
#pragma unroll
  for (int ks = 0; ks < 4; ++ks) {
    h8 a = *(const h8*)(VT + (32 * w + (l & 31)) * 72 + ks * 16 + (l >> 5) * 8);
#pragma unroll
    for (int j = 0; j < 2; ++j) {
      h8 b = *(const h8*)(KhT + (j * 32 + (l & 31)) * 72 + ks * 16 + (l >> 5) * 8);
      acc[j] = mfma16(a, b, acc[j]);
    }
  }
#pragma unroll
  for (int j = 0; j < 2; ++j)
#pragma unroll
    for (int r = 0; r < 16; ++r) {
      int e = 32 * w + crow(r, l);
      int d = j * 32 + (l & 31);
      ST[(size_t)item * 8192 + e * 64 + d] = (half_t)acc[j][r];
    }
}

__device__ void phase_scan(const Params& p) {
  half_t* ST = (half_t*)(p.ws + OFF_ST);
  const float* DEC = (const float*)(p.ws + OFF_DEC);
  for (int f2 = blockIdx.x * NTHREADS + otid(); f2 < 32768; f2 += gridDim.x * NTHREADS) {
    const int f = f2 * 2;
    const int Hh = f >> 13, d = f & 63;
    float s0 = 0.f, s1 = 0.f;
    for (int n0 = 0; n0 < 256; n0 += 16) {
      h2 kv[16]; float2 dc[16];
#pragma unroll
      for (int u = 0; u < 16; ++u) {
        kv[u] = *(const h2*)(ST + (size_t)(n0 + u) * 65536 + f);
        dc[u] = *(const float2*)(DEC + (size_t)((n0 + u) * 8 + Hh) * 64 + d);
      }
#pragma unroll
      for (int u = 0; u < 16; ++u) {
        h2 o; o[0] = (half_t)s0; o[1] = (half_t)s1;
        *(h2*)(ST + (size_t)(n0 + u) * 65536 + f) = o;
        s0 = dc[u].x * s0 + (float)kv[u][0];
        s1 = dc[u].y * s1 + (float)kv[u][1];
      }
    }
  }
}

__device__ void la_item_out(const Params& p, int layer, int item, unsigned char* lds) {
  const int tid = otid(), w = tid >> 6, l = tid & 63;
  const int n = item >> 3, Hh = item & 7;
  const int t0 = n * 64;
  const half_t* P = (const half_t*)(p.ws + OFF_P);
  const half_t* ST = (const half_t*)(p.ws + OFF_ST);
  half_t* BR = (half_t*)(p.ws + OFF_BR);
  const int qcol = (Hh < 4) ? (C_RETQ + Hh * 64) : (C_GLAQ + (Hh - 4) * 64);
  const int kcol = (Hh < 4) ? (C_RETK + Hh * 64) : (C_GLAK + (Hh - 4) * 64);
  const int vcol = (Hh < 4) ? (C_RETV + Hh * 128) : (C_GLAV + (Hh - 4) * 128);
  const int gcol = (Hh < 4) ? (C_RETG + Hh * 128) : (C_GLAG + (Hh - 4) * 128);
  const int ocol = (Hh < 4) ? (Hh * 128) : (1024 + (Hh - 4) * 128);
  h8 vr[2][2];
  la_load_v(P, t0, vcol, vr);
  h8 qr[2], kr[2], sr[4];
#pragma unroll
  for (int it = 0; it < 2; ++it) {
    const int c = tid + 256 * it;
    qr[it] = *(const h8*)(P + (size_t)(t0 + (c >> 3)) * PP + qcol + (c & 7) * 8);
    kr[it] = *(const h8*)(P + (size_t)(t0 + (c >> 3)) * PP + kcol + (c & 7) * 8);
  }
#pragma unroll
  for (int it = 0; it < 4; ++it) {
    const int c = tid + 256 * it;
    sr[it] = *(const h8*)(ST + (size_t)item * 8192 + (c >> 3) * 64 + (c & 7) * 8);
  }
  __syncthreads();
  la_bcum(p, layer, n, Hh, lds);
  const float* Bc = (const float*)(lds + LA_BC);
  half_t* Qt = (half_t*)(lds + LA_QT);
  half_t* Kt = (half_t*)(lds + LA_KT);
  half_t* AT = (half_t*)(lds + LA_AT);
  half_t* VT = (half_t*)(lds + LA_VT);
  half_t* SS = (half_t*)(lds + LA_SS);
  float* OS = (float*)(lds + LA_OS);
#pragma unroll
  for (int it = 0; it < 2; ++it) {
    int c = tid + 256 * it;
    int row = c >> 3, kc = c & 7;
    const h8 qv = qr[it];
    const h8 kv = kr[it];
    h8 qo, ko;
#pragma unroll
    for (int q = 0; q < 8; ++q) {
      float b = Bc[row * 65 + kc * 8 + q];
      qo[q] = (half_t)((float)qv[q] * __expf(b));
      ko[q] = (half_t)((float)kv[q] * __expf(-b));
    }
    *(h8*)(Qt + row * 72 + kc * 8) = qo;
    *(h8*)(Kt + row * 72 + kc * 8) = ko;
  }
  la_stage_vt(vr, lds);
#pragma unroll
  for (int it = 0; it < 4; ++it) {
    int c = tid + 256 * it;
    int e = c >> 3, kc = c & 7;
    *(h8*)(SS + e * 72 + kc * 8) = sr[it];
  }
  __syncthreads();
  {
    const int mi = w >> 1, nj = w & 1;
    f16v acc;
#pragma unroll
    for (int r = 0; r < 16; ++r) acc[r] = ozero();
#pragma unroll
    for (int ks = 0; ks < 4; ++ks) {
      h8 a = *(const h8*)(Qt + (mi * 32 + (l & 31)) * 72 + ks * 16 + (l >> 5) * 8);
      h8 b = *(const h8*)(Kt + (nj * 32 + (l & 31)) * 72 + ks * 16 + (l >> 5) * 8);
      acc = mfma16(a, b, acc);
    }
#pragma unroll
    for (int r = 0; r < 16; ++r) {
      int i = mi * 32 + crow(r, l);
      int j = nj * 32 + (l & 31);
      float v = (j <= i) ? acc[r] : 0.f;
      AT[i * 72 + j] = (half_t)v;
    }
  }
  __syncthreads();
  {
    const int mi = w >> 1, nh = w & 1;
    f16v acc[2];
#pragma unroll
    for (int j = 0; j < 2; ++j)
#pragma unroll
      for (int r = 0; r < 16; ++r) acc[j][r] = ozero();
#pragma unroll
    for (int ks = 0; ks < 4; ++ks) {
      h8 a1 = *(const h8*)(AT + (mi * 32 + (l & 31)) * 72 + ks * 16 + (l >> 5) * 8);
      h8 a2 = *(const h8*)(Qt + (mi * 32 + (l & 31)) * 72 + ks * 16 + (l >> 5) * 8);
#pragma unroll
      for (int j = 0; j < 2; ++j) {
        h8 b1 = *(const h8*)(VT + (nh * 64 + j * 32 + (l & 31)) * 72 + ks * 16 + (l >> 5) * 8);
        h8 b2 = *(const h8*)(SS + (nh * 64 + j * 32 + (l & 31)) * 72 + ks * 16 + (l >> 5) * 8);
        acc[j] = mfma16(a1, b1, acc[j]);
        acc[j] = mfma16(a2, b2, acc[j]);
      }
    }
#pragma unroll
    for (int j = 0; j < 2; ++j)
#pragma unroll
      for (int r = 0; r < 16; ++r) {
        int i = mi * 32 + crow(r, l);
        int e = nh * 64 + j * 32 + (l & 31);
        OS[i * 132 + e] = acc[j][r];
      }
  }
  __syncthreads();
  {
    const int i = tid >> 2, qd = tid & 3;
    float ov[32];
    float ss = 0.f;
#pragma unroll
    for (int c = 0; c < 8; ++c) {
      f4v v = *(const f4v*)(OS + i * 132 + qd * 32 + c * 4);
      ov[c * 4] = v[0]; ov[c * 4 + 1] = v[1]; ov[c * 4 + 2] = v[2]; ov[c * 4 + 3] = v[3];
      ss += v[0] * v[0] + v[1] * v[1] + v[2] * v[2] + v[3] * v[3];
    }
    ss += dppf<0xB1>(ss);
    ss += dppf<0x4E>(ss);
    float rs = rsqrtf(ss * (1.0f / 128.0f) + 1e-6f);
#pragma unroll
    for (int c = 0; c < 4; ++c) {
      h8 g = *(const h8*)(P + (size_t)(t0 + i) * PP + gcol + qd * 32 + c * 8);
      h8 o;
#pragma unroll
      for (int q = 0; q < 8; ++q) o[q] = (half_t)(ov[c * 8 + q] * rs * (float)g[q]);
      *(h8*)(BR + (size_t)(t0 + i) * 1536 + ocol + qd * 32 + c * 8) = o;
    }
  }
}

#define DS_CAP 768
#define DS_PRUNE_AT 640
#define NPL 12
#define DS_LS 0
#define DS_LI (32 * DS_CAP * 4)
#define DS_CNT (32 * DS_CAP * 6)
#define DS_THR (DS_CNT + 128)
#define DS_WQ (DS_CNT + 256)
#define DS_HIST (DS_CNT + 1024)

__device__ __forceinline__ unsigned long long wave_or64(unsigned long long v) {
  const unsigned lo = wave_or((unsigned)v), hi = wave_or((unsigned)(v >> 32));
  return ((unsigned long long)hi << 32) | lo;
}
template <bool APPROX>
__device__ __forceinline__ void dsa_prune(float* LSm, unsigned short* LIm, int n, unsigned* hist, int* cntm, float* thrm, int l) {
  unsigned long long comp[NPL];
  bool act[NPL], val[NPL];
#pragma unroll
  for (int k = 0; k < NPL; ++k) {
    int e = l + 64 * k;
    val[k] = e < n;
    const int ec = val[k] ? e : 0;
    unsigned u = __float_as_uint(LSm[ec]), li = LIm[ec];
    if (!val[k]) { u = 0; li = 0; }
    const unsigned key = (u >> 31) ? ~u : (u | 0x80000000u);
    comp[k] = ((unsigned long long)key << 14) | (unsigned long long)(16383u - li);
    act[k] = val[k];
  }
  const unsigned long long c0 = ((unsigned long long)(unsigned)__builtin_amdgcn_readfirstlane((int)(unsigned)(comp[0] >> 32)) << 32) | (unsigned)__builtin_amdgcn_readfirstlane((int)(unsigned)comp[0]);
  unsigned long long x = 0;
#pragma unroll
  for (int k = 0; k < NPL; ++k) x |= val[k] ? (comp[k] ^ c0) : 0ull;
  x = wave_or64(x);
  int shift = (x == 0ull) ? 0 : (63 - __clzll((long long)x)) - 7;
  if (shift < 0) shift = 0;
  unsigned rank = 256;
  bool fast = false; unsigned fsel = 0, fcnt = 0; int fshift = 0;
#pragma unroll 1
  for (int rd = 0; rd < 8; ++rd) {
    *(uint4*)(hist + 4 * l) = make_uint4(0, 0, 0, 0);
    asm volatile("" ::: "memory");
    unsigned dk[NPL];
#pragma unroll
    for (int k = 0; k < NPL; ++k) {
      dk[k] = (unsigned)(comp[k] >> shift) & 255u;
      if (act[k]) atomicAdd(&hist[dk[k]], 1u);
    }
    asm volatile("" ::: "memory");
    uint4 hv; hv.x = hist[4 * l]; hv.y = hist[4 * l + 1]; hv.z = hist[4 * l + 2]; hv.w = hist[4 * l + 3];
    unsigned tl = hv.x + hv.y + hv.z + hv.w;
    const unsigned pin = wave_incl_scan(tl);
    const unsigned tot = (unsigned)__builtin_amdgcn_readlane((int)pin, 63);
    unsigned sx = tot - pin;
    bool mine = (sx < rank) && (rank <= sx + tl);
    unsigned dsel = 0, nr = 0, hsel = 0;
    if (mine) {
      unsigned c = sx;
      if (c + hv.w >= rank) { dsel = 4 * l + 3; nr = rank - c; hsel = hv.w; }
      else {
        c += hv.w;
        if (c + hv.z >= rank) { dsel = 4 * l + 2; nr = rank - c; hsel = hv.z; }
        else {
          c += hv.z;
          if (c + hv.y >= rank) { dsel = 4 * l + 1; nr = rank - c; hsel = hv.y; }
          else { c += hv.y; dsel = 4 * l; nr = rank - c; hsel = hv.x; }
        }
      }
    }
    unsigned long long mk = __ballot(mine);
    int src = (mk == 0ull) ? 0 : (__ffsll((long long)mk) - 1);
    dsel = (unsigned)__builtin_amdgcn_readlane((int)dsel, src);
    rank = (unsigned)__builtin_amdgcn_readlane((int)nr, src);
    hsel = (unsigned)__builtin_amdgcn_readlane((int)hsel, src);
    if (APPROX && rd == 0) {
      const unsigned kept = 256u - rank + hsel;
      if (kept <= 320u) { fast = true; fsel = dsel; fcnt = kept; fshift = shift; break; }
    }
#pragma unroll
    for (int k = 0; k < NPL; ++k) act[k] = act[k] && (dk[k] == dsel);
    if (hsel <= 1u || shift == 0) break;
    shift = (shift >= 8) ? (shift - 8) : 0;
  }
  unsigned long long tsel = 0;
#pragma unroll
  for (int k = 0; k < NPL; ++k) tsel |= act[k] ? comp[k] : 0ull;
  unsigned long long T = 0ull;
  if (!fast) T = wave_or64(tsel);
  else T = ((c0 >> (fshift + 8)) << (fshift + 8)) | ((unsigned long long)fsel << fshift);
  bool keep[NPL];
  unsigned cntk = 0;
#pragma unroll
  for (int k = 0; k < NPL; ++k) {
    keep[k] = val[k] && (comp[k] >= T);
    cntk += keep[k] ? 1u : 0u;
  }
  unsigned pos = wave_incl_scan(cntk) - cntk;
  asm volatile("" ::: "memory");
#pragma unroll
  for (int k = 0; k < NPL; ++k) {
    if (keep[k]) {
      const unsigned kk = (unsigned)(comp[k] >> 14);
      const unsigned u = (kk & 0x80000000u) ? (kk & 0x7FFFFFFFu) : ~kk;
      LSm[pos] = __uint_as_float(u);
      LIm[pos] = (unsigned short)(16383u - ((unsigned)comp[k] & 16383u));
      ++pos;
    }
  }
  if (l == 0) {
    const unsigned T32 = (unsigned)(T >> 14);
    *cntm = fast ? (int)fcnt : 256;
    *thrm = __uint_as_float((T32 & 0x80000000u) ? (T32 & 0x7FFFFFFFu) : ~T32);
  }
  asm volatile("" ::: "memory");
}

__device__ void dsa_item(const Params& p, int qb, unsigned char* lds) {
  const int tid = otid(), w = tid >> 6, l = tid & 63;
  const int t0 = qb * 32;
  const half_t* P = (const half_t*)(p.ws + OFF_P);
  const float* IW = (const float*)(p.ws + OFF_IW);
  half_t* BR = (half_t*)(p.ws + OFF_BR);
  float* LS = (float*)(lds + DS_LS);
  unsigned short* LI = (unsigned short*)(lds + DS_LI);
  int* cnt = (int*)(lds + DS_CNT);
  float* thr = (float*)(lds + DS_THR);
  float* wq = (float*)(lds + DS_WQ);
  unsigned* hist = (unsigned*)(lds + DS_HIST) + w * 256;
  float* PWa = LS + (w * 8) * DS_CAP + 256;
  float* PWb = LS + (w * 8 + 1) * DS_CAP + 256;
  half_t* QS = (half_t*)(LI + (w * 8) * DS_CAP + 256);
  for (int rep_sel = 0; rep_sel < REP_SEL; ++rep_sel) {
  __syncthreads();
  if (tid < 32) { cnt[tid] = 0; thr[tid] = -INFINITY; }
  if (tid < 128) wq[tid] = IW[(size_t)t0 * 4 + tid];
  __syncthreads();
  h8 aq[4][4];
#pragma unroll
  for (int h = 0; h < 4; ++h)
#pragma unroll
    for (int ks = 0; ks < 4; ++ks)
      aq[h][ks] = *(const h8*)(P + (size_t)(t0 + (l & 31)) * PP + C_IDXQ + h * 64 + ks * 16 + (l >> 5) * 8);
  const int nt = qb + 1;
  const int nr = (nt + 3) >> 2;
  const int mq = l & 31;
  const f4v wv = *(const f4v*)(wq + mq * 4);
  float th = -INFINITY; asm volatile("" : "+v"(th));
  h8 bk[4];
  {
    const int k0 = (w < nt) ? w : 0;
#pragma unroll
    for (int ks = 0; ks < 4; ++ks)
      bk[ks] = *(const h8*)(BR + (size_t)(k0 * 32 + (l & 31)) * 1536 + 256 + ks * 16 + (l >> 5) * 8);
  }
#pragma unroll 1
  for (int rd = 0; rd < nr; ++rd) {
    const int kt = 4 * rd + w;
    h8 bkn[4];
    {
      const int kn = (kt + 4 < nt) ? (kt + 4) : 0;
#pragma unroll
      for (int ks = 0; ks < 4; ++ks)
        bkn[ks] = *(const h8*)(BR + (size_t)(kn * 32 + (l & 31)) * 1536 + 256 + ks * 16 + (l >> 5) * 8);
    }
    if (kt < nt) {
      const int sbase = kt * 32;
      f16v acc[4];
#pragma unroll
      for (int h = 0; h < 4; ++h) {
#pragma unroll
        for (int r = 0; r < 16; ++r) acc[h][r] = ozero();
#pragma unroll
        for (int ks = 0; ks < 4; ++ks) acc[h] = mfma16(bk[ks], aq[h][ks], acc[h]);
      }
      float scv[16];
#pragma unroll
      for (int r = 0; r < 16; ++r) {
        float sc = wv[0] * relu_f(acc[0][r]) + wv[1] * relu_f(acc[1][r]) + wv[2] * relu_f(acc[2][r]) + wv[3] * relu_f(acc[3][r]);
        sc += 0.0f;
        scv[r] = sc;
      }
      if (kt == qb) {
#pragma unroll
        for (int r = 0; r < 16; ++r) if (sbase + crow(r, l) > t0 + mq) scv[r] = -INFINITY;
      }
      unsigned pm = 0;
#pragma unroll
      for (int r = 0; r < 16; ++r) pm |= (scv[r] > th) ? (1u << r) : 0u;
      const int np = __popc(pm);
      if (__ballot(np > 0) != 0ull) {
        int base = 0;
        if (np > 0) base = atomicAdd(&cnt[mq], np);
#pragma unroll
        for (int r = 0; r < 16; ++r) {
          if ((pm >> r) & 1u) {
            const int slot = base + __popc(pm & ((1u << r) - 1u));
            LS[mq * DS_CAP + slot] = scv[r];
            LI[mq * DS_CAP + slot] = (unsigned short)(sbase + crow(r, l));
          }
        }
      }
    }
    lds_barrier();
    bool any_prune;
    {
      const int cv = (l < 32) ? cnt[l] : 0;
      unsigned pmask = (unsigned)__ballot(cv > DS_PRUNE_AT);
      any_prune = pmask != 0u;
      int j = 0;
      while (pmask != 0u) {
        const int m = __ffs((int)pmask) - 1;
        pmask &= pmask - 1u;
        if ((j & 3) == w) dsa_prune<true>(LS + m * DS_CAP, LI + m * DS_CAP, cnt[m], hist, cnt + m, thr + m, l);
        ++j;
      }
    }
    lds_barrier();
    if (any_prune) th = thr[mq];
#pragma unroll
    for (int ks = 0; ks < 4; ++ks) bk[ks] = bkn[ks];
  }
  }
#pragma unroll 1
  for (int mm = 0; mm < 8; ++mm) {
    const int m = w * 8 + mm;
    const int c = cnt[m];
    if (c > 256) dsa_prune<false>(LS + m * DS_CAP, LI + m * DS_CAP, c, hist, cnt + m, thr + m, l);
  }
  asm volatile("s_waitcnt lgkmcnt(0)" ::: "memory");
  for (int rep_att = 0; rep_att < REP_ATT; ++rep_att) {
  h8 kvr[4][8];
  {
    const int m = w * 8;
    const int c = min(cnt[m], 256);
    const unsigned short* LIm = LI + m * DS_CAP;
#pragma unroll
    for (int kk = 0; kk < 4; ++kk) {
      const int e = l + 64 * kk;
      const int s = (int)LIm[(e < c) ? e : 0];
      const half_t* kr = BR + (size_t)s * 1536;
#pragma unroll
      for (int ch = 0; ch < 8; ++ch) kvr[kk][ch] = *(const h8*)(kr + ch * 8);
    }
  }
  h8 qreg = *(const h8*)(P + (size_t)(t0 + w * 8) * PP + C_DSAQ + l * 8);
  const int dch = l >> 3, ksub = l & 7;
#pragma unroll 1
  for (int u = 0; u < 16; ++u) {
    const int mm = u >> 1, g = u & 1;
    const int m = w * 8 + mm;
    const int t = t0 + m;
    const int c = min(cnt[m], 256);
    const unsigned short* LIm = LI + m * DS_CAP;
    if (g == 0) {
      *(h8*)(QS + l * 8) = qreg;
      const int mq = (mm < 7) ? (m + 1) : m;
      qreg = *(const h8*)(P + (size_t)(t0 + mq) * PP + C_DSAQ + l * 8);
    }
    h8 gt[4];
#pragma unroll
    for (int hh = 0; hh < 4; ++hh) gt[hh] = *(const h8*)(P + (size_t)t * PP + C_DSAG + (g * 4 + hh) * 64 + dch * 8);
    h8 vv[16];
#pragma unroll
    for (int i = 0; i < 16; ++i) {
      const int e = i * 8 + ksub;
      const int s = (int)LIm[(e < c) ? e : 0];
      vv[i] = *(const h8*)(BR + (size_t)s * 1536 + 128 + g * 64 + dch * 8);
    }
    asm volatile("" ::: "memory");
    float lg[4][4];
#pragma unroll
    for (int hh = 0; hh < 4; ++hh) {
#pragma unroll
      for (int kk = 0; kk < 4; ++kk) lg[hh][kk] = ozero();
#pragma unroll
      for (int ch = 0; ch < 8; ++ch) {
        const h8 qq = *(const h8*)(QS + (g * 4 + hh) * 64 + ch * 8);
#pragma unroll
        for (int kk = 0; kk < 4; ++kk) {
          float a = lg[hh][kk];
          a = __builtin_amdgcn_fdot2(__builtin_shufflevector(qq, qq, 0, 1), __builtin_shufflevector(kvr[kk][ch], kvr[kk][ch], 0, 1), a, false);
          a = __builtin_amdgcn_fdot2(__builtin_shufflevector(qq, qq, 2, 3), __builtin_shufflevector(kvr[kk][ch], kvr[kk][ch], 2, 3), a, false);
          a = __builtin_amdgcn_fdot2(__builtin_shufflevector(qq, qq, 4, 5), __builtin_shufflevector(kvr[kk][ch], kvr[kk][ch], 4, 5), a, false);
          a = __builtin_amdgcn_fdot2(__builtin_shufflevector(qq, qq, 6, 7), __builtin_shufflevector(kvr[kk][ch], kvr[kk][ch], 6, 7), a, false);
          lg[hh][kk] = a;
        }
      }
#pragma unroll
      for (int kk = 0; kk < 4; ++kk) lg[hh][kk] = (l + 64 * kk < c) ? lg[hh][kk] : -INFINITY;
    }
    {
      const int un = (u < 15) ? (u + 1) : 15;
      const int mn = w * 8 + (un >> 1), gn = un & 1;
      const int cn = min(cnt[mn], 256);
      const unsigned short* LIn = LI + mn * DS_CAP;
#pragma unroll
      for (int kk = 0; kk < 4; ++kk) {
        const int e = l + 64 * kk;
        const int s = (int)LIn[(e < cn) ? e : 0];
        const half_t* kr = BR + (size_t)s * 1536 + gn * 64;
#pragma unroll
        for (int ch = 0; ch < 8; ++ch) kvr[kk][ch] = *(const h8*)(kr + ch * 8);
      }
    }
#pragma unroll
    for (int hh = 0; hh < 4; ++hh) {
      float mx = fmaxf(fmaxf(lg[hh][0], lg[hh][1]), fmaxf(lg[hh][2], lg[hh][3]));
      mx = wave_max(mx);
      float ev[4]; float sm = 0.f;
#pragma unroll
      for (int kk = 0; kk < 4; ++kk) { ev[kk] = __expf(lg[hh][kk] - mx); sm += ev[kk]; }
      sm = wave_sum(sm);
      const float inv = 1.0f / sm;
#pragma unroll
      for (int kk = 0; kk < 4; ++kk) ((kk < 2) ? PWa : PWb)[(l + 64 * (kk & 1)) * 4 + hh] = ev[kk] * inv;
    }
    asm volatile("" ::: "memory");
    float o[4][8];
#pragma unroll
    for (int hh = 0; hh < 4; ++hh)
#pragma unroll
      for (int q = 0; q < 8; ++q) o[hh][q] = ozero();
    const int nit = (c + 7) >> 3;
#pragma unroll 1
    for (int it0 = 0; it0 < nit; it0 += 16) {
      if (it0 > 0) {
#pragma unroll
        for (int i = 0; i < 16; ++i) {
          const int e = (it0 + i) * 8 + ksub;
          const int s = (int)LIm[(e < c) ? e : 0];
          vv[i] = *(const h8*)(BR + (size_t)s * 1536 + 128 + g * 64 + dch * 8);
        }
      }
#pragma unroll
      for (int i = 0; i < 16; ++i) {
        const int e = (it0 + i) * 8 + ksub;
        const f4v pv = *(const f4v*)(((e < 128) ? PWa : PWb) + (e & 127) * 4);
#pragma unroll
        for (int hh = 0; hh < 4; ++hh)
#pragma unroll
          for (int q = 0; q < 8; ++q) o[hh][q] += pv[hh] * (float)vv[i][q];
      }
    }
#pragma unroll
    for (int hh = 0; hh < 4; ++hh)
#pragma unroll
      for (int q = 0; q < 8; ++q) {
        float v = o[hh][q];
        v += dppf<0xB1>(v); v += dppf<0x4E>(v); v += dppf<0x141>(v);
        o[hh][q] = v;
      }
    if ((l & 7) == 0) {
#pragma unroll
      for (int hh = 0; hh < 4; ++hh) {
        const int col = (g * 4 + hh) * 64 + dch * 8;
        h8 ov;
#pragma unroll
        for (int q = 0; q < 8; ++q) ov[q] = (half_t)(o[hh][q] * (float)gt[hh][q]);
        *(h8*)(BR + (size_t)t * 1536 + 512 + col) = ov;
      }
    }
    asm volatile("" ::: "memory");
  }
  }
}

__device__ void phase_B(const Params& p, int layer, unsigned char* lds) {
  const int G = gridDim.x;
  for (int j = 0; j * G < 512; ++j) {
    const int b = (j & 1) ? (G - 1 - (int)blockIdx.x) : (int)blockIdx.x;
    const int idx = j * G + b;
#ifndef NO_DSA
    if (idx < 512) dsa_item(p, 511 - idx, lds);
#endif
  }
  for (int rep = 0; rep < REP_KV; ++rep)
  for (int it = blockIdx.x; it < 2048; it += G) la_item_kv(p, layer, it, lds);
}

__device__ void phase_E1(const Params& p, int layer, unsigned char* lds, int my_xcc, int my_loc, const unsigned* xcnt) {
  const int tid = otid(), w = tid >> 6, l = tid & 63;
  const half_t* BR = (const half_t*)(p.ws + OFF_BR);
  const half_t* WbrT = (const half_t*)(p.ws + OFF_WBRT) + (size_t)layer * 3 * 1024 * WBP;
  const half_t* P = (const half_t*)(p.ws + OFF_P);
  half_t* Y1 = (half_t*)(p.ws + OFF_H);
  const int wm = w >> 1, wn = w & 1;
  float* E = (float*)(lds + GEMM_EOFF) + w * (32 * EP);
  const int prow = l >> 3, c0 = (l & 7) * 8;
  const int nx = xcc_census(xcnt, my_xcc);
  const int nrounds = (nx > 0) ? (64 + nx - 1) / nx : (512 + (int)gridDim.x - 1) / (int)gridDim.x;
  for (int rnd = 0; rnd < nrounds; ++rnd) {
    int mt, nt;
    if (nx > 0) {
      const int s = my_loc + nx * rnd;
      if (s >= 64) continue;
      mt = my_xcc * 8 + (s & 7); nt = s >> 3;
    } else {
      const int tix = rnd * (int)gridDim.x + (int)blockIdx.x;
      if (tix >= 512) continue;
      mt = tix & 63; nt = tix >> 6;
    }
    h8 tot[4][4];
#pragma unroll
    for (int i = 0; i < 4; ++i)
#pragma unroll
      for (int ps = 0; ps < 4; ++ps)
#pragma unroll
        for (int q = 0; q < 8; ++q) tot[i][ps][q] = (half_t)ozero();
    const int m0w = mt * 256 + wm * 128;
    const int n0 = nt * 128 + wn * 64 + c0;
#pragma unroll 1
    for (int b = 0; b < 3; ++b) {
      f16v acc[4][2];
      zero_acc<2>(acc);
      gemm_kloop<2>(acc, BR + (size_t)mt * 256 * 1536 + b * 512, 1536, WbrT + (size_t)b * 1024 * WBP + (size_t)nt * 128 * WBP, WBP, 512, lds);
#pragma unroll
      for (int i = 0; i < 4; ++i) {
        h8 g[4];
#pragma unroll
        for (int ps = 0; ps < 4; ++ps) g[ps] = *(const h8*)(P + (size_t)(m0w + i * 32 + ps * 8 + prow) * PP + C_MRG + b * 1024 + n0);
        stage_pair(E, acc[i][0], acc[i][1], l);
#pragma unroll
        for (int ps = 0; ps < 4; ++ps) {
          const int rl = ps * 8 + prow;
          float ev[8];
          ld8(E + rl * EP + c0, ev);
#pragma unroll
          for (int q = 0; q < 8; ++q) tot[i][ps][q] = (half_t)((float)tot[i][ps][q] + (float)g[ps][q] * ev[q]);
        }
      }
    }
#pragma unroll
    for (int i = 0; i < 4; ++i)
#pragma unroll
      for (int ps = 0; ps < 4; ++ps) {
        const int row = m0w + i * 32 + ps * 8 + prow;
        *(h8*)(Y1 + (size_t)row * HP + n0) = tot[i][ps];
      }
  }
}

__device__ void phase_E2(const Params& p, int layer, unsigned char* lds, int my_xcc, int my_loc, const unsigned* xcnt) {
  const int tid = otid(), w = tid >> 6, l = tid & 63;
  const half_t* Y1 = (const half_t*)(p.ws + OFF_H);
  const half_t* Wo = (const half_t*)(p.ws + OFF_WOUTT) + (size_t)layer * 1024 * WP;
  float* Y = (float*)(p.ws + OFF_ST);
  const int wm = w >> 1, wn = w & 1;
  const int nx = xcc_census(xcnt, my_xcc);
  const int nrounds = (nx > 0) ? (64 + nx - 1) / nx : (512 + (int)gridDim.x - 1) / (int)gridDim.x;
  for (int rnd = 0; rnd < nrounds; ++rnd) {
    int mt, nt;
    if (nx > 0) {
      const int s = my_loc + nx * rnd;
      if (s >= 64) continue;
      mt = my_xcc * 8 + (s & 7); nt = s >> 3;
    } else {
      const int tix = rnd * (int)gridDim.x + (int)blockIdx.x;
      if (tix >= 512) continue;
      mt = tix & 63; nt = tix >> 6;
    }
    f16v acc[4][2];
    zero_acc<2>(acc);
    gemm_kloop<2>(acc, Y1 + (size_t)mt * 256 * HP, HP, Wo + (size_t)nt * 128 * WP, WP, 1024, lds);
    const int m0w = mt * 256 + wm * 128;
    const int n0w = nt * 128 + wn * 64;
    float* E = (float*)(lds + GEMM_EOFF) + w * (32 * EP);
    const int prow = l >> 3, c0 = (l & 7) * 8;
#pragma unroll
    for (int i = 0; i < 4; ++i) {
      stage_pair(E, acc[i][0], acc[i][1], l);
#pragma unroll
      for (int ps = 0; ps < 4; ++ps) {
        const int rl = ps * 8 + prow;
        const int row = m0w + i * 32 + rl;
        const f4v a = *(const f4v*)(E + rl * EP + c0), b = *(const f4v*)(E + rl * EP + c0 + 4);
        *(f4v*)(Y + (size_t)row * 1024 + n0w + c0) = a;
        *(f4v*)(Y + (size_t)row * 1024 + n0w + c0 + 4) = b;
      }
    }
  }
}

__device__ void phase_E3(const Params& p, int layer) {
  const int w = otid() >> 6, l = otid() & 63;
  const float* Y = (const float*)(p.ws + OFF_ST);
  const float* MOD = (const float*)(p.ws + OFF_MOD);
  half_t* H = (half_t*)(p.ws + OFF_H);
  const float* xin = (layer == 0) ? p.x : p.out;
  const float* gate = MOD + layer * 3072 + 2048;
  const float* post = p.post_norm + layer * 1024;
  const int stride = gridDim.x * 4;
  int row = blockIdx.x * 4 + w;
  f4v yn[4], xn[4];
  if (row < S_LEN) {
#pragma unroll
    for (int i = 0; i < 4; ++i) {
      yn[i] = *(const f4v*)(Y + (size_t)row * 1024 + i * 256 + l * 4);
      xn[i] = *(const f4v*)(xin + (size_t)row * 1024 + i * 256 + l * 4);
    }
  }
  for (; row < S_LEN; row += stride) {
    float yv[16], xv[16];
    float ss = 0.f;
#pragma unroll
    for (int i = 0; i < 4; ++i)
#pragma unroll
      for (int q = 0; q < 4; ++q) { yv[i * 4 + q] = yn[i][q]; xv[i * 4 + q] = xn[i][q]; ss += yn[i][q] * yn[i][q]; }
    const int nrow = (row + stride < S_LEN) ? (row + stride) : row;
#pragma unroll
    for (int i = 0; i < 4; ++i) {
      yn[i] = *(const f4v*)(Y + (size_t)nrow * 1024 + i * 256 + l * 4);
      xn[i] = *(const f4v*)(xin + (size_t)nrow * 1024 + i * 256 + l * 4);
    }
    ss = wave_sum(ss);
    const float rs = rsqrtf(ss * (1.0f / 1024.0f) + 1e-6f);
#pragma unroll
    for (int i = 0; i < 4; ++i) {
      const int c0 = i * 256 + l * 4;
      f4v gt = *(const f4v*)(gate + c0);
      f4v pn = *(const f4v*)(post + c0);
      f4v o;
#pragma unroll
      for (int q = 0; q < 4; ++q) { o[q] = xv[i * 4 + q] + gt[q] * (yv[i * 4 + q] * rs * pn[q]); xv[i * 4 + q] = o[q]; }
      *(f4v*)(p.out + (size_t)row * 1024 + c0) = o;
    }
    if (layer + 1 < DEPTH)
      write_h_row(xv, p.pre_norm + (layer + 1) * 1024, MOD + (layer + 1) * 3072, H + (size_t)row * HP, l);
  }
}

#define XB_TMO      128
#define XB_XCNT(j)  (256  + 64 * (j))
#define XB_XSUB(j)  (1280 + 64 * (j))
#define XB_XGEN(j)  (2304 + 64 * (j))
#define XB_TOP      3328
#define XB_TOPGEN   3392
#define XCD_BAR_WORDS 3456
#define XB_SPIN_CAP (1u << 18)
#define LAS __attribute__((address_space(3)))

__device__ __forceinline__ unsigned xb_ld(unsigned* p)              { return __hip_atomic_load(p, __ATOMIC_RELAXED, __HIP_MEMORY_SCOPE_AGENT); }
__device__ __forceinline__ unsigned xb_add(unsigned* p, unsigned v) { return __hip_atomic_fetch_add(p, v, __ATOMIC_RELAXED, __HIP_MEMORY_SCOPE_AGENT); }
__device__ __forceinline__ unsigned xb_xcc_id() { return (unsigned)__builtin_amdgcn_s_getreg((3 << 11) | 20) & 0xFu; }
#define XB_SPIN(cond, bar) do { unsigned _sp = 0; while (cond) { __builtin_amdgcn_s_sleep(1); \
    if ((++_sp & 255u) == 0u) { if (xb_ld(&(bar)[XB_TMO])) break; if (_sp > XB_SPIN_CAP) { atomicAdd(&(bar)[XB_TMO], 1u); break; } } } } while (0)

struct XcdBarrier {
    unsigned* bar; unsigned x;
    volatile LAS unsigned* st;
};

__device__ __forceinline__ XcdBarrier xcd_barrier_post(unsigned* bar, volatile LAS unsigned* st) {
    XcdBarrier b; b.bar = bar; b.x = xb_xcc_id(); b.st = st;
    if (otid() == 0) (void)xb_add(&bar[XB_XCNT(b.x)], 1u);
    return b;
}
__device__ __forceinline__ void xcd_barrier_complete(unsigned* bar, unsigned x, unsigned& nloc, unsigned& nx) {
    const unsigned G = gridDim.x * gridDim.y * gridDim.z;
    unsigned sum, cnt, mine, sp = 0u;
    for (;;) {
        sum = 0u; cnt = 0u; mine = 0u;
#pragma unroll
        for (unsigned j = 0; j < 16; ++j) { const unsigned c = xb_ld(&bar[XB_XCNT(j)]); sum += c; cnt += (c > 0u) ? 1u : 0u; mine = (j == x) ? c : mine; }
        if (sum == G) break;
        __builtin_amdgcn_s_sleep(1);
        if ((++sp & 255u) == 0u) { if (xb_ld(&bar[XB_TMO])) break; if (sp > XB_SPIN_CAP) { atomicAdd(&bar[XB_TMO], 1u); break; } }
    }
    nloc = mine > 0u ? mine : 1u; nx = cnt > 0u ? cnt : 1u;
}

__device__ __forceinline__ void xcd_barrier(const XcdBarrier& b) {
    asm volatile("s_waitcnt vmcnt(0)" ::: "memory");
    __syncthreads();
    if (otid() == 0) {
        unsigned* bar = b.bar;
        __builtin_amdgcn_s_waitcnt(0);
        unsigned nloc = b.st[0], nx = b.st[1];
        if (nloc == 0u) { xcd_barrier_complete(bar, b.x, nloc, nx); b.st[0] = nloc; b.st[1] = nx; }
        const unsigned old = xb_add(&bar[XB_XSUB(b.x)], 1u);
        const unsigned gen = old / nloc;
        if (old + 1u == (gen + 1u) * nloc) {
            __builtin_amdgcn_fence(__ATOMIC_RELEASE, "agent");
            asm volatile("s_waitcnt vmcnt(0)" ::: "memory");
            const unsigned og = xb_add(&bar[XB_TOP], 1u);
            const unsigned tg = og / nx;
            if (og + 1u == (tg + 1u) * nx) xb_add(&bar[XB_TOPGEN], 1u);
            else XB_SPIN(xb_ld(&bar[XB_TOPGEN]) == tg, bar);
            __builtin_amdgcn_fence(__ATOMIC_ACQUIRE, "agent");
            xb_add(&bar[XB_XGEN(b.x)], 1u);
            asm volatile("s_waitcnt vmcnt(0)" ::: "memory");
        } else {
            XB_SPIN(xb_ld(&bar[XB_XGEN(b.x)]) == gen, bar);
            __builtin_amdgcn_fence(__ATOMIC_ACQUIRE, "agent");
            asm volatile("s_waitcnt vmcnt(0)" ::: "memory");
        }
    }
    __syncthreads();
}


};

#ifndef REP_D
#define REP_D 1
#endif
#ifndef REP_E
#define REP_E 1
#endif
#ifndef REP_A
#define REP_A 1
#endif
#ifndef REP_B
#define REP_B 1
#endif
#ifdef ONLY_PHASE
#define PH_EN(x) (ONLY_PHASE == (x))
#else
#define PH_EN(x) true
#endif
__global__ void __launch_bounds__(NTHREADS) fwd_megakernel(Params p) {
  extern __shared__ __attribute__((aligned(16))) unsigned char lds[];
  cg::grid_group grid = cg::this_grid();
  K k; k.wbase = __builtin_amdgcn_readfirstlane((int)__builtin_amdgcn_workitem_id_x()) & ~63;
  unsigned* bar = (unsigned*)(p.ws + WS_END);
  unsigned* xcnt = bar + 16;
  unsigned* xbar = (unsigned*)(p.ws + WS_END + 1024);
  if (blockIdx.x == 0) {
    if (k.otid() < 17) __hip_atomic_store(bar + (k.otid() == 16 ? 0 : 16 + k.otid()), 0u, __ATOMIC_RELAXED, __HIP_MEMORY_SCOPE_AGENT);
    for (int i = k.otid(); i < XCD_BAR_WORDS; i += NTHREADS) __hip_atomic_store(xbar + i, 0u, __ATOMIC_RELAXED, __HIP_MEMORY_SCOPE_AGENT);
  }
  volatile LAS unsigned* xst = (volatile LAS unsigned*)(lds + LDS_BYTES - 16);
  if (k.otid() == 0) { xst[0] = 0u; xst[1] = 0u; }
  __syncthreads();
  K::XcdBarrier xb; xb.bar = xbar; xb.x = 0; xb.st = xst;
  int my_xcc = 0, my_loc = 0;
  for (int ph = p.ph_lo; ph < p.ph_hi; ++ph) {
    if (ph == 0) { if (PH_EN(0)) for (int rep = 0; rep < REP_P; ++rep) { k.phase_prologue(p, lds); __syncthreads(); } }
    else if (ph == 1) {
      xb = k.xcd_barrier_post(xbar, xst);
      int* sh = (int*)lds;
      if (k.otid() == 0) {
        const int xc = (int)(__builtin_amdgcn_s_getreg((3 << 11) | 20) & 0xFu);
        sh[0] = xc;
        sh[1] = (int)__hip_atomic_fetch_add(xcnt + xc, 1u, __ATOMIC_RELAXED, __HIP_MEMORY_SCOPE_AGENT);
      }
      __syncthreads();
      my_xcc = __builtin_amdgcn_readfirstlane(sh[0]);
      my_loc = __builtin_amdgcn_readfirstlane(sh[1]);
      __syncthreads();
      if (PH_EN(1)) k.phase_h0(p);
    }
    else {
      const int layer = (ph - 2) / 7, sub = (ph - 2) % 7;
      if (sub == 0) { if (PH_EN(2)) for (int rep = 0; rep < REP_A; ++rep) { k.phase_A(p, layer, lds, my_xcc, my_loc, xcnt); __syncthreads(); } }
      else if (sub == 1) { if (PH_EN(3)) for (int rep = 0; rep < REP_B; ++rep) { k.phase_B(p, layer, lds); __syncthreads(); } }
      else if (sub == 2) { if (PH_EN(4)) k.phase_scan(p); }
      else if (sub == 3) { if (PH_EN(5)) for (int rep = 0; rep < REP_D; ++rep) { for (int it = blockIdx.x; it < 2048; it += gridDim.x) k.la_item_out(p, layer, it, lds); __syncthreads(); } }
      else if (sub == 4) { if (PH_EN(6)) for (int rep = 0; rep < REP_E; ++rep) { k.phase_E1(p, layer, lds, my_xcc, my_loc, xcnt); __syncthreads(); } }
      else if (sub == 5) { if (PH_EN(7)) for (int rep = 0; rep < REP_E; ++rep) { k.phase_E2(p, layer, lds, my_xcc, my_loc, xcnt); __syncthreads(); } }
      else { if (PH_EN(8)) k.phase_E3(p, layer); }
    }
    if (ph + 1 < p.ph_hi) {
      if (ph == p.ph_lo) grid.sync();
      else k.xcd_barrier(xb);
    }
  }
}

extern "C" void kernel_launch(void* const* d_in, const int* in_sizes, int n_in, void* d_out, int out_size,
                              void* d_ws, size_t ws_size, hipStream_t stream) {
  static int grid_blocks = 0;
  if (!grid_blocks) {
    int dev = 0, cus = 0, per_cu = 0;
    hipGetDevice(&dev);
    hipDeviceGetAttribute(&cus, hipDeviceAttributeMultiprocessorCount, dev);
    hipFuncSetAttribute((const void*)fwd_megakernel, hipFuncAttributeMaxDynamicSharedMemorySize, LDS_BYTES);
    hipOccupancyMaxActiveBlocksPerMultiprocessor(&per_cu, (const void*)fwd_megakernel, NTHREADS, LDS_BYTES);
    if (per_cu < 1) per_cu = 1;
    if (per_cu > 1) per_cu = 1;
    grid_blocks = cus * per_cu;
    if (ws_size < WS_END) fprintf(stderr, "workspace too small: %zu < %llu\n", ws_size, (unsigned long long)WS_END);
  }
  Params p{};
  p.x = (const float*)d_in[0]; p.c = (const float*)d_in[1]; p.pos = (const int*)d_in[2];
  p.ada_w = (const float*)d_in[3]; p.ada_b = (const float*)d_in[4];
  p.pre_norm = (const float*)d_in[5]; p.post_norm = (const float*)d_in[6];
  p.w_in = (const float*)d_in[7]; p.gla_w_lr = (const float*)d_in[8]; p.gla_b_lr = (const float*)d_in[9];
  p.w_br_ret = (const float*)d_in[10]; p.w_br_dsa = (const float*)d_in[11]; p.w_br_gla = (const float*)d_in[12];
  p.w_out = (const float*)d_in[13];
  p.out = (float*)d_out; p.ws = (unsigned char*)d_ws;
  p.ph_lo = 0; p.ph_hi = 2 + 7 * DEPTH;
  void* args[] = {&p};
  hipError_t e = hipLaunchCooperativeKernel((const void*)fwd_megakernel, dim3(grid_blocks), dim3(NTHREADS), args, LDS_BYTES, stream);
  if (e != hipSuccess) fprintf(stderr, "cooperative launch failed: %s (grid %d)\n", hipGetErrorString(e), grid_blocks);
}
```

```cpp
#include <hip/hip_runtime.h>
#include <hip/hip_cooperative_groups.h>
#include <stdint.h>
#include <cstdio>
namespace cg = cooperative_groups;
#ifndef REP_P
#define REP_P 1
#endif
#ifndef REP_KV
#define REP_KV 1
#endif
#ifndef REP_SEL
#define REP_SEL 1
#endif
#ifndef REP_ATT
#define REP_ATT 1
#endif

typedef _Float16 half_t;
typedef _Float16 h8 __attribute__((ext_vector_type(8)));
typedef _Float16 h4 __attribute__((ext_vector_type(4)));
typedef _Float16 h2 __attribute__((ext_vector_type(2)));
typedef float f16v __attribute__((ext_vector_type(16)));
typedef float f4v __attribute__((ext_vector_type(4)));

#define S_LEN 16384
#define DM 1024
#define NIN 7764
#define NPAD 7936
#define PP 7808
#define DEPTH 4
#define NTHREADS 256
#define HP 1088
#define WP 1088
#define WBP 576
#define LDS_BYTES 152704

#define C_RETQ 0
#define C_RETK 256
#define C_RETV 512
#define C_RETG 1024
#define C_DSAQ 1536
#define C_DSAK 2048
#define C_DSAV 2176
#define C_DSAG 2304
#define C_IDXQ 2816
#define C_IDXK 3072
#define C_GLAQ 3136
#define C_GLAK 3392
#define C_GLAV 3648
#define C_GLAG 4160
#define C_GLAA 4672
#define C_MRG 4688
#define C_END 7760
#define C_IDXW 7760

#define OFF_WINT 0ull
#define OFF_WBRT (OFF_WINT + 4ull * NPAD * WP * 2)
#define OFF_WOUTT (OFF_WBRT + 4ull * 3 * 1024 * WBP * 2)
#define OFF_MOD (OFF_WOUTT + 4ull * 1024 * WP * 2)
#define OFF_RT (OFF_MOD + 4ull * 3072 * 4)
#define OFF_DT (OFF_RT + 16384ull * 64 * 4)
#define OFF_H (OFF_DT + 16384ull * 16 * 4)
#define OFF_P (OFF_H + 16384ull * HP * 2)
#define OFF_GA (OFF_P + 16384ull * PP * 2)
#define OFF_IW (OFF_GA + 16384ull * 16 * 4)
#define OFF_ST (OFF_IW + 16384ull * 4 * 4)
#define OFF_DEC (OFF_ST + 256ull * 65536 * 4)
#define OFF_BR (OFF_DEC + 256ull * 8 * 64 * 4)
#define WS_END (OFF_BR + 16384ull * 1536 * 2)
static_assert(WS_END + 16384 <= 508821504ull, "workspace too large");

struct Params {
  const float* x; const float* c; const int* pos; const float* ada_w; const float* ada_b;
  const float* pre_norm; const float* post_norm; const float* w_in; const float* gla_w_lr;
  const float* gla_b_lr; const float* w_br_ret; const float* w_br_dsa; const float* w_br_gla;
  const float* w_out; float* out; unsigned char* ws;
  int ph_lo; int ph_hi;
};

struct K {
int wbase;
__device__ __forceinline__ int otid() const {
  int lane;
  asm volatile("v_mbcnt_lo_u32_b32 %0, -1, 0\n\tv_mbcnt_hi_u32_b32 %0, -1, %0" : "=v"(lane));
  return wbase | lane;
}
__device__ __forceinline__ static float ozero() { float z = 0.f; asm volatile("" : "+v"(z)); return z; }
template <int CTRL>
__device__ __forceinline__ float dppf(float v) {
  return __int_as_float(__builtin_amdgcn_update_dpp(0, __float_as_int(v), CTRL, 0xF, 0xF, true));
}
template <int CTRL>
__device__ __forceinline__ unsigned dppu(unsigned v) {
  return (unsigned)__builtin_amdgcn_update_dpp(0, (int)v, CTRL, 0xF, 0xF, true);
}
__device__ __forceinline__ int olane() { return otid() & 63; }
__device__ __forceinline__ float xor16f(float v) { return __int_as_float(__builtin_amdgcn_ds_bpermute((olane() ^ 16) << 2, __float_as_int(v))); }
__device__ __forceinline__ float xor32f(float v) { return __int_as_float(__builtin_amdgcn_ds_bpermute((olane() ^ 32) << 2, __float_as_int(v))); }
__device__ __forceinline__ unsigned xor16u(unsigned v) { return (unsigned)__builtin_amdgcn_ds_bpermute((olane() ^ 16) << 2, (int)v); }
__device__ __forceinline__ unsigned xor32u(unsigned v) { return (unsigned)__builtin_amdgcn_ds_bpermute((olane() ^ 32) << 2, (int)v); }
__device__ __forceinline__ float rl_f(float v, int lane) { return __int_as_float(__builtin_amdgcn_readlane(__float_as_int(v), lane)); }
__device__ __forceinline__ float wave_sum(float v) {
  v += dppf<0xB1>(v); v += dppf<0x4E>(v); v += dppf<0x141>(v); v += dppf<0x140>(v);
  return (rl_f(v, 0) + rl_f(v, 16)) + (rl_f(v, 32) + rl_f(v, 48));
}
__device__ __forceinline__ float wave_max(float v) {
  v = fmaxf(v, dppf<0xB1>(v)); v = fmaxf(v, dppf<0x4E>(v)); v = fmaxf(v, dppf<0x141>(v)); v = fmaxf(v, dppf<0x140>(v));
  return fmaxf(fmaxf(rl_f(v, 0), rl_f(v, 16)), fmaxf(rl_f(v, 32), rl_f(v, 48)));
}
__device__ __forceinline__ unsigned wave_or(unsigned v) {
  v |= dppu<0xB1>(v); v |= dppu<0x4E>(v); v |= dppu<0x141>(v); v |= dppu<0x140>(v);
  return (unsigned)(__builtin_amdgcn_readlane((int)v, 0) | __builtin_amdgcn_readlane((int)v, 16) | __builtin_amdgcn_readlane((int)v, 32) | __builtin_amdgcn_readlane((int)v, 48));
}
__device__ __forceinline__ unsigned wave_incl_scan(unsigned v) {
  v += (unsigned)__builtin_amdgcn_update_dpp(0, (int)v, 0x111, 0xF, 0xF, false);
  v += (unsigned)__builtin_amdgcn_update_dpp(0, (int)v, 0x112, 0xF, 0xF, false);
  v += (unsigned)__builtin_amdgcn_update_dpp(0, (int)v, 0x114, 0xF, 0xF, false);
  v += (unsigned)__builtin_amdgcn_update_dpp(0, (int)v, 0x118, 0xF, 0xF, false);
  v += (unsigned)__builtin_amdgcn_update_dpp(0, (int)v, 0x142, 0xA, 0xF, false);
  v += (unsigned)__builtin_amdgcn_update_dpp(0, (int)v, 0x143, 0xC, 0xF, false);
  return v;
}
__device__ __forceinline__ f16v mfma16(h8 a, h8 b, f16v c) {
  return __builtin_amdgcn_mfma_f32_32x32x16_f16(a, b, c, 0, 0, 0);
}
__device__ __forceinline__ float relu_f(float x) { return __int_as_float(max(__float_as_int(x), 0)); }
__device__ __forceinline__ int crow(int r, int l) { return (r & 3) + 8 * (r >> 2) + 4 * (l >> 5); }

__device__ __forceinline__ int win_col(int nv) {
  if (nv < 3136) return nv;
  if (nv < 7760) return nv + 4;
  if (nv < 7764) return nv - 7760 + 3136;
  return -1;
}
__device__ void transpose_tile(const float* __restrict__ src, int ldn, half_t* __restrict__ dst, int K,
                               int k0, int n0, int mapmode, unsigned char* lds) {
  float* T = (float*)lds;
  const int tid = otid();
  const int nn = tid & 63;
  int col = n0 + nn;
  if (mapmode) col = win_col(col);
#pragma unroll
  for (int i = 0; i < 16; ++i) {
    int kk = (tid >> 6) + 4 * i;
    float v = 0.f;
    if (col >= 0) v = src[(size_t)(k0 + kk) * ldn + col];
    T[kk * 65 + nn] = v;
  }
  __syncthreads();
#pragma unroll
  for (int i = 0; i < 2; ++i) {
    int n2 = (tid >> 3) + 32 * i;
    int kc = tid & 7;
    h8 o;
#pragma unroll
    for (int q = 0; q < 8; ++q) o[q] = (half_t)T[(kc * 8 + q) * 65 + n2];
    *(h8*)(dst + (size_t)(n0 + n2) * K + k0 + kc * 8) = o;
  }
  __syncthreads();
}

__device__ void phase_prologue(const Params& p, unsigned char* lds) {
  const int tid = otid();
  half_t* WinT = (half_t*)(p.ws + OFF_WINT);
  half_t* WbrT = (half_t*)(p.ws + OFF_WBRT);
  half_t* WoutT = (half_t*)(p.ws + OFF_WOUTT);
  float* MOD = (float*)(p.ws + OFF_MOD);
  float* RT = (float*)(p.ws + OFF_RT);
  float* DT = (float*)(p.ws + OFF_DT);
  const int T_WIN = 4 * 124 * 16;
  const int T_WBR = 12 * 16 * 8;
  const int T_WOUT = 4 * 16 * 16;
  const int T_MOD = 192;
  const int T_ROPE = 16384 * 40 / 256;
  const int total = T_WIN + T_WBR + T_WOUT + T_MOD + T_ROPE;
  {
    float* T = (float*)lds;
    const int nn = tid & 63;
    float cur[16], nxt[16];
    int task = blockIdx.x;
    if (task < T_WIN) {
      const int l = task / (124 * 16), r = task % (124 * 16), nt = r / 16, kt = r % 16;
      const int col = win_col(nt * 64 + nn);
      const float* src = p.w_in + (size_t)l * 1024 * NIN;
#pragma unroll
      for (int i = 0; i < 16; ++i) { const int kk = (tid >> 6) + 4 * i; cur[i] = (col >= 0) ? src[(size_t)(kt * 64 + kk) * NIN + col] : 0.f; }
    }
    for (; task < T_WIN; task += gridDim.x) {
      const int tn = (task + (int)gridDim.x < T_WIN) ? task + (int)gridDim.x : task;
      {
        const int l = tn / (124 * 16), r = tn % (124 * 16), nt = r / 16, kt = r % 16;
        const int col = win_col(nt * 64 + nn);
        const float* src = p.w_in + (size_t)l * 1024 * NIN;
#pragma unroll
        for (int i = 0; i < 16; ++i) { const int kk = (tid >> 6) + 4 * i; nxt[i] = (col >= 0) ? src[(size_t)(kt * 64 + kk) * NIN + col] : 0.f; }
      }
      const int l = task / (124 * 16), r = task % (124 * 16), nt = r / 16, kt = r % 16;
      half_t* dst = WinT + (size_t)l * NPAD * WP;
#pragma unroll
      for (int i = 0; i < 16; ++i) T[((tid >> 6) + 4 * i) * 65 + nn] = cur[i];
      __syncthreads();
#pragma unroll
      for (int i = 0; i < 2; ++i) {
        const int n2 = (tid >> 3) + 32 * i, kc = tid & 7;
        h8 o;
#pragma unroll
        for (int q = 0; q < 8; ++q) o[q] = (half_t)T[(kc * 8 + q) * 65 + n2];
        *(h8*)(dst + (size_t)(nt * 64 + n2) * WP + kt * 64 + kc * 8) = o;
      }
      __syncthreads();
#pragma unroll
      for (int i = 0; i < 16; ++i) cur[i] = nxt[i];
    }
  }
  for (int task = blockIdx.x; task < total; task += gridDim.x) {
    int t = task;
    if (t < T_WIN) continue;
    if (t < T_WIN) {
      int l = t / (124 * 16); int r = t % (124 * 16); int nt = r / 16, kt = r % 16;
      transpose_tile(p.w_in + (size_t)l * 1024 * NIN, NIN, WinT + (size_t)l * NPAD * WP, WP, kt * 64, nt * 64, 1, lds);
      continue;
    }
    t -= T_WIN;
    if (t < T_WBR) {
      int lb = t / 128; int r = t % 128; int nt = r / 8, kt = r % 8;
      int l = lb / 3, b = lb % 3;
      const float* src = (b == 0 ? p.w_br_ret : (b == 1 ? p.w_br_dsa : p.w_br_gla)) + (size_t)l * 512 * 1024;
      transpose_tile(src, 1024, WbrT + (size_t)lb * 1024 * WBP, WBP, kt * 64, nt * 64, 0, lds);
      continue;
    }
    t -= T_WBR;
    if (t < T_WOUT) {
      int l = t / 256; int r = t % 256; int nt = r / 16, kt = r % 16;
      transpose_tile(p.w_out + (size_t)l * 1024 * 1024, 1024, WoutT + (size_t)l * 1024 * WP, WP, kt * 64, nt * 64, 0, lds);
      continue;
    }
    t -= T_WOUT;
    if (t < T_MOD) {
      int l = t / 48, jb = t % 48;
      int j = jb * 64 + (tid & 63);
      int ig = tid >> 6;
      float acc = 0.f;
      const float* aw = p.ada_w + (size_t)l * 1024 * 3072;
      for (int i = ig * 256; i < ig * 256 + 256; ++i) {
        float cv = p.c[i];
        float sc = cv / (1.f + expf(-cv));
        acc += sc * aw[(size_t)i * 3072 + j];
      }
      float* red = (float*)lds;
      red[tid] = acc;
      __syncthreads();
      if (tid < 64) {
        float s = red[tid] + red[tid + 64] + red[tid + 128] + red[tid + 192];
        MOD[l * 3072 + j] = s + p.ada_b[l * 3072 + j];
      }
      __syncthreads();
      continue;
    }
    t -= T_MOD;
    {
      int e = t * 256 + tid;
      int tok = e / 40, f = e % 40;
      float pf = (float)p.pos[tok];
      if (f < 32) {
        float fr = powf(10000.0f, -(float)f * 2.0f / 64.0f);
        float ang = pf * fr;
        RT[tok * 64 + f * 2] = cosf(ang);
        RT[tok * 64 + f * 2 + 1] = sinf(ang);
      } else {
        int g = f - 32;
        float fr = powf(500000.0f, -(float)g * 2.0f / 16.0f);
        float ang = pf * fr;
        DT[tok * 16 + g * 2] = cosf(ang);
        DT[tok * 16 + g * 2 + 1] = sinf(ang);
      }
    }
  }
}

__device__ __forceinline__ void write_h_row(const float (&xv)[16], const float* __restrict__ pre,
                                            const float* __restrict__ mod, half_t* __restrict__ hrow, int l) {
  float ss = 0.f;
#pragma unroll
  for (int i = 0; i < 16; ++i) ss += xv[i] * xv[i];
  ss = wave_sum(ss);
  float rs = rsqrtf(ss * (1.0f / 1024.0f) + 1e-6f);
#pragma unroll
  for (int i = 0; i < 4; ++i) {
    int c0 = i * 256 + l * 4;
    f4v pg = *(const f4v*)(pre + c0);
    f4v sh = *(const f4v*)(mod + c0);
    f4v sc = *(const f4v*)(mod + 1024 + c0);
    h4 o;
#pragma unroll
    for (int q = 0; q < 4; ++q) o[q] = (half_t)(xv[i * 4 + q] * rs * pg[q] * (1.f + sc[q]) + sh[q]);
    *(h4*)(hrow + c0) = o;
  }
}

__device__ void phase_h0(const Params& p) {
  const int w = otid() >> 6, l = otid() & 63;
  half_t* H = (half_t*)(p.ws + OFF_H);
  const float* MOD = (const float*)(p.ws + OFF_MOD);
  for (int row = blockIdx.x * 4 + w; row < S_LEN; row += gridDim.x * 4) {
    float xv[16];
#pragma unroll
    for (int i = 0; i < 4; ++i) {
      f4v v = *(const f4v*)(p.x + (size_t)row * 1024 + i * 256 + l * 4);
      xv[i * 4] = v[0]; xv[i * 4 + 1] = v[1]; xv[i * 4 + 2] = v[2]; xv[i * 4 + 3] = v[3];
    }
    write_h_row(xv, p.pre_norm, MOD, H + (size_t)row * HP, l);
  }
}

__device__ __forceinline__ void lds_barrier() {
  asm volatile("s_waitcnt lgkmcnt(0)" ::: "memory");
  __builtin_amdgcn_s_barrier();
  asm volatile("" ::: "memory");
}
#define GEMM_BUF 55296
#define GEMM_EOFF 110592
template <int NT>
__device__ __forceinline__ void gemm_step(f16v (&acc)[4][NT], h8 (&ra)[8], h8 (&rb)[2 * NT],
                                          const unsigned char* As, const unsigned char* Bs, unsigned char* Aw, unsigned char* Bw,
                                          const half_t* __restrict__ A, int lda, const half_t* __restrict__ B, int ldb, int kload,
                                          int wm, int wn, int l, int r0, int kc) {
  h8 af[2][4], bf[2][NT];
#pragma unroll
  for (int i = 0; i < 4; ++i) af[0][i] = *(const h8*)(As + (wm * 128 + i * 32 + (l & 31)) * 144 + (l >> 5) * 16);
#pragma unroll
  for (int j = 0; j < NT; ++j) bf[0][j] = *(const h8*)(Bs + (wn * 32 * NT + j * 32 + (l & 31)) * 144 + (l >> 5) * 16);
#pragma unroll
  for (int ks = 0; ks < 4; ++ks) {
    if (ks < 3) {
#pragma unroll
      for (int i = 0; i < 4; ++i) af[(ks + 1) & 1][i] = *(const h8*)(As + (wm * 128 + i * 32 + (l & 31)) * 144 + (ks + 1) * 32 + (l >> 5) * 16);
#pragma unroll
      for (int j = 0; j < NT; ++j) bf[(ks + 1) & 1][j] = *(const h8*)(Bs + (wn * 32 * NT + j * 32 + (l & 31)) * 144 + (ks + 1) * 32 + (l >> 5) * 16);
    }
    __builtin_amdgcn_sched_barrier(0);
#pragma unroll
    for (int i = 0; i < 4; ++i)
#pragma unroll
      for (int j = 0; j < NT; ++j) acc[i][j] = mfma16(af[ks & 1][i], bf[ks & 1][j], acc[i][j]);
#pragma unroll
    for (int i = 2 * ks; i < 2 * ks + 2; ++i) {
      *(h8*)(Aw + (r0 + 32 * i) * 144 + kc * 16) = ra[i];
      ra[i] = *(const h8*)(A + (size_t)(r0 + 32 * i) * lda + kload + kc * 8);
    }
    if (NT == 2) {
      *(h8*)(Bw + (r0 + 32 * ks) * 144 + kc * 16) = rb[ks];
      rb[ks] = *(const h8*)(B + (size_t)(r0 + 32 * ks) * ldb + kload + kc * 8);
    } else {
#pragma unroll
      for (int i = 2 * ks; i < 2 * ks + 2; ++i) {
        *(h8*)(Bw + (r0 + 32 * i) * 144 + kc * 16) = rb[i];
        rb[i] = *(const h8*)(B + (size_t)(r0 + 32 * i) * ldb + kload + kc * 8);
      }
    }
    __builtin_amdgcn_sched_barrier(0);
  }
}
template <int NT>
__device__ __forceinline__ void gemm_issue(h8 (&ra0)[8], h8 (&rb0)[2 * NT], h8 (&ra1)[8], h8 (&rb1)[2 * NT],
                                           const half_t* __restrict__ A, int lda, const half_t* __restrict__ B, int ldb) {
  const int tid = otid();
  const int kc = tid & 7, r0 = tid >> 3;
#pragma unroll
  for (int i = 0; i < 8; ++i) ra0[i] = *(const h8*)(A + (size_t)(r0 + 32 * i) * lda + kc * 8);
#pragma unroll
  for (int i = 0; i < 2 * NT; ++i) rb0[i] = *(const h8*)(B + (size_t)(r0 + 32 * i) * ldb + kc * 8);
#pragma unroll
  for (int i = 0; i < 8; ++i) ra1[i] = *(const h8*)(A + (size_t)(r0 + 32 * i) * lda + 64 + kc * 8);
#pragma unroll
  for (int i = 0; i < 2 * NT; ++i) rb1[i] = *(const h8*)(B + (size_t)(r0 + 32 * i) * ldb + 64 + kc * 8);
}
template <int NT>
__device__ __forceinline__ void gemm_run(f16v (&acc)[4][NT], h8 (&ra0)[8], h8 (&rb0)[2 * NT], h8 (&ra1)[8], h8 (&rb1)[2 * NT],
                                         const half_t* __restrict__ A, int lda, const half_t* __restrict__ B, int ldb, int K, unsigned char* lds) {
  const int tid = otid(), w = tid >> 6, l = tid & 63;
  constexpr int STAGE = 256 * 144 + 64 * NT * 144;
  unsigned char* A0 = lds;
  unsigned char* B0 = lds + 256 * 144;
  unsigned char* A1 = lds + STAGE;
  unsigned char* B1 = lds + STAGE + 256 * 144;
  const int wm = w >> 1, wn = w & 1;
  const int kc = tid & 7;
  const int r0 = tid >> 3;
  lds_barrier();
#pragma unroll
  for (int i = 0; i < 8; ++i) { *(h8*)(A0 + (r0 + 32 * i) * 144 + kc * 16) = ra0[i]; ra0[i] = *(const h8*)(A + (size_t)(r0 + 32 * i) * lda + 128 + kc * 8); }
#pragma unroll
  for (int i = 0; i < 2 * NT; ++i) { *(h8*)(B0 + (r0 + 32 * i) * 144 + kc * 16) = rb0[i]; rb0[i] = *(const h8*)(B + (size_t)(r0 + 32 * i) * ldb + 128 + kc * 8); }
  lds_barrier();
  const int nk = K / 64;
#pragma unroll 1
  for (int kt = 0; kt < nk; kt += 2) {
    gemm_step<NT>(acc, ra1, rb1, A0, B0, A1, B1, A, lda, B, ldb, (kt + 3 < nk) ? (kt + 3) * 64 : 0, wm, wn, l, r0, kc);
    lds_barrier();
    gemm_step<NT>(acc, ra0, rb0, A1, B1, A0, B0, A, lda, B, ldb, (kt + 4 < nk) ? (kt + 4) * 64 : 0, wm, wn, l, r0, kc);
    lds_barrier();
  }
}
template <int NT>
__device__ __forceinline__ void gemm_kloop(f16v (&acc)[4][NT], const half_t* __restrict__ A, int lda,
                                           const half_t* __restrict__ B, int ldb, int K, unsigned char* lds) {
  h8 ra0[8], rb0[2 * NT], ra1[8], rb1[2 * NT];
  gemm_issue<NT>(ra0, rb0, ra1, rb1, A, lda, B, ldb);
  gemm_run<NT>(acc, ra0, rb0, ra1, rb1, A, lda, B, ldb, K, lds);
}

template <int NT>
__device__ __forceinline__ void gemm_issue1(h8 (&ra)[8], h8 (&rb)[2 * NT], const half_t* __restrict__ A, int lda, const half_t* __restrict__ B, int ldb) {
  const int tid = otid();
  const int kc = tid & 7, r0 = tid >> 3;
#pragma unroll
  for (int i = 0; i < 8; ++i) ra[i] = *(const h8*)(A + (size_t)(r0 + 32 * i) * lda + kc * 8);
#pragma unroll
  for (int i = 0; i < 2 * NT; ++i) rb[i] = *(const h8*)(B + (size_t)(r0 + 32 * i) * ldb + kc * 8);
}
template <int NT>
__device__ __forceinline__ void gemm_run1(f16v (&acc)[4][NT], h8 (&ra)[8], h8 (&rb)[2 * NT],
                                          const half_t* __restrict__ A, int lda, const half_t* __restrict__ B, int ldb, int K, unsigned char* lds) {
  const int tid = otid(), w = tid >> 6, l = tid & 63;
  constexpr int STAGE = 256 * 144 + 64 * NT * 144;
  const int wm = w >> 1, wn = w & 1;
  const int kc = tid & 7;
  const int r0 = tid >> 3;
  lds_barrier();
#pragma unroll
  for (int i = 0; i < 8; ++i) { *(h8*)(lds + (r0 + 32 * i) * 144 + kc * 16) = ra[i]; ra[i] = *(const h8*)(A + (size_t)(r0 + 32 * i) * lda + 64 + kc * 8); }
#pragma unroll
  for (int i = 0; i < 2 * NT; ++i) { *(h8*)(lds + 256 * 144 + (r0 + 32 * i) * 144 + kc * 16) = rb[i]; rb[i] = *(const h8*)(B + (size_t)(r0 + 32 * i) * ldb + 64 + kc * 8); }
  lds_barrier();
  const int nk = K / 64;
#pragma unroll 1
  for (int kt = 0; kt < nk; ++kt) {
    unsigned char* cur = lds + (kt & 1) * STAGE;
    unsigned char* nxt = lds + ((kt + 1) & 1) * STAGE;
    gemm_step<NT>(acc, ra, rb, cur, cur + 256 * 144, nxt, nxt + 256 * 144, A, lda, B, ldb, (kt + 2 < nk) ? (kt + 2) * 64 : 0, wm, wn, l, r0, kc);
    lds_barrier();
  }
}

template <int NT>
__device__ __forceinline__ void zero_acc(f16v (&acc)[4][NT]) {
  float z = 0.f;
  asm volatile("" : "+v"(z));
#pragma unroll
  for (int i = 0; i < 4; ++i)
#pragma unroll
    for (int j = 0; j < NT; ++j)
#pragma unroll
      for (int r = 0; r < 16; ++r) acc[i][j][r] = z;
}

#define EP 68
__device__ __forceinline__ void stage_pair(float* E, const f16v& a0, const f16v& a1, int l) {
#pragma unroll
  for (int r = 0; r < 16; ++r) {
    const int rr = crow(r, l);
    E[rr * EP + (l & 31)] = a0[r];
    E[rr * EP + 32 + (l & 31)] = a1[r];
  }
}
__device__ __forceinline__ void ld8(const float* p, float (&v)[8]) {
  const f4v a = *(const f4v*)p, b = *(const f4v*)(p + 4);
  v[0] = a[0]; v[1] = a[1]; v[2] = a[2]; v[3] = a[3]; v[4] = b[0]; v[5] = b[1]; v[6] = b[2]; v[7] = b[3];
}
__device__ __forceinline__ int xcc_census(const unsigned* xcnt, int my_xcc) {
  unsigned sum = 0; bool ok = my_xcc < 8; int mine = 0;
#pragma unroll
  for (int j = 0; j < 16; ++j) {
    const unsigned c = __hip_atomic_load(xcnt + j, __ATOMIC_RELAXED, __HIP_MEMORY_SCOPE_AGENT);
    sum += c;
    if (j < 8 && c == 0u) ok = false;
    if (j >= 8 && c != 0u) ok = false;
    if (j == my_xcc) mine = (int)c;
  }
  if (sum != gridDim.x) ok = false;
  return ok ? mine : 0;
}

__device__ void phase_A(const Params& p, int layer, unsigned char* lds, int my_xcc, int my_loc, const unsigned* xcnt) {
  const int tid = otid(), w = tid >> 6, l = tid & 63;
  const half_t* H = (const half_t*)(p.ws + OFF_H);
  const half_t* Wt = (const half_t*)(p.ws + OFF_WINT) + (size_t)layer * NPAD * WP;
  half_t* P = (half_t*)(p.ws + OFF_P);
  float* GA = (float*)(p.ws + OFF_GA);
  float* IW = (float*)(p.ws + OFF_IW);
  half_t* BRc = (half_t*)(p.ws + OFF_BR);
  const float* RT = (const float*)(p.ws + OFF_RT);
  const float* DT = (const float*)(p.ws + OFF_DT);
  const int wm = w >> 1, wn = w & 1;
  const int G = gridDim.x;
  const int ntiles = 64 * 31;
  const int nx = xcc_census(xcnt, my_xcc);
  int nmine;
  if (nx > 0) nmine = (my_loc < 248) ? (248 - my_loc + nx - 1) / nx : 0;
  else nmine = ((int)blockIdx.x < ntiles) ? (ntiles - (int)blockIdx.x + G - 1) / G : 0;
  h8 ra0[8], rb0[8];
  int mt = 0, nt = 0;
  if (nmine > 0) {
    if (nx > 0) { const int s0 = my_loc; mt = my_xcc * 8 + (s0 & 7); nt = s0 >> 3; }
    else { const int tix = blockIdx.x; mt = tix & 63; nt = tix >> 6; }
    gemm_issue1<4>(ra0, rb0, H + (size_t)mt * 256 * HP, HP, Wt + (size_t)nt * 256 * WP, WP);
  }
#pragma unroll 1
  for (int rnd = 0; rnd < nmine; ++rnd) {
    f16v acc[4][4];
    zero_acc<4>(acc);
    gemm_run1<4>(acc, ra0, rb0, H + (size_t)mt * 256 * HP, HP, Wt + (size_t)nt * 256 * WP, WP, 1024, lds);
    const int mt_cur = mt, nt_cur = nt;
    if (rnd + 1 < nmine) {
      if (nx > 0) { const int s1 = my_loc + nx * (rnd + 1); mt = my_xcc * 8 + (s1 & 7); nt = s1 >> 3; }
      else { const int tix = (rnd + 1) * G + blockIdx.x; mt = tix & 63; nt = tix >> 6; }
      gemm_issue1<4>(ra0, rb0, H + (size_t)mt * 256 * HP, HP, Wt + (size_t)nt * 256 * WP, WP);
    }
    const int m0w = mt_cur * 256 + wm * 128;
    const int n0w = nt_cur * 256 + wn * 128;
    float* E = (float*)(lds) + w * (32 * EP);
    const int prow = l >> 3, c0 = (l & 7) * 8;
#pragma unroll
    for (int jp = 0; jp < 2; ++jp) {
      const int nb2 = n0w + jp * 64;
      const int n0 = nb2 + c0;
      const bool rope64 = nb2 < 512;
      const bool rope16 = ((nb2 >= C_DSAQ && nb2 < C_DSAV) || (nb2 >= C_IDXQ && nb2 < C_GLAQ)) && (c0 < 16);
      float scale = 1.f;
      if (n0 < 256 || (n0 >= C_DSAQ && n0 < C_DSAK) || (n0 >= C_IDXQ && n0 < C_IDXK) || (n0 >= C_GLAQ && n0 < C_GLAK)) scale = 0.125f;
      int mode = 0;
      if ((n0 >= C_RETG && n0 < C_DSAQ) || (n0 >= C_DSAG && n0 < C_IDXQ) || (n0 >= C_GLAG && n0 < C_GLAA)) mode = 1;
      if (n0 >= C_MRG && n0 < C_END) mode = 2;
#pragma unroll
      for (int i = 0; i < 4; ++i) {
        stage_pair(E, acc[i][2 * jp], acc[i][2 * jp + 1], l);
#pragma unroll 2
        for (int ps = 0; ps < 4; ++ps) {
          const int rl = ps * 8 + prow;
          const int row = m0w + i * 32 + rl;
          float v[8], o[8];
          ld8(E + rl * EP + c0, v);
#pragma unroll
          for (int q = 0; q < 8; ++q) o[q] = v[q];
          if (rope64) {
            float pv[8], tb[16];
            ld8(E + rl * EP + (c0 ^ 32), pv);
            const float* tp = RT + (size_t)row * 64 + (c0 & 31) * 2;
            ld8(tp, *(float(*)[8])&tb[0]); ld8(tp + 8, *(float(*)[8])&tb[8]);
#pragma unroll
            for (int q = 0; q < 8; ++q) o[q] = (c0 < 32) ? (v[q] * tb[2 * q] - pv[q] * tb[2 * q + 1]) : (v[q] * tb[2 * q] + pv[q] * tb[2 * q + 1]);
          } else if (rope16) {
            float pv[8], tb[16];
            ld8(E + rl * EP + (c0 ^ 8), pv);
            const float* tp = DT + (size_t)row * 16;
            ld8(tp, *(float(*)[8])&tb[0]); ld8(tp + 8, *(float(*)[8])&tb[8]);
#pragma unroll
            for (int q = 0; q < 8; ++q) o[q] = (c0 < 8) ? (v[q] * tb[2 * q] - pv[q] * tb[2 * q + 1]) : (v[q] * tb[2 * q] + pv[q] * tb[2 * q + 1]);
          }
          h8 ov;
#pragma unroll
          for (int q = 0; q < 8; ++q) {
            float t = o[q] * scale;
            if (mode != 0) {
              const float sg = __builtin_amdgcn_rcpf(1.f + __expf(-t));
              t = (mode == 1) ? t * sg : sg;
            }
            ov[q] = (half_t)t;
          }
          if (n0 < C_END) __builtin_nontemporal_store(ov, (h8*)(P + (size_t)row * PP + n0));
          if (n0 >= C_DSAK && n0 < C_DSAG) *(h8*)(BRc + (size_t)row * 1536 + (n0 - C_DSAK)) = ov;
          if (n0 >= C_IDXK && n0 < C_GLAQ) *(h8*)(BRc + (size_t)row * 1536 + 256 + (n0 - C_IDXK)) = ov;
          if (n0 >= C_GLAA && n0 < C_MRG) {
#pragma unroll
            for (int q = 0; q < 8; ++q) GA[(size_t)row * 16 + (n0 - C_GLAA) + q] = v[q];
          }
          if (n0 == C_IDXW) {
#pragma unroll
            for (int q = 0; q < 4; ++q) IW[(size_t)row * 4 + q] = 0.5f * v[q];
          }
        }
      }
    }
  }
}

#define LA_BC 0
#define LA_GAS 16640
#define LA_WL 20736
#define LA_QT 24832
#define LA_KT 34048
#define LA_AT 43264
#define LA_VT 52480
#define LA_SS 70912
#define LA_OS 89344
#define LA_SEG 123136

__device__ void la_bcum(const Params& p, int layer, int n, int Hh, unsigned char* lds) {
  const int tid = otid();
  float* Bc = (float*)(lds + LA_BC);
  const int d = tid & 63, q = tid >> 6;
  if (Hh < 4) {
    float lg = log1pf(-exp2f(-5.0f - (float)Hh));
#pragma unroll
    for (int jj = 0; jj < 16; ++jj) { int j = q * 16 + jj; Bc[j * 65 + d] = (float)(j + 1) * lg; }
    __syncthreads();
    return;
  }
  const int h = Hh - 4;
  float* GAs = (float*)(lds + LA_GAS);
  float* WL = (float*)(lds + LA_WL);
  float* SEG = (float*)(lds + LA_SEG);
  const float* GA = (const float*)(p.ws + OFF_GA);
#pragma unroll
  for (int i = 0; i < 4; ++i) {
    int e = tid + 256 * i;
    GAs[e] = GA[(size_t)n * 64 * 16 + e];
    int r = e >> 6, dd = e & 63;
    WL[e] = p.gla_w_lr[(size_t)layer * 16 * 256 + r * 256 + h * 64 + dd];
  }
  __syncthreads();
  float wl[16];
#pragma unroll
  for (int r = 0; r < 16; ++r) wl[r] = WL[r * 64 + d];
  const float bl = p.gla_b_lr[layer * 256 + h * 64 + d];
  float run = 0.f;
#pragma unroll
  for (int jj = 0; jj < 16; ++jj) {
    int j = q * 16 + jj;
    float z = bl;
#pragma unroll
    for (int r = 0; r < 16; ++r) z += GAs[j * 16 + r] * wl[r];
    float ls = fminf(z, 0.f) - __logf(1.f + __expf(-fabsf(z)));
    run += ls * (1.0f / 16.0f);
    Bc[j * 65 + d] = run;
  }
  SEG[q * 64 + d] = run;
  __syncthreads();
  float off = 0.f;
  for (int qq = 0; qq < q; ++qq) off += SEG[qq * 64 + d];
  if (q > 0) {
#pragma unroll
    for (int jj = 0; jj < 16; ++jj) { int j = q * 16 + jj; Bc[j * 65 + d] += off; }
  }
  __syncthreads();
}

__device__ __forceinline__ void la_load_v(const half_t* __restrict__ P, int t0, int vcol, h8 (&vr)[2][2]) {
  const int tid = otid(), w = tid >> 6, l = tid & 63;
  const int jp = l & 31, cgp = l >> 5;
#pragma unroll
  for (int it = 0; it < 2; ++it) {
    int c = it * 8 + w * 2 + cgp;
    vr[it][0] = *(const h8*)(P + (size_t)(t0 + 2 * jp) * PP + vcol + c * 8);
    vr[it][1] = *(const h8*)(P + (size_t)(t0 + 2 * jp + 1) * PP + vcol + c * 8);
  }
}
__device__ __forceinline__ void la_stage_vt(const h8 (&vr)[2][2], unsigned char* lds) {
  const int tid = otid(), w = tid >> 6, l = tid & 63;
  half_t* VT = (half_t*)(lds + LA_VT);
  const int jp = l & 31, cgp = l >> 5;
#pragma unroll
  for (int it = 0; it < 2; ++it) {
    int c = it * 8 + w * 2 + cgp;
#pragma unroll
    for (int q = 0; q < 8; ++q) {
      h2 pr; pr[0] = vr[it][0][q]; pr[1] = vr[it][1][q];
      *(h2*)(VT + (c * 8 + q) * 72 + 2 * jp) = pr;
    }
  }
}
__device__ void la_item_kv(const Params& p, int layer, int item, unsigned char* lds) {
  const int tid = otid(), w = tid >> 6, l = tid & 63;
  const int n = item >> 3, Hh = item & 7;
  const int t0 = n * 64;
  const half_t* P = (const half_t*)(p.ws + OFF_P);
  half_t* ST = (half_t*)(p.ws + OFF_ST);
  float* DEC = (float*)(p.ws + OFF_DEC);
  const int kcol = (Hh < 4) ? (C_RETK + Hh * 64) : (C_GLAK + (Hh - 4) * 64);
  const int vcol = (Hh < 4) ? (C_RETV + Hh * 128) : (C_GLAV + (Hh - 4) * 128);
  h8 vr[2][2];
  la_load_v(P, t0, vcol, vr);
  const h8 k0 = *(const h8*)(P + (size_t)(t0 + 2 * (l & 31)) * PP + kcol + (w * 2 + (l >> 5)) * 8);
  const h8 k1 = *(const h8*)(P + (size_t)(t0 + 2 * (l & 31) + 1) * PP + kcol + (w * 2 + (l >> 5)) * 8);
  __syncthreads();
  la_bcum(p, layer, n, Hh, lds);
  const float* Bc = (const float*)(lds + LA_BC);
  half_t* KhT = (half_t*)(lds + LA_KT);
  half_t* VT = (half_t*)(lds + LA_VT);
  {
    const int jp = l & 31, cgp = l >> 5;
    int c = w * 2 + cgp;
#pragma unroll
    for (int q = 0; q < 8; ++q) {
      int d = c * 8 + q;
      float bl = Bc[63 * 65 + d];
      h2 pr;
      pr[0] = (half_t)((float)k0[q] * __expf(bl - Bc[(2 * jp) * 65 + d]));
      pr[1] = (half_t)((float)k1[q] * __expf(bl - Bc[(2 * jp + 1) * 65 + d]));
      *(h2*)(KhT + d * 72 + 2 * jp) = pr;
    }
  }
  la_stage_vt(vr, lds);
  if (tid < 64) DEC[(size_t)item * 64 + tid] = __expf(Bc[63 * 65 + tid]);
  __syncthreads();
  f16v acc[2];
#pragma unroll
  for (int j = 0; j < 2; ++j)
#pragma unroll
    for (int r = 0; r < 16; ++r) acc[j][r] = ozero();
#pragma unroll
  for (int ks = 0; ks < 4; ++ks) {
    h8 a = *(const h8*)(VT + (32 * w + (l & 31)) * 72 + ks * 16 + (l >> 5) * 8);
#pragma unroll
    for (int j = 0; j < 2; ++j) {
      h8 b = *(const h8*)(KhT + (j * 32 + (l & 31)) * 72 + ks * 16 + (l >> 5) * 8);
      acc[j] = mfma16(a, b, acc[j]);
    }
  }
#pragma unroll
  for (int j = 0; j < 2; ++j)
#pragma unroll
    for (int r = 0; r < 16; ++r) {
      int e = 32 * w + crow(r, l);
      int d = j * 32 + (l & 31);
      ST[(size_t)item * 8192 + e * 64 + d] = (half_t)acc[j][r];
    }
}

__device__ void phase_scan(const Params& p) {
  half_t* ST = (half_t*)(p.ws + OFF_ST);
  const float* DEC = (const float*)(p.ws + OFF_DEC);
  for (int f2 = blockIdx.x * NTHREADS + otid(); f2 < 32768; f2 += gridDim.x * NTHREADS) {
    const int f = f2 * 2;
    const int Hh = f >> 13, d = f & 63;
    float s0 = 0.f, s1 = 0.f;
    for (int n0 = 0; n0 < 256; n0 += 16) {
      h2 kv[16]; float2 dc[16];
#pragma unroll
      for (int u = 0; u < 16; ++u) {
        kv[u] = *(const h2*)(ST + (size_t)(n0 + u) * 65536 + f);
        dc[u] = *(const float2*)(DEC + (size_t)((n0 + u) * 8 + Hh) * 64 + d);
      }
#pragma unroll
      for (int u = 0; u < 16; ++u) {
        h2 o; o[0] = (half_t)s0; o[1] = (half_t)s1;
        *(h2*)(ST + (size_t)(n0 + u) * 65536 + f) = o;
        s0 = dc[u].x * s0 + (float)kv[u][0];
        s1 = dc[u].y * s1 + (float)kv[u][1];
      }
    }
  }
}

__device__ void la_item_out(const Params& p, int layer, int item, unsigned char* lds) {
  const int tid = otid(), w = tid >> 6, l = tid & 63;
  const int n = item >> 3, Hh = item & 7;
  const int t0 = n * 64;
  const half_t* P = (const half_t*)(p.ws + OFF_P);
  const half_t* ST = (const half_t*)(p.ws + OFF_ST);
  half_t* BR = (half_t*)(p.ws + OFF_BR);
  const int qcol = (Hh < 4) ? (C_RETQ + Hh * 64) : (C_GLAQ + (Hh - 4) * 64);
  const int kcol = (Hh < 4) ? (C_RETK + Hh * 64) : (C_GLAK + (Hh - 4) * 64);
  const int vcol = (Hh < 4) ? (C_RETV + Hh * 128) : (C_GLAV + (Hh - 4) * 128);
  const int gcol = (Hh < 4) ? (C_RETG + Hh * 128) : (C_GLAG + (Hh - 4) * 128);
  const int ocol = (Hh < 4) ? (Hh * 128) : (1024 + (Hh - 4) * 128);
  h8 vr[2][2];
  la_load_v(P, t0, vcol, vr);
  h8 qr[2], kr[2], sr[4];
#pragma unroll
  for (int it = 0; it < 2; ++it) {
    const int c = tid + 256 * it;
    qr[it] = *(const h8*)(P + (size_t)(t0 + (c >> 3)) * PP + qcol + (c & 7) * 8);
    kr[it] = *(const h8*)(P + (size_t)(t0 + (c >> 3)) * PP + kcol + (c & 7) * 8);
  }
#pragma unroll
  for (int it = 0; it < 4; ++it) {
    const int c = tid + 256 * it;
    sr[it] = *(const h8*)(ST + (size_t)item * 8192 + (c >> 3) * 64 + (c & 7) * 8);
  }
  __syncthreads();
  la_bcum(p, layer, n, Hh, lds);
  const float* Bc = (const float*)(lds + LA_BC);
  half_t* Qt = (half_t*)(lds + LA_QT);
  half_t* Kt = (half_t*)(lds + LA_KT);
  half_t* AT = (half_t*)(lds + LA_AT);
  half_t* VT = (half_t*)(lds + LA_VT);
  half_t* SS = (half_t*)(lds + LA_SS);
  float* OS = (float*)(lds + LA_OS);
#pragma unroll
  for (int it = 0; it < 2; ++it) {
    int c = tid + 256 * it;
    int row = c >> 3, kc = c & 7;
    const h8 qv = qr[it];
    const h8 kv = kr[it];
    h8 qo, ko;
#pragma unroll
    for (int q = 0; q < 8; ++q) {
      float b = Bc[row * 65 + kc * 8 + q];
      qo[q] = (half_t)((float)qv[q] * __expf(b));
      ko[q] = (half_t)((float)kv[q] * __expf(-b));
    }
    *(h8*)(Qt + row * 72 + kc * 8) = qo;
    *(h8*)(Kt + row * 72 + kc * 8) = ko;
  }
  la_stage_vt(vr, lds);
#pragma unroll
  for (int it = 0; it < 4; ++it) {
    int c = tid + 256 * it;
    int e = c >> 3, kc = c & 7;
    *(h8*)(SS + e * 72 + kc * 8) = sr[it];
  }
  __syncthreads();
  {
    const int mi = w >> 1, nj = w & 1;
    f16v acc;
#pragma unroll
    for (int r = 0; r < 16; ++r) acc[r] = ozero();
#pragma unroll
    for (int ks = 0; ks < 4; ++ks) {
      h8 a = *(const h8*)(Qt + (mi * 32 + (l & 31)) * 72 + ks * 16 + (l >> 5) * 8);
      h8 b = *(const h8*)(Kt + (nj * 32 + (l & 31)) * 72 + ks * 16 + (l >> 5) * 8);
      acc = mfma16(a, b, acc);
    }
#pragma unroll
    for (int r = 0; r < 16; ++r) {
      int i = mi * 32 + crow(r, l);
      int j = nj * 32 + (l & 31);
      float v = (j <= i) ? acc[r] : 0.f;
      AT[i * 72 + j] = (half_t)v;
    }
  }
  __syncthreads();
  {
    const int mi = w >> 1, nh = w & 1;
    f16v acc[2];
#pragma unroll
    for (int j = 0; j < 2; ++j)
#pragma unroll
      for (int r = 0; r < 16; ++r) acc[j][r] = ozero();
#pragma unroll
    for (int ks = 0; ks < 4; ++ks) {
      h8 a1 = *(const h8*)(AT + (mi * 32 + (l & 31)) * 72 + ks * 16 + (l >> 5) * 8);
      h8 a2 = *(const h8*)(Qt + (mi * 32 + (l & 31)) * 72 + ks * 16 + (l >> 5) * 8);
#pragma unroll
      for (int j = 0; j < 2; ++j) {
        h8 b1 = *(const h8*)(VT + (nh * 64 + j * 32 + (l & 31)) * 72 + ks * 16 + (l >> 5) * 8);
        h8 b2 = *(const h8*)(SS + (nh * 64 + j * 32 + (l & 31)) * 72 + ks * 16 + (l >> 5) * 8);
        acc[j] = mfma16(a1, b1, acc[j]);
        acc[j] = mfma16(a2, b2, acc[j]);
      }
    }
#pragma unroll
    for (int j = 0; j < 2; ++j)
#pragma unroll
      for (int r = 0; r < 16; ++r) {
        int i = mi * 32 + crow(r, l);
        int e = nh * 64 + j * 32 + (l & 31);
        OS[i * 132 + e] = acc[j][r];
      }
  }
  __syncthreads();
  {
    const int i = tid >> 2, qd = tid & 3;
    float ov[32];
    float ss = 0.f;
#pragma unroll
    for (int c = 0; c < 8; ++c) {
      f4v v = *(const f4v*)(OS + i * 132 + qd * 32 + c * 4);
      ov[c * 4] = v[0]; ov[c * 4 + 1] = v[1]; ov[c * 4 + 2] = v[2]; ov[c * 4 + 3] = v[3];
      ss += v[0] * v[0] + v[1] * v[1] + v[2] * v[2] + v[3] * v[3];
    }
    ss += dppf<0xB1>(ss);
    ss += dppf<0x4E>(ss);
    float rs = rsqrtf(ss * (1.0f / 128.0f) + 1e-6f);
#pragma unroll
    for (int c = 0; c < 4; ++c) {
      h8 g = *(const h8*)(P + (size_t)(t0 + i) * PP + gcol + qd * 32 + c * 8);
      h8 o;
#pragma unroll
      for (int q = 0; q < 8; ++q) o[q] = (half_t)(ov[c * 8 + q] * rs * (float)g[q]);
      *(h8*)(BR + (size_t)(t0 + i) * 1536 + ocol + qd * 32 + c * 8) = o;
    }
  }
}

#define DS_CAP 768
#define DS_PRUNE_AT 640
#define NPL 12
#define DS_LS 0
#define DS_LI (32 * DS_CAP * 4)
#define DS_CNT (32 * DS_CAP * 6)
#define DS_THR (DS_CNT + 128)
#define DS_WQ (DS_CNT + 256)
#define DS_HIST (DS_CNT + 1024)

__device__ __forceinline__ unsigned long long wave_or64(unsigned long long v) {
  const unsigned lo = wave_or((unsigned)v), hi = wave_or((unsigned)(v >> 32));
  return ((unsigned long long)hi << 32) | lo;
}
template <bool APPROX>
__device__ __forceinline__ void dsa_prune(float* LSm, unsigned short* LIm, int n, unsigned* hist, int* cntm, float* thrm, int l) {
  unsigned long long comp[NPL];
  bool act[NPL], val[NPL];
#pragma unroll
  for (int k = 0; k < NPL; ++k) {
    int e = l + 64 * k;
    val[k] = e < n;
    const int ec = val[k] ? e : 0;
    unsigned u = __float_as_uint(LSm[ec]), li = LIm[ec];
    if (!val[k]) { u = 0; li = 0; }
    const unsigned key = (u >> 31) ? ~u : (u | 0x80000000u);
    comp[k] = ((unsigned long long)key << 14) | (unsigned long long)(16383u - li);
    act[k] = val[k];
  }
  const unsigned long long c0 = ((unsigned long long)(unsigned)__builtin_amdgcn_readfirstlane((int)(unsigned)(comp[0] >> 32)) << 32) | (unsigned)__builtin_amdgcn_readfirstlane((int)(unsigned)comp[0]);
  unsigned long long x = 0;
#pragma unroll
  for (int k = 0; k < NPL; ++k) x |= val[k] ? (comp[k] ^ c0) : 0ull;
  x = wave_or64(x);
  int shift = (x == 0ull) ? 0 : (63 - __clzll((long long)x)) - 7;
  if (shift < 0) shift = 0;
  unsigned rank = 256;
  bool fast = false; unsigned fsel = 0, fcnt = 0; int fshift = 0;
#pragma unroll 1
  for (int rd = 0; rd < 8; ++rd) {
    *(uint4*)(hist + 4 * l) = make_uint4(0, 0, 0, 0);
    asm volatile("" ::: "memory");
    unsigned dk[NPL];
#pragma unroll
    for (int k = 0; k < NPL; ++k) {
      dk[k] = (unsigned)(comp[k] >> shift) & 255u;
      if (act[k]) atomicAdd(&hist[dk[k]], 1u);
    }
    asm volatile("" ::: "memory");
    uint4 hv; hv.x = hist[4 * l]; hv.y = hist[4 * l + 1]; hv.z = hist[4 * l + 2]; hv.w = hist[4 * l + 3];
    unsigned tl = hv.x + hv.y + hv.z + hv.w;
    const unsigned pin = wave_incl_scan(tl);
    const unsigned tot = (unsigned)__builtin_amdgcn_readlane((int)pin, 63);
    unsigned sx = tot - pin;
    bool mine = (sx < rank) && (rank <= sx + tl);
    unsigned dsel = 0, nr = 0, hsel = 0;
    if (mine) {
      unsigned c = sx;
      if (c + hv.w >= rank) { dsel = 4 * l + 3; nr = rank - c; hsel = hv.w; }
      else {
        c += hv.w;
        if (c + hv.z >= rank) { dsel = 4 * l + 2; nr = rank - c; hsel = hv.z; }
        else {
          c += hv.z;
          if (c + hv.y >= rank) { dsel = 4 * l + 1; nr = rank - c; hsel = hv.y; }
          else { c += hv.y; dsel = 4 * l; nr = rank - c; hsel = hv.x; }
        }
      }
    }
    unsigned long long mk = __ballot(mine);
    int src = (mk == 0ull) ? 0 : (__ffsll((long long)mk) - 1);
    dsel = (unsigned)__builtin_amdgcn_readlane((int)dsel, src);
    rank = (unsigned)__builtin_amdgcn_readlane((int)nr, src);
    hsel = (unsigned)__builtin_amdgcn_readlane((int)hsel, src);
    if (APPROX && rd == 0) {
      const unsigned kept = 256u - rank + hsel;
      if (kept <= 288u) { fast = true; fsel = dsel; fcnt = kept; fshift = shift; break; }
    }
#pragma unroll
    for (int k = 0; k < NPL; ++k) act[k] = act[k] && (dk[k] == dsel);
    if (hsel <= 1u || shift == 0) break;
    shift = (shift >= 8) ? (shift - 8) : 0;
  }
  unsigned long long tsel = 0;
#pragma unroll
  for (int k = 0; k < NPL; ++k) tsel |= act[k] ? comp[k] : 0ull;
  unsigned long long T = 0ull;
  if (!fast) T = wave_or64(tsel);
  else T = ((c0 >> (fshift + 8)) << (fshift + 8)) | ((unsigned long long)fsel << fshift);
  bool keep[NPL];
  unsigned cntk = 0;
#pragma unroll
  for (int k = 0; k < NPL; ++k) {
    keep[k] = val[k] && (comp[k] >= T);
    cntk += keep[k] ? 1u : 0u;
  }
  unsigned pos = wave_incl_scan(cntk) - cntk;
  asm volatile("" ::: "memory");
#pragma unroll
  for (int k = 0; k < NPL; ++k) {
    if (keep[k]) {
      const unsigned kk = (unsigned)(comp[k] >> 14);
      const unsigned u = (kk & 0x80000000u) ? (kk & 0x7FFFFFFFu) : ~kk;
      LSm[pos] = __uint_as_float(u);
      LIm[pos] = (unsigned short)(16383u - ((unsigned)comp[k] & 16383u));
      ++pos;
    }
  }
  if (l == 0) {
    const unsigned T32 = (unsigned)(T >> 14);
    *cntm = fast ? (int)fcnt : 256;
    *thrm = __uint_as_float((T32 & 0x80000000u) ? (T32 & 0x7FFFFFFFu) : ~T32);
  }
  asm volatile("" ::: "memory");
}

__device__ void dsa_item(const Params& p, int qb, unsigned char* lds) {
  const int tid = otid(), w = tid >> 6, l = tid & 63;
  const int t0 = qb * 32;
  const half_t* P = (const half_t*)(p.ws + OFF_P);
  const float* IW = (const float*)(p.ws + OFF_IW);
  half_t* BR = (half_t*)(p.ws + OFF_BR);
  float* LS = (float*)(lds + DS_LS);
  unsigned short* LI = (unsigned short*)(lds + DS_LI);
  int* cnt = (int*)(lds + DS_CNT);
  float* thr = (float*)(lds + DS_THR);
  float* wq = (float*)(lds + DS_WQ);
  unsigned* hist = (unsigned*)(lds + DS_HIST) + w * 256;
  float* PWa = LS + (w * 8) * DS_CAP + 256;
  float* PWb = LS + (w * 8 + 1) * DS_CAP + 256;
  half_t* QS = (half_t*)(LI + (w * 8) * DS_CAP + 256);
  for (int rep_sel = 0; rep_sel < REP_SEL; ++rep_sel) {
  __syncthreads();
  if (tid < 32) { cnt[tid] = 0; thr[tid] = -INFINITY; }
  if (tid < 128) wq[tid] = IW[(size_t)t0 * 4 + tid];
  __syncthreads();
  h8 aq[4][4];
#pragma unroll
  for (int h = 0; h < 4; ++h)
#pragma unroll
    for (int ks = 0; ks < 4; ++ks)
      aq[h][ks] = *(const h8*)(P + (size_t)(t0 + (l & 31)) * PP + C_IDXQ + h * 64 + ks * 16 + (l >> 5) * 8);
  const int nt = qb + 1;
  const int nr = (nt + 3) >> 2;
  const int mq = l & 31;
  const f4v wv = *(const f4v*)(wq + mq * 4);
  float th = -INFINITY; asm volatile("" : "+v"(th));
  h8 bk[4];
  {
    const int k0 = (w < nt) ? w : 0;
#pragma unroll
    for (int ks = 0; ks < 4; ++ks)
      bk[ks] = *(const h8*)(BR + (size_t)(k0 * 32 + (l & 31)) * 1536 + 256 + ks * 16 + (l >> 5) * 8);
  }
#pragma unroll 1
  for (int rd = 0; rd < nr; ++rd) {
    const int kt = 4 * rd + w;
    h8 bkn[4];
    {
      const int kn = (kt + 4 < nt) ? (kt + 4) : 0;
#pragma unroll
      for (int ks = 0; ks < 4; ++ks)
        bkn[ks] = *(const h8*)(BR + (size_t)(kn * 32 + (l & 31)) * 1536 + 256 + ks * 16 + (l >> 5) * 8);
    }
    if (kt < nt) {
      const int sbase = kt * 32;
      f16v acc[4];
#pragma unroll
      for (int h = 0; h < 4; ++h) {
#pragma unroll
        for (int r = 0; r < 16; ++r) acc[h][r] = ozero();
#pragma unroll
        for (int ks = 0; ks < 4; ++ks) acc[h] = mfma16(bk[ks], aq[h][ks], acc[h]);
      }
      float scv[16];
#pragma unroll
      for (int r = 0; r < 16; ++r) {
        float sc = wv[0] * relu_f(acc[0][r]) + wv[1] * relu_f(acc[1][r]) + wv[2] * relu_f(acc[2][r]) + wv[3] * relu_f(acc[3][r]);
        sc += 0.0f;
        scv[r] = sc;
      }
      if (kt == qb) {
#pragma unroll
        for (int r = 0; r < 16; ++r) if (sbase + crow(r, l) > t0 + mq) scv[r] = -INFINITY;
      }
      unsigned pm = 0;
#pragma unroll
      for (int r = 0; r < 16; ++r) pm |= (scv[r] > th) ? (1u << r) : 0u;
      const int np = __popc(pm);
      if (__ballot(np > 0) != 0ull) {
        int base = 0;
        if (np > 0) base = atomicAdd(&cnt[mq], np);
#pragma unroll
        for (int r = 0; r < 16; ++r) {
          if ((pm >> r) & 1u) {
            const int slot = base + __popc(pm & ((1u << r) - 1u));
            LS[mq * DS_CAP + slot] = scv[r];
            LI[mq * DS_CAP + slot] = (unsigned short)(sbase + crow(r, l));
          }
        }
      }
    }
    lds_barrier();
    bool any_prune;
    {
      const int cv = (l < 32) ? cnt[l] : 0;
      unsigned pmask = (unsigned)__ballot(cv > DS_PRUNE_AT);
      any_prune = pmask != 0u;
      int j = 0;
      while (pmask != 0u) {
        const int m = __ffs((int)pmask) - 1;
        pmask &= pmask - 1u;
        if ((j & 3) == w) dsa_prune<true>(LS + m * DS_CAP, LI + m * DS_CAP, cnt[m], hist, cnt + m, thr + m, l);
        ++j;
      }
    }
    lds_barrier();
    if (any_prune) th = thr[mq];
#pragma unroll
    for (int ks = 0; ks < 4; ++ks) bk[ks] = bkn[ks];
  }
  }
#pragma unroll 1
  for (int mm = 0; mm < 8; ++mm) {
    const int m = w * 8 + mm;
    const int c = cnt[m];
    if (c > 256) dsa_prune<false>(LS + m * DS_CAP, LI + m * DS_CAP, c, hist, cnt + m, thr + m, l);
  }
  asm volatile("s_waitcnt lgkmcnt(0)" ::: "memory");
  for (int rep_att = 0; rep_att < REP_ATT; ++rep_att) {
  h8 kvr[4][8];
  {
    const int m = w * 8;
    const int c = min(cnt[m], 256);
    const unsigned short* LIm = LI + m * DS_CAP;
#pragma unroll
    for (int kk = 0; kk < 4; ++kk) {
      const int e = l + 64 * kk;
      const int s = (int)LIm[(e < c) ? e : 0];
      const half_t* kr = BR + (size_t)s * 1536;
#pragma unroll
      for (int ch = 0; ch < 8; ++ch) kvr[kk][ch] = *(const h8*)(kr + ch * 8);
    }
  }
  h8 qreg = *(const h8*)(P + (size_t)(t0 + w * 8) * PP + C_DSAQ + l * 8);
  const int dch = l >> 3, ksub = l & 7;
#pragma unroll 1
  for (int u = 0; u < 16; ++u) {
    const int mm = u >> 1, g = u & 1;
    const int m = w * 8 + mm;
    const int t = t0 + m;
    const int c = min(cnt[m], 256);
    const unsigned short* LIm = LI + m * DS_CAP;
    if (g == 0) {
      *(h8*)(QS + l * 8) = qreg;
      const int mq = (mm < 7) ? (m + 1) : m;
      qreg = *(const h8*)(P + (size_t)(t0 + mq) * PP + C_DSAQ + l * 8);
    }
    h8 gt[4];
#pragma unroll
    for (int hh = 0; hh < 4; ++hh) gt[hh] = *(const h8*)(P + (size_t)t * PP + C_DSAG + (g * 4 + hh) * 64 + dch * 8);
    h8 vv[16];
#pragma unroll
    for (int i = 0; i < 16; ++i) {
      const int e = i * 8 + ksub;
      const int s = (int)LIm[(e < c) ? e : 0];
      vv[i] = *(const h8*)(BR + (size_t)s * 1536 + 128 + g * 64 + dch * 8);
    }
    asm volatile("" ::: "memory");
    float lg[4][4];
#pragma unroll
    for (int hh = 0; hh < 4; ++hh) {
#pragma unroll
      for (int kk = 0; kk < 4; ++kk) lg[hh][kk] = ozero();
#pragma unroll
      for (int ch = 0; ch < 8; ++ch) {
        const h8 qq = *(const h8*)(QS + (g * 4 + hh) * 64 + ch * 8);
#pragma unroll
        for (int kk = 0; kk < 4; ++kk) {
          float a = lg[hh][kk];
          a = __builtin_amdgcn_fdot2(__builtin_shufflevector(qq, qq, 0, 1), __builtin_shufflevector(kvr[kk][ch], kvr[kk][ch], 0, 1), a, false);
          a = __builtin_amdgcn_fdot2(__builtin_shufflevector(qq, qq, 2, 3), __builtin_shufflevector(kvr[kk][ch], kvr[kk][ch], 2, 3), a, false);
          a = __builtin_amdgcn_fdot2(__builtin_shufflevector(qq, qq, 4, 5), __builtin_shufflevector(kvr[kk][ch], kvr[kk][ch], 4, 5), a, false);
          a = __builtin_amdgcn_fdot2(__builtin_shufflevector(qq, qq, 6, 7), __builtin_shufflevector(kvr[kk][ch], kvr[kk][ch], 6, 7), a, false);
          lg[hh][kk] = a;
        }
      }
#pragma unroll
      for (int kk = 0; kk < 4; ++kk) lg[hh][kk] = (l + 64 * kk < c) ? lg[hh][kk] : -INFINITY;
    }
    {
      const int un = (u < 15) ? (u + 1) : 15;
      const int mn = w * 8 + (un >> 1), gn = un & 1;
      const int cn = min(cnt[mn], 256);
      const unsigned short* LIn = LI + mn * DS_CAP;
#pragma unroll
      for (int kk = 0; kk < 4; ++kk) {
        const int e = l + 64 * kk;
        const int s = (int)LIn[(e < cn) ? e : 0];
        const half_t* kr = BR + (size_t)s * 1536 + gn * 64;
#pragma unroll
        for (int ch = 0; ch < 8; ++ch) kvr[kk][ch] = *(const h8*)(kr + ch * 8);
      }
    }
#pragma unroll
    for (int hh = 0; hh < 4; ++hh) {
      float mx = fmaxf(fmaxf(lg[hh][0], lg[hh][1]), fmaxf(lg[hh][2], lg[hh][3]));
      mx = wave_max(mx);
      float ev[4]; float sm = 0.f;
#pragma unroll
      for (int kk = 0; kk < 4; ++kk) { ev[kk] = __expf(lg[hh][kk] - mx); sm += ev[kk]; }
      sm = wave_sum(sm);
      const float inv = 1.0f / sm;
#pragma unroll
      for (int kk = 0; kk < 4; ++kk) ((kk < 2) ? PWa : PWb)[(l + 64 * (kk & 1)) * 4 + hh] = ev[kk] * inv;
    }
    asm volatile("" ::: "memory");
    float o[4][8];
#pragma unroll
    for (int hh = 0; hh < 4; ++hh)
#pragma unroll
      for (int q = 0; q < 8; ++q) o[hh][q] = ozero();
    const int nit = (c + 7) >> 3;
#pragma unroll 1
    for (int it0 = 0; it0 < nit; it0 += 16) {
      if (it0 > 0) {
#pragma unroll
        for (int i = 0; i < 16; ++i) {
          const int e = (it0 + i) * 8 + ksub;
          const int s = (int)LIm[(e < c) ? e : 0];
          vv[i] = *(const h8*)(BR + (size_t)s * 1536 + 128 + g * 64 + dch * 8);
        }
      }
#pragma unroll
      for (int i = 0; i < 16; ++i) {
        const int e = (it0 + i) * 8 + ksub;
        const f4v pv = *(const f4v*)(((e < 128) ? PWa : PWb) + (e & 127) * 4);
#pragma unroll
        for (int hh = 0; hh < 4; ++hh)
#pragma unroll
          for (int q = 0; q < 8; ++q) o[hh][q] += pv[hh] * (float)vv[i][q];
      }
    }
#pragma unroll
    for (int hh = 0; hh < 4; ++hh)
#pragma unroll
      for (int q = 0; q < 8; ++q) {
        float v = o[hh][q];
        v += dppf<0xB1>(v); v += dppf<0x4E>(v); v += dppf<0x141>(v);
        o[hh][q] = v;
      }
    if ((l & 7) == 0) {
#pragma unroll
      for (int hh = 0; hh < 4; ++hh) {
        const int col = (g * 4 + hh) * 64 + dch * 8;
        h8 ov;
#pragma unroll
        for (int q = 0; q < 8; ++q) ov[q] = (half_t)(o[hh][q] * (float)gt[hh][q]);
        *(h8*)(BR + (size_t)t * 1536 + 512 + col) = ov;
      }
    }
    asm volatile("" ::: "memory");
  }
  }
}

__device__ void phase_B(const Params& p, int layer, unsigned char* lds) {
  const int G = gridDim.x;
  for (int j = 0; j * G < 512; ++j) {
    const int b = (j & 1) ? (G - 1 - (int)blockIdx.x) : (int)blockIdx.x;
    const int idx = j * G + b;
#ifndef NO_DSA
    if (idx < 512) dsa_item(p, 511 - idx, lds);
#endif
  }
  for (int rep = 0; rep < REP_KV; ++rep)
  for (int it = blockIdx.x; it < 2048; it += G) la_item_kv(p, layer, it, lds);
}

__device__ void phase_E1(const Params& p, int layer, unsigned char* lds, int my_xcc, int my_loc, const unsigned* xcnt) {
  const int tid = otid(), w = tid >> 6, l = tid & 63;
  const half_t* BR = (const half_t*)(p.ws + OFF_BR);
  const half_t* WbrT = (const half_t*)(p.ws + OFF_WBRT) + (size_t)layer * 3 * 1024 * WBP;
  const half_t* P = (const half_t*)(p.ws + OFF_P);
  half_t* Y1 = (half_t*)(p.ws + OFF_H);
  const int wm = w >> 1, wn = w & 1;
  float* E = (float*)(lds + GEMM_EOFF) + w * (32 * EP);
  const int prow = l >> 3, c0 = (l & 7) * 8;
  const int nx = xcc_census(xcnt, my_xcc);
  const int nrounds = (nx > 0) ? (64 + nx - 1) / nx : (512 + (int)gridDim.x - 1) / (int)gridDim.x;
  for (int rnd = 0; rnd < nrounds; ++rnd) {
    int mt, nt;
    if (nx > 0) {
      const int s = my_loc + nx * rnd;
      if (s >= 64) continue;
      mt = my_xcc * 8 + (s & 7); nt = s >> 3;
    } else {
      const int tix = rnd * (int)gridDim.x + (int)blockIdx.x;
      if (tix >= 512) continue;
      mt = tix & 63; nt = tix >> 6;
    }
    h8 tot[4][4];
#pragma unroll
    for (int i = 0; i < 4; ++i)
#pragma unroll
      for (int ps = 0; ps < 4; ++ps)
#pragma unroll
        for (int q = 0; q < 8; ++q) tot[i][ps][q] = (half_t)ozero();
    const int m0w = mt * 256 + wm * 128;
    const int n0 = nt * 128 + wn * 64 + c0;
#pragma unroll 1
    for (int b = 0; b < 3; ++b) {
      f16v acc[4][2];
      zero_acc<2>(acc);
      gemm_kloop<2>(acc, BR + (size_t)mt * 256 * 1536 + b * 512, 1536, WbrT + (size_t)b * 1024 * WBP + (size_t)nt * 128 * WBP, WBP, 512, lds);
#pragma unroll
      for (int i = 0; i < 4; ++i) {
        h8 g[4];
#pragma unroll
        for (int ps = 0; ps < 4; ++ps) g[ps] = *(const h8*)(P + (size_t)(m0w + i * 32 + ps * 8 + prow) * PP + C_MRG + b * 1024 + n0);
        stage_pair(E, acc[i][0], acc[i][1], l);
#pragma unroll
        for (int ps = 0; ps < 4; ++ps) {
          const int rl = ps * 8 + prow;
          float ev[8];
          ld8(E + rl * EP + c0, ev);
#pragma unroll
          for (int q = 0; q < 8; ++q) tot[i][ps][q] = (half_t)((float)tot[i][ps][q] + (float)g[ps][q] * ev[q]);
        }
      }
    }
#pragma unroll
    for (int i = 0; i < 4; ++i)
#pragma unroll
      for (int ps = 0; ps < 4; ++ps) {
        const int row = m0w + i * 32 + ps * 8 + prow;
        *(h8*)(Y1 + (size_t)row * HP + n0) = tot[i][ps];
      }
  }
}

__device__ void phase_E2(const Params& p, int layer, unsigned char* lds, int my_xcc, int my_loc, const unsigned* xcnt) {
  const int tid = otid(), w = tid >> 6, l = tid & 63;
  const half_t* Y1 = (const half_t*)(p.ws + OFF_H);
  const half_t* Wo = (const half_t*)(p.ws + OFF_WOUTT) + (size_t)layer * 1024 * WP;
  float* Y = (float*)(p.ws + OFF_ST);
  const int wm = w >> 1, wn = w & 1;
  const int nx = xcc_census(xcnt, my_xcc);
  const int nrounds = (nx > 0) ? (64 + nx - 1) / nx : (512 + (int)gridDim.x - 1) / (int)gridDim.x;
  for (int rnd = 0; rnd < nrounds; ++rnd) {
    int mt, nt;
    if (nx > 0) {
      const int s = my_loc + nx * rnd;
      if (s >= 64) continue;
      mt = my_xcc * 8 + (s & 7); nt = s >> 3;
    } else {
      const int tix = rnd * (int)gridDim.x + (int)blockIdx.x;
      if (tix >= 512) continue;
      mt = tix & 63; nt = tix >> 6;
    }
    f16v acc[4][2];
    zero_acc<2>(acc);
    gemm_kloop<2>(acc, Y1 + (size_t)mt * 256 * HP, HP, Wo + (size_t)nt * 128 * WP, WP, 1024, lds);
    const int m0w = mt * 256 + wm * 128;
    const int n0w = nt * 128 + wn * 64;
    float* E = (float*)(lds + GEMM_EOFF) + w * (32 * EP);
    const int prow = l >> 3, c0 = (l & 7) * 8;
#pragma unroll
    for (int i = 0; i < 4; ++i) {
      stage_pair(E, acc[i][0], acc[i][1], l);
#pragma unroll
      for (int ps = 0; ps < 4; ++ps) {
        const int rl = ps * 8 + prow;
        const int row = m0w + i * 32 + rl;
        const f4v a = *(const f4v*)(E + rl * EP + c0), b = *(const f4v*)(E + rl * EP + c0 + 4);
        *(f4v*)(Y + (size_t)row * 1024 + n0w + c0) = a;
        *(f4v*)(Y + (size_t)row * 1024 + n0w + c0 + 4) = b;
      }
    }
  }
}

__device__ void phase_E3(const Params& p, int layer) {
  const int w = otid() >> 6, l = otid() & 63;
  const float* Y = (const float*)(p.ws + OFF_ST);
  const float* MOD = (const float*)(p.ws + OFF_MOD);
  half_t* H = (half_t*)(p.ws + OFF_H);
  const float* xin = (layer == 0) ? p.x : p.out;
  const float* gate = MOD + layer * 3072 + 2048;
  const float* post = p.post_norm + layer * 1024;
  const int stride = gridDim.x * 4;
  int row = blockIdx.x * 4 + w;
  f4v yn[4], xn[4];
  if (row < S_LEN) {
#pragma unroll
    for (int i = 0; i < 4; ++i) {
      yn[i] = *(const f4v*)(Y + (size_t)row * 1024 + i * 256 + l * 4);
      xn[i] = *(const f4v*)(xin + (size_t)row * 1024 + i * 256 + l * 4);
    }
  }
  for (; row < S_LEN; row += stride) {
    float yv[16], xv[16];
    float ss = 0.f;
#pragma unroll
    for (int i = 0; i < 4; ++i)
#pragma unroll
      for (int q = 0; q < 4; ++q) { yv[i * 4 + q] = yn[i][q]; xv[i * 4 + q] = xn[i][q]; ss += yn[i][q] * yn[i][q]; }
    const int nrow = (row + stride < S_LEN) ? (row + stride) : row;
#pragma unroll
    for (int i = 0; i < 4; ++i) {
      yn[i] = *(const f4v*)(Y + (size_t)nrow * 1024 + i * 256 + l * 4);
      xn[i] = *(const f4v*)(xin + (size_t)nrow * 1024 + i * 256 + l * 4);
    }
    ss = wave_sum(ss);
    const float rs = rsqrtf(ss * (1.0f / 1024.0f) + 1e-6f);
#pragma unroll
    for (int i = 0; i < 4; ++i) {
      const int c0 = i * 256 + l * 4;
      f4v gt = *(const f4v*)(gate + c0);
      f4v pn = *(const f4v*)(post + c0);
      f4v o;
#pragma unroll
      for (int q = 0; q < 4; ++q) { o[q] = xv[i * 4 + q] + gt[q] * (yv[i * 4 + q] * rs * pn[q]); xv[i * 4 + q] = o[q]; }
      *(f4v*)(p.out + (size_t)row * 1024 + c0) = o;
    }
    if (layer + 1 < DEPTH)
      write_h_row(xv, p.pre_norm + (layer + 1) * 1024, MOD + (layer + 1) * 3072, H + (size_t)row * HP, l);
  }
}

#define XB_TMO      128
#define XB_XCNT(j)  (256  + 64 * (j))
#define XB_XSUB(j)  (1280 + 64 * (j))
#define XB_XGEN(j)  (2304 + 64 * (j))
#define XB_TOP      3328
#define XB_TOPGEN   3392
#define XCD_BAR_WORDS 3456
#define XB_SPIN_CAP (1u << 18)
#define LAS __attribute__((address_space(3)))

__device__ __forceinline__ unsigned xb_ld(unsigned* p)              { return __hip_atomic_load(p, __ATOMIC_RELAXED, __HIP_MEMORY_SCOPE_AGENT); }
__device__ __forceinline__ unsigned xb_add(unsigned* p, unsigned v) { return __hip_atomic_fetch_add(p, v, __ATOMIC_RELAXED, __HIP_MEMORY_SCOPE_AGENT); }
__device__ __forceinline__ unsigned xb_xcc_id() { return (unsigned)__builtin_amdgcn_s_getreg((3 << 11) | 20) & 0xFu; }
#define XB_SPIN(cond, bar) do { unsigned _sp = 0; while (cond) { __builtin_amdgcn_s_sleep(1); \
    if ((++_sp & 255u) == 0u) { if (xb_ld(&(bar)[XB_TMO])) break; if (_sp > XB_SPIN_CAP) { atomicAdd(&(bar)[XB_TMO], 1u); break; } } } } while (0)

struct XcdBarrier {
    unsigned* bar; unsigned x;
    volatile LAS unsigned* st;
};

__device__ __forceinline__ XcdBarrier xcd_barrier_post(unsigned* bar, volatile LAS unsigned* st) {
    XcdBarrier b; b.bar = bar; b.x = xb_xcc_id(); b.st = st;
    if (otid() == 0) (void)xb_add(&bar[XB_XCNT(b.x)], 1u);
    return b;
}
__device__ __forceinline__ void xcd_barrier_complete(unsigned* bar, unsigned x, unsigned& nloc, unsigned& nx) {
    const unsigned G = gridDim.x * gridDim.y * gridDim.z;
    unsigned sum, cnt, mine, sp = 0u;
    for (;;) {
        sum = 0u; cnt = 0u; mine = 0u;
#pragma unroll
        for (unsigned j = 0; j < 16; ++j) { const unsigned c = xb_ld(&bar[XB_XCNT(j)]); sum += c; cnt += (c > 0u) ? 1u : 0u; mine = (j == x) ? c : mine; }
        if (sum == G) break;
        __builtin_amdgcn_s_sleep(1);
        if ((++sp & 255u) == 0u) { if (xb_ld(&bar[XB_TMO])) break; if (sp > XB_SPIN_CAP) { atomicAdd(&bar[XB_TMO], 1u); break; } }
    }
    nloc = mine > 0u ? mine : 1u; nx = cnt > 0u ? cnt : 1u;
}

__device__ __forceinline__ void xcd_barrier(const XcdBarrier& b) {
    asm volatile("s_waitcnt vmcnt(0)" ::: "memory");
    __syncthreads();
    if (otid() == 0) {
        unsigned* bar = b.bar;
        __builtin_amdgcn_s_waitcnt(0);
        unsigned nloc = b.st[0], nx = b.st[1];
        if (nloc == 0u) { xcd_barrier_complete(bar, b.x, nloc, nx); b.st[0] = nloc; b.st[1] = nx; }
        const unsigned old = xb_add(&bar[XB_XSUB(b.x)], 1u);
        const unsigned gen = old / nloc;
        if (old + 1u == (gen + 1u) * nloc) {
            __builtin_amdgcn_fence(__ATOMIC_RELEASE, "agent");
            asm volatile("s_waitcnt vmcnt(0)" ::: "memory");
            const unsigned og = xb_add(&bar[XB_TOP], 1u);
            const unsigned tg = og / nx;
            if (og + 1u == (tg + 1u) * nx) xb_add(&bar[XB_TOPGEN], 1u);
            else XB_SPIN(xb_ld(&bar[XB_TOPGEN]) == tg, bar);
            __builtin_amdgcn_fence(__ATOMIC_ACQUIRE, "agent");
            xb_add(&bar[XB_XGEN(b.x)], 1u);
            asm volatile("s_waitcnt vmcnt(0)" ::: "memory");
        } else {
            XB_SPIN(xb_ld(&bar[XB_XGEN(b.x)]) == gen, bar);
            __builtin_amdgcn_fence(__ATOMIC_ACQUIRE, "agent");
            asm volatile("s_waitcnt vmcnt(0)" ::: "memory");
        }
    }
    __syncthreads();
}


};

#ifndef REP_D
#define REP_D 1
#endif
#ifndef REP_E
#define REP_E 1
#endif
#ifndef REP_A
#define REP_A 1
#endif
#ifndef REP_B
#define REP_B 1
#endif
#ifdef ONLY_PHASE
#define PH_EN(x) (ONLY_PHASE == (x))
#else
#define PH_EN(x) true
#endif
__global__ void __launch_bounds__(NTHREADS) fwd_megakernel(Params p) {
  extern __shared__ __attribute__((aligned(16))) unsigned char lds[];
  cg::grid_group grid = cg::this_grid();
  K k; k.wbase = __builtin_amdgcn_readfirstlane((int)__builtin_amdgcn_workitem_id_x()) & ~63;
  unsigned* bar = (unsigned*)(p.ws + WS_END);
  unsigned* xcnt = bar + 16;
  unsigned* xbar = (unsigned*)(p.ws + WS_END + 1024);
  if (blockIdx.x == 0) {
    if (k.otid() < 17) __hip_atomic_store(bar + (k.otid() == 16 ? 0 : 16 + k.otid()), 0u, __ATOMIC_RELAXED, __HIP_MEMORY_SCOPE_AGENT);
    for (int i = k.otid(); i < XCD_BAR_WORDS; i += NTHREADS) __hip_atomic_store(xbar + i, 0u, __ATOMIC_RELAXED, __HIP_MEMORY_SCOPE_AGENT);
  }
  volatile LAS unsigned* xst = (volatile LAS unsigned*)(lds + LDS_BYTES - 16);
  if (k.otid() == 0) { xst[0] = 0u; xst[1] = 0u; }
  __syncthreads();
  K::XcdBarrier xb; xb.bar = xbar; xb.x = 0; xb.st = xst;
  int my_xcc = 0, my_loc = 0;
  for (int ph = p.ph_lo; ph < p.ph_hi; ++ph) {
    if (ph == 0) { if (PH_EN(0)) for (int rep = 0; rep < REP_P; ++rep) { k.phase_prologue(p, lds); __syncthreads(); } }
    else if (ph == 1) {
      xb = k.xcd_barrier_post(xbar, xst);
      int* sh = (int*)lds;
      if (k.otid() == 0) {
        const int xc = (int)(__builtin_amdgcn_s_getreg((3 << 11) | 20) & 0xFu);
        sh[0] = xc;
        sh[1] = (int)__hip_atomic_fetch_add(xcnt + xc, 1u, __ATOMIC_RELAXED, __HIP_MEMORY_SCOPE_AGENT);
      }
      __syncthreads();
      my_xcc = __builtin_amdgcn_readfirstlane(sh[0]);
      my_loc = __builtin_amdgcn_readfirstlane(sh[1]);
      __syncthreads();
      if (PH_EN(1)) k.phase_h0(p);
    }
    else {
      const int layer = (ph - 2) / 7, sub = (ph - 2) % 7;
      if (sub == 0) { if (PH_EN(2)) for (int rep = 0; rep < REP_A; ++rep) { k.phase_A(p, layer, lds, my_xcc, my_loc, xcnt); __syncthreads(); } }
      else if (sub == 1) { if (PH_EN(3)) for (int rep = 0; rep < REP_B; ++rep) { k.phase_B(p, layer, lds); __syncthreads(); } }
      else if (sub == 2) { if (PH_EN(4)) k.phase_scan(p); }
      else if (sub == 3) { if (PH_EN(5)) for (int rep = 0; rep < REP_D; ++rep) { for (int it = blockIdx.x; it < 2048; it += gridDim.x) k.la_item_out(p, layer, it, lds); __syncthreads(); } }
      else if (sub == 4) { if (PH_EN(6)) for (int rep = 0; rep < REP_E; ++rep) { k.phase_E1(p, layer, lds, my_xcc, my_loc, xcnt); __syncthreads(); } }
      else if (sub == 5) { if (PH_EN(7)) for (int rep = 0; rep < REP_E; ++rep) { k.phase_E2(p, layer, lds, my_xcc, my_loc, xcnt); __syncthreads(); } }
      else { if (PH_EN(8)) k.phase_E3(p, layer); }
    }
    if (ph + 1 < p.ph_hi) {
      if (ph == p.ph_lo) grid.sync();
      else k.xcd_barrier(xb);
    }
  }
}

extern "C" void kernel_launch(void* const* d_in, const int* in_sizes, int n_in, void* d_out, int out_size,
                              void* d_ws, size_t ws_size, hipStream_t stream) {
  static int grid_blocks = 0;
  if (!grid_blocks) {
    int dev = 0, cus = 0, per_cu = 0;
    hipGetDevice(&dev);
    hipDeviceGetAttribute(&cus, hipDeviceAttributeMultiprocessorCount, dev);
    hipFuncSetAttribute((const void*)fwd_megakernel, hipFuncAttributeMaxDynamicSharedMemorySize, LDS_BYTES);
    hipOccupancyMaxActiveBlocksPerMultiprocessor(&per_cu, (const void*)fwd_megakernel, NTHREADS, LDS_BYTES);
    if (per_cu < 1) per_cu = 1;
    if (per_cu > 1) per_cu = 1;
    grid_blocks = cus * per_cu;
    if (ws_size < WS_END) fprintf(stderr, "workspace too small: %zu < %llu\n", ws_size, (unsigned long long)WS_END);
  }
  Params p{};
  p.x = (const float*)d_in[0]; p.c = (const float*)d_in[1]; p.pos = (const int*)d_in[2];
  p.ada_w = (const float*)d_in[3]; p.ada_b = (const float*)d_in[4];
  p.pre_norm = (const float*)d_in[5]; p.post_norm = (const float*)d_in[6];
  p.w_in = (const float*)d_in[7]; p.gla_w_lr = (const float*)d_in[8]; p.gla_b_lr = (const float*)d_in[9];
  p.w_br_ret = (const float*)d_in[10]; p.w_br_dsa = (const float*)d_in[11]; p.w_br_gla = (const float*)d_in[12];
  p.w_out = (const float*)d_in[13];
  p.out = (float*)d_out; p.ws = (unsigned char*)d_ws;
  p.ph_lo = 0; p.ph_hi = 2 + 7 * DEPTH;
  void* args[] = {&p};
  hipError_t e = hipLaunchCooperativeKernel((const void*)fwd_megakernel, dim3(grid_blocks), dim3(NTHREADS), args, LDS_BYTES, stream);
  if (e != hipSuccess) fprintf(stderr, "cooperative launch failed: %s (grid %d)\n", hipGetErrorString(e), grid_blocks);
}
```

```cpp
#include <hip/hip_runtime.h>
#include <hip/hip_cooperative_groups.h>
#include <stdint.h>
#include <cstdio>
namespace cg = cooperative_groups;
#ifndef REP_P
#define REP_P 1
#endif
#ifndef REP_KV
#define REP_KV 1
#endif
#ifndef REP_SEL
#define REP_SEL 1
#endif
#ifndef REP_ATT
#define REP_ATT 1
#endif

typedef _Float16 half_t;
typedef _Float16 h8 __attribute__((ext_vector_type(8)));
typedef _Float16 h4 __attribute__((ext_vector_type(4)));
typedef _Float16 h2 __attribute__((ext_vector_type(2)));
typedef float f16v __attribute__((ext_vector_type(16)));
typedef float f4v __attribute__((ext_vector_type(4)));

#define S_LEN 16384
#define DM 1024
#define NIN 7764
#define NPAD 7936
#define PP 7808
#define DEPTH 4
#define NTHREADS 256
#define HP 1088
#define WP 1088
#define WBP 576
#define LDS_BYTES 152704

#define C_RETQ 0
#define C_RETK 256
#define C_RETV 512
#define C_RETG 1024
#define C_DSAQ 1536
#define C_DSAK 2048
#define C_DSAV 2176
#define C_DSAG 2304
#define C_IDXQ 2816
#define C_IDXK 3072
#define C_GLAQ 3136
#define C_GLAK 3392
#define C_GLAV 3648
#define C_GLAG 4160
#define C_GLAA 4672
#define C_MRG 4688
#define C_END 7760
#define C_IDXW 7760

#define OFF_WINT 0ull
#define OFF_WBRT (OFF_WINT + 4ull * NPAD * WP * 2)
#define OFF_WOUTT (OFF_WBRT + 4ull * 3 * 1024 * WBP * 2)
#define OFF_MOD (OFF_WOUTT + 4ull * 1024 * WP * 2)
#define OFF_RT (OFF_MOD + 4ull * 3072 * 4)
#define OFF_DT (OFF_RT + 16384ull * 64 * 4)
#define OFF_H (OFF_DT + 16384ull * 16 * 4)
#define OFF_P (OFF_H + 16384ull * HP * 2)
#define OFF_GA (OFF_P + 16384ull * PP * 2)
#define OFF_IW (OFF_GA + 16384ull * 16 * 4)
#define OFF_ST (OFF_IW + 16384ull * 4 * 4)
#define OFF_DEC (OFF_ST + 256ull * 65536 * 4)
#define OFF_BR (OFF_DEC + 256ull * 8 * 64 * 4)
#define WS_END (OFF_BR + 16384ull * 1536 * 2)
static_assert(WS_END + 16384 <= 508821504ull, "workspace too large");

struct Params {
  const float* x; const float* c; const int* pos; const float* ada_w; const float* ada_b;
  const float* pre_norm; const float* post_norm; const float* w_in; const float* gla_w_lr;
  const float* gla_b_lr; const float* w_br_ret; const float* w_br_dsa; const float* w_br_gla;
  const float* w_out; float* out; unsigned char* ws;
  int ph_lo; int ph_hi;
};

struct K {
int wbase;
__device__ __forceinline__ int otid() const {
  int lane;
  asm volatile("v_mbcnt_lo_u32_b32 %0, -1, 0\n\tv_mbcnt_hi_u32_b32 %0, -1, %0" : "=v"(lane));
  return wbase | lane;
}
__device__ __forceinline__ static float ozero() { float z = 0.f; asm volatile("" : "+v"(z)); return z; }
template <int CTRL>
__device__ __forceinline__ float dppf(float v) {
  return __int_as_float(__builtin_amdgcn_update_dpp(0, __float_as_int(v), CTRL, 0xF, 0xF, true));
}
template <int CTRL>
__device__ __forceinline__ unsigned dppu(unsigned v) {
  return (unsigned)__builtin_amdgcn_update_dpp(0, (int)v, CTRL, 0xF, 0xF, true);
}
__device__ __forceinline__ int olane() { return otid() & 63; }
__device__ __forceinline__ float xor16f(float v) { return __int_as_float(__builtin_amdgcn_ds_bpermute((olane() ^ 16) << 2, __float_as_int(v))); }
__device__ __forceinline__ float xor32f(float v) { return __int_as_float(__builtin_amdgcn_ds_bpermute((olane() ^ 32) << 2, __float_as_int(v))); }
__device__ __forceinline__ unsigned xor16u(unsigned v) { return (unsigned)__builtin_amdgcn_ds_bpermute((olane() ^ 16) << 2, (int)v); }
__device__ __forceinline__ unsigned xor32u(unsigned v) { return (unsigned)__builtin_amdgcn_ds_bpermute((olane() ^ 32) << 2, (int)v); }
__device__ __forceinline__ float rl_f(float v, int lane) { return __int_as_float(__builtin_amdgcn_readlane(__float_as_int(v), lane)); }
__device__ __forceinline__ float wave_sum(float v) {
  v += dppf<0xB1>(v); v += dppf<0x4E>(v); v += dppf<0x141>(v); v += dppf<0x140>(v);
  return (rl_f(v, 0) + rl_f(v, 16)) + (rl_f(v, 32) + rl_f(v, 48));
}
__device__ __forceinline__ float wave_max(float v) {
  v = fmaxf(v, dppf<0xB1>(v)); v = fmaxf(v, dppf<0x4E>(v)); v = fmaxf(v, dppf<0x141>(v)); v = fmaxf(v, dppf<0x140>(v));
  return fmaxf(fmaxf(rl_f(v, 0), rl_f(v, 16)), fmaxf(rl_f(v, 32), rl_f(v, 48)));
}
__device__ __forceinline__ unsigned wave_or(unsigned v) {
  v |= dppu<0xB1>(v); v |= dppu<0x4E>(v); v |= dppu<0x141>(v); v |= dppu<0x140>(v);
  return (unsigned)(__builtin_amdgcn_readlane((int)v, 0) | __builtin_amdgcn_readlane((int)v, 16) | __builtin_amdgcn_readlane((int)v, 32) | __builtin_amdgcn_readlane((int)v, 48));
}
__device__ __forceinline__ unsigned wave_incl_scan(unsigned v) {
  v += (unsigned)__builtin_amdgcn_update_dpp(0, (int)v, 0x111, 0xF, 0xF, false);
  v += (unsigned)__builtin_amdgcn_update_dpp(0, (int)v, 0x112, 0xF, 0xF, false);
  v += (unsigned)__builtin_amdgcn_update_dpp(0, (int)v, 0x114, 0xF, 0xF, false);
  v += (unsigned)__builtin_amdgcn_update_dpp(0, (int)v, 0x118, 0xF, 0xF, false);
  v += (unsigned)__builtin_amdgcn_update_dpp(0, (int)v, 0x142, 0xA, 0xF, false);
  v += (unsigned)__builtin_amdgcn_update_dpp(0, (int)v, 0x143, 0xC, 0xF, false);
  return v;
}
__device__ __forceinline__ f16v mfma16(h8 a, h8 b, f16v c) {
  return __builtin_amdgcn_mfma_f32_32x32x16_f16(a, b, c, 0, 0, 0);
}
__device__ __forceinline__ float relu_f(float x) { return __int_as_float(max(__float_as_int(x), 0)); }
__device__ __forceinline__ int crow(int r, int l) { return (r & 3) + 8 * (r >> 2) + 4 * (l >> 5); }

__device__ __forceinline__ int win_col(int nv) {
  if (nv < 3136) return nv;
  if (nv < 7760) return nv + 4;
  if (nv < 7764) return nv - 7760 + 3136;
  return -1;
}
__device__ void transpose_tile(const float* __restrict__ src, int ldn, half_t* __restrict__ dst, int K,
                               int k0, int n0, int mapmode, unsigned char* lds) {
  float* T = (float*)lds;
  const int tid = otid();
  const int nn = tid & 63;
  int col = n0 + nn;
  if (mapmode) col = win_col(col);
#pragma unroll
  for (int i = 0; i < 16; ++i) {
    int kk = (tid >> 6) + 4 * i;
    float v = 0.f;
    if (col >= 0) v = src[(size_t)(k0 + kk) * ldn + col];
    T[kk * 65 + nn] = v;
  }
  __syncthreads();
#pragma unroll
  for (int i = 0; i < 2; ++i) {
    int n2 = (tid >> 3) + 32 * i;
    int kc = tid & 7;
    h8 o;
#pragma unroll
    for (int q = 0; q < 8; ++q) o[q] = (half_t)T[(kc * 8 + q) * 65 + n2];
    *(h8*)(dst + (size_t)(n0 + n2) * K + k0 + kc * 8) = o;
  }
  __syncthreads();
}

__device__ void phase_prologue(const Params& p, unsigned char* lds) {
  const int tid = otid();
  half_t* WinT = (half_t*)(p.ws + OFF_WINT);
  half_t* WbrT = (half_t*)(p.ws + OFF_WBRT);
  half_t* WoutT = (half_t*)(p.ws + OFF_WOUTT);
  float* MOD = (float*)(p.ws + OFF_MOD);
  float* RT = (float*)(p.ws + OFF_RT);
  float* DT = (float*)(p.ws + OFF_DT);
  const int T_WIN = 4 * 124 * 16;
  const int T_WBR = 12 * 16 * 8;
  const int T_WOUT = 4 * 16 * 16;
  const int T_MOD = 192;
  const int T_ROPE = 16384 * 40 / 256;
  const int total = T_WIN + T_WBR + T_WOUT + T_MOD + T_ROPE;
  {
    float* T = (float*)lds;
    const int nn = tid & 63;
    float cur[16], nxt[16];
    int task = blockIdx.x;
    if (task < T_WIN) {
      const int l = task / (124 * 16), r = task % (124 * 16), nt = r / 16, kt = r % 16;
      const int col = win_col(nt * 64 + nn);
      const float* src = p.w_in + (size_t)l * 1024 * NIN;
#pragma unroll
      for (int i = 0; i < 16; ++i) { const int kk = (tid >> 6) + 4 * i; cur[i] = (col >= 0) ? src[(size_t)(kt * 64 + kk) * NIN + col] : 0.f; }
    }
    for (; task < T_WIN; task += gridDim.x) {
      const int tn = (task + (int)gridDim.x < T_WIN) ? task + (int)gridDim.x : task;
      {
        const int l = tn / (124 * 16), r = tn % (124 * 16), nt = r / 16, kt = r % 16;
        const int col = win_col(nt * 64 + nn);
        const float* src = p.w_in + (size_t)l * 1024 * NIN;
#pragma unroll
        for (int i = 0; i < 16; ++i) { const int kk = (tid >> 6) + 4 * i; nxt[i] = (col >= 0) ? src[(size_t)(kt * 64 + kk) * NIN + col] : 0.f; }
      }
      const int l = task / (124 * 16), r = task % (124 * 16), nt = r / 16, kt = r % 16;
      half_t* dst = WinT + (size_t)l * NPAD * WP;
#pragma unroll
      for (int i = 0; i < 16; ++i) T[((tid >> 6) + 4 * i) * 65 + nn] = cur[i];
      __syncthreads();
#pragma unroll
      for (int i = 0; i < 2; ++i) {
        const int n2 = (tid >> 3) + 32 * i, kc = tid & 7;
        h8 o;
#pragma unroll
        for (int q = 0; q < 8; ++q) o[q] = (half_t)T[(kc * 8 + q) * 65 + n2];
        *(h8*)(dst + (size_t)(nt * 64 + n2) * WP + kt * 64 + kc * 8) = o;
      }
      __syncthreads();
#pragma unroll
      for (int i = 0; i < 16; ++i) cur[i] = nxt[i];
    }
  }
  for (int task = blockIdx.x; task < total; task += gridDim.x) {
    int t = task;
    if (t < T_WIN) continue;
    if (t < T_WIN) {
      int l = t / (124 * 16); int r = t % (124 * 16); int nt = r / 16, kt = r % 16;
      transpose_tile(p.w_in + (size_t)l * 1024 * NIN, NIN, WinT + (size_t)l * NPAD * WP, WP, kt * 64, nt * 64, 1, lds);
      continue;
    }
    t -= T_WIN;
    if (t < T_WBR) {
      int lb = t / 128; int r = t % 128; int nt = r / 8, kt = r % 8;
      int l = lb / 3, b = lb % 3;
      const float* src = (b == 0 ? p.w_br_ret : (b == 1 ? p.w_br_dsa : p.w_br_gla)) + (size_t)l * 512 * 1024;
      transpose_tile(src, 1024, WbrT + (size_t)lb * 1024 * WBP, WBP, kt * 64, nt * 64, 0, lds);
      continue;
    }
    t -= T_WBR;
    if (t < T_WOUT) {
      int l = t / 256; int r = t % 256; int nt = r / 16, kt = r % 16;
      transpose_tile(p.w_out + (size_t)l * 1024 * 1024, 1024, WoutT + (size_t)l * 1024 * WP, WP, kt * 64, nt * 64, 0, lds);
      continue;
    }
    t -= T_WOUT;
    if (t < T_MOD) {
      int l = t / 48, jb = t % 48;
      int j = jb * 64 + (tid & 63);
      int ig = tid >> 6;
      float acc = 0.f;
      const float* aw = p.ada_w + (size_t)l * 1024 * 3072;
      for (int i = ig * 256; i < ig * 256 + 256; ++i) {
        float cv = p.c[i];
        float sc = cv / (1.f + expf(-cv));
        acc += sc * aw[(size_t)i * 3072 + j];
      }
      float* red = (float*)lds;
      red[tid] = acc;
      __syncthreads();
      if (tid < 64) {
        float s = red[tid] + red[tid + 64] + red[tid + 128] + red[tid + 192];
        MOD[l * 3072 + j] = s + p.ada_b[l * 3072 + j];
      }
      __syncthreads();
      continue;
    }
    t -= T_MOD;
    {
      int e = t * 256 + tid;
      int tok = e / 40, f = e % 40;
      float pf = (float)p.pos[tok];
      if (f < 32) {
        float fr = powf(10000.0f, -(float)f * 2.0f / 64.0f);
        float ang = pf * fr;
        RT[tok * 64 + f * 2] = cosf(ang);
        RT[tok * 64 + f * 2 + 1] = sinf(ang);
      } else {
        int g = f - 32;
        float fr = powf(500000.0f, -(float)g * 2.0f / 16.0f);
        float ang = pf * fr;
        DT[tok * 16 + g * 2] = cosf(ang);
        DT[tok * 16 + g * 2 + 1] = sinf(ang);
      }
    }
  }
}

__device__ __forceinline__ void write_h_row(const float (&xv)[16], const float* __restrict__ pre,
                                            const float* __restrict__ mod, half_t* __restrict__ hrow, int l) {
  float ss = 0.f;
#pragma unroll
  for (int i = 0; i < 16; ++i) ss += xv[i] * xv[i];
  ss = wave_sum(ss);
  float rs = rsqrtf(ss * (1.0f / 1024.0f) + 1e-6f);
#pragma unroll
  for (int i = 0; i < 4; ++i) {
    int c0 = i * 256 + l * 4;
    f4v pg = *(const f4v*)(pre + c0);
    f4v sh = *(const f4v*)(mod + c0);
    f4v sc = *(const f4v*)(mod + 1024 + c0);
    h4 o;
#pragma unroll
    for (int q = 0; q < 4; ++q) o[q] = (half_t)(xv[i * 4 + q] * rs * pg[q] * (1.f + sc[q]) + sh[q]);
    *(h4*)(hrow + c0) = o;
  }
}

__device__ void phase_h0(const Params& p) {
  const int w = otid() >> 6, l = otid() & 63;
  half_t* H = (half_t*)(p.ws + OFF_H);
  const float* MOD = (const float*)(p.ws + OFF_MOD);
  const int stride = gridDim.x * 4;
  int row = blockIdx.x * 4 + w;
  f4v xn[4];
  if (row < S_LEN) {
#pragma unroll
    for (int i = 0; i < 4; ++i) xn[i] = *(const f4v*)(p.x + (size_t)row * 1024 + i * 256 + l * 4);
  }
  for (; row < S_LEN; row += stride) {
    float xv[16];
#pragma unroll
    for (int i = 0; i < 4; ++i)
#pragma unroll
      for (int q = 0; q < 4; ++q) xv[i * 4 + q] = xn[i][q];
    const int nrow = (row + stride < S_LEN) ? (row + stride) : row;
#pragma unroll
    for (int i = 0; i < 4; ++i) xn[i] = *(const f4v*)(p.x + (size_t)nrow * 1024 + i * 256 + l * 4);
    write_h_row(xv, p.pre_norm, MOD, H + (size_t)row * HP, l);
  }
}

__device__ __forceinline__ void lds_barrier() {
  asm volatile("s_waitcnt lgkmcnt(0)" ::: "memory");
  __builtin_amdgcn_s_barrier();
  asm volatile("" ::: "memory");
}
#define GEMM_BUF 55296
#define GEMM_EOFF 110592
template <int NT>
__device__ __forceinline__ void gemm_step(f16v (&acc)[4][NT], h8 (&ra)[8], h8 (&rb)[2 * NT],
                                          const unsigned char* As, const unsigned char* Bs, unsigned char* Aw, unsigned char* Bw,
                                          const half_t* __restrict__ A, int lda, const half_t* __restrict__ B, int ldb, int kload,
                                          int wm, int wn, int l, int r0, int kc) {
  h8 af[2][4], bf[2][NT];
#pragma unroll
  for (int i = 0; i < 4; ++i) af[0][i] = *(const h8*)(As + (wm * 128 + i * 32 + (l & 31)) * 144 + (l >> 5) * 16);
#pragma unroll
  for (int j = 0; j < NT; ++j) bf[0][j] = *(const h8*)(Bs + (wn * 32 * NT + j * 32 + (l & 31)) * 144 + (l >> 5) * 16);
#pragma unroll
  for (int ks = 0; ks < 4; ++ks) {
    if (ks < 3) {
#pragma unroll
      for (int i = 0; i < 4; ++i) af[(ks + 1) & 1][i] = *(const h8*)(As + (wm * 128 + i * 32 + (l & 31)) * 144 + (ks + 1) * 32 + (l >> 5) * 16);
#pragma unroll
      for (int j = 0; j < NT; ++j) bf[(ks + 1) & 1][j] = *(const h8*)(Bs + (wn * 32 * NT + j * 32 + (l & 31)) * 144 + (ks + 1) * 32 + (l >> 5) * 16);
    }
    __builtin_amdgcn_sched_barrier(0);
#pragma unroll
    for (int i = 0; i < 4; ++i)
#pragma unroll
      for (int j = 0; j < NT; ++j) acc[i][j] = mfma16(af[ks & 1][i], bf[ks & 1][j], acc[i][j]);
#pragma unroll
    for (int i = 2 * ks; i < 2 * ks + 2; ++i) {
      *(h8*)(Aw + (r0 + 32 * i) * 144 + kc * 16) = ra[i];
      ra[i] = *(const h8*)(A + (size_t)(r0 + 32 * i) * lda + kload + kc * 8);
    }
    if (NT == 2) {
      *(h8*)(Bw + (r0 + 32 * ks) * 144 + kc * 16) = rb[ks];
      rb[ks] = *(const h8*)(B + (size_t)(r0 + 32 * ks) * ldb + kload + kc * 8);
    } else {
#pragma unroll
      for (int i = 2 * ks; i < 2 * ks + 2; ++i) {
        *(h8*)(Bw + (r0 + 32 * i) * 144 + kc * 16) = rb[i];
        rb[i] = *(const h8*)(B + (size_t)(r0 + 32 * i) * ldb + kload + kc * 8);
      }
    }
    __builtin_amdgcn_sched_barrier(0);
  }
}
template <int NT>
__device__ __forceinline__ void gemm_issue(h8 (&ra0)[8], h8 (&rb0)[2 * NT], h8 (&ra1)[8], h8 (&rb1)[2 * NT],
                                           const half_t* __restrict__ A, int lda, const half_t* __restrict__ B, int ldb) {
  const int tid = otid();
  const int kc = tid & 7, r0 = tid >> 3;
#pragma unroll
  for (int i = 0; i < 8; ++i) ra0[i] = *(const h8*)(A + (size_t)(r0 + 32 * i) * lda + kc * 8);
#pragma unroll
  for (int i = 0; i < 2 * NT; ++i) rb0[i] = *(const h8*)(B + (size_t)(r0 + 32 * i) * ldb + kc * 8);
#pragma unroll
  for (int i = 0; i < 8; ++i) ra1[i] = *(const h8*)(A + (size_t)(r0 + 32 * i) * lda + 64 + kc * 8);
#pragma unroll
  for (int i = 0; i < 2 * NT; ++i) rb1[i] = *(const h8*)(B + (size_t)(r0 + 32 * i) * ldb + 64 + kc * 8);
}
template <int NT>
__device__ __forceinline__ void gemm_run(f16v (&acc)[4][NT], h8 (&ra0)[8], h8 (&rb0)[2 * NT], h8 (&ra1)[8], h8 (&rb1)[2 * NT],
                                         const half_t* __restrict__ A, int lda, const half_t* __restrict__ B, int ldb, int K, unsigned char* lds) {
  const int tid = otid(), w = tid >> 6, l = tid & 63;
  constexpr int STAGE = 256 * 144 + 64 * NT * 144;
  unsigned char* A0 = lds;
  unsigned char* B0 = lds + 256 * 144;
  unsigned char* A1 = lds + STAGE;
  unsigned char* B1 = lds + STAGE + 256 * 144;
  const int wm = w >> 1, wn = w & 1;
  const int kc = tid & 7;
  const int r0 = tid >> 3;
  lds_barrier();
#pragma unroll
  for (int i = 0; i < 8; ++i) { *(h8*)(A0 + (r0 + 32 * i) * 144 + kc * 16) = ra0[i]; ra0[i] = *(const h8*)(A + (size_t)(r0 + 32 * i) * lda + 128 + kc * 8); }
#pragma unroll
  for (int i = 0; i < 2 * NT; ++i) { *(h8*)(B0 + (r0 + 32 * i) * 144 + kc * 16) = rb0[i]; rb0[i] = *(const h8*)(B + (size_t)(r0 + 32 * i) * ldb + 128 + kc * 8); }
  lds_barrier();
  const int nk = K / 64;
#pragma unroll 1
  for (int kt = 0; kt < nk; kt += 2) {
    gemm_step<NT>(acc, ra1, rb1, A0, B0, A1, B1, A, lda, B, ldb, (kt + 3 < nk) ? (kt + 3) * 64 : 0, wm, wn, l, r0, kc);
    lds_barrier();
    gemm_step<NT>(acc, ra0, rb0, A1, B1, A0, B0, A, lda, B, ldb, (kt + 4 < nk) ? (kt + 4) * 64 : 0, wm, wn, l, r0, kc);
    lds_barrier();
  }
}
template <int NT>
__device__ __forceinline__ void gemm_kloop(f16v (&acc)[4][NT], const half_t* __restrict__ A, int lda,
                                           const half_t* __restrict__ B, int ldb, int K, unsigned char* lds) {
  h8 ra0[8], rb0[2 * NT], ra1[8], rb1[2 * NT];
  gemm_issue<NT>(ra0, rb0, ra1, rb1, A, lda, B, ldb);
  gemm_run<NT>(acc, ra0, rb0, ra1, rb1, A, lda, B, ldb, K, lds);
}

template <int NT>
__device__ __forceinline__ void gemm_issue1(h8 (&ra)[8], h8 (&rb)[2 * NT], const half_t* __restrict__ A, int lda, const half_t* __restrict__ B, int ldb) {
  const int tid = otid();
  const int kc = tid & 7, r0 = tid >> 3;
#pragma unroll
  for (int i = 0; i < 8; ++i) ra[i] = *(const h8*)(A + (size_t)(r0 + 32 * i) * lda + kc * 8);
#pragma unroll
  for (int i = 0; i < 2 * NT; ++i) rb[i] = *(const h8*)(B + (size_t)(r0 + 32 * i) * ldb + kc * 8);
}
template <int NT>
__device__ __forceinline__ void gemm_run1(f16v (&acc)[4][NT], h8 (&ra)[8], h8 (&rb)[2 * NT],
                                          const half_t* __restrict__ A, int lda, const half_t* __restrict__ B, int ldb, int K, unsigned char* lds) {
  const int tid = otid(), w = tid >> 6, l = tid & 63;
  constexpr int STAGE = 256 * 144 + 64 * NT * 144;
  const int wm = w >> 1, wn = w & 1;
  const int kc = tid & 7;
  const int r0 = tid >> 3;
  lds_barrier();
#pragma unroll
  for (int i = 0; i < 8; ++i) { *(h8*)(lds + (r0 + 32 * i) * 144 + kc * 16) = ra[i]; ra[i] = *(const h8*)(A + (size_t)(r0 + 32 * i) * lda + 64 + kc * 8); }
#pragma unroll
  for (int i = 0; i < 2 * NT; ++i) { *(h8*)(lds + 256 * 144 + (r0 + 32 * i) * 144 + kc * 16) = rb[i]; rb[i] = *(const h8*)(B + (size_t)(r0 + 32 * i) * ldb + 64 + kc * 8); }
  lds_barrier();
  const int nk = K / 64;
#pragma unroll 1
  for (int kt = 0; kt < nk; ++kt) {
    unsigned char* cur = lds + (kt & 1) * STAGE;
    unsigned char* nxt = lds + ((kt + 1) & 1) * STAGE;
    gemm_step<NT>(acc, ra, rb, cur, cur + 256 * 144, nxt, nxt + 256 * 144, A, lda, B, ldb, (kt + 2 < nk) ? (kt + 2) * 64 : 0, wm, wn, l, r0, kc);
    lds_barrier();
  }
}

template <int NT>
__device__ __forceinline__ void zero_acc(f16v (&acc)[4][NT]) {
  float z = 0.f;
  asm volatile("" : "+v"(z));
#pragma unroll
  for (int i = 0; i < 4; ++i)
#pragma unroll
    for (int j = 0; j < NT; ++j)
#pragma unroll
      for (int r = 0; r < 16; ++r) acc[i][j][r] = z;
}

#define EP 68
__device__ __forceinline__ void stage_pair(float* E, const f16v& a0, const f16v& a1, int l) {
#pragma unroll
  for (int r = 0; r < 16; ++r) {
    const int rr = crow(r, l);
    E[rr * EP + (l & 31)] = a0[r];
    E[rr * EP + 32 + (l & 31)] = a1[r];
  }
}
__device__ __forceinline__ void ld8(const float* p, float (&v)[8]) {
  const f4v a = *(const f4v*)p, b = *(const f4v*)(p + 4);
  v[0] = a[0]; v[1] = a[1]; v[2] = a[2]; v[3] = a[3]; v[4] = b[0]; v[5] = b[1]; v[6] = b[2]; v[7] = b[3];
}
__device__ __forceinline__ int xcc_census(const unsigned* xcnt, int my_xcc) {
  unsigned sum = 0; bool ok = my_xcc < 8; int mine = 0;
#pragma unroll
  for (int j = 0; j < 16; ++j) {
    const unsigned c = __hip_atomic_load(xcnt + j, __ATOMIC_RELAXED, __HIP_MEMORY_SCOPE_AGENT);
    sum += c;
    if (j < 8 && c == 0u) ok = false;
    if (j >= 8 && c != 0u) ok = false;
    if (j == my_xcc) mine = (int)c;
  }
  if (sum != gridDim.x) ok = false;
  return ok ? mine : 0;
}

__device__ void phase_A(const Params& p, int layer, unsigned char* lds, int my_xcc, int my_loc, const unsigned* xcnt) {
  const int tid = otid(), w = tid >> 6, l = tid & 63;
  const half_t* H = (const half_t*)(p.ws + OFF_H);
  const half_t* Wt = (const half_t*)(p.ws + OFF_WINT) + (size_t)layer * NPAD * WP;
  half_t* P = (half_t*)(p.ws + OFF_P);
  float* GA = (float*)(p.ws + OFF_GA);
  float* IW = (float*)(p.ws + OFF_IW);
  half_t* BRc = (half_t*)(p.ws + OFF_BR);
  const float* RT = (const float*)(p.ws + OFF_RT);
  const float* DT = (const float*)(p.ws + OFF_DT);
  const int wm = w >> 1, wn = w & 1;
  const int G = gridDim.x;
  const int ntiles = 64 * 31;
  const int nx = xcc_census(xcnt, my_xcc);
  int nmine;
  if (nx > 0) nmine = (my_loc < 248) ? (248 - my_loc + nx - 1) / nx : 0;
  else nmine = ((int)blockIdx.x < ntiles) ? (ntiles - (int)blockIdx.x + G - 1) / G : 0;
  h8 ra0[8], rb0[8];
  int mt = 0, nt = 0;
  if (nmine > 0) {
    if (nx > 0) { const int s0 = my_loc; mt = my_xcc * 8 + (s0 & 7); nt = s0 >> 3; }
    else { const int tix = blockIdx.x; mt = tix & 63; nt = tix >> 6; }
    gemm_issue1<4>(ra0, rb0, H + (size_t)mt * 256 * HP, HP, Wt + (size_t)nt * 256 * WP, WP);
  }
#pragma unroll 1
  for (int rnd = 0; rnd < nmine; ++rnd) {
    f16v acc[4][4];
    zero_acc<4>(acc);
    gemm_run1<4>(acc, ra0, rb0, H + (size_t)mt * 256 * HP, HP, Wt + (size_t)nt * 256 * WP, WP, 1024, lds);
    const int mt_cur = mt, nt_cur = nt;
    if (rnd + 1 < nmine) {
      if (nx > 0) { const int s1 = my_loc + nx * (rnd + 1); mt = my_xcc * 8 + (s1 & 7); nt = s1 >> 3; }
      else { const int tix = (rnd + 1) * G + blockIdx.x; mt = tix & 63; nt = tix >> 6; }
      gemm_issue1<4>(ra0, rb0, H + (size_t)mt * 256 * HP, HP, Wt + (size_t)nt * 256 * WP, WP);
    }
    const int m0w = mt_cur * 256 + wm * 128;
    const int n0w = nt_cur * 256 + wn * 128;
    float* E = (float*)(lds) + w * (32 * EP);
    const int prow = l >> 3, c0 = (l & 7) * 8;
#pragma unroll
    for (int jp = 0; jp < 2; ++jp) {
      const int nb2 = n0w + jp * 64;
      const int n0 = nb2 + c0;
      const bool rope64 = nb2 < 512;
      const bool rope16 = ((nb2 >= C_DSAQ && nb2 < C_DSAV) || (nb2 >= C_IDXQ && nb2 < C_GLAQ)) && (c0 < 16);
      float scale = 1.f;
      if (n0 < 256 || (n0 >= C_DSAQ && n0 < C_DSAK) || (n0 >= C_IDXQ && n0 < C_IDXK) || (n0 >= C_GLAQ && n0 < C_GLAK)) scale = 0.125f;
      int mode = 0;
      if ((n0 >= C_RETG && n0 < C_DSAQ) || (n0 >= C_DSAG && n0 < C_IDXQ) || (n0 >= C_GLAG && n0 < C_GLAA)) mode = 1;
      if (n0 >= C_MRG && n0 < C_END) mode = 2;
#pragma unroll
      for (int i = 0; i < 4; ++i) {
        stage_pair(E, acc[i][2 * jp], acc[i][2 * jp + 1], l);
#pragma unroll 2
        for (int ps = 0; ps < 4; ++ps) {
          const int rl = ps * 8 + prow;
          const int row = m0w + i * 32 + rl;
          float v[8], o[8];
          ld8(E + rl * EP + c0, v);
#pragma unroll
          for (int q = 0; q < 8; ++q) o[q] = v[q];
          if (rope64) {
            float pv[8], tb[16];
            ld8(E + rl * EP + (c0 ^ 32), pv);
            const float* tp = RT + (size_t)row * 64 + (c0 & 31) * 2;
            ld8(tp, *(float(*)[8])&tb[0]); ld8(tp + 8, *(float(*)[8])&tb[8]);
#pragma unroll
            for (int q = 0; q < 8; ++q) o[q] = (c0 < 32) ? (v[q] * tb[2 * q] - pv[q] * tb[2 * q + 1]) : (v[q] * tb[2 * q] + pv[q] * tb[2 * q + 1]);
          } else if (rope16) {
            float pv[8], tb[16];
            ld8(E + rl * EP + (c0 ^ 8), pv);
            const float* tp = DT + (size_t)row * 16;
            ld8(tp, *(float(*)[8])&tb[0]); ld8(tp + 8, *(float(*)[8])&tb[8]);
#pragma unroll
            for (int q = 0; q < 8; ++q) o[q] = (c0 < 8) ? (v[q] * tb[2 * q] - pv[q] * tb[2 * q + 1]) : (v[q] * tb[2 * q] + pv[q] * tb[2 * q + 1]);
          }
          h8 ov;
#pragma unroll
          for (int q = 0; q < 8; ++q) {
            float t = o[q] * scale;
            if (mode != 0) {
              const float sg = __builtin_amdgcn_rcpf(1.f + __expf(-t));
              t = (mode == 1) ? t * sg : sg;
            }
            ov[q] = (half_t)t;
          }
          if (n0 < C_END) __builtin_nontemporal_store(ov, (h8*)(P + (size_t)row * PP + n0));
          if (n0 >= C_DSAK && n0 < C_DSAG) *(h8*)(BRc + (size_t)row * 1536 + (n0 - C_DSAK)) = ov;
          if (n0 >= C_IDXK && n0 < C_GLAQ) *(h8*)(BRc + (size_t)row * 1536 + 256 + (n0 - C_IDXK)) = ov;
          if (n0 >= C_GLAA && n0 < C_MRG) {
#pragma unroll
            for (int q = 0; q < 8; ++q) GA[(size_t)row * 16 + (n0 - C_GLAA) + q] = v[q];
          }
          if (n0 == C_IDXW) {
#pragma unroll
            for (int q = 0; q < 4; ++q) IW[(size_t)row * 4 + q] = 0.5f * v[q];
          }
        }
      }
    }
  }
}

#define LA_BC 0
#define LA_GAS 16640
#define LA_WL 20736
#define LA_QT 24832
#define LA_KT 34048
#define LA_AT 43264
#define LA_VT 52480
#define LA_SS 70912
#define LA_OS 89344
#define LA_SEG 123136

__device__ void la_bcum(const Params& p, int layer, int n, int Hh, unsigned char* lds) {
  const int tid = otid();
  float* Bc = (float*)(lds + LA_BC);
  const int d = tid & 63, q = tid >> 6;
  if (Hh < 4) {
    float lg = log1pf(-exp2f(-5.0f - (float)Hh));
#pragma unroll
    for (int jj = 0; jj < 16; ++jj) { int j = q * 16 + jj; Bc[j * 65 + d] = (float)(j + 1) * lg; }
    __syncthreads();
    return;
  }
  const int h = Hh - 4;
  float* GAs = (float*)(lds + LA_GAS);
  float* WL = (float*)(lds + LA_WL);
  float* SEG = (float*)(lds + LA_SEG);
  const float* GA = (const float*)(p.ws + OFF_GA);
#pragma unroll
  for (int i = 0; i < 4; ++i) {
    int e = tid + 256 * i;
    GAs[e] = GA[(size_t)n * 64 * 16 + e];
    int r = e >> 6, dd = e & 63;
    WL[e] = p.gla_w_lr[(size_t)layer * 16 * 256 + r * 256 + h * 64 + dd];
  }
  __syncthreads();
  float wl[16];
#pragma unroll
  for (int r = 0; r < 16; ++r) wl[r] = WL[r * 64 + d];
  const float bl = p.gla_b_lr[layer * 256 + h * 64 + d];
  float run = 0.f;
#pragma unroll
  for (int jj = 0; jj < 16; ++jj) {
    int j = q * 16 + jj;
    float z = bl;
#pragma unroll
    for (int r = 0; r < 16; ++r) z += GAs[j * 16 + r] * wl[r];
    float ls = fminf(z, 0.f) - __logf(1.f + __expf(-fabsf(z)));
    run += ls * (1.0f / 16.0f);
    Bc[j * 65 + d] = run;
  }
  SEG[q * 64 + d] = run;
  __syncthreads();
  float off = 0.f;
  for (int qq = 0; qq < q; ++qq) off += SEG[qq * 64 + d];
  if (q > 0) {
#pragma unroll
    for (int jj = 0; jj < 16; ++jj) { int j = q * 16 + jj; Bc[j * 65 + d] += off; }
  }
  __syncthreads();
}

__device__ __forceinline__ void la_load_v(const half_t* __restrict__ P, int t0, int vcol, h8 (&vr)[2][2]) {
  const int tid = otid(), w = tid >> 6, l = tid & 63;
  const int jp = l & 31, cgp = l >> 5;
#pragma unroll
  for (int it = 0; it < 2; ++it) {
    int c = it * 8 + w * 2 + cgp;
    vr[it][0] = *(const h8*)(P + (size_t)(t0 + 2 * jp) * PP + vcol + c * 8);
    vr[it][1] = *(const h8*)(P + (size_t)(t0 + 2 * jp + 1) * PP + vcol + c * 8);
  }
}
__device__ __forceinline__ void la_stage_vt(const h8 (&vr)[2][2], unsigned char* lds) {
  const int tid = otid(), w = tid >> 6, l = tid & 63;
  half_t* VT = (half_t*)(lds + LA_VT);
  const int jp = l & 31, cgp = l >> 5;
#pragma unroll
  for (int it = 0; it < 2; ++it) {
    int c = it * 8 + w * 2 + cgp;
#pragma unroll
    for (int q = 0; q < 8; ++q) {
      h2 pr; pr[0] = vr[it][0][q]; pr[1] = vr[it][1][q];
      *(h2*)(VT + (c * 8 + q) * 72 + 2 * jp) = pr;
    }
  }
}
__device__ void la_item_kv(const Params& p, int layer, int item, unsigned char* lds) {
  const int tid = otid(), w = tid >> 6, l = tid & 63;
  const int n = item >> 3, Hh = item & 7;
  const int t0 = n * 64;
  const half_t* P = (const half_t*)(p.ws + OFF_P);
  half_t* ST = (half_t*)(p.ws + OFF_ST);
  float* DEC = (float*)(p.ws + OFF_DEC);
  const int kcol = (Hh < 4) ? (C_RETK + Hh * 64) : (C_GLAK + (Hh - 4) * 64);
  const int vcol = (Hh < 4) ? (C_RETV + Hh * 128) : (C_GLAV + (Hh - 4) * 128);
  h8 vr[2][2];
  la_load_v(P, t0, vcol, vr);
  const h8 k0 = *(const h8*)(P + (size_t)(t0 + 2 * (l & 31)) * PP + kcol + (w * 2 + (l >> 5)) * 8);
  const h8 k1 = *(const h8*)(P + (size_t)(t0 + 2 * (l & 31) + 1) * PP + kcol + (w * 2 + (l >> 5)) * 8);
  __syncthreads();
  la_bcum(p, layer, n, Hh, lds);
  const float* Bc = (const float*)(lds + LA_BC);
  half_t* KhT = (half_t*)(lds + LA_KT);
  half_t* VT = (half_t*)(lds + LA_VT);
  {
    const int jp = l & 31, cgp = l >> 5;
    int c = w * 2 + cgp;
#pragma unroll
    for (int q = 0; q < 8; ++q) {
      int d = c * 8 + q;
      float bl = Bc[63 * 65 + d];
      h2 pr;
      pr[0] = (half_t)((float)k0[q] * __expf(bl - Bc[(2 * jp) * 65 + d]));
      pr[1] = (half_t)((float)k1[q] * __expf(bl - Bc[(2 * jp + 1) * 65 + d]));
      *(h2*)(KhT + d * 72 + 2 * jp) = pr;
    }
  }
  la_stage_vt(vr, lds);
  if (tid < 64) DEC[(size_t)item * 64 + tid] = __expf(Bc[63 * 65 + tid]);
  __syncthreads();
  f16v acc[2];
#pragma unroll
  for (int j = 0; j < 2; ++j)
#pragma unroll
    for (int r = 0; r < 16; ++r) acc[j][r] = ozero();
#pragma unroll
  for (int ks = 0; ks < 4; ++ks) {
    h8 a = *(const h8*)(VT + (32 * w + (l & 31)) * 72 + ks * 16 + (l >> 5) * 8);
#pragma unroll
    for (int j = 0; j < 2; ++j) {
      h8 b = *(const h8*)(KhT + (j * 32 + (l & 31)) * 72 + ks * 16 + (l >> 5) * 8);
      acc[j] = mfma16(a, b, acc[j]);
    }
  }
#pragma unroll
  for (int j = 0; j < 2; ++j)
#pragma unroll
    for (int r = 0; r < 16; ++r) {
      int e = 32 * w + crow(r, l);
      int d = j * 32 + (l & 31);
      ST[(size_t)item * 8192 + e * 64 + d] = (half_t)acc[j][r];
    }
}

__device__ void phase_scan(const Params& p) {
  half_t* ST = (half_t*)(p.ws + OFF_ST);
  const float* DEC = (const float*)(p.ws + OFF_DEC);
  for (int f2 = blockIdx.x * NTHREADS + otid(); f2 < 32768; f2 += gridDim.x * NTHREADS) {
    const int f = f2 * 2;
    const int Hh = f >> 13, d = f & 63;
    float s0 = 0.f, s1 = 0.f;
    for (int n0 = 0; n0 < 256; n0 += 16) {
      h2 kv[16]; float2 dc[16];
#pragma unroll
      for (int u = 0; u < 16; ++u) {
        kv[u] = *(const h2*)(ST + (size_t)(n0 + u) * 65536 + f);
        dc[u] = *(const float2*)(DEC + (size_t)((n0 + u) * 8 + Hh) * 64 + d);
      }
#pragma unroll
      for (int u = 0; u < 16; ++u) {
        h2 o; o[0] = (half_t)s0; o[1] = (half_t)s1;
        *(h2*)(ST + (size_t)(n0 + u) * 65536 + f) = o;
        s0 = dc[u].x * s0 + (float)kv[u][0];
        s1 = dc[u].y * s1 + (float)kv[u][1];
      }
    }
  }
}

__device__ void la_item_out(const Params& p, int layer, int item, unsigned char* lds) {
  const int tid = otid(), w = tid >> 6, l = tid & 63;
  const int n = item >> 3, Hh = item & 7;
  const int t0 = n * 64;
  const half_t* P = (const half_t*)(p.ws + OFF_P);
  const half_t* ST = (const half_t*)(p.ws + OFF_ST);
  half_t* BR = (half_t*)(p.ws + OFF_BR);
  const int qcol = (Hh < 4) ? (C_RETQ + Hh * 64) : (C_GLAQ + (Hh - 4) * 64);
  const int kcol = (Hh < 4) ? (C_RETK + Hh * 64) : (C_GLAK + (Hh - 4) * 64);
  const int vcol = (Hh < 4) ? (C_RETV + Hh * 128) : (C_GLAV + (Hh - 4) * 128);
  const int gcol = (Hh < 4) ? (C_RETG + Hh * 128) : (C_GLAG + (Hh - 4) * 128);
  const int ocol = (Hh < 4) ? (Hh * 128) : (1024 + (Hh - 4) * 128);
  h8 vr[2][2];
  la_load_v(P, t0, vcol, vr);
  h8 qr[2], kr[2], sr[4];
#pragma unroll
  for (int it = 0; it < 2; ++it) {
    const int c = tid + 256 * it;
    qr[it] = *(const h8*)(P + (size_t)(t0 + (c >> 3)) * PP + qcol + (c & 7) * 8);
    kr[it] = *(const h8*)(P + (size_t)(t0 + (c >> 3)) * PP + kcol + (c & 7) * 8);
  }
#pragma unroll
  for (int it = 0; it < 4; ++it) {
    const int c = tid + 256 * it;
    sr[it] = *(const h8*)(ST + (size_t)item * 8192 + (c >> 3) * 64 + (c & 7) * 8);
  }
  __syncthreads();
  la_bcum(p, layer, n, Hh, lds);
  const float* Bc = (const float*)(lds + LA_BC);
  half_t* Qt = (half_t*)(lds + LA_QT);
  half_t* Kt = (half_t*)(lds + LA_KT);
  half_t* AT = (half_t*)(lds + LA_AT);
  half_t* VT = (half_t*)(lds + LA_VT);
  half_t* SS = (half_t*)(lds + LA_SS);
  float* OS = (float*)(lds + LA_OS);
#pragma unroll
  for (int it = 0; it < 2; ++it) {
    int c = tid + 256 * it;
    int row = c >> 3, kc = c & 7;
    const h8 qv = qr[it];
    const h8 kv = kr[it];
    h8 qo, ko;
#pragma unroll
    for (int q = 0; q < 8; ++q) {
      float b = Bc[row * 65 + kc * 8 + q];
      qo[q] = (half_t)((float)qv[q] * __expf(b));
      ko[q] = (half_t)((float)kv[q] * __expf(-b));
    }
    *(h8*)(Qt + row * 72 + kc * 8) = qo;
    *(h8*)(Kt + row * 72 + kc * 8) = ko;
  }
  la_stage_vt(vr, lds);
#pragma unroll
  for (int it = 0; it < 4; ++it) {
    int c = tid + 256 * it;
    int e = c >> 3, kc = c & 7;
    *(h8*)(SS + e * 72 + kc * 8) = sr[it];
  }
  __syncthreads();
  {
    const int mi = w >> 1, nj = w & 1;
    f16v acc;
#pragma unroll
    for (int r = 0; r < 16; ++r) acc[r] = ozero();
#pragma unroll
    for (int ks = 0; ks < 4; ++ks) {
      h8 a = *(const h8*)(Qt + (mi * 32 + (l & 31)) * 72 + ks * 16 + (l >> 5) * 8);
      h8 b = *(const h8*)(Kt + (nj * 32 + (l & 31)) * 72 + ks * 16 + (l >> 5) * 8);
      acc = mfma16(a, b, acc);
    }
#pragma unroll
    for (int r = 0; r < 16; ++r) {
      int i = mi * 32 + crow(r, l);
      int j = nj * 32 + (l & 31);
      float v = (j <= i) ? acc[r] : 0.f;
      AT[i * 72 + j] = (half_t)v;
    }
  }
  __syncthreads();
  {
    const int mi = w >> 1, nh = w & 1;
    f16v acc[2];
#pragma unroll
    for (int j = 0; j < 2; ++j)
#pragma unroll
      for (int r = 0; r < 16; ++r) acc[j][r] = ozero();
#pragma unroll
    for (int ks = 0; ks < 4; ++ks) {
      h8 a1 = *(const h8*)(AT + (mi * 32 + (l & 31)) * 72 + ks * 16 + (l >> 5) * 8);
      h8 a2 = *(const h8*)(Qt + (mi * 32 + (l & 31)) * 72 + ks * 16 + (l >> 5) * 8);
#pragma unroll
      for (int j = 0; j < 2; ++j) {
        h8 b1 = *(const h8*)(VT + (nh * 64 + j * 32 + (l & 31)) * 72 + ks * 16 + (l >> 5) * 8);
        h8 b2 = *(const h8*)(SS + (nh * 64 + j * 32 + (l & 31)) * 72 + ks * 16 + (l >> 5) * 8);
        acc[j] = mfma16(a1, b1, acc[j]);
        acc[j] = mfma16(a2, b2, acc[j]);
      }
    }
#pragma unroll
    for (int j = 0; j < 2; ++j)
#pragma unroll
      for (int r = 0; r < 16; ++r) {
        int i = mi * 32 + crow(r, l);
        int e = nh * 64 + j * 32 + (l & 31);
        OS[i * 132 + e] = acc[j][r];
      }
  }
  __syncthreads();
  {
    const int i = tid >> 2, qd = tid & 3;
    float ov[32];
    float ss = 0.f;
#pragma unroll
    for (int c = 0; c < 8; ++c) {
      f4v v = *(const f4v*)(OS + i * 132 + qd * 32 + c * 4);
      ov[c * 4] = v[0]; ov[c * 4 + 1] = v[1]; ov[c * 4 + 2] = v[2]; ov[c * 4 + 3] = v[3];
      ss += v[0] * v[0] + v[1] * v[1] + v[2] * v[2] + v[3] * v[3];
    }
    ss += dppf<0xB1>(ss);
    ss += dppf<0x4E>(ss);
    float rs = rsqrtf(ss * (1.0f / 128.0f) + 1e-6f);
#pragma unroll
    for (int c = 0; c < 4; ++c) {
      h8 g = *(const h8*)(P + (size_t)(t0 + i) * PP + gcol + qd * 32 + c * 8);
      h8 o;
#pragma unroll
      for (int q = 0; q < 8; ++q) o[q] = (half_t)(ov[c * 8 + q] * rs * (float)g[q]);
      *(h8*)(BR + (size_t)(t0 + i) * 1536 + ocol + qd * 32 + c * 8) = o;
    }
  }
}

#define DS_CAP 768
#define DS_PRUNE_AT 640
#define NPL 12
#define DS_LS 0
#define DS_LI (32 * DS_CAP * 4)
#define DS_CNT (32 * DS_CAP * 6)
#define DS_THR (DS_CNT + 128)
#define DS_WQ (DS_CNT + 256)
#define DS_HIST (DS_CNT + 1024)

__device__ __forceinline__ unsigned long long wave_or64(unsigned long long v) {
  const unsigned lo = wave_or((unsigned)v), hi = wave_or((unsigned)(v >> 32));
  return ((unsigned long long)hi << 32) | lo;
}
template <bool APPROX>
__device__ __forceinline__ void dsa_prune(float* LSm, unsigned short* LIm, int n, unsigned* hist, int* cntm, float* thrm, int l) {
  unsigned long long comp[NPL];
  bool act[NPL], val[NPL];
#pragma unroll
  for (int k = 0; k < NPL; ++k) {
    int e = l + 64 * k;
    val[k] = e < n;
    const int ec = val[k] ? e : 0;
    unsigned u = __float_as_uint(LSm[ec]), li = LIm[ec];
    if (!val[k]) { u = 0; li = 0; }
    const unsigned key = (u >> 31) ? ~u : (u | 0x80000000u);
    comp[k] = ((unsigned long long)key << 14) | (unsigned long long)(16383u - li);
    act[k] = val[k];
  }
  const unsigned long long c0 = ((unsigned long long)(unsigned)__builtin_amdgcn_readfirstlane((int)(unsigned)(comp[0] >> 32)) << 32) | (unsigned)__builtin_amdgcn_readfirstlane((int)(unsigned)comp[0]);
  unsigned long long x = 0;
#pragma unroll
  for (int k = 0; k < NPL; ++k) x |= val[k] ? (comp[k] ^ c0) : 0ull;
  x = wave_or64(x);
  int shift = (x == 0ull) ? 0 : (63 - __clzll((long long)x)) - 7;
  if (shift < 0) shift = 0;
  unsigned rank = 256;
  bool fast = false; unsigned fsel = 0, fcnt = 0; int fshift = 0;
#pragma unroll 1
  for (int rd = 0; rd < 8; ++rd) {
    *(uint4*)(hist + 4 * l) = make_uint4(0, 0, 0, 0);
    asm volatile("" ::: "memory");
    unsigned dk[NPL];
#pragma unroll
    for (int k = 0; k < NPL; ++k) {
      dk[k] = (unsigned)(comp[k] >> shift) & 255u;
      if (act[k]) atomicAdd(&hist[dk[k]], 1u);
    }
    asm volatile("" ::: "memory");
    uint4 hv; hv.x = hist[4 * l]; hv.y = hist[4 * l + 1]; hv.z = hist[4 * l + 2]; hv.w = hist[4 * l + 3];
    unsigned tl = hv.x + hv.y + hv.z + hv.w;
    const unsigned pin = wave_incl_scan(tl);
    const unsigned tot = (unsigned)__builtin_amdgcn_readlane((int)pin, 63);
    unsigned sx = tot - pin;
    bool mine = (sx < rank) && (rank <= sx + tl);
    unsigned dsel = 0, nr = 0, hsel = 0;
    if (mine) {
      unsigned c = sx;
      if (c + hv.w >= rank) { dsel = 4 * l + 3; nr = rank - c; hsel = hv.w; }
      else {
        c += hv.w;
        if (c + hv.z >= rank) { dsel = 4 * l + 2; nr = rank - c; hsel = hv.z; }
        else {
          c += hv.z;
          if (c + hv.y >= rank) { dsel = 4 * l + 1; nr = rank - c; hsel = hv.y; }
          else { c += hv.y; dsel = 4 * l; nr = rank - c; hsel = hv.x; }
        }
      }
    }
    unsigned long long mk = __ballot(mine);
    int src = (mk == 0ull) ? 0 : (__ffsll((long long)mk) - 1);
    dsel = (unsigned)__builtin_amdgcn_readlane((int)dsel, src);
    rank = (unsigned)__builtin_amdgcn_readlane((int)nr, src);
    hsel = (unsigned)__builtin_amdgcn_readlane((int)hsel, src);
    if (APPROX && rd == 0) {
      const unsigned kept = 256u - rank + hsel;
      if (kept <= 288u) { fast = true; fsel = dsel; fcnt = kept; fshift = shift; break; }
    }
#pragma unroll
    for (int k = 0; k < NPL; ++k) act[k] = act[k] && (dk[k] == dsel);
    if (hsel <= 1u || shift == 0) break;
    shift = (shift >= 8) ? (shift - 8) : 0;
  }
  unsigned long long tsel = 0;
#pragma unroll
  for (int k = 0; k < NPL; ++k) tsel |= act[k] ? comp[k] : 0ull;
  unsigned long long T = 0ull;
  if (!fast) T = wave_or64(tsel);
  else T = ((c0 >> (fshift + 8)) << (fshift + 8)) | ((unsigned long long)fsel << fshift);
  bool keep[NPL];
  unsigned cntk = 0;
#pragma unroll
  for (int k = 0; k < NPL; ++k) {
    keep[k] = val[k] && (comp[k] >= T);
    cntk += keep[k] ? 1u : 0u;
  }
  unsigned pos = wave_incl_scan(cntk) - cntk;
  asm volatile("" ::: "memory");
#pragma unroll
  for (int k = 0; k < NPL; ++k) {
    if (keep[k]) {
      const unsigned kk = (unsigned)(comp[k] >> 14);
      const unsigned u = (kk & 0x80000000u) ? (kk & 0x7FFFFFFFu) : ~kk;
      LSm[pos] = __uint_as_float(u);
      LIm[pos] = (unsigned short)(16383u - ((unsigned)comp[k] & 16383u));
      ++pos;
    }
  }
  if (l == 0) {
    const unsigned T32 = (unsigned)(T >> 14);
    *cntm = fast ? (int)fcnt : 256;
    *thrm = __uint_as_float((T32 & 0x80000000u) ? (T32 & 0x7FFFFFFFu) : ~T32);
  }
  asm volatile("" ::: "memory");
}

__device__ void dsa_item(const Params& p, int qb, unsigned char* lds) {
  const int tid = otid(), w = tid >> 6, l = tid & 63;
  const int t0 = qb * 32;
  const half_t* P = (const half_t*)(p.ws + OFF_P);
  const float* IW = (const float*)(p.ws + OFF_IW);
  half_t* BR = (half_t*)(p.ws + OFF_BR);
  float* LS = (float*)(lds + DS_LS);
  unsigned short* LI = (unsigned short*)(lds + DS_LI);
  int* cnt = (int*)(lds + DS_CNT);
  float* thr = (float*)(lds + DS_THR);
  float* wq = (float*)(lds + DS_WQ);
  unsigned* hist = (unsigned*)(lds + DS_HIST) + w * 256;
  float* PWa = LS + (w * 8) * DS_CAP + 256;
  float* PWb = LS + (w * 8 + 1) * DS_CAP + 256;
  half_t* QS = (half_t*)(LI + (w * 8) * DS_CAP + 256);
  for (int rep_sel = 0; rep_sel < REP_SEL; ++rep_sel) {
  __syncthreads();
  if (tid < 32) { cnt[tid] = 0; thr[tid] = -INFINITY; }
  if (tid < 128) wq[tid] = IW[(size_t)t0 * 4 + tid];
  __syncthreads();
  h8 aq[4][4];
#pragma unroll
  for (int h = 0; h < 4; ++h)
#pragma unroll
    for (int ks = 0; ks < 4; ++ks)
      aq[h][ks] = *(const h8*)(P + (size_t)(t0 + (l & 31)) * PP + C_IDXQ + h * 64 + ks * 16 + (l >> 5) * 8);
  const int nt = qb + 1;
  const int nr = (nt + 3) >> 2;
  const int mq = l & 31;
  const f4v wv = *(const f4v*)(wq + mq * 4);
  float th = -INFINITY; asm volatile("" : "+v"(th));
  h8 bk[4];
  {
    const int k0 = (w < nt) ? w : 0;
#pragma unroll
    for (int ks = 0; ks < 4; ++ks)
      bk[ks] = *(const h8*)(BR + (size_t)(k0 * 32 + (l & 31)) * 1536 + 256 + ks * 16 + (l >> 5) * 8);
  }
#pragma unroll 1
  for (int rd = 0; rd < nr; ++rd) {
    const int kt = 4 * rd + w;
    h8 bkn[4];
    {
      const int kn = (kt + 4 < nt) ? (kt + 4) : 0;
#pragma unroll
      for (int ks = 0; ks < 4; ++ks)
        bkn[ks] = *(const h8*)(BR + (size_t)(kn * 32 + (l & 31)) * 1536 + 256 + ks * 16 + (l >> 5) * 8);
    }
    if (kt < nt) {
      const int sbase = kt * 32;
      f16v acc[4];
#pragma unroll
      for (int h = 0; h < 4; ++h) {
#pragma unroll
        for (int r = 0; r < 16; ++r) acc[h][r] = ozero();
#pragma unroll
        for (int ks = 0; ks < 4; ++ks) acc[h] = mfma16(bk[ks], aq[h][ks], acc[h]);
      }
      float scv[16];
#pragma unroll
      for (int r = 0; r < 16; ++r) {
        float sc = wv[0] * relu_f(acc[0][r]) + wv[1] * relu_f(acc[1][r]) + wv[2] * relu_f(acc[2][r]) + wv[3] * relu_f(acc[3][r]);
        sc += 0.0f;
        scv[r] = sc;
      }
      if (kt == qb) {
#pragma unroll
        for (int r = 0; r < 16; ++r) if (sbase + crow(r, l) > t0 + mq) scv[r] = -INFINITY;
      }
      unsigned pm = 0;
#pragma unroll
      for (int r = 0; r < 16; ++r) pm |= (scv[r] > th) ? (1u << r) : 0u;
      const int np = __popc(pm);
      if (__ballot(np > 0) != 0ull) {
        int base = 0;
        if (np > 0) base = atomicAdd(&cnt[mq], np);
#pragma unroll
        for (int r = 0; r < 16; ++r) {
          if ((pm >> r) & 1u) {
            const int slot = base + __popc(pm & ((1u << r) - 1u));
            LS[mq * DS_CAP + slot] = scv[r];
            LI[mq * DS_CAP + slot] = (unsigned short)(sbase + crow(r, l));
          }
        }
      }
    }
    lds_barrier();
    bool any_prune;
    {
      const int cv = (l < 32) ? cnt[l] : 0;
      unsigned pmask = (unsigned)__ballot(cv > DS_PRUNE_AT);
      any_prune = pmask != 0u;
      int j = 0;
      while (pmask != 0u) {
        const int m = __ffs((int)pmask) - 1;
        pmask &= pmask - 1u;
        if ((j & 3) == w) dsa_prune<true>(LS + m * DS_CAP, LI + m * DS_CAP, cnt[m], hist, cnt + m, thr + m, l);
        ++j;
      }
    }
    lds_barrier();
    if (any_prune) th = thr[mq];
#pragma unroll
    for (int ks = 0; ks < 4; ++ks) bk[ks] = bkn[ks];
  }
  }
#pragma unroll 1
  for (int mm = 0; mm < 8; ++mm) {
    const int m = w * 8 + mm;
    const int c = cnt[m];
    if (c > 256) dsa_prune<false>(LS + m * DS_CAP, LI + m * DS_CAP, c, hist, cnt + m, thr + m, l);
  }
  asm volatile("s_waitcnt lgkmcnt(0)" ::: "memory");
  for (int rep_att = 0; rep_att < REP_ATT; ++rep_att) {
  h8 kvr[4][8];
  {
    const int m = w * 8;
    const int c = min(cnt[m], 256);
    const unsigned short* LIm = LI + m * DS_CAP;
#pragma unroll
    for (int kk = 0; kk < 4; ++kk) {
      const int e = l + 64 * kk;
      const int s = (int)LIm[(e < c) ? e : 0];
      const half_t* kr = BR + (size_t)s * 1536;
#pragma unroll
      for (int ch = 0; ch < 8; ++ch) kvr[kk][ch] = *(const h8*)(kr + ch * 8);
    }
  }
  h8 qreg = *(const h8*)(P + (size_t)(t0 + w * 8) * PP + C_DSAQ + l * 8);
  const int dch = l >> 3, ksub = l & 7;
#pragma unroll 1
  for (int u = 0; u < 16; ++u) {
    const int mm = u >> 1, g = u & 1;
    const int m = w * 8 + mm;
    const int t = t0 + m;
    const int c = min(cnt[m], 256);
    const unsigned short* LIm = LI + m * DS_CAP;
    if (g == 0) {
      *(h8*)(QS + l * 8) = qreg;
      const int mq = (mm < 7) ? (m + 1) : m;
      qreg = *(const h8*)(P + (size_t)(t0 + mq) * PP + C_DSAQ + l * 8);
    }
    h8 gt[4];
#pragma unroll
    for (int hh = 0; hh < 4; ++hh) gt[hh] = *(const h8*)(P + (size_t)t * PP + C_DSAG + (g * 4 + hh) * 64 + dch * 8);
    h8 vv[16];
#pragma unroll
    for (int i = 0; i < 16; ++i) {
      const int e = i * 8 + ksub;
      const int s = (int)LIm[(e < c) ? e : 0];
      vv[i] = *(const h8*)(BR + (size_t)s * 1536 + 128 + g * 64 + dch * 8);
    }
    asm volatile("" ::: "memory");
    float lg[4][4];
#pragma unroll
    for (int hh = 0; hh < 4; ++hh) {
#pragma unroll
      for (int kk = 0; kk < 4; ++kk) lg[hh][kk] = ozero();
#pragma unroll
      for (int ch = 0; ch < 8; ++ch) {
        const h8 qq = *(const h8*)(QS + (g * 4 + hh) * 64 + ch * 8);
#pragma unroll
        for (int kk = 0; kk < 4; ++kk) {
          float a = lg[hh][kk];
          a = __builtin_amdgcn_fdot2(__builtin_shufflevector(qq, qq, 0, 1), __builtin_shufflevector(kvr[kk][ch], kvr[kk][ch], 0, 1), a, false);
          a = __builtin_amdgcn_fdot2(__builtin_shufflevector(qq, qq, 2, 3), __builtin_shufflevector(kvr[kk][ch], kvr[kk][ch], 2, 3), a, false);
          a = __builtin_amdgcn_fdot2(__builtin_shufflevector(qq, qq, 4, 5), __builtin_shufflevector(kvr[kk][ch], kvr[kk][ch], 4, 5), a, false);
          a = __builtin_amdgcn_fdot2(__builtin_shufflevector(qq, qq, 6, 7), __builtin_shufflevector(kvr[kk][ch], kvr[kk][ch], 6, 7), a, false);
          lg[hh][kk] = a;
        }
      }
#pragma unroll
      for (int kk = 0; kk < 4; ++kk) lg[hh][kk] = (l + 64 * kk < c) ? lg[hh][kk] : -INFINITY;
    }
    {
      const int un = (u < 15) ? (u + 1) : 15;
      const int mn = w * 8 + (un >> 1), gn = un & 1;
      const int cn = min(cnt[mn], 256);
      const unsigned short* LIn = LI + mn * DS_CAP;
#pragma unroll
      for (int kk = 0; kk < 4; ++kk) {
        const int e = l + 64 * kk;
        const int s = (int)LIn[(e < cn) ? e : 0];
        const half_t* kr = BR + (size_t)s * 1536 + gn * 64;
#pragma unroll
        for (int ch = 0; ch < 8; ++ch) kvr[kk][ch] = *(const h8*)(kr + ch * 8);
      }
    }
#pragma unroll
    for (int hh = 0; hh < 4; ++hh) {
      float mx = fmaxf(fmaxf(lg[hh][0], lg[hh][1]), fmaxf(lg[hh][2], lg[hh][3]));
      mx = wave_max(mx);
      float ev[4]; float sm = 0.f;
#pragma unroll
      for (int kk = 0; kk < 4; ++kk) { ev[kk] = __expf(lg[hh][kk] - mx); sm += ev[kk]; }
      sm = wave_sum(sm);
      const float inv = 1.0f / sm;
#pragma unroll
      for (int kk = 0; kk < 4; ++kk) ((kk < 2) ? PWa : PWb)[(l + 64 * (kk & 1)) * 4 + hh] = ev[kk] * inv;
    }
    asm volatile("" ::: "memory");
    float o[4][8];
#pragma unroll
    for (int hh = 0; hh < 4; ++hh)
#pragma unroll
      for (int q = 0; q < 8; ++q) o[hh][q] = ozero();
    const int nit = (c + 7) >> 3;
#pragma unroll 1
    for (int it0 = 0; it0 < nit; it0 += 16) {
      if (it0 > 0) {
#pragma unroll
        for (int i = 0; i < 16; ++i) {
          const int e = (it0 + i) * 8 + ksub;
          const int s = (int)LIm[(e < c) ? e : 0];
          vv[i] = *(const h8*)(BR + (size_t)s * 1536 + 128 + g * 64 + dch * 8);
        }
      }
#pragma unroll
      for (int i = 0; i < 16; ++i) {
        const int e = (it0 + i) * 8 + ksub;
        const f4v pv = *(const f4v*)(((e < 128) ? PWa : PWb) + (e & 127) * 4);
#pragma unroll
        for (int hh = 0; hh < 4; ++hh)
#pragma unroll
          for (int q = 0; q < 8; ++q) o[hh][q] += pv[hh] * (float)vv[i][q];
      }
    }
#pragma unroll
    for (int hh = 0; hh < 4; ++hh)
#pragma unroll
      for (int q = 0; q < 8; ++q) {
        float v = o[hh][q];
        v += dppf<0xB1>(v); v += dppf<0x4E>(v); v += dppf<0x141>(v);
        o[hh][q] = v;
      }
    if ((l & 7) == 0) {
#pragma unroll
      for (int hh = 0; hh < 4; ++hh) {
        const int col = (g * 4 + hh) * 64 + dch * 8;
        h8 ov;
#pragma unroll
        for (int q = 0; q < 8; ++q) ov[q] = (half_t)(o[hh][q] * (float)gt[hh][q]);
        *(h8*)(BR + (size_t)t * 1536 + 512 + col) = ov;
      }
    }
    asm volatile("" ::: "memory");
  }
  }
}

__device__ void phase_B(const Params& p, int layer, unsigned char* lds) {
  const int G = gridDim.x;
  for (int j = 0; j * G < 512; ++j) {
    const int b = (j & 1) ? (G - 1 - (int)blockIdx.x) : (int)blockIdx.x;
    const int idx = j * G + b;
#ifndef NO_DSA
    if (idx < 512) dsa_item(p, 511 - idx, lds);
#endif
  }
  for (int rep = 0; rep < REP_KV; ++rep)
  for (int it = blockIdx.x; it < 2048; it += G) la_item_kv(p, layer, it, lds);
}

__device__ void phase_E1(const Params& p, int layer, unsigned char* lds, int my_xcc, int my_loc, const unsigned* xcnt) {
  const int tid = otid(), w = tid >> 6, l = tid & 63;
  const half_t* BR = (const half_t*)(p.ws + OFF_BR);
  const half_t* WbrT = (const half_t*)(p.ws + OFF_WBRT) + (size_t)layer * 3 * 1024 * WBP;
  const half_t* P = (const half_t*)(p.ws + OFF_P);
  half_t* Y1 = (half_t*)(p.ws + OFF_H);
  const int wm = w >> 1, wn = w & 1;
  float* E = (float*)(lds + GEMM_EOFF) + w * (32 * EP);
  const int prow = l >> 3, c0 = (l & 7) * 8;
  const int nx = xcc_census(xcnt, my_xcc);
  const int nrounds = (nx > 0) ? (64 + nx - 1) / nx : (512 + (int)gridDim.x - 1) / (int)gridDim.x;
  for (int rnd = 0; rnd < nrounds; ++rnd) {
    int mt, nt;
    if (nx > 0) {
      const int s = my_loc + nx * rnd;
      if (s >= 64) continue;
      mt = my_xcc * 8 + (s & 7); nt = s >> 3;
    } else {
      const int tix = rnd * (int)gridDim.x + (int)blockIdx.x;
      if (tix >= 512) continue;
      mt = tix & 63; nt = tix >> 6;
    }
    h8 tot[4][4];
#pragma unroll
    for (int i = 0; i < 4; ++i)
#pragma unroll
      for (int ps = 0; ps < 4; ++ps)
#pragma unroll
        for (int q = 0; q < 8; ++q) tot[i][ps][q] = (half_t)ozero();
    const int m0w = mt * 256 + wm * 128;
    const int n0 = nt * 128 + wn * 64 + c0;
#pragma unroll 1
    for (int b = 0; b < 3; ++b) {
      f16v acc[4][2];
      zero_acc<2>(acc);
      gemm_kloop<2>(acc, BR + (size_t)mt * 256 * 1536 + b * 512, 1536, WbrT + (size_t)b * 1024 * WBP + (size_t)nt * 128 * WBP, WBP, 512, lds);
#pragma unroll
      for (int i = 0; i < 4; ++i) {
        h8 g[4];
#pragma unroll
        for (int ps = 0; ps < 4; ++ps) g[ps] = *(const h8*)(P + (size_t)(m0w + i * 32 + ps * 8 + prow) * PP + C_MRG + b * 1024 + n0);
        stage_pair(E, acc[i][0], acc[i][1], l);
#pragma unroll
        for (int ps = 0; ps < 4; ++ps) {
          const int rl = ps * 8 + prow;
          float ev[8];
          ld8(E + rl * EP + c0, ev);
#pragma unroll
          for (int q = 0; q < 8; ++q) tot[i][ps][q] = (half_t)((float)tot[i][ps][q] + (float)g[ps][q] * ev[q]);
        }
      }
    }
#pragma unroll
    for (int i = 0; i < 4; ++i)
#pragma unroll
      for (int ps = 0; ps < 4; ++ps) {
        const int row = m0w + i * 32 + ps * 8 + prow;
        *(h8*)(Y1 + (size_t)row * HP + n0) = tot[i][ps];
      }
  }
}

__device__ void phase_E2(const Params& p, int layer, unsigned char* lds, int my_xcc, int my_loc, const unsigned* xcnt) {
  const int tid = otid(), w = tid >> 6, l = tid & 63;
  const half_t* Y1 = (const half_t*)(p.ws + OFF_H);
  const half_t* Wo = (const half_t*)(p.ws + OFF_WOUTT) + (size_t)layer * 1024 * WP;
  float* Y = (float*)(p.ws + OFF_ST);
  const int wm = w >> 1, wn = w & 1;
  const int nx = xcc_census(xcnt, my_xcc);
  const int nrounds = (nx > 0) ? (64 + nx - 1) / nx : (512 + (int)gridDim.x - 1) / (int)gridDim.x;
  for (int rnd = 0; rnd < nrounds; ++rnd) {
    int mt, nt;
    if (nx > 0) {
      const int s = my_loc + nx * rnd;
      if (s >= 64) continue;
      mt = my_xcc * 8 + (s & 7); nt = s >> 3;
    } else {
      const int tix = rnd * (int)gridDim.x + (int)blockIdx.x;
      if (tix >= 512) continue;
      mt = tix & 63; nt = tix >> 6;
    }
    f16v acc[4][2];
    zero_acc<2>(acc);
    gemm_kloop<2>(acc, Y1 + (size_t)mt * 256 * HP, HP, Wo + (size_t)nt * 128 * WP, WP, 1024, lds);
    const int m0w = mt * 256 + wm * 128;
    const int n0w = nt * 128 + wn * 64;
    float* E = (float*)(lds + GEMM_EOFF) + w * (32 * EP);
    const int prow = l >> 3, c0 = (l & 7) * 8;
#pragma unroll
    for (int i = 0; i < 4; ++i) {
      stage_pair(E, acc[i][0], acc[i][1], l);
#pragma unroll
      for (int ps = 0; ps < 4; ++ps) {
        const int rl = ps * 8 + prow;
        const int row = m0w + i * 32 + rl;
        const f4v a = *(const f4v*)(E + rl * EP + c0), b = *(const f4v*)(E + rl * EP + c0 + 4);
        *(f4v*)(Y + (size_t)row * 1024 + n0w + c0) = a;
        *(f4v*)(Y + (size_t)row * 1024 + n0w + c0 + 4) = b;
      }
    }
  }
}

__device__ void phase_E3(const Params& p, int layer) {
  const int w = otid() >> 6, l = otid() & 63;
  const float* Y = (const float*)(p.ws + OFF_ST);
  const float* MOD = (const float*)(p.ws + OFF_MOD);
  half_t* H = (half_t*)(p.ws + OFF_H);
  const float* xin = (layer == 0) ? p.x : p.out;
  const float* gate = MOD + layer * 3072 + 2048;
  const float* post = p.post_norm + layer * 1024;
  const int stride = gridDim.x * 4;
  int row = blockIdx.x * 4 + w;
  f4v yn[4], xn[4];
  if (row < S_LEN) {
#pragma unroll
    for (int i = 0; i < 4; ++i) {
      yn[i] = *(const f4v*)(Y + (size_t)row * 1024 + i * 256 + l * 4);
      xn[i] = *(const f4v*)(xin + (size_t)row * 1024 + i * 256 + l * 4);
    }
  }
  for (; row < S_LEN; row += stride) {
    float yv[16], xv[16];
    float ss = 0.f;
#pragma unroll
    for (int i = 0; i < 4; ++i)
#pragma unroll
      for (int q = 0; q < 4; ++q) { yv[i * 4 + q] = yn[i][q]; xv[i * 4 + q] = xn[i][q]; ss += yn[i][q] * yn[i][q]; }
    const int nrow = (row + stride < S_LEN) ? (row + stride) : row;
#pragma unroll
    for (int i = 0; i < 4; ++i) {
      yn[i] = *(const f4v*)(Y + (size_t)nrow * 1024 + i * 256 + l * 4);
      xn[i] = *(const f4v*)(xin + (size_t)nrow * 1024 + i * 256 + l * 4);
    }
    ss = wave_sum(ss);
    const float rs = rsqrtf(ss * (1.0f / 1024.0f) + 1e-6f);
#pragma unroll
    for (int i = 0; i < 4; ++i) {
      const int c0 = i * 256 + l * 4;
      f4v gt = *(const f4v*)(gate + c0);
      f4v pn = *(const f4v*)(post + c0);
      f4v o;
#pragma unroll
      for (int q = 0; q < 4; ++q) { o[q] = xv[i * 4 + q] + gt[q] * (yv[i * 4 + q] * rs * pn[q]); xv[i * 4 + q] = o[q]; }
      *(f4v*)(p.out + (size_t)row * 1024 + c0) = o;
    }
    if (layer + 1 < DEPTH)
      write_h_row(xv, p.pre_norm + (layer + 1) * 1024, MOD + (layer + 1) * 3072, H + (size_t)row * HP, l);
  }
}

#define XB_TMO      128
#define XB_XCNT(j)  (256  + 64 * (j))
#define XB_XSUB(j)  (1280 + 64 * (j))
#define XB_XGEN(j)  (2304 + 64 * (j))
#define XB_TOP      3328
#define XB_TOPGEN   3392
#define XCD_BAR_WORDS 3456
#define XB_SPIN_CAP (1u << 18)
#define LAS __attribute__((address_space(3)))

__device__ __forceinline__ unsigned xb_ld(unsigned* p)              { return __hip_atomic_load(p, __ATOMIC_RELAXED, __HIP_MEMORY_SCOPE_AGENT); }
__device__ __forceinline__ unsigned xb_add(unsigned* p, unsigned v) { return __hip_atomic_fetch_add(p, v, __ATOMIC_RELAXED, __HIP_MEMORY_SCOPE_AGENT); }
__device__ __forceinline__ unsigned xb_xcc_id() { return (unsigned)__builtin_amdgcn_s_getreg((3 << 11) | 20) & 0xFu; }
#define XB_SPIN(cond, bar) do { unsigned _sp = 0; while (cond) { __builtin_amdgcn_s_sleep(1); \
    if ((++_sp & 255u) == 0u) { if (xb_ld(&(bar)[XB_TMO])) break; if (_sp > XB_SPIN_CAP) { atomicAdd(&(bar)[XB_TMO], 1u); break; } } } } while (0)

struct XcdBarrier {
    unsigned* bar; unsigned x;
    volatile LAS unsigned* st;
};

__device__ __forceinline__ XcdBarrier xcd_barrier_post(unsigned* bar, volatile LAS unsigned* st) {
    XcdBarrier b; b.bar = bar; b.x = xb_xcc_id(); b.st = st;
    if (otid() == 0) (void)xb_add(&bar[XB_XCNT(b.x)], 1u);
    return b;
}
__device__ __forceinline__ void xcd_barrier_complete(unsigned* bar, unsigned x, unsigned& nloc, unsigned& nx) {
    const unsigned G = gridDim.x * gridDim.y * gridDim.z;
    unsigned sum, cnt, mine, sp = 0u;
    for (;;) {
        sum = 0u; cnt = 0u; mine = 0u;
#pragma unroll
        for (unsigned j = 0; j < 16; ++j) { const unsigned c = xb_ld(&bar[XB_XCNT(j)]); sum += c; cnt += (c > 0u) ? 1u : 0u; mine = (j == x) ? c : mine; }
        if (sum == G) break;
        __builtin_amdgcn_s_sleep(1);
        if ((++sp & 255u) == 0u) { if (xb_ld(&bar[XB_TMO])) break; if (sp > XB_SPIN_CAP) { atomicAdd(&bar[XB_TMO], 1u); break; } }
    }
    nloc = mine > 0u ? mine : 1u; nx = cnt > 0u ? cnt : 1u;
}

__device__ __forceinline__ void xcd_barrier(const XcdBarrier& b) {
    asm volatile("s_waitcnt vmcnt(0)" ::: "memory");
    __syncthreads();
    if (otid() == 0) {
        unsigned* bar = b.bar;
        __builtin_amdgcn_s_waitcnt(0);
        unsigned nloc = b.st[0], nx = b.st[1];
        if (nloc == 0u) { xcd_barrier_complete(bar, b.x, nloc, nx); b.st[0] = nloc; b.st[1] = nx; }
        const unsigned old = xb_add(&bar[XB_XSUB(b.x)], 1u);
        const unsigned gen = old / nloc;
        if (old + 1u == (gen + 1u) * nloc) {
            __builtin_amdgcn_fence(__ATOMIC_RELEASE, "agent");
            asm volatile("s_waitcnt vmcnt(0)" ::: "memory");
            const unsigned og = xb_add(&bar[XB_TOP], 1u);
            const unsigned tg = og / nx;
            if (og + 1u == (tg + 1u) * nx) xb_add(&bar[XB_TOPGEN], 1u);
            else XB_SPIN(xb_ld(&bar[XB_TOPGEN]) == tg, bar);
            __builtin_amdgcn_fence(__ATOMIC_ACQUIRE, "agent");
            xb_add(&bar[XB_XGEN(b.x)], 1u);
            asm volatile("s_waitcnt vmcnt(0)" ::: "memory");
        } else {
            XB_SPIN(xb_ld(&bar[XB_XGEN(b.x)]) == gen, bar);
            __builtin_amdgcn_fence(__ATOMIC_ACQUIRE, "agent");
            asm volatile("s_waitcnt vmcnt(0)" ::: "memory");
        }
    }
    __syncthreads();
}


};

#ifndef REP_D
#define REP_D 1
#endif
#ifndef REP_E
#define REP_E 1
#endif
#ifndef REP_A
#define REP_A 1
#endif
#ifndef REP_B
#define REP_B 1
#endif
#ifdef ONLY_PHASE
#define PH_EN(x) (ONLY_PHASE == (x))
#else
#define PH_EN(x) true
#endif
__global__ void __launch_bounds__(NTHREADS) fwd_megakernel(Params p) {
  extern __shared__ __attribute__((aligned(16))) unsigned char lds[];
  cg::grid_group grid = cg::this_grid();
  K k; k.wbase = __builtin_amdgcn_readfirstlane((int)__builtin_amdgcn_workitem_id_x()) & ~63;
  unsigned* bar = (unsigned*)(p.ws + WS_END);
  unsigned* xcnt = bar + 16;
  unsigned* xbar = (unsigned*)(p.ws + WS_END + 1024);
  if (blockIdx.x == 0) {
    if (k.otid() < 17) __hip_atomic_store(bar + (k.otid() == 16 ? 0 : 16 + k.otid()), 0u, __ATOMIC_RELAXED, __HIP_MEMORY_SCOPE_AGENT);
    for (int i = k.otid(); i < XCD_BAR_WORDS; i += NTHREADS) __hip_atomic_store(xbar + i, 0u, __ATOMIC_RELAXED, __HIP_MEMORY_SCOPE_AGENT);
  }
  volatile LAS unsigned* xst = (volatile LAS unsigned*)(lds + LDS_BYTES - 16);
  if (k.otid() == 0) { xst[0] = 0u; xst[1] = 0u; }
  __syncthreads();
  K::XcdBarrier xb; xb.bar = xbar; xb.x = 0; xb.st = xst;
  int my_xcc = 0, my_loc = 0;
  for (int ph = p.ph_lo; ph < p.ph_hi; ++ph) {
    if (ph == 0) { if (PH_EN(0)) for (int rep = 0; rep < REP_P; ++rep) { k.phase_prologue(p, lds); __syncthreads(); } }
    else if (ph == 1) {
      xb = k.xcd_barrier_post(xbar, xst);
      int* sh = (int*)lds;
      if (k.otid() == 0) {
        const int xc = (int)(__builtin_amdgcn_s_getreg((3 << 11) | 20) & 0xFu);
        sh[0] = xc;
        sh[1] = (int)__hip_atomic_fetch_add(xcnt + xc, 1u, __ATOMIC_RELAXED, __HIP_MEMORY_SCOPE_AGENT);
      }
      __syncthreads();
      my_xcc = __builtin_amdgcn_readfirstlane(sh[0]);
      my_loc = __builtin_amdgcn_readfirstlane(sh[1]);
      __syncthreads();
      if (PH_EN(1)) k.phase_h0(p);
    }
    else {
      const int layer = (ph - 2) / 7, sub = (ph - 2) % 7;
      if (sub == 0) { if (PH_EN(2)) for (int rep = 0; rep < REP_A; ++rep) { k.phase_A(p, layer, lds, my_xcc, my_loc, xcnt); __syncthreads(); } }
      else if (sub == 1) { if (PH_EN(3)) for (int rep = 0; rep < REP_B; ++rep) { k.phase_B(p, layer, lds); __syncthreads(); } }
      else if (sub == 2) { if (PH_EN(4)) k.phase_scan(p); }
      else if (sub == 3) { if (PH_EN(5)) for (int rep = 0; rep < REP_D; ++rep) { for (int it = blockIdx.x; it < 2048; it += gridDim.x) k.la_item_out(p, layer, it, lds); __syncthreads(); } }
      else if (sub == 4) { if (PH_EN(6)) for (int rep = 0; rep < REP_E; ++rep) { k.phase_E1(p, layer, lds, my_xcc, my_loc, xcnt); __syncthreads(); } }
      else if (sub == 5) { if (PH_EN(7)) for (int rep = 0; rep < REP_E; ++rep) { k.phase_E2(p, layer, lds, my_xcc, my_loc, xcnt); __syncthreads(); } }
      else { if (PH_EN(8)) k.phase_E3(p, layer); }
    }
    if (ph + 1 < p.ph_hi) {
      if (ph == p.ph_lo) grid.sync();
      else k.xcd_barrier(xb);
    }
  }
}

extern "C" void kernel_launch(void* const* d_in, const int* in_sizes, int n_in, void* d_out, int out_size,
                              void* d_ws, size_t ws_size, hipStream_t stream) {
  static int grid_blocks = 0;
  if (!grid_blocks) {
    int dev = 0, cus = 0, per_cu = 0;
    hipGetDevice(&dev);
    hipDeviceGetAttribute(&cus, hipDeviceAttributeMultiprocessorCount, dev);
    hipFuncSetAttribute((const void*)fwd_megakernel, hipFuncAttributeMaxDynamicSharedMemorySize, LDS_BYTES);
    hipOccupancyMaxActiveBlocksPerMultiprocessor(&per_cu, (const void*)fwd_megakernel, NTHREADS, LDS_BYTES);
    if (per_cu < 1) per_cu = 1;
    if (per_cu > 1) per_cu = 1;
    grid_blocks = cus * per_cu;
    if (ws_size < WS_END) fprintf(stderr, "workspace too small: %zu < %llu\n", ws_size, (unsigned long long)WS_END);
  }
  Params p{};
  p.x = (const float*)d_in[0]; p.c = (const float*)d_in[1]; p.pos = (const int*)d_in[2];
  p.ada_w = (const float*)d_in[3]; p.ada_b = (const float*)d_in[4];
  p.pre_norm = (const float*)d_in[5]; p.post_norm = (const float*)d_in[6];
  p.w_in = (const float*)d_in[7]; p.gla_w_lr = (const float*)d_in[8]; p.gla_b_lr = (const float*)d_in[9];
  p.w_br_ret = (const float*)d_in[10]; p.w_br_dsa = (const float*)d_in[11]; p.w_br_gla = (const float*)d_in[12];
  p.w_out = (const float*)d_in[13];
  p.out = (float*)d_out; p.ws = (unsigned char*)d_ws;
  p.ph_lo = 0; p.ph_hi = 2 + 7 * DEPTH;
  void* args[] = {&p};
  hipError_t e = hipLaunchCooperativeKernel((const void*)fwd_megakernel, dim3(grid_blocks), dim3(NTHREADS), args, LDS_BYTES, stream);
  if (e != hipSuccess) fprintf(stderr, "cooperative launch failed: %s (grid %d)\n", hipGetErrorString(e), grid_blocks);
}
```
